# Optimizing an MI355X kernel written in HIP

```python
import math
import jax, jax.numpy as jnp
from jax import lax
import numpy as np

D_MODEL = 2048
BATCH = 2
SEQ = 4096
DEPTH = 1

GRID_W = 64
CTX_LEN = 256
EPS = 1e-6
ROPE_BASE = 10000.0
H_R = 8
R_DK = 128
R_DV = 256
RET_CHUNK = 128
H_D = 8
D_HEAD = 64
Q_BLOCK = 128
RK = H_R * R_DK
RV = H_R * R_DV
DKW = H_D * 2 * D_HEAD
DVW = H_D * 2 * D_HEAD
KV_COLS = RK + RV + DKW + DVW
Q_COLS = RK + RV + DKW + 2 * D_MODEL
IN_COLS = KV_COLS + Q_COLS
N_EXPERTS = 256
TOP_K = 8
N_GROUPS = 8
TOPK_GROUPS = 4
D_EXPERT = 256
D_SHARED = 256
ROUTED_SCALE = 2.5
MOE_BLOCK = 64

kernel_name = 'hybrid_retention_diffattn_moe_dit'


def rms_norm(x, w):
    xf = x.astype(jnp.float32)
    y = xf * lax.rsqrt(jnp.mean(xf * xf, axis=-1, keepdims=True) + EPS) * w.astype(jnp.float32)
    return y.astype(x.dtype)


def modulate(h, shift, scale):
    return h * (1.0 + scale) + shift


def rope_1d(x, pos):
    half = x.shape[-1] // 2
    inv = ROPE_BASE ** (-jnp.arange(half, dtype=jnp.float32) / half)
    ang = pos.astype(jnp.float32)[:, None] * inv
    shape = (1, pos.shape[0]) + (1,) * (x.ndim - 3) + (half,)
    cos = jnp.cos(ang).reshape(shape)
    sin = jnp.sin(ang).reshape(shape)
    xf = x.astype(jnp.float32)
    x1, x2 = xf[..., :half], xf[..., half:]
    return jnp.concatenate([x1 * cos - x2 * sin, x1 * sin + x2 * cos], axis=-1).astype(x.dtype)


def axial_rope(x, row, col):
    half = x.shape[-1] // 2
    return jnp.concatenate([rope_1d(x[..., :half], row), rope_1d(x[..., half:], col)], axis=-1)


def kv_heads(p):
    B, n = p.shape[:2]
    rk, rv, dk, dv = jnp.split(p[..., :KV_COLS], [RK, RK + RV, RK + RV + DKW], axis=-1)
    return (rk.reshape(B, n, H_R, R_DK), rv.reshape(B, n, H_R, R_DV),
            dk.reshape(B, n, H_D, 2, D_HEAD), dv.reshape(B, n, H_D, 2 * D_HEAD))


def q_heads(p):
    B, n = p.shape[:2]
    rq, rg, dq, gates = jnp.split(p[..., KV_COLS:], [RK, RK + RV, RK + RV + DKW], axis=-1)
    return rq.reshape(B, n, H_R, R_DK), rg, dq.reshape(B, n, H_D, 2, D_HEAD), gates


def retention_scan(q, k, v, log_g, state0, strict):
    B, n, H, dk = q.shape
    dv = v.shape[-1]
    nc = n // RET_CHUNK

    def chunks(t):
        return t.reshape(B, nc, RET_CHUNK, H, t.shape[-1]).transpose(1, 0, 3, 2, 4)

    pos = jnp.arange(RET_CHUNK, dtype=jnp.float32)
    dist = pos[:, None] - pos[None, :]
    keep = dist > 0 if strict else dist >= 0
    d_mask = jnp.where(keep, jnp.exp(log_g[:, None, None] * jnp.maximum(dist, 0.0)), 0.0)
    q_dec = jnp.exp(log_g[:, None] * (pos + 1.0))[:, :, None]
    k_dec = jnp.exp(log_g[:, None] * (RET_CHUNK - 1.0 - pos))[:, :, None]
    c_dec = jnp.exp(log_g * RET_CHUNK)[:, None, None]

    def step(S, blk):
        qb, kb, vb = blk
        scores = jnp.einsum('bhid,bhjd->bhij', qb, kb) * d_mask
        out = (jnp.einsum('bhij,bhje->bhie', scores, vb)
               + jnp.einsum('bhid,bhde->bhie', qb * q_dec, S))
        S = S * c_dec + jnp.einsum('bhjd,bhje->bhde', kb * k_dec, vb)
        return S, out

    _, outs = lax.scan(step, state0, (chunks(q), chunks(k), chunks(v)))
    return outs.transpose(1, 0, 3, 2, 4).reshape(B, n, H, dv)


def ret_ctx_states(rk, rv, log_g):
    L = rk.shape[1]
    m = jnp.arange(L, dtype=jnp.float32)
    k = rk.astype(jnp.float32)
    v = rv.astype(jnp.float32)
    w_f = jnp.exp(log_g[0][:, None] * (L - 1.0 - m))
    w_b = jnp.exp(log_g[1][:, None] * m)
    s_f = jnp.einsum('blhd,hl,blhe->bhde', k, w_f, v)
    s_b = jnp.einsum('blhd,hl,blhe->bhde', k, w_b, v)
    return s_f, s_b


def retention_branch(rq, rk, rv, rg, log_g, s_f, s_b, w_o):
    B, n = rq.shape[:2]
    f = jnp.float32
    q = rq.astype(f) * R_DK ** -0.5
    k = rk.astype(f)
    v = rv.astype(f)
    o_f = retention_scan(q, k, v, log_g[0], s_f, strict=False)
    o_b = retention_scan(q[:, ::-1], k[:, ::-1], v[:, ::-1], log_g[1], s_b, strict=True)[:, ::-1]
    o = o_f + o_b
    o = o * lax.rsqrt(jnp.mean(o * o, axis=-1, keepdims=True) + EPS)
    o = o.reshape(B, n, RV).astype(rg.dtype) * jax.nn.silu(rg)
    return o @ w_o


def diff_attend(q, k, v, lam):
    B, n, H, _, d = q.shape
    nb = n // Q_BLOCK
    qb = q.reshape(B, nb, Q_BLOCK, H, 2, d).transpose(1, 0, 2, 3, 4, 5)
    scale = d ** -0.5

    def one_block(qi):
        s = jnp.einsum('bqhcd,bkhcd->bchqk', qi, k) * scale
        p = jax.nn.softmax(s, axis=-1)
        a = p[:, 0] - lam * p[:, 1]
        return jnp.einsum('bhqk,bkhe->bqhe', a, v)

    o = lax.map(one_block, qb)
    return o.transpose(1, 0, 2, 3, 4).reshape(B, n, H, 2 * d)


def diff_branch(dq, dk, dv, lam, lam_init, subln_w, w_o):
    B, n = dq.shape[:2]
    f = jnp.float32
    o = diff_attend(dq.astype(f), dk.astype(f), dv.astype(f), lam)
    o = o * lax.rsqrt(jnp.mean(o * o, axis=-1, keepdims=True) + EPS) * subln_w.astype(f) * (1.0 - lam_init)
    return o.reshape(B, n, DVW).astype(dq.dtype) @ w_o


def mixer_output(rq, rg, dq, gates, rk, rv, k_att, v_att, s_f, s_b, log_g, lam, lam_init,
                 subln_w, w_ret_o, w_diff_o, w_out):
    ret_o = retention_branch(rq, rk, rv, rg, log_g, s_f, s_b, w_ret_o)
    diff_o = diff_branch(dq, k_att, v_att, lam, lam_init, subln_w, w_diff_o)
    g_r, g_d = jnp.split(gates, 2, axis=-1)
    return (jax.nn.sigmoid(g_r) * ret_o + jax.nn.sigmoid(g_d) * diff_o) @ w_out


def moe_ffn(h, w_router, router_bias, w_exp_gu, w_exp_down, w_sh_gu, w_sh_down):
    T = h.shape[0]
    f = jnp.float32
    scores = jax.nn.sigmoid(h.astype(f) @ w_router.astype(f).T)
    sel = scores + router_bias.astype(f)
    grp = sel.reshape(T, N_GROUPS, N_EXPERTS // N_GROUPS)
    grp_score = lax.top_k(grp, 2)[0].sum(-1)
    _, top_g = lax.top_k(grp_score, TOPK_GROUPS)
    gmask = jnp.any(top_g[..., None] == jnp.arange(N_GROUPS), axis=-2)
    emask = jnp.repeat(gmask, N_EXPERTS // N_GROUPS, axis=-1)
    _, eidx = lax.top_k(jnp.where(emask, sel, -jnp.inf), TOP_K)
    wts = jnp.take_along_axis(scores, eidx, axis=-1)
    wts = wts / jnp.sum(wts, axis=-1, keepdims=True) * ROUTED_SCALE

    n_assign = T * TOP_K
    e_flat = eidx.reshape(-1)
    t_flat = jnp.repeat(jnp.arange(T, dtype=jnp.int32), TOP_K)
    w_flat = wts.reshape(-1)
    order = jnp.argsort(e_flat)
    e_s, t_s, w_s = e_flat[order], t_flat[order], w_flat[order]
    counts = jax.ops.segment_sum(jnp.ones_like(e_flat), e_flat, num_segments=N_EXPERTS)
    padded = (counts + MOE_BLOCK - 1) // MOE_BLOCK * MOE_BLOCK
    starts = jnp.cumsum(counts) - counts
    p_ends = jnp.cumsum(padded)
    p_starts = p_ends - padded
    dest = p_starts[e_s] + jnp.arange(n_assign, dtype=jnp.int32) - starts[e_s]
    n_rows = -(-(n_assign + N_EXPERTS * (MOE_BLOCK - 1)) // MOE_BLOCK) * MOE_BLOCK
    row_tok = jnp.zeros((n_rows,), jnp.int32).at[dest].set(t_s)
    row_w = jnp.zeros((n_rows,), f).at[dest].set(w_s)
    n_blocks = n_rows // MOE_BLOCK
    blk_exp = jnp.minimum(
        jnp.searchsorted(p_ends, jnp.arange(n_blocks, dtype=jnp.int32) * MOE_BLOCK, side='right'),
        N_EXPERTS - 1)

    def step(acc, blk):
        rows, bw, e = blk
        g, u = jnp.split(h[rows] @ w_exp_gu[e], 2, axis=-1)
        y = (jax.nn.silu(g) * u) @ w_exp_down[e]
        return acc.at[rows].add(y * bw[:, None].astype(y.dtype)), None

    routed, _ = lax.scan(step, jnp.zeros_like(h),
                         (row_tok.reshape(n_blocks, MOE_BLOCK), row_w.reshape(n_blocks, MOE_BLOCK), blk_exp))
    gs, us = jnp.split(h @ w_sh_gu, 2, axis=-1)
    return routed + (jax.nn.silu(gs) * us) @ w_sh_down


def setup_inputs(seed: int = 0) -> dict:
    key = jax.random.key(seed)
    ks = jax.random.split(key, 24)
    f = jnp.float32
    D = D_MODEL

    def nrm(k, shape, scale=1.0):
        return jax.random.normal(k, shape, f) * scale

    decay0 = jnp.log(-jnp.log1p(-(2.0 ** (-5.0 - jnp.arange(H_R, dtype=f)))))
    return {
        'x': nrm(ks[0], (BATCH, SEQ, D)),
        'c': nrm(ks[1], (BATCH, D)),
        'ctx': nrm(ks[2], (BATCH, CTX_LEN, D)),
        'c_ctx': nrm(ks[3], (D,)),
        'w_mod': nrm(ks[4], (DEPTH, D, 6 * D), 0.5 * D ** -0.5),
        'b_mod': nrm(ks[5], (DEPTH, 6 * D), 0.01),
        'norm_attn': 1.0 + nrm(ks[6], (DEPTH, D), 0.05),
        'norm_ffn': 1.0 + nrm(ks[7], (DEPTH, D), 0.05),
        'w_in': nrm(ks[8], (DEPTH, D, IN_COLS), D ** -0.5),
        'ret_decay': decay0 + nrm(ks[9], (DEPTH, 2, H_R), 0.05),
        'diff_lambda': nrm(ks[10], (DEPTH, 4, D_HEAD), 0.1),
        'diff_subln': 1.0 + nrm(ks[11], (DEPTH, 2 * D_HEAD), 0.05),
        'w_ret_o': nrm(ks[12], (DEPTH, RV, D), RV ** -0.5),
        'w_diff_o': nrm(ks[13], (DEPTH, DVW, D), DVW ** -0.5),
        'w_out': nrm(ks[14], (DEPTH, D, D), D ** -0.5),
        'w_router': nrm(ks[15], (DEPTH, N_EXPERTS, D), D ** -0.5),
        'router_bias': nrm(ks[16], (DEPTH, N_EXPERTS), 0.01),
        'w_exp_gu': nrm(ks[17], (DEPTH, N_EXPERTS, D, 2 * D_EXPERT), D ** -0.5),
        'w_exp_down': nrm(ks[18], (DEPTH, N_EXPERTS, D_EXPERT, D), D_EXPERT ** -0.5),
        'w_sh_gu': nrm(ks[19], (DEPTH, D, 2 * D_SHARED), D ** -0.5),
        'w_sh_down': nrm(ks[20], (DEPTH, D_SHARED, D), D_SHARED ** -0.5),
        'final_norm': 1.0 + nrm(ks[21], (D,), 0.05),
    }


def reference(x, c, ctx, c_ctx, w_mod, b_mod, norm_attn, norm_ffn, w_in, ret_decay,
              diff_lambda, diff_subln, w_ret_o, w_diff_o, w_out, w_router, router_bias,
              w_exp_gu, w_exp_down, w_sh_gu, w_sh_down, final_norm):
    B, n_lat, D = x.shape
    rows = n_lat // GRID_W
    row = jnp.repeat(jnp.arange(rows, dtype=jnp.int32), GRID_W)
    col = jnp.tile(jnp.arange(GRID_W, dtype=jnp.int32), rows)
    xc = ctx
    silu_c = jax.nn.silu(c)
    silu_cc = jax.nn.silu(c_ctx)
    for l in range(DEPTH):
        last = l == DEPTH - 1
        lam_init = 0.8 - 0.6 * math.exp(-0.3 * l)
        mod = (silu_c @ w_mod[l] + b_mod[l])[:, None, :]
        mod_c = (silu_cc @ w_mod[l] + b_mod[l])[None, None, :]
        sh1, sc1, g1, sh2, sc2, g2 = jnp.split(mod, 6, axis=-1)
        sh1c, sc1c, g1c, sh2c, sc2c, g2c = jnp.split(mod_c, 6, axis=-1)
        log_g = -jnp.exp(ret_decay[l].astype(jnp.float32))
        dl = diff_lambda[l].astype(jnp.float32)
        lam = jnp.exp(jnp.sum(dl[0] * dl[1])) - jnp.exp(jnp.sum(dl[2] * dl[3])) + lam_init

        h = modulate(rms_norm(x, norm_attn[l]), sh1, sc1)
        hc = modulate(rms_norm(xc, norm_attn[l]), sh1c, sc1c)
        p = h @ w_in[l]
        pc = hc @ (w_in[l][:, :KV_COLS] if last else w_in[l])
        rq, rg, dq, gates = q_heads(p)
        rk, rv, dk, dv = kv_heads(p)
        rq, rk = axial_rope(rq, row, col), axial_rope(rk, row, col)
        dq, dk = axial_rope(dq, row, col), axial_rope(dk, row, col)
        rkc, rvc, dkc, dvc = kv_heads(pc)
        s_f, s_b = ret_ctx_states(rkc, rvc, log_g)
        mix = mixer_output(rq, rg, dq, gates, rk, rv,
                           jnp.concatenate([dkc, dk], axis=1), jnp.concatenate([dvc, dv], axis=1),
                           s_f, s_b, log_g, lam, lam_init, diff_subln[l], w_ret_o[l], w_diff_o[l], w_out[l])
        if not last:
            rqc, rgc, dqc, gatesc = q_heads(pc)
            zero_state = jnp.zeros_like(s_f)
            mix_c = mixer_output(rqc, rgc, dqc, gatesc, rkc, rvc, dkc, dvc, zero_state, zero_state,
                                 log_g, lam, lam_init, diff_subln[l], w_ret_o[l], w_diff_o[l], w_out[l])
            xc = xc + g1c * mix_c
            hc2 = modulate(rms_norm(xc, norm_ffn[l]), sh2c, sc2c)
            xc = xc + g2c * moe_ffn(hc2.reshape(-1, D), w_router[l], router_bias[l], w_exp_gu[l],
                                    w_exp_down[l], w_sh_gu[l], w_sh_down[l]).reshape(xc.shape)
        x = x + g1 * mix

        h2 = modulate(rms_norm(x, norm_ffn[l]), sh2, sc2)
        x = x + g2 * moe_ffn(h2.reshape(-1, D), w_router[l], router_bias[l], w_exp_gu[l],
                             w_exp_down[l], w_sh_gu[l], w_sh_down[l]).reshape(x.shape)
    return rms_norm(x, final_norm)
```

```cpp
#include <hip/hip_runtime.h>
#include <cstdio>
#include <cstdint>

#define LAS __attribute__((address_space(3)))
#define GAS __attribute__((address_space(1)))
typedef _Float16 h16;
typedef _Float16 h16x8 __attribute__((ext_vector_type(8)));
typedef _Float16 h16x4 __attribute__((ext_vector_type(4)));
typedef _Float16 h16x2 __attribute__((ext_vector_type(2)));
typedef float f32x2 __attribute__((ext_vector_type(2)));
typedef float f32x4 __attribute__((ext_vector_type(4)));
typedef float f32x16 __attribute__((ext_vector_type(16)));
typedef unsigned u32x4 __attribute__((ext_vector_type(4)));
typedef unsigned u32x2 __attribute__((ext_vector_type(2)));
typedef short v4i16_t __attribute__((ext_vector_type(4)));

constexpr int DM = 2048, NBATCH = 2, SEQ = 4096, CTXL = 256;
constexpr int MLAT = NBATCH * SEQ, MCTX = NBATCH * CTXL, MALL = MLAT + MCTX;
constexpr int IN_COLS = 13312, KV_COLS = 5120;
constexpr int C_RK = 0, C_RV = 1024, C_DK = 3072, C_DV = 4096, C_RQ = 5120, C_RG = 6144, C_DQ = 8192, C_GR = 9216, C_GD = 11264;
constexpr int NEXP = 256, TOPK = 8, DEXP = 256;
constexpr float EPS = 1e-6f;
constexpr int NWAVES = 8, NTHR = 512;

constexpr size_t MiB = 1u << 20;
constexpr size_t WS_CTL = 0, CTL_ZERO_BYTES = 1 * MiB;
constexpr size_t WS_MODP = 1 * MiB;
constexpr size_t WS_MOD = 3 * MiB;
constexpr size_t WS_ROPE = 3 * MiB + 512 * 1024;
constexpr size_t WS_WINT = 4 * MiB;
constexpr size_t WS_WRET = 56 * MiB;
constexpr size_t WS_WDIF = 64 * MiB;
constexpr size_t WS_WOUT = 68 * MiB;
constexpr size_t WS_WSGU = 76 * MiB;
constexpr size_t WS_WSDN = 78 * MiB;
constexpr size_t WS_WRTR = 79 * MiB;
constexpr size_t WS_H = 82 * MiB;
constexpr size_t WS_P = 116 * MiB;
constexpr size_t WS_LST = 340 * MiB;
constexpr size_t WS_SST = 408 * MiB;
constexpr size_t WS_ARET = 472 * MiB;
constexpr size_t WS_ADIF = 504 * MiB;
constexpr size_t WS_T = 520 * MiB;
constexpr size_t WS_U = 584 * MiB;
constexpr size_t WS_X1 = 616 * MiB;
constexpr size_t WS_H2X = 680 * MiB;
constexpr size_t WS_LG = 776 * MiB;
constexpr size_t WS_EIDX = 784 * MiB;
constexpr size_t WS_EW = 785 * MiB;
constexpr size_t WS_LIST = 786 * MiB;
constexpr size_t WS_ACTS = 794 * MiB;
constexpr size_t WS_YSH = 798 * MiB;
constexpr size_t WS_Y = 830 * MiB;
constexpr size_t WS_ACT = 1086 * MiB;
constexpr size_t WS_LGP = 1118 * MiB;
constexpr size_t WS_SGP = 1182 * MiB;
constexpr size_t WS_ACAT = 1246 * MiB;
constexpr size_t WS_WCAT = 1294 * MiB;
constexpr size_t WS_LIST2 = 1306 * MiB;
constexpr size_t WS_END = 1322 * MiB;

constexpr int CW_BAR = 4096;
constexpr int CW_CNT = 16384;
constexpr int CW_Q = 20480;

constexpr int RING_BYTES = 131072;
constexpr int LDS_BYTES = 163840;
constexpr int LDSCTL_OFF = LDS_BYTES - 512;

#define XB_TMO      128
#define XB_XCNT(j)  (256  + 64 * (j))
#define XB_XSUB(j)  (1280 + 64 * (j))
#define XB_XGEN(j)  (2304 + 64 * (j))
#define XB_TOP      3328
#define XB_TOPGEN   3392
#define XCD_BAR_WORDS 3456
#define XB_SPIN_CAP (1u << 18)

__device__ __forceinline__ unsigned xb_ld(unsigned* p)              { return __hip_atomic_load(p, __ATOMIC_RELAXED, __HIP_MEMORY_SCOPE_AGENT); }
__device__ __forceinline__ unsigned xb_add(unsigned* p, unsigned v) { return __hip_atomic_fetch_add(p, v, __ATOMIC_RELAXED, __HIP_MEMORY_SCOPE_AGENT); }
__device__ __forceinline__ unsigned xb_xcc_id() { return (unsigned)__builtin_amdgcn_s_getreg((3 << 11) | 20) & 0xFu; }
#define XB_SPIN(cond, bar) do { unsigned _sp = 0; while (cond) { __builtin_amdgcn_s_sleep(1); \
    if ((++_sp & 255u) == 0u) { if (xb_ld(&(bar)[XB_TMO])) break; if (_sp > XB_SPIN_CAP) { atomicAdd(&(bar)[XB_TMO], 1u); break; } } } } while (0)

struct XcdBarrier { unsigned* bar; unsigned x; volatile LAS unsigned* st; };

__device__ __forceinline__ XcdBarrier xcd_barrier_post(unsigned* bar, volatile LAS unsigned* st) {
    XcdBarrier b; b.bar = bar; b.x = xb_xcc_id(); b.st = st;
    if (threadIdx.x == 0) (void)xb_add(&bar[XB_XCNT(b.x)], 1u);
    return b;
}
__device__ __forceinline__ void xcd_barrier_complete(unsigned* bar, unsigned x, unsigned& nloc, unsigned& nx) {
    const unsigned G = gridDim.x * gridDim.y * gridDim.z;
    unsigned sum, cnt, mine, sp = 0u;
    for (;;) {
        sum = 0u; cnt = 0u; mine = 0u;
#pragma unroll
        for (unsigned j = 0; j < 16; ++j) { const unsigned c = xb_ld(&bar[XB_XCNT(j)]); sum += c; cnt += (c > 0u) ? 1u : 0u; mine = (j == x) ? c : mine; }
        if (sum == G) break;
        __builtin_amdgcn_s_sleep(1);
        if ((++sp & 255u) == 0u) { if (xb_ld(&bar[XB_TMO])) break; if (sp > XB_SPIN_CAP) { atomicAdd(&bar[XB_TMO], 1u); break; } }
    }
    nloc = mine > 0u ? mine : 1u; nx = cnt > 0u ? cnt : 1u;
}
__device__ __forceinline__ void xcd_barrier(const XcdBarrier& b) {
    asm volatile("s_waitcnt vmcnt(0)" ::: "memory");
    __syncthreads();
    if (threadIdx.x == 0) {
        unsigned* bar = b.bar;
        __builtin_amdgcn_s_waitcnt(0);
        unsigned nloc = b.st[0], nx = b.st[1];
        if (nloc == 0u) { xcd_barrier_complete(bar, b.x, nloc, nx); b.st[0] = nloc; b.st[1] = nx; }
        const unsigned old = xb_add(&bar[XB_XSUB(b.x)], 1u);
        const unsigned gen = old / nloc;
        if (old + 1u == (gen + 1u) * nloc) {
            __builtin_amdgcn_fence(__ATOMIC_RELEASE, "agent");
            asm volatile("s_waitcnt vmcnt(0)" ::: "memory");
            const unsigned og = xb_add(&bar[XB_TOP], 1u);
            const unsigned tg = og / nx;
            if (og + 1u == (tg + 1u) * nx) xb_add(&bar[XB_TOPGEN], 1u);
            else XB_SPIN(xb_ld(&bar[XB_TOPGEN]) == tg, bar);
            __builtin_amdgcn_fence(__ATOMIC_ACQUIRE, "agent");
            xb_add(&bar[XB_XGEN(b.x)], 1u);
            asm volatile("s_waitcnt vmcnt(0)" ::: "memory");
        } else {
            XB_SPIN(xb_ld(&bar[XB_XGEN(b.x)]) == gen, bar);
            __builtin_amdgcn_fence(__ATOMIC_ACQUIRE, "agent");
            asm volatile("s_waitcnt vmcnt(0)" ::: "memory");
        }
    }
    __syncthreads();
}


namespace pg8 {
constexpr int BM = 256, BK = 64, HALF = 128, HTB = HALF * BK * 2, STAGE_BYTES = 8 * HTB, NXCD = 8, WGM = 8;
__host__ __device__ __forceinline__ int lds_byte(int r, int c) { const int st = (r >> 4) * 2 + (c >> 5), rr = r & 15, cc = c & 31, ob = rr * 64 + cc * 2; return st * 1024 + (ob ^ (((ob >> 9) & 1) << 5)); }
__host__ __device__ __forceinline__ void stage_rc(int b, int& R, int& C) { const int st = b / 1024, sb = b % 1024, swz = sb ^ (((sb >> 9) & 1) << 5); R = (st >> 1) * 16 + swz / 64; C = (st & 1) * 32 + (swz % 64) / 2; }
struct Unit { int pm, pn, ko, nt, keep; };
struct Gemm { const h16* A; const h16* Bt; int lda, ldb, K; };
struct StaticOrder {
    int nM, nN, nwg, G, c;
    __host__ __device__ void init(int M, int N, int G_, int c_) { nM = M / BM; nN = N / BM; nwg = nM * nN; G = G_; c = c_; }
    __host__ __device__ bool next(int i, Unit& u) const {
        const long L = (long)i * G + c; if (L >= nwg) return false;
        int wgid = (int)L; { const int q = nwg / NXCD, r = nwg % NXCD, xcd = wgid % NXCD, off = wgid / NXCD; wgid = (xcd < r ? xcd * (q + 1) : r * (q + 1) + (xcd - r) * q) + off; }
        const int nig = WGM * nN, gid = wgid / nig, fm = gid * WGM, gsz = (nM - fm) < WGM ? (nM - fm) : WGM;
        u.pm = fm + ((wgid % nig) % gsz); u.pn = (wgid % nig) / gsz; u.ko = 0; u.nt = 0; u.keep = 0; return true;
    }
};
template <class Epi, class Sched, bool ALIGN_EPI = true>
__device__ __forceinline__ void gemm_phase(LAS unsigned char* lds, const Gemm g, const Sched& S, const Epi& E) {
    const int tid = threadIdx.x, wid = __builtin_amdgcn_readfirstlane(tid >> 6), lane = tid & 63, wr = wid >> 2, wc = wid & 3, fr = lane & 15, fq = lane >> 4;
    const int nt0 = g.K / BK;
    unsigned voffA[2], voffB[2];
#pragma unroll
    for (int i = 0; i < 2; ++i) { int R, C; stage_rc(tid * 16 + i * 8192, R, C); voffA[i] = (unsigned)(R * g.lda + C) * 2u; voffB[i] = (unsigned)(R * g.ldb + C) * 2u; }
    const size_t kstep = (size_t)(BK * 2);
    const size_t hstepA = (size_t)HALF * g.lda * 2, hstepB = (size_t)HALF * g.ldb * 2;
    const size_t tstepA = 2 * hstepA, tstepB = 2 * hstepB;
    const unsigned ldsw = (unsigned)wid * 1024u;
    const int aoff = lds_byte(wr * 64 + fr, fq * 8), boff = lds_byte(wc * 32 + fr, fq * 8);
#define PG8_SA(b, h) (((b) * 2 + (h)) * HTB)
#define PG8_SB(b, h) ((4 + (b) * 2 + (h)) * HTB)
#define PG8_STAGE(bufoff, gbase, voff) do { _Pragma("unroll") for (int _i = 0; _i < 2; ++_i) \
        __builtin_amdgcn_global_load_lds((const unsigned*)((const char*)(gbase) + (voff)[_i]), (LAS unsigned*)(lds + (bufoff) + ldsw + _i * 8192), 16, 0, 0); } while (0)
#define PG8_LDA(dst, b, h) do { _Pragma("unroll") for (int m = 0; m < 4; ++m) _Pragma("unroll") for (int k = 0; k < 2; ++k) dst[m][k] = *(const LAS h16x8*)(lds + PG8_SA(b, h) + aoff + m * 2048 + k * 1024); } while (0)
#define PG8_LDB(dst, b, h) do { _Pragma("unroll") for (int n = 0; n < 2; ++n) _Pragma("unroll") for (int k = 0; k < 2; ++k) dst[n][k] = *(const LAS h16x8*)(lds + PG8_SB(b, h) + boff + n * 2048 + k * 1024); } while (0)
#define PG8_MMA(ai, bj, At, Bt) do { __builtin_amdgcn_s_setprio(1); _Pragma("unroll") for (int m = 0; m < 4; ++m) _Pragma("unroll") for (int n = 0; n < 2; ++n) _Pragma("unroll") for (int k = 0; k < 2; ++k) \
        acc[ai][bj][m][n] = __builtin_amdgcn_mfma_f32_16x16x32_f16(Bt[n][k], At[m][k], acc[ai][bj][m][n], 0, 0, 0); __builtin_amdgcn_s_setprio(0); } while (0)
#define PG8_WAIT_V(n) asm volatile("s_waitcnt vmcnt(" #n ")" ::: "memory")
#define PG8_WAIT_L(n) asm volatile("s_waitcnt lgkmcnt(" #n ")" ::: "memory")
#define PG8_BAR __builtin_amdgcn_s_barrier()
#define PG8_SCHED __builtin_amdgcn_sched_barrier(0)
    Unit cur, nxt; int ui = 0;
    if (!S.next(0, cur)) return;
    f32x4 acc[2][2][4][2];
#pragma unroll
    for (int a = 0; a < 2; ++a)
#pragma unroll
        for (int b = 0; b < 2; ++b)
#pragma unroll
            for (int m = 0; m < 4; ++m)
#pragma unroll
                for (int n = 0; n < 2; ++n) acc[a][b][m][n] = (f32x4){0.f, 0.f, 0.f, 0.f};
    h16x8 At[4][2], B0[2][2], B1[2][2];
    const char* cA = (const char*)g.A + (size_t)cur.pm * tstepA + (size_t)cur.ko * 2; const char* cB = (const char*)g.Bt + (size_t)cur.pn * tstepB + (size_t)cur.ko * 2;
    {
        PG8_STAGE(PG8_SB(0, 0), cB, voffB); PG8_STAGE(PG8_SB(0, 1), cB + hstepB, voffB); PG8_STAGE(PG8_SA(0, 0), cA, voffA); PG8_STAGE(PG8_SA(0, 1), cA + hstepA, voffA);
        if (wr == 1) PG8_BAR;
        PG8_WAIT_V(2); PG8_BAR;
        PG8_STAGE(PG8_SB(1, 0), cB + kstep, voffB); PG8_STAGE(PG8_SA(1, 0), cA + kstep, voffA); PG8_STAGE(PG8_SB(1, 1), cB + hstepB + kstep, voffB);
        PG8_WAIT_V(6); PG8_BAR;
    }
    for (;;) {
        const bool has_next = S.next(ui + 1, nxt);
        const char* nA = has_next ? (const char*)g.A + (size_t)nxt.pm * tstepA + (size_t)nxt.ko * 2 : cA; const char* nB = has_next ? (const char*)g.Bt + (size_t)nxt.pn * tstepB + (size_t)nxt.ko * 2 : cB;
        int nt = cur.nt ? cur.nt : nt0; asm volatile("" : "+s"(nt));
        for (int t = 0; t < nt; t += 2) {
            const bool last = (t == nt - 2);
            const char* a1 = cA + (size_t)(t + 1) * kstep;
            const char* a2 = last ? nA : cA + (size_t)(t + 2) * kstep; const char* b2 = last ? nB : cB + (size_t)(t + 2) * kstep;
            const char* a3 = a2 + kstep; const char* b3 = b2 + kstep;
            PG8_LDB(B0, 0, 0); PG8_LDB(B1, 0, 1); PG8_SCHED; PG8_LDA(At, 0, 0); PG8_STAGE(PG8_SA(1, 1), a1 + hstepA, voffA);
            PG8_WAIT_V(8); PG8_WAIT_L(0); PG8_BAR; PG8_MMA(0, 0, At, B0); PG8_MMA(0, 1, At, B1); PG8_BAR; PG8_SCHED;
            PG8_LDA(At, 0, 1); PG8_STAGE(PG8_SB(0, 0), b2, voffB); PG8_STAGE(PG8_SB(0, 1), b2 + hstepB, voffB); PG8_STAGE(PG8_SA(0, 0), a2, voffA);
            PG8_WAIT_V(8); PG8_WAIT_L(0); PG8_BAR; PG8_MMA(1, 0, At, B0); PG8_MMA(1, 1, At, B1); PG8_BAR; PG8_SCHED;
            PG8_LDB(B0, 1, 0); PG8_LDB(B1, 1, 1); PG8_SCHED; PG8_LDA(At, 1, 0); PG8_STAGE(PG8_SA(0, 1), a2 + hstepA, voffA);
            PG8_WAIT_V(8); PG8_WAIT_L(0); PG8_BAR; PG8_MMA(0, 0, At, B0); PG8_MMA(0, 1, At, B1); PG8_BAR; PG8_SCHED;
            PG8_LDA(At, 1, 1); PG8_STAGE(PG8_SB(1, 0), b3, voffB); PG8_STAGE(PG8_SB(1, 1), b3 + hstepB, voffB); PG8_STAGE(PG8_SA(1, 0), a3, voffA);
            PG8_WAIT_V(8); PG8_WAIT_L(0); PG8_BAR; PG8_MMA(1, 0, At, B0); PG8_MMA(1, 1, At, B1); PG8_BAR; PG8_SCHED;
        }
        if constexpr (ALIGN_EPI) { if (wr == 0) PG8_BAR; }
        E(acc, cur, wr, wc, fr, fq);
        if (!has_next) break;
        if (!cur.keep) {
#pragma unroll
        for (int a = 0; a < 2; ++a)
#pragma unroll
            for (int b = 0; b < 2; ++b)
#pragma unroll
                for (int m = 0; m < 4; ++m)
#pragma unroll
                    for (int n = 0; n < 2; ++n) acc[a][b][m][n] = (f32x4){0.f, 0.f, 0.f, 0.f};
        }
        cur = nxt; cA = nA; cB = nB; ++ui;
        if constexpr (ALIGN_EPI) { if (wr == 1) PG8_BAR; }
    }
    PG8_WAIT_V(0);
    if constexpr (!ALIGN_EPI) { if (wr == 0) PG8_BAR; }
    PG8_BAR;
#undef PG8_SA
#undef PG8_SB
#undef PG8_STAGE
#undef PG8_LDA
#undef PG8_LDB
#undef PG8_MMA
#undef PG8_WAIT_V
#undef PG8_WAIT_L
#undef PG8_BAR
#undef PG8_SCHED
}
}

struct Frame {
    LAS unsigned char* lds;
    int tid, lane, wave, vcu, G;
    const float *x, *c, *ctx, *c_ctx, *w_mod, *b_mod, *norm_attn, *norm_ffn, *w_in, *ret_decay, *diff_lambda, *diff_subln,
                *w_ret_o, *w_diff_o, *w_out, *w_router, *router_bias, *w_exp_gu, *w_exp_down, *w_sh_gu, *w_sh_down, *final_norm;
    float* out;
    unsigned char* ws;
};

__device__ __forceinline__ float wave_sum(float v) {
#pragma unroll
    for (int o = 1; o < 64; o <<= 1) v += __shfl_xor(v, o);
    return v;
}
__device__ __forceinline__ unsigned pk2h(float lo, float hi) { f32x2 v = {lo, hi}; h16x2 h = __builtin_convertvector(v, h16x2); return __builtin_bit_cast(unsigned, h); }
__device__ __forceinline__ float silu_f(float v) { return v / (1.0f + __expf(-v)); }
__device__ __forceinline__ float sigmoid_f(float v) { return 1.0f / (1.0f + __expf(-v)); }

__device__ __forceinline__ void p0_mod_unit(Frame& F, int unit) {
    const int cb = unit % 24, ks = unit / 24;
    LAS float* sv = (LAS float*)F.lds;
    LAS float* red = sv + 768;
    for (int i = F.tid; i < 768; i += NTHR) { const int v = i >> 8, k = i & 255; const float cv = (v < 2) ? F.c[v * DM + ks * 256 + k] : F.c_ctx[ks * 256 + k]; sv[i] = silu_f(cv); }
    __syncthreads();
    const int cl = F.tid & 127, rl = F.tid >> 7;
    const float* wp = F.w_mod + (size_t)(ks * 256 + rl) * (6 * DM) + cb * 512 + cl * 4;
    f32x4 a0 = {0.f, 0.f, 0.f, 0.f}, a1 = a0, a2 = a0;
#pragma unroll 8
    for (int i = 0; i < 64; ++i) { const f32x4 w = *(const f32x4*)(wp + (size_t)i * 4 * (6 * DM)); const int k = rl + 4 * i; a0 += w * sv[k]; a1 += w * sv[256 + k]; a2 += w * sv[512 + k]; }
    *(LAS f32x4*)(red + (rl * 3 + 0) * 512 + cl * 4) = a0; *(LAS f32x4*)(red + (rl * 3 + 1) * 512 + cl * 4) = a1; *(LAS f32x4*)(red + (rl * 3 + 2) * 512 + cl * 4) = a2;
    __syncthreads();
    float* modp = (float*)(F.ws + WS_MODP);
    for (int i = F.tid; i < 1536; i += NTHR) { const int v = i >> 9, cc = i & 511; const float s = (red[(0 * 3 + v) * 512 + cc] + red[(1 * 3 + v) * 512 + cc]) + (red[(2 * 3 + v) * 512 + cc] + red[(3 * 3 + v) * 512 + cc]);
        modp[(size_t)(ks * 3 + v) * (6 * DM) + cb * 512 + cc] = s; }
    __syncthreads();
}
template <int MAP>
__device__ __forceinline__ void p0_transpose_item(const float* W, int K, int N, h16* WT, LAS float* scr, int item, int lane, int ldd = 0) {
    if (ldd == 0) ldd = K;
    const int nblk = N / 32, kb = item / nblk, nb = item % nblk, k0 = 64 * kb, n0 = 32 * nb;
#pragma unroll 8
    for (int i = 0; i < 32; ++i) { const int kk = 2 * i + (lane >> 5); scr[kk * 33 + (lane & 31)] = W[(size_t)(k0 + kk) * N + n0 + (lane & 31)]; }
    asm volatile("s_waitcnt lgkmcnt(0)" ::: "memory");
    const int cch = lane & 7;
#pragma unroll
    for (int j = 0; j < 4; ++j) { const int n = (lane >> 3) + 8 * j; const LAS float* s = scr + (8 * cch) * 33 + n;
        u32x4 o; o.x = pk2h(s[0 * 33], s[1 * 33]); o.y = pk2h(s[2 * 33], s[3 * 33]); o.z = pk2h(s[4 * 33], s[5 * 33]); o.w = pk2h(s[6 * 33], s[7 * 33]);
        int nn = n0 + n;
        if (MAP == 1) { const bool isrope = (nn < 1024) || (nn >= C_RQ && nn < C_RQ + 1024); if (isrope) nn = (nn & ~48) | ((nn & 16) << 1) | ((nn & 32) >> 1); }
        if (MAP == 2) { const int j = nn & 255, isu = nn >> 8; nn = 32 * (j >> 4) + 16 * isu + (j & 15); }
        *(u32x4*)(WT + (size_t)nn * ldd + k0 + 8 * cch) = o; }
    asm volatile("s_waitcnt lgkmcnt(0)" ::: "memory");
}
__device__ __forceinline__ void p0a_mod(Frame& F) {
    for (int u = F.vcu; u < 192; u += F.G) p0_mod_unit(F, u);
}
__device__ __forceinline__ void p0b_weights(Frame& F) {
    __syncthreads();
    LAS float* scr = (LAS float*)(F.lds + F.wave * 16384);
    const int gw = F.vcu * NWAVES + F.wave, NGW = F.G * NWAVES;
    constexpr int I_IN = (DM / 64) * (IN_COLS / 32), I_RET = (2048 / 64) * (DM / 32), I_DIF = (1024 / 64) * (DM / 32), I_OUT = (DM / 64) * (DM / 32), I_SGU = (DM / 64) * (512 / 32), I_SDN = (256 / 64) * (DM / 32);
    constexpr int NITEMS = I_IN + I_RET + I_DIF + I_OUT + I_SGU + I_SDN;
    for (int it = gw; it < NITEMS; it += NGW) {
        int r = it;
        if (r < I_IN) { p0_transpose_item<1>(F.w_in, DM, IN_COLS, (h16*)(F.ws + WS_WINT), scr, r, F.lane); continue; } r -= I_IN;
        if (r < I_RET) { p0_transpose_item<0>(F.w_ret_o, 2048, DM, (h16*)(F.ws + WS_WCAT), scr, r, F.lane, 3072); continue; } r -= I_RET;
        if (r < I_DIF) { p0_transpose_item<0>(F.w_diff_o, 1024, DM, (h16*)(F.ws + WS_WCAT) + 2048, scr, r, F.lane, 3072); continue; } r -= I_DIF;
        if (r < I_OUT) { p0_transpose_item<0>(F.w_out, DM, DM, (h16*)(F.ws + WS_WOUT), scr, r, F.lane); continue; } r -= I_OUT;
        if (r < I_SGU) { p0_transpose_item<2>(F.w_sh_gu, DM, 512, (h16*)(F.ws + WS_WSGU), scr, r, F.lane); continue; } r -= I_SGU;
        p0_transpose_item<0>(F.w_sh_down, 256, DM, (h16*)(F.ws + WS_WSDN), scr, r, F.lane);
    }
    {
        const int i = blockIdx.x * NTHR + F.tid;
        for (int q = i; q < NEXP * DM / 4; q += F.G * NTHR) {
            const int e = q / (DM / 4), k = (q % (DM / 4)) * 4;
            const f32x4 w = *(const f32x4*)(F.w_router + (size_t)e * DM + k);
            h16 hi[4], lo[4];
#pragma unroll
            for (int j = 0; j < 4; ++j) { hi[j] = (h16)w[j]; lo[j] = (h16)(w[j] - (float)hi[j]); }
            h16* dst = (h16*)(F.ws + WS_WRTR) + (size_t)e * 6144 + k;
            *(h16x4*)(dst) = (h16x4){hi[0], hi[1], hi[2], hi[3]}; *(h16x4*)(dst + 2048) = (h16x4){hi[0], hi[1], hi[2], hi[3]}; *(h16x4*)(dst + 4096) = (h16x4){lo[0], lo[1], lo[2], lo[3]};
        }
    }
    if (blockIdx.x == 0) {
        float* rope = (float*)(F.ws + WS_ROPE);
        for (int i = F.tid; i < 64 * 32; i += NTHR) { const int pos = i >> 5, j = i & 31; const float inv = exp2f(-(float)j * (13.287712379549449f / 32.0f)); const float ang = (float)pos * inv; rope[i] = cosf(ang); rope[2048 + i] = sinf(ang); }
        for (int i = F.tid; i < 64 * 16; i += NTHR) { const int pos = i >> 4, j = i & 15; const float inv = exp2f(-(float)j * (13.287712379549449f / 16.0f)); const float ang = (float)pos * inv; rope[4096 + i] = cosf(ang); rope[4096 + 1024 + i] = sinf(ang); }
    }
}

__device__ __forceinline__ void p1_norm1(Frame& F) {
    LAS float* msh = (LAS float*)F.lds; LAS float* msc = msh + 3 * DM;
    const float* modp = (const float*)(F.ws + WS_MODP);
    for (int i = F.tid; i < 3 * 2 * DM; i += NTHR) { const int v = i / (2 * DM), cc = i % (2 * DM); float s = F.b_mod[cc];
#pragma unroll
        for (int ks = 0; ks < 8; ++ks) s += modp[(size_t)(ks * 3 + v) * (6 * DM) + cc];
        if (cc < DM) msh[v * DM + cc] = s; else msc[v * DM + cc - DM] = s; }
    __syncthreads();
    const int gw = F.vcu * NWAVES + F.wave, NGW = F.G * NWAVES;
    h16* H = (h16*)(F.ws + WS_H);
    for (int r = gw; r < MALL; r += NGW) {
        const float* src = (r < MLAT) ? F.x + (size_t)r * DM : F.ctx + (size_t)(r - MLAT) * DM; const int v = (r < MLAT) ? (r / SEQ) : 2;
        f32x4 xv[8]; float ss = 0.f;
#pragma unroll
        for (int j = 0; j < 8; ++j) { xv[j] = *(const f32x4*)(src + 4 * F.lane + 256 * j); ss += (xv[j].x * xv[j].x + xv[j].y * xv[j].y) + (xv[j].z * xv[j].z + xv[j].w * xv[j].w); }
        const float rstd = 1.0f / sqrtf(wave_sum(ss) * (1.0f / DM) + EPS);
#pragma unroll
        for (int j = 0; j < 8; ++j) { const int cc = 4 * F.lane + 256 * j; const f32x4 nw = *(const f32x4*)(F.norm_attn + cc);
            const f32x4 sc = *(LAS f32x4*)(msc + v * DM + cc), sh = *(LAS f32x4*)(msh + v * DM + cc);
            const f32x4 y = xv[j] * rstd * nw * (sc + 1.0f) + sh;
            u32x2 o; o.x = pk2h(y.x, y.y); o.y = pk2h(y.z, y.w); *(u32x2*)(H + (size_t)r * DM + cc) = o; }
    }
    float* MOD = (float*)(F.ws + WS_MOD);
    for (int i = blockIdx.x * NTHR + F.tid; i < 3 * 6 * DM; i += F.G * NTHR) { const int v = i / (6 * DM), cc = i % (6 * DM); float s = F.b_mod[cc];
#pragma unroll
        for (int ks = 0; ks < 8; ++ks) s += modp[(size_t)(ks * 3 + v) * (6 * DM) + cc];
        MOD[i] = s; }
}


__device__ __forceinline__ int crow(int r, int hi) { return (r & 3) + 8 * (r >> 2) + 4 * hi; }
__device__ __forceinline__ h16x8 frag_row(const LAS unsigned char* base, int strideB, int r0, int k0, int lane) {
    return *(const LAS h16x8*)(base + (r0 + (lane & 31)) * strideB + (k0 + 8 * (lane >> 5)) * 2);
}
__device__ __forceinline__ v4i16_t tr16(const LAS unsigned char* p) { return __builtin_amdgcn_ds_read_tr16_b64_v4i16((LAS v4i16_t*)p); }
__device__ __forceinline__ h16x8 frag_tr(const LAS unsigned char* base, int strideB, int k0, int n0, int lane) {
    const int kb = k0 + 8 * (lane >> 5) + ((lane & 15) >> 2), nc = n0 + 16 * ((lane >> 4) & 1) + 4 * (lane & 3);
    const LAS unsigned char* p = base + kb * strideB + nc * 2;
    const v4i16_t lo = tr16(p), hi = tr16(p + 4 * strideB);
    typedef short s16x8 __attribute__((ext_vector_type(8)));
    const s16x8 v = {lo[0], lo[1], lo[2], lo[3], hi[0], hi[1], hi[2], hi[3]};
    return __builtin_bit_cast(h16x8, v);
}
__device__ __forceinline__ h16x8 frag_tr_perm(const LAS unsigned char* base, int strideB, int k0, int n0, int lane) {
    const int kb = k0 + 4 * (lane >> 5) + ((lane & 15) >> 2), nc = n0 + 16 * ((lane >> 4) & 1) + 4 * (lane & 3);
    const LAS unsigned char* p = base + kb * strideB + nc * 2;
    const v4i16_t lo = tr16(p), hi = tr16(p + 8 * strideB);
    typedef short s16x8 __attribute__((ext_vector_type(8)));
    const s16x8 v = {lo[0], lo[1], lo[2], lo[3], hi[0], hi[1], hi[2], hi[3]};
    return __builtin_bit_cast(h16x8, v);
}
__device__ __forceinline__ h16x8 pack8(float a0, float a1, float a2, float a3, float a4, float a5, float a6, float a7) {
    u32x4 w; w.x = pk2h(a0, a1); w.y = pk2h(a2, a3); w.z = pk2h(a4, a5); w.w = pk2h(a6, a7); return __builtin_bit_cast(h16x8, w);
}
#define MFMA32(a, b, c) __builtin_amdgcn_mfma_f32_32x32x16_f16((a), (b), (c), 0, 0, 0)

struct SchedG1 {
    pg8::StaticOrder so; int G, c;
    __device__ __forceinline__ bool next(int i, pg8::Unit& u) const {
        const int L = i * G + c;
        if (L < 32 * 52) return so.next(i, u);
        const int r = L - 32 * 52; if (r >= 40) return false;
        u.pm = 32 + r / 20; u.pn = r % 20; u.ko = 0; u.nt = 0; u.keep = 0; return true;
    }
};
struct EpiP {
    h16* P; const float* rope;
    __device__ __forceinline__ void operator()(f32x4 (&acc)[2][2][4][2], const pg8::Unit& u, int wr, int wc, int fr, int fq) const {
        const int colt = u.pn * 256; const bool lat = u.pm < 32;
        int kind;
        if (colt < C_RV) kind = 1; else if (colt < C_DK) kind = 0; else if (colt < C_DV) kind = 3; else if (colt < C_RQ) kind = 0; else if (colt < C_RG) kind = 2; else if (colt < C_DQ) kind = 5; else if (colt < C_GR) kind = 4; else kind = 6;
        if (!lat) kind = (kind == 1) ? 7 : 0;
#pragma unroll
        for (int ai = 0; ai < 2; ++ai)
#pragma unroll
            for (int m = 0; m < 4; ++m) {
                const int row = u.pm * 256 + ai * 128 + wr * 64 + m * 16 + fr; const int t = row & (SEQ - 1);
                h16* prow = P + (size_t)row * IN_COLS;
#pragma unroll
                for (int bj = 0; bj < 2; ++bj) {
                    const int cbase = colt + bj * 128 + wc * 32;
                    const f32x4 x0 = acc[ai][bj][m][0], x1 = acc[ai][bj][m][1];
                    f32x4 o0, o1; int c0, c1;
                    if (kind == 1 || kind == 2) {
                        const int g5 = (cbase >> 5) & 1, axis = (cbase >> 6) & 1, pos = axis ? (t & 63) : (t >> 6), j0 = 16 * g5 + 4 * fq;
                        const f32x4 cs = *(const f32x4*)(rope + pos * 32 + j0), sn = *(const f32x4*)(rope + 2048 + pos * 32 + j0);
                        o0 = x0 * cs - x1 * sn; o1 = x0 * sn + x1 * cs;
                        if (kind == 2) { o0 *= 0.08838834764831845f; o1 *= 0.08838834764831845f; }
                        c0 = (cbase & ~63) + j0; c1 = c0 + 32;
                    } else if (kind == 7) {
                        const int g5 = (cbase >> 5) & 1; c0 = (cbase & ~63) + 16 * g5 + 4 * fq; c1 = c0 + 32; o0 = x0; o1 = x1;
                    } else if (kind == 3 || kind == 4) {
                        const int axis = (cbase >> 5) & 1, pos = axis ? (t & 63) : (t >> 6), j0 = 4 * fq;
                        const f32x4 cs = *(const f32x4*)(rope + 4096 + pos * 16 + j0), sn = *(const f32x4*)(rope + 5120 + pos * 16 + j0);
                        o0 = x0 * cs - x1 * sn; o1 = x0 * sn + x1 * cs;
                        if (kind == 4) { o0 *= 0.18033688011112042f; o1 *= 0.18033688011112042f; }
                        c0 = cbase + j0; c1 = c0 + 16;
                    } else {
                        c0 = cbase + 4 * fq; c1 = c0 + 16; o0 = x0; o1 = x1;
                        if (kind == 5) {
#pragma unroll
                            for (int e = 0; e < 4; ++e) { o0[e] = silu_f(x0[e]); o1[e] = silu_f(x1[e]); }
                        } else if (kind == 6) {
#pragma unroll
                            for (int e = 0; e < 4; ++e) { o0[e] = sigmoid_f(x0[e]); o1[e] = sigmoid_f(x1[e]); }
                        }
                    }
                    u32x2 w0, w1; w0.x = pk2h(o0[0], o0[1]); w0.y = pk2h(o0[2], o0[3]); w1.x = pk2h(o1[0], o1[1]); w1.y = pk2h(o1[2], o1[3]);
                    *(u32x2*)(prow + c0) = w0; *(u32x2*)(prow + c1) = w1;
                }
            }
    }
};
__device__ __forceinline__ void p2_gemm1(Frame& F) {
    pg8::Gemm g{(const h16*)(F.ws + WS_H), (const h16*)(F.ws + WS_WINT), DM, DM, DM};
    SchedG1 S; S.so.init(MLAT, IN_COLS, F.G, (int)blockIdx.x); S.G = F.G; S.c = (int)blockIdx.x;
    EpiP E{(h16*)(F.ws + WS_P), (const float*)(F.ws + WS_ROPE)};
    pg8::gemm_phase<EpiP, SchedG1>(F.lds, g, S, E);
}

__device__ __forceinline__ void p3_ret_local(Frame& F) {
    LAS unsigned char* KF = F.lds; LAS unsigned char* KB = F.lds + 40960; LAS unsigned char* VH = F.lds + 81920;
    const h16* P = (const h16*)(F.ws + WS_P); h16* LST = (h16*)(F.ws + WS_LST);
    const int hi = F.lane >> 5;
    for (int u = F.vcu; u < 16 * 34; u += F.G) {
        const int bh = u / 34, cc = u % 34, b = bh >> 3, h = bh & 7;
        const int row0 = (cc < 2) ? (MLAT + b * CTXL + cc * 128) : (b * SEQ + (cc - 2) * 128);
        const float lgf = -__expf(F.ret_decay[h]), lgb = -__expf(F.ret_decay[8 + h]);
#pragma unroll
        for (int i = 0; i < 4; ++i) { const int q = F.tid + NTHR * i, row = q >> 4, ch = q & 15;
            const h16x8 kv = *(const h16x8*)(P + (size_t)(row0 + row) * IN_COLS + C_RK + h * 128 + ch * 8);
            const float sf = __expf(lgf * (float)(127 - row)), sb = __expf(lgb * (float)row);
            *(LAS h16x8*)(KF + row * 320 + ch * 16) = pack8((float)kv[0] * sf, (float)kv[1] * sf, (float)kv[2] * sf, (float)kv[3] * sf, (float)kv[4] * sf, (float)kv[5] * sf, (float)kv[6] * sf, (float)kv[7] * sf);
            *(LAS h16x8*)(KB + row * 320 + ch * 16) = pack8((float)kv[0] * sb, (float)kv[1] * sb, (float)kv[2] * sb, (float)kv[3] * sb, (float)kv[4] * sb, (float)kv[5] * sb, (float)kv[6] * sb, (float)kv[7] * sb); }
        for (int eh = 0; eh < 2; ++eh) {
            if (eh) __syncthreads();
#pragma unroll
            for (int i = 0; i < 4; ++i) { const int q = F.tid + NTHR * i, row = q >> 4, ch = q & 15;
                *(LAS h16x8*)(VH + row * 320 + ch * 16) = *(const h16x8*)(P + (size_t)(row0 + row) * IN_COLS + C_RV + h * 256 + eh * 128 + ch * 8); }
            __syncthreads();
            const int dir = F.wave >> 2, eb = F.wave & 3; const LAS unsigned char* Kd = dir ? KB : KF;
            f32x16 acc[4];
#pragma unroll
            for (int db = 0; db < 4; ++db) acc[db] = (f32x16){};
#pragma unroll
            for (int ks = 0; ks < 8; ++ks) { const h16x8 a = frag_tr(VH, 320, 16 * ks, 32 * eb, F.lane);
#pragma unroll
                for (int db = 0; db < 4; ++db) { const h16x8 bb = frag_tr(Kd, 320, 16 * ks, 32 * db, F.lane); acc[db] = MFMA32(a, bb, acc[db]); } }
            h16* dst = LST + ((size_t)((dir * 16 + bh) * 34 + cc) * 256 + eh * 128 + eb * 32) * 128;
#pragma unroll
            for (int db = 0; db < 4; ++db)
#pragma unroll
                for (int r = 0; r < 16; ++r) dst[crow(r, hi) * 128 + db * 32 + (F.lane & 31)] = (h16)acc[db][r];
        }
        __syncthreads();
    }
}
__device__ __forceinline__ void p4_ret_scan(Frame& F) {
    const h16* LST = (const h16*)(F.ws + WS_LST); h16* SST = (h16*)(F.ws + WS_SST);
    for (int g = blockIdx.x * NTHR + F.tid; g < 2 * 16 * 4096; g += F.G * NTHR) {
        const int seq = g >> 12, off = (g & 4095) * 8, dir = seq >> 4, bh = seq & 15, h = bh & 7;
        const float cd = __expf(-__expf(F.ret_decay[dir * 8 + h]) * 128.0f);
        const h16* Lp = LST + (size_t)seq * 34 * 32768 + off; h16* Sp = SST + (size_t)seq * 32 * 32768 + off;
        float s[8];
#pragma unroll
        for (int e = 0; e < 8; ++e) s[e] = 0.f;
        if (dir == 0) {
            for (int cc = 0; cc < 33; ++cc) {
                if (cc >= 2) *(h16x8*)(Sp + (size_t)(cc - 2) * 32768) = pack8(s[0], s[1], s[2], s[3], s[4], s[5], s[6], s[7]);
                const h16x8 l = *(const h16x8*)(Lp + (size_t)cc * 32768);
#pragma unroll
                for (int e = 0; e < 8; ++e) s[e] = s[e] * cd + (float)l[e];
            }
            *(h16x8*)(Sp + (size_t)31 * 32768) = pack8(s[0], s[1], s[2], s[3], s[4], s[5], s[6], s[7]);
        } else {
            { const h16x8 l1 = *(const h16x8*)(Lp + (size_t)1 * 32768), l0 = *(const h16x8*)(Lp);
#pragma unroll
              for (int e = 0; e < 8; ++e) s[e] = (float)l1[e] * cd + (float)l0[e]; }
            for (int c = 31; c >= 0; --c) {
                *(h16x8*)(Sp + (size_t)c * 32768) = pack8(s[0], s[1], s[2], s[3], s[4], s[5], s[6], s[7]);
                const h16x8 l = *(const h16x8*)(Lp + (size_t)(c + 2) * 32768);
#pragma unroll
                for (int e = 0; e < 8; ++e) s[e] = s[e] * cd + (float)l[e];
            }
        }
    }
}
__device__ __forceinline__ void p5_ret_out(Frame& F) {
    LAS unsigned char* QL = F.lds; LAS unsigned char* KL = F.lds + 34816; LAS unsigned char* VL = F.lds;
    LAS float* RED = (LAS float*)(F.lds + 98304);
    const h16* P = (const h16*)(F.ws + WS_P); const h16* SST = (const h16*)(F.ws + WS_SST); h16* ARET = (h16*)(F.ws + WS_ACAT);
    const int hi = F.lane >> 5, ln = F.lane & 31;
    for (int u = F.vcu; u < 512; u += F.G) {
        const int bh = u >> 5, c = u & 31, b = bh >> 3, h = bh & 7, row0 = b * SEQ + c * 128;
        const float lgf = -__expf(F.ret_decay[h]), lgb = -__expf(F.ret_decay[8 + h]);
#pragma unroll
        for (int i = 0; i < 4; ++i) { const int q = F.tid + NTHR * i, row = q >> 4, ch = q & 15; const h16* pr = P + (size_t)(row0 + row) * IN_COLS + h * 128 + ch * 8;
            *(LAS h16x8*)(QL + row * 272 + ch * 16) = *(const h16x8*)(pr + C_RQ); *(LAS h16x8*)(KL + row * 272 + ch * 16) = *(const h16x8*)(pr + C_RK); }
        __syncthreads();
        const int ib = F.wave & 3, ehalf = F.wave >> 2, i0 = 32 * ib, il = i0 + ln;
        h16x8 qf[8];
#pragma unroll
        for (int ks = 0; ks < 8; ++ks) qf[ks] = frag_row(QL, 272, i0, 16 * ks, F.lane);
        h16x8 pb[4][2];
#pragma unroll
        for (int jt = 0; jt < 4; ++jt) { f32x16 s = (f32x16){};
#pragma unroll
            for (int ks = 0; ks < 8; ++ks) s = MFMA32(frag_row(KL, 272, 32 * jt, 16 * ks, F.lane), qf[ks], s);
#pragma unroll
            for (int r = 0; r < 16; ++r) { const int d = il - (32 * jt + crow(r, hi)); s[r] *= (d >= 0) ? __expf(lgf * (float)d) : __expf(lgb * (float)(-d)); }
            pb[jt][0] = pack8(s[0], s[1], s[2], s[3], s[4], s[5], s[6], s[7]); pb[jt][1] = pack8(s[8], s[9], s[10], s[11], s[12], s[13], s[14], s[15]); }
        __syncthreads();
#pragma unroll
        for (int i = 0; i < 8; ++i) { const int q = F.tid + NTHR * i, row = q >> 5, c32 = q & 31, eh = c32 >> 4, ch = c32 & 15;
            *(LAS h16x8*)(VL + eh * 40960 + row * 320 + ch * 16) = *(const h16x8*)(P + (size_t)(row0 + row) * IN_COLS + C_RV + h * 256 + c32 * 8); }
        __syncthreads();
        f32x16 o[4];
#pragma unroll
        for (int et = 0; et < 4; ++et) o[et] = (f32x16){};
        const LAS unsigned char* Vh = VL + ehalf * 40960;
#pragma unroll
        for (int jt = 0; jt < 4; ++jt)
#pragma unroll
            for (int s2 = 0; s2 < 2; ++s2)
#pragma unroll
                for (int et = 0; et < 4; ++et) o[et] = MFMA32(frag_tr_perm(Vh, 320, 32 * jt + 16 * s2, 32 * et, F.lane), pb[jt][s2], o[et]);
#pragma unroll
        for (int dir = 0; dir < 2; ++dir) {
            const h16 sc = (h16)(dir ? __expf(lgb * (float)(128 - il)) : __expf(lgf * (float)(il + 1)));
            const h16* Sg = SST + ((size_t)((dir * 16 + bh) * 32 + c) * 256 + ehalf * 128) * 128;
#pragma unroll
            for (int ks = 0; ks < 8; ++ks) { const h16x8 qs = qf[ks] * sc;
#pragma unroll
                for (int et = 0; et < 4; ++et) { const h16x8 a = *(const h16x8*)(Sg + (size_t)(32 * et + ln) * 128 + 16 * ks + 8 * hi); o[et] = MFMA32(a, qs, o[et]); } }
        }
        float ss = 0.f;
#pragma unroll
        for (int et = 0; et < 4; ++et)
#pragma unroll
            for (int r = 0; r < 16; ++r) ss += o[et][r] * o[et][r];
        ss += __shfl_xor(ss, 32);
        if (hi == 0) RED[F.wave * 32 + ln] = ss;
        __syncthreads();
        const float rstd = 1.0f / sqrtf((RED[F.wave * 32 + ln] + RED[(F.wave ^ 4) * 32 + ln]) * (1.0f / 256.0f) + EPS);
        const size_t grow = (size_t)(row0 + il);
#pragma unroll
        for (int et = 0; et < 4; ++et)
#pragma unroll
            for (int r4 = 0; r4 < 4; ++r4) { const int e = ehalf * 128 + 32 * et + 8 * r4 + 4 * hi;
                const h16x4 gt = *(const h16x4*)(P + grow * IN_COLS + C_RG + h * 256 + e);
                u32x2 w; w.x = pk2h(o[et][4 * r4] * rstd * (float)gt[0], o[et][4 * r4 + 1] * rstd * (float)gt[1]); w.y = pk2h(o[et][4 * r4 + 2] * rstd * (float)gt[2], o[et][4 * r4 + 3] * rstd * (float)gt[3]);
                *(u32x2*)(ARET + grow * 3072 + h * 256 + e) = w; }
        __syncthreads();
    }
}
__device__ __forceinline__ void p6_attn(Frame& F) {
    const h16* P = (const h16*)(F.ws + WS_P); h16* ADIF = (h16*)(F.ws + WS_ACAT) + 2048;
    const int hi = F.lane >> 5, ln = F.lane & 31;
    float lam;
    { const float s1 = wave_sum(F.diff_lambda[F.lane] * F.diff_lambda[64 + F.lane]), s2 = wave_sum(F.diff_lambda[128 + F.lane] * F.diff_lambda[192 + F.lane]); lam = __expf(s1) - __expf(s2) + 0.2f; }
    constexpr int KT0 = 0, VT0 = 34816, KTB = 17408, VTB = 20480;
    LAS float* XB = (LAS float*)F.lds;
    for (int u = F.vcu; u < 512; u += F.G) {
        const int bh = u >> 5, qb = u & 31, b = bh >> 3, h = bh & 7;
        const int cm = F.wave & 1, qs = F.wave >> 1, qrow0 = b * SEQ + qb * 128 + qs * 32;
        h16x8 qf[4];
#pragma unroll
        for (int ks = 0; ks < 4; ++ks) qf[ks] = *(const h16x8*)(P + (size_t)(qrow0 + ln) * IN_COLS + C_DQ + h * 128 + cm * 64 + 16 * ks + 8 * hi);
        f32x16 o[4];
#pragma unroll
        for (int et = 0; et < 4; ++et) o[et] = (f32x16){};
        float mrun = -1e30f, lsum = 0.f;
        h16x8 kreg[2], vreg[2];
#define ATT_LOAD(t) do { _Pragma("unroll") for (int i = 0; i < 2; ++i) { const int q = F.tid + NTHR * i, row = q >> 4, ch = q & 15; const int j = (t) * 64 + row; \
            const size_t srow = (j < CTXL) ? (size_t)(MLAT + b * CTXL + j) : (size_t)(b * SEQ + j - CTXL); const h16* pr = P + srow * IN_COLS + h * 128 + ch * 8; \
            kreg[i] = *(const h16x8*)(pr + C_DK); vreg[i] = *(const h16x8*)(pr + C_DV); } } while (0)
#define ATT_WRITE(buf) do { _Pragma("unroll") for (int i = 0; i < 2; ++i) { const int q = F.tid + NTHR * i, row = q >> 4, ch = q & 15; \
            *(LAS h16x8*)(F.lds + KT0 + (buf) * KTB + row * 272 + ch * 16) = kreg[i]; *(LAS h16x8*)(F.lds + VT0 + (buf) * VTB + row * 320 + ch * 16) = vreg[i]; } } while (0)
        ATT_LOAD(0); ATT_WRITE(0);
        __syncthreads();
        constexpr int NT = (CTXL + SEQ) / 64;
        for (int t = 0; t < NT; ++t) {
            const int buf = t & 1;
            if (t + 1 < NT) ATT_LOAD(t + 1);
            const LAS unsigned char* Kt = F.lds + KT0 + buf * KTB; const LAS unsigned char* Vt = F.lds + VT0 + buf * VTB;
            f32x16 s[2];
#pragma unroll
            for (int kt = 0; kt < 2; ++kt) { s[kt] = (f32x16){};
#pragma unroll
                for (int ks = 0; ks < 4; ++ks) s[kt] = MFMA32(frag_row(Kt, 272, 32 * kt, cm * 64 + 16 * ks, F.lane), qf[ks], s[kt]); }
            float mx = s[0][0];
#pragma unroll
            for (int r = 0; r < 16; ++r) { mx = fmaxf(mx, s[0][r]); mx = fmaxf(mx, s[1][r]); }
            mx = fmaxf(mx, __shfl_xor(mx, 32));
            if (__any(mx > mrun + 8.0f)) { const float mn = fmaxf(mrun, mx), alpha = __builtin_amdgcn_exp2f(mrun - mn); mrun = mn; lsum *= alpha;
#pragma unroll
                for (int et = 0; et < 4; ++et) o[et] *= alpha; }
            float ps = 0.f;
#pragma unroll
            for (int kt = 0; kt < 2; ++kt)
#pragma unroll
                for (int r = 0; r < 16; ++r) { s[kt][r] = __builtin_amdgcn_exp2f(s[kt][r] - mrun); ps += s[kt][r]; }
            lsum += ps;
#pragma unroll
            for (int kt = 0; kt < 2; ++kt)
#pragma unroll
                for (int s2 = 0; s2 < 2; ++s2) {
                    const h16x8 pbf = pack8(s[kt][8 * s2], s[kt][8 * s2 + 1], s[kt][8 * s2 + 2], s[kt][8 * s2 + 3], s[kt][8 * s2 + 4], s[kt][8 * s2 + 5], s[kt][8 * s2 + 6], s[kt][8 * s2 + 7]);
#pragma unroll
                    for (int et = 0; et < 4; ++et) o[et] = MFMA32(frag_tr_perm(Vt, 320, 32 * kt + 16 * s2, 32 * et, F.lane), pbf, o[et]);
                }
            if (t + 1 < NT) ATT_WRITE(buf ^ 1);
            __syncthreads();
        }
#undef ATT_LOAD
#undef ATT_WRITE
        lsum += __shfl_xor(lsum, 32);
        const float inv = 1.0f / lsum;
        if (cm == 1) {
#pragma unroll
            for (int et = 0; et < 4; ++et)
#pragma unroll
                for (int r = 0; r < 16; ++r) XB[(qs * 128 + 32 * et + crow(r, hi)) * 32 + ln] = o[et][r] * inv;
        }
        __syncthreads();
        if (cm == 0) {
            float ss = 0.f;
#pragma unroll
            for (int et = 0; et < 4; ++et)
#pragma unroll
                for (int r = 0; r < 16; ++r) { const float v = o[et][r] * inv - lam * XB[(qs * 128 + 32 * et + crow(r, hi)) * 32 + ln]; o[et][r] = v; ss += v * v; }
            ss += __shfl_xor(ss, 32);
            const float rstd = 0.8f / sqrtf(ss * (1.0f / 128.0f) + EPS);
            const size_t grow = (size_t)(qrow0 + ln);
#pragma unroll
            for (int et = 0; et < 4; ++et)
#pragma unroll
                for (int r4 = 0; r4 < 4; ++r4) { const int e = 32 * et + 8 * r4 + 4 * hi; const f32x4 sw = *(const f32x4*)(F.diff_subln + e);
                    u32x2 w; w.x = pk2h(o[et][4 * r4] * rstd * sw[0], o[et][4 * r4 + 1] * rstd * sw[1]); w.y = pk2h(o[et][4 * r4 + 2] * rstd * sw[2], o[et][4 * r4 + 3] * rstd * sw[3]);
                    *(u32x2*)(ADIF + grow * 3072 + h * 128 + e) = w; }
        }
        __syncthreads();
    }
}
struct SchedG2 {
    pg8::StaticOrder so;
    __device__ __forceinline__ bool next(int i, pg8::Unit& u) const { if (!so.next(i >> 1, u)) return false; if (i & 1) { u.ko = 2048; u.nt = 16; u.keep = 0; } else { u.ko = 0; u.nt = 32; u.keep = 1; } return true; }
};
struct EpiU2 {
    h16* U; const h16* P;
    __device__ __forceinline__ void operator()(f32x4 (&acc)[2][2][4][2], const pg8::Unit& u, int wr, int wc, int fr, int fq) const {
#pragma unroll
        for (int ai = 0; ai < 2; ++ai)
#pragma unroll
            for (int m = 0; m < 4; ++m) { const int row = u.pm * 256 + ai * 128 + wr * 64 + m * 16 + fr;
#pragma unroll
                for (int bj = 0; bj < 2; ++bj)
#pragma unroll
                    for (int n = 0; n < 2; ++n) { const int col = u.pn * 256 + bj * 128 + wc * 32 + 16 * n + 4 * fq;
                        const h16x4 gd = *(const h16x4*)(P + (size_t)row * IN_COLS + C_GD + col);
                        if (u.keep) { const h16x4 gr = *(const h16x4*)(P + (size_t)row * IN_COLS + C_GR + col);
#pragma unroll
                            for (int e = 0; e < 4; ++e) acc[ai][bj][m][n][e] *= (float)gr[e] / (float)gd[e];
                        } else { const f32x4 a = acc[ai][bj][m][n];
                            u32x2 w; w.x = pk2h(a[0] * (float)gd[0], a[1] * (float)gd[1]); w.y = pk2h(a[2] * (float)gd[2], a[3] * (float)gd[3]);
                            *(u32x2*)(U + (size_t)row * DM + col) = w; } } }
    }
};
struct EpiX1 {
    h16* X1; const float* x; const float* MOD;
    __device__ __forceinline__ void operator()(f32x4 (&acc)[2][2][4][2], const pg8::Unit& u, int wr, int wc, int fr, int fq) const {
        const int b = (u.pm * 256) / SEQ;
#pragma unroll
        for (int ai = 0; ai < 2; ++ai)
#pragma unroll
            for (int m = 0; m < 4; ++m) { const int row = u.pm * 256 + ai * 128 + wr * 64 + m * 16 + fr;
#pragma unroll
                for (int bj = 0; bj < 2; ++bj)
#pragma unroll
                    for (int n = 0; n < 2; ++n) { const int col = u.pn * 256 + bj * 128 + wc * 32 + 16 * n + 4 * fq;
                        const f32x4 g1 = *(const f32x4*)(MOD + (size_t)b * (6 * DM) + 2 * DM + col); const f32x4 xv = *(const f32x4*)(x + (size_t)row * DM + col);
                        const f32x4 y = xv + g1 * acc[ai][bj][m][n]; u32x2 w; w.x = pk2h(y[0], y[1]); w.y = pk2h(y[2], y[3]); *(u32x2*)(X1 + (size_t)row * DM + col) = w; } }
    }
};
__device__ __forceinline__ void p7_gemm2(Frame& F) {
    pg8::Gemm g{(const h16*)(F.ws + WS_ACAT), (const h16*)(F.ws + WS_WCAT), 3072, 3072, 2048};
    SchedG2 S; S.so.init(MLAT, DM, F.G, (int)blockIdx.x);
    EpiU2 E{(h16*)(F.ws + WS_U), (const h16*)(F.ws + WS_P)};
    pg8::gemm_phase<EpiU2, SchedG2>(F.lds, g, S, E);
}
__device__ __forceinline__ void p9_gemm3(Frame& F) {
    pg8::Gemm g{(const h16*)(F.ws + WS_U), (const h16*)(F.ws + WS_WOUT), 2048, 2048, 2048};
    pg8::StaticOrder S; S.init(MLAT, DM, F.G, (int)blockIdx.x);
    EpiX1 E{(h16*)(F.ws + WS_X1), F.x, (const float*)(F.ws + WS_MOD)};
    pg8::gemm_phase<EpiX1, pg8::StaticOrder>(F.lds, g, S, E);
}


__device__ __forceinline__ void p10_norm2(Frame& F) {
    const h16* X1 = (const h16*)(F.ws + WS_X1); const float* MOD = (const float*)(F.ws + WS_MOD); h16* H2X = (h16*)(F.ws + WS_H2X);
    const int gw = F.vcu * NWAVES + F.wave, NGW = F.G * NWAVES;
    for (int r = gw; r < MLAT; r += NGW) {
        const h16* src = X1 + (size_t)r * DM; const int b = r / SEQ;
        f32x4 xv[8]; float ss = 0.f;
#pragma unroll
        for (int j = 0; j < 8; ++j) { const h16x4 hx = *(const h16x4*)(src + 4 * F.lane + 256 * j); xv[j] = (f32x4){(float)hx[0], (float)hx[1], (float)hx[2], (float)hx[3]}; ss += (xv[j].x * xv[j].x + xv[j].y * xv[j].y) + (xv[j].z * xv[j].z + xv[j].w * xv[j].w); }
        const float rstd = 1.0f / sqrtf(wave_sum(ss) * (1.0f / DM) + EPS);
#pragma unroll
        for (int j = 0; j < 8; ++j) { const int cc = 4 * F.lane + 256 * j; const f32x4 nw = *(const f32x4*)(F.norm_ffn + cc);
            const f32x4 sh = *(const f32x4*)(MOD + (size_t)b * (6 * DM) + 3 * DM + cc), sc = *(const f32x4*)(MOD + (size_t)b * (6 * DM) + 4 * DM + cc);
            const f32x4 y = xv[j] * rstd * nw * (sc + 1.0f) + sh;
            h16 hh[4], ll[4];
#pragma unroll
            for (int e = 0; e < 4; ++e) { hh[e] = (h16)y[e]; ll[e] = (h16)(y[e] - (float)hh[e]); }
            h16* dst = H2X + (size_t)r * 6144 + cc;
            *(h16x4*)(dst) = (h16x4){hh[0], hh[1], hh[2], hh[3]}; *(h16x4*)(dst + 4096) = (h16x4){hh[0], hh[1], hh[2], hh[3]}; *(h16x4*)(dst + 2048) = (h16x4){ll[0], ll[1], ll[2], ll[3]}; }
    }
}
struct SchedRT {
    int G, c;
    __device__ __forceinline__ bool next(int i, pg8::Unit& u) const { const int L = i * G + c; if (L >= 256) return false; u.pm = L >> 3; u.pn = 0; u.ko = (L & 7) * 768; u.nt = 0; u.keep = 0; return true; }
};
struct EpiLG {
    float* LGP;
    __device__ __forceinline__ void operator()(f32x4 (&acc)[2][2][4][2], const pg8::Unit& u, int wr, int wc, int fr, int fq) const {
        float* dst = LGP + (size_t)(u.ko / 768) * MLAT * NEXP;
#pragma unroll
        for (int ai = 0; ai < 2; ++ai)
#pragma unroll
            for (int m = 0; m < 4; ++m) { const int row = u.pm * 256 + ai * 128 + wr * 64 + m * 16 + fr;
#pragma unroll
                for (int bj = 0; bj < 2; ++bj)
#pragma unroll
                    for (int n = 0; n < 2; ++n) { const int col = bj * 128 + wc * 32 + 16 * n + 4 * fq; *(f32x4*)(dst + (size_t)row * NEXP + col) = acc[ai][bj][m][n]; } }
    }
};
__device__ __forceinline__ void p11_router(Frame& F) {
    pg8::Gemm g{(const h16*)(F.ws + WS_H2X), (const h16*)(F.ws + WS_WRTR), 6144, 6144, 768};
    SchedRT S; S.G = F.G; S.c = (int)blockIdx.x;
    EpiLG E{(float*)(F.ws + WS_LGP)};
    pg8::gemm_phase<EpiLG, SchedRT>(F.lds, g, S, E);
}
__device__ __forceinline__ void p12_topk(Frame& F) {
    const float* LGP = (const float*)(F.ws + WS_LGP); int* EIDX = (int*)(F.ws + WS_EIDX); float* EW = (float*)(F.ws + WS_EW); u32x2* LIST = (u32x2*)(F.ws + WS_LIST2);
    unsigned* CNT = (unsigned*)(F.ws + WS_CTL) + CW_CNT;
    const int gw = F.vcu * NWAVES + F.wave, NGW = F.G * NWAVES, lane = F.lane;
    const f32x4 bias = *(const f32x4*)(F.router_bias + 4 * lane);
    for (int t = gw; t < MLAT; t += NGW) {
        f32x4 lg = *(const f32x4*)(LGP + (size_t)t * NEXP + 4 * lane);
#pragma unroll
        for (int ks = 1; ks < 8; ++ks) lg += *(const f32x4*)(LGP + ((size_t)ks * MLAT + t) * NEXP + 4 * lane);
        float sc[4], sel[4];
#pragma unroll
        for (int i = 0; i < 4; ++i) { sc[i] = 1.0f / (1.0f + __expf(-lg[i])); sel[i] = sc[i] + bias[i]; }
        float a1 = fmaxf(sel[0], sel[1]), a2 = fminf(sel[0], sel[1]);
        { const float b1 = fmaxf(sel[2], sel[3]), b2 = fminf(sel[2], sel[3]); const float n1 = fmaxf(a1, b1), n2 = fmaxf(fminf(a1, b1), fmaxf(a2, b2)); a1 = n1; a2 = n2; }
#pragma unroll
        for (int off = 1; off < 8; off <<= 1) { const float b1 = __shfl_xor(a1, off), b2 = __shfl_xor(a2, off); const float n1 = fmaxf(a1, b1), n2 = fmaxf(fminf(a1, b1), fmaxf(a2, b2)); a1 = n1; a2 = n2; }
        const float gs = a1 + a2; const int g = lane >> 3;
        int rank = 0;
#pragma unroll
        for (int j = 0; j < 8; ++j) { const float o = __shfl(gs, 8 * j); rank += (o > gs || (o == gs && j < g)) ? 1 : 0; }
        const bool gsel = rank < 4;
        float ms[4];
#pragma unroll
        for (int i = 0; i < 4; ++i) ms[i] = gsel ? sel[i] : -INFINITY;
        float myw = 0.f; int mye = 0; float wsum = 0.f;
#pragma unroll
        for (int k = 0; k < TOPK; ++k) {
            float bv = ms[0]; int bi = 4 * lane;
#pragma unroll
            for (int i = 1; i < 4; ++i) if (ms[i] > bv) { bv = ms[i]; bi = 4 * lane + i; }
#pragma unroll
            for (int off = 1; off < 64; off <<= 1) { const float ov = __shfl_xor(bv, off); const int oi = __shfl_xor(bi, off); if (ov > bv || (ov == bv && oi < bi)) { bv = ov; bi = oi; } }
            const int ol = bi >> 2, oi = bi & 3;
            const float mysc = (oi == 0) ? sc[0] : (oi == 1) ? sc[1] : (oi == 2) ? sc[2] : sc[3];
            const float w = __shfl(mysc, ol);
            if (lane == ol) {
#pragma unroll
                for (int i = 0; i < 4; ++i) if (i == oi) ms[i] = -INFINITY; }
            wsum += w;
            if (lane == k) { myw = w; mye = bi; }
        }
        if (lane < TOPK) {
            const float wn = myw / wsum * 2.5f;
            EIDX[t * TOPK + lane] = mye; EW[t * TOPK + lane] = wn;
            const unsigned pos = atomicAdd(&CNT[mye], 1u);
            LIST[mye * MLAT + pos] = (u32x2){(unsigned)(t * TOPK + lane), __float_as_uint(wn)};
        }
    }
}
constexpr int EX_NSTG = 3, EX_ASTG = 24576, EX_WSTG = 16384, EX_A0 = 0, EX_W0 = EX_NSTG * EX_ASTG, EX_WH0 = EX_W0 + EX_NSTG * EX_WSTG, EX_WHS = 10240, EX_ROW0 = EX_WH0 + 2 * EX_WHS;
constexpr int EX_TAB0 = EX_ROW0 + 3200, EX_SCR0 = EX_TAB0 + 3072;
static_assert(EX_ROW0 == 143360 && EX_SCR0 + 8192 <= LDSCTL_OFF, "expert LDS map");
template <bool GU>
__device__ __forceinline__ void ring_w_prologue(Frame& F, const float* W, int cgrp) {
    constexpr int LDB = GU ? 512 : 2048;
    const int lane = F.lane, w = F.wave, v = 4 * (lane & 31);
    const int wcol0 = GU ? (((v >> 5) & 1) * 256 + 32 * (v >> 6) + (v & 31) + 64 * cgrp) : (v + 512 * cgrp);
    const float* wlane = W + (size_t)(4 * w + (lane >> 5)) * LDB + wcol0;
#pragma unroll
    for (int s = 0; s < 3; ++s)
#pragma unroll
        for (int j = 0; j < 2; ++j) __builtin_amdgcn_global_load_lds((const unsigned*)(wlane + (size_t)(s * 32 + 2 * j) * LDB), (LAS unsigned*)(F.lds + EX_W0 + s * EX_WSTG + (2 * w + j) * 1024), 16, 0, 2);
}
template <bool GU, int NLAY>
__device__ __forceinline__ void expert_ring(Frame& F, const float* W, const h16* Abase, const int (&arow)[3], int nr, int cgrp, h16* ACTrow0, h16* Y) {
    constexpr int KT = GU ? 64 : 8, NP = GU ? 1 : 4, LDB = GU ? 512 : 2048, NS = KT * NP;
    const int tid = F.tid, lane = F.lane, hi = lane >> 5, ln = lane & 31, cp = F.wave & 1, rg = F.wave >> 1, w = F.wave;
    const LAS int* RSLOT = (const LAS int*)(F.lds + EX_ROW0); const LAS float* RW = (const LAS float*)(F.lds + EX_ROW0 + 1536);
    const int ngrp = (nr + 15) >> 4;
    const int nA = (w < ngrp ? 1 : 0) + (w + 8 < ngrp ? 1 : 0) + (w + 16 < ngrp ? 1 : 0);
    const int achunk = ((lane & 3) ^ ((lane >> 4) & 3)) * 8;
    const int v = 4 * (lane & 31);
    const int wcol0 = GU ? (((v >> 5) & 1) * 256 + 32 * (v >> 6) + (v & 31) + 64 * cgrp) : (v + 512 * cgrp);
    const float* wlane = W + (size_t)(4 * w + (lane >> 5)) * LDB + wcol0;
    const unsigned lds0 = (unsigned)(uintptr_t)F.lds;
    const int xs = (ln >> 2) & 3;
    const unsigned aofs0 = (unsigned)((2 * rg + (ln >> 4)) * 1024 + (ln & 15) * 64 + ((hi ^ xs) * 16)), aofs1 = (unsigned)((2 * rg + (ln >> 4)) * 1024 + (ln & 15) * 64 + (((2 + hi) ^ xs) * 16));
    const unsigned tofs = (unsigned)((8 * hi + ((lane & 15) >> 2)) * 320 + (64 * cp + 16 * ((lane >> 4) & 1) + 4 * (lane & 3)) * 2);
    f32x16 acc[2 * NLAY];
#pragma unroll
    for (int i = 0; i < 2 * NLAY; ++i) acc[i] = (f32x16){};
#define EX_DMA_A(s) do { const int kt_ = (s) % KT, stg_ = (s) % EX_NSTG; \
        _Pragma("unroll") for (int j = 0; j < 3; ++j) if (j < nA) __builtin_amdgcn_global_load_lds((const unsigned*)(Abase + arow[j] + kt_ * 32 + achunk), (LAS unsigned*)(F.lds + EX_A0 + stg_ * EX_ASTG + (w + 8 * j) * 1024), 16, 0, 0); } while (0)
#define EX_DMA_W(s) do { const int pass_ = (s) / KT, kt_ = (s) % KT, stg_ = (s) % EX_NSTG; \
        _Pragma("unroll") for (int j = 0; j < 2; ++j) __builtin_amdgcn_global_load_lds((const unsigned*)(wlane + (size_t)(kt_ * 32 + 2 * j) * LDB + 128 * pass_), (LAS unsigned*)(F.lds + EX_W0 + stg_ * EX_WSTG + (2 * w + j) * 1024), 16, 0, 2); } while (0)
#define EX_WAITV(k) asm volatile("s_waitcnt vmcnt(" #k ")" ::: "memory")
#define EX_WAITN() do { if (nA == 3) EX_WAITV(5); else if (nA == 2) EX_WAITV(4); else if (nA == 1) EX_WAITV(3); else EX_WAITV(2); } while (0)
    const unsigned cvsrc = lds0 + EX_W0 + (tid >> 4) * 512 + (tid & 15) * 32, cvdst = lds0 + EX_WH0 + (tid >> 4) * 320 + (tid & 15) * 16;
    EX_DMA_A(0); EX_DMA_A(1);
    if (nA == 3) EX_WAITV(3); else if (nA == 2) EX_WAITV(2); else if (nA == 1) EX_WAITV(1); else EX_WAITV(0);
    __builtin_amdgcn_s_barrier(); asm volatile("" ::: "memory");
    { f32x4 c0, c1; asm volatile("ds_read_b128 %0, %2\n\tds_read_b128 %1, %2 offset:16\n\ts_waitcnt lgkmcnt(0)" : "=&v"(c0), "=&v"(c1) : "v"(cvsrc) : "memory");
      const h16x8 hv = pack8(c0[0], c0[1], c0[2], c0[3], c1[0], c1[1], c1[2], c1[3]); asm volatile("ds_write_b128 %0, %1" :: "v"(cvdst), "v"(hv) : "memory"); }
    typedef short s16x8 __attribute__((ext_vector_type(8)));
    for (int s = 0; s < NS; ++s) {
        if (s + 2 < NS) EX_WAITN(); else EX_WAITV(0);
        asm volatile("s_waitcnt lgkmcnt(0)" ::: "memory");
        __builtin_amdgcn_s_barrier();
        asm volatile("" ::: "memory");
        const bool pend = ((s % KT) == KT - 1);
        if (!pend) { if (s + 2 < NS) EX_DMA_A(s + 2); if (s + 3 < NS) EX_DMA_W(s + 3); }
        const unsigned abase = lds0 + EX_A0 + (s % EX_NSTG) * EX_ASTG, wbase = lds0 + EX_WH0 + (s & 1) * EX_WHS + tofs;
        const unsigned cs = cvsrc + ((s + 1) % EX_NSTG) * EX_WSTG;
        const unsigned pa0 = abase + aofs0, pa1 = abase + aofs1;
        if constexpr (NLAY < 3) {
            v4i16_t t0, t1, t2, t3, t4, t5, t6, t7; h16x8 a0[NLAY], a1[NLAY];
            asm volatile("ds_read_b64_tr_b16 %0, %8\n\tds_read_b64_tr_b16 %1, %8 offset:1280\n\tds_read_b64_tr_b16 %2, %8 offset:64\n\tds_read_b64_tr_b16 %3, %8 offset:1344\n\t"
                         "ds_read_b64_tr_b16 %4, %8 offset:5120\n\tds_read_b64_tr_b16 %5, %8 offset:6400\n\tds_read_b64_tr_b16 %6, %8 offset:5184\n\tds_read_b64_tr_b16 %7, %8 offset:6464"
                         : "=&v"(t0), "=&v"(t1), "=&v"(t2), "=&v"(t3), "=&v"(t4), "=&v"(t5), "=&v"(t6), "=&v"(t7) : "v"(wbase) : "memory");
            asm volatile("ds_read_b128 %0, %2\n\tds_read_b128 %1, %3" : "=&v"(a0[0]), "=&v"(a1[0]) : "v"(pa0), "v"(pa1) : "memory");
            if constexpr (NLAY >= 2) asm volatile("ds_read_b128 %0, %2 offset:8192\n\tds_read_b128 %1, %3 offset:8192" : "=&v"(a0[1]), "=&v"(a1[1]) : "v"(pa0), "v"(pa1) : "memory");
            asm volatile("s_waitcnt lgkmcnt(0)" ::: "memory");
            __builtin_amdgcn_sched_barrier(0);
            const h16x8 b00 = __builtin_bit_cast(h16x8, (s16x8){t0[0], t0[1], t0[2], t0[3], t1[0], t1[1], t1[2], t1[3]}), b01 = __builtin_bit_cast(h16x8, (s16x8){t2[0], t2[1], t2[2], t2[3], t3[0], t3[1], t3[2], t3[3]});
            const h16x8 b10 = __builtin_bit_cast(h16x8, (s16x8){t4[0], t4[1], t4[2], t4[3], t5[0], t5[1], t5[2], t5[3]}), b11 = __builtin_bit_cast(h16x8, (s16x8){t6[0], t6[1], t6[2], t6[3], t7[0], t7[1], t7[2], t7[3]});
#pragma unroll
            for (int i = 0; i < NLAY; ++i) { acc[2 * i] = MFMA32(a0[i], b00, acc[2 * i]); acc[2 * i + 1] = MFMA32(a0[i], b01, acc[2 * i + 1]); }
#pragma unroll
            for (int i = 0; i < NLAY; ++i) { acc[2 * i] = MFMA32(a1[i], b10, acc[2 * i]); acc[2 * i + 1] = MFMA32(a1[i], b11, acc[2 * i + 1]); }
        } else {
#pragma unroll
            for (int k16 = 0; k16 < 2; ++k16) {
                v4i16_t t0, t1, t2, t3; h16x8 a[3]; const unsigned pa = k16 ? pa1 : pa0, pw = wbase + k16 * 5120;
                asm volatile("ds_read_b64_tr_b16 %0, %4\n\tds_read_b64_tr_b16 %1, %4 offset:1280\n\tds_read_b64_tr_b16 %2, %4 offset:64\n\tds_read_b64_tr_b16 %3, %4 offset:1344"
                             : "=&v"(t0), "=&v"(t1), "=&v"(t2), "=&v"(t3) : "v"(pw) : "memory");
                asm volatile("ds_read_b128 %0, %3\n\tds_read_b128 %1, %3 offset:8192\n\tds_read_b128 %2, %3 offset:16384\n\ts_waitcnt lgkmcnt(0)" : "=&v"(a[0]), "=&v"(a[1]), "=&v"(a[2]) : "v"(pa) : "memory");
                __builtin_amdgcn_sched_barrier(0);
                const h16x8 b0 = __builtin_bit_cast(h16x8, (s16x8){t0[0], t0[1], t0[2], t0[3], t1[0], t1[1], t1[2], t1[3]}), b1 = __builtin_bit_cast(h16x8, (s16x8){t2[0], t2[1], t2[2], t2[3], t3[0], t3[1], t3[2], t3[3]});
#pragma unroll
                for (int i = 0; i < 3; ++i) { acc[2 * i] = MFMA32(a[i], b0, acc[2 * i]); acc[2 * i + 1] = MFMA32(a[i], b1, acc[2 * i + 1]); }
                __builtin_amdgcn_sched_barrier(0);
            }
        }
        if (s + 1 < NS) {
            f32x4 c0, c1; asm volatile("ds_read_b128 %0, %2\n\tds_read_b128 %1, %2 offset:16\n\ts_waitcnt lgkmcnt(0)" : "=&v"(c0), "=&v"(c1) : "v"(cs) : "memory");
            const h16x8 hv = pack8(c0[0], c0[1], c0[2], c0[3], c1[0], c1[1], c1[2], c1[3]); const unsigned cd = cvdst + ((s + 1) & 1) * EX_WHS; asm volatile("ds_write_b128 %0, %1" :: "v"(cd), "v"(hv) : "memory"); }
        if (pend) {
            const int pass = s / KT;
            int hio = hi, lno = ln; asm volatile("" : "+v"(hio), "+v"(lno));
            if (GU) {
#pragma unroll
                for (int i = 0; i < NLAY; ++i) { const int rt = rg + 4 * i;
#pragma unroll
                    for (int r = 0; r < 16; ++r) { const int row = 32 * rt + crow(r, hio);
                        if (row < nr) ACTrow0[(size_t)row * DEXP + 64 * cgrp + 32 * cp + lno] = (h16)(silu_f(acc[2 * i][r]) * acc[2 * i + 1][r]); }
                    acc[2 * i] = (f32x16){}; acc[2 * i + 1] = (f32x16){}; }
            } else {
                const unsigned scr = lds0 + EX_SCR0 + w * 1024;
#pragma unroll
                for (int i = 0; i < NLAY; ++i) { const int rt = rg + 4 * i;
#pragma unroll
                    for (int g8 = 0; g8 < 4; ++g8) {
#pragma unroll
                        for (int q = 0; q < 4; ++q) { const int lr = 4 * hio + q; const float wt = RW[32 * rt + 8 * g8 + lr];
                            const h16 v0 = (h16)(acc[2 * i][4 * g8 + q] * wt), v1 = (h16)(acc[2 * i + 1][4 * g8 + q] * wt); const unsigned wa = scr + lr * 128 + lno * 2;
                            asm volatile("ds_write_b16 %0, %1\n\tds_write_b16 %0, %2 offset:64" :: "v"(wa), "v"(v0), "v"(v1) : "memory"); }
                        u32x4 pv; const unsigned ra = scr + (lane >> 3) * 128 + (lane & 7) * 16;
                        asm volatile("s_waitcnt lgkmcnt(0)\n\tds_read_b128 %0, %1\n\ts_waitcnt lgkmcnt(0)" : "=&v"(pv) : "v"(ra) : "memory");
                        const int grow = 32 * rt + 8 * g8 + (lane >> 3);
                        if (grow < nr) { const int slot = RSLOT[grow]; *(u32x4*)(Y + (size_t)slot * DM + 512 * cgrp + 128 * pass + 64 * cp + (lane & 7) * 8) = pv; }
                    }
                    acc[2 * i] = (f32x16){}; acc[2 * i + 1] = (f32x16){}; }
            }
            if (s + 2 < NS) EX_DMA_A(s + 2);
            if (s + 3 < NS) EX_DMA_W(s + 3);
        }
    }
    asm volatile("s_waitcnt vmcnt(0) lgkmcnt(0)" ::: "memory");
    __builtin_amdgcn_s_barrier();
    asm volatile("" ::: "memory");
#undef EX_DMA_A
#undef EX_DMA_W
#undef EX_WAITV
#undef EX_WAITN
}
template <bool GU>
__device__ __forceinline__ void p13_expert_phase(Frame& F, int qid) {
    const h16* H2X = (const h16*)(F.ws + WS_H2X); h16* Y = (h16*)(F.ws + WS_Y); h16* ACT = (h16*)(F.ws + WS_ACT);
    const unsigned* CNT = (const unsigned*)(F.ws + WS_CTL) + CW_CNT; unsigned* QH = (unsigned*)(F.ws + WS_CTL) + CW_Q + 64 * qid;
    LAS int* RSLOT = (LAS int*)(F.lds + EX_ROW0); LAS float* RW = (LAS float*)(F.lds + EX_ROW0 + 1536); LAS int* RED = (LAS int*)(F.lds + EX_ROW0 + 3072);
    LAS int* CN = (LAS int*)(F.lds + EX_TAB0); LAS int* ORD = CN + 256; LAS int* OFF = CN + 512;
    __syncthreads();
    if (F.tid < NEXP) CN[F.tid] = (int)CNT[F.tid];
    __syncthreads();
    if (F.tid < NEXP) { const int c = CN[F.tid]; int rank = 0, off = 0;
        for (int j = 0; j < NEXP; ++j) { const int cj = CN[j]; rank += (cj > c || (cj == c && j < F.tid)) ? 1 : 0; off += (j < F.tid) ? cj : 0; }
        ORD[rank] = F.tid; OFF[F.tid] = off; }
    __syncthreads();
    const u32x2* LIST2 = (const u32x2*)(F.ws + WS_LIST2);
    if (F.tid == 0) RED[0] = (int)__hip_atomic_fetch_add(QH, 1u, __ATOMIC_RELAXED, __HIP_MEMORY_SCOPE_AGENT);
    __syncthreads();
    int u = RED[0];
    while (u < NEXP * 4) {
        const int e = ORD[u >> 2], cg = u & 3, cnt = CN[e], off_e = OFF[e];
        const float* Wgu = F.w_exp_gu + (size_t)e * DM * 512; const float* Wdn = F.w_exp_down + (size_t)e * DEXP * DM;
        for (int rs = 0; rs < cnt; rs += 384) {
            const int nr = (cnt - rs) < 384 ? (cnt - rs) : 384;
            __syncthreads();
            ring_w_prologue<GU>(F, GU ? Wgu : Wdn, cg);
            if (F.tid < 384) { u32x2 ent = {0u, 0u}; if (F.tid < nr) ent = LIST2[e * MLAT + rs + F.tid]; RSLOT[F.tid] = (int)ent.x; RW[F.tid] = __uint_as_float(ent.y); }
            __syncthreads();
            h16* ACTrow0 = ACT + (size_t)(off_e + rs) * DEXP;
            int arow[3];
            if (GU) {
#pragma unroll
                for (int j = 0; j < 3; ++j) arow[j] = (RSLOT[16 * (F.wave + 8 * j) + (F.lane >> 2)] >> 3) * 6144;
                if (nr > 256) expert_ring<true, 3>(F, Wgu, H2X, arow, nr, cg, ACTrow0, Y); else if (nr > 128) expert_ring<true, 2>(F, Wgu, H2X, arow, nr, cg, ACTrow0, Y); else expert_ring<true, 1>(F, Wgu, H2X, arow, nr, cg, ACTrow0, Y);
            } else {
#pragma unroll
                for (int j = 0; j < 3; ++j) { const int r = 16 * (F.wave + 8 * j) + (F.lane >> 2); arow[j] = ((r < nr) ? r : 0) * DEXP; }
                if (nr > 256) expert_ring<false, 3>(F, Wdn, ACTrow0, arow, nr, cg, ACTrow0, Y); else if (nr > 128) expert_ring<false, 2>(F, Wdn, ACTrow0, arow, nr, cg, ACTrow0, Y); else expert_ring<false, 1>(F, Wdn, ACTrow0, arow, nr, cg, ACTrow0, Y);
            }
        }
        __syncthreads();
        if (F.tid == 0) RED[0] = (int)__hip_atomic_fetch_add(QH, 1u, __ATOMIC_RELAXED, __HIP_MEMORY_SCOPE_AGENT);
        __syncthreads();
        u = RED[0];
    }
}
struct SchedSG {
    int G, c;
    __device__ __forceinline__ bool next(int i, pg8::Unit& u) const { const int L = i * G + c; if (L >= 256) return false; u.pm = L >> 3; u.pn = (L >> 2) & 1; u.ko = (L & 3) * 512; u.nt = 0; u.keep = 0; return true; }
};
struct EpiSGP {
    float* SGP;
    __device__ __forceinline__ void operator()(f32x4 (&acc)[2][2][4][2], const pg8::Unit& u, int wr, int wc, int fr, int fq) const {
        float* dst = SGP + (size_t)(u.ko / 512) * MLAT * 512;
#pragma unroll
        for (int ai = 0; ai < 2; ++ai)
#pragma unroll
            for (int m = 0; m < 4; ++m) { const int row = u.pm * 256 + ai * 128 + wr * 64 + m * 16 + fr;
#pragma unroll
                for (int bj = 0; bj < 2; ++bj)
#pragma unroll
                    for (int n = 0; n < 2; ++n) { const int col = u.pn * 256 + bj * 128 + wc * 32 + 16 * n + 4 * fq; *(f32x4*)(dst + (size_t)row * 512 + col) = acc[ai][bj][m][n]; } }
    }
};
__device__ __forceinline__ void p11b_shared_gu(Frame& F) {
    pg8::Gemm g{(const h16*)(F.ws + WS_H2X), (const h16*)(F.ws + WS_WSGU), 6144, 2048, 512};
    SchedSG S; S.G = F.G; S.c = (int)blockIdx.x;
    EpiSGP E{(float*)(F.ws + WS_SGP)};
    pg8::gemm_phase<EpiSGP, SchedSG>(F.lds, g, S, E);
}
__device__ __forceinline__ void p12b_shared_act(Frame& F) {
    const float* SGP = (const float*)(F.ws + WS_SGP); h16* ACTS = (h16*)(F.ws + WS_ACTS);
    for (int q = blockIdx.x * NTHR + F.tid; q < MLAT * 64; q += F.G * NTHR) {
        const int row = q >> 6, j = (q & 63) * 4, pg = 32 * (j >> 4) + (j & 15);
        f32x4 gv = {0.f, 0.f, 0.f, 0.f}, uv = gv;
#pragma unroll
        for (int ks = 0; ks < 4; ++ks) { const float* p = SGP + ((size_t)ks * MLAT + row) * 512 + pg; gv += *(const f32x4*)p; uv += *(const f32x4*)(p + 16); }
        u32x2 w; w.x = pk2h(silu_f(gv[0]) * uv[0], silu_f(gv[1]) * uv[1]); w.y = pk2h(silu_f(gv[2]) * uv[2], silu_f(gv[3]) * uv[3]);
        *(u32x2*)(ACTS + (size_t)row * DEXP + j) = w;
    }
}
struct EpiYsh {
    h16* YSH;
    __device__ __forceinline__ void operator()(f32x4 (&acc)[2][2][4][2], const pg8::Unit& u, int wr, int wc, int fr, int fq) const {
#pragma unroll
        for (int ai = 0; ai < 2; ++ai)
#pragma unroll
            for (int m = 0; m < 4; ++m) { const int row = u.pm * 256 + ai * 128 + wr * 64 + m * 16 + fr;
#pragma unroll
                for (int bj = 0; bj < 2; ++bj)
#pragma unroll
                    for (int n = 0; n < 2; ++n) { const int col = u.pn * 256 + bj * 128 + wc * 32 + 16 * n + 4 * fq; const f32x4 a = acc[ai][bj][m][n];
                        u32x2 w; w.x = pk2h(a[0], a[1]); w.y = pk2h(a[2], a[3]); *(u32x2*)(YSH + (size_t)row * DM + col) = w; } }
    }
};
__device__ __forceinline__ void p15_shared_down(Frame& F) {
    pg8::Gemm g{(const h16*)(F.ws + WS_ACTS), (const h16*)(F.ws + WS_WSDN), 256, 256, 256};
    pg8::StaticOrder S; S.init(MLAT, DM, F.G, (int)blockIdx.x);
    EpiYsh E{(h16*)(F.ws + WS_YSH)};
    pg8::gemm_phase<EpiYsh, pg8::StaticOrder>(F.lds, g, S, E);
}
__device__ __forceinline__ void p16_combine(Frame& F) {
    const h16* X1 = (const h16*)(F.ws + WS_X1); const float* MOD = (const float*)(F.ws + WS_MOD); const h16* Y = (const h16*)(F.ws + WS_Y); const h16* YSH = (const h16*)(F.ws + WS_YSH);
    const int gw = F.vcu * NWAVES + F.wave, NGW = F.G * NWAVES;
    for (int r = gw; r < MLAT; r += NGW) {
        const int b = r / SEQ;
        f32x4 xv[8]; float ss = 0.f;
#pragma unroll
        for (int j = 0; j < 8; ++j) { const int cc = 4 * F.lane + 256 * j;
            f32x4 m = {0.f, 0.f, 0.f, 0.f};
#pragma unroll
            for (int k = 0; k < TOPK; ++k) { const h16x4 yv = *(const h16x4*)(Y + (size_t)(r * TOPK + k) * DM + cc); m += (f32x4){(float)yv[0], (float)yv[1], (float)yv[2], (float)yv[3]}; }
            { const h16x4 yv = *(const h16x4*)(YSH + (size_t)r * DM + cc); m += (f32x4){(float)yv[0], (float)yv[1], (float)yv[2], (float)yv[3]}; }
            const f32x4 g2 = *(const f32x4*)(MOD + (size_t)b * (6 * DM) + 5 * DM + cc);
            { const h16x4 hx = *(const h16x4*)(X1 + (size_t)r * DM + cc); xv[j] = (f32x4){(float)hx[0], (float)hx[1], (float)hx[2], (float)hx[3]} + g2 * m; }
            ss += (xv[j].x * xv[j].x + xv[j].y * xv[j].y) + (xv[j].z * xv[j].z + xv[j].w * xv[j].w);
            if (j & 1) asm volatile("" ::: "memory"); }
        const float rstd = 1.0f / sqrtf(wave_sum(ss) * (1.0f / DM) + EPS);
#pragma unroll
        for (int j = 0; j < 8; ++j) { const int cc = 4 * F.lane + 256 * j; const f32x4 nw = *(const f32x4*)(F.final_norm + cc);
            *(f32x4*)(F.out + (size_t)r * DM + cc) = xv[j] * rstd * nw; }
    }
}

__device__ __forceinline__ void p_final_plain(Frame& F, const float* xin) {
    const int gw = F.vcu * NWAVES + F.wave, NGW = F.G * NWAVES;
    for (int r = gw; r < MLAT; r += NGW) {
        const float* src = xin + (size_t)r * DM;
        f32x4 xv[8]; float ss = 0.f;
#pragma unroll
        for (int j = 0; j < 8; ++j) { xv[j] = *(const f32x4*)(src + 4 * F.lane + 256 * j); ss += (xv[j].x * xv[j].x + xv[j].y * xv[j].y) + (xv[j].z * xv[j].z + xv[j].w * xv[j].w); }
        const float rstd = 1.0f / sqrtf(wave_sum(ss) * (1.0f / DM) + EPS);
#pragma unroll
        for (int j = 0; j < 8; ++j) { const int cc = 4 * F.lane + 256 * j; const f32x4 nw = *(const f32x4*)(F.final_norm + cc);
            *(f32x4*)(F.out + (size_t)r * DM + cc) = xv[j] * rstd * nw; }
    }
}

constexpr int N_PHASES = 15;
#ifndef DUP_PHASE
#define DUP_PHASE -1
#endif
#ifndef DUP_VAR
#define DUP_VAR 7
#endif
struct Args { const float* in[22]; float* out; unsigned char* ws; int ph_lo, ph_hi; };
__global__ void __launch_bounds__(NTHR, 2) mk_fwd(Args args) {
    extern __shared__ __attribute__((aligned(16))) unsigned char lds_raw[];
    Frame F;
    F.lds = (LAS unsigned char*)lds_raw;
    F.tid = threadIdx.x; F.lane = F.tid & 63; F.wave = __builtin_amdgcn_readfirstlane(F.tid >> 6);
    F.G = gridDim.x; { const int bx = blockIdx.x; F.vcu = (F.G % 8 == 0) ? (bx % 8) * (F.G / 8) + bx / 8 : bx; }
    F.x = args.in[0]; F.c = args.in[1]; F.ctx = args.in[2]; F.c_ctx = args.in[3]; F.w_mod = args.in[4]; F.b_mod = args.in[5]; F.norm_attn = args.in[6]; F.norm_ffn = args.in[7];
    F.w_in = args.in[8]; F.ret_decay = args.in[9]; F.diff_lambda = args.in[10]; F.diff_subln = args.in[11]; F.w_ret_o = args.in[12]; F.w_diff_o = args.in[13]; F.w_out = args.in[14];
    F.w_router = args.in[15]; F.router_bias = args.in[16]; F.w_exp_gu = args.in[17]; F.w_exp_down = args.in[18]; F.w_sh_gu = args.in[19]; F.w_sh_down = args.in[20]; F.final_norm = args.in[21];
    F.out = args.out; F.ws = args.ws;
    volatile LAS unsigned* MISC = (volatile LAS unsigned*)(F.lds + LDSCTL_OFF);
    for (int u = F.tid; u < (LDS_BYTES - LDSCTL_OFF) / 4; u += NTHR) ((LAS unsigned*)(F.lds + LDSCTL_OFF))[u] = 0u;
    __syncthreads();
    const int lo = args.ph_lo, hi = args.ph_hi;
    const bool multi = (hi - lo) > 1;
    XcdBarrier bar; bar.bar = (unsigned*)(F.ws + WS_CTL) + CW_BAR; bar.x = 0; bar.st = nullptr;
    if (multi) bar = xcd_barrier_post((unsigned*)(F.ws + WS_CTL) + CW_BAR, MISC + 8);
#define IN(k) (lo <= (k) && (k) < hi)
#define SEAM(k) do { if (IN(k) && IN((k) + 1)) xcd_barrier(bar); } while (0)

#define RUNP(k, call) do { if (IN(k)) { call; if (DUP_PHASE == (k)) { xcd_barrier(bar); call; } } SEAM(k); } while (0)
    RUNP(0, p0a_mod(F));
    RUNP(1, (p1_norm1(F), p0b_weights(F)));
    RUNP(2, p2_gemm1(F));
    RUNP(3, p3_ret_local(F));
    RUNP(4, p4_ret_scan(F));
    RUNP(5, p5_ret_out(F));
    RUNP(6, p6_attn(F));
    RUNP(7, p7_gemm2(F));
    RUNP(8, p9_gemm3(F));
    RUNP(9, p10_norm2(F));
    RUNP(10, (p11_router(F), p11b_shared_gu(F)));
    RUNP(11, (p12_topk(F), p12b_shared_act(F)));
    if (IN(12)) { p13_expert_phase<true>(F, 0); if (DUP_PHASE == 12) { xcd_barrier(bar); p13_expert_phase<true>(F, 2); } } SEAM(12);
    if (IN(13)) { p15_shared_down(F); p13_expert_phase<false>(F, 1); if (DUP_PHASE == 13) { xcd_barrier(bar); p13_expert_phase<false>(F, 3); } } SEAM(13);
    if (IN(14)) { p16_combine(F); }
#undef RUNP
#undef IN
#undef SEAM
}

constexpr bool ONE_LAUNCH = true;
extern "C" void kernel_launch(void* const* d_in, const int* in_sizes, int n_in, void* d_out, int out_size, void* d_ws, size_t ws_size, hipStream_t stream) {
    static int grid = 0;
    if (grid == 0) {
        if (n_in != 22 || out_size != MLAT * DM || ws_size < WS_END) { fprintf(stderr, "kernel_launch: unexpected sizes n_in %d out %d ws %zu\n", n_in, out_size, ws_size); grid = -1; return; }
        int dev = 0, cus = 0;
        if (hipGetDevice(&dev) != hipSuccess || hipDeviceGetAttribute(&cus, hipDeviceAttributeMultiprocessorCount, dev) != hipSuccess) { grid = -1; return; }
        if (hipFuncSetAttribute((const void*)mk_fwd, hipFuncAttributeMaxDynamicSharedMemorySize, LDS_BYTES) != hipSuccess) { fprintf(stderr, "kernel_launch: hipFuncSetAttribute failed\n"); grid = -1; return; }
        int per_cu = 0;
        if (hipOccupancyMaxActiveBlocksPerMultiprocessor(&per_cu, (const void*)mk_fwd, NTHR, LDS_BYTES) != hipSuccess || per_cu < 1) fprintf(stderr, "kernel_launch: occupancy query reports %d\n", per_cu);
        (void)hipGetLastError();
        grid = cus;
    }
    if (grid < 0) return;
    (void)hipMemsetAsync((char*)d_ws + WS_CTL, 0, CTL_ZERO_BYTES, stream);
    Args a{};
    for (int i = 0; i < 22; ++i) a.in[i] = (const float*)d_in[i];
    a.out = (float*)d_out; a.ws = (unsigned char*)d_ws;
    if (ONE_LAUNCH) {
        a.ph_lo = 0; a.ph_hi = N_PHASES;
        hipLaunchKernelGGL(mk_fwd, dim3(grid), dim3(NTHR), LDS_BYTES, stream, a);
    } else {
        for (int p = 0; p < N_PHASES; ++p) { a.ph_lo = p; a.ph_hi = p + 1; hipLaunchKernelGGL(mk_fwd, dim3(grid), dim3(NTHR), LDS_BYTES, stream, a); }
    }
}
```

```cpp
#include <hip/hip_runtime.h>
#include <cstdio>
#include <cstdint>

#define LAS __attribute__((address_space(3)))
#define GAS __attribute__((address_space(1)))
typedef _Float16 h16;
typedef _Float16 h16x8 __attribute__((ext_vector_type(8)));
typedef _Float16 h16x4 __attribute__((ext_vector_type(4)));
typedef _Float16 h16x2 __attribute__((ext_vector_type(2)));
typedef float f32x2 __attribute__((ext_vector_type(2)));
typedef float f32x4 __attribute__((ext_vector_type(4)));
typedef float f32x16 __attribute__((ext_vector_type(16)));
typedef unsigned u32x4 __attribute__((ext_vector_type(4)));
typedef unsigned u32x2 __attribute__((ext_vector_type(2)));
typedef short v4i16_t __attribute__((ext_vector_type(4)));

constexpr int DM = 2048, NBATCH = 2, SEQ = 4096, CTXL = 256;
constexpr int MLAT = NBATCH * SEQ, MCTX = NBATCH * CTXL, MALL = MLAT + MCTX;
constexpr int IN_COLS = 13312, KV_COLS = 5120;
constexpr int C_RK = 0, C_RV = 1024, C_DK = 3072, C_DV = 4096, C_RQ = 5120, C_RG = 6144, C_DQ = 8192, C_GR = 9216, C_GD = 11264;
constexpr int NEXP = 256, TOPK = 8, DEXP = 256;
constexpr float EPS = 1e-6f;
constexpr int NWAVES = 8, NTHR = 512;

constexpr size_t MiB = 1u << 20;
constexpr size_t WS_CTL = 0, CTL_ZERO_BYTES = 1 * MiB;
constexpr size_t WS_MODP = 1 * MiB;
constexpr size_t WS_MOD = 3 * MiB;
constexpr size_t WS_ROPE = 3 * MiB + 512 * 1024;
constexpr size_t WS_WINT = 4 * MiB;
constexpr size_t WS_WRET = 56 * MiB;
constexpr size_t WS_WDIF = 64 * MiB;
constexpr size_t WS_WOUT = 68 * MiB;
constexpr size_t WS_WSGU = 76 * MiB;
constexpr size_t WS_WSDN = 78 * MiB;
constexpr size_t WS_WRTR = 79 * MiB;
constexpr size_t WS_H = 82 * MiB;
constexpr size_t WS_P = 116 * MiB;
constexpr size_t WS_LST = 340 * MiB;
constexpr size_t WS_SST = 408 * MiB;
constexpr size_t WS_ARET = 472 * MiB;
constexpr size_t WS_ADIF = 504 * MiB;
constexpr size_t WS_T = 520 * MiB;
constexpr size_t WS_U = 584 * MiB;
constexpr size_t WS_X1 = 616 * MiB;
constexpr size_t WS_H2X = 680 * MiB;
constexpr size_t WS_LG = 776 * MiB;
constexpr size_t WS_EIDX = 784 * MiB;
constexpr size_t WS_EW = 785 * MiB;
constexpr size_t WS_LIST = 786 * MiB;
constexpr size_t WS_ACTS = 794 * MiB;
constexpr size_t WS_YSH = 798 * MiB;
constexpr size_t WS_Y = 830 * MiB;
constexpr size_t WS_ACT = 1086 * MiB;
constexpr size_t WS_LGP = 1118 * MiB;
constexpr size_t WS_SGP = 1182 * MiB;
constexpr size_t WS_ACAT = 1246 * MiB;
constexpr size_t WS_WCAT = 1294 * MiB;
constexpr size_t WS_LIST2 = 1306 * MiB;
constexpr size_t WS_H2F8 = 1322 * MiB;
constexpr size_t WS_END = 1338 * MiB;

constexpr int CW_BAR = 4096;
constexpr int CW_CNT = 16384;
constexpr int CW_Q = 20480;

constexpr int RING_BYTES = 131072;
constexpr int LDS_BYTES = 163840;
constexpr int LDSCTL_OFF = LDS_BYTES - 512;

#define XB_TMO      128
#define XB_XCNT(j)  (256  + 64 * (j))
#define XB_XSUB(j)  (1280 + 64 * (j))
#define XB_XGEN(j)  (2304 + 64 * (j))
#define XB_TOP      3328
#define XB_TOPGEN   3392
#define XCD_BAR_WORDS 3456
#define XB_SPIN_CAP (1u << 18)

__device__ __forceinline__ unsigned xb_ld(unsigned* p)              { return __hip_atomic_load(p, __ATOMIC_RELAXED, __HIP_MEMORY_SCOPE_AGENT); }
__device__ __forceinline__ unsigned xb_add(unsigned* p, unsigned v) { return __hip_atomic_fetch_add(p, v, __ATOMIC_RELAXED, __HIP_MEMORY_SCOPE_AGENT); }
__device__ __forceinline__ unsigned xb_xcc_id() { return (unsigned)__builtin_amdgcn_s_getreg((3 << 11) | 20) & 0xFu; }
#define XB_SPIN(cond, bar) do { unsigned _sp = 0; while (cond) { __builtin_amdgcn_s_sleep(1); \
    if ((++_sp & 255u) == 0u) { if (xb_ld(&(bar)[XB_TMO])) break; if (_sp > XB_SPIN_CAP) { atomicAdd(&(bar)[XB_TMO], 1u); break; } } } } while (0)

struct XcdBarrier { unsigned* bar; unsigned x; volatile LAS unsigned* st; };

__device__ __forceinline__ XcdBarrier xcd_barrier_post(unsigned* bar, volatile LAS unsigned* st) {
    XcdBarrier b; b.bar = bar; b.x = xb_xcc_id(); b.st = st;
    if (threadIdx.x == 0) (void)xb_add(&bar[XB_XCNT(b.x)], 1u);
    return b;
}
__device__ __forceinline__ void xcd_barrier_complete(unsigned* bar, unsigned x, unsigned& nloc, unsigned& nx) {
    const unsigned G = gridDim.x * gridDim.y * gridDim.z;
    unsigned sum, cnt, mine, sp = 0u;
    for (;;) {
        sum = 0u; cnt = 0u; mine = 0u;
#pragma unroll
        for (unsigned j = 0; j < 16; ++j) { const unsigned c = xb_ld(&bar[XB_XCNT(j)]); sum += c; cnt += (c > 0u) ? 1u : 0u; mine = (j == x) ? c : mine; }
        if (sum == G) break;
        __builtin_amdgcn_s_sleep(1);
        if ((++sp & 255u) == 0u) { if (xb_ld(&bar[XB_TMO])) break; if (sp > XB_SPIN_CAP) { atomicAdd(&bar[XB_TMO], 1u); break; } }
    }
    nloc = mine > 0u ? mine : 1u; nx = cnt > 0u ? cnt : 1u;
}
__device__ __forceinline__ void xcd_barrier(const XcdBarrier& b) {
    asm volatile("s_waitcnt vmcnt(0)" ::: "memory");
    __syncthreads();
    if (threadIdx.x == 0) {
        unsigned* bar = b.bar;
        __builtin_amdgcn_s_waitcnt(0);
        unsigned nloc = b.st[0], nx = b.st[1];
        if (nloc == 0u) { xcd_barrier_complete(bar, b.x, nloc, nx); b.st[0] = nloc; b.st[1] = nx; }
        const unsigned old = xb_add(&bar[XB_XSUB(b.x)], 1u);
        const unsigned gen = old / nloc;
        if (old + 1u == (gen + 1u) * nloc) {
            __builtin_amdgcn_fence(__ATOMIC_RELEASE, "agent");
            asm volatile("s_waitcnt vmcnt(0)" ::: "memory");
            const unsigned og = xb_add(&bar[XB_TOP], 1u);
            const unsigned tg = og / nx;
            if (og + 1u == (tg + 1u) * nx) xb_add(&bar[XB_TOPGEN], 1u);
            else XB_SPIN(xb_ld(&bar[XB_TOPGEN]) == tg, bar);
            __builtin_amdgcn_fence(__ATOMIC_ACQUIRE, "agent");
            xb_add(&bar[XB_XGEN(b.x)], 1u);
            asm volatile("s_waitcnt vmcnt(0)" ::: "memory");
        } else {
            XB_SPIN(xb_ld(&bar[XB_XGEN(b.x)]) == gen, bar);
            __builtin_amdgcn_fence(__ATOMIC_ACQUIRE, "agent");
            asm volatile("s_waitcnt vmcnt(0)" ::: "memory");
        }
    }
    __syncthreads();
}


namespace pg8 {
constexpr int BM = 256, BK = 64, HALF = 128, HTB = HALF * BK * 2, STAGE_BYTES = 8 * HTB, NXCD = 8, WGM = 8;
__host__ __device__ __forceinline__ int lds_byte(int r, int c) { const int st = (r >> 4) * 2 + (c >> 5), rr = r & 15, cc = c & 31, ob = rr * 64 + cc * 2; return st * 1024 + (ob ^ (((ob >> 9) & 1) << 5)); }
__host__ __device__ __forceinline__ void stage_rc(int b, int& R, int& C) { const int st = b / 1024, sb = b % 1024, swz = sb ^ (((sb >> 9) & 1) << 5); R = (st >> 1) * 16 + swz / 64; C = (st & 1) * 32 + (swz % 64) / 2; }
struct Unit { int pm, pn, ko, nt, keep; };
struct Gemm { const h16* A; const h16* Bt; int lda, ldb, K; };
struct StaticOrder {
    int nM, nN, nwg, G, c;
    __host__ __device__ void init(int M, int N, int G_, int c_) { nM = M / BM; nN = N / BM; nwg = nM * nN; G = G_; c = c_; }
    __host__ __device__ bool next(int i, Unit& u) const {
        const long L = (long)i * G + c; if (L >= nwg) return false;
        int wgid = (int)L; { const int q = nwg / NXCD, r = nwg % NXCD, xcd = wgid % NXCD, off = wgid / NXCD; wgid = (xcd < r ? xcd * (q + 1) : r * (q + 1) + (xcd - r) * q) + off; }
        const int nig = WGM * nN, gid = wgid / nig, fm = gid * WGM, gsz = (nM - fm) < WGM ? (nM - fm) : WGM;
        u.pm = fm + ((wgid % nig) % gsz); u.pn = (wgid % nig) / gsz; u.ko = 0; u.nt = 0; u.keep = 0; return true;
    }
};
template <class Epi, class Sched, bool ALIGN_EPI = true>
__device__ __forceinline__ void gemm_phase(LAS unsigned char* lds, const Gemm g, const Sched& S, const Epi& E) {
    const int tid = threadIdx.x, wid = __builtin_amdgcn_readfirstlane(tid >> 6), lane = tid & 63, wr = wid >> 2, wc = wid & 3, fr = lane & 15, fq = lane >> 4;
    const int nt0 = g.K / BK;
    unsigned voffA[2], voffB[2];
#pragma unroll
    for (int i = 0; i < 2; ++i) { int R, C; stage_rc(tid * 16 + i * 8192, R, C); voffA[i] = (unsigned)(R * g.lda + C) * 2u; voffB[i] = (unsigned)(R * g.ldb + C) * 2u; }
    const size_t kstep = (size_t)(BK * 2);
    const size_t hstepA = (size_t)HALF * g.lda * 2, hstepB = (size_t)HALF * g.ldb * 2;
    const size_t tstepA = 2 * hstepA, tstepB = 2 * hstepB;
    const unsigned ldsw = (unsigned)wid * 1024u;
    const int aoff = lds_byte(wr * 64 + fr, fq * 8), boff = lds_byte(wc * 32 + fr, fq * 8);
#define PG8_SA(b, h) (((b) * 2 + (h)) * HTB)
#define PG8_SB(b, h) ((4 + (b) * 2 + (h)) * HTB)
#define PG8_STAGE(bufoff, gbase, voff) do { _Pragma("unroll") for (int _i = 0; _i < 2; ++_i) \
        __builtin_amdgcn_global_load_lds((const unsigned*)((const char*)(gbase) + (voff)[_i]), (LAS unsigned*)(lds + (bufoff) + ldsw + _i * 8192), 16, 0, 0); } while (0)
#define PG8_LDA(dst, b, h) do { _Pragma("unroll") for (int m = 0; m < 4; ++m) _Pragma("unroll") for (int k = 0; k < 2; ++k) dst[m][k] = *(const LAS h16x8*)(lds + PG8_SA(b, h) + aoff + m * 2048 + k * 1024); } while (0)
#define PG8_LDB(dst, b, h) do { _Pragma("unroll") for (int n = 0; n < 2; ++n) _Pragma("unroll") for (int k = 0; k < 2; ++k) dst[n][k] = *(const LAS h16x8*)(lds + PG8_SB(b, h) + boff + n * 2048 + k * 1024); } while (0)
#define PG8_MMA(ai, bj, At, Bt) do { __builtin_amdgcn_s_setprio(1); _Pragma("unroll") for (int m = 0; m < 4; ++m) _Pragma("unroll") for (int n = 0; n < 2; ++n) _Pragma("unroll") for (int k = 0; k < 2; ++k) \
        acc[ai][bj][m][n] = __builtin_amdgcn_mfma_f32_16x16x32_f16(Bt[n][k], At[m][k], acc[ai][bj][m][n], 0, 0, 0); __builtin_amdgcn_s_setprio(0); } while (0)
#define PG8_WAIT_V(n) asm volatile("s_waitcnt vmcnt(" #n ")" ::: "memory")
#define PG8_WAIT_L(n) asm volatile("s_waitcnt lgkmcnt(" #n ")" ::: "memory")
#define PG8_BAR __builtin_amdgcn_s_barrier()
#define PG8_SCHED __builtin_amdgcn_sched_barrier(0)
    Unit cur, nxt; int ui = 0;
    if (!S.next(0, cur)) return;
    f32x4 acc[2][2][4][2];
#pragma unroll
    for (int a = 0; a < 2; ++a)
#pragma unroll
        for (int b = 0; b < 2; ++b)
#pragma unroll
            for (int m = 0; m < 4; ++m)
#pragma unroll
                for (int n = 0; n < 2; ++n) acc[a][b][m][n] = (f32x4){0.f, 0.f, 0.f, 0.f};
    h16x8 At[4][2], B0[2][2], B1[2][2];
    const char* cA = (const char*)g.A + (size_t)cur.pm * tstepA + (size_t)cur.ko * 2; const char* cB = (const char*)g.Bt + (size_t)cur.pn * tstepB + (size_t)cur.ko * 2;
    {
        PG8_STAGE(PG8_SB(0, 0), cB, voffB); PG8_STAGE(PG8_SB(0, 1), cB + hstepB, voffB); PG8_STAGE(PG8_SA(0, 0), cA, voffA); PG8_STAGE(PG8_SA(0, 1), cA + hstepA, voffA);
        if (wr == 1) PG8_BAR;
        PG8_WAIT_V(2); PG8_BAR;
        PG8_STAGE(PG8_SB(1, 0), cB + kstep, voffB); PG8_STAGE(PG8_SA(1, 0), cA + kstep, voffA); PG8_STAGE(PG8_SB(1, 1), cB + hstepB + kstep, voffB);
        PG8_WAIT_V(6); PG8_BAR;
    }
    for (;;) {
        const bool has_next = S.next(ui + 1, nxt);
        const char* nA = has_next ? (const char*)g.A + (size_t)nxt.pm * tstepA + (size_t)nxt.ko * 2 : cA; const char* nB = has_next ? (const char*)g.Bt + (size_t)nxt.pn * tstepB + (size_t)nxt.ko * 2 : cB;
        int nt = cur.nt ? cur.nt : nt0; asm volatile("" : "+s"(nt));
        for (int t = 0; t < nt; t += 2) {
            const bool last = (t == nt - 2);
            const char* a1 = cA + (size_t)(t + 1) * kstep;
            const char* a2 = last ? nA : cA + (size_t)(t + 2) * kstep; const char* b2 = last ? nB : cB + (size_t)(t + 2) * kstep;
            const char* a3 = a2 + kstep; const char* b3 = b2 + kstep;
            PG8_LDB(B0, 0, 0); PG8_LDB(B1, 0, 1); PG8_SCHED; PG8_LDA(At, 0, 0); PG8_STAGE(PG8_SA(1, 1), a1 + hstepA, voffA);
            PG8_WAIT_V(8); PG8_WAIT_L(0); PG8_BAR; PG8_MMA(0, 0, At, B0); PG8_MMA(0, 1, At, B1); PG8_BAR; PG8_SCHED;
            PG8_LDA(At, 0, 1); PG8_STAGE(PG8_SB(0, 0), b2, voffB); PG8_STAGE(PG8_SB(0, 1), b2 + hstepB, voffB); PG8_STAGE(PG8_SA(0, 0), a2, voffA);
            PG8_WAIT_V(8); PG8_WAIT_L(0); PG8_BAR; PG8_MMA(1, 0, At, B0); PG8_MMA(1, 1, At, B1); PG8_BAR; PG8_SCHED;
            PG8_LDB(B0, 1, 0); PG8_LDB(B1, 1, 1); PG8_SCHED; PG8_LDA(At, 1, 0); PG8_STAGE(PG8_SA(0, 1), a2 + hstepA, voffA);
            PG8_WAIT_V(8); PG8_WAIT_L(0); PG8_BAR; PG8_MMA(0, 0, At, B0); PG8_MMA(0, 1, At, B1); PG8_BAR; PG8_SCHED;
            PG8_LDA(At, 1, 1); PG8_STAGE(PG8_SB(1, 0), b3, voffB); PG8_STAGE(PG8_SB(1, 1), b3 + hstepB, voffB); PG8_STAGE(PG8_SA(1, 0), a3, voffA);
            PG8_WAIT_V(8); PG8_WAIT_L(0); PG8_BAR; PG8_MMA(1, 0, At, B0); PG8_MMA(1, 1, At, B1); PG8_BAR; PG8_SCHED;
        }
        if constexpr (ALIGN_EPI) { if (wr == 0) PG8_BAR; }
        E(acc, cur, wr, wc, fr, fq);
        if (!has_next) break;
        if (!cur.keep) {
#pragma unroll
        for (int a = 0; a < 2; ++a)
#pragma unroll
            for (int b = 0; b < 2; ++b)
#pragma unroll
                for (int m = 0; m < 4; ++m)
#pragma unroll
                    for (int n = 0; n < 2; ++n) acc[a][b][m][n] = (f32x4){0.f, 0.f, 0.f, 0.f};
        }
        cur = nxt; cA = nA; cB = nB; ++ui;
        if constexpr (ALIGN_EPI) { if (wr == 1) PG8_BAR; }
    }
    PG8_WAIT_V(0);
    if constexpr (!ALIGN_EPI) { if (wr == 0) PG8_BAR; }
    PG8_BAR;
#undef PG8_SA
#undef PG8_SB
#undef PG8_STAGE
#undef PG8_LDA
#undef PG8_LDB
#undef PG8_MMA
#undef PG8_WAIT_V
#undef PG8_WAIT_L
#undef PG8_BAR
#undef PG8_SCHED
}
}

struct Frame {
    LAS unsigned char* lds;
    int tid, lane, wave, vcu, G;
    const float *x, *c, *ctx, *c_ctx, *w_mod, *b_mod, *norm_attn, *norm_ffn, *w_in, *ret_decay, *diff_lambda, *diff_subln,
                *w_ret_o, *w_diff_o, *w_out, *w_router, *router_bias, *w_exp_gu, *w_exp_down, *w_sh_gu, *w_sh_down, *final_norm;
    float* out;
    unsigned char* ws;
};

__device__ __forceinline__ float wave_sum(float v) {
#pragma unroll
    for (int o = 1; o < 64; o <<= 1) v += __shfl_xor(v, o);
    return v;
}
__device__ __forceinline__ unsigned pk2h(float lo, float hi) { f32x2 v = {lo, hi}; h16x2 h = __builtin_convertvector(v, h16x2); return __builtin_bit_cast(unsigned, h); }
__device__ __forceinline__ float silu_f(float v) { return v / (1.0f + __expf(-v)); }
__device__ __forceinline__ float sigmoid_f(float v) { return 1.0f / (1.0f + __expf(-v)); }

__device__ __forceinline__ void p0_mod_unit(Frame& F, int unit) {
    const int cb = unit % 24, ks = unit / 24;
    LAS float* sv = (LAS float*)F.lds;
    LAS float* red = sv + 768;
    for (int i = F.tid; i < 768; i += NTHR) { const int v = i >> 8, k = i & 255; const float cv = (v < 2) ? F.c[v * DM + ks * 256 + k] : F.c_ctx[ks * 256 + k]; sv[i] = silu_f(cv); }
    __syncthreads();
    const int cl = F.tid & 127, rl = F.tid >> 7;
    const float* wp = F.w_mod + (size_t)(ks * 256 + rl) * (6 * DM) + cb * 512 + cl * 4;
    f32x4 a0 = {0.f, 0.f, 0.f, 0.f}, a1 = a0, a2 = a0;
#pragma unroll 8
    for (int i = 0; i < 64; ++i) { const f32x4 w = *(const f32x4*)(wp + (size_t)i * 4 * (6 * DM)); const int k = rl + 4 * i; a0 += w * sv[k]; a1 += w * sv[256 + k]; a2 += w * sv[512 + k]; }
    *(LAS f32x4*)(red + (rl * 3 + 0) * 512 + cl * 4) = a0; *(LAS f32x4*)(red + (rl * 3 + 1) * 512 + cl * 4) = a1; *(LAS f32x4*)(red + (rl * 3 + 2) * 512 + cl * 4) = a2;
    __syncthreads();
    float* modp = (float*)(F.ws + WS_MODP);
    for (int i = F.tid; i < 1536; i += NTHR) { const int v = i >> 9, cc = i & 511; const float s = (red[(0 * 3 + v) * 512 + cc] + red[(1 * 3 + v) * 512 + cc]) + (red[(2 * 3 + v) * 512 + cc] + red[(3 * 3 + v) * 512 + cc]);
        modp[(size_t)(ks * 3 + v) * (6 * DM) + cb * 512 + cc] = s; }
    __syncthreads();
}
template <int MAP>
__device__ __forceinline__ void p0_transpose_item(const float* W, int K, int N, h16* WT, LAS float* scr, int item, int lane, int ldd = 0) {
    if (ldd == 0) ldd = K;
    const int nblk = N / 32, kb = item / nblk, nb = item % nblk, k0 = 64 * kb, n0 = 32 * nb;
#pragma unroll 8
    for (int i = 0; i < 32; ++i) { const int kk = 2 * i + (lane >> 5); scr[kk * 33 + (lane & 31)] = W[(size_t)(k0 + kk) * N + n0 + (lane & 31)]; }
    asm volatile("s_waitcnt lgkmcnt(0)" ::: "memory");
    const int cch = lane & 7;
#pragma unroll
    for (int j = 0; j < 4; ++j) { const int n = (lane >> 3) + 8 * j; const LAS float* s = scr + (8 * cch) * 33 + n;
        u32x4 o; o.x = pk2h(s[0 * 33], s[1 * 33]); o.y = pk2h(s[2 * 33], s[3 * 33]); o.z = pk2h(s[4 * 33], s[5 * 33]); o.w = pk2h(s[6 * 33], s[7 * 33]);
        int nn = n0 + n;
        if (MAP == 1) { const bool isrope = (nn < 1024) || (nn >= C_RQ && nn < C_RQ + 1024); if (isrope) nn = (nn & ~48) | ((nn & 16) << 1) | ((nn & 32) >> 1); }
        if (MAP == 2) { const int j = nn & 255, isu = nn >> 8; nn = 32 * (j >> 4) + 16 * isu + (j & 15); }
        *(u32x4*)(WT + (size_t)nn * ldd + k0 + 8 * cch) = o; }
    asm volatile("s_waitcnt lgkmcnt(0)" ::: "memory");
}
__device__ __forceinline__ void p0a_mod(Frame& F) {
    for (int u = F.vcu; u < 192; u += F.G) p0_mod_unit(F, u);
}
__device__ __forceinline__ void p0b_weights(Frame& F) {
    __syncthreads();
    LAS float* scr = (LAS float*)(F.lds + F.wave * 16384);
    const int gw = F.vcu * NWAVES + F.wave, NGW = F.G * NWAVES;
    constexpr int I_IN = (DM / 64) * (IN_COLS / 32), I_RET = (2048 / 64) * (DM / 32), I_DIF = (1024 / 64) * (DM / 32), I_OUT = (DM / 64) * (DM / 32), I_SGU = (DM / 64) * (512 / 32), I_SDN = (256 / 64) * (DM / 32);
    constexpr int NITEMS = I_IN + I_RET + I_DIF + I_OUT + I_SGU + I_SDN;
    for (int it = gw; it < NITEMS; it += NGW) {
        int r = it;
        if (r < I_IN) { p0_transpose_item<1>(F.w_in, DM, IN_COLS, (h16*)(F.ws + WS_WINT), scr, r, F.lane); continue; } r -= I_IN;
        if (r < I_RET) { p0_transpose_item<0>(F.w_ret_o, 2048, DM, (h16*)(F.ws + WS_WCAT), scr, r, F.lane, 3072); continue; } r -= I_RET;
        if (r < I_DIF) { p0_transpose_item<0>(F.w_diff_o, 1024, DM, (h16*)(F.ws + WS_WCAT) + 2048, scr, r, F.lane, 3072); continue; } r -= I_DIF;
        if (r < I_OUT) { p0_transpose_item<0>(F.w_out, DM, DM, (h16*)(F.ws + WS_WOUT), scr, r, F.lane); continue; } r -= I_OUT;
        if (r < I_SGU) { p0_transpose_item<2>(F.w_sh_gu, DM, 512, (h16*)(F.ws + WS_WSGU), scr, r, F.lane); continue; } r -= I_SGU;
        p0_transpose_item<0>(F.w_sh_down, 256, DM, (h16*)(F.ws + WS_WSDN), scr, r, F.lane);
    }
    {
        const int i = blockIdx.x * NTHR + F.tid;
        for (int q = i; q < NEXP * DM / 4; q += F.G * NTHR) {
            const int e = q / (DM / 4), k = (q % (DM / 4)) * 4;
            const f32x4 w = *(const f32x4*)(F.w_router + (size_t)e * DM + k);
            h16 hi[4], lo[4];
#pragma unroll
            for (int j = 0; j < 4; ++j) { hi[j] = (h16)w[j]; lo[j] = (h16)(w[j] - (float)hi[j]); }
            h16* dst = (h16*)(F.ws + WS_WRTR) + (size_t)e * 6144 + k;
            *(h16x4*)(dst) = (h16x4){hi[0], hi[1], hi[2], hi[3]}; *(h16x4*)(dst + 2048) = (h16x4){hi[0], hi[1], hi[2], hi[3]}; *(h16x4*)(dst + 4096) = (h16x4){lo[0], lo[1], lo[2], lo[3]};
        }
    }
    if (blockIdx.x == 0) {
        float* rope = (float*)(F.ws + WS_ROPE);
        for (int i = F.tid; i < 64 * 32; i += NTHR) { const int pos = i >> 5, j = i & 31; const float inv = exp2f(-(float)j * (13.287712379549449f / 32.0f)); const float ang = (float)pos * inv; rope[i] = cosf(ang); rope[2048 + i] = sinf(ang); }
        for (int i = F.tid; i < 64 * 16; i += NTHR) { const int pos = i >> 4, j = i & 15; const float inv = exp2f(-(float)j * (13.287712379549449f / 16.0f)); const float ang = (float)pos * inv; rope[4096 + i] = cosf(ang); rope[4096 + 1024 + i] = sinf(ang); }
    }
}

__device__ __forceinline__ void p1_norm1(Frame& F) {
    LAS float* msh = (LAS float*)F.lds; LAS float* msc = msh + 3 * DM;
    const float* modp = (const float*)(F.ws + WS_MODP);
    for (int i = F.tid; i < 3 * 2 * DM; i += NTHR) { const int v = i / (2 * DM), cc = i % (2 * DM); float s = F.b_mod[cc];
#pragma unroll
        for (int ks = 0; ks < 8; ++ks) s += modp[(size_t)(ks * 3 + v) * (6 * DM) + cc];
        if (cc < DM) msh[v * DM + cc] = s; else msc[v * DM + cc - DM] = s; }
    __syncthreads();
    const int gw = F.vcu * NWAVES + F.wave, NGW = F.G * NWAVES;
    h16* H = (h16*)(F.ws + WS_H);
    for (int r = gw; r < MALL; r += NGW) {
        const float* src = (r < MLAT) ? F.x + (size_t)r * DM : F.ctx + (size_t)(r - MLAT) * DM; const int v = (r < MLAT) ? (r / SEQ) : 2;
        f32x4 xv[8]; float ss = 0.f;
#pragma unroll
        for (int j = 0; j < 8; ++j) { xv[j] = *(const f32x4*)(src + 4 * F.lane + 256 * j); ss += (xv[j].x * xv[j].x + xv[j].y * xv[j].y) + (xv[j].z * xv[j].z + xv[j].w * xv[j].w); }
        const float rstd = 1.0f / sqrtf(wave_sum(ss) * (1.0f / DM) + EPS);
#pragma unroll
        for (int j = 0; j < 8; ++j) { const int cc = 4 * F.lane + 256 * j; const f32x4 nw = *(const f32x4*)(F.norm_attn + cc);
            const f32x4 sc = *(LAS f32x4*)(msc + v * DM + cc), sh = *(LAS f32x4*)(msh + v * DM + cc);
            const f32x4 y = xv[j] * rstd * nw * (sc + 1.0f) + sh;
            u32x2 o; o.x = pk2h(y.x, y.y); o.y = pk2h(y.z, y.w); *(u32x2*)(H + (size_t)r * DM + cc) = o; }
    }
    float* MOD = (float*)(F.ws + WS_MOD);
    for (int i = blockIdx.x * NTHR + F.tid; i < 3 * 6 * DM; i += F.G * NTHR) { const int v = i / (6 * DM), cc = i % (6 * DM); float s = F.b_mod[cc];
#pragma unroll
        for (int ks = 0; ks < 8; ++ks) s += modp[(size_t)(ks * 3 + v) * (6 * DM) + cc];
        MOD[i] = s; }
}


__device__ __forceinline__ int crow(int r, int hi) { return (r & 3) + 8 * (r >> 2) + 4 * hi; }
__device__ __forceinline__ h16x8 frag_row(const LAS unsigned char* base, int strideB, int r0, int k0, int lane) {
    return *(const LAS h16x8*)(base + (r0 + (lane & 31)) * strideB + (k0 + 8 * (lane >> 5)) * 2);
}
__device__ __forceinline__ v4i16_t tr16(const LAS unsigned char* p) { return __builtin_amdgcn_ds_read_tr16_b64_v4i16((LAS v4i16_t*)p); }
__device__ __forceinline__ h16x8 frag_tr(const LAS unsigned char* base, int strideB, int k0, int n0, int lane) {
    const int kb = k0 + 8 * (lane >> 5) + ((lane & 15) >> 2), nc = n0 + 16 * ((lane >> 4) & 1) + 4 * (lane & 3);
    const LAS unsigned char* p = base + kb * strideB + nc * 2;
    const v4i16_t lo = tr16(p), hi = tr16(p + 4 * strideB);
    typedef short s16x8 __attribute__((ext_vector_type(8)));
    const s16x8 v = {lo[0], lo[1], lo[2], lo[3], hi[0], hi[1], hi[2], hi[3]};
    return __builtin_bit_cast(h16x8, v);
}
__device__ __forceinline__ h16x8 frag_tr_perm(const LAS unsigned char* base, int strideB, int k0, int n0, int lane) {
    const int kb = k0 + 4 * (lane >> 5) + ((lane & 15) >> 2), nc = n0 + 16 * ((lane >> 4) & 1) + 4 * (lane & 3);
    const LAS unsigned char* p = base + kb * strideB + nc * 2;
    const v4i16_t lo = tr16(p), hi = tr16(p + 8 * strideB);
    typedef short s16x8 __attribute__((ext_vector_type(8)));
    const s16x8 v = {lo[0], lo[1], lo[2], lo[3], hi[0], hi[1], hi[2], hi[3]};
    return __builtin_bit_cast(h16x8, v);
}
__device__ __forceinline__ h16x8 pack8(float a0, float a1, float a2, float a3, float a4, float a5, float a6, float a7) {
    u32x4 w; w.x = pk2h(a0, a1); w.y = pk2h(a2, a3); w.z = pk2h(a4, a5); w.w = pk2h(a6, a7); return __builtin_bit_cast(h16x8, w);
}
#define MFMA32(a, b, c) __builtin_amdgcn_mfma_f32_32x32x16_f16((a), (b), (c), 0, 0, 0)

struct SchedG1 {
    pg8::StaticOrder so; int G, c;
    __device__ __forceinline__ bool next(int i, pg8::Unit& u) const {
        const int L = i * G + c;
        if (L < 32 * 52) return so.next(i, u);
        const int r = L - 32 * 52; if (r >= 40) return false;
        u.pm = 32 + r / 20; u.pn = r % 20; u.ko = 0; u.nt = 0; u.keep = 0; return true;
    }
};
struct EpiP {
    h16* P; const float* rope;
    __device__ __forceinline__ void operator()(f32x4 (&acc)[2][2][4][2], const pg8::Unit& u, int wr, int wc, int fr, int fq) const {
        const int colt = u.pn * 256; const bool lat = u.pm < 32;
        int kind;
        if (colt < C_RV) kind = 1; else if (colt < C_DK) kind = 0; else if (colt < C_DV) kind = 3; else if (colt < C_RQ) kind = 0; else if (colt < C_RG) kind = 2; else if (colt < C_DQ) kind = 5; else if (colt < C_GR) kind = 4; else kind = 6;
        if (!lat) kind = (kind == 1) ? 7 : 0;
#pragma unroll
        for (int ai = 0; ai < 2; ++ai)
#pragma unroll
            for (int m = 0; m < 4; ++m) {
                const int row = u.pm * 256 + ai * 128 + wr * 64 + m * 16 + fr; const int t = row & (SEQ - 1);
                h16* prow = P + (size_t)row * IN_COLS;
#pragma unroll
                for (int bj = 0; bj < 2; ++bj) {
                    const int cbase = colt + bj * 128 + wc * 32;
                    const f32x4 x0 = acc[ai][bj][m][0], x1 = acc[ai][bj][m][1];
                    f32x4 o0, o1; int c0, c1;
                    if (kind == 1 || kind == 2) {
                        const int g5 = (cbase >> 5) & 1, axis = (cbase >> 6) & 1, pos = axis ? (t & 63) : (t >> 6), j0 = 16 * g5 + 4 * fq;
                        const f32x4 cs = *(const f32x4*)(rope + pos * 32 + j0), sn = *(const f32x4*)(rope + 2048 + pos * 32 + j0);
                        o0 = x0 * cs - x1 * sn; o1 = x0 * sn + x1 * cs;
                        if (kind == 2) { o0 *= 0.08838834764831845f; o1 *= 0.08838834764831845f; }
                        c0 = (cbase & ~63) + j0; c1 = c0 + 32;
                    } else if (kind == 7) {
                        const int g5 = (cbase >> 5) & 1; c0 = (cbase & ~63) + 16 * g5 + 4 * fq; c1 = c0 + 32; o0 = x0; o1 = x1;
                    } else if (kind == 3 || kind == 4) {
                        const int axis = (cbase >> 5) & 1, pos = axis ? (t & 63) : (t >> 6), j0 = 4 * fq;
                        const f32x4 cs = *(const f32x4*)(rope + 4096 + pos * 16 + j0), sn = *(const f32x4*)(rope + 5120 + pos * 16 + j0);
                        o0 = x0 * cs - x1 * sn; o1 = x0 * sn + x1 * cs;
                        if (kind == 4) { o0 *= 0.18033688011112042f; o1 *= 0.18033688011112042f; }
                        c0 = cbase + j0; c1 = c0 + 16;
                    } else {
                        c0 = cbase + 4 * fq; c1 = c0 + 16; o0 = x0; o1 = x1;
                        if (kind == 5) {
#pragma unroll
                            for (int e = 0; e < 4; ++e) { o0[e] = silu_f(x0[e]); o1[e] = silu_f(x1[e]); }
                        } else if (kind == 6) {
#pragma unroll
                            for (int e = 0; e < 4; ++e) { o0[e] = sigmoid_f(x0[e]); o1[e] = sigmoid_f(x1[e]); }
                        }
                    }
                    u32x2 w0, w1; w0.x = pk2h(o0[0], o0[1]); w0.y = pk2h(o0[2], o0[3]); w1.x = pk2h(o1[0], o1[1]); w1.y = pk2h(o1[2], o1[3]);
                    *(u32x2*)(prow + c0) = w0; *(u32x2*)(prow + c1) = w1;
                }
            }
    }
};
__device__ __forceinline__ void p2_gemm1(Frame& F) {
    pg8::Gemm g{(const h16*)(F.ws + WS_H), (const h16*)(F.ws + WS_WINT), DM, DM, DM};
    SchedG1 S; S.so.init(MLAT, IN_COLS, F.G, (int)blockIdx.x); S.G = F.G; S.c = (int)blockIdx.x;
    EpiP E{(h16*)(F.ws + WS_P), (const float*)(F.ws + WS_ROPE)};
    pg8::gemm_phase<EpiP, SchedG1>(F.lds, g, S, E);
}

__device__ __forceinline__ void p3_ret_local(Frame& F) {
    LAS unsigned char* KF = F.lds; LAS unsigned char* KB = F.lds + 40960; LAS unsigned char* VH = F.lds + 81920;
    const h16* P = (const h16*)(F.ws + WS_P); h16* LST = (h16*)(F.ws + WS_LST);
    const int hi = F.lane >> 5;
    for (int u = F.vcu; u < 16 * 34; u += F.G) {
        const int bh = u / 34, cc = u % 34, b = bh >> 3, h = bh & 7;
        const int row0 = (cc < 2) ? (MLAT + b * CTXL + cc * 128) : (b * SEQ + (cc - 2) * 128);
        const float lgf = -__expf(F.ret_decay[h]), lgb = -__expf(F.ret_decay[8 + h]);
#pragma unroll
        for (int i = 0; i < 4; ++i) { const int q = F.tid + NTHR * i, row = q >> 4, ch = q & 15;
            const h16x8 kv = *(const h16x8*)(P + (size_t)(row0 + row) * IN_COLS + C_RK + h * 128 + ch * 8);
            const float sf = __expf(lgf * (float)(127 - row)), sb = __expf(lgb * (float)row);
            *(LAS h16x8*)(KF + row * 320 + ch * 16) = pack8((float)kv[0] * sf, (float)kv[1] * sf, (float)kv[2] * sf, (float)kv[3] * sf, (float)kv[4] * sf, (float)kv[5] * sf, (float)kv[6] * sf, (float)kv[7] * sf);
            *(LAS h16x8*)(KB + row * 320 + ch * 16) = pack8((float)kv[0] * sb, (float)kv[1] * sb, (float)kv[2] * sb, (float)kv[3] * sb, (float)kv[4] * sb, (float)kv[5] * sb, (float)kv[6] * sb, (float)kv[7] * sb); }
        for (int eh = 0; eh < 2; ++eh) {
            if (eh) __syncthreads();
#pragma unroll
            for (int i = 0; i < 4; ++i) { const int q = F.tid + NTHR * i, row = q >> 4, ch = q & 15;
                *(LAS h16x8*)(VH + row * 320 + ch * 16) = *(const h16x8*)(P + (size_t)(row0 + row) * IN_COLS + C_RV + h * 256 + eh * 128 + ch * 8); }
            __syncthreads();
            const int dir = F.wave >> 2, eb = F.wave & 3; const LAS unsigned char* Kd = dir ? KB : KF;
            f32x16 acc[4];
#pragma unroll
            for (int db = 0; db < 4; ++db) acc[db] = (f32x16){};
#pragma unroll
            for (int ks = 0; ks < 8; ++ks) { const h16x8 a = frag_tr(VH, 320, 16 * ks, 32 * eb, F.lane);
#pragma unroll
                for (int db = 0; db < 4; ++db) { const h16x8 bb = frag_tr(Kd, 320, 16 * ks, 32 * db, F.lane); acc[db] = MFMA32(a, bb, acc[db]); } }
            h16* dst = LST + ((size_t)((dir * 16 + bh) * 34 + cc) * 256 + eh * 128 + eb * 32) * 128;
#pragma unroll
            for (int db = 0; db < 4; ++db)
#pragma unroll
                for (int r = 0; r < 16; ++r) dst[crow(r, hi) * 128 + db * 32 + (F.lane & 31)] = (h16)acc[db][r];
        }
        __syncthreads();
    }
}
__device__ __forceinline__ void p4_ret_scan(Frame& F) {
    const h16* LST = (const h16*)(F.ws + WS_LST); h16* SST = (h16*)(F.ws + WS_SST);
    for (int g = blockIdx.x * NTHR + F.tid; g < 2 * 16 * 4096; g += F.G * NTHR) {
        const int seq = g >> 12, off = (g & 4095) * 8, dir = seq >> 4, bh = seq & 15, h = bh & 7;
        const float cd = __expf(-__expf(F.ret_decay[dir * 8 + h]) * 128.0f);
        const h16* Lp = LST + (size_t)seq * 34 * 32768 + off; h16* Sp = SST + (size_t)seq * 32 * 32768 + off;
        float s[8];
#pragma unroll
        for (int e = 0; e < 8; ++e) s[e] = 0.f;
        if (dir == 0) {
            for (int cc = 0; cc < 33; ++cc) {
                if (cc >= 2) *(h16x8*)(Sp + (size_t)(cc - 2) * 32768) = pack8(s[0], s[1], s[2], s[3], s[4], s[5], s[6], s[7]);
                const h16x8 l = *(const h16x8*)(Lp + (size_t)cc * 32768);
#pragma unroll
                for (int e = 0; e < 8; ++e) s[e] = s[e] * cd + (float)l[e];
            }
            *(h16x8*)(Sp + (size_t)31 * 32768) = pack8(s[0], s[1], s[2], s[3], s[4], s[5], s[6], s[7]);
        } else {
            { const h16x8 l1 = *(const h16x8*)(Lp + (size_t)1 * 32768), l0 = *(const h16x8*)(Lp);
#pragma unroll
              for (int e = 0; e < 8; ++e) s[e] = (float)l1[e] * cd + (float)l0[e]; }
            for (int c = 31; c >= 0; --c) {
                *(h16x8*)(Sp + (size_t)c * 32768) = pack8(s[0], s[1], s[2], s[3], s[4], s[5], s[6], s[7]);
                const h16x8 l = *(const h16x8*)(Lp + (size_t)(c + 2) * 32768);
#pragma unroll
                for (int e = 0; e < 8; ++e) s[e] = s[e] * cd + (float)l[e];
            }
        }
    }
}
__device__ __forceinline__ void p5_ret_out(Frame& F) {
    LAS unsigned char* QL = F.lds; LAS unsigned char* KL = F.lds + 34816; LAS unsigned char* VL = F.lds;
    LAS float* RED = (LAS float*)(F.lds + 98304);
    const h16* P = (const h16*)(F.ws + WS_P); const h16* SST = (const h16*)(F.ws + WS_SST); h16* ARET = (h16*)(F.ws + WS_ACAT);
    const int hi = F.lane >> 5, ln = F.lane & 31;
    for (int u = F.vcu; u < 512; u += F.G) {
        const int bh = u >> 5, c = u & 31, b = bh >> 3, h = bh & 7, row0 = b * SEQ + c * 128;
        const float lgf = -__expf(F.ret_decay[h]), lgb = -__expf(F.ret_decay[8 + h]);
#pragma unroll
        for (int i = 0; i < 4; ++i) { const int q = F.tid + NTHR * i, row = q >> 4, ch = q & 15; const h16* pr = P + (size_t)(row0 + row) * IN_COLS + h * 128 + ch * 8;
            *(LAS h16x8*)(QL + row * 272 + ch * 16) = *(const h16x8*)(pr + C_RQ); *(LAS h16x8*)(KL + row * 272 + ch * 16) = *(const h16x8*)(pr + C_RK); }
        __syncthreads();
        const int ib = F.wave & 3, ehalf = F.wave >> 2, i0 = 32 * ib, il = i0 + ln;
        h16x8 qf[8];
#pragma unroll
        for (int ks = 0; ks < 8; ++ks) qf[ks] = frag_row(QL, 272, i0, 16 * ks, F.lane);
        h16x8 pb[4][2];
#pragma unroll
        for (int jt = 0; jt < 4; ++jt) { f32x16 s = (f32x16){};
#pragma unroll
            for (int ks = 0; ks < 8; ++ks) s = MFMA32(frag_row(KL, 272, 32 * jt, 16 * ks, F.lane), qf[ks], s);
#pragma unroll
            for (int r = 0; r < 16; ++r) { const int d = il - (32 * jt + crow(r, hi)); s[r] *= (d >= 0) ? __expf(lgf * (float)d) : __expf(lgb * (float)(-d)); }
            pb[jt][0] = pack8(s[0], s[1], s[2], s[3], s[4], s[5], s[6], s[7]); pb[jt][1] = pack8(s[8], s[9], s[10], s[11], s[12], s[13], s[14], s[15]); }
        __syncthreads();
#pragma unroll
        for (int i = 0; i < 8; ++i) { const int q = F.tid + NTHR * i, row = q >> 5, c32 = q & 31, eh = c32 >> 4, ch = c32 & 15;
            *(LAS h16x8*)(VL + eh * 40960 + row * 320 + ch * 16) = *(const h16x8*)(P + (size_t)(row0 + row) * IN_COLS + C_RV + h * 256 + c32 * 8); }
        __syncthreads();
        f32x16 o[4];
#pragma unroll
        for (int et = 0; et < 4; ++et) o[et] = (f32x16){};
        const LAS unsigned char* Vh = VL + ehalf * 40960;
#pragma unroll
        for (int jt = 0; jt < 4; ++jt)
#pragma unroll
            for (int s2 = 0; s2 < 2; ++s2)
#pragma unroll
                for (int et = 0; et < 4; ++et) o[et] = MFMA32(frag_tr_perm(Vh, 320, 32 * jt + 16 * s2, 32 * et, F.lane), pb[jt][s2], o[et]);
#pragma unroll
        for (int dir = 0; dir < 2; ++dir) {
            const h16 sc = (h16)(dir ? __expf(lgb * (float)(128 - il)) : __expf(lgf * (float)(il + 1)));
            const h16* Sg = SST + ((size_t)((dir * 16 + bh) * 32 + c) * 256 + ehalf * 128) * 128;
#pragma unroll
            for (int ks = 0; ks < 8; ++ks) { const h16x8 qs = qf[ks] * sc;
#pragma unroll
                for (int et = 0; et < 4; ++et) { const h16x8 a = *(const h16x8*)(Sg + (size_t)(32 * et + ln) * 128 + 16 * ks + 8 * hi); o[et] = MFMA32(a, qs, o[et]); } }
        }
        float ss = 0.f;
#pragma unroll
        for (int et = 0; et < 4; ++et)
#pragma unroll
            for (int r = 0; r < 16; ++r) ss += o[et][r] * o[et][r];
        ss += __shfl_xor(ss, 32);
        if (hi == 0) RED[F.wave * 32 + ln] = ss;
        __syncthreads();
        const float rstd = 1.0f / sqrtf((RED[F.wave * 32 + ln] + RED[(F.wave ^ 4) * 32 + ln]) * (1.0f / 256.0f) + EPS);
        const size_t grow = (size_t)(row0 + il);
#pragma unroll
        for (int et = 0; et < 4; ++et)
#pragma unroll
            for (int r4 = 0; r4 < 4; ++r4) { const int e = ehalf * 128 + 32 * et + 8 * r4 + 4 * hi;
                const h16x4 gt = *(const h16x4*)(P + grow * IN_COLS + C_RG + h * 256 + e);
                u32x2 w; w.x = pk2h(o[et][4 * r4] * rstd * (float)gt[0], o[et][4 * r4 + 1] * rstd * (float)gt[1]); w.y = pk2h(o[et][4 * r4 + 2] * rstd * (float)gt[2], o[et][4 * r4 + 3] * rstd * (float)gt[3]);
                *(u32x2*)(ARET + grow * 3072 + h * 256 + e) = w; }
        __syncthreads();
    }
}
__device__ __forceinline__ void p6_attn(Frame& F) {
    const h16* P = (const h16*)(F.ws + WS_P); h16* ADIF = (h16*)(F.ws + WS_ACAT) + 2048;
    const int hi = F.lane >> 5, ln = F.lane & 31;
    float lam;
    { const float s1 = wave_sum(F.diff_lambda[F.lane] * F.diff_lambda[64 + F.lane]), s2 = wave_sum(F.diff_lambda[128 + F.lane] * F.diff_lambda[192 + F.lane]); lam = __expf(s1) - __expf(s2) + 0.2f; }
    constexpr int KT0 = 0, VT0 = 34816, KTB = 17408, VTB = 20480;
    LAS float* XB = (LAS float*)F.lds;
    for (int u = F.vcu; u < 512; u += F.G) {
        const int bh = u >> 5, qb = u & 31, b = bh >> 3, h = bh & 7;
        const int cm = F.wave & 1, qs = F.wave >> 1, qrow0 = b * SEQ + qb * 128 + qs * 32;
        h16x8 qf[4];
#pragma unroll
        for (int ks = 0; ks < 4; ++ks) qf[ks] = *(const h16x8*)(P + (size_t)(qrow0 + ln) * IN_COLS + C_DQ + h * 128 + cm * 64 + 16 * ks + 8 * hi);
        f32x16 o[4];
#pragma unroll
        for (int et = 0; et < 4; ++et) o[et] = (f32x16){};
        float mrun = -1e30f, lsum = 0.f;
        h16x8 kreg[2], vreg[2];
#define ATT_LOAD(t) do { _Pragma("unroll") for (int i = 0; i < 2; ++i) { const int q = F.tid + NTHR * i, row = q >> 4, ch = q & 15; const int j = (t) * 64 + row; \
            const size_t srow = (j < CTXL) ? (size_t)(MLAT + b * CTXL + j) : (size_t)(b * SEQ + j - CTXL); const h16* pr = P + srow * IN_COLS + h * 128 + ch * 8; \
            kreg[i] = *(const h16x8*)(pr + C_DK); vreg[i] = *(const h16x8*)(pr + C_DV); } } while (0)
#define ATT_WRITE(buf) do { _Pragma("unroll") for (int i = 0; i < 2; ++i) { const int q = F.tid + NTHR * i, row = q >> 4, ch = q & 15; \
            *(LAS h16x8*)(F.lds + KT0 + (buf) * KTB + row * 272 + ch * 16) = kreg[i]; *(LAS h16x8*)(F.lds + VT0 + (buf) * VTB + row * 320 + ch * 16) = vreg[i]; } } while (0)
        ATT_LOAD(0); ATT_WRITE(0);
        __syncthreads();
        constexpr int NT = (CTXL + SEQ) / 64;
        for (int t = 0; t < NT; ++t) {
            const int buf = t & 1;
            if (t + 1 < NT) ATT_LOAD(t + 1);
            const LAS unsigned char* Kt = F.lds + KT0 + buf * KTB; const LAS unsigned char* Vt = F.lds + VT0 + buf * VTB;
            f32x16 s[2];
#pragma unroll
            for (int kt = 0; kt < 2; ++kt) { s[kt] = (f32x16){};
#pragma unroll
                for (int ks = 0; ks < 4; ++ks) s[kt] = MFMA32(frag_row(Kt, 272, 32 * kt, cm * 64 + 16 * ks, F.lane), qf[ks], s[kt]); }
            float mx = s[0][0];
#pragma unroll
            for (int r = 0; r < 16; ++r) { mx = fmaxf(mx, s[0][r]); mx = fmaxf(mx, s[1][r]); }
            mx = fmaxf(mx, __shfl_xor(mx, 32));
            if (__any(mx > mrun + 8.0f)) { const float mn = fmaxf(mrun, mx), alpha = __builtin_amdgcn_exp2f(mrun - mn); mrun = mn; lsum *= alpha;
#pragma unroll
                for (int et = 0; et < 4; ++et) o[et] *= alpha; }
            float ps = 0.f;
#pragma unroll
            for (int kt = 0; kt < 2; ++kt)
#pragma unroll
                for (int r = 0; r < 16; ++r) { s[kt][r] = __builtin_amdgcn_exp2f(s[kt][r] - mrun); ps += s[kt][r]; }
            lsum += ps;
#pragma unroll
            for (int kt = 0; kt < 2; ++kt)
#pragma unroll
                for (int s2 = 0; s2 < 2; ++s2) {
                    const h16x8 pbf = pack8(s[kt][8 * s2], s[kt][8 * s2 + 1], s[kt][8 * s2 + 2], s[kt][8 * s2 + 3], s[kt][8 * s2 + 4], s[kt][8 * s2 + 5], s[kt][8 * s2 + 6], s[kt][8 * s2 + 7]);
#pragma unroll
                    for (int et = 0; et < 4; ++et) o[et] = MFMA32(frag_tr_perm(Vt, 320, 32 * kt + 16 * s2, 32 * et, F.lane), pbf, o[et]);
                }
            if (t + 1 < NT) ATT_WRITE(buf ^ 1);
            __syncthreads();
        }
#undef ATT_LOAD
#undef ATT_WRITE
        lsum += __shfl_xor(lsum, 32);
        const float inv = 1.0f / lsum;
        if (cm == 1) {
#pragma unroll
            for (int et = 0; et < 4; ++et)
#pragma unroll
                for (int r = 0; r < 16; ++r) XB[(qs * 128 + 32 * et + crow(r, hi)) * 32 + ln] = o[et][r] * inv;
        }
        __syncthreads();
        if (cm == 0) {
            float ss = 0.f;
#pragma unroll
            for (int et = 0; et < 4; ++et)
#pragma unroll
                for (int r = 0; r < 16; ++r) { const float v = o[et][r] * inv - lam * XB[(qs * 128 + 32 * et + crow(r, hi)) * 32 + ln]; o[et][r] = v; ss += v * v; }
            ss += __shfl_xor(ss, 32);
            const float rstd = 0.8f / sqrtf(ss * (1.0f / 128.0f) + EPS);
            const size_t grow = (size_t)(qrow0 + ln);
#pragma unroll
            for (int et = 0; et < 4; ++et)
#pragma unroll
                for (int r4 = 0; r4 < 4; ++r4) { const int e = 32 * et + 8 * r4 + 4 * hi; const f32x4 sw = *(const f32x4*)(F.diff_subln + e);
                    u32x2 w; w.x = pk2h(o[et][4 * r4] * rstd * sw[0], o[et][4 * r4 + 1] * rstd * sw[1]); w.y = pk2h(o[et][4 * r4 + 2] * rstd * sw[2], o[et][4 * r4 + 3] * rstd * sw[3]);
                    *(u32x2*)(ADIF + grow * 3072 + h * 128 + e) = w; }
        }
        __syncthreads();
    }
}
struct SchedG2 {
    pg8::StaticOrder so;
    __device__ __forceinline__ bool next(int i, pg8::Unit& u) const { if (!so.next(i >> 1, u)) return false; if (i & 1) { u.ko = 2048; u.nt = 16; u.keep = 0; } else { u.ko = 0; u.nt = 32; u.keep = 1; } return true; }
};
struct EpiU2 {
    h16* U; const h16* P;
    __device__ __forceinline__ void operator()(f32x4 (&acc)[2][2][4][2], const pg8::Unit& u, int wr, int wc, int fr, int fq) const {
#pragma unroll
        for (int ai = 0; ai < 2; ++ai)
#pragma unroll
            for (int m = 0; m < 4; ++m) { const int row = u.pm * 256 + ai * 128 + wr * 64 + m * 16 + fr;
#pragma unroll
                for (int bj = 0; bj < 2; ++bj)
#pragma unroll
                    for (int n = 0; n < 2; ++n) { const int col = u.pn * 256 + bj * 128 + wc * 32 + 16 * n + 4 * fq;
                        const h16x4 gd = *(const h16x4*)(P + (size_t)row * IN_COLS + C_GD + col);
                        if (u.keep) { const h16x4 gr = *(const h16x4*)(P + (size_t)row * IN_COLS + C_GR + col);
#pragma unroll
                            for (int e = 0; e < 4; ++e) acc[ai][bj][m][n][e] *= (float)gr[e] / (float)gd[e];
                        } else { const f32x4 a = acc[ai][bj][m][n];
                            u32x2 w; w.x = pk2h(a[0] * (float)gd[0], a[1] * (float)gd[1]); w.y = pk2h(a[2] * (float)gd[2], a[3] * (float)gd[3]);
                            *(u32x2*)(U + (size_t)row * DM + col) = w; } } }
    }
};
struct EpiX1 {
    float* X1; const float* x; const float* MOD;
    __device__ __forceinline__ void operator()(f32x4 (&acc)[2][2][4][2], const pg8::Unit& u, int wr, int wc, int fr, int fq) const {
        const int b = (u.pm * 256) / SEQ;
#pragma unroll
        for (int ai = 0; ai < 2; ++ai)
#pragma unroll
            for (int m = 0; m < 4; ++m) { const int row = u.pm * 256 + ai * 128 + wr * 64 + m * 16 + fr;
#pragma unroll
                for (int bj = 0; bj < 2; ++bj)
#pragma unroll
                    for (int n = 0; n < 2; ++n) { const int col = u.pn * 256 + bj * 128 + wc * 32 + 16 * n + 4 * fq;
                        const f32x4 g1 = *(const f32x4*)(MOD + (size_t)b * (6 * DM) + 2 * DM + col); const f32x4 xv = *(const f32x4*)(x + (size_t)row * DM + col);
                        *(f32x4*)(X1 + (size_t)row * DM + col) = xv + g1 * acc[ai][bj][m][n]; } }
    }
};
__device__ __forceinline__ void p7_gemm2(Frame& F) {
    pg8::Gemm g{(const h16*)(F.ws + WS_ACAT), (const h16*)(F.ws + WS_WCAT), 3072, 3072, 2048};
    SchedG2 S; S.so.init(MLAT, DM, F.G, (int)blockIdx.x);
    EpiU2 E{(h16*)(F.ws + WS_U), (const h16*)(F.ws + WS_P)};
    pg8::gemm_phase<EpiU2, SchedG2>(F.lds, g, S, E);
}
__device__ __forceinline__ void p9_gemm3(Frame& F) {
    pg8::Gemm g{(const h16*)(F.ws + WS_U), (const h16*)(F.ws + WS_WOUT), 2048, 2048, 2048};
    pg8::StaticOrder S; S.init(MLAT, DM, F.G, (int)blockIdx.x);
    EpiX1 E{(float*)(F.ws + WS_X1), F.x, (const float*)(F.ws + WS_MOD)};
    pg8::gemm_phase<EpiX1, pg8::StaticOrder>(F.lds, g, S, E);
}


__device__ __forceinline__ void p10_norm2(Frame& F) {
    const float* X1 = (const float*)(F.ws + WS_X1); const float* MOD = (const float*)(F.ws + WS_MOD); h16* H2X = (h16*)(F.ws + WS_H2X);
    const int gw = F.vcu * NWAVES + F.wave, NGW = F.G * NWAVES;
    for (int r = gw; r < MLAT; r += NGW) {
        const float* src = X1 + (size_t)r * DM; const int b = r / SEQ;
        f32x4 xv[8]; float ss = 0.f;
#pragma unroll
        for (int j = 0; j < 8; ++j) { xv[j] = *(const f32x4*)(src + 4 * F.lane + 256 * j); ss += (xv[j].x * xv[j].x + xv[j].y * xv[j].y) + (xv[j].z * xv[j].z + xv[j].w * xv[j].w); }
        const float rstd = 1.0f / sqrtf(wave_sum(ss) * (1.0f / DM) + EPS);
#pragma unroll
        for (int j = 0; j < 8; ++j) { const int cc = 4 * F.lane + 256 * j; const f32x4 nw = *(const f32x4*)(F.norm_ffn + cc);
            const f32x4 sh = *(const f32x4*)(MOD + (size_t)b * (6 * DM) + 3 * DM + cc), sc = *(const f32x4*)(MOD + (size_t)b * (6 * DM) + 4 * DM + cc);
            const f32x4 y = xv[j] * rstd * nw * (sc + 1.0f) + sh;
            h16 hh[4], ll[4];
#pragma unroll
            for (int e = 0; e < 4; ++e) { hh[e] = (h16)y[e]; ll[e] = (h16)(y[e] - (float)hh[e]); }
            h16* dst = H2X + (size_t)r * 6144 + cc;
            *(h16x4*)(dst) = (h16x4){hh[0], hh[1], hh[2], hh[3]}; *(h16x4*)(dst + 4096) = (h16x4){hh[0], hh[1], hh[2], hh[3]}; *(h16x4*)(dst + 2048) = (h16x4){ll[0], ll[1], ll[2], ll[3]};
            { int p8 = __builtin_amdgcn_cvt_pk_fp8_f32(y[0], y[1], 0, false); p8 = __builtin_amdgcn_cvt_pk_fp8_f32(y[2], y[3], p8, true); *(int*)((unsigned char*)(F.ws + WS_H2F8) + (size_t)r * DM + cc) = p8; } }
    }
}
struct SchedRT {
    int G, c;
    __device__ __forceinline__ bool next(int i, pg8::Unit& u) const { const int L = i * G + c; if (L >= 256) return false; u.pm = L >> 3; u.pn = 0; u.ko = (L & 7) * 768; u.nt = 0; u.keep = 0; return true; }
};
struct EpiLG {
    float* LGP;
    __device__ __forceinline__ void operator()(f32x4 (&acc)[2][2][4][2], const pg8::Unit& u, int wr, int wc, int fr, int fq) const {
        float* dst = LGP + (size_t)(u.ko / 768) * MLAT * NEXP;
#pragma unroll
        for (int ai = 0; ai < 2; ++ai)
#pragma unroll
            for (int m = 0; m < 4; ++m) { const int row = u.pm * 256 + ai * 128 + wr * 64 + m * 16 + fr;
#pragma unroll
                for (int bj = 0; bj < 2; ++bj)
#pragma unroll
                    for (int n = 0; n < 2; ++n) { const int col = bj * 128 + wc * 32 + 16 * n + 4 * fq; *(f32x4*)(dst + (size_t)row * NEXP + col) = acc[ai][bj][m][n]; } }
    }
};
__device__ __forceinline__ void p11_router(Frame& F) {
    pg8::Gemm g{(const h16*)(F.ws + WS_H2X), (const h16*)(F.ws + WS_WRTR), 6144, 6144, 768};
    SchedRT S; S.G = F.G; S.c = (int)blockIdx.x;
    EpiLG E{(float*)(F.ws + WS_LGP)};
    pg8::gemm_phase<EpiLG, SchedRT>(F.lds, g, S, E);
}
__device__ __forceinline__ void p12_topk(Frame& F) {
    const float* LGP = (const float*)(F.ws + WS_LGP); int* EIDX = (int*)(F.ws + WS_EIDX); float* EW = (float*)(F.ws + WS_EW); u32x2* LIST = (u32x2*)(F.ws + WS_LIST2);
    unsigned* CNT = (unsigned*)(F.ws + WS_CTL) + CW_CNT;
    const int gw = F.vcu * NWAVES + F.wave, NGW = F.G * NWAVES, lane = F.lane;
    const f32x4 bias = *(const f32x4*)(F.router_bias + 4 * lane);
    for (int t = gw; t < MLAT; t += NGW) {
        f32x4 lg = *(const f32x4*)(LGP + (size_t)t * NEXP + 4 * lane);
#pragma unroll
        for (int ks = 1; ks < 8; ++ks) lg += *(const f32x4*)(LGP + ((size_t)ks * MLAT + t) * NEXP + 4 * lane);
        float sc[4], sel[4];
#pragma unroll
        for (int i = 0; i < 4; ++i) { sc[i] = 1.0f / (1.0f + __expf(-lg[i])); sel[i] = sc[i] + bias[i]; }
        float a1 = fmaxf(sel[0], sel[1]), a2 = fminf(sel[0], sel[1]);
        { const float b1 = fmaxf(sel[2], sel[3]), b2 = fminf(sel[2], sel[3]); const float n1 = fmaxf(a1, b1), n2 = fmaxf(fminf(a1, b1), fmaxf(a2, b2)); a1 = n1; a2 = n2; }
#pragma unroll
        for (int off = 1; off < 8; off <<= 1) { const float b1 = __shfl_xor(a1, off), b2 = __shfl_xor(a2, off); const float n1 = fmaxf(a1, b1), n2 = fmaxf(fminf(a1, b1), fmaxf(a2, b2)); a1 = n1; a2 = n2; }
        const float gs = a1 + a2; const int g = lane >> 3;
        int rank = 0;
#pragma unroll
        for (int j = 0; j < 8; ++j) { const float o = __shfl(gs, 8 * j); rank += (o > gs || (o == gs && j < g)) ? 1 : 0; }
        const bool gsel = rank < 4;
        float ms[4];
#pragma unroll
        for (int i = 0; i < 4; ++i) ms[i] = gsel ? sel[i] : -INFINITY;
        float myw = 0.f; int mye = 0; float wsum = 0.f;
#pragma unroll
        for (int k = 0; k < TOPK; ++k) {
            float bv = ms[0]; int bi = 4 * lane;
#pragma unroll
            for (int i = 1; i < 4; ++i) if (ms[i] > bv) { bv = ms[i]; bi = 4 * lane + i; }
#pragma unroll
            for (int off = 1; off < 64; off <<= 1) { const float ov = __shfl_xor(bv, off); const int oi = __shfl_xor(bi, off); if (ov > bv || (ov == bv && oi < bi)) { bv = ov; bi = oi; } }
            const int ol = bi >> 2, oi = bi & 3;
            const float mysc = (oi == 0) ? sc[0] : (oi == 1) ? sc[1] : (oi == 2) ? sc[2] : sc[3];
            const float w = __shfl(mysc, ol);
            if (lane == ol) {
#pragma unroll
                for (int i = 0; i < 4; ++i) if (i == oi) ms[i] = -INFINITY; }
            wsum += w;
            if (lane == k) { myw = w; mye = bi; }
        }
        if (lane < TOPK) {
            const float wn = myw / wsum * 2.5f;
            EIDX[t * TOPK + lane] = mye; EW[t * TOPK + lane] = wn;
            const unsigned pos = atomicAdd(&CNT[mye], 1u);
            LIST[mye * MLAT + pos] = (u32x2){(unsigned)(t * TOPK + lane), __float_as_uint(wn)};
        }
    }
}
constexpr int EX_NSTG = 3, EX_ASTG = 24576, EX_WSTG = 16384, EX_A0 = 0, EX_W0 = EX_NSTG * EX_ASTG, EX_WH0 = EX_W0 + EX_NSTG * EX_WSTG, EX_WHS = 10240, EX_ROW0 = EX_WH0 + 2 * EX_WHS;
constexpr int EX_TAB0 = EX_ROW0 + 3200, EX_SCR0 = EX_TAB0 + 3072;
static_assert(EX_ROW0 == 143360 && EX_SCR0 + 8192 <= LDSCTL_OFF, "expert LDS map");
template <bool GU>
__device__ __forceinline__ void ring_w_prologue(Frame& F, const float* W, int cgrp) {
    constexpr int LDB = GU ? 512 : 2048;
    const int lane = F.lane, w = F.wave, v = 4 * (lane & 31);
    const int wcol0 = GU ? (((v >> 5) & 1) * 256 + 32 * (v >> 6) + (v & 31) + 64 * cgrp) : (v + 512 * cgrp);
    const float* wlane = W + (size_t)(4 * w + (lane >> 5)) * LDB + wcol0;
#pragma unroll
    for (int s = 0; s < 3; ++s)
#pragma unroll
        for (int j = 0; j < 2; ++j) __builtin_amdgcn_global_load_lds((const unsigned*)(wlane + (size_t)(s * 32 + 2 * j) * LDB), (LAS unsigned*)(F.lds + EX_W0 + s * EX_WSTG + (2 * w + j) * 1024), 16, 0, 2);
}
template <bool GU, int NLAY>
__device__ __forceinline__ void expert_ring(Frame& F, const float* W, const h16* Abase, const int (&arow)[3], int nr, int cgrp, h16* ACTrow0, h16* Y) {
    constexpr int KT = GU ? 64 : 8, NP = GU ? 1 : 4, LDB = GU ? 512 : 2048, NS = KT * NP;
    const int tid = F.tid, lane = F.lane, hi = lane >> 5, ln = lane & 31, cp = F.wave & 1, rg = F.wave >> 1, w = F.wave;
    const LAS int* RSLOT = (const LAS int*)(F.lds + EX_ROW0); const LAS float* RW = (const LAS float*)(F.lds + EX_ROW0 + 1536);
    const int ngrp = (nr + 15) >> 4;
    const int nA = (w < ngrp ? 1 : 0) + (w + 8 < ngrp ? 1 : 0) + (w + 16 < ngrp ? 1 : 0);
    const int achunk = ((lane & 3) ^ ((lane >> 4) & 3)) * 8;
    const int v = 4 * (lane & 31);
    const int wcol0 = GU ? (((v >> 5) & 1) * 256 + 32 * (v >> 6) + (v & 31) + 64 * cgrp) : (v + 512 * cgrp);
    const float* wlane = W + (size_t)(4 * w + (lane >> 5)) * LDB + wcol0;
    const unsigned lds0 = (unsigned)(uintptr_t)F.lds;
    const int xs = (ln >> 2) & 3;
    const unsigned aofs0 = (unsigned)((2 * rg + (ln >> 4)) * 1024 + (ln & 15) * 64 + ((hi ^ xs) * 16)), aofs1 = (unsigned)((2 * rg + (ln >> 4)) * 1024 + (ln & 15) * 64 + (((2 + hi) ^ xs) * 16));
    const unsigned tofs = (unsigned)((8 * hi + ((lane & 15) >> 2)) * 320 + (64 * cp + 16 * ((lane >> 4) & 1) + 4 * (lane & 3)) * 2);
    f32x16 acc[2 * NLAY];
#pragma unroll
    for (int i = 0; i < 2 * NLAY; ++i) acc[i] = (f32x16){};
#define EX_DMA_A(s) do { const int kt_ = (s) % KT, stg_ = (s) % EX_NSTG; \
        _Pragma("unroll") for (int j = 0; j < 3; ++j) if (j < nA) __builtin_amdgcn_global_load_lds((const unsigned*)(Abase + arow[j] + kt_ * 32 + achunk), (LAS unsigned*)(F.lds + EX_A0 + stg_ * EX_ASTG + (w + 8 * j) * 1024), 16, 0, 0); } while (0)
#define EX_DMA_W(s) do { const int pass_ = (s) / KT, kt_ = (s) % KT, stg_ = (s) % EX_NSTG; \
        _Pragma("unroll") for (int j = 0; j < 2; ++j) __builtin_amdgcn_global_load_lds((const unsigned*)(wlane + (size_t)(kt_ * 32 + 2 * j) * LDB + 128 * pass_), (LAS unsigned*)(F.lds + EX_W0 + stg_ * EX_WSTG + (2 * w + j) * 1024), 16, 0, 2); } while (0)
#define EX_WAITV(k) asm volatile("s_waitcnt vmcnt(" #k ")" ::: "memory")
#define EX_WAITN() do { if (nA == 3) EX_WAITV(5); else if (nA == 2) EX_WAITV(4); else if (nA == 1) EX_WAITV(3); else EX_WAITV(2); } while (0)
    const unsigned cvsrc = lds0 + EX_W0 + (tid >> 4) * 512 + (tid & 15) * 32, cvdst = lds0 + EX_WH0 + (tid >> 4) * 320 + (tid & 15) * 16;
    EX_DMA_A(0); EX_DMA_A(1);
    if (nA == 3) EX_WAITV(3); else if (nA == 2) EX_WAITV(2); else if (nA == 1) EX_WAITV(1); else EX_WAITV(0);
    __builtin_amdgcn_s_barrier(); asm volatile("" ::: "memory");
    { f32x4 c0, c1; asm volatile("ds_read_b128 %0, %2\n\tds_read_b128 %1, %2 offset:16\n\ts_waitcnt lgkmcnt(0)" : "=&v"(c0), "=&v"(c1) : "v"(cvsrc) : "memory");
      const h16x8 hv = pack8(c0[0], c0[1], c0[2], c0[3], c1[0], c1[1], c1[2], c1[3]); asm volatile("ds_write_b128 %0, %1" :: "v"(cvdst), "v"(hv) : "memory"); }
    typedef short s16x8 __attribute__((ext_vector_type(8)));
    for (int s = 0; s < NS; ++s) {
        if (s + 2 < NS) EX_WAITN(); else EX_WAITV(0);
        asm volatile("s_waitcnt lgkmcnt(0)" ::: "memory");
        __builtin_amdgcn_s_barrier();
        asm volatile("" ::: "memory");
        const bool pend = ((s % KT) == KT - 1);
        if (!pend) { if (s + 2 < NS) EX_DMA_A(s + 2); if (s + 3 < NS) EX_DMA_W(s + 3); }
        const unsigned abase = lds0 + EX_A0 + (s % EX_NSTG) * EX_ASTG, wbase = lds0 + EX_WH0 + (s & 1) * EX_WHS + tofs;
        const unsigned cs = cvsrc + ((s + 1) % EX_NSTG) * EX_WSTG;
        const unsigned pa0 = abase + aofs0, pa1 = abase + aofs1;
        if constexpr (NLAY < 3) {
            v4i16_t t0, t1, t2, t3, t4, t5, t6, t7; h16x8 a0[NLAY], a1[NLAY];
            asm volatile("ds_read_b64_tr_b16 %0, %8\n\tds_read_b64_tr_b16 %1, %8 offset:1280\n\tds_read_b64_tr_b16 %2, %8 offset:64\n\tds_read_b64_tr_b16 %3, %8 offset:1344\n\t"
                         "ds_read_b64_tr_b16 %4, %8 offset:5120\n\tds_read_b64_tr_b16 %5, %8 offset:6400\n\tds_read_b64_tr_b16 %6, %8 offset:5184\n\tds_read_b64_tr_b16 %7, %8 offset:6464"
                         : "=&v"(t0), "=&v"(t1), "=&v"(t2), "=&v"(t3), "=&v"(t4), "=&v"(t5), "=&v"(t6), "=&v"(t7) : "v"(wbase) : "memory");
            asm volatile("ds_read_b128 %0, %2\n\tds_read_b128 %1, %3" : "=&v"(a0[0]), "=&v"(a1[0]) : "v"(pa0), "v"(pa1) : "memory");
            if constexpr (NLAY >= 2) asm volatile("ds_read_b128 %0, %2 offset:8192\n\tds_read_b128 %1, %3 offset:8192" : "=&v"(a0[1]), "=&v"(a1[1]) : "v"(pa0), "v"(pa1) : "memory");
            asm volatile("s_waitcnt lgkmcnt(0)" ::: "memory");
            __builtin_amdgcn_sched_barrier(0);
            const h16x8 b00 = __builtin_bit_cast(h16x8, (s16x8){t0[0], t0[1], t0[2], t0[3], t1[0], t1[1], t1[2], t1[3]}), b01 = __builtin_bit_cast(h16x8, (s16x8){t2[0], t2[1], t2[2], t2[3], t3[0], t3[1], t3[2], t3[3]});
            const h16x8 b10 = __builtin_bit_cast(h16x8, (s16x8){t4[0], t4[1], t4[2], t4[3], t5[0], t5[1], t5[2], t5[3]}), b11 = __builtin_bit_cast(h16x8, (s16x8){t6[0], t6[1], t6[2], t6[3], t7[0], t7[1], t7[2], t7[3]});
#pragma unroll
            for (int i = 0; i < NLAY; ++i) { acc[2 * i] = MFMA32(a0[i], b00, acc[2 * i]); acc[2 * i + 1] = MFMA32(a0[i], b01, acc[2 * i + 1]); }
#pragma unroll
            for (int i = 0; i < NLAY; ++i) { acc[2 * i] = MFMA32(a1[i], b10, acc[2 * i]); acc[2 * i + 1] = MFMA32(a1[i], b11, acc[2 * i + 1]); }
        } else {
#pragma unroll
            for (int k16 = 0; k16 < 2; ++k16) {
                v4i16_t t0, t1, t2, t3; h16x8 a[3]; const unsigned pa = k16 ? pa1 : pa0, pw = wbase + k16 * 5120;
                asm volatile("ds_read_b64_tr_b16 %0, %4\n\tds_read_b64_tr_b16 %1, %4 offset:1280\n\tds_read_b64_tr_b16 %2, %4 offset:64\n\tds_read_b64_tr_b16 %3, %4 offset:1344"
                             : "=&v"(t0), "=&v"(t1), "=&v"(t2), "=&v"(t3) : "v"(pw) : "memory");
                asm volatile("ds_read_b128 %0, %3\n\tds_read_b128 %1, %3 offset:8192\n\tds_read_b128 %2, %3 offset:16384\n\ts_waitcnt lgkmcnt(0)" : "=&v"(a[0]), "=&v"(a[1]), "=&v"(a[2]) : "v"(pa) : "memory");
                __builtin_amdgcn_sched_barrier(0);
                const h16x8 b0 = __builtin_bit_cast(h16x8, (s16x8){t0[0], t0[1], t0[2], t0[3], t1[0], t1[1], t1[2], t1[3]}), b1 = __builtin_bit_cast(h16x8, (s16x8){t2[0], t2[1], t2[2], t2[3], t3[0], t3[1], t3[2], t3[3]});
#pragma unroll
                for (int i = 0; i < 3; ++i) { acc[2 * i] = MFMA32(a[i], b0, acc[2 * i]); acc[2 * i + 1] = MFMA32(a[i], b1, acc[2 * i + 1]); }
                __builtin_amdgcn_sched_barrier(0);
            }
        }
        if (s + 1 < NS) {
            f32x4 c0, c1; asm volatile("ds_read_b128 %0, %2\n\tds_read_b128 %1, %2 offset:16\n\ts_waitcnt lgkmcnt(0)" : "=&v"(c0), "=&v"(c1) : "v"(cs) : "memory");
            const h16x8 hv = pack8(c0[0], c0[1], c0[2], c0[3], c1[0], c1[1], c1[2], c1[3]); const unsigned cd = cvdst + ((s + 1) & 1) * EX_WHS; asm volatile("ds_write_b128 %0, %1" :: "v"(cd), "v"(hv) : "memory"); }
        if (pend) {
            const int pass = s / KT;
            int hio = hi, lno = ln; asm volatile("" : "+v"(hio), "+v"(lno));
            if (GU) {
#pragma unroll
                for (int i = 0; i < NLAY; ++i) { const int rt = rg + 4 * i;
#pragma unroll
                    for (int r = 0; r < 16; ++r) { const int row = 32 * rt + crow(r, hio);
                        if (row < nr) ACTrow0[(size_t)row * DEXP + 64 * cgrp + 32 * cp + lno] = (h16)(silu_f(acc[2 * i][r]) * acc[2 * i + 1][r]); }
                    acc[2 * i] = (f32x16){}; acc[2 * i + 1] = (f32x16){}; }
            } else {
                const unsigned scr = lds0 + EX_SCR0 + w * 1024;
#pragma unroll
                for (int i = 0; i < NLAY; ++i) { const int rt = rg + 4 * i;
#pragma unroll
                    for (int g8 = 0; g8 < 4; ++g8) {
#pragma unroll
                        for (int q = 0; q < 4; ++q) { const int lr = 4 * hio + q; const float wt = RW[32 * rt + 8 * g8 + lr];
                            const h16 v0 = (h16)(acc[2 * i][4 * g8 + q] * wt), v1 = (h16)(acc[2 * i + 1][4 * g8 + q] * wt); const unsigned wa = scr + lr * 128 + lno * 2;
                            asm volatile("ds_write_b16 %0, %1\n\tds_write_b16 %0, %2 offset:64" :: "v"(wa), "v"(v0), "v"(v1) : "memory"); }
                        u32x4 pv; const unsigned ra = scr + (lane >> 3) * 128 + (lane & 7) * 16;
                        asm volatile("s_waitcnt lgkmcnt(0)\n\tds_read_b128 %0, %1\n\ts_waitcnt lgkmcnt(0)" : "=&v"(pv) : "v"(ra) : "memory");
                        const int grow = 32 * rt + 8 * g8 + (lane >> 3);
                        if (grow < nr) { const int slot = RSLOT[grow]; *(u32x4*)(Y + (size_t)slot * DM + 512 * cgrp + 128 * pass + 64 * cp + (lane & 7) * 8) = pv; }
                    }
                    acc[2 * i] = (f32x16){}; acc[2 * i + 1] = (f32x16){}; }
            }
            if (s + 2 < NS) EX_DMA_A(s + 2);
            if (s + 3 < NS) EX_DMA_W(s + 3);
        }
    }
    asm volatile("s_waitcnt vmcnt(0) lgkmcnt(0)" ::: "memory");
    __builtin_amdgcn_s_barrier();
    asm volatile("" ::: "memory");
#undef EX_DMA_A
#undef EX_DMA_W
#undef EX_WAITV
#undef EX_WAITN
}

constexpr int G8_NSTG = 4, G8_ASTG = 12288, G8_WSTG = 16384, G8_A0 = 0, G8_W0 = G8_NSTG * G8_ASTG, G8_WH0 = G8_W0 + G8_NSTG * G8_WSTG, G8_WHS = 4096;
static_assert(G8_WH0 + 2 * G8_WHS <= EX_ROW0, "gu8 LDS map");
__device__ __forceinline__ void gu8_w_prologue(Frame& F, const float* W, int cgrp) {
    const int lane = F.lane, w = F.wave, v = 4 * (lane & 31);
    const int wcol0 = ((v >> 5) & 1) * 256 + 32 * (v >> 6) + (v & 31) + 64 * cgrp;
    const float* wlane = W + (size_t)(4 * w + (lane >> 5)) * 512 + wcol0;
#pragma unroll
    for (int s = 0; s < 4; ++s)
#pragma unroll
        for (int j = 0; j < 2; ++j) __builtin_amdgcn_global_load_lds((const unsigned*)(wlane + (size_t)(s * 32 + 2 * j) * 512), (LAS unsigned*)(F.lds + G8_W0 + s * G8_WSTG + (2 * w + j) * 1024), 16, 0, 2);
}
template <int NLAY>
__device__ __forceinline__ void expert_ring_gu8(Frame& F, const float* W, const unsigned char* A8, const int (&arow)[2], int nr, int cgrp, h16* ACTrow0) {
    constexpr int NS = 64;
    typedef long v2i64 __attribute__((ext_vector_type(2)));
    const int tid = F.tid, lane = F.lane, hi = lane >> 5, ln = lane & 31, cp = F.wave & 1, rg = F.wave >> 1, w = F.wave;
    const int ngrp = (nr + 31) >> 5;
    const int nA = (w < ngrp ? 1 : 0) + (w + 8 < ngrp ? 1 : 0);
    const int v = 4 * (lane & 31);
    const int wcol0 = ((v >> 5) & 1) * 256 + 32 * (v >> 6) + (v & 31) + 64 * cgrp;
    const float* wlane = W + (size_t)(4 * w + (lane >> 5)) * 512 + wcol0;
    const unsigned lds0 = (unsigned)(uintptr_t)F.lds;
    const unsigned aofs = (unsigned)(rg * 1024 + ln * 32 + hi * 16);
    const unsigned bofs = (unsigned)((64 * cp + ln) * 32 + hi * 16);
    const unsigned cvsrc = lds0 + G8_W0 + (tid >> 7) * 8 * 512 + (tid & 127) * 4, cvdst = lds0 + G8_WH0 + (tid & 127) * 32 + (tid >> 7) * 8;
    f32x16 acc[2 * NLAY];
#pragma unroll
    for (int i = 0; i < 2 * NLAY; ++i) acc[i] = (f32x16){};
#define G8_DMA_A(s) do { const int stg_ = (s) & 3; \
        _Pragma("unroll") for (int j = 0; j < 2; ++j) if (j < nA) __builtin_amdgcn_global_load_lds((const unsigned*)(A8 + arow[j] + (s) * 32 + (lane & 1) * 16), (LAS unsigned*)(F.lds + G8_A0 + stg_ * G8_ASTG + (w + 8 * j) * 1024), 16, 0, 0); } while (0)
#define G8_DMA_W(s) do { const int stg_ = (s) & 3; \
        _Pragma("unroll") for (int j = 0; j < 2; ++j) __builtin_amdgcn_global_load_lds((const unsigned*)(wlane + (size_t)((s) * 32 + 2 * j) * 512), (LAS unsigned*)(F.lds + G8_W0 + stg_ * G8_WSTG + (2 * w + j) * 1024), 16, 0, 2); } while (0)
#define G8_WAITV(k) asm volatile("s_waitcnt vmcnt(" #k ")" ::: "memory")
#define G8_CVT(s) do { float c_[8]; const unsigned cs_ = cvsrc + ((s) & 3) * G8_WSTG; \
        asm volatile("ds_read_b32 %0, %8\n\tds_read_b32 %1, %8 offset:512\n\tds_read_b32 %2, %8 offset:1024\n\tds_read_b32 %3, %8 offset:1536\n\tds_read_b32 %4, %8 offset:2048\n\tds_read_b32 %5, %8 offset:2560\n\tds_read_b32 %6, %8 offset:3072\n\tds_read_b32 %7, %8 offset:3584\n\ts_waitcnt lgkmcnt(0)" \
                     : "=&v"(c_[0]), "=&v"(c_[1]), "=&v"(c_[2]), "=&v"(c_[3]), "=&v"(c_[4]), "=&v"(c_[5]), "=&v"(c_[6]), "=&v"(c_[7]) : "v"(cs_) : "memory"); \
        int p0_ = __builtin_amdgcn_cvt_pk_fp8_f32(c_[0] * 64.f, c_[1] * 64.f, 0, false); p0_ = __builtin_amdgcn_cvt_pk_fp8_f32(c_[2] * 64.f, c_[3] * 64.f, p0_, true); \
        int p1_ = __builtin_amdgcn_cvt_pk_fp8_f32(c_[4] * 64.f, c_[5] * 64.f, 0, false); p1_ = __builtin_amdgcn_cvt_pk_fp8_f32(c_[6] * 64.f, c_[7] * 64.f, p1_, true); \
        const u32x2 pk_ = {(unsigned)p0_, (unsigned)p1_}; const unsigned cd_ = cvdst + ((s) & 1) * G8_WHS; asm volatile("ds_write_b64 %0, %1" :: "v"(cd_), "v"(pk_) : "memory"); } while (0)
    G8_DMA_A(0); G8_DMA_A(1); G8_DMA_A(2);
    if (nA == 2) G8_WAITV(4); else if (nA == 1) G8_WAITV(2); else G8_WAITV(0);
    __builtin_amdgcn_s_barrier(); asm volatile("" ::: "memory");
    G8_CVT(0);
    for (int s = 0; s < NS; ++s) {
        if (s >= 2 && s + 4 < NS) { if (nA == 2) G8_WAITV(8); else if (nA == 1) G8_WAITV(6); else G8_WAITV(4); }
        else if (s < 2) { if (nA == 2) G8_WAITV(4); else if (nA == 1) G8_WAITV(3); else G8_WAITV(2); }
        else G8_WAITV(0);
        asm volatile("s_waitcnt lgkmcnt(0)" ::: "memory");
        __builtin_amdgcn_s_barrier();
        asm volatile("" ::: "memory");
        if (s + 3 < NS) G8_DMA_A(s + 3);
        if (s + 4 < NS) G8_DMA_W(s + 4);
        const unsigned pa = lds0 + G8_A0 + (s & 3) * G8_ASTG + aofs, pb = lds0 + G8_WH0 + (s & 1) * G8_WHS + bofs;
        v2i64 a[NLAY], b0, b1;
        asm volatile("ds_read_b128 %0, %2\n\tds_read_b128 %1, %2 offset:1024" : "=&v"(b0), "=&v"(b1) : "v"(pb) : "memory");
        asm volatile("ds_read_b128 %0, %1" : "=&v"(a[0]) : "v"(pa) : "memory");
        if constexpr (NLAY >= 2) asm volatile("ds_read_b128 %0, %1 offset:4096" : "=&v"(a[1]) : "v"(pa) : "memory");
        if constexpr (NLAY >= 3) asm volatile("ds_read_b128 %0, %1 offset:8192" : "=&v"(a[2]) : "v"(pa) : "memory");
        asm volatile("s_waitcnt lgkmcnt(0)" ::: "memory");
        __builtin_amdgcn_sched_barrier(0);
#pragma unroll
        for (int i = 0; i < NLAY; ++i) { acc[2 * i] = __builtin_amdgcn_mfma_f32_32x32x16_fp8_fp8(a[i][0], b0[0], acc[2 * i], 0, 0, 0); acc[2 * i + 1] = __builtin_amdgcn_mfma_f32_32x32x16_fp8_fp8(a[i][0], b1[0], acc[2 * i + 1], 0, 0, 0); }
#pragma unroll
        for (int i = 0; i < NLAY; ++i) { acc[2 * i] = __builtin_amdgcn_mfma_f32_32x32x16_fp8_fp8(a[i][1], b0[1], acc[2 * i], 0, 0, 0); acc[2 * i + 1] = __builtin_amdgcn_mfma_f32_32x32x16_fp8_fp8(a[i][1], b1[1], acc[2 * i + 1], 0, 0, 0); }
        if (s + 1 < NS) G8_CVT(s + 1);
    }
    {
        int hio = hi, lno = ln; asm volatile("" : "+v"(hio), "+v"(lno));
#pragma unroll
        for (int i = 0; i < NLAY; ++i) { const int rt = rg + 4 * i;
#pragma unroll
            for (int r = 0; r < 16; ++r) { const int row = 32 * rt + crow(r, hio);
                if (row < nr) ACTrow0[(size_t)row * DEXP + 64 * cgrp + 32 * cp + lno] = (h16)(silu_f(acc[2 * i][r] * 0.015625f) * (acc[2 * i + 1][r] * 0.015625f)); } }
    }
    asm volatile("s_waitcnt vmcnt(0) lgkmcnt(0)" ::: "memory");
    __builtin_amdgcn_s_barrier();
    asm volatile("" ::: "memory");
#undef G8_DMA_A
#undef G8_DMA_W
#undef G8_WAITV
#undef G8_CVT
}
template <bool GU>
__device__ __forceinline__ void p13_expert_phase(Frame& F, int qid) {
    const h16* H2X = (const h16*)(F.ws + WS_H2X); h16* Y = (h16*)(F.ws + WS_Y); h16* ACT = (h16*)(F.ws + WS_ACT);
    const unsigned* CNT = (const unsigned*)(F.ws + WS_CTL) + CW_CNT; unsigned* QH = (unsigned*)(F.ws + WS_CTL) + CW_Q + 64 * qid;
    LAS int* RSLOT = (LAS int*)(F.lds + EX_ROW0); LAS float* RW = (LAS float*)(F.lds + EX_ROW0 + 1536); LAS int* RED = (LAS int*)(F.lds + EX_ROW0 + 3072);
    LAS int* CN = (LAS int*)(F.lds + EX_TAB0); LAS int* ORD = CN + 256; LAS int* OFF = CN + 512;
    __syncthreads();
    if (F.tid < NEXP) CN[F.tid] = (int)CNT[F.tid];
    __syncthreads();
    if (F.tid < NEXP) { const int c = CN[F.tid]; int rank = 0, off = 0;
        for (int j = 0; j < NEXP; ++j) { const int cj = CN[j]; rank += (cj > c || (cj == c && j < F.tid)) ? 1 : 0; off += (j < F.tid) ? cj : 0; }
        ORD[rank] = F.tid; OFF[F.tid] = off; }
    __syncthreads();
    const u32x2* LIST2 = (const u32x2*)(F.ws + WS_LIST2);
    if (F.tid == 0) RED[0] = (int)__hip_atomic_fetch_add(QH, 1u, __ATOMIC_RELAXED, __HIP_MEMORY_SCOPE_AGENT);
    __syncthreads();
    int u = RED[0];
    while (u < NEXP * 4) {
        const int e = ORD[u >> 2], cg = u & 3, cnt = CN[e], off_e = OFF[e];
        const float* Wgu = F.w_exp_gu + (size_t)e * DM * 512; const float* Wdn = F.w_exp_down + (size_t)e * DEXP * DM;
        for (int rs = 0; rs < cnt; rs += 384) {
            const int nr = (cnt - rs) < 384 ? (cnt - rs) : 384;
            __syncthreads();
            if (GU) gu8_w_prologue(F, Wgu, cg); else ring_w_prologue<false>(F, Wdn, cg);
            if (F.tid < 384) { u32x2 ent = {0u, 0u}; if (F.tid < nr) ent = LIST2[e * MLAT + rs + F.tid]; RSLOT[F.tid] = (int)ent.x; RW[F.tid] = __uint_as_float(ent.y); }
            __syncthreads();
            h16* ACTrow0 = ACT + (size_t)(off_e + rs) * DEXP;
            int arow[3];
            if (GU) {
                int ar8[2];
#pragma unroll
                for (int j = 0; j < 2; ++j) { const int r = 32 * (F.wave + 8 * j) + (F.lane >> 1); ar8[j] = (r < 384 ? (RSLOT[r] >> 3) : 0) * DM; }
                const unsigned char* A8 = (const unsigned char*)(F.ws + WS_H2F8);
                if (nr > 256) expert_ring_gu8<3>(F, Wgu, A8, ar8, nr, cg, ACTrow0); else if (nr > 128) expert_ring_gu8<2>(F, Wgu, A8, ar8, nr, cg, ACTrow0); else expert_ring_gu8<1>(F, Wgu, A8, ar8, nr, cg, ACTrow0);
            } else {
#pragma unroll
                for (int j = 0; j < 3; ++j) { const int r = 16 * (F.wave + 8 * j) + (F.lane >> 2); arow[j] = ((r < nr) ? r : 0) * DEXP; }
                if (nr > 256) expert_ring<false, 3>(F, Wdn, ACTrow0, arow, nr, cg, ACTrow0, Y); else if (nr > 128) expert_ring<false, 2>(F, Wdn, ACTrow0, arow, nr, cg, ACTrow0, Y); else expert_ring<false, 1>(F, Wdn, ACTrow0, arow, nr, cg, ACTrow0, Y);
            }
        }
        __syncthreads();
        if (F.tid == 0) RED[0] = (int)__hip_atomic_fetch_add(QH, 1u, __ATOMIC_RELAXED, __HIP_MEMORY_SCOPE_AGENT);
        __syncthreads();
        u = RED[0];
    }
}
struct SchedSG {
    int G, c;
    __device__ __forceinline__ bool next(int i, pg8::Unit& u) const { const int L = i * G + c; if (L >= 256) return false; u.pm = L >> 3; u.pn = (L >> 2) & 1; u.ko = (L & 3) * 512; u.nt = 0; u.keep = 0; return true; }
};
struct EpiSGP {
    float* SGP;
    __device__ __forceinline__ void operator()(f32x4 (&acc)[2][2][4][2], const pg8::Unit& u, int wr, int wc, int fr, int fq) const {
        float* dst = SGP + (size_t)(u.ko / 512) * MLAT * 512;
#pragma unroll
        for (int ai = 0; ai < 2; ++ai)
#pragma unroll
            for (int m = 0; m < 4; ++m) { const int row = u.pm * 256 + ai * 128 + wr * 64 + m * 16 + fr;
#pragma unroll
                for (int bj = 0; bj < 2; ++bj)
#pragma unroll
                    for (int n = 0; n < 2; ++n) { const int col = u.pn * 256 + bj * 128 + wc * 32 + 16 * n + 4 * fq; *(f32x4*)(dst + (size_t)row * 512 + col) = acc[ai][bj][m][n]; } }
    }
};
__device__ __forceinline__ void p11b_shared_gu(Frame& F) {
    pg8::Gemm g{(const h16*)(F.ws + WS_H2X), (const h16*)(F.ws + WS_WSGU), 6144, 2048, 512};
    SchedSG S; S.G = F.G; S.c = (int)blockIdx.x;
    EpiSGP E{(float*)(F.ws + WS_SGP)};
    pg8::gemm_phase<EpiSGP, SchedSG>(F.lds, g, S, E);
}
__device__ __forceinline__ void p12b_shared_act(Frame& F) {
    const float* SGP = (const float*)(F.ws + WS_SGP); h16* ACTS = (h16*)(F.ws + WS_ACTS);
    for (int q = blockIdx.x * NTHR + F.tid; q < MLAT * 64; q += F.G * NTHR) {
        const int row = q >> 6, j = (q & 63) * 4, pg = 32 * (j >> 4) + (j & 15);
        f32x4 gv = {0.f, 0.f, 0.f, 0.f}, uv = gv;
#pragma unroll
        for (int ks = 0; ks < 4; ++ks) { const float* p = SGP + ((size_t)ks * MLAT + row) * 512 + pg; gv += *(const f32x4*)p; uv += *(const f32x4*)(p + 16); }
        u32x2 w; w.x = pk2h(silu_f(gv[0]) * uv[0], silu_f(gv[1]) * uv[1]); w.y = pk2h(silu_f(gv[2]) * uv[2], silu_f(gv[3]) * uv[3]);
        *(u32x2*)(ACTS + (size_t)row * DEXP + j) = w;
    }
}
struct EpiYsh {
    h16* YSH;
    __device__ __forceinline__ void operator()(f32x4 (&acc)[2][2][4][2], const pg8::Unit& u, int wr, int wc, int fr, int fq) const {
#pragma unroll
        for (int ai = 0; ai < 2; ++ai)
#pragma unroll
            for (int m = 0; m < 4; ++m) { const int row = u.pm * 256 + ai * 128 + wr * 64 + m * 16 + fr;
#pragma unroll
                for (int bj = 0; bj < 2; ++bj)
#pragma unroll
                    for (int n = 0; n < 2; ++n) { const int col = u.pn * 256 + bj * 128 + wc * 32 + 16 * n + 4 * fq; const f32x4 a = acc[ai][bj][m][n];
                        u32x2 w; w.x = pk2h(a[0], a[1]); w.y = pk2h(a[2], a[3]); *(u32x2*)(YSH + (size_t)row * DM + col) = w; } }
    }
};
__device__ __forceinline__ void p15_shared_down(Frame& F) {
    pg8::Gemm g{(const h16*)(F.ws + WS_ACTS), (const h16*)(F.ws + WS_WSDN), 256, 256, 256};
    pg8::StaticOrder S; S.init(MLAT, DM, F.G, (int)blockIdx.x);
    EpiYsh E{(h16*)(F.ws + WS_YSH)};
    pg8::gemm_phase<EpiYsh, pg8::StaticOrder>(F.lds, g, S, E);
}
__device__ __forceinline__ void p16_combine(Frame& F) {
    const float* X1 = (const float*)(F.ws + WS_X1); const float* MOD = (const float*)(F.ws + WS_MOD); const h16* Y = (const h16*)(F.ws + WS_Y); const h16* YSH = (const h16*)(F.ws + WS_YSH);
    const int gw = F.vcu * NWAVES + F.wave, NGW = F.G * NWAVES;
    for (int r = gw; r < MLAT; r += NGW) {
        const int b = r / SEQ;
        f32x4 xv[8]; float ss = 0.f;
#pragma unroll
        for (int j = 0; j < 8; ++j) { const int cc = 4 * F.lane + 256 * j;
            f32x4 m = {0.f, 0.f, 0.f, 0.f};
#pragma unroll
            for (int k = 0; k < TOPK; ++k) { const h16x4 yv = *(const h16x4*)(Y + (size_t)(r * TOPK + k) * DM + cc); m += (f32x4){(float)yv[0], (float)yv[1], (float)yv[2], (float)yv[3]}; }
            { const h16x4 yv = *(const h16x4*)(YSH + (size_t)r * DM + cc); m += (f32x4){(float)yv[0], (float)yv[1], (float)yv[2], (float)yv[3]}; }
            const f32x4 g2 = *(const f32x4*)(MOD + (size_t)b * (6 * DM) + 5 * DM + cc);
            xv[j] = *(const f32x4*)(X1 + (size_t)r * DM + cc) + g2 * m;
            ss += (xv[j].x * xv[j].x + xv[j].y * xv[j].y) + (xv[j].z * xv[j].z + xv[j].w * xv[j].w); }
        const float rstd = 1.0f / sqrtf(wave_sum(ss) * (1.0f / DM) + EPS);
#pragma unroll
        for (int j = 0; j < 8; ++j) { const int cc = 4 * F.lane + 256 * j; const f32x4 nw = *(const f32x4*)(F.final_norm + cc);
            *(f32x4*)(F.out + (size_t)r * DM + cc) = xv[j] * rstd * nw; }
    }
}

__device__ __forceinline__ void p_final_plain(Frame& F, const float* xin) {
    const int gw = F.vcu * NWAVES + F.wave, NGW = F.G * NWAVES;
    for (int r = gw; r < MLAT; r += NGW) {
        const float* src = xin + (size_t)r * DM;
        f32x4 xv[8]; float ss = 0.f;
#pragma unroll
        for (int j = 0; j < 8; ++j) { xv[j] = *(const f32x4*)(src + 4 * F.lane + 256 * j); ss += (xv[j].x * xv[j].x + xv[j].y * xv[j].y) + (xv[j].z * xv[j].z + xv[j].w * xv[j].w); }
        const float rstd = 1.0f / sqrtf(wave_sum(ss) * (1.0f / DM) + EPS);
#pragma unroll
        for (int j = 0; j < 8; ++j) { const int cc = 4 * F.lane + 256 * j; const f32x4 nw = *(const f32x4*)(F.final_norm + cc);
            *(f32x4*)(F.out + (size_t)r * DM + cc) = xv[j] * rstd * nw; }
    }
}

constexpr int N_PHASES = 15;
#ifndef DUP_PHASE
#define DUP_PHASE -1
#endif
#ifndef DUP_VAR
#define DUP_VAR 7
#endif
struct Args { const float* in[22]; float* out; unsigned char* ws; int ph_lo, ph_hi; };
__global__ void __launch_bounds__(NTHR, 2) mk_fwd(Args args) {
    extern __shared__ __attribute__((aligned(16))) unsigned char lds_raw[];
    Frame F;
    F.lds = (LAS unsigned char*)lds_raw;
    F.tid = threadIdx.x; F.lane = F.tid & 63; F.wave = __builtin_amdgcn_readfirstlane(F.tid >> 6);
    F.G = gridDim.x; { const int bx = blockIdx.x; F.vcu = (F.G % 8 == 0) ? (bx % 8) * (F.G / 8) + bx / 8 : bx; }
    F.x = args.in[0]; F.c = args.in[1]; F.ctx = args.in[2]; F.c_ctx = args.in[3]; F.w_mod = args.in[4]; F.b_mod = args.in[5]; F.norm_attn = args.in[6]; F.norm_ffn = args.in[7];
    F.w_in = args.in[8]; F.ret_decay = args.in[9]; F.diff_lambda = args.in[10]; F.diff_subln = args.in[11]; F.w_ret_o = args.in[12]; F.w_diff_o = args.in[13]; F.w_out = args.in[14];
    F.w_router = args.in[15]; F.router_bias = args.in[16]; F.w_exp_gu = args.in[17]; F.w_exp_down = args.in[18]; F.w_sh_gu = args.in[19]; F.w_sh_down = args.in[20]; F.final_norm = args.in[21];
    F.out = args.out; F.ws = args.ws;
    volatile LAS unsigned* MISC = (volatile LAS unsigned*)(F.lds + LDSCTL_OFF);
    for (int u = F.tid; u < (LDS_BYTES - LDSCTL_OFF) / 4; u += NTHR) ((LAS unsigned*)(F.lds + LDSCTL_OFF))[u] = 0u;
    __syncthreads();
    const int lo = args.ph_lo, hi = args.ph_hi;
    const bool multi = (hi - lo) > 1;
    XcdBarrier bar; bar.bar = (unsigned*)(F.ws + WS_CTL) + CW_BAR; bar.x = 0; bar.st = nullptr;
    if (multi) bar = xcd_barrier_post((unsigned*)(F.ws + WS_CTL) + CW_BAR, MISC + 8);
#define IN(k) (lo <= (k) && (k) < hi)
#define SEAM(k) do { if (IN(k) && IN((k) + 1)) xcd_barrier(bar); } while (0)

#define RUNP(k, call) do { if (IN(k)) { call; if (DUP_PHASE == (k)) { xcd_barrier(bar); call; } } SEAM(k); } while (0)
    RUNP(0, p0a_mod(F));
    RUNP(1, (p1_norm1(F), p0b_weights(F)));
    RUNP(2, p2_gemm1(F));
    RUNP(3, p3_ret_local(F));
    RUNP(4, p4_ret_scan(F));
    RUNP(5, p5_ret_out(F));
    RUNP(6, p6_attn(F));
    RUNP(7, p7_gemm2(F));
    RUNP(8, p9_gemm3(F));
    RUNP(9, p10_norm2(F));
    RUNP(10, (p11_router(F), p11b_shared_gu(F)));
    RUNP(11, (p12_topk(F), p12b_shared_act(F)));
    if (IN(12)) { p13_expert_phase<true>(F, 0); if (DUP_PHASE == 12) { xcd_barrier(bar); p13_expert_phase<true>(F, 2); } } SEAM(12);
    if (IN(13)) { p15_shared_down(F); p13_expert_phase<false>(F, 1); if (DUP_PHASE == 13) { xcd_barrier(bar); p13_expert_phase<false>(F, 3); } } SEAM(13);
    if (IN(14)) { p16_combine(F); }
#undef RUNP
#undef IN
#undef SEAM
}

constexpr bool ONE_LAUNCH = true;
extern "C" void kernel_launch(void* const* d_in, const int* in_sizes, int n_in, void* d_out, int out_size, void* d_ws, size_t ws_size, hipStream_t stream) {
    static int grid = 0;
    if (grid == 0) {
        if (n_in != 22 || out_size != MLAT * DM || ws_size < WS_END) { fprintf(stderr, "kernel_launch: unexpected sizes n_in %d out %d ws %zu\n", n_in, out_size, ws_size); grid = -1; return; }
        int dev = 0, cus = 0;
        if (hipGetDevice(&dev) != hipSuccess || hipDeviceGetAttribute(&cus, hipDeviceAttributeMultiprocessorCount, dev) != hipSuccess) { grid = -1; return; }
        if (hipFuncSetAttribute((const void*)mk_fwd, hipFuncAttributeMaxDynamicSharedMemorySize, LDS_BYTES) != hipSuccess) { fprintf(stderr, "kernel_launch: hipFuncSetAttribute failed\n"); grid = -1; return; }
        int per_cu = 0;
        if (hipOccupancyMaxActiveBlocksPerMultiprocessor(&per_cu, (const void*)mk_fwd, NTHR, LDS_BYTES) != hipSuccess || per_cu < 1) fprintf(stderr, "kernel_launch: occupancy query reports %d\n", per_cu);
        (void)hipGetLastError();
        grid = cus;
    }
    if (grid < 0) return;
    (void)hipMemsetAsync((char*)d_ws + WS_CTL, 0, CTL_ZERO_BYTES, stream);
    Args a{};
    for (int i = 0; i < 22; ++i) a.in[i] = (const float*)d_in[i];
    a.out = (float*)d_out; a.ws = (unsigned char*)d_ws;
    if (ONE_LAUNCH) {
        a.ph_lo = 0; a.ph_hi = N_PHASES;
        hipLaunchKernelGGL(mk_fwd, dim3(grid), dim3(NTHR), LDS_BYTES, stream, a);
    } else {
        for (int p = 0; p < N_PHASES; ++p) { a.ph_lo = p; a.ph_hi = p + 1; hipLaunchKernelGGL(mk_fwd, dim3(grid), dim3(NTHR), LDS_BYTES, stream, a); }
    }
}
```

```cpp
#include <hip/hip_runtime.h>
#include <cstdio>
#include <cstdint>

#define LAS __attribute__((address_space(3)))
#define GAS __attribute__((address_space(1)))
typedef _Float16 h16;
typedef _Float16 h16x8 __attribute__((ext_vector_type(8)));
typedef _Float16 h16x4 __attribute__((ext_vector_type(4)));
typedef _Float16 h16x2 __attribute__((ext_vector_type(2)));
typedef float f32x2 __attribute__((ext_vector_type(2)));
typedef float f32x4 __attribute__((ext_vector_type(4)));
typedef float f32x16 __attribute__((ext_vector_type(16)));
typedef unsigned u32x4 __attribute__((ext_vector_type(4)));
typedef unsigned u32x2 __attribute__((ext_vector_type(2)));
typedef short v4i16_t __attribute__((ext_vector_type(4)));

constexpr int DM = 2048, NBATCH = 2, SEQ = 4096, CTXL = 256;
constexpr int MLAT = NBATCH * SEQ, MCTX = NBATCH * CTXL, MALL = MLAT + MCTX;
constexpr int IN_COLS = 13312, KV_COLS = 5120;
constexpr int C_RK = 0, C_RV = 1024, C_DK = 3072, C_DV = 4096, C_RQ = 5120, C_RG = 6144, C_DQ = 8192, C_GR = 9216, C_GD = 11264;
constexpr int NEXP = 256, TOPK = 8, DEXP = 256;
constexpr float EPS = 1e-6f;
constexpr int NWAVES = 8, NTHR = 512;

constexpr size_t MiB = 1u << 20;
constexpr size_t WS_CTL = 0, CTL_ZERO_BYTES = 1 * MiB;
constexpr size_t WS_MODP = 1 * MiB;
constexpr size_t WS_MOD = 3 * MiB;
constexpr size_t WS_ROPE = 3 * MiB + 512 * 1024;
constexpr size_t WS_WINT = 4 * MiB;
constexpr size_t WS_WRET = 56 * MiB;
constexpr size_t WS_WDIF = 64 * MiB;
constexpr size_t WS_WOUT = 68 * MiB;
constexpr size_t WS_WSGU = 76 * MiB;
constexpr size_t WS_WSDN = 78 * MiB;
constexpr size_t WS_WRTR = 79 * MiB;
constexpr size_t WS_H = 82 * MiB;
constexpr size_t WS_P = 116 * MiB;
constexpr size_t WS_LST = 340 * MiB;
constexpr size_t WS_SST = 408 * MiB;
constexpr size_t WS_ARET = 472 * MiB;
constexpr size_t WS_ADIF = 504 * MiB;
constexpr size_t WS_T = 520 * MiB;
constexpr size_t WS_U = 584 * MiB;
constexpr size_t WS_X1 = 616 * MiB;
constexpr size_t WS_H2X = 680 * MiB;
constexpr size_t WS_LG = 776 * MiB;
constexpr size_t WS_EIDX = 784 * MiB;
constexpr size_t WS_EW = 785 * MiB;
constexpr size_t WS_LIST = 786 * MiB;
constexpr size_t WS_ACTS = 794 * MiB;
constexpr size_t WS_YSH = 798 * MiB;
constexpr size_t WS_Y = 830 * MiB;
constexpr size_t WS_ACT = 1086 * MiB;
constexpr size_t WS_LGP = 1118 * MiB;
constexpr size_t WS_SGP = 1182 * MiB;
constexpr size_t WS_ACAT = 1246 * MiB;
constexpr size_t WS_WCAT = 1294 * MiB;
constexpr size_t WS_LIST2 = 1306 * MiB;
constexpr size_t WS_H2F8 = 1322 * MiB;
constexpr size_t WS_END = 1338 * MiB;

constexpr int CW_BAR = 4096;
constexpr int CW_CNT = 16384;
constexpr int CW_Q = 20480;

constexpr int RING_BYTES = 131072;
constexpr int LDS_BYTES = 163840;
constexpr int LDSCTL_OFF = LDS_BYTES - 512;

#define XB_TMO      128
#define XB_XCNT(j)  (256  + 64 * (j))
#define XB_XSUB(j)  (1280 + 64 * (j))
#define XB_XGEN(j)  (2304 + 64 * (j))
#define XB_TOP      3328
#define XB_TOPGEN   3392
#define XCD_BAR_WORDS 3456
#define XB_SPIN_CAP (1u << 18)

__device__ __forceinline__ unsigned xb_ld(unsigned* p)              { return __hip_atomic_load(p, __ATOMIC_RELAXED, __HIP_MEMORY_SCOPE_AGENT); }
__device__ __forceinline__ unsigned xb_add(unsigned* p, unsigned v) { return __hip_atomic_fetch_add(p, v, __ATOMIC_RELAXED, __HIP_MEMORY_SCOPE_AGENT); }
__device__ __forceinline__ unsigned xb_xcc_id() { return (unsigned)__builtin_amdgcn_s_getreg((3 << 11) | 20) & 0xFu; }
#define XB_SPIN(cond, bar) do { unsigned _sp = 0; while (cond) { __builtin_amdgcn_s_sleep(1); \
    if ((++_sp & 255u) == 0u) { if (xb_ld(&(bar)[XB_TMO])) break; if (_sp > XB_SPIN_CAP) { atomicAdd(&(bar)[XB_TMO], 1u); break; } } } } while (0)

struct XcdBarrier { unsigned* bar; unsigned x; volatile LAS unsigned* st; };

__device__ __forceinline__ XcdBarrier xcd_barrier_post(unsigned* bar, volatile LAS unsigned* st) {
    XcdBarrier b; b.bar = bar; b.x = xb_xcc_id(); b.st = st;
    if (threadIdx.x == 0) (void)xb_add(&bar[XB_XCNT(b.x)], 1u);
    return b;
}
__device__ __forceinline__ void xcd_barrier_complete(unsigned* bar, unsigned x, unsigned& nloc, unsigned& nx) {
    const unsigned G = gridDim.x * gridDim.y * gridDim.z;
    unsigned sum, cnt, mine, sp = 0u;
    for (;;) {
        sum = 0u; cnt = 0u; mine = 0u;
#pragma unroll
        for (unsigned j = 0; j < 16; ++j) { const unsigned c = xb_ld(&bar[XB_XCNT(j)]); sum += c; cnt += (c > 0u) ? 1u : 0u; mine = (j == x) ? c : mine; }
        if (sum == G) break;
        __builtin_amdgcn_s_sleep(1);
        if ((++sp & 255u) == 0u) { if (xb_ld(&bar[XB_TMO])) break; if (sp > XB_SPIN_CAP) { atomicAdd(&bar[XB_TMO], 1u); break; } }
    }
    nloc = mine > 0u ? mine : 1u; nx = cnt > 0u ? cnt : 1u;
}
__device__ __forceinline__ void xcd_barrier(const XcdBarrier& b) {
    asm volatile("s_waitcnt vmcnt(0)" ::: "memory");
    __syncthreads();
    if (threadIdx.x == 0) {
        unsigned* bar = b.bar;
        __builtin_amdgcn_s_waitcnt(0);
        unsigned nloc = b.st[0], nx = b.st[1];
        if (nloc == 0u) { xcd_barrier_complete(bar, b.x, nloc, nx); b.st[0] = nloc; b.st[1] = nx; }
        const unsigned old = xb_add(&bar[XB_XSUB(b.x)], 1u);
        const unsigned gen = old / nloc;
        if (old + 1u == (gen + 1u) * nloc) {
            __builtin_amdgcn_fence(__ATOMIC_RELEASE, "agent");
            asm volatile("s_waitcnt vmcnt(0)" ::: "memory");
            const unsigned og = xb_add(&bar[XB_TOP], 1u);
            const unsigned tg = og / nx;
            if (og + 1u == (tg + 1u) * nx) xb_add(&bar[XB_TOPGEN], 1u);
            else XB_SPIN(xb_ld(&bar[XB_TOPGEN]) == tg, bar);
            __builtin_amdgcn_fence(__ATOMIC_ACQUIRE, "agent");
            xb_add(&bar[XB_XGEN(b.x)], 1u);
            asm volatile("s_waitcnt vmcnt(0)" ::: "memory");
        } else {
            XB_SPIN(xb_ld(&bar[XB_XGEN(b.x)]) == gen, bar);
            __builtin_amdgcn_fence(__ATOMIC_ACQUIRE, "agent");
            asm volatile("s_waitcnt vmcnt(0)" ::: "memory");
        }
    }
    __syncthreads();
}


namespace pg8 {
constexpr int BM = 256, BK = 64, HALF = 128, HTB = HALF * BK * 2, STAGE_BYTES = 8 * HTB, NXCD = 8, WGM = 8;
__host__ __device__ __forceinline__ int lds_byte(int r, int c) { const int st = (r >> 4) * 2 + (c >> 5), rr = r & 15, cc = c & 31, ob = rr * 64 + cc * 2; return st * 1024 + (ob ^ (((ob >> 9) & 1) << 5)); }
__host__ __device__ __forceinline__ void stage_rc(int b, int& R, int& C) { const int st = b / 1024, sb = b % 1024, swz = sb ^ (((sb >> 9) & 1) << 5); R = (st >> 1) * 16 + swz / 64; C = (st & 1) * 32 + (swz % 64) / 2; }
struct Unit { int pm, pn, ko, nt, keep; };
struct Gemm { const h16* A; const h16* Bt; int lda, ldb, K; };
struct StaticOrder {
    int nM, nN, nwg, G, c;
    __host__ __device__ void init(int M, int N, int G_, int c_) { nM = M / BM; nN = N / BM; nwg = nM * nN; G = G_; c = c_; }
    __host__ __device__ bool next(int i, Unit& u) const {
        const long L = (long)i * G + c; if (L >= nwg) return false;
        int wgid = (int)L; { const int q = nwg / NXCD, r = nwg % NXCD, xcd = wgid % NXCD, off = wgid / NXCD; wgid = (xcd < r ? xcd * (q + 1) : r * (q + 1) + (xcd - r) * q) + off; }
        const int nig = WGM * nN, gid = wgid / nig, fm = gid * WGM, gsz = (nM - fm) < WGM ? (nM - fm) : WGM;
        u.pm = fm + ((wgid % nig) % gsz); u.pn = (wgid % nig) / gsz; u.ko = 0; u.nt = 0; u.keep = 0; return true;
    }
};
template <class Epi, class Sched, bool ALIGN_EPI = true>
__device__ __forceinline__ void gemm_phase(LAS unsigned char* lds, const Gemm g, const Sched& S, const Epi& E) {
    const int tid = threadIdx.x, wid = __builtin_amdgcn_readfirstlane(tid >> 6), lane = tid & 63, wr = wid >> 2, wc = wid & 3, fr = lane & 15, fq = lane >> 4;
    const int nt0 = g.K / BK;
    unsigned voffA[2], voffB[2];
#pragma unroll
    for (int i = 0; i < 2; ++i) { int R, C; stage_rc(tid * 16 + i * 8192, R, C); voffA[i] = (unsigned)(R * g.lda + C) * 2u; voffB[i] = (unsigned)(R * g.ldb + C) * 2u; }
    const size_t kstep = (size_t)(BK * 2);
    const size_t hstepA = (size_t)HALF * g.lda * 2, hstepB = (size_t)HALF * g.ldb * 2;
    const size_t tstepA = 2 * hstepA, tstepB = 2 * hstepB;
    const unsigned ldsw = (unsigned)wid * 1024u;
    const int aoff = lds_byte(wr * 64 + fr, fq * 8), boff = lds_byte(wc * 32 + fr, fq * 8);
#define PG8_SA(b, h) (((b) * 2 + (h)) * HTB)
#define PG8_SB(b, h) ((4 + (b) * 2 + (h)) * HTB)
#define PG8_STAGE(bufoff, gbase, voff) do { _Pragma("unroll") for (int _i = 0; _i < 2; ++_i) \
        __builtin_amdgcn_global_load_lds((const unsigned*)((const char*)(gbase) + (voff)[_i]), (LAS unsigned*)(lds + (bufoff) + ldsw + _i * 8192), 16, 0, 0); } while (0)
#define PG8_LDA(dst, b, h) do { _Pragma("unroll") for (int m = 0; m < 4; ++m) _Pragma("unroll") for (int k = 0; k < 2; ++k) dst[m][k] = *(const LAS h16x8*)(lds + PG8_SA(b, h) + aoff + m * 2048 + k * 1024); } while (0)
#define PG8_LDB(dst, b, h) do { _Pragma("unroll") for (int n = 0; n < 2; ++n) _Pragma("unroll") for (int k = 0; k < 2; ++k) dst[n][k] = *(const LAS h16x8*)(lds + PG8_SB(b, h) + boff + n * 2048 + k * 1024); } while (0)
#define PG8_MMA(ai, bj, At, Bt) do { __builtin_amdgcn_s_setprio(1); _Pragma("unroll") for (int m = 0; m < 4; ++m) _Pragma("unroll") for (int n = 0; n < 2; ++n) _Pragma("unroll") for (int k = 0; k < 2; ++k) \
        acc[ai][bj][m][n] = __builtin_amdgcn_mfma_f32_16x16x32_f16(Bt[n][k], At[m][k], acc[ai][bj][m][n], 0, 0, 0); __builtin_amdgcn_s_setprio(0); } while (0)
#define PG8_WAIT_V(n) asm volatile("s_waitcnt vmcnt(" #n ")" ::: "memory")
#define PG8_WAIT_L(n) asm volatile("s_waitcnt lgkmcnt(" #n ")" ::: "memory")
#define PG8_BAR __builtin_amdgcn_s_barrier()
#define PG8_SCHED __builtin_amdgcn_sched_barrier(0)
    Unit cur, nxt; int ui = 0;
    if (!S.next(0, cur)) return;
    f32x4 acc[2][2][4][2];
#pragma unroll
    for (int a = 0; a < 2; ++a)
#pragma unroll
        for (int b = 0; b < 2; ++b)
#pragma unroll
            for (int m = 0; m < 4; ++m)
#pragma unroll
                for (int n = 0; n < 2; ++n) acc[a][b][m][n] = (f32x4){0.f, 0.f, 0.f, 0.f};
    h16x8 At[4][2], B0[2][2], B1[2][2];
    const char* cA = (const char*)g.A + (size_t)cur.pm * tstepA + (size_t)cur.ko * 2; const char* cB = (const char*)g.Bt + (size_t)cur.pn * tstepB + (size_t)cur.ko * 2;
    {
        PG8_STAGE(PG8_SB(0, 0), cB, voffB); PG8_STAGE(PG8_SB(0, 1), cB + hstepB, voffB); PG8_STAGE(PG8_SA(0, 0), cA, voffA); PG8_STAGE(PG8_SA(0, 1), cA + hstepA, voffA);
        if (wr == 1) PG8_BAR;
        PG8_WAIT_V(2); PG8_BAR;
        PG8_STAGE(PG8_SB(1, 0), cB + kstep, voffB); PG8_STAGE(PG8_SA(1, 0), cA + kstep, voffA); PG8_STAGE(PG8_SB(1, 1), cB + hstepB + kstep, voffB);
        PG8_WAIT_V(6); PG8_BAR;
    }
    for (;;) {
        const bool has_next = S.next(ui + 1, nxt);
        const char* nA = has_next ? (const char*)g.A + (size_t)nxt.pm * tstepA + (size_t)nxt.ko * 2 : cA; const char* nB = has_next ? (const char*)g.Bt + (size_t)nxt.pn * tstepB + (size_t)nxt.ko * 2 : cB;
        int nt = cur.nt ? cur.nt : nt0; asm volatile("" : "+s"(nt));
        for (int t = 0; t < nt; t += 2) {
            const bool last = (t == nt - 2);
            const char* a1 = cA + (size_t)(t + 1) * kstep;
            const char* a2 = last ? nA : cA + (size_t)(t + 2) * kstep; const char* b2 = last ? nB : cB + (size_t)(t + 2) * kstep;
            const char* a3 = a2 + kstep; const char* b3 = b2 + kstep;
            PG8_LDB(B0, 0, 0); PG8_LDB(B1, 0, 1); PG8_SCHED; PG8_LDA(At, 0, 0); PG8_STAGE(PG8_SA(1, 1), a1 + hstepA, voffA);
            PG8_WAIT_V(8); PG8_WAIT_L(0); PG8_BAR; PG8_MMA(0, 0, At, B0); PG8_MMA(0, 1, At, B1); PG8_BAR; PG8_SCHED;
            PG8_LDA(At, 0, 1); PG8_STAGE(PG8_SB(0, 0), b2, voffB); PG8_STAGE(PG8_SB(0, 1), b2 + hstepB, voffB); PG8_STAGE(PG8_SA(0, 0), a2, voffA);
            PG8_WAIT_V(8); PG8_WAIT_L(0); PG8_BAR; PG8_MMA(1, 0, At, B0); PG8_MMA(1, 1, At, B1); PG8_BAR; PG8_SCHED;
            PG8_LDB(B0, 1, 0); PG8_LDB(B1, 1, 1); PG8_SCHED; PG8_LDA(At, 1, 0); PG8_STAGE(PG8_SA(0, 1), a2 + hstepA, voffA);
            PG8_WAIT_V(8); PG8_WAIT_L(0); PG8_BAR; PG8_MMA(0, 0, At, B0); PG8_MMA(0, 1, At, B1); PG8_BAR; PG8_SCHED;
            PG8_LDA(At, 1, 1); PG8_STAGE(PG8_SB(1, 0), b3, voffB); PG8_STAGE(PG8_SB(1, 1), b3 + hstepB, voffB); PG8_STAGE(PG8_SA(1, 0), a3, voffA);
            PG8_WAIT_V(8); PG8_WAIT_L(0); PG8_BAR; PG8_MMA(1, 0, At, B0); PG8_MMA(1, 1, At, B1); PG8_BAR; PG8_SCHED;
        }
        if constexpr (ALIGN_EPI) { if (wr == 0) PG8_BAR; }
        E(acc, cur, wr, wc, fr, fq);
        if (!has_next) break;
        if (!cur.keep) {
#pragma unroll
        for (int a = 0; a < 2; ++a)
#pragma unroll
            for (int b = 0; b < 2; ++b)
#pragma unroll
                for (int m = 0; m < 4; ++m)
#pragma unroll
                    for (int n = 0; n < 2; ++n) acc[a][b][m][n] = (f32x4){0.f, 0.f, 0.f, 0.f};
        }
        cur = nxt; cA = nA; cB = nB; ++ui;
        if constexpr (ALIGN_EPI) { if (wr == 1) PG8_BAR; }
    }
    PG8_WAIT_V(0);
    if constexpr (!ALIGN_EPI) { if (wr == 0) PG8_BAR; }
    PG8_BAR;
#undef PG8_SA
#undef PG8_SB
#undef PG8_STAGE
#undef PG8_LDA
#undef PG8_LDB
#undef PG8_MMA
#undef PG8_WAIT_V
#undef PG8_WAIT_L
#undef PG8_BAR
#undef PG8_SCHED
}
}

struct Frame {
    LAS unsigned char* lds;
    int tid, lane, wave, vcu, G;
    const float *x, *c, *ctx, *c_ctx, *w_mod, *b_mod, *norm_attn, *norm_ffn, *w_in, *ret_decay, *diff_lambda, *diff_subln,
                *w_ret_o, *w_diff_o, *w_out, *w_router, *router_bias, *w_exp_gu, *w_exp_down, *w_sh_gu, *w_sh_down, *final_norm;
    float* out;
    unsigned char* ws;
};

__device__ __forceinline__ float wave_sum(float v) {
#pragma unroll
    for (int o = 1; o < 64; o <<= 1) v += __shfl_xor(v, o);
    return v;
}
__device__ __forceinline__ unsigned pk2h(float lo, float hi) { f32x2 v = {lo, hi}; h16x2 h = __builtin_convertvector(v, h16x2); return __builtin_bit_cast(unsigned, h); }
__device__ __forceinline__ float silu_f(float v) { return v / (1.0f + __expf(-v)); }
__device__ __forceinline__ float sigmoid_f(float v) { return 1.0f / (1.0f + __expf(-v)); }

__device__ __forceinline__ void p0_mod_unit(Frame& F, int unit) {
    const int cb = unit % 24, ks = unit / 24;
    LAS float* sv = (LAS float*)F.lds;
    LAS float* red = sv + 768;
    for (int i = F.tid; i < 768; i += NTHR) { const int v = i >> 8, k = i & 255; const float cv = (v < 2) ? F.c[v * DM + ks * 256 + k] : F.c_ctx[ks * 256 + k]; sv[i] = silu_f(cv); }
    __syncthreads();
    const int cl = F.tid & 127, rl = F.tid >> 7;
    const float* wp = F.w_mod + (size_t)(ks * 256 + rl) * (6 * DM) + cb * 512 + cl * 4;
    f32x4 a0 = {0.f, 0.f, 0.f, 0.f}, a1 = a0, a2 = a0;
#pragma unroll 8
    for (int i = 0; i < 64; ++i) { const f32x4 w = *(const f32x4*)(wp + (size_t)i * 4 * (6 * DM)); const int k = rl + 4 * i; a0 += w * sv[k]; a1 += w * sv[256 + k]; a2 += w * sv[512 + k]; }
    *(LAS f32x4*)(red + (rl * 3 + 0) * 512 + cl * 4) = a0; *(LAS f32x4*)(red + (rl * 3 + 1) * 512 + cl * 4) = a1; *(LAS f32x4*)(red + (rl * 3 + 2) * 512 + cl * 4) = a2;
    __syncthreads();
    float* modp = (float*)(F.ws + WS_MODP);
    for (int i = F.tid; i < 1536; i += NTHR) { const int v = i >> 9, cc = i & 511; const float s = (red[(0 * 3 + v) * 512 + cc] + red[(1 * 3 + v) * 512 + cc]) + (red[(2 * 3 + v) * 512 + cc] + red[(3 * 3 + v) * 512 + cc]);
        modp[(size_t)(ks * 3 + v) * (6 * DM) + cb * 512 + cc] = s; }
    __syncthreads();
}
template <int MAP>
__device__ __forceinline__ void p0_transpose_item(const float* W, int K, int N, h16* WT, LAS float* scr, int item, int lane, int ldd = 0) {
    if (ldd == 0) ldd = K;
    const int nblk = N / 32, kb = item / nblk, nb = item % nblk, k0 = 64 * kb, n0 = 32 * nb;
#pragma unroll 8
    for (int i = 0; i < 32; ++i) { const int kk = 2 * i + (lane >> 5); scr[kk * 33 + (lane & 31)] = W[(size_t)(k0 + kk) * N + n0 + (lane & 31)]; }
    asm volatile("s_waitcnt lgkmcnt(0)" ::: "memory");
    const int cch = lane & 7;
#pragma unroll
    for (int j = 0; j < 4; ++j) { const int n = (lane >> 3) + 8 * j; const LAS float* s = scr + (8 * cch) * 33 + n;
        u32x4 o; o.x = pk2h(s[0 * 33], s[1 * 33]); o.y = pk2h(s[2 * 33], s[3 * 33]); o.z = pk2h(s[4 * 33], s[5 * 33]); o.w = pk2h(s[6 * 33], s[7 * 33]);
        int nn = n0 + n;
        if (MAP == 1) { const bool isrope = (nn < 1024) || (nn >= C_RQ && nn < C_RQ + 1024); if (isrope) nn = (nn & ~48) | ((nn & 16) << 1) | ((nn & 32) >> 1); }
        if (MAP == 2) { const int j = nn & 255, isu = nn >> 8; nn = 32 * (j >> 4) + 16 * isu + (j & 15); }
        *(u32x4*)(WT + (size_t)nn * ldd + k0 + 8 * cch) = o; }
    asm volatile("s_waitcnt lgkmcnt(0)" ::: "memory");
}
__device__ __forceinline__ void p0a_mod(Frame& F) {
    for (int u = F.vcu; u < 192; u += F.G) p0_mod_unit(F, u);
}
__device__ __forceinline__ void p0b_weights(Frame& F) {
    __syncthreads();
    LAS float* scr = (LAS float*)(F.lds + F.wave * 16384);
    const int gw = F.vcu * NWAVES + F.wave, NGW = F.G * NWAVES;
    constexpr int I_IN = (DM / 64) * (IN_COLS / 32), I_RET = (2048 / 64) * (DM / 32), I_DIF = (1024 / 64) * (DM / 32), I_OUT = (DM / 64) * (DM / 32), I_SGU = (DM / 64) * (512 / 32), I_SDN = (256 / 64) * (DM / 32);
    constexpr int NITEMS = I_IN + I_RET + I_DIF + I_OUT + I_SGU + I_SDN;
    for (int it = gw; it < NITEMS; it += NGW) {
        int r = it;
        if (r < I_IN) { p0_transpose_item<1>(F.w_in, DM, IN_COLS, (h16*)(F.ws + WS_WINT), scr, r, F.lane); continue; } r -= I_IN;
        if (r < I_RET) { p0_transpose_item<0>(F.w_ret_o, 2048, DM, (h16*)(F.ws + WS_WCAT), scr, r, F.lane, 3072); continue; } r -= I_RET;
        if (r < I_DIF) { p0_transpose_item<0>(F.w_diff_o, 1024, DM, (h16*)(F.ws + WS_WCAT) + 2048, scr, r, F.lane, 3072); continue; } r -= I_DIF;
        if (r < I_OUT) { p0_transpose_item<0>(F.w_out, DM, DM, (h16*)(F.ws + WS_WOUT), scr, r, F.lane); continue; } r -= I_OUT;
        if (r < I_SGU) { p0_transpose_item<2>(F.w_sh_gu, DM, 512, (h16*)(F.ws + WS_WSGU), scr, r, F.lane); continue; } r -= I_SGU;
        p0_transpose_item<0>(F.w_sh_down, 256, DM, (h16*)(F.ws + WS_WSDN), scr, r, F.lane);
    }
    {
        const int i = blockIdx.x * NTHR + F.tid;
        for (int q = i; q < NEXP * DM / 4; q += F.G * NTHR) {
            const int e = q / (DM / 4), k = (q % (DM / 4)) * 4;
            const f32x4 w = *(const f32x4*)(F.w_router + (size_t)e * DM + k);
            h16 hi[4], lo[4];
#pragma unroll
            for (int j = 0; j < 4; ++j) { hi[j] = (h16)w[j]; lo[j] = (h16)(w[j] - (float)hi[j]); }
            h16* dst = (h16*)(F.ws + WS_WRTR) + (size_t)e * 6144 + k;
            *(h16x4*)(dst) = (h16x4){hi[0], hi[1], hi[2], hi[3]}; *(h16x4*)(dst + 2048) = (h16x4){hi[0], hi[1], hi[2], hi[3]}; *(h16x4*)(dst + 4096) = (h16x4){lo[0], lo[1], lo[2], lo[3]};
        }
    }
    if (blockIdx.x == 0) {
        float* rope = (float*)(F.ws + WS_ROPE);
        for (int i = F.tid; i < 64 * 32; i += NTHR) { const int pos = i >> 5, j = i & 31; const float inv = exp2f(-(float)j * (13.287712379549449f / 32.0f)); const float ang = (float)pos * inv; rope[i] = cosf(ang); rope[2048 + i] = sinf(ang); }
        for (int i = F.tid; i < 64 * 16; i += NTHR) { const int pos = i >> 4, j = i & 15; const float inv = exp2f(-(float)j * (13.287712379549449f / 16.0f)); const float ang = (float)pos * inv; rope[4096 + i] = cosf(ang); rope[4096 + 1024 + i] = sinf(ang); }
    }
}

__device__ __forceinline__ void p1_norm1(Frame& F) {
    LAS float* msh = (LAS float*)F.lds; LAS float* msc = msh + 3 * DM;
    const float* modp = (const float*)(F.ws + WS_MODP);
    for (int i = F.tid; i < 3 * 2 * DM; i += NTHR) { const int v = i / (2 * DM), cc = i % (2 * DM); float s = F.b_mod[cc];
#pragma unroll
        for (int ks = 0; ks < 8; ++ks) s += modp[(size_t)(ks * 3 + v) * (6 * DM) + cc];
        if (cc < DM) msh[v * DM + cc] = s; else msc[v * DM + cc - DM] = s; }
    __syncthreads();
    const int gw = F.vcu * NWAVES + F.wave, NGW = F.G * NWAVES;
    h16* H = (h16*)(F.ws + WS_H);
    for (int r = gw; r < MALL; r += NGW) {
        const float* src = (r < MLAT) ? F.x + (size_t)r * DM : F.ctx + (size_t)(r - MLAT) * DM; const int v = (r < MLAT) ? (r / SEQ) : 2;
        f32x4 xv[8]; float ss = 0.f;
#pragma unroll
        for (int j = 0; j < 8; ++j) { xv[j] = *(const f32x4*)(src + 4 * F.lane + 256 * j); ss += (xv[j].x * xv[j].x + xv[j].y * xv[j].y) + (xv[j].z * xv[j].z + xv[j].w * xv[j].w); }
        const float rstd = 1.0f / sqrtf(wave_sum(ss) * (1.0f / DM) + EPS);
#pragma unroll
        for (int j = 0; j < 8; ++j) { const int cc = 4 * F.lane + 256 * j; const f32x4 nw = *(const f32x4*)(F.norm_attn + cc);
            const f32x4 sc = *(LAS f32x4*)(msc + v * DM + cc), sh = *(LAS f32x4*)(msh + v * DM + cc);
            const f32x4 y = xv[j] * rstd * nw * (sc + 1.0f) + sh;
            u32x2 o; o.x = pk2h(y.x, y.y); o.y = pk2h(y.z, y.w); *(u32x2*)(H + (size_t)r * DM + cc) = o; }
    }
    float* MOD = (float*)(F.ws + WS_MOD);
    for (int i = blockIdx.x * NTHR + F.tid; i < 3 * 6 * DM; i += F.G * NTHR) { const int v = i / (6 * DM), cc = i % (6 * DM); float s = F.b_mod[cc];
#pragma unroll
        for (int ks = 0; ks < 8; ++ks) s += modp[(size_t)(ks * 3 + v) * (6 * DM) + cc];
        MOD[i] = s; }
}


__device__ __forceinline__ int crow(int r, int hi) { return (r & 3) + 8 * (r >> 2) + 4 * hi; }
__device__ __forceinline__ h16x8 frag_row(const LAS unsigned char* base, int strideB, int r0, int k0, int lane) {
    return *(const LAS h16x8*)(base + (r0 + (lane & 31)) * strideB + (k0 + 8 * (lane >> 5)) * 2);
}
__device__ __forceinline__ v4i16_t tr16(const LAS unsigned char* p) { return __builtin_amdgcn_ds_read_tr16_b64_v4i16((LAS v4i16_t*)p); }
__device__ __forceinline__ h16x8 frag_tr(const LAS unsigned char* base, int strideB, int k0, int n0, int lane) {
    const int kb = k0 + 8 * (lane >> 5) + ((lane & 15) >> 2), nc = n0 + 16 * ((lane >> 4) & 1) + 4 * (lane & 3);
    const LAS unsigned char* p = base + kb * strideB + nc * 2;
    const v4i16_t lo = tr16(p), hi = tr16(p + 4 * strideB);
    typedef short s16x8 __attribute__((ext_vector_type(8)));
    const s16x8 v = {lo[0], lo[1], lo[2], lo[3], hi[0], hi[1], hi[2], hi[3]};
    return __builtin_bit_cast(h16x8, v);
}
__device__ __forceinline__ h16x8 frag_tr_perm(const LAS unsigned char* base, int strideB, int k0, int n0, int lane) {
    const int kb = k0 + 4 * (lane >> 5) + ((lane & 15) >> 2), nc = n0 + 16 * ((lane >> 4) & 1) + 4 * (lane & 3);
    const LAS unsigned char* p = base + kb * strideB + nc * 2;
    const v4i16_t lo = tr16(p), hi = tr16(p + 8 * strideB);
    typedef short s16x8 __attribute__((ext_vector_type(8)));
    const s16x8 v = {lo[0], lo[1], lo[2], lo[3], hi[0], hi[1], hi[2], hi[3]};
    return __builtin_bit_cast(h16x8, v);
}
__device__ __forceinline__ h16x8 pack8(float a0, float a1, float a2, float a3, float a4, float a5, float a6, float a7) {
    u32x4 w; w.x = pk2h(a0, a1); w.y = pk2h(a2, a3); w.z = pk2h(a4, a5); w.w = pk2h(a6, a7); return __builtin_bit_cast(h16x8, w);
}
#define MFMA32(a, b, c) __builtin_amdgcn_mfma_f32_32x32x16_f16((a), (b), (c), 0, 0, 0)

struct SchedG1 {
    pg8::StaticOrder so; int G, c;
    __device__ __forceinline__ bool next(int i, pg8::Unit& u) const {
        const int L = i * G + c;
        if (L < 32 * 52) return so.next(i, u);
        const int r = L - 32 * 52; if (r >= 40) return false;
        u.pm = 32 + r / 20; u.pn = r % 20; u.ko = 0; u.nt = 0; u.keep = 0; return true;
    }
};
struct EpiP {
    h16* P; const float* rope;
    __device__ __forceinline__ void operator()(f32x4 (&acc)[2][2][4][2], const pg8::Unit& u, int wr, int wc, int fr, int fq) const {
        const int colt = u.pn * 256; const bool lat = u.pm < 32;
        int kind;
        if (colt < C_RV) kind = 1; else if (colt < C_DK) kind = 0; else if (colt < C_DV) kind = 3; else if (colt < C_RQ) kind = 0; else if (colt < C_RG) kind = 2; else if (colt < C_DQ) kind = 5; else if (colt < C_GR) kind = 4; else kind = 6;
        if (!lat) kind = (kind == 1) ? 7 : 0;
#pragma unroll
        for (int ai = 0; ai < 2; ++ai)
#pragma unroll
            for (int m = 0; m < 4; ++m) {
                const int row = u.pm * 256 + ai * 128 + wr * 64 + m * 16 + fr; const int t = row & (SEQ - 1);
                h16* prow = P + (size_t)row * IN_COLS;
#pragma unroll
                for (int bj = 0; bj < 2; ++bj) {
                    const int cbase = colt + bj * 128 + wc * 32;
                    const f32x4 x0 = acc[ai][bj][m][0], x1 = acc[ai][bj][m][1];
                    f32x4 o0, o1; int c0, c1;
                    if (kind == 1 || kind == 2) {
                        const int g5 = (cbase >> 5) & 1, axis = (cbase >> 6) & 1, pos = axis ? (t & 63) : (t >> 6), j0 = 16 * g5 + 4 * fq;
                        const f32x4 cs = *(const f32x4*)(rope + pos * 32 + j0), sn = *(const f32x4*)(rope + 2048 + pos * 32 + j0);
                        o0 = x0 * cs - x1 * sn; o1 = x0 * sn + x1 * cs;
                        if (kind == 2) { o0 *= 0.08838834764831845f; o1 *= 0.08838834764831845f; }
                        c0 = (cbase & ~63) + j0; c1 = c0 + 32;
                    } else if (kind == 7) {
                        const int g5 = (cbase >> 5) & 1; c0 = (cbase & ~63) + 16 * g5 + 4 * fq; c1 = c0 + 32; o0 = x0; o1 = x1;
                    } else if (kind == 3 || kind == 4) {
                        const int axis = (cbase >> 5) & 1, pos = axis ? (t & 63) : (t >> 6), j0 = 4 * fq;
                        const f32x4 cs = *(const f32x4*)(rope + 4096 + pos * 16 + j0), sn = *(const f32x4*)(rope + 5120 + pos * 16 + j0);
                        o0 = x0 * cs - x1 * sn; o1 = x0 * sn + x1 * cs;
                        if (kind == 4) { o0 *= 0.18033688011112042f; o1 *= 0.18033688011112042f; }
                        c0 = cbase + j0; c1 = c0 + 16;
                    } else {
                        c0 = cbase + 4 * fq; c1 = c0 + 16; o0 = x0; o1 = x1;
                        if (kind == 5) {
#pragma unroll
                            for (int e = 0; e < 4; ++e) { o0[e] = silu_f(x0[e]); o1[e] = silu_f(x1[e]); }
                        } else if (kind == 6) {
#pragma unroll
                            for (int e = 0; e < 4; ++e) { o0[e] = sigmoid_f(x0[e]); o1[e] = sigmoid_f(x1[e]); }
                        }
                    }
                    u32x2 w0, w1; w0.x = pk2h(o0[0], o0[1]); w0.y = pk2h(o0[2], o0[3]); w1.x = pk2h(o1[0], o1[1]); w1.y = pk2h(o1[2], o1[3]);
                    *(u32x2*)(prow + c0) = w0; *(u32x2*)(prow + c1) = w1;
                }
            }
    }
};
__device__ __forceinline__ void p2_gemm1(Frame& F) {
    pg8::Gemm g{(const h16*)(F.ws + WS_H), (const h16*)(F.ws + WS_WINT), DM, DM, DM};
    SchedG1 S; S.so.init(MLAT, IN_COLS, F.G, (int)blockIdx.x); S.G = F.G; S.c = (int)blockIdx.x;
    EpiP E{(h16*)(F.ws + WS_P), (const float*)(F.ws + WS_ROPE)};
    pg8::gemm_phase<EpiP, SchedG1>(F.lds, g, S, E);
}

__device__ __forceinline__ void p3_ret_local(Frame& F) {
    LAS unsigned char* KF = F.lds; LAS unsigned char* KB = F.lds + 40960; LAS unsigned char* VH = F.lds + 81920;
    const h16* P = (const h16*)(F.ws + WS_P); h16* LST = (h16*)(F.ws + WS_LST);
    const int hi = F.lane >> 5;
    for (int u = F.vcu; u < 16 * 34; u += F.G) {
        const int bh = u / 34, cc = u % 34, b = bh >> 3, h = bh & 7;
        const int row0 = (cc < 2) ? (MLAT + b * CTXL + cc * 128) : (b * SEQ + (cc - 2) * 128);
        const float lgf = -__expf(F.ret_decay[h]), lgb = -__expf(F.ret_decay[8 + h]);
#pragma unroll
        for (int i = 0; i < 4; ++i) { const int q = F.tid + NTHR * i, row = q >> 4, ch = q & 15;
            const h16x8 kv = *(const h16x8*)(P + (size_t)(row0 + row) * IN_COLS + C_RK + h * 128 + ch * 8);
            const float sf = __expf(lgf * (float)(127 - row)), sb = __expf(lgb * (float)row);
            *(LAS h16x8*)(KF + row * 320 + ch * 16) = pack8((float)kv[0] * sf, (float)kv[1] * sf, (float)kv[2] * sf, (float)kv[3] * sf, (float)kv[4] * sf, (float)kv[5] * sf, (float)kv[6] * sf, (float)kv[7] * sf);
            *(LAS h16x8*)(KB + row * 320 + ch * 16) = pack8((float)kv[0] * sb, (float)kv[1] * sb, (float)kv[2] * sb, (float)kv[3] * sb, (float)kv[4] * sb, (float)kv[5] * sb, (float)kv[6] * sb, (float)kv[7] * sb); }
        for (int eh = 0; eh < 2; ++eh) {
            if (eh) __syncthreads();
#pragma unroll
            for (int i = 0; i < 4; ++i) { const int q = F.tid + NTHR * i, row = q >> 4, ch = q & 15;
                *(LAS h16x8*)(VH + row * 320 + ch * 16) = *(const h16x8*)(P + (size_t)(row0 + row) * IN_COLS + C_RV + h * 256 + eh * 128 + ch * 8); }
            __syncthreads();
            const int dir = F.wave >> 2, eb = F.wave & 3; const LAS unsigned char* Kd = dir ? KB : KF;
            f32x16 acc[4];
#pragma unroll
            for (int db = 0; db < 4; ++db) acc[db] = (f32x16){};
#pragma unroll
            for (int ks = 0; ks < 8; ++ks) { const h16x8 a = frag_tr(VH, 320, 16 * ks, 32 * eb, F.lane);
#pragma unroll
                for (int db = 0; db < 4; ++db) { const h16x8 bb = frag_tr(Kd, 320, 16 * ks, 32 * db, F.lane); acc[db] = MFMA32(a, bb, acc[db]); } }
            h16* dst = LST + ((size_t)((dir * 16 + bh) * 34 + cc) * 256 + eh * 128 + eb * 32) * 128;
#pragma unroll
            for (int db = 0; db < 4; ++db)
#pragma unroll
                for (int r = 0; r < 16; ++r) dst[crow(r, hi) * 128 + db * 32 + (F.lane & 31)] = (h16)acc[db][r];
        }
        __syncthreads();
    }
}
__device__ __forceinline__ void p4_ret_scan(Frame& F) {
    const h16* LST = (const h16*)(F.ws + WS_LST); h16* SST = (h16*)(F.ws + WS_SST);
    for (int g = blockIdx.x * NTHR + F.tid; g < 2 * 16 * 4096; g += F.G * NTHR) {
        const int seq = g >> 12, off = (g & 4095) * 8, dir = seq >> 4, bh = seq & 15, h = bh & 7;
        const float cd = __expf(-__expf(F.ret_decay[dir * 8 + h]) * 128.0f);
        const h16* Lp = LST + (size_t)seq * 34 * 32768 + off; h16* Sp = SST + (size_t)seq * 32 * 32768 + off;
        float s[8];
#pragma unroll
        for (int e = 0; e < 8; ++e) s[e] = 0.f;
        if (dir == 0) {
            for (int cc = 0; cc < 33; ++cc) {
                if (cc >= 2) *(h16x8*)(Sp + (size_t)(cc - 2) * 32768) = pack8(s[0], s[1], s[2], s[3], s[4], s[5], s[6], s[7]);
                const h16x8 l = *(const h16x8*)(Lp + (size_t)cc * 32768);
#pragma unroll
                for (int e = 0; e < 8; ++e) s[e] = s[e] * cd + (float)l[e];
            }
            *(h16x8*)(Sp + (size_t)31 * 32768) = pack8(s[0], s[1], s[2], s[3], s[4], s[5], s[6], s[7]);
        } else {
            { const h16x8 l1 = *(const h16x8*)(Lp + (size_t)1 * 32768), l0 = *(const h16x8*)(Lp);
#pragma unroll
              for (int e = 0; e < 8; ++e) s[e] = (float)l1[e] * cd + (float)l0[e]; }
            for (int c = 31; c >= 0; --c) {
                *(h16x8*)(Sp + (size_t)c * 32768) = pack8(s[0], s[1], s[2], s[3], s[4], s[5], s[6], s[7]);
                const h16x8 l = *(const h16x8*)(Lp + (size_t)(c + 2) * 32768);
#pragma unroll
                for (int e = 0; e < 8; ++e) s[e] = s[e] * cd + (float)l[e];
            }
        }
    }
}
__device__ __forceinline__ void p5_ret_out(Frame& F) {
    LAS unsigned char* QL = F.lds; LAS unsigned char* KL = F.lds + 34816; LAS unsigned char* PL = KL; LAS unsigned char* VL = F.lds + 69632;
    LAS float* RED = (LAS float*)(F.lds + 69632 + 73728);
    const h16* P = (const h16*)(F.ws + WS_P); const h16* SST = (const h16*)(F.ws + WS_SST); h16* ARET = (h16*)(F.ws + WS_ACAT);
    const int hi = F.lane >> 5, ln = F.lane & 31, w = F.wave;
    for (int u = F.vcu; u < 512; u += F.G) {
        const int bh = u >> 5, c = u & 31, b = bh >> 3, h = bh & 7, row0 = b * SEQ + c * 128;
        const float lgf = -__expf(F.ret_decay[h]), lgb = -__expf(F.ret_decay[8 + h]);
#pragma unroll
        for (int i = 0; i < 4; ++i) { const int q = F.tid + NTHR * i, row = q >> 4, ch = q & 15; const h16* pr = P + (size_t)(row0 + row) * IN_COLS + h * 128 + ch * 8;
            *(LAS h16x8*)(QL + row * 272 + ch * 16) = *(const h16x8*)(pr + C_RQ); *(LAS h16x8*)(KL + row * 272 + ch * 16) = *(const h16x8*)(pr + C_RK); }
        h16x8 vreg[8];
#pragma unroll
        for (int i = 0; i < 8; ++i) { const int q = F.tid + NTHR * i, row = q >> 5, c32 = q & 31; vreg[i] = *(const h16x8*)(P + (size_t)(row0 + row) * IN_COLS + C_RV + h * 256 + c32 * 8); }
        __syncthreads();
        u32x2 pw[2][4];
        { const int jt = w >> 1;
#pragma unroll
          for (int t2 = 0; t2 < 2; ++t2) { const int ib = 2 * (w & 1) + t2, il = 32 * ib + ln; f32x16 s = (f32x16){};
#pragma unroll
            for (int ks = 0; ks < 8; ++ks) s = MFMA32(frag_row(KL, 272, 32 * jt, 16 * ks, F.lane), frag_row(QL, 272, 32 * ib, 16 * ks, F.lane), s);
#pragma unroll
            for (int r = 0; r < 16; ++r) { const int d = il - (32 * jt + crow(r, hi)); s[r] *= (d >= 0) ? __expf(lgf * (float)d) : __expf(lgb * (float)(-d)); }
#pragma unroll
            for (int r4 = 0; r4 < 4; ++r4) { pw[t2][r4].x = pk2h(s[4 * r4], s[4 * r4 + 1]); pw[t2][r4].y = pk2h(s[4 * r4 + 2], s[4 * r4 + 3]); } } }
        __syncthreads();
        { const int jt = w >> 1;
#pragma unroll
          for (int t2 = 0; t2 < 2; ++t2) { const int il = 32 * (2 * (w & 1) + t2) + ln;
#pragma unroll
            for (int r4 = 0; r4 < 4; ++r4) *(LAS u32x2*)(PL + il * 272 + (32 * jt + 8 * r4 + 4 * hi) * 2) = pw[t2][r4]; } }
#pragma unroll
        for (int i = 0; i < 8; ++i) { const int q = F.tid + NTHR * i, row = q >> 5, c32 = q & 31; *(LAS h16x8*)(VL + row * 576 + c32 * 16) = vreg[i]; }
        __syncthreads();
        f32x16 o[4];
#pragma unroll
        for (int ib = 0; ib < 4; ++ib) o[ib] = (f32x16){};
#pragma unroll
        for (int k16 = 0; k16 < 8; ++k16) { const h16x8 a = frag_tr(VL, 576, 16 * k16, 32 * w, F.lane);
#pragma unroll
            for (int ib = 0; ib < 4; ++ib) o[ib] = MFMA32(a, frag_row(PL, 272, 32 * ib, 16 * k16, F.lane), o[ib]);
            if (k16 & 1) __builtin_amdgcn_sched_barrier(0); }
#pragma unroll
        for (int dir = 0; dir < 2; ++dir) {
            h16 sc[4];
#pragma unroll
            for (int ib = 0; ib < 4; ++ib) { const int il = 32 * ib + ln; sc[ib] = (h16)(dir ? __expf(lgb * (float)(128 - il)) : __expf(lgf * (float)(il + 1))); }
            const h16* Sg = SST + ((size_t)((dir * 16 + bh) * 32 + c) * 256 + 32 * w + ln) * 128 + 8 * hi;
#pragma unroll
            for (int kh = 0; kh < 2; ++kh) {
                h16x8 sa[4];
#pragma unroll
                for (int k4 = 0; k4 < 4; ++k4) sa[k4] = *(const h16x8*)(Sg + 16 * (4 * kh + k4));
#pragma unroll
                for (int k4 = 0; k4 < 4; ++k4) {
#pragma unroll
                    for (int ib = 0; ib < 4; ++ib) o[ib] = MFMA32(sa[k4], frag_row(QL, 272, 32 * ib, 16 * (4 * kh + k4), F.lane) * sc[ib], o[ib]);
                    __builtin_amdgcn_sched_barrier(0); }
            }
        }
#pragma unroll
        for (int ib = 0; ib < 4; ++ib) { float ss = 0.f;
#pragma unroll
            for (int r = 0; r < 16; ++r) ss += o[ib][r] * o[ib][r];
            ss += __shfl_xor(ss, 32);
            if (hi == 0) RED[(w * 4 + ib) * 32 + ln] = ss; }
        __syncthreads();
#pragma unroll
        for (int ib = 0; ib < 4; ++ib) { float tot = 0.f;
#pragma unroll
            for (int ww = 0; ww < 8; ++ww) tot += RED[(ww * 4 + ib) * 32 + ln];
            const float rstd = 1.0f / sqrtf(tot * (1.0f / 256.0f) + EPS);
            const size_t grow = (size_t)(row0 + 32 * ib + ln);
#pragma unroll
            for (int r4 = 0; r4 < 4; ++r4) { const int e = 32 * w + 8 * r4 + 4 * hi;
                const h16x4 gt = *(const h16x4*)(P + grow * IN_COLS + C_RG + h * 256 + e);
                u32x2 wv; wv.x = pk2h(o[ib][4 * r4] * rstd * (float)gt[0], o[ib][4 * r4 + 1] * rstd * (float)gt[1]); wv.y = pk2h(o[ib][4 * r4 + 2] * rstd * (float)gt[2], o[ib][4 * r4 + 3] * rstd * (float)gt[3]);
                *(u32x2*)(ARET + grow * 3072 + h * 256 + e) = wv; } }
        __syncthreads();
    }
}
__device__ __forceinline__ void p6_attn(Frame& F) {
    const h16* P = (const h16*)(F.ws + WS_P); h16* ADIF = (h16*)(F.ws + WS_ACAT) + 2048;
    const int hi = F.lane >> 5, ln = F.lane & 31;
    float lam;
    { const float s1 = wave_sum(F.diff_lambda[F.lane] * F.diff_lambda[64 + F.lane]), s2 = wave_sum(F.diff_lambda[128 + F.lane] * F.diff_lambda[192 + F.lane]); lam = __expf(s1) - __expf(s2) + 0.2f; }
    constexpr int KT0 = 0, VT0 = 34816, KTB = 17408, VTB = 20480;
    LAS float* XB = (LAS float*)F.lds;
    for (int u = F.vcu; u < 512; u += F.G) {
        const int bh = u >> 5, qb = u & 31, b = bh >> 3, h = bh & 7;
        const int cm = F.wave & 1, qs = F.wave >> 1, qrow0 = b * SEQ + qb * 128 + qs * 32;
        h16x8 qf[4];
#pragma unroll
        for (int ks = 0; ks < 4; ++ks) qf[ks] = *(const h16x8*)(P + (size_t)(qrow0 + ln) * IN_COLS + C_DQ + h * 128 + cm * 64 + 16 * ks + 8 * hi);
        f32x16 o[4];
#pragma unroll
        for (int et = 0; et < 4; ++et) o[et] = (f32x16){};
        float mrun = -1e30f, lsum = 0.f;
        h16x8 kreg[2], vreg[2];
#define ATT_LOAD(t) do { _Pragma("unroll") for (int i = 0; i < 2; ++i) { const int q = F.tid + NTHR * i, row = q >> 4, ch = q & 15; const int j = (t) * 64 + row; \
            const size_t srow = (j < CTXL) ? (size_t)(MLAT + b * CTXL + j) : (size_t)(b * SEQ + j - CTXL); const h16* pr = P + srow * IN_COLS + h * 128 + ch * 8; \
            kreg[i] = *(const h16x8*)(pr + C_DK); vreg[i] = *(const h16x8*)(pr + C_DV); } } while (0)
#define ATT_WRITE(buf) do { _Pragma("unroll") for (int i = 0; i < 2; ++i) { const int q = F.tid + NTHR * i, row = q >> 4, ch = q & 15; \
            *(LAS h16x8*)(F.lds + KT0 + (buf) * KTB + row * 272 + ch * 16) = kreg[i]; *(LAS h16x8*)(F.lds + VT0 + (buf) * VTB + row * 320 + ch * 16) = vreg[i]; } } while (0)
        ATT_LOAD(0); ATT_WRITE(0);
        __syncthreads();
        constexpr int NT = (CTXL + SEQ) / 64;
        for (int t = 0; t < NT; ++t) {
            const int buf = t & 1;
            if (t + 1 < NT) ATT_LOAD(t + 1);
            const LAS unsigned char* Kt = F.lds + KT0 + buf * KTB; const LAS unsigned char* Vt = F.lds + VT0 + buf * VTB;
            f32x16 s[2];
#pragma unroll
            for (int kt = 0; kt < 2; ++kt) { s[kt] = (f32x16){};
#pragma unroll
                for (int ks = 0; ks < 4; ++ks) s[kt] = MFMA32(frag_row(Kt, 272, 32 * kt, cm * 64 + 16 * ks, F.lane), qf[ks], s[kt]); }
            float mx = s[0][0];
#pragma unroll
            for (int r = 0; r < 16; ++r) { mx = fmaxf(mx, s[0][r]); mx = fmaxf(mx, s[1][r]); }
            mx = fmaxf(mx, __shfl_xor(mx, 32));
            if (__any(mx > mrun + 8.0f)) { const float mn = fmaxf(mrun, mx), alpha = __builtin_amdgcn_exp2f(mrun - mn); mrun = mn; lsum *= alpha;
#pragma unroll
                for (int et = 0; et < 4; ++et) o[et] *= alpha; }
            float ps = 0.f;
#pragma unroll
            for (int kt = 0; kt < 2; ++kt)
#pragma unroll
                for (int r = 0; r < 16; ++r) { s[kt][r] = __builtin_amdgcn_exp2f(s[kt][r] - mrun); ps += s[kt][r]; }
            lsum += ps;
#pragma unroll
            for (int kt = 0; kt < 2; ++kt)
#pragma unroll
                for (int s2 = 0; s2 < 2; ++s2) {
                    const h16x8 pbf = pack8(s[kt][8 * s2], s[kt][8 * s2 + 1], s[kt][8 * s2 + 2], s[kt][8 * s2 + 3], s[kt][8 * s2 + 4], s[kt][8 * s2 + 5], s[kt][8 * s2 + 6], s[kt][8 * s2 + 7]);
#pragma unroll
                    for (int et = 0; et < 4; ++et) o[et] = MFMA32(frag_tr_perm(Vt, 320, 32 * kt + 16 * s2, 32 * et, F.lane), pbf, o[et]);
                }
            if (t + 1 < NT) ATT_WRITE(buf ^ 1);
            __syncthreads();
        }
#undef ATT_LOAD
#undef ATT_WRITE
        lsum += __shfl_xor(lsum, 32);
        const float inv = 1.0f / lsum;
        if (cm == 1) {
#pragma unroll
            for (int et = 0; et < 4; ++et)
#pragma unroll
                for (int r = 0; r < 16; ++r) XB[(qs * 128 + 32 * et + crow(r, hi)) * 32 + ln] = o[et][r] * inv;
        }
        __syncthreads();
        if (cm == 0) {
            float ss = 0.f;
#pragma unroll
            for (int et = 0; et < 4; ++et)
#pragma unroll
                for (int r = 0; r < 16; ++r) { const float v = o[et][r] * inv - lam * XB[(qs * 128 + 32 * et + crow(r, hi)) * 32 + ln]; o[et][r] = v; ss += v * v; }
            ss += __shfl_xor(ss, 32);
            const float rstd = 0.8f / sqrtf(ss * (1.0f / 128.0f) + EPS);
            const size_t grow = (size_t)(qrow0 + ln);
#pragma unroll
            for (int et = 0; et < 4; ++et)
#pragma unroll
                for (int r4 = 0; r4 < 4; ++r4) { const int e = 32 * et + 8 * r4 + 4 * hi; const f32x4 sw = *(const f32x4*)(F.diff_subln + e);
                    u32x2 w; w.x = pk2h(o[et][4 * r4] * rstd * sw[0], o[et][4 * r4 + 1] * rstd * sw[1]); w.y = pk2h(o[et][4 * r4 + 2] * rstd * sw[2], o[et][4 * r4 + 3] * rstd * sw[3]);
                    *(u32x2*)(ADIF + grow * 3072 + h * 128 + e) = w; }
        }
        __syncthreads();
    }
}
struct SchedG2 {
    pg8::StaticOrder so;
    __device__ __forceinline__ bool next(int i, pg8::Unit& u) const { if (!so.next(i >> 1, u)) return false; if (i & 1) { u.ko = 2048; u.nt = 16; u.keep = 0; } else { u.ko = 0; u.nt = 32; u.keep = 1; } return true; }
};
struct EpiU2 {
    h16* U; const h16* P;
    __device__ __forceinline__ void operator()(f32x4 (&acc)[2][2][4][2], const pg8::Unit& u, int wr, int wc, int fr, int fq) const {
#pragma unroll
        for (int ai = 0; ai < 2; ++ai)
#pragma unroll
            for (int m = 0; m < 4; ++m) { const int row = u.pm * 256 + ai * 128 + wr * 64 + m * 16 + fr;
#pragma unroll
                for (int bj = 0; bj < 2; ++bj)
#pragma unroll
                    for (int n = 0; n < 2; ++n) { const int col = u.pn * 256 + bj * 128 + wc * 32 + 16 * n + 4 * fq;
                        const h16x4 gd = *(const h16x4*)(P + (size_t)row * IN_COLS + C_GD + col);
                        if (u.keep) { const h16x4 gr = *(const h16x4*)(P + (size_t)row * IN_COLS + C_GR + col);
#pragma unroll
                            for (int e = 0; e < 4; ++e) acc[ai][bj][m][n][e] *= (float)gr[e] / (float)gd[e];
                        } else { const f32x4 a = acc[ai][bj][m][n];
                            u32x2 w; w.x = pk2h(a[0] * (float)gd[0], a[1] * (float)gd[1]); w.y = pk2h(a[2] * (float)gd[2], a[3] * (float)gd[3]);
                            *(u32x2*)(U + (size_t)row * DM + col) = w; } } }
    }
};
struct EpiX1 {
    float* X1; const float* x; const float* MOD;
    __device__ __forceinline__ void operator()(f32x4 (&acc)[2][2][4][2], const pg8::Unit& u, int wr, int wc, int fr, int fq) const {
        const int b = (u.pm * 256) / SEQ;
#pragma unroll
        for (int ai = 0; ai < 2; ++ai)
#pragma unroll
            for (int m = 0; m < 4; ++m) { const int row = u.pm * 256 + ai * 128 + wr * 64 + m * 16 + fr;
#pragma unroll
                for (int bj = 0; bj < 2; ++bj)
#pragma unroll
                    for (int n = 0; n < 2; ++n) { const int col = u.pn * 256 + bj * 128 + wc * 32 + 16 * n + 4 * fq;
                        const f32x4 g1 = *(const f32x4*)(MOD + (size_t)b * (6 * DM) + 2 * DM + col); const f32x4 xv = *(const f32x4*)(x + (size_t)row * DM + col);
                        *(f32x4*)(X1 + (size_t)row * DM + col) = xv + g1 * acc[ai][bj][m][n]; } }
    }
};
__device__ __forceinline__ void p7_gemm2(Frame& F) {
    pg8::Gemm g{(const h16*)(F.ws + WS_ACAT), (const h16*)(F.ws + WS_WCAT), 3072, 3072, 2048};
    SchedG2 S; S.so.init(MLAT, DM, F.G, (int)blockIdx.x);
    EpiU2 E{(h16*)(F.ws + WS_U), (const h16*)(F.ws + WS_P)};
    pg8::gemm_phase<EpiU2, SchedG2>(F.lds, g, S, E);
}
__device__ __forceinline__ void p9_gemm3(Frame& F) {
    pg8::Gemm g{(const h16*)(F.ws + WS_U), (const h16*)(F.ws + WS_WOUT), 2048, 2048, 2048};
    pg8::StaticOrder S; S.init(MLAT, DM, F.G, (int)blockIdx.x);
    EpiX1 E{(float*)(F.ws + WS_X1), F.x, (const float*)(F.ws + WS_MOD)};
    pg8::gemm_phase<EpiX1, pg8::StaticOrder>(F.lds, g, S, E);
}


__device__ __forceinline__ void p10_norm2(Frame& F) {
    const float* X1 = (const float*)(F.ws + WS_X1); const float* MOD = (const float*)(F.ws + WS_MOD); h16* H2X = (h16*)(F.ws + WS_H2X);
    const int gw = F.vcu * NWAVES + F.wave, NGW = F.G * NWAVES;
    for (int r = gw; r < MLAT; r += NGW) {
        const float* src = X1 + (size_t)r * DM; const int b = r / SEQ;
        f32x4 xv[8]; float ss = 0.f;
#pragma unroll
        for (int j = 0; j < 8; ++j) { xv[j] = *(const f32x4*)(src + 4 * F.lane + 256 * j); ss += (xv[j].x * xv[j].x + xv[j].y * xv[j].y) + (xv[j].z * xv[j].z + xv[j].w * xv[j].w); }
        const float rstd = 1.0f / sqrtf(wave_sum(ss) * (1.0f / DM) + EPS);
#pragma unroll
        for (int j = 0; j < 8; ++j) { const int cc = 4 * F.lane + 256 * j; const f32x4 nw = *(const f32x4*)(F.norm_ffn + cc);
            const f32x4 sh = *(const f32x4*)(MOD + (size_t)b * (6 * DM) + 3 * DM + cc), sc = *(const f32x4*)(MOD + (size_t)b * (6 * DM) + 4 * DM + cc);
            const f32x4 y = xv[j] * rstd * nw * (sc + 1.0f) + sh;
            h16 hh[4], ll[4];
#pragma unroll
            for (int e = 0; e < 4; ++e) { hh[e] = (h16)y[e]; ll[e] = (h16)(y[e] - (float)hh[e]); }
            h16* dst = H2X + (size_t)r * 6144 + cc;
            *(h16x4*)(dst) = (h16x4){hh[0], hh[1], hh[2], hh[3]}; *(h16x4*)(dst + 4096) = (h16x4){hh[0], hh[1], hh[2], hh[3]}; *(h16x4*)(dst + 2048) = (h16x4){ll[0], ll[1], ll[2], ll[3]};
            { int p8 = __builtin_amdgcn_cvt_pk_fp8_f32(y[0], y[1], 0, false); p8 = __builtin_amdgcn_cvt_pk_fp8_f32(y[2], y[3], p8, true); *(int*)((unsigned char*)(F.ws + WS_H2F8) + (size_t)r * DM + cc) = p8; } }
    }
}
struct SchedRT {
    int G, c;
    __device__ __forceinline__ bool next(int i, pg8::Unit& u) const { const int L = i * G + c; if (L >= 256) return false; u.pm = L >> 3; u.pn = 0; u.ko = (L & 7) * 768; u.nt = 0; u.keep = 0; return true; }
};
struct EpiLG {
    float* LGP;
    __device__ __forceinline__ void operator()(f32x4 (&acc)[2][2][4][2], const pg8::Unit& u, int wr, int wc, int fr, int fq) const {
        float* dst = LGP + (size_t)(u.ko / 768) * MLAT * NEXP;
#pragma unroll
        for (int ai = 0; ai < 2; ++ai)
#pragma unroll
            for (int m = 0; m < 4; ++m) { const int row = u.pm * 256 + ai * 128 + wr * 64 + m * 16 + fr;
#pragma unroll
                for (int bj = 0; bj < 2; ++bj)
#pragma unroll
                    for (int n = 0; n < 2; ++n) { const int col = bj * 128 + wc * 32 + 16 * n + 4 * fq; *(f32x4*)(dst + (size_t)row * NEXP + col) = acc[ai][bj][m][n]; } }
    }
};
__device__ __forceinline__ void p11_router(Frame& F) {
    pg8::Gemm g{(const h16*)(F.ws + WS_H2X), (const h16*)(F.ws + WS_WRTR), 6144, 6144, 768};
    SchedRT S; S.G = F.G; S.c = (int)blockIdx.x;
    EpiLG E{(float*)(F.ws + WS_LGP)};
    pg8::gemm_phase<EpiLG, SchedRT>(F.lds, g, S, E);
}
__device__ __forceinline__ void p12_topk(Frame& F) {
    const float* LGP = (const float*)(F.ws + WS_LGP); int* EIDX = (int*)(F.ws + WS_EIDX); float* EW = (float*)(F.ws + WS_EW); u32x2* LIST = (u32x2*)(F.ws + WS_LIST2);
    unsigned* CNT = (unsigned*)(F.ws + WS_CTL) + CW_CNT;
    const int gw = F.vcu * NWAVES + F.wave, NGW = F.G * NWAVES, lane = F.lane;
    const f32x4 bias = *(const f32x4*)(F.router_bias + 4 * lane);
    for (int t = gw; t < MLAT; t += NGW) {
        f32x4 lg = *(const f32x4*)(LGP + (size_t)t * NEXP + 4 * lane);
#pragma unroll
        for (int ks = 1; ks < 8; ++ks) lg += *(const f32x4*)(LGP + ((size_t)ks * MLAT + t) * NEXP + 4 * lane);
        float sc[4], sel[4];
#pragma unroll
        for (int i = 0; i < 4; ++i) { sc[i] = 1.0f / (1.0f + __expf(-lg[i])); sel[i] = sc[i] + bias[i]; }
        float a1 = fmaxf(sel[0], sel[1]), a2 = fminf(sel[0], sel[1]);
        { const float b1 = fmaxf(sel[2], sel[3]), b2 = fminf(sel[2], sel[3]); const float n1 = fmaxf(a1, b1), n2 = fmaxf(fminf(a1, b1), fmaxf(a2, b2)); a1 = n1; a2 = n2; }
#pragma unroll
        for (int off = 1; off < 8; off <<= 1) { const float b1 = __shfl_xor(a1, off), b2 = __shfl_xor(a2, off); const float n1 = fmaxf(a1, b1), n2 = fmaxf(fminf(a1, b1), fmaxf(a2, b2)); a1 = n1; a2 = n2; }
        const float gs = a1 + a2; const int g = lane >> 3;
        int rank = 0;
#pragma unroll
        for (int j = 0; j < 8; ++j) { const float o = __shfl(gs, 8 * j); rank += (o > gs || (o == gs && j < g)) ? 1 : 0; }
        const bool gsel = rank < 4;
        float ms[4];
#pragma unroll
        for (int i = 0; i < 4; ++i) ms[i] = gsel ? sel[i] : -INFINITY;
        float myw = 0.f; int mye = 0; float wsum = 0.f;
#pragma unroll
        for (int k = 0; k < TOPK; ++k) {
            float bv = ms[0]; int bi = 4 * lane;
#pragma unroll
            for (int i = 1; i < 4; ++i) if (ms[i] > bv) { bv = ms[i]; bi = 4 * lane + i; }
#pragma unroll
            for (int off = 1; off < 64; off <<= 1) { const float ov = __shfl_xor(bv, off); const int oi = __shfl_xor(bi, off); if (ov > bv || (ov == bv && oi < bi)) { bv = ov; bi = oi; } }
            const int ol = bi >> 2, oi = bi & 3;
            const float mysc = (oi == 0) ? sc[0] : (oi == 1) ? sc[1] : (oi == 2) ? sc[2] : sc[3];
            const float w = __shfl(mysc, ol);
            if (lane == ol) {
#pragma unroll
                for (int i = 0; i < 4; ++i) if (i == oi) ms[i] = -INFINITY; }
            wsum += w;
            if (lane == k) { myw = w; mye = bi; }
        }
        if (lane < TOPK) {
            const float wn = myw / wsum * 2.5f;
            EIDX[t * TOPK + lane] = mye; EW[t * TOPK + lane] = wn;
            const unsigned pos = atomicAdd(&CNT[mye], 1u);
            LIST[mye * MLAT + pos] = (u32x2){(unsigned)(t * TOPK + lane), __float_as_uint(wn)};
        }
    }
}
constexpr int EX_NSTG = 3, EX_ASTG = 24576, EX_WSTG = 16384, EX_A0 = 0, EX_W0 = EX_NSTG * EX_ASTG, EX_WH0 = EX_W0 + EX_NSTG * EX_WSTG, EX_WHS = 10240, EX_ROW0 = EX_WH0 + 2 * EX_WHS;
constexpr int EX_TAB0 = EX_ROW0 + 3200, EX_SCR0 = EX_TAB0 + 3072;
static_assert(EX_ROW0 == 143360 && EX_SCR0 + 8192 <= LDSCTL_OFF, "expert LDS map");
template <bool GU>
__device__ __forceinline__ void ring_w_prologue(Frame& F, const float* W, int cgrp) {
    constexpr int LDB = GU ? 512 : 2048;
    const int lane = F.lane, w = F.wave, v = 4 * (lane & 31);
    const int wcol0 = GU ? (((v >> 5) & 1) * 256 + 32 * (v >> 6) + (v & 31) + 64 * cgrp) : (v + 512 * cgrp);
    const float* wlane = W + (size_t)(4 * w + (lane >> 5)) * LDB + wcol0;
#pragma unroll
    for (int s = 0; s < 3; ++s)
#pragma unroll
        for (int j = 0; j < 2; ++j) __builtin_amdgcn_global_load_lds((const unsigned*)(wlane + (size_t)(s * 32 + 2 * j) * LDB), (LAS unsigned*)(F.lds + EX_W0 + s * EX_WSTG + (2 * w + j) * 1024), 16, 0, 2);
}
template <bool GU, int NLAY>
__device__ __forceinline__ void expert_ring(Frame& F, const float* W, const h16* Abase, const int (&arow)[3], int nr, int cgrp, h16* ACTrow0, h16* Y) {
    constexpr int KT = GU ? 64 : 8, NP = GU ? 1 : 4, LDB = GU ? 512 : 2048, NS = KT * NP;
    const int tid = F.tid, lane = F.lane, hi = lane >> 5, ln = lane & 31, cp = F.wave & 1, rg = F.wave >> 1, w = F.wave;
    const LAS int* RSLOT = (const LAS int*)(F.lds + EX_ROW0); const LAS float* RW = (const LAS float*)(F.lds + EX_ROW0 + 1536);
    const int ngrp = (nr + 15) >> 4;
    const int nA = (w < ngrp ? 1 : 0) + (w + 8 < ngrp ? 1 : 0) + (w + 16 < ngrp ? 1 : 0);
    const int achunk = ((lane & 3) ^ ((lane >> 4) & 3)) * 8;
    const int v = 4 * (lane & 31);
    const int wcol0 = GU ? (((v >> 5) & 1) * 256 + 32 * (v >> 6) + (v & 31) + 64 * cgrp) : (v + 512 * cgrp);
    const float* wlane = W + (size_t)(4 * w + (lane >> 5)) * LDB + wcol0;
    const unsigned lds0 = (unsigned)(uintptr_t)F.lds;
    const int xs = (ln >> 2) & 3;
    const unsigned aofs0 = (unsigned)((2 * rg + (ln >> 4)) * 1024 + (ln & 15) * 64 + ((hi ^ xs) * 16)), aofs1 = (unsigned)((2 * rg + (ln >> 4)) * 1024 + (ln & 15) * 64 + (((2 + hi) ^ xs) * 16));
    const unsigned tofs = (unsigned)((8 * hi + ((lane & 15) >> 2)) * 320 + (64 * cp + 16 * ((lane >> 4) & 1) + 4 * (lane & 3)) * 2);
    f32x16 acc[2 * NLAY];
#pragma unroll
    for (int i = 0; i < 2 * NLAY; ++i) acc[i] = (f32x16){};
#define EX_DMA_A(s) do { const int kt_ = (s) % KT, stg_ = (s) % EX_NSTG; \
        _Pragma("unroll") for (int j = 0; j < 3; ++j) if (j < nA) __builtin_amdgcn_global_load_lds((const unsigned*)(Abase + arow[j] + kt_ * 32 + achunk), (LAS unsigned*)(F.lds + EX_A0 + stg_ * EX_ASTG + (w + 8 * j) * 1024), 16, 0, 0); } while (0)
#define EX_DMA_W(s) do { const int pass_ = (s) / KT, kt_ = (s) % KT, stg_ = (s) % EX_NSTG; \
        _Pragma("unroll") for (int j = 0; j < 2; ++j) __builtin_amdgcn_global_load_lds((const unsigned*)(wlane + (size_t)(kt_ * 32 + 2 * j) * LDB + 128 * pass_), (LAS unsigned*)(F.lds + EX_W0 + stg_ * EX_WSTG + (2 * w + j) * 1024), 16, 0, 2); } while (0)
#define EX_WAITV(k) asm volatile("s_waitcnt vmcnt(" #k ")" ::: "memory")
#define EX_WAITN() do { if (nA == 3) EX_WAITV(5); else if (nA == 2) EX_WAITV(4); else if (nA == 1) EX_WAITV(3); else EX_WAITV(2); } while (0)
    const unsigned cvsrc = lds0 + EX_W0 + (tid >> 4) * 512 + (tid & 15) * 32, cvdst = lds0 + EX_WH0 + (tid >> 4) * 320 + (tid & 15) * 16;
    EX_DMA_A(0); EX_DMA_A(1);
    if (nA == 3) EX_WAITV(3); else if (nA == 2) EX_WAITV(2); else if (nA == 1) EX_WAITV(1); else EX_WAITV(0);
    __builtin_amdgcn_s_barrier(); asm volatile("" ::: "memory");
    { f32x4 c0, c1; asm volatile("ds_read_b128 %0, %2\n\tds_read_b128 %1, %2 offset:16\n\ts_waitcnt lgkmcnt(0)" : "=&v"(c0), "=&v"(c1) : "v"(cvsrc) : "memory");
      const h16x8 hv = pack8(c0[0], c0[1], c0[2], c0[3], c1[0], c1[1], c1[2], c1[3]); asm volatile("ds_write_b128 %0, %1" :: "v"(cvdst), "v"(hv) : "memory"); }
    typedef short s16x8 __attribute__((ext_vector_type(8)));
    for (int s = 0; s < NS; ++s) {
        if (s + 2 < NS) EX_WAITN(); else EX_WAITV(0);
        asm volatile("s_waitcnt lgkmcnt(0)" ::: "memory");
        __builtin_amdgcn_s_barrier();
        asm volatile("" ::: "memory");
        const bool pend = ((s % KT) == KT - 1);
        if (!pend) { if (s + 2 < NS) EX_DMA_A(s + 2); if (s + 3 < NS) EX_DMA_W(s + 3); }
        const unsigned abase = lds0 + EX_A0 + (s % EX_NSTG) * EX_ASTG, wbase = lds0 + EX_WH0 + (s & 1) * EX_WHS + tofs;
        const unsigned cs = cvsrc + ((s + 1) % EX_NSTG) * EX_WSTG;
        const unsigned pa0 = abase + aofs0, pa1 = abase + aofs1;
        if constexpr (NLAY < 3) {
            v4i16_t t0, t1, t2, t3, t4, t5, t6, t7; h16x8 a0[NLAY], a1[NLAY];
            asm volatile("ds_read_b64_tr_b16 %0, %8\n\tds_read_b64_tr_b16 %1, %8 offset:1280\n\tds_read_b64_tr_b16 %2, %8 offset:64\n\tds_read_b64_tr_b16 %3, %8 offset:1344\n\t"
                         "ds_read_b64_tr_b16 %4, %8 offset:5120\n\tds_read_b64_tr_b16 %5, %8 offset:6400\n\tds_read_b64_tr_b16 %6, %8 offset:5184\n\tds_read_b64_tr_b16 %7, %8 offset:6464"
                         : "=&v"(t0), "=&v"(t1), "=&v"(t2), "=&v"(t3), "=&v"(t4), "=&v"(t5), "=&v"(t6), "=&v"(t7) : "v"(wbase) : "memory");
            asm volatile("ds_read_b128 %0, %2\n\tds_read_b128 %1, %3" : "=&v"(a0[0]), "=&v"(a1[0]) : "v"(pa0), "v"(pa1) : "memory");
            if constexpr (NLAY >= 2) asm volatile("ds_read_b128 %0, %2 offset:8192\n\tds_read_b128 %1, %3 offset:8192" : "=&v"(a0[1]), "=&v"(a1[1]) : "v"(pa0), "v"(pa1) : "memory");
            asm volatile("s_waitcnt lgkmcnt(0)" ::: "memory");
            __builtin_amdgcn_sched_barrier(0);
            const h16x8 b00 = __builtin_bit_cast(h16x8, (s16x8){t0[0], t0[1], t0[2], t0[3], t1[0], t1[1], t1[2], t1[3]}), b01 = __builtin_bit_cast(h16x8, (s16x8){t2[0], t2[1], t2[2], t2[3], t3[0], t3[1], t3[2], t3[3]});
            const h16x8 b10 = __builtin_bit_cast(h16x8, (s16x8){t4[0], t4[1], t4[2], t4[3], t5[0], t5[1], t5[2], t5[3]}), b11 = __builtin_bit_cast(h16x8, (s16x8){t6[0], t6[1], t6[2], t6[3], t7[0], t7[1], t7[2], t7[3]});
#pragma unroll
            for (int i = 0; i < NLAY; ++i) { acc[2 * i] = MFMA32(a0[i], b00, acc[2 * i]); acc[2 * i + 1] = MFMA32(a0[i], b01, acc[2 * i + 1]); }
#pragma unroll
            for (int i = 0; i < NLAY; ++i) { acc[2 * i] = MFMA32(a1[i], b10, acc[2 * i]); acc[2 * i + 1] = MFMA32(a1[i], b11, acc[2 * i + 1]); }
        } else {
#pragma unroll
            for (int k16 = 0; k16 < 2; ++k16) {
                v4i16_t t0, t1, t2, t3; h16x8 a[3]; const unsigned pa = k16 ? pa1 : pa0, pw = wbase + k16 * 5120;
                asm volatile("ds_read_b64_tr_b16 %0, %4\n\tds_read_b64_tr_b16 %1, %4 offset:1280\n\tds_read_b64_tr_b16 %2, %4 offset:64\n\tds_read_b64_tr_b16 %3, %4 offset:1344"
                             : "=&v"(t0), "=&v"(t1), "=&v"(t2), "=&v"(t3) : "v"(pw) : "memory");
                asm volatile("ds_read_b128 %0, %3\n\tds_read_b128 %1, %3 offset:8192\n\tds_read_b128 %2, %3 offset:16384\n\ts_waitcnt lgkmcnt(0)" : "=&v"(a[0]), "=&v"(a[1]), "=&v"(a[2]) : "v"(pa) : "memory");
                __builtin_amdgcn_sched_barrier(0);
                const h16x8 b0 = __builtin_bit_cast(h16x8, (s16x8){t0[0], t0[1], t0[2], t0[3], t1[0], t1[1], t1[2], t1[3]}), b1 = __builtin_bit_cast(h16x8, (s16x8){t2[0], t2[1], t2[2], t2[3], t3[0], t3[1], t3[2], t3[3]});
#pragma unroll
                for (int i = 0; i < 3; ++i) { acc[2 * i] = MFMA32(a[i], b0, acc[2 * i]); acc[2 * i + 1] = MFMA32(a[i], b1, acc[2 * i + 1]); }
                __builtin_amdgcn_sched_barrier(0);
            }
        }
        if (s + 1 < NS) {
            f32x4 c0, c1; asm volatile("ds_read_b128 %0, %2\n\tds_read_b128 %1, %2 offset:16\n\ts_waitcnt lgkmcnt(0)" : "=&v"(c0), "=&v"(c1) : "v"(cs) : "memory");
            const h16x8 hv = pack8(c0[0], c0[1], c0[2], c0[3], c1[0], c1[1], c1[2], c1[3]); const unsigned cd = cvdst + ((s + 1) & 1) * EX_WHS; asm volatile("ds_write_b128 %0, %1" :: "v"(cd), "v"(hv) : "memory"); }
        if (pend) {
            const int pass = s / KT;
            int hio = hi, lno = ln; asm volatile("" : "+v"(hio), "+v"(lno));
            if (GU) {
#pragma unroll
                for (int i = 0; i < NLAY; ++i) { const int rt = rg + 4 * i;
#pragma unroll
                    for (int r = 0; r < 16; ++r) { const int row = 32 * rt + crow(r, hio);
                        if (row < nr) ACTrow0[(size_t)row * DEXP + 64 * cgrp + 32 * cp + lno] = (h16)(silu_f(acc[2 * i][r]) * acc[2 * i + 1][r]); }
                    acc[2 * i] = (f32x16){}; acc[2 * i + 1] = (f32x16){}; }
            } else {
                const unsigned scr = lds0 + EX_SCR0 + w * 1024;
                unsigned char* Y8 = (unsigned char*)Y;
#pragma unroll
                for (int i = 0; i < NLAY; ++i) { const int rt = rg + 4 * i;
#pragma unroll
                    for (int g8 = 0; g8 < 4; ++g8) {
#pragma unroll
                        for (int q = 0; q < 4; ++q) { const int lr = 4 * hio + q; const float wt = RW[32 * rt + 8 * g8 + lr];
                            const int pk = __builtin_amdgcn_cvt_pk_fp8_f32(acc[2 * i][4 * g8 + q] * wt, acc[2 * i + 1][4 * g8 + q] * wt, 0, false); const int pk1 = pk >> 8; const unsigned wa = scr + lr * 64 + lno;
                            asm volatile("ds_write_b8 %0, %1\n\tds_write_b8 %0, %2 offset:32" :: "v"(wa), "v"(pk), "v"(pk1) : "memory"); }
                        u32x2 pv; const unsigned ra = scr + (lane >> 3) * 64 + (lane & 7) * 8;
                        asm volatile("s_waitcnt lgkmcnt(0)\n\tds_read_b64 %0, %1\n\ts_waitcnt lgkmcnt(0)" : "=&v"(pv) : "v"(ra) : "memory");
                        const int grow = 32 * rt + 8 * g8 + (lane >> 3);
                        if (grow < nr) { const int slot = RSLOT[grow]; *(u32x2*)(Y8 + (size_t)slot * DM + 512 * cgrp + 128 * pass + 64 * cp + (lane & 7) * 8) = pv; }
                    }
                    acc[2 * i] = (f32x16){}; acc[2 * i + 1] = (f32x16){}; }
            }
            if (s + 2 < NS) EX_DMA_A(s + 2);
            if (s + 3 < NS) EX_DMA_W(s + 3);
        }
    }
    asm volatile("s_waitcnt vmcnt(0) lgkmcnt(0)" ::: "memory");
    __builtin_amdgcn_s_barrier();
    asm volatile("" ::: "memory");
#undef EX_DMA_A
#undef EX_DMA_W
#undef EX_WAITV
#undef EX_WAITN
}

constexpr int G8_NSTG = 4, G8_ASTG = 12288, G8_WSTG = 16384, G8_A0 = 0, G8_W0 = G8_NSTG * G8_ASTG, G8_WH0 = G8_W0 + G8_NSTG * G8_WSTG, G8_WHS = 4096;
static_assert(G8_WH0 + 2 * G8_WHS <= EX_ROW0, "gu8 LDS map");
__device__ __forceinline__ void gu8_w_prologue(Frame& F, const float* W, int cgrp) {
    const int lane = F.lane, w = F.wave, v = 4 * (lane & 31);
    const int wcol0 = ((v >> 5) & 1) * 256 + 32 * (v >> 6) + (v & 31) + 64 * cgrp;
    const float* wlane = W + (size_t)(4 * w + (lane >> 5)) * 512 + wcol0;
#pragma unroll
    for (int s = 0; s < 4; ++s)
#pragma unroll
        for (int j = 0; j < 2; ++j) __builtin_amdgcn_global_load_lds((const unsigned*)(wlane + (size_t)(s * 32 + 2 * j) * 512), (LAS unsigned*)(F.lds + G8_W0 + s * G8_WSTG + (2 * w + j) * 1024), 16, 0, 2);
}
template <int NLAY>
__device__ __forceinline__ void expert_ring_gu8(Frame& F, const float* W, const unsigned char* A8, const int (&arow)[2], int nr, int cgrp, h16* ACTrow0) {
    constexpr int NS = 64;
    typedef long v2i64 __attribute__((ext_vector_type(2)));
    const int tid = F.tid, lane = F.lane, hi = lane >> 5, ln = lane & 31, cp = F.wave & 1, rg = F.wave >> 1, w = F.wave;
    const int ngrp = (nr + 31) >> 5;
    const int nA = (w < ngrp ? 1 : 0) + (w + 8 < ngrp ? 1 : 0);
    const int v = 4 * (lane & 31);
    const int wcol0 = ((v >> 5) & 1) * 256 + 32 * (v >> 6) + (v & 31) + 64 * cgrp;
    const float* wlane = W + (size_t)(4 * w + (lane >> 5)) * 512 + wcol0;
    const unsigned lds0 = (unsigned)(uintptr_t)F.lds;
    const unsigned aofs = (unsigned)(rg * 1024 + ln * 32 + hi * 16);
    const unsigned bofs = (unsigned)((64 * cp + ln) * 32 + hi * 16);
    const unsigned cvsrc = lds0 + G8_W0 + (tid >> 7) * 8 * 512 + (tid & 127) * 4, cvdst = lds0 + G8_WH0 + (tid & 127) * 32 + (tid >> 7) * 8;
    f32x16 acc[2 * NLAY];
#pragma unroll
    for (int i = 0; i < 2 * NLAY; ++i) acc[i] = (f32x16){};
#define G8_DMA_A(s) do { const int stg_ = (s) & 3; \
        _Pragma("unroll") for (int j = 0; j < 2; ++j) if (j < nA) __builtin_amdgcn_global_load_lds((const unsigned*)(A8 + arow[j] + (s) * 32 + (lane & 1) * 16), (LAS unsigned*)(F.lds + G8_A0 + stg_ * G8_ASTG + (w + 8 * j) * 1024), 16, 0, 0); } while (0)
#define G8_DMA_W(s) do { const int stg_ = (s) & 3; \
        _Pragma("unroll") for (int j = 0; j < 2; ++j) __builtin_amdgcn_global_load_lds((const unsigned*)(wlane + (size_t)((s) * 32 + 2 * j) * 512), (LAS unsigned*)(F.lds + G8_W0 + stg_ * G8_WSTG + (2 * w + j) * 1024), 16, 0, 2); } while (0)
#define G8_WAITV(k) asm volatile("s_waitcnt vmcnt(" #k ")" ::: "memory")
#define G8_CVT(s) do { float c_[8]; const unsigned cs_ = cvsrc + ((s) & 3) * G8_WSTG; \
        asm volatile("ds_read_b32 %0, %8\n\tds_read_b32 %1, %8 offset:512\n\tds_read_b32 %2, %8 offset:1024\n\tds_read_b32 %3, %8 offset:1536\n\tds_read_b32 %4, %8 offset:2048\n\tds_read_b32 %5, %8 offset:2560\n\tds_read_b32 %6, %8 offset:3072\n\tds_read_b32 %7, %8 offset:3584\n\ts_waitcnt lgkmcnt(0)" \
                     : "=&v"(c_[0]), "=&v"(c_[1]), "=&v"(c_[2]), "=&v"(c_[3]), "=&v"(c_[4]), "=&v"(c_[5]), "=&v"(c_[6]), "=&v"(c_[7]) : "v"(cs_) : "memory"); \
        int p0_ = __builtin_amdgcn_cvt_pk_fp8_f32(c_[0] * 64.f, c_[1] * 64.f, 0, false); p0_ = __builtin_amdgcn_cvt_pk_fp8_f32(c_[2] * 64.f, c_[3] * 64.f, p0_, true); \
        int p1_ = __builtin_amdgcn_cvt_pk_fp8_f32(c_[4] * 64.f, c_[5] * 64.f, 0, false); p1_ = __builtin_amdgcn_cvt_pk_fp8_f32(c_[6] * 64.f, c_[7] * 64.f, p1_, true); \
        const u32x2 pk_ = {(unsigned)p0_, (unsigned)p1_}; const unsigned cd_ = cvdst + ((s) & 1) * G8_WHS; asm volatile("ds_write_b64 %0, %1" :: "v"(cd_), "v"(pk_) : "memory"); } while (0)
    G8_DMA_A(0); G8_DMA_A(1); G8_DMA_A(2);
    if (nA == 2) G8_WAITV(4); else if (nA == 1) G8_WAITV(2); else G8_WAITV(0);
    __builtin_amdgcn_s_barrier(); asm volatile("" ::: "memory");
    G8_CVT(0);
    for (int s = 0; s < NS; ++s) {
        if (s >= 2 && s + 4 < NS) { if (nA == 2) G8_WAITV(8); else if (nA == 1) G8_WAITV(6); else G8_WAITV(4); }
        else if (s < 2) { if (nA == 2) G8_WAITV(4); else if (nA == 1) G8_WAITV(3); else G8_WAITV(2); }
        else G8_WAITV(0);
        asm volatile("s_waitcnt lgkmcnt(0)" ::: "memory");
        __builtin_amdgcn_s_barrier();
        asm volatile("" ::: "memory");
        if (s + 3 < NS) G8_DMA_A(s + 3);
        if (s + 4 < NS) G8_DMA_W(s + 4);
        const unsigned pa = lds0 + G8_A0 + (s & 3) * G8_ASTG + aofs, pb = lds0 + G8_WH0 + (s & 1) * G8_WHS + bofs;
        v2i64 a[NLAY], b0, b1;
        asm volatile("ds_read_b128 %0, %2\n\tds_read_b128 %1, %2 offset:1024" : "=&v"(b0), "=&v"(b1) : "v"(pb) : "memory");
        asm volatile("ds_read_b128 %0, %1" : "=&v"(a[0]) : "v"(pa) : "memory");
        if constexpr (NLAY >= 2) asm volatile("ds_read_b128 %0, %1 offset:4096" : "=&v"(a[1]) : "v"(pa) : "memory");
        if constexpr (NLAY >= 3) asm volatile("ds_read_b128 %0, %1 offset:8192" : "=&v"(a[2]) : "v"(pa) : "memory");
        asm volatile("s_waitcnt lgkmcnt(0)" ::: "memory");
        __builtin_amdgcn_sched_barrier(0);
#pragma unroll
        for (int i = 0; i < NLAY; ++i) { acc[2 * i] = __builtin_amdgcn_mfma_f32_32x32x16_fp8_fp8(a[i][0], b0[0], acc[2 * i], 0, 0, 0); acc[2 * i + 1] = __builtin_amdgcn_mfma_f32_32x32x16_fp8_fp8(a[i][0], b1[0], acc[2 * i + 1], 0, 0, 0); }
#pragma unroll
        for (int i = 0; i < NLAY; ++i) { acc[2 * i] = __builtin_amdgcn_mfma_f32_32x32x16_fp8_fp8(a[i][1], b0[1], acc[2 * i], 0, 0, 0); acc[2 * i + 1] = __builtin_amdgcn_mfma_f32_32x32x16_fp8_fp8(a[i][1], b1[1], acc[2 * i + 1], 0, 0, 0); }
        if (s + 1 < NS) G8_CVT(s + 1);
    }
    {
        int hio = hi, lno = ln; asm volatile("" : "+v"(hio), "+v"(lno));
#pragma unroll
        for (int i = 0; i < NLAY; ++i) { const int rt = rg + 4 * i;
#pragma unroll
            for (int r = 0; r < 16; ++r) { const int row = 32 * rt + crow(r, hio);
                if (row < nr) ACTrow0[(size_t)row * DEXP + 64 * cgrp + 32 * cp + lno] = (h16)(silu_f(acc[2 * i][r] * 0.015625f) * (acc[2 * i + 1][r] * 0.015625f)); } }
    }
    asm volatile("s_waitcnt vmcnt(0) lgkmcnt(0)" ::: "memory");
    __builtin_amdgcn_s_barrier();
    asm volatile("" ::: "memory");
#undef G8_DMA_A
#undef G8_DMA_W
#undef G8_WAITV
#undef G8_CVT
}
template <bool GU>
__device__ __forceinline__ void p13_expert_phase(Frame& F, int qid) {
    const h16* H2X = (const h16*)(F.ws + WS_H2X); h16* Y = (h16*)(F.ws + WS_Y); h16* ACT = (h16*)(F.ws + WS_ACT);
    const unsigned* CNT = (const unsigned*)(F.ws + WS_CTL) + CW_CNT; unsigned* QH = (unsigned*)(F.ws + WS_CTL) + CW_Q + 64 * qid;
    LAS int* RSLOT = (LAS int*)(F.lds + EX_ROW0); LAS float* RW = (LAS float*)(F.lds + EX_ROW0 + 1536); LAS int* RED = (LAS int*)(F.lds + EX_ROW0 + 3072);
    LAS int* CN = (LAS int*)(F.lds + EX_TAB0); LAS int* ORD = CN + 256; LAS int* OFF = CN + 512;
    __syncthreads();
    if (F.tid < NEXP) CN[F.tid] = (int)CNT[F.tid];
    __syncthreads();
    if (F.tid < NEXP) { const int c = CN[F.tid]; int rank = 0, off = 0;
        for (int j = 0; j < NEXP; ++j) { const int cj = CN[j]; rank += (cj > c || (cj == c && j < F.tid)) ? 1 : 0; off += (j < F.tid) ? cj : 0; }
        ORD[rank] = F.tid; OFF[F.tid] = off; }
    __syncthreads();
    const u32x2* LIST2 = (const u32x2*)(F.ws + WS_LIST2);
    if (F.tid == 0) RED[0] = (int)__hip_atomic_fetch_add(QH, 1u, __ATOMIC_RELAXED, __HIP_MEMORY_SCOPE_AGENT);
    __syncthreads();
    int u = RED[0];
    while (u < NEXP * 4) {
        const int e = ORD[u >> 2], cg = u & 3, cnt = CN[e], off_e = OFF[e];
        const float* Wgu = F.w_exp_gu + (size_t)e * DM * 512; const float* Wdn = F.w_exp_down + (size_t)e * DEXP * DM;
        for (int rs = 0; rs < cnt; rs += 384) {
            const int nr = (cnt - rs) < 384 ? (cnt - rs) : 384;
            __syncthreads();
            if (GU) gu8_w_prologue(F, Wgu, cg); else ring_w_prologue<false>(F, Wdn, cg);
            if (F.tid < 384) { u32x2 ent = {0u, 0u}; if (F.tid < nr) ent = LIST2[e * MLAT + rs + F.tid]; RSLOT[F.tid] = (int)ent.x; RW[F.tid] = __uint_as_float(ent.y); }
            __syncthreads();
            h16* ACTrow0 = ACT + (size_t)(off_e + rs) * DEXP;
            int arow[3];
            if (GU) {
                int ar8[2];
#pragma unroll
                for (int j = 0; j < 2; ++j) { const int r = 32 * (F.wave + 8 * j) + (F.lane >> 1); ar8[j] = (r < 384 ? (RSLOT[r] >> 3) : 0) * DM; }
                const unsigned char* A8 = (const unsigned char*)(F.ws + WS_H2F8);
                if (nr > 256) expert_ring_gu8<3>(F, Wgu, A8, ar8, nr, cg, ACTrow0); else if (nr > 128) expert_ring_gu8<2>(F, Wgu, A8, ar8, nr, cg, ACTrow0); else expert_ring_gu8<1>(F, Wgu, A8, ar8, nr, cg, ACTrow0);
            } else {
#pragma unroll
                for (int j = 0; j < 3; ++j) { const int r = 16 * (F.wave + 8 * j) + (F.lane >> 2); arow[j] = ((r < nr) ? r : 0) * DEXP; }
                if (nr > 256) expert_ring<false, 3>(F, Wdn, ACTrow0, arow, nr, cg, ACTrow0, Y); else if (nr > 128) expert_ring<false, 2>(F, Wdn, ACTrow0, arow, nr, cg, ACTrow0, Y); else expert_ring<false, 1>(F, Wdn, ACTrow0, arow, nr, cg, ACTrow0, Y);
            }
        }
        __syncthreads();
        if (F.tid == 0) RED[0] = (int)__hip_atomic_fetch_add(QH, 1u, __ATOMIC_RELAXED, __HIP_MEMORY_SCOPE_AGENT);
        __syncthreads();
        u = RED[0];
    }
}
struct SchedSG {
    int G, c;
    __device__ __forceinline__ bool next(int i, pg8::Unit& u) const { const int L = i * G + c; if (L >= 256) return false; u.pm = L >> 3; u.pn = (L >> 2) & 1; u.ko = (L & 3) * 512; u.nt = 0; u.keep = 0; return true; }
};
struct EpiSGP {
    float* SGP;
    __device__ __forceinline__ void operator()(f32x4 (&acc)[2][2][4][2], const pg8::Unit& u, int wr, int wc, int fr, int fq) const {
        float* dst = SGP + (size_t)(u.ko / 512) * MLAT * 512;
#pragma unroll
        for (int ai = 0; ai < 2; ++ai)
#pragma unroll
            for (int m = 0; m < 4; ++m) { const int row = u.pm * 256 + ai * 128 + wr * 64 + m * 16 + fr;
#pragma unroll
                for (int bj = 0; bj < 2; ++bj)
#pragma unroll
                    for (int n = 0; n < 2; ++n) { const int col = u.pn * 256 + bj * 128 + wc * 32 + 16 * n + 4 * fq; *(f32x4*)(dst + (size_t)row * 512 + col) = acc[ai][bj][m][n]; } }
    }
};
__device__ __forceinline__ void p11b_shared_gu(Frame& F) {
    pg8::Gemm g{(const h16*)(F.ws + WS_H2X), (const h16*)(F.ws + WS_WSGU), 6144, 2048, 512};
    SchedSG S; S.G = F.G; S.c = (int)blockIdx.x;
    EpiSGP E{(float*)(F.ws + WS_SGP)};
    pg8::gemm_phase<EpiSGP, SchedSG>(F.lds, g, S, E);
}
__device__ __forceinline__ void p12b_shared_act(Frame& F) {
    const float* SGP = (const float*)(F.ws + WS_SGP); h16* ACTS = (h16*)(F.ws + WS_ACTS);
    for (int q = blockIdx.x * NTHR + F.tid; q < MLAT * 64; q += F.G * NTHR) {
        const int row = q >> 6, j = (q & 63) * 4, pg = 32 * (j >> 4) + (j & 15);
        f32x4 gv = {0.f, 0.f, 0.f, 0.f}, uv = gv;
#pragma unroll
        for (int ks = 0; ks < 4; ++ks) { const float* p = SGP + ((size_t)ks * MLAT + row) * 512 + pg; gv += *(const f32x4*)p; uv += *(const f32x4*)(p + 16); }
        u32x2 w; w.x = pk2h(silu_f(gv[0]) * uv[0], silu_f(gv[1]) * uv[1]); w.y = pk2h(silu_f(gv[2]) * uv[2], silu_f(gv[3]) * uv[3]);
        *(u32x2*)(ACTS + (size_t)row * DEXP + j) = w;
    }
}
struct EpiYsh {
    h16* YSH;
    __device__ __forceinline__ void operator()(f32x4 (&acc)[2][2][4][2], const pg8::Unit& u, int wr, int wc, int fr, int fq) const {
#pragma unroll
        for (int ai = 0; ai < 2; ++ai)
#pragma unroll
            for (int m = 0; m < 4; ++m) { const int row = u.pm * 256 + ai * 128 + wr * 64 + m * 16 + fr;
#pragma unroll
                for (int bj = 0; bj < 2; ++bj)
#pragma unroll
                    for (int n = 0; n < 2; ++n) { const int col = u.pn * 256 + bj * 128 + wc * 32 + 16 * n + 4 * fq; const f32x4 a = acc[ai][bj][m][n];
                        u32x2 w; w.x = pk2h(a[0], a[1]); w.y = pk2h(a[2], a[3]); *(u32x2*)(YSH + (size_t)row * DM + col) = w; } }
    }
};
__device__ __forceinline__ void p15_shared_down(Frame& F) {
    pg8::Gemm g{(const h16*)(F.ws + WS_ACTS), (const h16*)(F.ws + WS_WSDN), 256, 256, 256};
    pg8::StaticOrder S; S.init(MLAT, DM, F.G, (int)blockIdx.x);
    EpiYsh E{(h16*)(F.ws + WS_YSH)};
    pg8::gemm_phase<EpiYsh, pg8::StaticOrder>(F.lds, g, S, E);
}
__device__ __forceinline__ void p16_combine(Frame& F) {
    const float* X1 = (const float*)(F.ws + WS_X1); const float* MOD = (const float*)(F.ws + WS_MOD); const h16* Y = (const h16*)(F.ws + WS_Y); const h16* YSH = (const h16*)(F.ws + WS_YSH);
    const int gw = F.vcu * NWAVES + F.wave, NGW = F.G * NWAVES;
    for (int r = gw; r < MLAT; r += NGW) {
        const int b = r / SEQ;
        f32x4 xv[8]; float ss = 0.f;
#pragma unroll
        for (int j = 0; j < 8; ++j) { const int cc = 4 * F.lane + 256 * j;
            f32x4 m = {0.f, 0.f, 0.f, 0.f};
#pragma unroll
            for (int k = 0; k < TOPK; ++k) { const int yv = *(const int*)((const unsigned char*)Y + (size_t)(r * TOPK + k) * DM + cc);
                const f32x2 lo = __builtin_amdgcn_cvt_pk_f32_fp8(yv, false), hi2 = __builtin_amdgcn_cvt_pk_f32_fp8(yv, true); m += (f32x4){lo[0], lo[1], hi2[0], hi2[1]}; }
            { const h16x4 yv = *(const h16x4*)(YSH + (size_t)r * DM + cc); m += (f32x4){(float)yv[0], (float)yv[1], (float)yv[2], (float)yv[3]}; }
            const f32x4 g2 = *(const f32x4*)(MOD + (size_t)b * (6 * DM) + 5 * DM + cc);
            xv[j] = *(const f32x4*)(X1 + (size_t)r * DM + cc) + g2 * m;
            ss += (xv[j].x * xv[j].x + xv[j].y * xv[j].y) + (xv[j].z * xv[j].z + xv[j].w * xv[j].w); }
        const float rstd = 1.0f / sqrtf(wave_sum(ss) * (1.0f / DM) + EPS);
#pragma unroll
        for (int j = 0; j < 8; ++j) { const int cc = 4 * F.lane + 256 * j; const f32x4 nw = *(const f32x4*)(F.final_norm + cc);
            *(f32x4*)(F.out + (size_t)r * DM + cc) = xv[j] * rstd * nw; }
    }
}

__device__ __forceinline__ void p_final_plain(Frame& F, const float* xin) {
    const int gw = F.vcu * NWAVES + F.wave, NGW = F.G * NWAVES;
    for (int r = gw; r < MLAT; r += NGW) {
        const float* src = xin + (size_t)r * DM;
        f32x4 xv[8]; float ss = 0.f;
#pragma unroll
        for (int j = 0; j < 8; ++j) { xv[j] = *(const f32x4*)(src + 4 * F.lane + 256 * j); ss += (xv[j].x * xv[j].x + xv[j].y * xv[j].y) + (xv[j].z * xv[j].z + xv[j].w * xv[j].w); }
        const float rstd = 1.0f / sqrtf(wave_sum(ss) * (1.0f / DM) + EPS);
#pragma unroll
        for (int j = 0; j < 8; ++j) { const int cc = 4 * F.lane + 256 * j; const f32x4 nw = *(const f32x4*)(F.final_norm + cc);
            *(f32x4*)(F.out + (size_t)r * DM + cc) = xv[j] * rstd * nw; }
    }
}

constexpr int N_PHASES = 15;
#ifndef DUP_PHASE
#define DUP_PHASE -1
#endif
#ifndef DUP_VAR
#define DUP_VAR 7
#endif
struct Args { const float* in[22]; float* out; unsigned char* ws; int ph_lo, ph_hi; };
__global__ void __launch_bounds__(NTHR, 2) mk_fwd(Args args) {
    extern __shared__ __attribute__((aligned(16))) unsigned char lds_raw[];
    Frame F;
    F.lds = (LAS unsigned char*)lds_raw;
    F.tid = threadIdx.x; F.lane = F.tid & 63; F.wave = __builtin_amdgcn_readfirstlane(F.tid >> 6);
    F.G = gridDim.x; { const int bx = blockIdx.x; F.vcu = (F.G % 8 == 0) ? (bx % 8) * (F.G / 8) + bx / 8 : bx; }
    F.x = args.in[0]; F.c = args.in[1]; F.ctx = args.in[2]; F.c_ctx = args.in[3]; F.w_mod = args.in[4]; F.b_mod = args.in[5]; F.norm_attn = args.in[6]; F.norm_ffn = args.in[7];
    F.w_in = args.in[8]; F.ret_decay = args.in[9]; F.diff_lambda = args.in[10]; F.diff_subln = args.in[11]; F.w_ret_o = args.in[12]; F.w_diff_o = args.in[13]; F.w_out = args.in[14];
    F.w_router = args.in[15]; F.router_bias = args.in[16]; F.w_exp_gu = args.in[17]; F.w_exp_down = args.in[18]; F.w_sh_gu = args.in[19]; F.w_sh_down = args.in[20]; F.final_norm = args.in[21];
    F.out = args.out; F.ws = args.ws;
    volatile LAS unsigned* MISC = (volatile LAS unsigned*)(F.lds + LDSCTL_OFF);
    for (int u = F.tid; u < (LDS_BYTES - LDSCTL_OFF) / 4; u += NTHR) ((LAS unsigned*)(F.lds + LDSCTL_OFF))[u] = 0u;
    __syncthreads();
    const int lo = args.ph_lo, hi = args.ph_hi;
    const bool multi = (hi - lo) > 1;
    XcdBarrier bar; bar.bar = (unsigned*)(F.ws + WS_CTL) + CW_BAR; bar.x = 0; bar.st = nullptr;
    if (multi) bar = xcd_barrier_post((unsigned*)(F.ws + WS_CTL) + CW_BAR, MISC + 8);
#define IN(k) (lo <= (k) && (k) < hi)
#define SEAM(k) do { if (IN(k) && IN((k) + 1)) xcd_barrier(bar); } while (0)

#define RUNP(k, call) do { if (IN(k)) { call; if (DUP_PHASE == (k)) { xcd_barrier(bar); call; } } SEAM(k); } while (0)
    RUNP(0, p0a_mod(F));
    RUNP(1, (p1_norm1(F), p0b_weights(F)));
    RUNP(2, p2_gemm1(F));
    RUNP(3, p3_ret_local(F));
    RUNP(4, p4_ret_scan(F));
    RUNP(5, p5_ret_out(F));
    RUNP(6, p6_attn(F));
    RUNP(7, p7_gemm2(F));
    RUNP(8, p9_gemm3(F));
    RUNP(9, p10_norm2(F));
    RUNP(10, (p11_router(F), p11b_shared_gu(F)));
    RUNP(11, (p12_topk(F), p12b_shared_act(F)));
    if (IN(12)) { p13_expert_phase<true>(F, 0); if (DUP_PHASE == 12) { xcd_barrier(bar); p13_expert_phase<true>(F, 2); } } SEAM(12);
    if (IN(13)) { p15_shared_down(F); p13_expert_phase<false>(F, 1); if (DUP_PHASE == 13) { xcd_barrier(bar); p13_expert_phase<false>(F, 3); } } SEAM(13);
    if (IN(14)) { p16_combine(F); }
#undef RUNP
#undef IN
#undef SEAM
}

constexpr bool ONE_LAUNCH = true;
extern "C" void kernel_launch(void* const* d_in, const int* in_sizes, int n_in, void* d_out, int out_size, void* d_ws, size_t ws_size, hipStream_t stream) {
    static int grid = 0;
    if (grid == 0) {
        if (n_in != 22 || out_size != MLAT * DM || ws_size < WS_END) { fprintf(stderr, "kernel_launch: unexpected sizes n_in %d out %d ws %zu\n", n_in, out_size, ws_size); grid = -1; return; }
        int dev = 0, cus = 0;
        if (hipGetDevice(&dev) != hipSuccess || hipDeviceGetAttribute(&cus, hipDeviceAttributeMultiprocessorCount, dev) != hipSuccess) { grid = -1; return; }
        if (hipFuncSetAttribute((const void*)mk_fwd, hipFuncAttributeMaxDynamicSharedMemorySize, LDS_BYTES) != hipSuccess) { fprintf(stderr, "kernel_launch: hipFuncSetAttribute failed\n"); grid = -1; return; }
        int per_cu = 0;
        if (hipOccupancyMaxActiveBlocksPerMultiprocessor(&per_cu, (const void*)mk_fwd, NTHR, LDS_BYTES) != hipSuccess || per_cu < 1) fprintf(stderr, "kernel_launch: occupancy query reports %d\n", per_cu);
        (void)hipGetLastError();
        grid = cus;
    }
    if (grid < 0) return;
    (void)hipMemsetAsync((char*)d_ws + WS_CTL, 0, CTL_ZERO_BYTES, stream);
    Args a{};
    for (int i = 0; i < 22; ++i) a.in[i] = (const float*)d_in[i];
    a.out = (float*)d_out; a.ws = (unsigned char*)d_ws;
    if (ONE_LAUNCH) {
        a.ph_lo = 0; a.ph_hi = N_PHASES;
        hipLaunchKernelGGL(mk_fwd, dim3(grid), dim3(NTHR), LDS_BYTES, stream, a);
    } else {
        for (int p = 0; p < N_PHASES; ++p) { a.ph_lo = p; a.ph_hi = p + 1; hipLaunchKernelGGL(mk_fwd, dim3(grid), dim3(NTHR), LDS_BYTES, stream, a); }
    }
}
```

```cpp
#include <hip/hip_runtime.h>
#include <cstdio>
#include <cstdint>

#define LAS __attribute__((address_space(3)))
#define GAS __attribute__((address_space(1)))
typedef _Float16 h16;
typedef _Float16 h16x8 __attribute__((ext_vector_type(8)));
typedef _Float16 h16x4 __attribute__((ext_vector_type(4)));
typedef _Float16 h16x2 __attribute__((ext_vector_type(2)));
typedef float f32x2 __attribute__((ext_vector_type(2)));
typedef float f32x4 __attribute__((ext_vector_type(4)));
typedef float f32x16 __attribute__((ext_vector_type(16)));
typedef unsigned u32x4 __attribute__((ext_vector_type(4)));
typedef unsigned u32x2 __attribute__((ext_vector_type(2)));
typedef short v4i16_t __attribute__((ext_vector_type(4)));

constexpr int DM = 2048, NBATCH = 2, SEQ = 4096, CTXL = 256;
constexpr int MLAT = NBATCH * SEQ, MCTX = NBATCH * CTXL, MALL = MLAT + MCTX;
constexpr int IN_COLS = 13312, KV_COLS = 5120;
constexpr int C_RK = 0, C_RV = 1024, C_DK = 3072, C_DV = 4096, C_RQ = 5120, C_RG = 6144, C_DQ = 8192, C_GR = 9216, C_GD = 11264;
constexpr int NEXP = 256, TOPK = 8, DEXP = 256;
constexpr float EPS = 1e-6f;
constexpr int NWAVES = 8, NTHR = 512;

constexpr size_t MiB = 1u << 20;
constexpr size_t WS_CTL = 0, CTL_ZERO_BYTES = 1 * MiB;
constexpr size_t WS_MODP = 1 * MiB;
constexpr size_t WS_MOD = 3 * MiB;
constexpr size_t WS_ROPE = 3 * MiB + 512 * 1024;
constexpr size_t WS_WINT = 4 * MiB;
constexpr size_t WS_WRET = 56 * MiB;
constexpr size_t WS_WDIF = 64 * MiB;
constexpr size_t WS_WOUT = 68 * MiB;
constexpr size_t WS_WSGU = 76 * MiB;
constexpr size_t WS_WSDN = 78 * MiB;
constexpr size_t WS_WRTR = 79 * MiB;
constexpr size_t WS_H = 82 * MiB;
constexpr size_t WS_P = 116 * MiB;
constexpr size_t WS_LST = 340 * MiB;
constexpr size_t WS_SST = 408 * MiB;
constexpr size_t WS_ARET = 472 * MiB;
constexpr size_t WS_ADIF = 504 * MiB;
constexpr size_t WS_T = 520 * MiB;
constexpr size_t WS_U = 584 * MiB;
constexpr size_t WS_X1 = 616 * MiB;
constexpr size_t WS_H2X = 680 * MiB;
constexpr size_t WS_LG = 776 * MiB;
constexpr size_t WS_EIDX = 784 * MiB;
constexpr size_t WS_EW = 785 * MiB;
constexpr size_t WS_LIST = 786 * MiB;
constexpr size_t WS_ACTS = 794 * MiB;
constexpr size_t WS_YSH = 798 * MiB;
constexpr size_t WS_Y = 830 * MiB;
constexpr size_t WS_ACT = 1086 * MiB;
constexpr size_t WS_LGP = 1118 * MiB;
constexpr size_t WS_SGP = 1182 * MiB;
constexpr size_t WS_ACAT = 1246 * MiB;
constexpr size_t WS_WCAT = 1294 * MiB;
constexpr size_t WS_LIST2 = 1306 * MiB;
constexpr size_t WS_H2F8 = 1322 * MiB;
constexpr size_t WS_END = 1338 * MiB;

constexpr int CW_BAR = 4096;
constexpr int CW_CNT = 16384;
constexpr int CW_Q = 20480;

constexpr int RING_BYTES = 131072;
constexpr int LDS_BYTES = 163840;
constexpr int LDSCTL_OFF = LDS_BYTES - 512;
constexpr int LDS_TICKET = 146432;

#define XB_TMO      128
#define XB_XCNT(j)  (256  + 64 * (j))
#define XB_XSUB(j)  (1280 + 64 * (j))
#define XB_XGEN(j)  (2304 + 64 * (j))
#define XB_TOP      3328
#define XB_TOPGEN   3392
#define XCD_BAR_WORDS 3456
#define XB_SPIN_CAP (1u << 18)

__device__ __forceinline__ unsigned xb_ld(unsigned* p)              { return __hip_atomic_load(p, __ATOMIC_RELAXED, __HIP_MEMORY_SCOPE_AGENT); }
__device__ __forceinline__ unsigned xb_add(unsigned* p, unsigned v) { return __hip_atomic_fetch_add(p, v, __ATOMIC_RELAXED, __HIP_MEMORY_SCOPE_AGENT); }
__device__ __forceinline__ unsigned xb_xcc_id() { return (unsigned)__builtin_amdgcn_s_getreg((3 << 11) | 20) & 0xFu; }
#define XB_SPIN(cond, bar) do { unsigned _sp = 0; while (cond) { __builtin_amdgcn_s_sleep(1); \
    if ((++_sp & 255u) == 0u) { if (xb_ld(&(bar)[XB_TMO])) break; if (_sp > XB_SPIN_CAP) { atomicAdd(&(bar)[XB_TMO], 1u); break; } } } } while (0)

struct XcdBarrier { unsigned* bar; unsigned x; volatile LAS unsigned* st; };

__device__ __forceinline__ XcdBarrier xcd_barrier_post(unsigned* bar, volatile LAS unsigned* st) {
    XcdBarrier b; b.bar = bar; b.x = xb_xcc_id(); b.st = st;
    if (threadIdx.x == 0) (void)xb_add(&bar[XB_XCNT(b.x)], 1u);
    return b;
}
__device__ __forceinline__ void xcd_barrier_complete(unsigned* bar, unsigned x, unsigned& nloc, unsigned& nx) {
    const unsigned G = gridDim.x * gridDim.y * gridDim.z;
    unsigned sum, cnt, mine, sp = 0u;
    for (;;) {
        sum = 0u; cnt = 0u; mine = 0u;
#pragma unroll
        for (unsigned j = 0; j < 16; ++j) { const unsigned c = xb_ld(&bar[XB_XCNT(j)]); sum += c; cnt += (c > 0u) ? 1u : 0u; mine = (j == x) ? c : mine; }
        if (sum == G) break;
        __builtin_amdgcn_s_sleep(1);
        if ((++sp & 255u) == 0u) { if (xb_ld(&bar[XB_TMO])) break; if (sp > XB_SPIN_CAP) { atomicAdd(&bar[XB_TMO], 1u); break; } }
    }
    nloc = mine > 0u ? mine : 1u; nx = cnt > 0u ? cnt : 1u;
}
__device__ __forceinline__ void xcd_barrier(const XcdBarrier& b) {
    asm volatile("s_waitcnt vmcnt(0)" ::: "memory");
    __syncthreads();
    if (threadIdx.x == 0) {
        unsigned* bar = b.bar;
        __builtin_amdgcn_s_waitcnt(0);
        unsigned nloc = b.st[0], nx = b.st[1];
        if (nloc == 0u) { xcd_barrier_complete(bar, b.x, nloc, nx); b.st[0] = nloc; b.st[1] = nx; }
        const unsigned old = xb_add(&bar[XB_XSUB(b.x)], 1u);
        const unsigned gen = old / nloc;
        if (old + 1u == (gen + 1u) * nloc) {
            __builtin_amdgcn_fence(__ATOMIC_RELEASE, "agent");
            asm volatile("s_waitcnt vmcnt(0)" ::: "memory");
            const unsigned og = xb_add(&bar[XB_TOP], 1u);
            const unsigned tg = og / nx;
            if (og + 1u == (tg + 1u) * nx) xb_add(&bar[XB_TOPGEN], 1u);
            else XB_SPIN(xb_ld(&bar[XB_TOPGEN]) == tg, bar);
            __builtin_amdgcn_fence(__ATOMIC_ACQUIRE, "agent");
            xb_add(&bar[XB_XGEN(b.x)], 1u);
            asm volatile("s_waitcnt vmcnt(0)" ::: "memory");
        } else {
            XB_SPIN(xb_ld(&bar[XB_XGEN(b.x)]) == gen, bar);
            __builtin_amdgcn_fence(__ATOMIC_ACQUIRE, "agent");
            asm volatile("s_waitcnt vmcnt(0)" ::: "memory");
        }
    }
    __syncthreads();
}


namespace pg8 {
constexpr int BM = 256, BK = 64, HALF = 128, HTB = HALF * BK * 2, STAGE_BYTES = 8 * HTB, NXCD = 8, WGM = 8;
__host__ __device__ __forceinline__ int lds_byte(int r, int c) { const int st = (r >> 4) * 2 + (c >> 5), rr = r & 15, cc = c & 31, ob = rr * 64 + cc * 2; return st * 1024 + (ob ^ (((ob >> 9) & 1) << 5)); }
__host__ __device__ __forceinline__ void stage_rc(int b, int& R, int& C) { const int st = b / 1024, sb = b % 1024, swz = sb ^ (((sb >> 9) & 1) << 5); R = (st >> 1) * 16 + swz / 64; C = (st & 1) * 32 + (swz % 64) / 2; }
struct Unit { int pm, pn, ko, nt, keep; };
struct Gemm { const h16* A; const h16* Bt; int lda, ldb, K; };
struct StaticOrder {
    int nM, nN, nwg, G, c;
    __host__ __device__ void init(int M, int N, int G_, int c_) { nM = M / BM; nN = N / BM; nwg = nM * nN; G = G_; c = c_; }
    __host__ __device__ bool next(int i, Unit& u) const {
        const long L = (long)i * G + c; if (L >= nwg) return false;
        int wgid = (int)L; { const int q = nwg / NXCD, r = nwg % NXCD, xcd = wgid % NXCD, off = wgid / NXCD; wgid = (xcd < r ? xcd * (q + 1) : r * (q + 1) + (xcd - r) * q) + off; }
        const int nig = WGM * nN, gid = wgid / nig, fm = gid * WGM, gsz = (nM - fm) < WGM ? (nM - fm) : WGM;
        u.pm = fm + ((wgid % nig) % gsz); u.pn = (wgid % nig) / gsz; u.ko = 0; u.nt = 0; u.keep = 0; return true;
    }
};
template <class Epi, class Sched, bool ALIGN_EPI = true>
__device__ __forceinline__ void gemm_phase(LAS unsigned char* lds, const Gemm g, const Sched& S, const Epi& E) {
    const int tid = threadIdx.x, wid = __builtin_amdgcn_readfirstlane(tid >> 6), lane = tid & 63, wr = wid >> 2, wc = wid & 3, fr = lane & 15, fq = lane >> 4;
    const int nt0 = g.K / BK;
    unsigned voffA[2], voffB[2];
#pragma unroll
    for (int i = 0; i < 2; ++i) { int R, C; stage_rc(tid * 16 + i * 8192, R, C); voffA[i] = (unsigned)(R * g.lda + C) * 2u; voffB[i] = (unsigned)(R * g.ldb + C) * 2u; }
    const size_t kstep = (size_t)(BK * 2);
    const size_t hstepA = (size_t)HALF * g.lda * 2, hstepB = (size_t)HALF * g.ldb * 2;
    const size_t tstepA = 2 * hstepA, tstepB = 2 * hstepB;
    const unsigned ldsw = (unsigned)wid * 1024u;
    const int aoff = lds_byte(wr * 64 + fr, fq * 8), boff = lds_byte(wc * 32 + fr, fq * 8);
#define PG8_SA(b, h) (((b) * 2 + (h)) * HTB)
#define PG8_SB(b, h) ((4 + (b) * 2 + (h)) * HTB)
#define PG8_STAGE(bufoff, gbase, voff) do { _Pragma("unroll") for (int _i = 0; _i < 2; ++_i) \
        __builtin_amdgcn_global_load_lds((const unsigned*)((const char*)(gbase) + (voff)[_i]), (LAS unsigned*)(lds + (bufoff) + ldsw + _i * 8192), 16, 0, 0); } while (0)
#define PG8_LDA(dst, b, h) do { _Pragma("unroll") for (int m = 0; m < 4; ++m) _Pragma("unroll") for (int k = 0; k < 2; ++k) dst[m][k] = *(const LAS h16x8*)(lds + PG8_SA(b, h) + aoff + m * 2048 + k * 1024); } while (0)
#define PG8_LDB(dst, b, h) do { _Pragma("unroll") for (int n = 0; n < 2; ++n) _Pragma("unroll") for (int k = 0; k < 2; ++k) dst[n][k] = *(const LAS h16x8*)(lds + PG8_SB(b, h) + boff + n * 2048 + k * 1024); } while (0)
#define PG8_MMA(ai, bj, At, Bt) do { __builtin_amdgcn_s_setprio(1); _Pragma("unroll") for (int m = 0; m < 4; ++m) _Pragma("unroll") for (int n = 0; n < 2; ++n) _Pragma("unroll") for (int k = 0; k < 2; ++k) \
        acc[ai][bj][m][n] = __builtin_amdgcn_mfma_f32_16x16x32_f16(Bt[n][k], At[m][k], acc[ai][bj][m][n], 0, 0, 0); __builtin_amdgcn_s_setprio(0); } while (0)
#define PG8_WAIT_V(n) asm volatile("s_waitcnt vmcnt(" #n ")" ::: "memory")
#define PG8_WAIT_L(n) asm volatile("s_waitcnt lgkmcnt(" #n ")" ::: "memory")
#define PG8_BAR __builtin_amdgcn_s_barrier()
#define PG8_SCHED __builtin_amdgcn_sched_barrier(0)
    Unit cur, nxt; int ui = 0;
    if (!S.next(0, cur)) return;
    f32x4 acc[2][2][4][2];
#pragma unroll
    for (int a = 0; a < 2; ++a)
#pragma unroll
        for (int b = 0; b < 2; ++b)
#pragma unroll
            for (int m = 0; m < 4; ++m)
#pragma unroll
                for (int n = 0; n < 2; ++n) acc[a][b][m][n] = (f32x4){0.f, 0.f, 0.f, 0.f};
    h16x8 At[4][2], B0[2][2], B1[2][2];
    const char* cA = (const char*)g.A + (size_t)cur.pm * tstepA + (size_t)cur.ko * 2; const char* cB = (const char*)g.Bt + (size_t)cur.pn * tstepB + (size_t)cur.ko * 2;
    {
        PG8_STAGE(PG8_SB(0, 0), cB, voffB); PG8_STAGE(PG8_SB(0, 1), cB + hstepB, voffB); PG8_STAGE(PG8_SA(0, 0), cA, voffA); PG8_STAGE(PG8_SA(0, 1), cA + hstepA, voffA);
        if (wr == 1) PG8_BAR;
        PG8_WAIT_V(2); PG8_BAR;
        PG8_STAGE(PG8_SB(1, 0), cB + kstep, voffB); PG8_STAGE(PG8_SA(1, 0), cA + kstep, voffA); PG8_STAGE(PG8_SB(1, 1), cB + hstepB + kstep, voffB);
        PG8_WAIT_V(6); PG8_BAR;
    }
    for (;;) {
        const bool has_next = S.next(ui + 1, nxt);
        const char* nA = has_next ? (const char*)g.A + (size_t)nxt.pm * tstepA + (size_t)nxt.ko * 2 : cA; const char* nB = has_next ? (const char*)g.Bt + (size_t)nxt.pn * tstepB + (size_t)nxt.ko * 2 : cB;
        int nt = cur.nt ? cur.nt : nt0; asm volatile("" : "+s"(nt));
        for (int t = 0; t < nt; t += 2) {
            const bool last = (t == nt - 2);
            const char* a1 = cA + (size_t)(t + 1) * kstep;
            const char* a2 = last ? nA : cA + (size_t)(t + 2) * kstep; const char* b2 = last ? nB : cB + (size_t)(t + 2) * kstep;
            const char* a3 = a2 + kstep; const char* b3 = b2 + kstep;
            PG8_LDB(B0, 0, 0); PG8_LDB(B1, 0, 1); PG8_SCHED; PG8_LDA(At, 0, 0); PG8_STAGE(PG8_SA(1, 1), a1 + hstepA, voffA);
            PG8_WAIT_V(8); PG8_WAIT_L(0); PG8_BAR; PG8_MMA(0, 0, At, B0); PG8_MMA(0, 1, At, B1); PG8_BAR; PG8_SCHED;
            PG8_LDA(At, 0, 1); PG8_STAGE(PG8_SB(0, 0), b2, voffB); PG8_STAGE(PG8_SB(0, 1), b2 + hstepB, voffB); PG8_STAGE(PG8_SA(0, 0), a2, voffA);
            PG8_WAIT_V(8); PG8_WAIT_L(0); PG8_BAR; PG8_MMA(1, 0, At, B0); PG8_MMA(1, 1, At, B1); PG8_BAR; PG8_SCHED;
            PG8_LDB(B0, 1, 0); PG8_LDB(B1, 1, 1); PG8_SCHED; PG8_LDA(At, 1, 0); PG8_STAGE(PG8_SA(0, 1), a2 + hstepA, voffA);
            PG8_WAIT_V(8); PG8_WAIT_L(0); PG8_BAR; PG8_MMA(0, 0, At, B0); PG8_MMA(0, 1, At, B1); PG8_BAR; PG8_SCHED;
            PG8_LDA(At, 1, 1); PG8_STAGE(PG8_SB(1, 0), b3, voffB); PG8_STAGE(PG8_SB(1, 1), b3 + hstepB, voffB); PG8_STAGE(PG8_SA(1, 0), a3, voffA);
            PG8_WAIT_V(8); PG8_WAIT_L(0); PG8_BAR; PG8_MMA(1, 0, At, B0); PG8_MMA(1, 1, At, B1); PG8_BAR; PG8_SCHED;
        }
        if constexpr (ALIGN_EPI) { if (wr == 0) PG8_BAR; }
        E(acc, cur, wr, wc, fr, fq);
        if (!has_next) break;
        if (!cur.keep) {
#pragma unroll
        for (int a = 0; a < 2; ++a)
#pragma unroll
            for (int b = 0; b < 2; ++b)
#pragma unroll
                for (int m = 0; m < 4; ++m)
#pragma unroll
                    for (int n = 0; n < 2; ++n) acc[a][b][m][n] = (f32x4){0.f, 0.f, 0.f, 0.f};
        }
        cur = nxt; cA = nA; cB = nB; ++ui;
        if constexpr (ALIGN_EPI) { if (wr == 1) PG8_BAR; }
    }
    PG8_WAIT_V(0);
    if constexpr (!ALIGN_EPI) { if (wr == 0) PG8_BAR; }
    PG8_BAR;
#undef PG8_SA
#undef PG8_SB
#undef PG8_STAGE
#undef PG8_LDA
#undef PG8_LDB
#undef PG8_MMA
#undef PG8_WAIT_V
#undef PG8_WAIT_L
#undef PG8_BAR
#undef PG8_SCHED
}
}

struct Frame {
    LAS unsigned char* lds;
    int tid, lane, wave, vcu, G;
    const float *x, *c, *ctx, *c_ctx, *w_mod, *b_mod, *norm_attn, *norm_ffn, *w_in, *ret_decay, *diff_lambda, *diff_subln,
                *w_ret_o, *w_diff_o, *w_out, *w_router, *router_bias, *w_exp_gu, *w_exp_down, *w_sh_gu, *w_sh_down, *final_norm;
    float* out;
    unsigned char* ws;
};

__device__ __forceinline__ float wave_sum(float v) {
#pragma unroll
    for (int o = 1; o < 64; o <<= 1) v += __shfl_xor(v, o);
    return v;
}
__device__ __forceinline__ unsigned pk2h(float lo, float hi) { f32x2 v = {lo, hi}; h16x2 h = __builtin_convertvector(v, h16x2); return __builtin_bit_cast(unsigned, h); }
__device__ __forceinline__ float silu_f(float v) { return v / (1.0f + __expf(-v)); }
__device__ __forceinline__ float sigmoid_f(float v) { return 1.0f / (1.0f + __expf(-v)); }

__device__ __forceinline__ void p0_mod_unit(Frame& F, int unit) {
    const int cb = unit % 24, ks = unit / 24;
    LAS float* sv = (LAS float*)F.lds;
    LAS float* red = sv + 768;
    for (int i = F.tid; i < 768; i += NTHR) { const int v = i >> 8, k = i & 255; const float cv = (v < 2) ? F.c[v * DM + ks * 256 + k] : F.c_ctx[ks * 256 + k]; sv[i] = silu_f(cv); }
    __syncthreads();
    const int cl = F.tid & 127, rl = F.tid >> 7;
    const float* wp = F.w_mod + (size_t)(ks * 256 + rl) * (6 * DM) + cb * 512 + cl * 4;
    f32x4 a0 = {0.f, 0.f, 0.f, 0.f}, a1 = a0, a2 = a0;
#pragma unroll 8
    for (int i = 0; i < 64; ++i) { const f32x4 w = *(const f32x4*)(wp + (size_t)i * 4 * (6 * DM)); const int k = rl + 4 * i; a0 += w * sv[k]; a1 += w * sv[256 + k]; a2 += w * sv[512 + k]; }
    *(LAS f32x4*)(red + (rl * 3 + 0) * 512 + cl * 4) = a0; *(LAS f32x4*)(red + (rl * 3 + 1) * 512 + cl * 4) = a1; *(LAS f32x4*)(red + (rl * 3 + 2) * 512 + cl * 4) = a2;
    __syncthreads();
    float* modp = (float*)(F.ws + WS_MODP);
    for (int i = F.tid; i < 1536; i += NTHR) { const int v = i >> 9, cc = i & 511; const float s = (red[(0 * 3 + v) * 512 + cc] + red[(1 * 3 + v) * 512 + cc]) + (red[(2 * 3 + v) * 512 + cc] + red[(3 * 3 + v) * 512 + cc]);
        modp[(size_t)(ks * 3 + v) * (6 * DM) + cb * 512 + cc] = s; }
    __syncthreads();
}
template <int MAP>
__device__ __forceinline__ void p0_transpose_item(const float* W, int K, int N, h16* WT, LAS float* scr, int item, int lane, int ldd = 0) {
    if (ldd == 0) ldd = K;
    const int nblk = N / 32, kb = item / nblk, nb = item % nblk, k0 = 64 * kb, n0 = 32 * nb;
#pragma unroll 8
    for (int i = 0; i < 32; ++i) { const int kk = 2 * i + (lane >> 5); scr[kk * 33 + (lane & 31)] = W[(size_t)(k0 + kk) * N + n0 + (lane & 31)]; }
    asm volatile("s_waitcnt lgkmcnt(0)" ::: "memory");
    const int cch = lane & 7;
#pragma unroll
    for (int j = 0; j < 4; ++j) { const int n = (lane >> 3) + 8 * j; const LAS float* s = scr + (8 * cch) * 33 + n;
        u32x4 o; o.x = pk2h(s[0 * 33], s[1 * 33]); o.y = pk2h(s[2 * 33], s[3 * 33]); o.z = pk2h(s[4 * 33], s[5 * 33]); o.w = pk2h(s[6 * 33], s[7 * 33]);
        int nn = n0 + n;
        if (MAP == 1) { const bool isrope = (nn < 1024) || (nn >= C_RQ && nn < C_RQ + 1024); if (isrope) nn = (nn & ~48) | ((nn & 16) << 1) | ((nn & 32) >> 1); }
        if (MAP == 2) { const int j = nn & 255, isu = nn >> 8; nn = 32 * (j >> 4) + 16 * isu + (j & 15); }
        *(u32x4*)(WT + (size_t)nn * ldd + k0 + 8 * cch) = o; }
    asm volatile("s_waitcnt lgkmcnt(0)" ::: "memory");
}
__device__ __forceinline__ void p0a_mod(Frame& F) {
    for (int u = F.vcu; u < 192; u += F.G) p0_mod_unit(F, u);
}
__device__ __forceinline__ void p0b_weights(Frame& F) {
    __syncthreads();
    LAS float* scr = (LAS float*)(F.lds + F.wave * 16384);
    const int gw = F.vcu * NWAVES + F.wave, NGW = F.G * NWAVES;
    constexpr int I_IN = (DM / 64) * (IN_COLS / 32);
    for (int it = gw; it < I_IN; it += NGW) p0_transpose_item<1>(F.w_in, DM, IN_COLS, (h16*)(F.ws + WS_WINT), scr, it, F.lane);
    if (blockIdx.x == 0) {
        float* rope = (float*)(F.ws + WS_ROPE);
        for (int i = F.tid; i < 64 * 32; i += NTHR) { const int pos = i >> 5, j = i & 31; const float inv = exp2f(-(float)j * (13.287712379549449f / 32.0f)); const float ang = (float)pos * inv; rope[i] = cosf(ang); rope[2048 + i] = sinf(ang); }
        for (int i = F.tid; i < 64 * 16; i += NTHR) { const int pos = i >> 4, j = i & 15; const float inv = exp2f(-(float)j * (13.287712379549449f / 16.0f)); const float ang = (float)pos * inv; rope[4096 + i] = cosf(ang); rope[4096 + 1024 + i] = sinf(ang); }
    }
}
__device__ __forceinline__ void p0c_weights_dyn(Frame& F, int qid) {
    unsigned* QH = (unsigned*)(F.ws + WS_CTL) + CW_Q + 64 * 8 * qid;
    LAS int* RED = (LAS int*)(F.lds + LDS_TICKET);
    LAS float* scr = (LAS float*)(F.lds + F.wave * 16384);
    constexpr int I_RET = (2048 / 64) * (DM / 32), I_DIF = (1024 / 64) * (DM / 32), I_OUT = (DM / 64) * (DM / 32), I_SGU = (DM / 64) * (512 / 32), I_SDN = (256 / 64) * (DM / 32), I_RT = NEXP * DM / 4 / 64;
    constexpr int NITEMS = I_RET + I_DIF + I_OUT + I_SGU + I_SDN + I_RT, NTICK = (NITEMS + 7) / 8;
    for (;;) {
        __syncthreads();
        if (F.tid == 0) RED[0] = (int)__hip_atomic_fetch_add(QH, 1u, __ATOMIC_RELAXED, __HIP_MEMORY_SCOPE_AGENT);
        __syncthreads();
        const int t = RED[0];
        if (t >= NTICK) break;
        int r = t * 8 + F.wave;
        if (r >= NITEMS) continue;
        if (r < I_RET) { p0_transpose_item<0>(F.w_ret_o, 2048, DM, (h16*)(F.ws + WS_WCAT), scr, r, F.lane, 3072); continue; } r -= I_RET;
        if (r < I_DIF) { p0_transpose_item<0>(F.w_diff_o, 1024, DM, (h16*)(F.ws + WS_WCAT) + 2048, scr, r, F.lane, 3072); continue; } r -= I_DIF;
        if (r < I_OUT) { p0_transpose_item<0>(F.w_out, DM, DM, (h16*)(F.ws + WS_WOUT), scr, r, F.lane); continue; } r -= I_OUT;
        if (r < I_SGU) { p0_transpose_item<2>(F.w_sh_gu, DM, 512, (h16*)(F.ws + WS_WSGU), scr, r, F.lane); continue; } r -= I_SGU;
        if (r < I_SDN) { p0_transpose_item<0>(F.w_sh_down, 256, DM, (h16*)(F.ws + WS_WSDN), scr, r, F.lane); continue; } r -= I_SDN;
        {
            const int q = r * 64 + F.lane, e = q / (DM / 4), k = (q % (DM / 4)) * 4;
            const f32x4 w = *(const f32x4*)(F.w_router + (size_t)e * DM + k);
            h16 hi[4], lo[4];
#pragma unroll
            for (int j = 0; j < 4; ++j) { hi[j] = (h16)w[j]; lo[j] = (h16)(w[j] - (float)hi[j]); }
            h16* dst = (h16*)(F.ws + WS_WRTR) + (size_t)e * 6144 + k;
            *(h16x4*)(dst) = (h16x4){hi[0], hi[1], hi[2], hi[3]}; *(h16x4*)(dst + 2048) = (h16x4){hi[0], hi[1], hi[2], hi[3]}; *(h16x4*)(dst + 4096) = (h16x4){lo[0], lo[1], lo[2], lo[3]};
        }
    }
}

__device__ __forceinline__ void p1_norm1(Frame& F) {
    LAS float* msh = (LAS float*)F.lds; LAS float* msc = msh + 3 * DM;
    const float* modp = (const float*)(F.ws + WS_MODP);
    for (int i = F.tid; i < 3 * 2 * DM; i += NTHR) { const int v = i / (2 * DM), cc = i % (2 * DM); float s = F.b_mod[cc];
#pragma unroll
        for (int ks = 0; ks < 8; ++ks) s += modp[(size_t)(ks * 3 + v) * (6 * DM) + cc];
        if (cc < DM) msh[v * DM + cc] = s; else msc[v * DM + cc - DM] = s; }
    __syncthreads();
    const int gw = F.vcu * NWAVES + F.wave, NGW = F.G * NWAVES;
    h16* H = (h16*)(F.ws + WS_H);
    for (int r = gw; r < MALL; r += NGW) {
        const float* src = (r < MLAT) ? F.x + (size_t)r * DM : F.ctx + (size_t)(r - MLAT) * DM; const int v = (r < MLAT) ? (r / SEQ) : 2;
        f32x4 xv[8]; float ss = 0.f;
#pragma unroll
        for (int j = 0; j < 8; ++j) { xv[j] = *(const f32x4*)(src + 4 * F.lane + 256 * j); ss += (xv[j].x * xv[j].x + xv[j].y * xv[j].y) + (xv[j].z * xv[j].z + xv[j].w * xv[j].w); }
        const float rstd = 1.0f / sqrtf(wave_sum(ss) * (1.0f / DM) + EPS);
#pragma unroll
        for (int j = 0; j < 8; ++j) { const int cc = 4 * F.lane + 256 * j; const f32x4 nw = *(const f32x4*)(F.norm_attn + cc);
            const f32x4 sc = *(LAS f32x4*)(msc + v * DM + cc), sh = *(LAS f32x4*)(msh + v * DM + cc);
            const f32x4 y = xv[j] * rstd * nw * (sc + 1.0f) + sh;
            u32x2 o; o.x = pk2h(y.x, y.y); o.y = pk2h(y.z, y.w); *(u32x2*)(H + (size_t)r * DM + cc) = o; }
    }
    float* MOD = (float*)(F.ws + WS_MOD);
    for (int i = blockIdx.x * NTHR + F.tid; i < 3 * 6 * DM; i += F.G * NTHR) { const int v = i / (6 * DM), cc = i % (6 * DM); float s = F.b_mod[cc];
#pragma unroll
        for (int ks = 0; ks < 8; ++ks) s += modp[(size_t)(ks * 3 + v) * (6 * DM) + cc];
        MOD[i] = s; }
}


__device__ __forceinline__ int crow(int r, int hi) { return (r & 3) + 8 * (r >> 2) + 4 * hi; }
__device__ __forceinline__ h16x8 frag_row(const LAS unsigned char* base, int strideB, int r0, int k0, int lane) {
    return *(const LAS h16x8*)(base + (r0 + (lane & 31)) * strideB + (k0 + 8 * (lane >> 5)) * 2);
}
__device__ __forceinline__ v4i16_t tr16(const LAS unsigned char* p) { return __builtin_amdgcn_ds_read_tr16_b64_v4i16((LAS v4i16_t*)p); }
__device__ __forceinline__ h16x8 frag_tr(const LAS unsigned char* base, int strideB, int k0, int n0, int lane) {
    const int kb = k0 + 8 * (lane >> 5) + ((lane & 15) >> 2), nc = n0 + 16 * ((lane >> 4) & 1) + 4 * (lane & 3);
    const LAS unsigned char* p = base + kb * strideB + nc * 2;
    const v4i16_t lo = tr16(p), hi = tr16(p + 4 * strideB);
    typedef short s16x8 __attribute__((ext_vector_type(8)));
    const s16x8 v = {lo[0], lo[1], lo[2], lo[3], hi[0], hi[1], hi[2], hi[3]};
    return __builtin_bit_cast(h16x8, v);
}
__device__ __forceinline__ h16x8 frag_tr_perm(const LAS unsigned char* base, int strideB, int k0, int n0, int lane) {
    const int kb = k0 + 4 * (lane >> 5) + ((lane & 15) >> 2), nc = n0 + 16 * ((lane >> 4) & 1) + 4 * (lane & 3);
    const LAS unsigned char* p = base + kb * strideB + nc * 2;
    const v4i16_t lo = tr16(p), hi = tr16(p + 8 * strideB);
    typedef short s16x8 __attribute__((ext_vector_type(8)));
    const s16x8 v = {lo[0], lo[1], lo[2], lo[3], hi[0], hi[1], hi[2], hi[3]};
    return __builtin_bit_cast(h16x8, v);
}
__device__ __forceinline__ h16x8 pack8(float a0, float a1, float a2, float a3, float a4, float a5, float a6, float a7) {
    u32x4 w; w.x = pk2h(a0, a1); w.y = pk2h(a2, a3); w.z = pk2h(a4, a5); w.w = pk2h(a6, a7); return __builtin_bit_cast(h16x8, w);
}
#define MFMA32(a, b, c) __builtin_amdgcn_mfma_f32_32x32x16_f16((a), (b), (c), 0, 0, 0)

struct SchedG1 {
    pg8::StaticOrder so; int G, c;
    __device__ __forceinline__ bool next(int i, pg8::Unit& u) const {
        const int L = i * G + c;
        if (L < 32 * 52) return so.next(i, u);
        const int r = L - 32 * 52; if (r >= 40) return false;
        u.pm = 32 + r / 20; u.pn = r % 20; u.ko = 0; u.nt = 0; u.keep = 0; return true;
    }
};
struct EpiP {
    h16* P; const float* rope;
    __device__ __forceinline__ void operator()(f32x4 (&acc)[2][2][4][2], const pg8::Unit& u, int wr, int wc, int fr, int fq) const {
        const int colt = u.pn * 256; const bool lat = u.pm < 32;
        int kind;
        if (colt < C_RV) kind = 1; else if (colt < C_DK) kind = 0; else if (colt < C_DV) kind = 3; else if (colt < C_RQ) kind = 0; else if (colt < C_RG) kind = 2; else if (colt < C_DQ) kind = 5; else if (colt < C_GR) kind = 4; else kind = 6;
        if (!lat) kind = (kind == 1) ? 7 : 0;
#pragma unroll
        for (int ai = 0; ai < 2; ++ai)
#pragma unroll
            for (int m = 0; m < 4; ++m) {
                const int row = u.pm * 256 + ai * 128 + wr * 64 + m * 16 + fr; const int t = row & (SEQ - 1);
                h16* prow = P + (size_t)row * IN_COLS;
#pragma unroll
                for (int bj = 0; bj < 2; ++bj) {
                    const int cbase = colt + bj * 128 + wc * 32;
                    const f32x4 x0 = acc[ai][bj][m][0], x1 = acc[ai][bj][m][1];
                    f32x4 o0, o1; int c0, c1;
                    if (kind == 1 || kind == 2) {
                        const int g5 = (cbase >> 5) & 1, axis = (cbase >> 6) & 1, pos = axis ? (t & 63) : (t >> 6), j0 = 16 * g5 + 4 * fq;
                        const f32x4 cs = *(const f32x4*)(rope + pos * 32 + j0), sn = *(const f32x4*)(rope + 2048 + pos * 32 + j0);
                        o0 = x0 * cs - x1 * sn; o1 = x0 * sn + x1 * cs;
                        if (kind == 2) { o0 *= 0.08838834764831845f; o1 *= 0.08838834764831845f; }
                        c0 = (cbase & ~63) + j0; c1 = c0 + 32;
                    } else if (kind == 7) {
                        const int g5 = (cbase >> 5) & 1; c0 = (cbase & ~63) + 16 * g5 + 4 * fq; c1 = c0 + 32; o0 = x0; o1 = x1;
                    } else if (kind == 3 || kind == 4) {
                        const int axis = (cbase >> 5) & 1, pos = axis ? (t & 63) : (t >> 6), j0 = 4 * fq;
                        const f32x4 cs = *(const f32x4*)(rope + 4096 + pos * 16 + j0), sn = *(const f32x4*)(rope + 5120 + pos * 16 + j0);
                        o0 = x0 * cs - x1 * sn; o1 = x0 * sn + x1 * cs;
                        if (kind == 4) { o0 *= 0.18033688011112042f; o1 *= 0.18033688011112042f; }
                        c0 = cbase + j0; c1 = c0 + 16;
                    } else {
                        c0 = cbase + 4 * fq; c1 = c0 + 16; o0 = x0; o1 = x1;
                        if (kind == 5) {
#pragma unroll
                            for (int e = 0; e < 4; ++e) { o0[e] = silu_f(x0[e]); o1[e] = silu_f(x1[e]); }
                        } else if (kind == 6) {
#pragma unroll
                            for (int e = 0; e < 4; ++e) { o0[e] = sigmoid_f(x0[e]); o1[e] = sigmoid_f(x1[e]); }
                        }
                    }
                    u32x2 w0, w1; w0.x = pk2h(o0[0], o0[1]); w0.y = pk2h(o0[2], o0[3]); w1.x = pk2h(o1[0], o1[1]); w1.y = pk2h(o1[2], o1[3]);
                    *(u32x2*)(prow + c0) = w0; *(u32x2*)(prow + c1) = w1;
                }
            }
    }
};
__device__ __forceinline__ void p2_gemm1(Frame& F) {
    pg8::Gemm g{(const h16*)(F.ws + WS_H), (const h16*)(F.ws + WS_WINT), DM, DM, DM};
    SchedG1 S; S.so.init(MLAT, IN_COLS, F.G, (int)blockIdx.x); S.G = F.G; S.c = (int)blockIdx.x;
    EpiP E{(h16*)(F.ws + WS_P), (const float*)(F.ws + WS_ROPE)};
    pg8::gemm_phase<EpiP, SchedG1>(F.lds, g, S, E);
}

__device__ __forceinline__ void p3_ret_local(Frame& F) {
    LAS unsigned char* KF = F.lds; LAS unsigned char* KB = F.lds + 40960; LAS unsigned char* VH = F.lds + 81920;
    const h16* P = (const h16*)(F.ws + WS_P); h16* LST = (h16*)(F.ws + WS_LST);
    const int hi = F.lane >> 5;
    for (int u = F.vcu; u < 16 * 34; u += F.G) {
        const int bh = u / 34, cc = u % 34, b = bh >> 3, h = bh & 7;
        const int row0 = (cc < 2) ? (MLAT + b * CTXL + cc * 128) : (b * SEQ + (cc - 2) * 128);
        const float lgf = -__expf(F.ret_decay[h]), lgb = -__expf(F.ret_decay[8 + h]);
#pragma unroll
        for (int i = 0; i < 4; ++i) { const int q = F.tid + NTHR * i, row = q >> 4, ch = q & 15;
            const h16x8 kv = *(const h16x8*)(P + (size_t)(row0 + row) * IN_COLS + C_RK + h * 128 + ch * 8);
            const float sf = __expf(lgf * (float)(127 - row)), sb = __expf(lgb * (float)row);
            *(LAS h16x8*)(KF + row * 320 + ch * 16) = pack8((float)kv[0] * sf, (float)kv[1] * sf, (float)kv[2] * sf, (float)kv[3] * sf, (float)kv[4] * sf, (float)kv[5] * sf, (float)kv[6] * sf, (float)kv[7] * sf);
            *(LAS h16x8*)(KB + row * 320 + ch * 16) = pack8((float)kv[0] * sb, (float)kv[1] * sb, (float)kv[2] * sb, (float)kv[3] * sb, (float)kv[4] * sb, (float)kv[5] * sb, (float)kv[6] * sb, (float)kv[7] * sb); }
        for (int eh = 0; eh < 2; ++eh) {
            if (eh) __syncthreads();
#pragma unroll
            for (int i = 0; i < 4; ++i) { const int q = F.tid + NTHR * i, row = q >> 4, ch = q & 15;
                *(LAS h16x8*)(VH + row * 320 + ch * 16) = *(const h16x8*)(P + (size_t)(row0 + row) * IN_COLS + C_RV + h * 256 + eh * 128 + ch * 8); }
            __syncthreads();
            const int dir = F.wave >> 2, eb = F.wave & 3; const LAS unsigned char* Kd = dir ? KB : KF;
            f32x16 acc[4];
#pragma unroll
            for (int db = 0; db < 4; ++db) acc[db] = (f32x16){};
#pragma unroll
            for (int ks = 0; ks < 8; ++ks) { const h16x8 a = frag_tr(VH, 320, 16 * ks, 32 * eb, F.lane);
#pragma unroll
                for (int db = 0; db < 4; ++db) { const h16x8 bb = frag_tr(Kd, 320, 16 * ks, 32 * db, F.lane); acc[db] = MFMA32(a, bb, acc[db]); } }
            h16* dst = LST + ((size_t)((dir * 16 + bh) * 34 + cc) * 256 + eh * 128 + eb * 32) * 128;
#pragma unroll
            for (int db = 0; db < 4; ++db)
#pragma unroll
                for (int r = 0; r < 16; ++r) dst[crow(r, hi) * 128 + db * 32 + (F.lane & 31)] = (h16)acc[db][r];
        }
        __syncthreads();
    }
}
__device__ __forceinline__ void p4_ret_scan(Frame& F) {
    const h16* LST = (const h16*)(F.ws + WS_LST); h16* SST = (h16*)(F.ws + WS_SST);
    for (int g = blockIdx.x * NTHR + F.tid; g < 2 * 16 * 4096; g += F.G * NTHR) {
        const int seq = g >> 12, off = (g & 4095) * 8, dir = seq >> 4, bh = seq & 15, h = bh & 7;
        const float cd = __expf(-__expf(F.ret_decay[dir * 8 + h]) * 128.0f);
        const h16* Lp = LST + (size_t)seq * 34 * 32768 + off; h16* Sp = SST + (size_t)seq * 32 * 32768 + off;
        float s[8];
#pragma unroll
        for (int e = 0; e < 8; ++e) s[e] = 0.f;
        if (dir == 0) {
            for (int cc = 0; cc < 33; ++cc) {
                if (cc >= 2) *(h16x8*)(Sp + (size_t)(cc - 2) * 32768) = pack8(s[0], s[1], s[2], s[3], s[4], s[5], s[6], s[7]);
                const h16x8 l = *(const h16x8*)(Lp + (size_t)cc * 32768);
#pragma unroll
                for (int e = 0; e < 8; ++e) s[e] = s[e] * cd + (float)l[e];
            }
            *(h16x8*)(Sp + (size_t)31 * 32768) = pack8(s[0], s[1], s[2], s[3], s[4], s[5], s[6], s[7]);
        } else {
            { const h16x8 l1 = *(const h16x8*)(Lp + (size_t)1 * 32768), l0 = *(const h16x8*)(Lp);
#pragma unroll
              for (int e = 0; e < 8; ++e) s[e] = (float)l1[e] * cd + (float)l0[e]; }
            for (int c = 31; c >= 0; --c) {
                *(h16x8*)(Sp + (size_t)c * 32768) = pack8(s[0], s[1], s[2], s[3], s[4], s[5], s[6], s[7]);
                const h16x8 l = *(const h16x8*)(Lp + (size_t)(c + 2) * 32768);
#pragma unroll
                for (int e = 0; e < 8; ++e) s[e] = s[e] * cd + (float)l[e];
            }
        }
    }
}
__device__ __forceinline__ void p5_ret_out(Frame& F) {
    LAS unsigned char* QL = F.lds; LAS unsigned char* KL = F.lds + 34816; LAS unsigned char* PL = KL; LAS unsigned char* VL = F.lds + 69632;
    LAS float* RED = (LAS float*)(F.lds + 69632 + 73728);
    const h16* P = (const h16*)(F.ws + WS_P); const h16* SST = (const h16*)(F.ws + WS_SST); h16* ARET = (h16*)(F.ws + WS_ACAT);
    const int hi = F.lane >> 5, ln = F.lane & 31, w = F.wave;
    for (int u = F.vcu; u < 512; u += F.G) {
        const int bh = u >> 5, c = u & 31, b = bh >> 3, h = bh & 7, row0 = b * SEQ + c * 128;
        const float lgf = -__expf(F.ret_decay[h]), lgb = -__expf(F.ret_decay[8 + h]);
#pragma unroll
        for (int i = 0; i < 4; ++i) { const int q = F.tid + NTHR * i, row = q >> 4, ch = q & 15; const h16* pr = P + (size_t)(row0 + row) * IN_COLS + h * 128 + ch * 8;
            *(LAS h16x8*)(QL + row * 272 + ch * 16) = *(const h16x8*)(pr + C_RQ); *(LAS h16x8*)(KL + row * 272 + ch * 16) = *(const h16x8*)(pr + C_RK); }
        h16x8 vreg[8];
#pragma unroll
        for (int i = 0; i < 8; ++i) { const int q = F.tid + NTHR * i, row = q >> 5, c32 = q & 31; vreg[i] = *(const h16x8*)(P + (size_t)(row0 + row) * IN_COLS + C_RV + h * 256 + c32 * 8); }
        __syncthreads();
        u32x2 pw[2][4];
        { const int jt = w >> 1;
#pragma unroll
          for (int t2 = 0; t2 < 2; ++t2) { const int ib = 2 * (w & 1) + t2, il = 32 * ib + ln; f32x16 s = (f32x16){};
#pragma unroll
            for (int ks = 0; ks < 8; ++ks) s = MFMA32(frag_row(KL, 272, 32 * jt, 16 * ks, F.lane), frag_row(QL, 272, 32 * ib, 16 * ks, F.lane), s);
#pragma unroll
            for (int r = 0; r < 16; ++r) { const int d = il - (32 * jt + crow(r, hi)); s[r] *= (d >= 0) ? __expf(lgf * (float)d) : __expf(lgb * (float)(-d)); }
#pragma unroll
            for (int r4 = 0; r4 < 4; ++r4) { pw[t2][r4].x = pk2h(s[4 * r4], s[4 * r4 + 1]); pw[t2][r4].y = pk2h(s[4 * r4 + 2], s[4 * r4 + 3]); } } }
        __syncthreads();
        { const int jt = w >> 1;
#pragma unroll
          for (int t2 = 0; t2 < 2; ++t2) { const int il = 32 * (2 * (w & 1) + t2) + ln;
#pragma unroll
            for (int r4 = 0; r4 < 4; ++r4) *(LAS u32x2*)(PL + il * 272 + (32 * jt + 8 * r4 + 4 * hi) * 2) = pw[t2][r4]; } }
#pragma unroll
        for (int i = 0; i < 8; ++i) { const int q = F.tid + NTHR * i, row = q >> 5, c32 = q & 31; *(LAS h16x8*)(VL + row * 576 + c32 * 16) = vreg[i]; }
        __syncthreads();
        f32x16 o[4];
#pragma unroll
        for (int ib = 0; ib < 4; ++ib) o[ib] = (f32x16){};
#pragma unroll
        for (int k16 = 0; k16 < 8; ++k16) { const h16x8 a = frag_tr(VL, 576, 16 * k16, 32 * w, F.lane);
#pragma unroll
            for (int ib = 0; ib < 4; ++ib) o[ib] = MFMA32(a, frag_row(PL, 272, 32 * ib, 16 * k16, F.lane), o[ib]);
            if (k16 & 1) __builtin_amdgcn_sched_barrier(0); }
#pragma unroll
        for (int dir = 0; dir < 2; ++dir) {
            h16 sc[4];
#pragma unroll
            for (int ib = 0; ib < 4; ++ib) { const int il = 32 * ib + ln; sc[ib] = (h16)(dir ? __expf(lgb * (float)(128 - il)) : __expf(lgf * (float)(il + 1))); }
            const h16* Sg = SST + ((size_t)((dir * 16 + bh) * 32 + c) * 256 + 32 * w + ln) * 128 + 8 * hi;
#pragma unroll
            for (int kh = 0; kh < 2; ++kh) {
                h16x8 sa[4];
#pragma unroll
                for (int k4 = 0; k4 < 4; ++k4) sa[k4] = *(const h16x8*)(Sg + 16 * (4 * kh + k4));
#pragma unroll
                for (int k4 = 0; k4 < 4; ++k4) {
#pragma unroll
                    for (int ib = 0; ib < 4; ++ib) o[ib] = MFMA32(sa[k4], frag_row(QL, 272, 32 * ib, 16 * (4 * kh + k4), F.lane) * sc[ib], o[ib]);
                    __builtin_amdgcn_sched_barrier(0); }
            }
        }
#pragma unroll
        for (int ib = 0; ib < 4; ++ib) { float ss = 0.f;
#pragma unroll
            for (int r = 0; r < 16; ++r) ss += o[ib][r] * o[ib][r];
            ss += __shfl_xor(ss, 32);
            if (hi == 0) RED[(w * 4 + ib) * 32 + ln] = ss; }
        __syncthreads();
#pragma unroll
        for (int ib = 0; ib < 4; ++ib) { float tot = 0.f;
#pragma unroll
            for (int ww = 0; ww < 8; ++ww) tot += RED[(ww * 4 + ib) * 32 + ln];
            const float rstd = 1.0f / sqrtf(tot * (1.0f / 256.0f) + EPS);
            const size_t grow = (size_t)(row0 + 32 * ib + ln);
#pragma unroll
            for (int r4 = 0; r4 < 4; ++r4) { const int e = 32 * w + 8 * r4 + 4 * hi;
                const h16x4 gt = *(const h16x4*)(P + grow * IN_COLS + C_RG + h * 256 + e);
                u32x2 wv; wv.x = pk2h(o[ib][4 * r4] * rstd * (float)gt[0], o[ib][4 * r4 + 1] * rstd * (float)gt[1]); wv.y = pk2h(o[ib][4 * r4 + 2] * rstd * (float)gt[2], o[ib][4 * r4 + 3] * rstd * (float)gt[3]);
                *(u32x2*)(ARET + grow * 3072 + h * 256 + e) = wv; } }
        __syncthreads();
    }
}
__device__ __forceinline__ void p6_attn(Frame& F) {
    const h16* P = (const h16*)(F.ws + WS_P); h16* ADIF = (h16*)(F.ws + WS_ACAT) + 2048;
    const int hi = F.lane >> 5, ln = F.lane & 31;
    float lam;
    { const float s1 = wave_sum(F.diff_lambda[F.lane] * F.diff_lambda[64 + F.lane]), s2 = wave_sum(F.diff_lambda[128 + F.lane] * F.diff_lambda[192 + F.lane]); lam = __expf(s1) - __expf(s2) + 0.2f; }
    constexpr int KT0 = 0, VT0 = 34816, KTB = 17408, VTB = 20480;
    LAS float* XB = (LAS float*)F.lds;
    for (int u = F.vcu; u < 512; u += F.G) {
        const int bh = u >> 5, qb = u & 31, b = bh >> 3, h = bh & 7;
        const int cm = F.wave & 1, qs = F.wave >> 1, qrow0 = b * SEQ + qb * 128 + qs * 32;
        h16x8 qf[4];
#pragma unroll
        for (int ks = 0; ks < 4; ++ks) qf[ks] = *(const h16x8*)(P + (size_t)(qrow0 + ln) * IN_COLS + C_DQ + h * 128 + cm * 64 + 16 * ks + 8 * hi);
        f32x16 o[4];
#pragma unroll
        for (int et = 0; et < 4; ++et) o[et] = (f32x16){};
        float mrun = -1e30f, lsum = 0.f;
        h16x8 kreg[2], vreg[2];
#define ATT_LOAD(t) do { _Pragma("unroll") for (int i = 0; i < 2; ++i) { const int q = F.tid + NTHR * i, row = q >> 4, ch = q & 15; const int j = (t) * 64 + row; \
            const size_t srow = (j < CTXL) ? (size_t)(MLAT + b * CTXL + j) : (size_t)(b * SEQ + j - CTXL); const h16* pr = P + srow * IN_COLS + h * 128 + ch * 8; \
            kreg[i] = *(const h16x8*)(pr + C_DK); vreg[i] = *(const h16x8*)(pr + C_DV); } } while (0)
#define ATT_WRITE(buf) do { _Pragma("unroll") for (int i = 0; i < 2; ++i) { const int q = F.tid + NTHR * i, row = q >> 4, ch = q & 15; \
            *(LAS h16x8*)(F.lds + KT0 + (buf) * KTB + row * 272 + ch * 16) = kreg[i]; *(LAS h16x8*)(F.lds + VT0 + (buf) * VTB + row * 320 + ch * 16) = vreg[i]; } } while (0)
        ATT_LOAD(0); ATT_WRITE(0);
        __syncthreads();
        constexpr int NT = (CTXL + SEQ) / 64;
        for (int t = 0; t < NT; ++t) {
            const int buf = t & 1;
            if (t + 1 < NT) ATT_LOAD(t + 1);
            const LAS unsigned char* Kt = F.lds + KT0 + buf * KTB; const LAS unsigned char* Vt = F.lds + VT0 + buf * VTB;
            f32x16 s[2];
#pragma unroll
            for (int kt = 0; kt < 2; ++kt) { s[kt] = (f32x16){};
#pragma unroll
                for (int ks = 0; ks < 4; ++ks) s[kt] = MFMA32(frag_row(Kt, 272, 32 * kt, cm * 64 + 16 * ks, F.lane), qf[ks], s[kt]); }
            float mx = s[0][0];
#pragma unroll
            for (int r = 0; r < 16; ++r) { mx = fmaxf(mx, s[0][r]); mx = fmaxf(mx, s[1][r]); }
            mx = fmaxf(mx, __shfl_xor(mx, 32));
            if (__any(mx > mrun + 8.0f)) { const float mn = fmaxf(mrun, mx), alpha = __builtin_amdgcn_exp2f(mrun - mn); mrun = mn; lsum *= alpha;
#pragma unroll
                for (int et = 0; et < 4; ++et) o[et] *= alpha; }
            float ps = 0.f;
#pragma unroll
            for (int kt = 0; kt < 2; ++kt)
#pragma unroll
                for (int r = 0; r < 16; ++r) { s[kt][r] = __builtin_amdgcn_exp2f(s[kt][r] - mrun); ps += s[kt][r]; }
            lsum += ps;
#pragma unroll
            for (int kt = 0; kt < 2; ++kt)
#pragma unroll
                for (int s2 = 0; s2 < 2; ++s2) {
                    const h16x8 pbf = pack8(s[kt][8 * s2], s[kt][8 * s2 + 1], s[kt][8 * s2 + 2], s[kt][8 * s2 + 3], s[kt][8 * s2 + 4], s[kt][8 * s2 + 5], s[kt][8 * s2 + 6], s[kt][8 * s2 + 7]);
#pragma unroll
                    for (int et = 0; et < 4; ++et) o[et] = MFMA32(frag_tr_perm(Vt, 320, 32 * kt + 16 * s2, 32 * et, F.lane), pbf, o[et]);
                }
            if (t + 1 < NT) ATT_WRITE(buf ^ 1);
            __syncthreads();
        }
#undef ATT_LOAD
#undef ATT_WRITE
        lsum += __shfl_xor(lsum, 32);
        const float inv = 1.0f / lsum;
        if (cm == 1) {
#pragma unroll
            for (int et = 0; et < 4; ++et)
#pragma unroll
                for (int r = 0; r < 16; ++r) XB[(qs * 128 + 32 * et + crow(r, hi)) * 32 + ln] = o[et][r] * inv;
        }
        __syncthreads();
        if (cm == 0) {
            float ss = 0.f;
#pragma unroll
            for (int et = 0; et < 4; ++et)
#pragma unroll
                for (int r = 0; r < 16; ++r) { const float v = o[et][r] * inv - lam * XB[(qs * 128 + 32 * et + crow(r, hi)) * 32 + ln]; o[et][r] = v; ss += v * v; }
            ss += __shfl_xor(ss, 32);
            const float rstd = 0.8f / sqrtf(ss * (1.0f / 128.0f) + EPS);
            const size_t grow = (size_t)(qrow0 + ln);
#pragma unroll
            for (int et = 0; et < 4; ++et)
#pragma unroll
                for (int r4 = 0; r4 < 4; ++r4) { const int e = 32 * et + 8 * r4 + 4 * hi; const f32x4 sw = *(const f32x4*)(F.diff_subln + e);
                    u32x2 w; w.x = pk2h(o[et][4 * r4] * rstd * sw[0], o[et][4 * r4 + 1] * rstd * sw[1]); w.y = pk2h(o[et][4 * r4 + 2] * rstd * sw[2], o[et][4 * r4 + 3] * rstd * sw[3]);
                    *(u32x2*)(ADIF + grow * 3072 + h * 128 + e) = w; }
        }
        __syncthreads();
    }
}
struct SchedG2 {
    pg8::StaticOrder so;
    __device__ __forceinline__ bool next(int i, pg8::Unit& u) const { if (!so.next(i >> 1, u)) return false; if (i & 1) { u.ko = 2048; u.nt = 16; u.keep = 0; } else { u.ko = 0; u.nt = 32; u.keep = 1; } return true; }
};
struct EpiU2 {
    h16* U; const h16* P;
    __device__ __forceinline__ void operator()(f32x4 (&acc)[2][2][4][2], const pg8::Unit& u, int wr, int wc, int fr, int fq) const {
#pragma unroll
        for (int ai = 0; ai < 2; ++ai)
#pragma unroll
            for (int m = 0; m < 4; ++m) { const int row = u.pm * 256 + ai * 128 + wr * 64 + m * 16 + fr;
#pragma unroll
                for (int bj = 0; bj < 2; ++bj)
#pragma unroll
                    for (int n = 0; n < 2; ++n) { const int col = u.pn * 256 + bj * 128 + wc * 32 + 16 * n + 4 * fq;
                        const h16x4 gd = *(const h16x4*)(P + (size_t)row * IN_COLS + C_GD + col);
                        if (u.keep) { const h16x4 gr = *(const h16x4*)(P + (size_t)row * IN_COLS + C_GR + col);
#pragma unroll
                            for (int e = 0; e < 4; ++e) acc[ai][bj][m][n][e] *= (float)gr[e] / (float)gd[e];
                        } else { const f32x4 a = acc[ai][bj][m][n];
                            u32x2 w; w.x = pk2h(a[0] * (float)gd[0], a[1] * (float)gd[1]); w.y = pk2h(a[2] * (float)gd[2], a[3] * (float)gd[3]);
                            *(u32x2*)(U + (size_t)row * DM + col) = w; } } }
    }
};
struct EpiX1 {
    float* X1; const float* x; const float* MOD;
    __device__ __forceinline__ void operator()(f32x4 (&acc)[2][2][4][2], const pg8::Unit& u, int wr, int wc, int fr, int fq) const {
        const int b = (u.pm * 256) / SEQ;
#pragma unroll
        for (int ai = 0; ai < 2; ++ai)
#pragma unroll
            for (int m = 0; m < 4; ++m) { const int row = u.pm * 256 + ai * 128 + wr * 64 + m * 16 + fr;
#pragma unroll
                for (int bj = 0; bj < 2; ++bj)
#pragma unroll
                    for (int n = 0; n < 2; ++n) { const int col = u.pn * 256 + bj * 128 + wc * 32 + 16 * n + 4 * fq;
                        const f32x4 g1 = *(const f32x4*)(MOD + (size_t)b * (6 * DM) + 2 * DM + col); const f32x4 xv = *(const f32x4*)(x + (size_t)row * DM + col);
                        *(f32x4*)(X1 + (size_t)row * DM + col) = xv + g1 * acc[ai][bj][m][n]; } }
    }
};
__device__ __forceinline__ void p7_gemm2(Frame& F) {
    pg8::Gemm g{(const h16*)(F.ws + WS_ACAT), (const h16*)(F.ws + WS_WCAT), 3072, 3072, 2048};
    SchedG2 S; S.so.init(MLAT, DM, F.G, (int)blockIdx.x);
    EpiU2 E{(h16*)(F.ws + WS_U), (const h16*)(F.ws + WS_P)};
    pg8::gemm_phase<EpiU2, SchedG2>(F.lds, g, S, E);
}
__device__ __forceinline__ void p9_gemm3(Frame& F) {
    pg8::Gemm g{(const h16*)(F.ws + WS_U), (const h16*)(F.ws + WS_WOUT), 2048, 2048, 2048};
    pg8::StaticOrder S; S.init(MLAT, DM, F.G, (int)blockIdx.x);
    EpiX1 E{(float*)(F.ws + WS_X1), F.x, (const float*)(F.ws + WS_MOD)};
    pg8::gemm_phase<EpiX1, pg8::StaticOrder>(F.lds, g, S, E);
}


__device__ __forceinline__ void p10_norm2(Frame& F) {
    const float* X1 = (const float*)(F.ws + WS_X1); const float* MOD = (const float*)(F.ws + WS_MOD); h16* H2X = (h16*)(F.ws + WS_H2X);
    const int gw = F.vcu * NWAVES + F.wave, NGW = F.G * NWAVES;
    for (int r = gw; r < MLAT; r += NGW) {
        const float* src = X1 + (size_t)r * DM; const int b = r / SEQ;
        f32x4 xv[8]; float ss = 0.f;
#pragma unroll
        for (int j = 0; j < 8; ++j) { xv[j] = *(const f32x4*)(src + 4 * F.lane + 256 * j); ss += (xv[j].x * xv[j].x + xv[j].y * xv[j].y) + (xv[j].z * xv[j].z + xv[j].w * xv[j].w); }
        const float rstd = 1.0f / sqrtf(wave_sum(ss) * (1.0f / DM) + EPS);
#pragma unroll
        for (int j = 0; j < 8; ++j) { const int cc = 4 * F.lane + 256 * j; const f32x4 nw = *(const f32x4*)(F.norm_ffn + cc);
            const f32x4 sh = *(const f32x4*)(MOD + (size_t)b * (6 * DM) + 3 * DM + cc), sc = *(const f32x4*)(MOD + (size_t)b * (6 * DM) + 4 * DM + cc);
            const f32x4 y = xv[j] * rstd * nw * (sc + 1.0f) + sh;
            h16 hh[4], ll[4];
#pragma unroll
            for (int e = 0; e < 4; ++e) { hh[e] = (h16)y[e]; ll[e] = (h16)(y[e] - (float)hh[e]); }
            h16* dst = H2X + (size_t)r * 6144 + cc;
            *(h16x4*)(dst) = (h16x4){hh[0], hh[1], hh[2], hh[3]}; *(h16x4*)(dst + 4096) = (h16x4){hh[0], hh[1], hh[2], hh[3]}; *(h16x4*)(dst + 2048) = (h16x4){ll[0], ll[1], ll[2], ll[3]};
            { int p8 = __builtin_amdgcn_cvt_pk_fp8_f32(y[0], y[1], 0, false); p8 = __builtin_amdgcn_cvt_pk_fp8_f32(y[2], y[3], p8, true); *(int*)((unsigned char*)(F.ws + WS_H2F8) + (size_t)r * DM + cc) = p8; } }
    }
}
struct SchedRT {
    int G, c;
    __device__ __forceinline__ bool next(int i, pg8::Unit& u) const { const int L = i * G + c; if (L >= 256) return false; u.pm = L >> 3; u.pn = 0; u.ko = (L & 7) * 768; u.nt = 0; u.keep = 0; return true; }
};
struct EpiLG {
    float* LGP;
    __device__ __forceinline__ void operator()(f32x4 (&acc)[2][2][4][2], const pg8::Unit& u, int wr, int wc, int fr, int fq) const {
        float* dst = LGP + (size_t)(u.ko / 768) * MLAT * NEXP;
#pragma unroll
        for (int ai = 0; ai < 2; ++ai)
#pragma unroll
            for (int m = 0; m < 4; ++m) { const int row = u.pm * 256 + ai * 128 + wr * 64 + m * 16 + fr;
#pragma unroll
                for (int bj = 0; bj < 2; ++bj)
#pragma unroll
                    for (int n = 0; n < 2; ++n) { const int col = bj * 128 + wc * 32 + 16 * n + 4 * fq; *(f32x4*)(dst + (size_t)row * NEXP + col) = acc[ai][bj][m][n]; } }
    }
};
__device__ __forceinline__ void p11_router(Frame& F) {
    pg8::Gemm g{(const h16*)(F.ws + WS_H2X), (const h16*)(F.ws + WS_WRTR), 6144, 6144, 768};
    SchedRT S; S.G = F.G; S.c = (int)blockIdx.x;
    EpiLG E{(float*)(F.ws + WS_LGP)};
    pg8::gemm_phase<EpiLG, SchedRT>(F.lds, g, S, E);
}
__device__ __forceinline__ void p12_topk(Frame& F) {
    const float* LGP = (const float*)(F.ws + WS_LGP); int* EIDX = (int*)(F.ws + WS_EIDX); float* EW = (float*)(F.ws + WS_EW); u32x2* LIST = (u32x2*)(F.ws + WS_LIST2);
    unsigned* CNT = (unsigned*)(F.ws + WS_CTL) + CW_CNT;
    const int gw = F.vcu * NWAVES + F.wave, NGW = F.G * NWAVES, lane = F.lane;
    const f32x4 bias = *(const f32x4*)(F.router_bias + 4 * lane);
    for (int t = gw; t < MLAT; t += NGW) {
        f32x4 lg = *(const f32x4*)(LGP + (size_t)t * NEXP + 4 * lane);
#pragma unroll
        for (int ks = 1; ks < 8; ++ks) lg += *(const f32x4*)(LGP + ((size_t)ks * MLAT + t) * NEXP + 4 * lane);
        float sc[4], sel[4];
#pragma unroll
        for (int i = 0; i < 4; ++i) { sc[i] = 1.0f / (1.0f + __expf(-lg[i])); sel[i] = sc[i] + bias[i]; }
        float a1 = fmaxf(sel[0], sel[1]), a2 = fminf(sel[0], sel[1]);
        { const float b1 = fmaxf(sel[2], sel[3]), b2 = fminf(sel[2], sel[3]); const float n1 = fmaxf(a1, b1), n2 = fmaxf(fminf(a1, b1), fmaxf(a2, b2)); a1 = n1; a2 = n2; }
#pragma unroll
        for (int off = 1; off < 8; off <<= 1) { const float b1 = __shfl_xor(a1, off), b2 = __shfl_xor(a2, off); const float n1 = fmaxf(a1, b1), n2 = fmaxf(fminf(a1, b1), fmaxf(a2, b2)); a1 = n1; a2 = n2; }
        const float gs = a1 + a2; const int g = lane >> 3;
        int rank = 0;
#pragma unroll
        for (int j = 0; j < 8; ++j) { const float o = __shfl(gs, 8 * j); rank += (o > gs || (o == gs && j < g)) ? 1 : 0; }
        const bool gsel = rank < 4;
        float ms[4];
#pragma unroll
        for (int i = 0; i < 4; ++i) ms[i] = gsel ? sel[i] : -INFINITY;
        float myw = 0.f; int mye = 0; float wsum = 0.f;
#pragma unroll
        for (int k = 0; k < TOPK; ++k) {
            float bv = ms[0]; int bi = 4 * lane;
#pragma unroll
            for (int i = 1; i < 4; ++i) if (ms[i] > bv) { bv = ms[i]; bi = 4 * lane + i; }
#pragma unroll
            for (int off = 1; off < 64; off <<= 1) { const float ov = __shfl_xor(bv, off); const int oi = __shfl_xor(bi, off); if (ov > bv || (ov == bv && oi < bi)) { bv = ov; bi = oi; } }
            const int ol = bi >> 2, oi = bi & 3;
            const float mysc = (oi == 0) ? sc[0] : (oi == 1) ? sc[1] : (oi == 2) ? sc[2] : sc[3];
            const float w = __shfl(mysc, ol);
            if (lane == ol) {
#pragma unroll
                for (int i = 0; i < 4; ++i) if (i == oi) ms[i] = -INFINITY; }
            wsum += w;
            if (lane == k) { myw = w; mye = bi; }
        }
        if (lane < TOPK) {
            const float wn = myw / wsum * 2.5f;
            EIDX[t * TOPK + lane] = mye; EW[t * TOPK + lane] = wn;
            const unsigned pos = atomicAdd(&CNT[mye], 1u);
            LIST[mye * MLAT + pos] = (u32x2){(unsigned)(t * TOPK + lane), __float_as_uint(wn)};
        }
    }
}
constexpr int EX_NSTG = 3, EX_ASTG = 24576, EX_WSTG = 16384, EX_A0 = 0, EX_W0 = EX_NSTG * EX_ASTG, EX_WH0 = EX_W0 + EX_NSTG * EX_WSTG, EX_WHS = 10240, EX_ROW0 = EX_WH0 + 2 * EX_WHS;
constexpr int EX_TAB0 = EX_ROW0 + 3200, EX_SCR0 = EX_TAB0 + 3072;
static_assert(EX_ROW0 == 143360 && EX_SCR0 + 8192 <= LDSCTL_OFF, "expert LDS map");
template <bool GU>
__device__ __forceinline__ void ring_w_prologue(Frame& F, const float* W, int cgrp) {
    constexpr int LDB = GU ? 512 : 2048;
    const int lane = F.lane, w = F.wave, v = 4 * (lane & 31);
    const int wcol0 = GU ? (((v >> 5) & 1) * 256 + 32 * (v >> 6) + (v & 31) + 64 * cgrp) : (v + 512 * cgrp);
    const float* wlane = W + (size_t)(4 * w + (lane >> 5)) * LDB + wcol0;
#pragma unroll
    for (int s = 0; s < 3; ++s)
#pragma unroll
        for (int j = 0; j < 2; ++j) __builtin_amdgcn_global_load_lds((const unsigned*)(wlane + (size_t)(s * 32 + 2 * j) * LDB), (LAS unsigned*)(F.lds + EX_W0 + s * EX_WSTG + (2 * w + j) * 1024), 16, 0, 2);
}
template <bool GU, int NLAY>
__device__ __forceinline__ void expert_ring(Frame& F, const float* W, const h16* Abase, const int (&arow)[3], int nr, int cgrp, h16* ACTrow0, h16* Y) {
    constexpr int KT = GU ? 64 : 8, NP = GU ? 1 : 4, LDB = GU ? 512 : 2048, NS = KT * NP;
    const int tid = F.tid, lane = F.lane, hi = lane >> 5, ln = lane & 31, cp = F.wave & 1, rg = F.wave >> 1, w = F.wave;
    const LAS int* RSLOT = (const LAS int*)(F.lds + EX_ROW0); const LAS float* RW = (const LAS float*)(F.lds + EX_ROW0 + 1536);
    const int ngrp = (nr + 15) >> 4;
    const int nA = (w < ngrp ? 1 : 0) + (w + 8 < ngrp ? 1 : 0) + (w + 16 < ngrp ? 1 : 0);
    const int achunk = ((lane & 3) ^ ((lane >> 4) & 3)) * 8;
    const int v = 4 * (lane & 31);
    const int wcol0 = GU ? (((v >> 5) & 1) * 256 + 32 * (v >> 6) + (v & 31) + 64 * cgrp) : (v + 512 * cgrp);
    const float* wlane = W + (size_t)(4 * w + (lane >> 5)) * LDB + wcol0;
    const unsigned lds0 = (unsigned)(uintptr_t)F.lds;
    const int xs = (ln >> 2) & 3;
    const unsigned aofs0 = (unsigned)((2 * rg + (ln >> 4)) * 1024 + (ln & 15) * 64 + ((hi ^ xs) * 16)), aofs1 = (unsigned)((2 * rg + (ln >> 4)) * 1024 + (ln & 15) * 64 + (((2 + hi) ^ xs) * 16));
    const unsigned tofs = (unsigned)((8 * hi + ((lane & 15) >> 2)) * 320 + (64 * cp + 16 * ((lane >> 4) & 1) + 4 * (lane & 3)) * 2);
    f32x16 acc[2 * NLAY];
#pragma unroll
    for (int i = 0; i < 2 * NLAY; ++i) acc[i] = (f32x16){};
#define EX_DMA_A(s) do { const int kt_ = (s) % KT, stg_ = (s) % EX_NSTG; \
        _Pragma("unroll") for (int j = 0; j < 3; ++j) if (j < nA) __builtin_amdgcn_global_load_lds((const unsigned*)(Abase + arow[j] + kt_ * 32 + achunk), (LAS unsigned*)(F.lds + EX_A0 + stg_ * EX_ASTG + (w + 8 * j) * 1024), 16, 0, 0); } while (0)
#define EX_DMA_W(s) do { const int pass_ = (s) / KT, kt_ = (s) % KT, stg_ = (s) % EX_NSTG; \
        _Pragma("unroll") for (int j = 0; j < 2; ++j) __builtin_amdgcn_global_load_lds((const unsigned*)(wlane + (size_t)(kt_ * 32 + 2 * j) * LDB + 128 * pass_), (LAS unsigned*)(F.lds + EX_W0 + stg_ * EX_WSTG + (2 * w + j) * 1024), 16, 0, 2); } while (0)
#define EX_WAITV(k) asm volatile("s_waitcnt vmcnt(" #k ")" ::: "memory")
#define EX_WAITN() do { if (nA == 3) EX_WAITV(5); else if (nA == 2) EX_WAITV(4); else if (nA == 1) EX_WAITV(3); else EX_WAITV(2); } while (0)
    const unsigned cvsrc = lds0 + EX_W0 + (tid >> 4) * 512 + (tid & 15) * 32, cvdst = lds0 + EX_WH0 + (tid >> 4) * 320 + (tid & 15) * 16;
    EX_DMA_A(0); EX_DMA_A(1);
    if (nA == 3) EX_WAITV(3); else if (nA == 2) EX_WAITV(2); else if (nA == 1) EX_WAITV(1); else EX_WAITV(0);
    __builtin_amdgcn_s_barrier(); asm volatile("" ::: "memory");
    { f32x4 c0, c1; asm volatile("ds_read_b128 %0, %2\n\tds_read_b128 %1, %2 offset:16\n\ts_waitcnt lgkmcnt(0)" : "=&v"(c0), "=&v"(c1) : "v"(cvsrc) : "memory");
      const h16x8 hv = pack8(c0[0], c0[1], c0[2], c0[3], c1[0], c1[1], c1[2], c1[3]); asm volatile("ds_write_b128 %0, %1" :: "v"(cvdst), "v"(hv) : "memory"); }
    typedef short s16x8 __attribute__((ext_vector_type(8)));
    for (int s = 0; s < NS; ++s) {
        if (s + 2 < NS) EX_WAITN(); else EX_WAITV(0);
        asm volatile("s_waitcnt lgkmcnt(0)" ::: "memory");
        __builtin_amdgcn_s_barrier();
        asm volatile("" ::: "memory");
        const bool pend = ((s % KT) == KT - 1);
        if (!pend) { if (s + 2 < NS) EX_DMA_A(s + 2); if (s + 3 < NS) EX_DMA_W(s + 3); }
        const unsigned abase = lds0 + EX_A0 + (s % EX_NSTG) * EX_ASTG, wbase = lds0 + EX_WH0 + (s & 1) * EX_WHS + tofs;
        const unsigned cs = cvsrc + ((s + 1) % EX_NSTG) * EX_WSTG;
        const unsigned pa0 = abase + aofs0, pa1 = abase + aofs1;
        if constexpr (NLAY < 3) {
            v4i16_t t0, t1, t2, t3, t4, t5, t6, t7; h16x8 a0[NLAY], a1[NLAY];
            asm volatile("ds_read_b64_tr_b16 %0, %8\n\tds_read_b64_tr_b16 %1, %8 offset:1280\n\tds_read_b64_tr_b16 %2, %8 offset:64\n\tds_read_b64_tr_b16 %3, %8 offset:1344\n\t"
                         "ds_read_b64_tr_b16 %4, %8 offset:5120\n\tds_read_b64_tr_b16 %5, %8 offset:6400\n\tds_read_b64_tr_b16 %6, %8 offset:5184\n\tds_read_b64_tr_b16 %7, %8 offset:6464"
                         : "=&v"(t0), "=&v"(t1), "=&v"(t2), "=&v"(t3), "=&v"(t4), "=&v"(t5), "=&v"(t6), "=&v"(t7) : "v"(wbase) : "memory");
            asm volatile("ds_read_b128 %0, %2\n\tds_read_b128 %1, %3" : "=&v"(a0[0]), "=&v"(a1[0]) : "v"(pa0), "v"(pa1) : "memory");
            if constexpr (NLAY >= 2) asm volatile("ds_read_b128 %0, %2 offset:8192\n\tds_read_b128 %1, %3 offset:8192" : "=&v"(a0[1]), "=&v"(a1[1]) : "v"(pa0), "v"(pa1) : "memory");
            asm volatile("s_waitcnt lgkmcnt(0)" ::: "memory");
            __builtin_amdgcn_sched_barrier(0);
            const h16x8 b00 = __builtin_bit_cast(h16x8, (s16x8){t0[0], t0[1], t0[2], t0[3], t1[0], t1[1], t1[2], t1[3]}), b01 = __builtin_bit_cast(h16x8, (s16x8){t2[0], t2[1], t2[2], t2[3], t3[0], t3[1], t3[2], t3[3]});
            const h16x8 b10 = __builtin_bit_cast(h16x8, (s16x8){t4[0], t4[1], t4[2], t4[3], t5[0], t5[1], t5[2], t5[3]}), b11 = __builtin_bit_cast(h16x8, (s16x8){t6[0], t6[1], t6[2], t6[3], t7[0], t7[1], t7[2], t7[3]});
#pragma unroll
            for (int i = 0; i < NLAY; ++i) { acc[2 * i] = MFMA32(a0[i], b00, acc[2 * i]); acc[2 * i + 1] = MFMA32(a0[i], b01, acc[2 * i + 1]); }
#pragma unroll
            for (int i = 0; i < NLAY; ++i) { acc[2 * i] = MFMA32(a1[i], b10, acc[2 * i]); acc[2 * i + 1] = MFMA32(a1[i], b11, acc[2 * i + 1]); }
        } else {
#pragma unroll
            for (int k16 = 0; k16 < 2; ++k16) {
                v4i16_t t0, t1, t2, t3; h16x8 a[3]; const unsigned pa = k16 ? pa1 : pa0, pw = wbase + k16 * 5120;
                asm volatile("ds_read_b64_tr_b16 %0, %4\n\tds_read_b64_tr_b16 %1, %4 offset:1280\n\tds_read_b64_tr_b16 %2, %4 offset:64\n\tds_read_b64_tr_b16 %3, %4 offset:1344"
                             : "=&v"(t0), "=&v"(t1), "=&v"(t2), "=&v"(t3) : "v"(pw) : "memory");
                asm volatile("ds_read_b128 %0, %3\n\tds_read_b128 %1, %3 offset:8192\n\tds_read_b128 %2, %3 offset:16384\n\ts_waitcnt lgkmcnt(0)" : "=&v"(a[0]), "=&v"(a[1]), "=&v"(a[2]) : "v"(pa) : "memory");
                __builtin_amdgcn_sched_barrier(0);
                const h16x8 b0 = __builtin_bit_cast(h16x8, (s16x8){t0[0], t0[1], t0[2], t0[3], t1[0], t1[1], t1[2], t1[3]}), b1 = __builtin_bit_cast(h16x8, (s16x8){t2[0], t2[1], t2[2], t2[3], t3[0], t3[1], t3[2], t3[3]});
#pragma unroll
                for (int i = 0; i < 3; ++i) { acc[2 * i] = MFMA32(a[i], b0, acc[2 * i]); acc[2 * i + 1] = MFMA32(a[i], b1, acc[2 * i + 1]); }
                __builtin_amdgcn_sched_barrier(0);
            }
        }
        if (s + 1 < NS) {
            f32x4 c0, c1; asm volatile("ds_read_b128 %0, %2\n\tds_read_b128 %1, %2 offset:16\n\ts_waitcnt lgkmcnt(0)" : "=&v"(c0), "=&v"(c1) : "v"(cs) : "memory");
            const h16x8 hv = pack8(c0[0], c0[1], c0[2], c0[3], c1[0], c1[1], c1[2], c1[3]); const unsigned cd = cvdst + ((s + 1) & 1) * EX_WHS; asm volatile("ds_write_b128 %0, %1" :: "v"(cd), "v"(hv) : "memory"); }
        if (pend) {
            const int pass = s / KT;
            int hio = hi, lno = ln; asm volatile("" : "+v"(hio), "+v"(lno));
            if (GU) {
#pragma unroll
                for (int i = 0; i < NLAY; ++i) { const int rt = rg + 4 * i;
#pragma unroll
                    for (int r = 0; r < 16; ++r) { const int row = 32 * rt + crow(r, hio);
                        if (row < nr) ACTrow0[(size_t)row * DEXP + 64 * cgrp + 32 * cp + lno] = (h16)(silu_f(acc[2 * i][r]) * acc[2 * i + 1][r]); }
                    acc[2 * i] = (f32x16){}; acc[2 * i + 1] = (f32x16){}; }
            } else {
                const unsigned scr = lds0 + EX_SCR0 + w * 1024;
                unsigned char* Y8 = (unsigned char*)Y;
#pragma unroll
                for (int i = 0; i < NLAY; ++i) { const int rt = rg + 4 * i;
#pragma unroll
                    for (int g8 = 0; g8 < 4; ++g8) {
#pragma unroll
                        for (int q = 0; q < 4; ++q) { const int lr = 4 * hio + q; const float wt = RW[32 * rt + 8 * g8 + lr];
                            const int pk = __builtin_amdgcn_cvt_pk_fp8_f32(acc[2 * i][4 * g8 + q] * wt, acc[2 * i + 1][4 * g8 + q] * wt, 0, false); const int pk1 = pk >> 8; const unsigned wa = scr + lr * 64 + lno;
                            asm volatile("ds_write_b8 %0, %1\n\tds_write_b8 %0, %2 offset:32" :: "v"(wa), "v"(pk), "v"(pk1) : "memory"); }
                        u32x2 pv; const unsigned ra = scr + (lane >> 3) * 64 + (lane & 7) * 8;
                        asm volatile("s_waitcnt lgkmcnt(0)\n\tds_read_b64 %0, %1\n\ts_waitcnt lgkmcnt(0)" : "=&v"(pv) : "v"(ra) : "memory");
                        const int grow = 32 * rt + 8 * g8 + (lane >> 3);
                        if (grow < nr) { const int slot = RSLOT[grow]; *(u32x2*)(Y8 + (size_t)slot * DM + 512 * cgrp + 128 * pass + 64 * cp + (lane & 7) * 8) = pv; }
                    }
                    acc[2 * i] = (f32x16){}; acc[2 * i + 1] = (f32x16){}; }
            }
            if (s + 2 < NS) EX_DMA_A(s + 2);
            if (s + 3 < NS) EX_DMA_W(s + 3);
        }
    }
    asm volatile("s_waitcnt vmcnt(0) lgkmcnt(0)" ::: "memory");
    __builtin_amdgcn_s_barrier();
    asm volatile("" ::: "memory");
#undef EX_DMA_A
#undef EX_DMA_W
#undef EX_WAITV
#undef EX_WAITN
}

constexpr int G8_NSTG = 4, G8_ASTG = 12288, G8_WSTG = 16384, G8_A0 = 0, G8_W0 = G8_NSTG * G8_ASTG, G8_WH0 = G8_W0 + G8_NSTG * G8_WSTG, G8_WHS = 4096;
static_assert(G8_WH0 + 2 * G8_WHS <= EX_ROW0, "gu8 LDS map");
__device__ __forceinline__ void gu8_w_prologue(Frame& F, const float* W, int cgrp) {
    const int lane = F.lane, w = F.wave, v = 4 * (lane & 31);
    const int wcol0 = ((v >> 5) & 1) * 256 + 32 * (v >> 6) + (v & 31) + 64 * cgrp;
    const float* wlane = W + (size_t)(4 * w + (lane >> 5)) * 512 + wcol0;
#pragma unroll
    for (int s = 0; s < 4; ++s)
#pragma unroll
        for (int j = 0; j < 2; ++j) __builtin_amdgcn_global_load_lds((const unsigned*)(wlane + (size_t)(s * 32 + 2 * j) * 512), (LAS unsigned*)(F.lds + G8_W0 + s * G8_WSTG + (2 * w + j) * 1024), 16, 0, 2);
}
template <int NLAY>
__device__ __forceinline__ void expert_ring_gu8(Frame& F, const float* W, const unsigned char* A8, const int (&arow)[2], int nr, int cgrp, h16* ACTrow0) {
    constexpr int NS = 64;
    typedef long v2i64 __attribute__((ext_vector_type(2)));
    const int tid = F.tid, lane = F.lane, hi = lane >> 5, ln = lane & 31, cp = F.wave & 1, rg = F.wave >> 1, w = F.wave;
    const int ngrp = (nr + 31) >> 5;
    const int nA = (w < ngrp ? 1 : 0) + (w + 8 < ngrp ? 1 : 0);
    const int v = 4 * (lane & 31);
    const int wcol0 = ((v >> 5) & 1) * 256 + 32 * (v >> 6) + (v & 31) + 64 * cgrp;
    const float* wlane = W + (size_t)(4 * w + (lane >> 5)) * 512 + wcol0;
    const unsigned lds0 = (unsigned)(uintptr_t)F.lds;
    const unsigned aofs = (unsigned)(rg * 1024 + ln * 32 + hi * 16);
    const unsigned bofs = (unsigned)((64 * cp + ln) * 32 + hi * 16);
    const unsigned cvsrc = lds0 + G8_W0 + (tid >> 7) * 8 * 512 + (tid & 127) * 4, cvdst = lds0 + G8_WH0 + (tid & 127) * 32 + (tid >> 7) * 8;
    f32x16 acc[2 * NLAY];
#pragma unroll
    for (int i = 0; i < 2 * NLAY; ++i) acc[i] = (f32x16){};
#define G8_DMA_A(s) do { const int stg_ = (s) & 3; \
        _Pragma("unroll") for (int j = 0; j < 2; ++j) if (j < nA) __builtin_amdgcn_global_load_lds((const unsigned*)(A8 + arow[j] + (s) * 32 + (lane & 1) * 16), (LAS unsigned*)(F.lds + G8_A0 + stg_ * G8_ASTG + (w + 8 * j) * 1024), 16, 0, 0); } while (0)
#define G8_DMA_W(s) do { const int stg_ = (s) & 3; \
        _Pragma("unroll") for (int j = 0; j < 2; ++j) __builtin_amdgcn_global_load_lds((const unsigned*)(wlane + (size_t)((s) * 32 + 2 * j) * 512), (LAS unsigned*)(F.lds + G8_W0 + stg_ * G8_WSTG + (2 * w + j) * 1024), 16, 0, 2); } while (0)
#define G8_WAITV(k) asm volatile("s_waitcnt vmcnt(" #k ")" ::: "memory")
#define G8_CVT(s) do { float c_[8]; const unsigned cs_ = cvsrc + ((s) & 3) * G8_WSTG; \
        asm volatile("ds_read_b32 %0, %8\n\tds_read_b32 %1, %8 offset:512\n\tds_read_b32 %2, %8 offset:1024\n\tds_read_b32 %3, %8 offset:1536\n\tds_read_b32 %4, %8 offset:2048\n\tds_read_b32 %5, %8 offset:2560\n\tds_read_b32 %6, %8 offset:3072\n\tds_read_b32 %7, %8 offset:3584\n\ts_waitcnt lgkmcnt(0)" \
                     : "=&v"(c_[0]), "=&v"(c_[1]), "=&v"(c_[2]), "=&v"(c_[3]), "=&v"(c_[4]), "=&v"(c_[5]), "=&v"(c_[6]), "=&v"(c_[7]) : "v"(cs_) : "memory"); \
        int p0_ = __builtin_amdgcn_cvt_pk_fp8_f32(c_[0] * 64.f, c_[1] * 64.f, 0, false); p0_ = __builtin_amdgcn_cvt_pk_fp8_f32(c_[2] * 64.f, c_[3] * 64.f, p0_, true); \
        int p1_ = __builtin_amdgcn_cvt_pk_fp8_f32(c_[4] * 64.f, c_[5] * 64.f, 0, false); p1_ = __builtin_amdgcn_cvt_pk_fp8_f32(c_[6] * 64.f, c_[7] * 64.f, p1_, true); \
        const u32x2 pk_ = {(unsigned)p0_, (unsigned)p1_}; const unsigned cd_ = cvdst + ((s) & 1) * G8_WHS; asm volatile("ds_write_b64 %0, %1" :: "v"(cd_), "v"(pk_) : "memory"); } while (0)
    G8_DMA_A(0); G8_DMA_A(1); G8_DMA_A(2);
    if (nA == 2) G8_WAITV(4); else if (nA == 1) G8_WAITV(2); else G8_WAITV(0);
    __builtin_amdgcn_s_barrier(); asm volatile("" ::: "memory");
    G8_CVT(0);
    for (int s = 0; s < NS; ++s) {
        if (s >= 2 && s + 4 < NS) { if (nA == 2) G8_WAITV(8); else if (nA == 1) G8_WAITV(6); else G8_WAITV(4); }
        else if (s < 2) { if (nA == 2) G8_WAITV(4); else if (nA == 1) G8_WAITV(3); else G8_WAITV(2); }
        else G8_WAITV(0);
        asm volatile("s_waitcnt lgkmcnt(0)" ::: "memory");
        __builtin_amdgcn_s_barrier();
        asm volatile("" ::: "memory");
        if (s + 3 < NS) G8_DMA_A(s + 3);
        if (s + 4 < NS) G8_DMA_W(s + 4);
        const unsigned pa = lds0 + G8_A0 + (s & 3) * G8_ASTG + aofs, pb = lds0 + G8_WH0 + (s & 1) * G8_WHS + bofs;
        v2i64 a[NLAY], b0, b1;
        asm volatile("ds_read_b128 %0, %2\n\tds_read_b128 %1, %2 offset:1024" : "=&v"(b0), "=&v"(b1) : "v"(pb) : "memory");
        asm volatile("ds_read_b128 %0, %1" : "=&v"(a[0]) : "v"(pa) : "memory");
        if constexpr (NLAY >= 2) asm volatile("ds_read_b128 %0, %1 offset:4096" : "=&v"(a[1]) : "v"(pa) : "memory");
        if constexpr (NLAY >= 3) asm volatile("ds_read_b128 %0, %1 offset:8192" : "=&v"(a[2]) : "v"(pa) : "memory");
        asm volatile("s_waitcnt lgkmcnt(0)" ::: "memory");
        __builtin_amdgcn_sched_barrier(0);
#pragma unroll
        for (int i = 0; i < NLAY; ++i) { acc[2 * i] = __builtin_amdgcn_mfma_f32_32x32x16_fp8_fp8(a[i][0], b0[0], acc[2 * i], 0, 0, 0); acc[2 * i + 1] = __builtin_amdgcn_mfma_f32_32x32x16_fp8_fp8(a[i][0], b1[0], acc[2 * i + 1], 0, 0, 0); }
#pragma unroll
        for (int i = 0; i < NLAY; ++i) { acc[2 * i] = __builtin_amdgcn_mfma_f32_32x32x16_fp8_fp8(a[i][1], b0[1], acc[2 * i], 0, 0, 0); acc[2 * i + 1] = __builtin_amdgcn_mfma_f32_32x32x16_fp8_fp8(a[i][1], b1[1], acc[2 * i + 1], 0, 0, 0); }
        if (s + 1 < NS) G8_CVT(s + 1);
    }
    {
        int hio = hi, lno = ln; asm volatile("" : "+v"(hio), "+v"(lno));
#pragma unroll
        for (int i = 0; i < NLAY; ++i) { const int rt = rg + 4 * i;
#pragma unroll
            for (int r = 0; r < 16; ++r) { const int row = 32 * rt + crow(r, hio);
                if (row < nr) ACTrow0[(size_t)row * DEXP + 64 * cgrp + 32 * cp + lno] = (h16)(silu_f(acc[2 * i][r] * 0.015625f) * (acc[2 * i + 1][r] * 0.015625f)); } }
    }
    asm volatile("s_waitcnt vmcnt(0) lgkmcnt(0)" ::: "memory");
    __builtin_amdgcn_s_barrier();
    asm volatile("" ::: "memory");
#undef G8_DMA_A
#undef G8_DMA_W
#undef G8_WAITV
#undef G8_CVT
}
template <bool GU>
__device__ __forceinline__ void p13_expert_phase(Frame& F, int qid) {
    const h16* H2X = (const h16*)(F.ws + WS_H2X); h16* Y = (h16*)(F.ws + WS_Y); h16* ACT = (h16*)(F.ws + WS_ACT);
    const unsigned* CNT = (const unsigned*)(F.ws + WS_CTL) + CW_CNT; unsigned* QH = (unsigned*)(F.ws + WS_CTL) + CW_Q + 64 * qid;
    LAS int* RSLOT = (LAS int*)(F.lds + EX_ROW0); LAS float* RW = (LAS float*)(F.lds + EX_ROW0 + 1536); LAS int* RED = (LAS int*)(F.lds + EX_ROW0 + 3072);
    LAS int* CN = (LAS int*)(F.lds + EX_TAB0); LAS int* ORD = CN + 256; LAS int* OFF = CN + 512;
    __syncthreads();
    if (F.tid < NEXP) CN[F.tid] = (int)CNT[F.tid];
    __syncthreads();
    if (F.tid < NEXP) { const int c = CN[F.tid]; int rank = 0, off = 0;
        for (int j = 0; j < NEXP; ++j) { const int cj = CN[j]; rank += (cj > c || (cj == c && j < F.tid)) ? 1 : 0; off += (j < F.tid) ? cj : 0; }
        ORD[rank] = F.tid; OFF[F.tid] = off; }
    __syncthreads();
    const u32x2* LIST2 = (const u32x2*)(F.ws + WS_LIST2);
    if (F.tid == 0) RED[0] = (int)__hip_atomic_fetch_add(QH, 1u, __ATOMIC_RELAXED, __HIP_MEMORY_SCOPE_AGENT);
    __syncthreads();
    int u = RED[0];
    while (u < NEXP * 4) {
        const int e = ORD[u >> 2], cg = u & 3, cnt = CN[e], off_e = OFF[e];
        const float* Wgu = F.w_exp_gu + (size_t)e * DM * 512; const float* Wdn = F.w_exp_down + (size_t)e * DEXP * DM;
        for (int rs = 0; rs < cnt; rs += 384) {
            const int nr = (cnt - rs) < 384 ? (cnt - rs) : 384;
            __syncthreads();
            if (GU) gu8_w_prologue(F, Wgu, cg); else ring_w_prologue<false>(F, Wdn, cg);
            if (F.tid < 384) { u32x2 ent = {0u, 0u}; if (F.tid < nr) ent = LIST2[e * MLAT + rs + F.tid]; RSLOT[F.tid] = (int)ent.x; RW[F.tid] = __uint_as_float(ent.y); }
            __syncthreads();
            h16* ACTrow0 = ACT + (size_t)(off_e + rs) * DEXP;
            int arow[3];
            if (GU) {
                int ar8[2];
#pragma unroll
                for (int j = 0; j < 2; ++j) { const int r = 32 * (F.wave + 8 * j) + (F.lane >> 1); ar8[j] = (r < 384 ? (RSLOT[r] >> 3) : 0) * DM; }
                const unsigned char* A8 = (const unsigned char*)(F.ws + WS_H2F8);
                if (nr > 256) expert_ring_gu8<3>(F, Wgu, A8, ar8, nr, cg, ACTrow0); else if (nr > 128) expert_ring_gu8<2>(F, Wgu, A8, ar8, nr, cg, ACTrow0); else expert_ring_gu8<1>(F, Wgu, A8, ar8, nr, cg, ACTrow0);
            } else {
#pragma unroll
                for (int j = 0; j < 3; ++j) { const int r = 16 * (F.wave + 8 * j) + (F.lane >> 2); arow[j] = ((r < nr) ? r : 0) * DEXP; }
                if (nr > 256) expert_ring<false, 3>(F, Wdn, ACTrow0, arow, nr, cg, ACTrow0, Y); else if (nr > 128) expert_ring<false, 2>(F, Wdn, ACTrow0, arow, nr, cg, ACTrow0, Y); else expert_ring<false, 1>(F, Wdn, ACTrow0, arow, nr, cg, ACTrow0, Y);
            }
        }
        __syncthreads();
        if (F.tid == 0) RED[0] = (int)__hip_atomic_fetch_add(QH, 1u, __ATOMIC_RELAXED, __HIP_MEMORY_SCOPE_AGENT);
        __syncthreads();
        u = RED[0];
    }
}
struct SchedSG {
    int G, c;
    __device__ __forceinline__ bool next(int i, pg8::Unit& u) const { const int L = i * G + c; if (L >= 256) return false; u.pm = L >> 3; u.pn = (L >> 2) & 1; u.ko = (L & 3) * 512; u.nt = 0; u.keep = 0; return true; }
};
struct EpiSGP {
    float* SGP;
    __device__ __forceinline__ void operator()(f32x4 (&acc)[2][2][4][2], const pg8::Unit& u, int wr, int wc, int fr, int fq) const {
        float* dst = SGP + (size_t)(u.ko / 512) * MLAT * 512;
#pragma unroll
        for (int ai = 0; ai < 2; ++ai)
#pragma unroll
            for (int m = 0; m < 4; ++m) { const int row = u.pm * 256 + ai * 128 + wr * 64 + m * 16 + fr;
#pragma unroll
                for (int bj = 0; bj < 2; ++bj)
#pragma unroll
                    for (int n = 0; n < 2; ++n) { const int col = u.pn * 256 + bj * 128 + wc * 32 + 16 * n + 4 * fq; *(f32x4*)(dst + (size_t)row * 512 + col) = acc[ai][bj][m][n]; } }
    }
};
__device__ __forceinline__ void p11b_shared_gu(Frame& F) {
    pg8::Gemm g{(const h16*)(F.ws + WS_H2X), (const h16*)(F.ws + WS_WSGU), 6144, 2048, 512};
    SchedSG S; S.G = F.G; S.c = (int)blockIdx.x;
    EpiSGP E{(float*)(F.ws + WS_SGP)};
    pg8::gemm_phase<EpiSGP, SchedSG>(F.lds, g, S, E);
}
__device__ __forceinline__ void p12b_shared_act(Frame& F) {
    const float* SGP = (const float*)(F.ws + WS_SGP); h16* ACTS = (h16*)(F.ws + WS_ACTS);
    for (int q = blockIdx.x * NTHR + F.tid; q < MLAT * 64; q += F.G * NTHR) {
        const int row = q >> 6, j = (q & 63) * 4, pg = 32 * (j >> 4) + (j & 15);
        f32x4 gv = {0.f, 0.f, 0.f, 0.f}, uv = gv;
#pragma unroll
        for (int ks = 0; ks < 4; ++ks) { const float* p = SGP + ((size_t)ks * MLAT + row) * 512 + pg; gv += *(const f32x4*)p; uv += *(const f32x4*)(p + 16); }
        u32x2 w; w.x = pk2h(silu_f(gv[0]) * uv[0], silu_f(gv[1]) * uv[1]); w.y = pk2h(silu_f(gv[2]) * uv[2], silu_f(gv[3]) * uv[3]);
        *(u32x2*)(ACTS + (size_t)row * DEXP + j) = w;
    }
}
struct EpiYsh {
    h16* YSH;
    __device__ __forceinline__ void operator()(f32x4 (&acc)[2][2][4][2], const pg8::Unit& u, int wr, int wc, int fr, int fq) const {
#pragma unroll
        for (int ai = 0; ai < 2; ++ai)
#pragma unroll
            for (int m = 0; m < 4; ++m) { const int row = u.pm * 256 + ai * 128 + wr * 64 + m * 16 + fr;
#pragma unroll
                for (int bj = 0; bj < 2; ++bj)
#pragma unroll
                    for (int n = 0; n < 2; ++n) { const int col = u.pn * 256 + bj * 128 + wc * 32 + 16 * n + 4 * fq; const f32x4 a = acc[ai][bj][m][n];
                        u32x2 w; w.x = pk2h(a[0], a[1]); w.y = pk2h(a[2], a[3]); *(u32x2*)(YSH + (size_t)row * DM + col) = w; } }
    }
};
struct SchedOne {
    int pm, pn;
    __device__ __forceinline__ bool next(int i, pg8::Unit& u) const { if (i != 0) return false; u.pm = pm; u.pn = pn; u.ko = 0; u.nt = 0; u.keep = 0; return true; }
};
__device__ __forceinline__ void p15_shared_down_dyn(Frame& F, int qid) {
    unsigned* QH = (unsigned*)(F.ws + WS_CTL) + CW_Q + 64 * 8 * qid;
    LAS int* RED = (LAS int*)(F.lds + EX_ROW0 + 3072);
    for (;;) {
        __syncthreads();
        if (F.tid == 0) RED[0] = (int)__hip_atomic_fetch_add(QH, 1u, __ATOMIC_RELAXED, __HIP_MEMORY_SCOPE_AGENT);
        __syncthreads();
        const int t = RED[0];
        if (t >= 256) break;
        pg8::Gemm g{(const h16*)(F.ws + WS_ACTS), (const h16*)(F.ws + WS_WSDN), 256, 256, 256};
        SchedOne S; S.pm = t >> 3; S.pn = t & 7;
        EpiYsh E{(h16*)(F.ws + WS_YSH)};
        pg8::gemm_phase<EpiYsh, SchedOne>(F.lds, g, S, E);
    }
}
__device__ __forceinline__ void p15_shared_down(Frame& F) {
    pg8::Gemm g{(const h16*)(F.ws + WS_ACTS), (const h16*)(F.ws + WS_WSDN), 256, 256, 256};
    pg8::StaticOrder S; S.init(MLAT, DM, F.G, (int)blockIdx.x);
    EpiYsh E{(h16*)(F.ws + WS_YSH)};
    pg8::gemm_phase<EpiYsh, pg8::StaticOrder>(F.lds, g, S, E);
}
__device__ __forceinline__ void p16_combine(Frame& F) {
    const float* X1 = (const float*)(F.ws + WS_X1); const float* MOD = (const float*)(F.ws + WS_MOD); const h16* Y = (const h16*)(F.ws + WS_Y); const h16* YSH = (const h16*)(F.ws + WS_YSH);
    const int gw = F.vcu * NWAVES + F.wave, NGW = F.G * NWAVES;
    for (int r = gw; r < MLAT; r += NGW) {
        const int b = r / SEQ;
        f32x4 xv[8]; float ss = 0.f;
#pragma unroll
        for (int j = 0; j < 8; ++j) { const int cc = 4 * F.lane + 256 * j;
            f32x4 m = {0.f, 0.f, 0.f, 0.f};
#pragma unroll
            for (int k = 0; k < TOPK; ++k) { const int yv = *(const int*)((const unsigned char*)Y + (size_t)(r * TOPK + k) * DM + cc);
                const f32x2 lo = __builtin_amdgcn_cvt_pk_f32_fp8(yv, false), hi2 = __builtin_amdgcn_cvt_pk_f32_fp8(yv, true); m += (f32x4){lo[0], lo[1], hi2[0], hi2[1]}; }
            { const h16x4 yv = *(const h16x4*)(YSH + (size_t)r * DM + cc); m += (f32x4){(float)yv[0], (float)yv[1], (float)yv[2], (float)yv[3]}; }
            const f32x4 g2 = *(const f32x4*)(MOD + (size_t)b * (6 * DM) + 5 * DM + cc);
            xv[j] = *(const f32x4*)(X1 + (size_t)r * DM + cc) + g2 * m;
            ss += (xv[j].x * xv[j].x + xv[j].y * xv[j].y) + (xv[j].z * xv[j].z + xv[j].w * xv[j].w); }
        const float rstd = 1.0f / sqrtf(wave_sum(ss) * (1.0f / DM) + EPS);
#pragma unroll
        for (int j = 0; j < 8; ++j) { const int cc = 4 * F.lane + 256 * j; const f32x4 nw = *(const f32x4*)(F.final_norm + cc);
            *(f32x4*)(F.out + (size_t)r * DM + cc) = xv[j] * rstd * nw; }
    }
}

__device__ __forceinline__ void p_final_plain(Frame& F, const float* xin) {
    const int gw = F.vcu * NWAVES + F.wave, NGW = F.G * NWAVES;
    for (int r = gw; r < MLAT; r += NGW) {
        const float* src = xin + (size_t)r * DM;
        f32x4 xv[8]; float ss = 0.f;
#pragma unroll
        for (int j = 0; j < 8; ++j) { xv[j] = *(const f32x4*)(src + 4 * F.lane + 256 * j); ss += (xv[j].x * xv[j].x + xv[j].y * xv[j].y) + (xv[j].z * xv[j].z + xv[j].w * xv[j].w); }
        const float rstd = 1.0f / sqrtf(wave_sum(ss) * (1.0f / DM) + EPS);
#pragma unroll
        for (int j = 0; j < 8; ++j) { const int cc = 4 * F.lane + 256 * j; const f32x4 nw = *(const f32x4*)(F.final_norm + cc);
            *(f32x4*)(F.out + (size_t)r * DM + cc) = xv[j] * rstd * nw; }
    }
}

constexpr int N_PHASES = 15;
#ifndef DUP_PHASE
#define DUP_PHASE -1
#endif
#ifndef DUP_VAR
#define DUP_VAR 7
#endif
struct Args { const float* in[22]; float* out; unsigned char* ws; int ph_lo, ph_hi; };
__global__ void __launch_bounds__(NTHR, 2) mk_fwd(Args args) {
    extern __shared__ __attribute__((aligned(16))) unsigned char lds_raw[];
    Frame F;
    F.lds = (LAS unsigned char*)lds_raw;
    F.tid = threadIdx.x; F.lane = F.tid & 63; F.wave = __builtin_amdgcn_readfirstlane(F.tid >> 6);
    F.G = gridDim.x; { const int bx = blockIdx.x; F.vcu = (F.G % 8 == 0) ? (bx % 8) * (F.G / 8) + bx / 8 : bx; }
    F.x = args.in[0]; F.c = args.in[1]; F.ctx = args.in[2]; F.c_ctx = args.in[3]; F.w_mod = args.in[4]; F.b_mod = args.in[5]; F.norm_attn = args.in[6]; F.norm_ffn = args.in[7];
    F.w_in = args.in[8]; F.ret_decay = args.in[9]; F.diff_lambda = args.in[10]; F.diff_subln = args.in[11]; F.w_ret_o = args.in[12]; F.w_diff_o = args.in[13]; F.w_out = args.in[14];
    F.w_router = args.in[15]; F.router_bias = args.in[16]; F.w_exp_gu = args.in[17]; F.w_exp_down = args.in[18]; F.w_sh_gu = args.in[19]; F.w_sh_down = args.in[20]; F.final_norm = args.in[21];
    F.out = args.out; F.ws = args.ws;
    volatile LAS unsigned* MISC = (volatile LAS unsigned*)(F.lds + LDSCTL_OFF);
    for (int u = F.tid; u < (LDS_BYTES - LDSCTL_OFF) / 4; u += NTHR) ((LAS unsigned*)(F.lds + LDSCTL_OFF))[u] = 0u;
    __syncthreads();
    const int lo = args.ph_lo, hi = args.ph_hi;
    const bool multi = (hi - lo) > 1;
    XcdBarrier bar; bar.bar = (unsigned*)(F.ws + WS_CTL) + CW_BAR; bar.x = 0; bar.st = nullptr;
    if (multi) bar = xcd_barrier_post((unsigned*)(F.ws + WS_CTL) + CW_BAR, MISC + 8);
#define IN(k) (lo <= (k) && (k) < hi)
#define SEAM(k) do { if (IN(k) && IN((k) + 1)) xcd_barrier(bar); } while (0)

#define RUNP(k, call) do { if (IN(k)) { call; if (DUP_PHASE == (k)) { xcd_barrier(bar); call; } } SEAM(k); } while (0)
    RUNP(0, p0a_mod(F));
    RUNP(1, (p1_norm1(F), p0b_weights(F)));
    RUNP(2, (p2_gemm1(F), p0c_weights_dyn(F, 5)));
    RUNP(3, p3_ret_local(F));
    RUNP(4, p4_ret_scan(F));
    RUNP(5, p5_ret_out(F));
    RUNP(6, p6_attn(F));
    RUNP(7, p7_gemm2(F));
    RUNP(8, p9_gemm3(F));
    RUNP(9, p10_norm2(F));
    RUNP(10, (p11_router(F), p11b_shared_gu(F)));
    RUNP(11, (p12_topk(F), p12b_shared_act(F)));
    if (IN(12)) { p13_expert_phase<true>(F, 0); p15_shared_down_dyn(F, 4); if (DUP_PHASE == 12) { xcd_barrier(bar); p13_expert_phase<true>(F, 2); } } SEAM(12);
    if (IN(13)) { p13_expert_phase<false>(F, 1); if (DUP_PHASE == 13) { xcd_barrier(bar); p13_expert_phase<false>(F, 3); } } SEAM(13);
    if (IN(14)) { p16_combine(F); }
#undef RUNP
#undef IN
#undef SEAM
}

constexpr bool ONE_LAUNCH = true;
extern "C" void kernel_launch(void* const* d_in, const int* in_sizes, int n_in, void* d_out, int out_size, void* d_ws, size_t ws_size, hipStream_t stream) {
    static int grid = 0;
    if (grid == 0) {
        if (n_in != 22 || out_size != MLAT * DM || ws_size < WS_END) { fprintf(stderr, "kernel_launch: unexpected sizes n_in %d out %d ws %zu\n", n_in, out_size, ws_size); grid = -1; return; }
        int dev = 0, cus = 0;
        if (hipGetDevice(&dev) != hipSuccess || hipDeviceGetAttribute(&cus, hipDeviceAttributeMultiprocessorCount, dev) != hipSuccess) { grid = -1; return; }
        if (hipFuncSetAttribute((const void*)mk_fwd, hipFuncAttributeMaxDynamicSharedMemorySize, LDS_BYTES) != hipSuccess) { fprintf(stderr, "kernel_launch: hipFuncSetAttribute failed\n"); grid = -1; return; }
        int per_cu = 0;
        if (hipOccupancyMaxActiveBlocksPerMultiprocessor(&per_cu, (const void*)mk_fwd, NTHR, LDS_BYTES) != hipSuccess || per_cu < 1) fprintf(stderr, "kernel_launch: occupancy query reports %d\n", per_cu);
        (void)hipGetLastError();
        grid = cus;
    }
    if (grid < 0) return;
    (void)hipMemsetAsync((char*)d_ws + WS_CTL, 0, CTL_ZERO_BYTES, stream);
    Args a{};
    for (int i = 0; i < 22; ++i) a.in[i] = (const float*)d_in[i];
    a.out = (float*)d_out; a.ws = (unsigned char*)d_ws;
    if (ONE_LAUNCH) {
        a.ph_lo = 0; a.ph_hi = N_PHASES;
        hipLaunchKernelGGL(mk_fwd, dim3(grid), dim3(NTHR), LDS_BYTES, stream, a);
    } else {
        for (int p = 0; p < N_PHASES; ++p) { a.ph_lo = p; a.ph_hi = p + 1; hipLaunchKernelGGL(mk_fwd, dim3(grid), dim3(NTHR), LDS_BYTES, stream, a); }
    }
}
```

```cpp
#include <hip/hip_runtime.h>
#include <cstdio>
#include <cstdint>

#define LAS __attribute__((address_space(3)))
#define GAS __attribute__((address_space(1)))
typedef _Float16 h16;
typedef _Float16 h16x8 __attribute__((ext_vector_type(8)));
typedef _Float16 h16x4 __attribute__((ext_vector_type(4)));
typedef _Float16 h16x2 __attribute__((ext_vector_type(2)));
typedef float f32x2 __attribute__((ext_vector_type(2)));
typedef float f32x4 __attribute__((ext_vector_type(4)));
typedef float f32x16 __attribute__((ext_vector_type(16)));
typedef unsigned u32x4 __attribute__((ext_vector_type(4)));
typedef unsigned u32x2 __attribute__((ext_vector_type(2)));
typedef short v4i16_t __attribute__((ext_vector_type(4)));

constexpr int DM = 2048, NBATCH = 2, SEQ = 4096, CTXL = 256;
constexpr int MLAT = NBATCH * SEQ, MCTX = NBATCH * CTXL, MALL = MLAT + MCTX;
constexpr int IN_COLS = 13312, KV_COLS = 5120;
constexpr int C_RK = 0, C_RV = 1024, C_DK = 3072, C_DV = 4096, C_RQ = 5120, C_RG = 6144, C_DQ = 8192, C_GR = 9216, C_GD = 11264;
constexpr int NEXP = 256, TOPK = 8, DEXP = 256;
constexpr float EPS = 1e-6f;
constexpr int NWAVES = 8, NTHR = 512;

constexpr size_t MiB = 1u << 20;
constexpr size_t WS_CTL = 0, CTL_ZERO_BYTES = 1 * MiB;
constexpr size_t WS_MODP = 1 * MiB;
constexpr size_t WS_MOD = 3 * MiB;
constexpr size_t WS_ROPE = 3 * MiB + 512 * 1024;
constexpr size_t WS_WINT = 4 * MiB;
constexpr size_t WS_WRET = 56 * MiB;
constexpr size_t WS_WDIF = 64 * MiB;
constexpr size_t WS_WOUT = 68 * MiB;
constexpr size_t WS_WSGU = 76 * MiB;
constexpr size_t WS_WSDN = 78 * MiB;
constexpr size_t WS_WRTR = 79 * MiB;
constexpr size_t WS_H = 82 * MiB;
constexpr size_t WS_P = 116 * MiB;
constexpr size_t WS_LST = 340 * MiB;
constexpr size_t WS_SST = 408 * MiB;
constexpr size_t WS_ARET = 472 * MiB;
constexpr size_t WS_ADIF = 504 * MiB;
constexpr size_t WS_T = 520 * MiB;
constexpr size_t WS_U = 584 * MiB;
constexpr size_t WS_X1 = 616 * MiB;
constexpr size_t WS_H2X = 680 * MiB;
constexpr size_t WS_LG = 776 * MiB;
constexpr size_t WS_EIDX = 784 * MiB;
constexpr size_t WS_EW = 785 * MiB;
constexpr size_t WS_LIST = 786 * MiB;
constexpr size_t WS_ACTS = 794 * MiB;
constexpr size_t WS_YSH = 798 * MiB;
constexpr size_t WS_Y = 830 * MiB;
constexpr size_t WS_ACT = 1086 * MiB;
constexpr size_t WS_LGP = 1118 * MiB;
constexpr size_t WS_SGP = 1182 * MiB;
constexpr size_t WS_ACAT = 1246 * MiB;
constexpr size_t WS_WCAT = 1294 * MiB;
constexpr size_t WS_LIST2 = 1306 * MiB;
constexpr size_t WS_H2F8 = 1322 * MiB;
constexpr size_t WS_END = 1338 * MiB;

constexpr int CW_BAR = 4096;
constexpr int CW_CNT = 16384;
constexpr int CW_Q = 20480;

constexpr int RING_BYTES = 131072;
constexpr int LDS_BYTES = 163840;
constexpr int LDSCTL_OFF = LDS_BYTES - 512;
constexpr int LDS_TICKET = 146432;

#define XB_TMO      128
#define XB_XCNT(j)  (256  + 64 * (j))
#define XB_XSUB(j)  (1280 + 64 * (j))
#define XB_XGEN(j)  (2304 + 64 * (j))
#define XB_TOP      3328
#define XB_TOPGEN   3392
#define XCD_BAR_WORDS 3456
#define XB_SPIN_CAP (1u << 18)

__device__ __forceinline__ unsigned xb_ld(unsigned* p)              { return __hip_atomic_load(p, __ATOMIC_RELAXED, __HIP_MEMORY_SCOPE_AGENT); }
__device__ __forceinline__ unsigned xb_add(unsigned* p, unsigned v) { return __hip_atomic_fetch_add(p, v, __ATOMIC_RELAXED, __HIP_MEMORY_SCOPE_AGENT); }
__device__ __forceinline__ unsigned xb_xcc_id() { return (unsigned)__builtin_amdgcn_s_getreg((3 << 11) | 20) & 0xFu; }
#define XB_SPIN(cond, bar) do { unsigned _sp = 0; while (cond) { __builtin_amdgcn_s_sleep(1); \
    if ((++_sp & 255u) == 0u) { if (xb_ld(&(bar)[XB_TMO])) break; if (_sp > XB_SPIN_CAP) { atomicAdd(&(bar)[XB_TMO], 1u); break; } } } } while (0)

struct XcdBarrier { unsigned* bar; unsigned x; volatile LAS unsigned* st; };

__device__ __forceinline__ XcdBarrier xcd_barrier_post(unsigned* bar, volatile LAS unsigned* st) {
    XcdBarrier b; b.bar = bar; b.x = xb_xcc_id(); b.st = st;
    if (threadIdx.x == 0) (void)xb_add(&bar[XB_XCNT(b.x)], 1u);
    return b;
}
__device__ __forceinline__ void xcd_barrier_complete(unsigned* bar, unsigned x, unsigned& nloc, unsigned& nx) {
    const unsigned G = gridDim.x * gridDim.y * gridDim.z;
    unsigned sum, cnt, mine, sp = 0u;
    for (;;) {
        sum = 0u; cnt = 0u; mine = 0u;
#pragma unroll
        for (unsigned j = 0; j < 16; ++j) { const unsigned c = xb_ld(&bar[XB_XCNT(j)]); sum += c; cnt += (c > 0u) ? 1u : 0u; mine = (j == x) ? c : mine; }
        if (sum == G) break;
        __builtin_amdgcn_s_sleep(1);
        if ((++sp & 255u) == 0u) { if (xb_ld(&bar[XB_TMO])) break; if (sp > XB_SPIN_CAP) { atomicAdd(&bar[XB_TMO], 1u); break; } }
    }
    nloc = mine > 0u ? mine : 1u; nx = cnt > 0u ? cnt : 1u;
}
__device__ __forceinline__ void xcd_barrier(const XcdBarrier& b) {
    asm volatile("s_waitcnt vmcnt(0)" ::: "memory");
    __syncthreads();
    if (threadIdx.x == 0) {
        unsigned* bar = b.bar;
        __builtin_amdgcn_s_waitcnt(0);
        unsigned nloc = b.st[0], nx = b.st[1];
        if (nloc == 0u) { xcd_barrier_complete(bar, b.x, nloc, nx); b.st[0] = nloc; b.st[1] = nx; }
        const unsigned old = xb_add(&bar[XB_XSUB(b.x)], 1u);
        const unsigned gen = old / nloc;
        if (old + 1u == (gen + 1u) * nloc) {
            __builtin_amdgcn_fence(__ATOMIC_RELEASE, "agent");
            asm volatile("s_waitcnt vmcnt(0)" ::: "memory");
            const unsigned og = xb_add(&bar[XB_TOP], 1u);
            const unsigned tg = og / nx;
            if (og + 1u == (tg + 1u) * nx) xb_add(&bar[XB_TOPGEN], 1u);
            else XB_SPIN(xb_ld(&bar[XB_TOPGEN]) == tg, bar);
            __builtin_amdgcn_fence(__ATOMIC_ACQUIRE, "agent");
            xb_add(&bar[XB_XGEN(b.x)], 1u);
            asm volatile("s_waitcnt vmcnt(0)" ::: "memory");
        } else {
            XB_SPIN(xb_ld(&bar[XB_XGEN(b.x)]) == gen, bar);
            __builtin_amdgcn_fence(__ATOMIC_ACQUIRE, "agent");
            asm volatile("s_waitcnt vmcnt(0)" ::: "memory");
        }
    }
    __syncthreads();
}


namespace pg8 {
constexpr int BM = 256, BK = 64, HALF = 128, HTB = HALF * BK * 2, STAGE_BYTES = 8 * HTB, NXCD = 8, WGM = 8;
__host__ __device__ __forceinline__ int lds_byte(int r, int c) { const int st = (r >> 4) * 2 + (c >> 5), rr = r & 15, cc = c & 31, ob = rr * 64 + cc * 2; return st * 1024 + (ob ^ (((ob >> 9) & 1) << 5)); }
__host__ __device__ __forceinline__ void stage_rc(int b, int& R, int& C) { const int st = b / 1024, sb = b % 1024, swz = sb ^ (((sb >> 9) & 1) << 5); R = (st >> 1) * 16 + swz / 64; C = (st & 1) * 32 + (swz % 64) / 2; }
struct Unit { int pm, pn, ko, nt, keep; };
struct Gemm { const h16* A; const h16* Bt; int lda, ldb, K; };
struct StaticOrder {
    int nM, nN, nwg, G, c;
    __host__ __device__ void init(int M, int N, int G_, int c_) { nM = M / BM; nN = N / BM; nwg = nM * nN; G = G_; c = c_; }
    __host__ __device__ bool next(int i, Unit& u) const {
        const long L = (long)i * G + c; if (L >= nwg) return false;
        int wgid = (int)L; { const int q = nwg / NXCD, r = nwg % NXCD, xcd = wgid % NXCD, off = wgid / NXCD; wgid = (xcd < r ? xcd * (q + 1) : r * (q + 1) + (xcd - r) * q) + off; }
        const int nig = WGM * nN, gid = wgid / nig, fm = gid * WGM, gsz = (nM - fm) < WGM ? (nM - fm) : WGM;
        u.pm = fm + ((wgid % nig) % gsz); u.pn = (wgid % nig) / gsz; u.ko = 0; u.nt = 0; u.keep = 0; return true;
    }
};
template <class Epi, class Sched, bool ALIGN_EPI = true>
__device__ __forceinline__ void gemm_phase(LAS unsigned char* lds, const Gemm g, const Sched& S, const Epi& E) {
    const int tid = threadIdx.x, wid = __builtin_amdgcn_readfirstlane(tid >> 6), lane = tid & 63, wr = wid >> 2, wc = wid & 3, fr = lane & 15, fq = lane >> 4;
    const int nt0 = g.K / BK;
    unsigned voffA[2], voffB[2];
#pragma unroll
    for (int i = 0; i < 2; ++i) { int R, C; stage_rc(tid * 16 + i * 8192, R, C); voffA[i] = (unsigned)(R * g.lda + C) * 2u; voffB[i] = (unsigned)(R * g.ldb + C) * 2u; }
    const size_t kstep = (size_t)(BK * 2);
    const size_t hstepA = (size_t)HALF * g.lda * 2, hstepB = (size_t)HALF * g.ldb * 2;
    const size_t tstepA = 2 * hstepA, tstepB = 2 * hstepB;
    const unsigned ldsw = (unsigned)wid * 1024u;
    const int aoff = lds_byte(wr * 64 + fr, fq * 8), boff = lds_byte(wc * 32 + fr, fq * 8);
#define PG8_SA(b, h) (((b) * 2 + (h)) * HTB)
#define PG8_SB(b, h) ((4 + (b) * 2 + (h)) * HTB)
#define PG8_STAGE(bufoff, gbase, voff) do { _Pragma("unroll") for (int _i = 0; _i < 2; ++_i) \
        __builtin_amdgcn_global_load_lds((const unsigned*)((const char*)(gbase) + (voff)[_i]), (LAS unsigned*)(lds + (bufoff) + ldsw + _i * 8192), 16, 0, 0); } while (0)
#define PG8_LDA(dst, b, h) do { _Pragma("unroll") for (int m = 0; m < 4; ++m) _Pragma("unroll") for (int k = 0; k < 2; ++k) dst[m][k] = *(const LAS h16x8*)(lds + PG8_SA(b, h) + aoff + m * 2048 + k * 1024); } while (0)
#define PG8_LDB(dst, b, h) do { _Pragma("unroll") for (int n = 0; n < 2; ++n) _Pragma("unroll") for (int k = 0; k < 2; ++k) dst[n][k] = *(const LAS h16x8*)(lds + PG8_SB(b, h) + boff + n * 2048 + k * 1024); } while (0)
#define PG8_MMA(ai, bj, At, Bt) do { __builtin_amdgcn_s_setprio(1); _Pragma("unroll") for (int m = 0; m < 4; ++m) _Pragma("unroll") for (int n = 0; n < 2; ++n) _Pragma("unroll") for (int k = 0; k < 2; ++k) \
        acc[ai][bj][m][n] = __builtin_amdgcn_mfma_f32_16x16x32_f16(Bt[n][k], At[m][k], acc[ai][bj][m][n], 0, 0, 0); __builtin_amdgcn_s_setprio(0); } while (0)
#define PG8_WAIT_V(n) asm volatile("s_waitcnt vmcnt(" #n ")" ::: "memory")
#define PG8_WAIT_L(n) asm volatile("s_waitcnt lgkmcnt(" #n ")" ::: "memory")
#define PG8_BAR __builtin_amdgcn_s_barrier()
#define PG8_SCHED __builtin_amdgcn_sched_barrier(0)
    Unit cur, nxt; int ui = 0;
    if (!S.next(0, cur)) return;
    f32x4 acc[2][2][4][2];
#pragma unroll
    for (int a = 0; a < 2; ++a)
#pragma unroll
        for (int b = 0; b < 2; ++b)
#pragma unroll
            for (int m = 0; m < 4; ++m)
#pragma unroll
                for (int n = 0; n < 2; ++n) acc[a][b][m][n] = (f32x4){0.f, 0.f, 0.f, 0.f};
    h16x8 At[4][2], B0[2][2], B1[2][2];
    const char* cA = (const char*)g.A + (size_t)cur.pm * tstepA + (size_t)cur.ko * 2; const char* cB = (const char*)g.Bt + (size_t)cur.pn * tstepB + (size_t)cur.ko * 2;
    {
        PG8_STAGE(PG8_SB(0, 0), cB, voffB); PG8_STAGE(PG8_SB(0, 1), cB + hstepB, voffB); PG8_STAGE(PG8_SA(0, 0), cA, voffA); PG8_STAGE(PG8_SA(0, 1), cA + hstepA, voffA);
        if (wr == 1) PG8_BAR;
        PG8_WAIT_V(2); PG8_BAR;
        PG8_STAGE(PG8_SB(1, 0), cB + kstep, voffB); PG8_STAGE(PG8_SA(1, 0), cA + kstep, voffA); PG8_STAGE(PG8_SB(1, 1), cB + hstepB + kstep, voffB);
        PG8_WAIT_V(6); PG8_BAR;
    }
    for (;;) {
        const bool has_next = S.next(ui + 1, nxt);
        const char* nA = has_next ? (const char*)g.A + (size_t)nxt.pm * tstepA + (size_t)nxt.ko * 2 : cA; const char* nB = has_next ? (const char*)g.Bt + (size_t)nxt.pn * tstepB + (size_t)nxt.ko * 2 : cB;
        int nt = cur.nt ? cur.nt : nt0; asm volatile("" : "+s"(nt));
        for (int t = 0; t < nt; t += 2) {
            const bool last = (t == nt - 2);
            const char* a1 = cA + (size_t)(t + 1) * kstep;
            const char* a2 = last ? nA : cA + (size_t)(t + 2) * kstep; const char* b2 = last ? nB : cB + (size_t)(t + 2) * kstep;
            const char* a3 = a2 + kstep; const char* b3 = b2 + kstep;
            PG8_LDB(B0, 0, 0); PG8_LDB(B1, 0, 1); PG8_SCHED; PG8_LDA(At, 0, 0); PG8_STAGE(PG8_SA(1, 1), a1 + hstepA, voffA);
            PG8_WAIT_V(8); PG8_WAIT_L(0); PG8_BAR; PG8_MMA(0, 0, At, B0); PG8_MMA(0, 1, At, B1); PG8_BAR; PG8_SCHED;
            PG8_LDA(At, 0, 1); PG8_STAGE(PG8_SB(0, 0), b2, voffB); PG8_STAGE(PG8_SB(0, 1), b2 + hstepB, voffB); PG8_STAGE(PG8_SA(0, 0), a2, voffA);
            PG8_WAIT_V(8); PG8_WAIT_L(0); PG8_BAR; PG8_MMA(1, 0, At, B0); PG8_MMA(1, 1, At, B1); PG8_BAR; PG8_SCHED;
            PG8_LDB(B0, 1, 0); PG8_LDB(B1, 1, 1); PG8_SCHED; PG8_LDA(At, 1, 0); PG8_STAGE(PG8_SA(0, 1), a2 + hstepA, voffA);
            PG8_WAIT_V(8); PG8_WAIT_L(0); PG8_BAR; PG8_MMA(0, 0, At, B0); PG8_MMA(0, 1, At, B1); PG8_BAR; PG8_SCHED;
            PG8_LDA(At, 1, 1); PG8_STAGE(PG8_SB(1, 0), b3, voffB); PG8_STAGE(PG8_SB(1, 1), b3 + hstepB, voffB); PG8_STAGE(PG8_SA(1, 0), a3, voffA);
            PG8_WAIT_V(8); PG8_WAIT_L(0); PG8_BAR; PG8_MMA(1, 0, At, B0); PG8_MMA(1, 1, At, B1); PG8_BAR; PG8_SCHED;
        }
        if constexpr (ALIGN_EPI) { if (wr == 0) PG8_BAR; }
        E(acc, cur, wr, wc, fr, fq);
        if (!has_next) break;
        if (!cur.keep) {
#pragma unroll
        for (int a = 0; a < 2; ++a)
#pragma unroll
            for (int b = 0; b < 2; ++b)
#pragma unroll
                for (int m = 0; m < 4; ++m)
#pragma unroll
                    for (int n = 0; n < 2; ++n) acc[a][b][m][n] = (f32x4){0.f, 0.f, 0.f, 0.f};
        }
        cur = nxt; cA = nA; cB = nB; ++ui;
        if constexpr (ALIGN_EPI) { if (wr == 1) PG8_BAR; }
    }
    PG8_WAIT_V(0);
    if constexpr (!ALIGN_EPI) { if (wr == 0) PG8_BAR; }
    PG8_BAR;
#undef PG8_SA
#undef PG8_SB
#undef PG8_STAGE
#undef PG8_LDA
#undef PG8_LDB
#undef PG8_MMA
#undef PG8_WAIT_V
#undef PG8_WAIT_L
#undef PG8_BAR
#undef PG8_SCHED
}
}

struct Frame {
    LAS unsigned char* lds;
    int tid, lane, wave, vcu, G;
    const float *x, *c, *ctx, *c_ctx, *w_mod, *b_mod, *norm_attn, *norm_ffn, *w_in, *ret_decay, *diff_lambda, *diff_subln,
                *w_ret_o, *w_diff_o, *w_out, *w_router, *router_bias, *w_exp_gu, *w_exp_down, *w_sh_gu, *w_sh_down, *final_norm;
    float* out;
    unsigned char* ws;
};

__device__ __forceinline__ float wave_sum(float v) {
#pragma unroll
    for (int o = 1; o < 64; o <<= 1) v += __shfl_xor(v, o);
    return v;
}
__device__ __forceinline__ unsigned pk2h(float lo, float hi) { f32x2 v = {lo, hi}; h16x2 h = __builtin_convertvector(v, h16x2); return __builtin_bit_cast(unsigned, h); }
__device__ __forceinline__ float silu_f(float v) { return v / (1.0f + __expf(-v)); }
__device__ __forceinline__ float sigmoid_f(float v) { return 1.0f / (1.0f + __expf(-v)); }

__device__ __forceinline__ void p0_mod_unit(Frame& F, int unit) {
    const int cb = unit % 24, ks = unit / 24;
    LAS float* sv = (LAS float*)F.lds;
    LAS float* red = sv + 768;
    for (int i = F.tid; i < 768; i += NTHR) { const int v = i >> 8, k = i & 255; const float cv = (v < 2) ? F.c[v * DM + ks * 256 + k] : F.c_ctx[ks * 256 + k]; sv[i] = silu_f(cv); }
    __syncthreads();
    const int cl = F.tid & 127, rl = F.tid >> 7;
    const float* wp = F.w_mod + (size_t)(ks * 256 + rl) * (6 * DM) + cb * 512 + cl * 4;
    f32x4 a0 = {0.f, 0.f, 0.f, 0.f}, a1 = a0, a2 = a0;
#pragma unroll 8
    for (int i = 0; i < 64; ++i) { const f32x4 w = *(const f32x4*)(wp + (size_t)i * 4 * (6 * DM)); const int k = rl + 4 * i; a0 += w * sv[k]; a1 += w * sv[256 + k]; a2 += w * sv[512 + k]; }
    *(LAS f32x4*)(red + (rl * 3 + 0) * 512 + cl * 4) = a0; *(LAS f32x4*)(red + (rl * 3 + 1) * 512 + cl * 4) = a1; *(LAS f32x4*)(red + (rl * 3 + 2) * 512 + cl * 4) = a2;
    __syncthreads();
    float* modp = (float*)(F.ws + WS_MODP);
    for (int i = F.tid; i < 1536; i += NTHR) { const int v = i >> 9, cc = i & 511; const float s = (red[(0 * 3 + v) * 512 + cc] + red[(1 * 3 + v) * 512 + cc]) + (red[(2 * 3 + v) * 512 + cc] + red[(3 * 3 + v) * 512 + cc]);
        modp[(size_t)(ks * 3 + v) * (6 * DM) + cb * 512 + cc] = s; }
    __syncthreads();
}
template <int MAP>
__device__ __forceinline__ void p0_transpose_item(const float* W, int K, int N, h16* WT, LAS float* scr, int item, int lane, int ldd = 0) {
    if (ldd == 0) ldd = K;
    const int nblk = N / 32, kb = item / nblk, nb = item % nblk, k0 = 64 * kb, n0 = 32 * nb;
#pragma unroll 8
    for (int i = 0; i < 32; ++i) { const int kk = 2 * i + (lane >> 5); scr[kk * 33 + (lane & 31)] = W[(size_t)(k0 + kk) * N + n0 + (lane & 31)]; }
    asm volatile("s_waitcnt lgkmcnt(0)" ::: "memory");
    const int cch = lane & 7;
#pragma unroll
    for (int j = 0; j < 4; ++j) { const int n = (lane >> 3) + 8 * j; const LAS float* s = scr + (8 * cch) * 33 + n;
        u32x4 o; o.x = pk2h(s[0 * 33], s[1 * 33]); o.y = pk2h(s[2 * 33], s[3 * 33]); o.z = pk2h(s[4 * 33], s[5 * 33]); o.w = pk2h(s[6 * 33], s[7 * 33]);
        int nn = n0 + n;
        if (MAP == 1) { const bool isrope = (nn < 1024) || (nn >= C_RQ && nn < C_RQ + 1024); if (isrope) nn = (nn & ~48) | ((nn & 16) << 1) | ((nn & 32) >> 1); }
        if (MAP == 2) { const int j = nn & 255, isu = nn >> 8; nn = 32 * (j >> 4) + 16 * isu + (j & 15); }
        *(u32x4*)(WT + (size_t)nn * ldd + k0 + 8 * cch) = o; }
    asm volatile("s_waitcnt lgkmcnt(0)" ::: "memory");
}
__device__ __forceinline__ void p0a_mod(Frame& F) {
    for (int u = F.vcu; u < 192; u += F.G) p0_mod_unit(F, u);
}
__device__ __forceinline__ void p0b_weights(Frame& F) {
    __syncthreads();
    LAS float* scr = (LAS float*)(F.lds + F.wave * 16384);
    const int gw = F.vcu * NWAVES + F.wave, NGW = F.G * NWAVES;
    constexpr int I_IN = (DM / 64) * (IN_COLS / 32);
    for (int it = gw; it < I_IN; it += NGW) p0_transpose_item<1>(F.w_in, DM, IN_COLS, (h16*)(F.ws + WS_WINT), scr, it, F.lane);
    if (blockIdx.x == 0) {
        float* rope = (float*)(F.ws + WS_ROPE);
        for (int i = F.tid; i < 64 * 32; i += NTHR) { const int pos = i >> 5, j = i & 31; const float inv = exp2f(-(float)j * (13.287712379549449f / 32.0f)); const float ang = (float)pos * inv; rope[i] = cosf(ang); rope[2048 + i] = sinf(ang); }
        for (int i = F.tid; i < 64 * 16; i += NTHR) { const int pos = i >> 4, j = i & 15; const float inv = exp2f(-(float)j * (13.287712379549449f / 16.0f)); const float ang = (float)pos * inv; rope[4096 + i] = cosf(ang); rope[4096 + 1024 + i] = sinf(ang); }
    }
}
__device__ __forceinline__ void p0c_weights_dyn(Frame& F, int qid) {
    unsigned* QH = (unsigned*)(F.ws + WS_CTL) + CW_Q + 64 * 8 * qid;
    LAS int* RED = (LAS int*)(F.lds + LDS_TICKET);
    LAS float* scr = (LAS float*)(F.lds + F.wave * 16384);
    constexpr int I_RET = (2048 / 64) * (DM / 32), I_DIF = (1024 / 64) * (DM / 32), I_OUT = (DM / 64) * (DM / 32), I_SGU = (DM / 64) * (512 / 32), I_SDN = (256 / 64) * (DM / 32), I_RT = NEXP * DM / 4 / 64;
    constexpr int NITEMS = I_RET + I_DIF + I_OUT + I_SGU + I_SDN + I_RT, NTICK = (NITEMS + 7) / 8;
    for (;;) {
        __syncthreads();
        if (F.tid == 0) RED[0] = (int)__hip_atomic_fetch_add(QH, 1u, __ATOMIC_RELAXED, __HIP_MEMORY_SCOPE_AGENT);
        __syncthreads();
        const int t = RED[0];
        if (t >= NTICK) break;
        int r = t * 8 + F.wave;
        if (r >= NITEMS) continue;
        if (r < I_RET) { p0_transpose_item<0>(F.w_ret_o, 2048, DM, (h16*)(F.ws + WS_WCAT), scr, r, F.lane, 3072); continue; } r -= I_RET;
        if (r < I_DIF) { p0_transpose_item<0>(F.w_diff_o, 1024, DM, (h16*)(F.ws + WS_WCAT) + 2048, scr, r, F.lane, 3072); continue; } r -= I_DIF;
        if (r < I_OUT) { p0_transpose_item<0>(F.w_out, DM, DM, (h16*)(F.ws + WS_WOUT), scr, r, F.lane); continue; } r -= I_OUT;
        if (r < I_SGU) { p0_transpose_item<2>(F.w_sh_gu, DM, 512, (h16*)(F.ws + WS_WSGU), scr, r, F.lane); continue; } r -= I_SGU;
        if (r < I_SDN) { p0_transpose_item<0>(F.w_sh_down, 256, DM, (h16*)(F.ws + WS_WSDN), scr, r, F.lane); continue; } r -= I_SDN;
        {
            const int q = r * 64 + F.lane, e = q / (DM / 4), k = (q % (DM / 4)) * 4;
            const f32x4 w = *(const f32x4*)(F.w_router + (size_t)e * DM + k);
            h16 hi[4], lo[4];
#pragma unroll
            for (int j = 0; j < 4; ++j) { hi[j] = (h16)w[j]; lo[j] = (h16)(w[j] - (float)hi[j]); }
            h16* dst = (h16*)(F.ws + WS_WRTR) + (size_t)e * 6144 + k;
            *(h16x4*)(dst) = (h16x4){hi[0], hi[1], hi[2], hi[3]}; *(h16x4*)(dst + 2048) = (h16x4){hi[0], hi[1], hi[2], hi[3]}; *(h16x4*)(dst + 4096) = (h16x4){lo[0], lo[1], lo[2], lo[3]};
        }
    }
}

__device__ __forceinline__ void p1_norm1(Frame& F) {
    LAS float* msh = (LAS float*)F.lds; LAS float* msc = msh + 3 * DM;
    const float* modp = (const float*)(F.ws + WS_MODP);
    for (int i = F.tid; i < 3 * 2 * DM; i += NTHR) { const int v = i / (2 * DM), cc = i % (2 * DM); float s = F.b_mod[cc];
#pragma unroll
        for (int ks = 0; ks < 8; ++ks) s += modp[(size_t)(ks * 3 + v) * (6 * DM) + cc];
        if (cc < DM) msh[v * DM + cc] = s; else msc[v * DM + cc - DM] = s; }
    __syncthreads();
    const int gw = F.vcu * NWAVES + F.wave, NGW = F.G * NWAVES;
    h16* H = (h16*)(F.ws + WS_H);
    for (int r = gw; r < MALL; r += NGW) {
        const float* src = (r < MLAT) ? F.x + (size_t)r * DM : F.ctx + (size_t)(r - MLAT) * DM; const int v = (r < MLAT) ? (r / SEQ) : 2;
        f32x4 xv[8]; float ss = 0.f;
#pragma unroll
        for (int j = 0; j < 8; ++j) { xv[j] = *(const f32x4*)(src + 4 * F.lane + 256 * j); ss += (xv[j].x * xv[j].x + xv[j].y * xv[j].y) + (xv[j].z * xv[j].z + xv[j].w * xv[j].w); }
        const float rstd = 1.0f / sqrtf(wave_sum(ss) * (1.0f / DM) + EPS);
#pragma unroll
        for (int j = 0; j < 8; ++j) { const int cc = 4 * F.lane + 256 * j; const f32x4 nw = *(const f32x4*)(F.norm_attn + cc);
            const f32x4 sc = *(LAS f32x4*)(msc + v * DM + cc), sh = *(LAS f32x4*)(msh + v * DM + cc);
            const f32x4 y = xv[j] * rstd * nw * (sc + 1.0f) + sh;
            u32x2 o; o.x = pk2h(y.x, y.y); o.y = pk2h(y.z, y.w); *(u32x2*)(H + (size_t)r * DM + cc) = o; }
    }
    float* MOD = (float*)(F.ws + WS_MOD);
    for (int i = blockIdx.x * NTHR + F.tid; i < 3 * 6 * DM; i += F.G * NTHR) { const int v = i / (6 * DM), cc = i % (6 * DM); float s = F.b_mod[cc];
#pragma unroll
        for (int ks = 0; ks < 8; ++ks) s += modp[(size_t)(ks * 3 + v) * (6 * DM) + cc];
        MOD[i] = s; }
}


__device__ __forceinline__ int crow(int r, int hi) { return (r & 3) + 8 * (r >> 2) + 4 * hi; }
__device__ __forceinline__ h16x8 frag_row(const LAS unsigned char* base, int strideB, int r0, int k0, int lane) {
    return *(const LAS h16x8*)(base + (r0 + (lane & 31)) * strideB + (k0 + 8 * (lane >> 5)) * 2);
}
__device__ __forceinline__ v4i16_t tr16(const LAS unsigned char* p) { return __builtin_amdgcn_ds_read_tr16_b64_v4i16((LAS v4i16_t*)p); }
__device__ __forceinline__ h16x8 frag_tr(const LAS unsigned char* base, int strideB, int k0, int n0, int lane) {
    const int kb = k0 + 8 * (lane >> 5) + ((lane & 15) >> 2), nc = n0 + 16 * ((lane >> 4) & 1) + 4 * (lane & 3);
    const LAS unsigned char* p = base + kb * strideB + nc * 2;
    const v4i16_t lo = tr16(p), hi = tr16(p + 4 * strideB);
    typedef short s16x8 __attribute__((ext_vector_type(8)));
    const s16x8 v = {lo[0], lo[1], lo[2], lo[3], hi[0], hi[1], hi[2], hi[3]};
    return __builtin_bit_cast(h16x8, v);
}
__device__ __forceinline__ h16x8 frag_tr_perm(const LAS unsigned char* base, int strideB, int k0, int n0, int lane) {
    const int kb = k0 + 4 * (lane >> 5) + ((lane & 15) >> 2), nc = n0 + 16 * ((lane >> 4) & 1) + 4 * (lane & 3);
    const LAS unsigned char* p = base + kb * strideB + nc * 2;
    const v4i16_t lo = tr16(p), hi = tr16(p + 8 * strideB);
    typedef short s16x8 __attribute__((ext_vector_type(8)));
    const s16x8 v = {lo[0], lo[1], lo[2], lo[3], hi[0], hi[1], hi[2], hi[3]};
    return __builtin_bit_cast(h16x8, v);
}
__device__ __forceinline__ h16x8 pack8(float a0, float a1, float a2, float a3, float a4, float a5, float a6, float a7) {
    u32x4 w; w.x = pk2h(a0, a1); w.y = pk2h(a2, a3); w.z = pk2h(a4, a5); w.w = pk2h(a6, a7); return __builtin_bit_cast(h16x8, w);
}
#define MFMA32(a, b, c) __builtin_amdgcn_mfma_f32_32x32x16_f16((a), (b), (c), 0, 0, 0)

struct SchedG1 {
    pg8::StaticOrder so; int G, c;
    __device__ __forceinline__ bool next(int i, pg8::Unit& u) const {
        const int L = i * G + c;
        if (L < 32 * 52) return so.next(i, u);
        const int r = L - 32 * 52; if (r >= 40) return false;
        u.pm = 32 + r / 20; u.pn = r % 20; u.ko = 0; u.nt = 0; u.keep = 0; return true;
    }
};
struct EpiP {
    h16* P; const float* rope;
    __device__ __forceinline__ void operator()(f32x4 (&acc)[2][2][4][2], const pg8::Unit& u, int wr, int wc, int fr, int fq) const {
        const int colt = u.pn * 256; const bool lat = u.pm < 32;
        int kind;
        if (colt < C_RV) kind = 1; else if (colt < C_DK) kind = 0; else if (colt < C_DV) kind = 3; else if (colt < C_RQ) kind = 0; else if (colt < C_RG) kind = 2; else if (colt < C_DQ) kind = 5; else if (colt < C_GR) kind = 4; else kind = 6;
        if (!lat) kind = (kind == 1) ? 7 : 0;
#pragma unroll
        for (int ai = 0; ai < 2; ++ai)
#pragma unroll
            for (int m = 0; m < 4; ++m) {
                const int row = u.pm * 256 + ai * 128 + wr * 64 + m * 16 + fr; const int t = row & (SEQ - 1);
                h16* prow = P + (size_t)row * IN_COLS;
#pragma unroll
                for (int bj = 0; bj < 2; ++bj) {
                    const int cbase = colt + bj * 128 + wc * 32;
                    const f32x4 x0 = acc[ai][bj][m][0], x1 = acc[ai][bj][m][1];
                    f32x4 o0, o1; int c0, c1;
                    if (kind == 1 || kind == 2) {
                        const int g5 = (cbase >> 5) & 1, axis = (cbase >> 6) & 1, pos = axis ? (t & 63) : (t >> 6), j0 = 16 * g5 + 4 * fq;
                        const f32x4 cs = *(const f32x4*)(rope + pos * 32 + j0), sn = *(const f32x4*)(rope + 2048 + pos * 32 + j0);
                        o0 = x0 * cs - x1 * sn; o1 = x0 * sn + x1 * cs;
                        if (kind == 2) { o0 *= 0.08838834764831845f; o1 *= 0.08838834764831845f; }
                        c0 = (cbase & ~63) + j0; c1 = c0 + 32;
                    } else if (kind == 7) {
                        const int g5 = (cbase >> 5) & 1; c0 = (cbase & ~63) + 16 * g5 + 4 * fq; c1 = c0 + 32; o0 = x0; o1 = x1;
                    } else if (kind == 3 || kind == 4) {
                        const int axis = (cbase >> 5) & 1, pos = axis ? (t & 63) : (t >> 6), j0 = 4 * fq;
                        const f32x4 cs = *(const f32x4*)(rope + 4096 + pos * 16 + j0), sn = *(const f32x4*)(rope + 5120 + pos * 16 + j0);
                        o0 = x0 * cs - x1 * sn; o1 = x0 * sn + x1 * cs;
                        if (kind == 4) { o0 *= 0.18033688011112042f; o1 *= 0.18033688011112042f; }
                        c0 = cbase + j0; c1 = c0 + 16;
                    } else {
                        c0 = cbase + 4 * fq; c1 = c0 + 16; o0 = x0; o1 = x1;
                        if (kind == 5) {
#pragma unroll
                            for (int e = 0; e < 4; ++e) { o0[e] = silu_f(x0[e]); o1[e] = silu_f(x1[e]); }
                        } else if (kind == 6) {
#pragma unroll
                            for (int e = 0; e < 4; ++e) { o0[e] = sigmoid_f(x0[e]); o1[e] = sigmoid_f(x1[e]); }
                        }
                    }
                    u32x2 w0, w1; w0.x = pk2h(o0[0], o0[1]); w0.y = pk2h(o0[2], o0[3]); w1.x = pk2h(o1[0], o1[1]); w1.y = pk2h(o1[2], o1[3]);
                    *(u32x2*)(prow + c0) = w0; *(u32x2*)(prow + c1) = w1;
                }
            }
    }
};
__device__ __forceinline__ void p2_gemm1(Frame& F) {
    pg8::Gemm g{(const h16*)(F.ws + WS_H), (const h16*)(F.ws + WS_WINT), DM, DM, DM};
    SchedG1 S; S.so.init(MLAT, IN_COLS, F.G, (int)blockIdx.x); S.G = F.G; S.c = (int)blockIdx.x;
    EpiP E{(h16*)(F.ws + WS_P), (const float*)(F.ws + WS_ROPE)};
    pg8::gemm_phase<EpiP, SchedG1>(F.lds, g, S, E);
}

__device__ __forceinline__ void p3_ret_local(Frame& F) {
    LAS unsigned char* KF = F.lds; LAS unsigned char* KB = F.lds + 40960; LAS unsigned char* VH = F.lds + 81920;
    const h16* P = (const h16*)(F.ws + WS_P); h16* LST = (h16*)(F.ws + WS_LST);
    const int hi = F.lane >> 5;
    for (int u = F.vcu; u < 16 * 34; u += F.G) {
        const int bh = u / 34, cc = u % 34, b = bh >> 3, h = bh & 7;
        const int row0 = (cc < 2) ? (MLAT + b * CTXL + cc * 128) : (b * SEQ + (cc - 2) * 128);
        const float lgf = -__expf(F.ret_decay[h]), lgb = -__expf(F.ret_decay[8 + h]);
#pragma unroll
        for (int i = 0; i < 4; ++i) { const int q = F.tid + NTHR * i, row = q >> 4, ch = q & 15;
            const h16x8 kv = *(const h16x8*)(P + (size_t)(row0 + row) * IN_COLS + C_RK + h * 128 + ch * 8);
            const float sf = __expf(lgf * (float)(127 - row)), sb = __expf(lgb * (float)row);
            *(LAS h16x8*)(KF + row * 320 + ch * 16) = pack8((float)kv[0] * sf, (float)kv[1] * sf, (float)kv[2] * sf, (float)kv[3] * sf, (float)kv[4] * sf, (float)kv[5] * sf, (float)kv[6] * sf, (float)kv[7] * sf);
            *(LAS h16x8*)(KB + row * 320 + ch * 16) = pack8((float)kv[0] * sb, (float)kv[1] * sb, (float)kv[2] * sb, (float)kv[3] * sb, (float)kv[4] * sb, (float)kv[5] * sb, (float)kv[6] * sb, (float)kv[7] * sb); }
        for (int eh = 0; eh < 2; ++eh) {
            if (eh) __syncthreads();
#pragma unroll
            for (int i = 0; i < 4; ++i) { const int q = F.tid + NTHR * i, row = q >> 4, ch = q & 15;
                *(LAS h16x8*)(VH + row * 320 + ch * 16) = *(const h16x8*)(P + (size_t)(row0 + row) * IN_COLS + C_RV + h * 256 + eh * 128 + ch * 8); }
            __syncthreads();
            const int dir = F.wave >> 2, eb = F.wave & 3; const LAS unsigned char* Kd = dir ? KB : KF;
            f32x16 acc[4];
#pragma unroll
            for (int db = 0; db < 4; ++db) acc[db] = (f32x16){};
#pragma unroll
            for (int ks = 0; ks < 8; ++ks) { const h16x8 a = frag_tr(VH, 320, 16 * ks, 32 * eb, F.lane);
#pragma unroll
                for (int db = 0; db < 4; ++db) { const h16x8 bb = frag_tr(Kd, 320, 16 * ks, 32 * db, F.lane); acc[db] = MFMA32(a, bb, acc[db]); } }
            h16* dst = LST + ((size_t)((dir * 16 + bh) * 34 + cc) * 256 + eh * 128 + eb * 32) * 128;
#pragma unroll
            for (int db = 0; db < 4; ++db)
#pragma unroll
                for (int r = 0; r < 16; ++r) dst[crow(r, hi) * 128 + db * 32 + (F.lane & 31)] = (h16)acc[db][r];
        }
        __syncthreads();
    }
}
__device__ __forceinline__ void p4_ret_scan(Frame& F) {
    const h16* LST = (const h16*)(F.ws + WS_LST); h16* SST = (h16*)(F.ws + WS_SST);
    for (int g = blockIdx.x * NTHR + F.tid; g < 2 * 16 * 4096; g += F.G * NTHR) {
        const int seq = g >> 12, off = (g & 4095) * 8, dir = seq >> 4, bh = seq & 15, h = bh & 7;
        const float cd = __expf(-__expf(F.ret_decay[dir * 8 + h]) * 128.0f);
        const h16* Lp = LST + (size_t)seq * 34 * 32768 + off; h16* Sp = SST + (size_t)seq * 32 * 32768 + off;
        float s[8];
#pragma unroll
        for (int e = 0; e < 8; ++e) s[e] = 0.f;
        if (dir == 0) {
            for (int cc = 0; cc < 33; ++cc) {
                if (cc >= 2) *(h16x8*)(Sp + (size_t)(cc - 2) * 32768) = pack8(s[0], s[1], s[2], s[3], s[4], s[5], s[6], s[7]);
                const h16x8 l = *(const h16x8*)(Lp + (size_t)cc * 32768);
#pragma unroll
                for (int e = 0; e < 8; ++e) s[e] = s[e] * cd + (float)l[e];
            }
            *(h16x8*)(Sp + (size_t)31 * 32768) = pack8(s[0], s[1], s[2], s[3], s[4], s[5], s[6], s[7]);
        } else {
            { const h16x8 l1 = *(const h16x8*)(Lp + (size_t)1 * 32768), l0 = *(const h16x8*)(Lp);
#pragma unroll
              for (int e = 0; e < 8; ++e) s[e] = (float)l1[e] * cd + (float)l0[e]; }
            for (int c = 31; c >= 0; --c) {
                *(h16x8*)(Sp + (size_t)c * 32768) = pack8(s[0], s[1], s[2], s[3], s[4], s[5], s[6], s[7]);
                const h16x8 l = *(const h16x8*)(Lp + (size_t)(c + 2) * 32768);
#pragma unroll
                for (int e = 0; e < 8; ++e) s[e] = s[e] * cd + (float)l[e];
            }
        }
    }
}
__device__ __forceinline__ void p5_ret_out(Frame& F) {
    LAS unsigned char* QL = F.lds; LAS unsigned char* KL = F.lds + 34816; LAS unsigned char* PL = KL; LAS unsigned char* VL = F.lds + 69632;
    LAS float* RED = (LAS float*)(F.lds + 69632 + 73728);
    const h16* P = (const h16*)(F.ws + WS_P); const h16* SST = (const h16*)(F.ws + WS_SST); h16* ARET = (h16*)(F.ws + WS_ACAT);
    const int hi = F.lane >> 5, ln = F.lane & 31, w = F.wave;
    for (int u = F.vcu; u < 512; u += F.G) {
        const int bh = u >> 5, c = u & 31, b = bh >> 3, h = bh & 7, row0 = b * SEQ + c * 128;
        const float lgf = -__expf(F.ret_decay[h]), lgb = -__expf(F.ret_decay[8 + h]);
#pragma unroll
        for (int i = 0; i < 4; ++i) { const int q = F.tid + NTHR * i, row = q >> 4, ch = q & 15; const h16* pr = P + (size_t)(row0 + row) * IN_COLS + h * 128 + ch * 8;
            *(LAS h16x8*)(QL + row * 272 + ch * 16) = *(const h16x8*)(pr + C_RQ); *(LAS h16x8*)(KL + row * 272 + ch * 16) = *(const h16x8*)(pr + C_RK); }
        h16x8 vreg[8];
#pragma unroll
        for (int i = 0; i < 8; ++i) { const int q = F.tid + NTHR * i, row = q >> 5, c32 = q & 31; vreg[i] = *(const h16x8*)(P + (size_t)(row0 + row) * IN_COLS + C_RV + h * 256 + c32 * 8); }
        __syncthreads();
        u32x2 pw[2][4];
        { const int jt = w >> 1;
#pragma unroll
          for (int t2 = 0; t2 < 2; ++t2) { const int ib = 2 * (w & 1) + t2, il = 32 * ib + ln; f32x16 s = (f32x16){};
#pragma unroll
            for (int ks = 0; ks < 8; ++ks) s = MFMA32(frag_row(KL, 272, 32 * jt, 16 * ks, F.lane), frag_row(QL, 272, 32 * ib, 16 * ks, F.lane), s);
#pragma unroll
            for (int r = 0; r < 16; ++r) { const int d = il - (32 * jt + crow(r, hi)); s[r] *= (d >= 0) ? __expf(lgf * (float)d) : __expf(lgb * (float)(-d)); }
#pragma unroll
            for (int r4 = 0; r4 < 4; ++r4) { pw[t2][r4].x = pk2h(s[4 * r4], s[4 * r4 + 1]); pw[t2][r4].y = pk2h(s[4 * r4 + 2], s[4 * r4 + 3]); } } }
        __syncthreads();
        { const int jt = w >> 1;
#pragma unroll
          for (int t2 = 0; t2 < 2; ++t2) { const int il = 32 * (2 * (w & 1) + t2) + ln;
#pragma unroll
            for (int r4 = 0; r4 < 4; ++r4) *(LAS u32x2*)(PL + il * 272 + (32 * jt + 8 * r4 + 4 * hi) * 2) = pw[t2][r4]; } }
#pragma unroll
        for (int i = 0; i < 8; ++i) { const int q = F.tid + NTHR * i, row = q >> 5, c32 = q & 31; *(LAS h16x8*)(VL + row * 576 + c32 * 16) = vreg[i]; }
        __syncthreads();
        f32x16 o[4];
#pragma unroll
        for (int ib = 0; ib < 4; ++ib) o[ib] = (f32x16){};
#pragma unroll
        for (int k16 = 0; k16 < 8; ++k16) { const h16x8 a = frag_tr(VL, 576, 16 * k16, 32 * w, F.lane);
#pragma unroll
            for (int ib = 0; ib < 4; ++ib) o[ib] = MFMA32(a, frag_row(PL, 272, 32 * ib, 16 * k16, F.lane), o[ib]);
            if (k16 & 1) __builtin_amdgcn_sched_barrier(0); }
#pragma unroll
        for (int dir = 0; dir < 2; ++dir) {
            h16 sc[4];
#pragma unroll
            for (int ib = 0; ib < 4; ++ib) { const int il = 32 * ib + ln; sc[ib] = (h16)(dir ? __expf(lgb * (float)(128 - il)) : __expf(lgf * (float)(il + 1))); }
            const h16* Sg = SST + ((size_t)((dir * 16 + bh) * 32 + c) * 256 + 32 * w + ln) * 128 + 8 * hi;
#pragma unroll
            for (int kh = 0; kh < 2; ++kh) {
                h16x8 sa[4];
#pragma unroll
                for (int k4 = 0; k4 < 4; ++k4) sa[k4] = *(const h16x8*)(Sg + 16 * (4 * kh + k4));
#pragma unroll
                for (int k4 = 0; k4 < 4; ++k4) {
#pragma unroll
                    for (int ib = 0; ib < 4; ++ib) o[ib] = MFMA32(sa[k4], frag_row(QL, 272, 32 * ib, 16 * (4 * kh + k4), F.lane) * sc[ib], o[ib]);
                    __builtin_amdgcn_sched_barrier(0); }
            }
        }
#pragma unroll
        for (int ib = 0; ib < 4; ++ib) { float ss = 0.f;
#pragma unroll
            for (int r = 0; r < 16; ++r) ss += o[ib][r] * o[ib][r];
            ss += __shfl_xor(ss, 32);
            if (hi == 0) RED[(w * 4 + ib) * 32 + ln] = ss; }
        __syncthreads();
#pragma unroll
        for (int ib = 0; ib < 4; ++ib) { float tot = 0.f;
#pragma unroll
            for (int ww = 0; ww < 8; ++ww) tot += RED[(ww * 4 + ib) * 32 + ln];
            const float rstd = 1.0f / sqrtf(tot * (1.0f / 256.0f) + EPS);
            const size_t grow = (size_t)(row0 + 32 * ib + ln);
#pragma unroll
            for (int r4 = 0; r4 < 4; ++r4) { const int e = 32 * w + 8 * r4 + 4 * hi;
                const h16x4 gt = *(const h16x4*)(P + grow * IN_COLS + C_RG + h * 256 + e);
                u32x2 wv; wv.x = pk2h(o[ib][4 * r4] * rstd * (float)gt[0], o[ib][4 * r4 + 1] * rstd * (float)gt[1]); wv.y = pk2h(o[ib][4 * r4 + 2] * rstd * (float)gt[2], o[ib][4 * r4 + 3] * rstd * (float)gt[3]);
                *(u32x2*)(ARET + grow * 3072 + h * 256 + e) = wv; } }
        __syncthreads();
    }
}
__device__ __forceinline__ void p6_attn(Frame& F) {
    const h16* P = (const h16*)(F.ws + WS_P); h16* ADIF = (h16*)(F.ws + WS_ACAT) + 2048;
    const int hi = F.lane >> 5, ln = F.lane & 31;
    float lam;
    { const float s1 = wave_sum(F.diff_lambda[F.lane] * F.diff_lambda[64 + F.lane]), s2 = wave_sum(F.diff_lambda[128 + F.lane] * F.diff_lambda[192 + F.lane]); lam = __expf(s1) - __expf(s2) + 0.2f; }
    constexpr int KT0 = 0, VT0 = 34816, KTB = 17408, VTB = 20480;
    LAS float* XB = (LAS float*)F.lds;
    for (int u = F.vcu; u < 512; u += F.G) {
        const int bh = u >> 5, qb = u & 31, b = bh >> 3, h = bh & 7;
        const int cm = F.wave & 1, qs = F.wave >> 1, qrow0 = b * SEQ + qb * 128 + qs * 32;
        h16x8 qf[4];
#pragma unroll
        for (int ks = 0; ks < 4; ++ks) qf[ks] = *(const h16x8*)(P + (size_t)(qrow0 + ln) * IN_COLS + C_DQ + h * 128 + cm * 64 + 16 * ks + 8 * hi);
        f32x16 o[4];
#pragma unroll
        for (int et = 0; et < 4; ++et) o[et] = (f32x16){};
        float mrun = 0.f, lsum = 0.f; f32x16 negm = (f32x16){};
        h16x8 kreg[2], vreg[2];
#define ATT_LOAD(t) do { _Pragma("unroll") for (int i = 0; i < 2; ++i) { const int q = F.tid + NTHR * i, row = q >> 4, ch = q & 15; const int j = (t) * 64 + row; \
            const size_t srow = (j < CTXL) ? (size_t)(MLAT + b * CTXL + j) : (size_t)(b * SEQ + j - CTXL); const h16* pr = P + srow * IN_COLS + h * 128 + ch * 8; \
            kreg[i] = *(const h16x8*)(pr + C_DK); vreg[i] = *(const h16x8*)(pr + C_DV); } } while (0)
#define ATT_WRITE(buf) do { _Pragma("unroll") for (int i = 0; i < 2; ++i) { const int q = F.tid + NTHR * i, row = q >> 4, ch = q & 15; \
            *(LAS h16x8*)(F.lds + KT0 + (buf) * KTB + row * 272 + ch * 16) = kreg[i]; *(LAS h16x8*)(F.lds + VT0 + (buf) * VTB + row * 320 + ch * 16) = vreg[i]; } } while (0)
        ATT_LOAD(0); ATT_WRITE(0);
        __syncthreads();
        constexpr int NT = (CTXL + SEQ) / 64;
        for (int t = 0; t < NT; ++t) {
            const int buf = t & 1;
            if (t + 1 < NT) ATT_LOAD(t + 1);
            const LAS unsigned char* Kt = F.lds + KT0 + buf * KTB; const LAS unsigned char* Vt = F.lds + VT0 + buf * VTB;
            f32x16 s[2];
#pragma unroll
            for (int kt = 0; kt < 2; ++kt) { s[kt] = negm;
#pragma unroll
                for (int ks = 0; ks < 4; ++ks) s[kt] = MFMA32(frag_row(Kt, 272, 32 * kt, cm * 64 + 16 * ks, F.lane), qf[ks], s[kt]); }
            float mx = s[0][0];
#pragma unroll
            for (int r = 0; r < 16; ++r) { mx = fmaxf(mx, s[0][r]); mx = fmaxf(mx, s[1][r]); }
            mx = fmaxf(mx, __shfl_xor(mx, 32));
            if (t == 0 || __any(mx > 8.0f)) { const float dl = (t == 0) ? mx : fmaxf(mx, 0.0f), alpha = (t == 0) ? 0.0f : __builtin_amdgcn_exp2f(-dl); mrun += dl; lsum *= alpha;
#pragma unroll
                for (int et = 0; et < 4; ++et) o[et] *= alpha;
#pragma unroll
                for (int kt = 0; kt < 2; ++kt)
#pragma unroll
                    for (int r = 0; r < 16; ++r) s[kt][r] -= dl;
#pragma unroll
                for (int r = 0; r < 16; ++r) negm[r] = -mrun; }
            float ps = 0.f;
#pragma unroll
            for (int kt = 0; kt < 2; ++kt)
#pragma unroll
                for (int r = 0; r < 16; ++r) { s[kt][r] = __builtin_amdgcn_exp2f(s[kt][r]); ps += s[kt][r]; }
            lsum += ps;
#pragma unroll
            for (int kt = 0; kt < 2; ++kt)
#pragma unroll
                for (int s2 = 0; s2 < 2; ++s2) {
                    const h16x8 pbf = pack8(s[kt][8 * s2], s[kt][8 * s2 + 1], s[kt][8 * s2 + 2], s[kt][8 * s2 + 3], s[kt][8 * s2 + 4], s[kt][8 * s2 + 5], s[kt][8 * s2 + 6], s[kt][8 * s2 + 7]);
#pragma unroll
                    for (int et = 0; et < 4; ++et) o[et] = MFMA32(frag_tr_perm(Vt, 320, 32 * kt + 16 * s2, 32 * et, F.lane), pbf, o[et]);
                }
            if (t + 1 < NT) ATT_WRITE(buf ^ 1);
            __syncthreads();
        }
#undef ATT_LOAD
#undef ATT_WRITE
        lsum += __shfl_xor(lsum, 32);
        const float inv = 1.0f / lsum;
        if (cm == 1) {
#pragma unroll
            for (int et = 0; et < 4; ++et)
#pragma unroll
                for (int r = 0; r < 16; ++r) XB[(qs * 128 + 32 * et + crow(r, hi)) * 32 + ln] = o[et][r] * inv;
        }
        __syncthreads();
        if (cm == 0) {
            float ss = 0.f;
#pragma unroll
            for (int et = 0; et < 4; ++et)
#pragma unroll
                for (int r = 0; r < 16; ++r) { const float v = o[et][r] * inv - lam * XB[(qs * 128 + 32 * et + crow(r, hi)) * 32 + ln]; o[et][r] = v; ss += v * v; }
            ss += __shfl_xor(ss, 32);
            const float rstd = 0.8f / sqrtf(ss * (1.0f / 128.0f) + EPS);
            const size_t grow = (size_t)(qrow0 + ln);
#pragma unroll
            for (int et = 0; et < 4; ++et)
#pragma unroll
                for (int r4 = 0; r4 < 4; ++r4) { const int e = 32 * et + 8 * r4 + 4 * hi; const f32x4 sw = *(const f32x4*)(F.diff_subln + e);
                    u32x2 w; w.x = pk2h(o[et][4 * r4] * rstd * sw[0], o[et][4 * r4 + 1] * rstd * sw[1]); w.y = pk2h(o[et][4 * r4 + 2] * rstd * sw[2], o[et][4 * r4 + 3] * rstd * sw[3]);
                    *(u32x2*)(ADIF + grow * 3072 + h * 128 + e) = w; }
        }
        __syncthreads();
    }
}
struct SchedG2 {
    pg8::StaticOrder so;
    __device__ __forceinline__ bool next(int i, pg8::Unit& u) const { if (!so.next(i >> 1, u)) return false; if (i & 1) { u.ko = 2048; u.nt = 16; u.keep = 0; } else { u.ko = 0; u.nt = 32; u.keep = 1; } return true; }
};
struct EpiU2 {
    h16* U; const h16* P;
    __device__ __forceinline__ void operator()(f32x4 (&acc)[2][2][4][2], const pg8::Unit& u, int wr, int wc, int fr, int fq) const {
#pragma unroll
        for (int ai = 0; ai < 2; ++ai)
#pragma unroll
            for (int m = 0; m < 4; ++m) { const int row = u.pm * 256 + ai * 128 + wr * 64 + m * 16 + fr;
#pragma unroll
                for (int bj = 0; bj < 2; ++bj)
#pragma unroll
                    for (int n = 0; n < 2; ++n) { const int col = u.pn * 256 + bj * 128 + wc * 32 + 16 * n + 4 * fq;
                        const h16x4 gd = *(const h16x4*)(P + (size_t)row * IN_COLS + C_GD + col);
                        if (u.keep) { const h16x4 gr = *(const h16x4*)(P + (size_t)row * IN_COLS + C_GR + col);
#pragma unroll
                            for (int e = 0; e < 4; ++e) acc[ai][bj][m][n][e] *= (float)gr[e] / (float)gd[e];
                        } else { const f32x4 a = acc[ai][bj][m][n];
                            u32x2 w; w.x = pk2h(a[0] * (float)gd[0], a[1] * (float)gd[1]); w.y = pk2h(a[2] * (float)gd[2], a[3] * (float)gd[3]);
                            *(u32x2*)(U + (size_t)row * DM + col) = w; } } }
    }
};
struct EpiX1 {
    float* X1; const float* x; const float* MOD;
    __device__ __forceinline__ void operator()(f32x4 (&acc)[2][2][4][2], const pg8::Unit& u, int wr, int wc, int fr, int fq) const {
        const int b = (u.pm * 256) / SEQ;
#pragma unroll
        for (int ai = 0; ai < 2; ++ai)
#pragma unroll
            for (int m = 0; m < 4; ++m) { const int row = u.pm * 256 + ai * 128 + wr * 64 + m * 16 + fr;
#pragma unroll
                for (int bj = 0; bj < 2; ++bj)
#pragma unroll
                    for (int n = 0; n < 2; ++n) { const int col = u.pn * 256 + bj * 128 + wc * 32 + 16 * n + 4 * fq;
                        const f32x4 g1 = *(const f32x4*)(MOD + (size_t)b * (6 * DM) + 2 * DM + col); const f32x4 xv = *(const f32x4*)(x + (size_t)row * DM + col);
                        *(f32x4*)(X1 + (size_t)row * DM + col) = xv + g1 * acc[ai][bj][m][n]; } }
    }
};
__device__ __forceinline__ void p7_gemm2(Frame& F) {
    pg8::Gemm g{(const h16*)(F.ws + WS_ACAT), (const h16*)(F.ws + WS_WCAT), 3072, 3072, 2048};
    SchedG2 S; S.so.init(MLAT, DM, F.G, (int)blockIdx.x);
    EpiU2 E{(h16*)(F.ws + WS_U), (const h16*)(F.ws + WS_P)};
    pg8::gemm_phase<EpiU2, SchedG2>(F.lds, g, S, E);
}
__device__ __forceinline__ void p9_gemm3(Frame& F) {
    pg8::Gemm g{(const h16*)(F.ws + WS_U), (const h16*)(F.ws + WS_WOUT), 2048, 2048, 2048};
    pg8::StaticOrder S; S.init(MLAT, DM, F.G, (int)blockIdx.x);
    EpiX1 E{(float*)(F.ws + WS_X1), F.x, (const float*)(F.ws + WS_MOD)};
    pg8::gemm_phase<EpiX1, pg8::StaticOrder>(F.lds, g, S, E);
}


__device__ __forceinline__ void p10_norm2(Frame& F) {
    const float* X1 = (const float*)(F.ws + WS_X1); const float* MOD = (const float*)(F.ws + WS_MOD); h16* H2X = (h16*)(F.ws + WS_H2X);
    const int gw = F.vcu * NWAVES + F.wave, NGW = F.G * NWAVES;
    for (int r = gw; r < MLAT; r += NGW) {
        const float* src = X1 + (size_t)r * DM; const int b = r / SEQ;
        f32x4 xv[8]; float ss = 0.f;
#pragma unroll
        for (int j = 0; j < 8; ++j) { xv[j] = *(const f32x4*)(src + 4 * F.lane + 256 * j); ss += (xv[j].x * xv[j].x + xv[j].y * xv[j].y) + (xv[j].z * xv[j].z + xv[j].w * xv[j].w); }
        const float rstd = 1.0f / sqrtf(wave_sum(ss) * (1.0f / DM) + EPS);
#pragma unroll
        for (int j = 0; j < 8; ++j) { const int cc = 4 * F.lane + 256 * j; const f32x4 nw = *(const f32x4*)(F.norm_ffn + cc);
            const f32x4 sh = *(const f32x4*)(MOD + (size_t)b * (6 * DM) + 3 * DM + cc), sc = *(const f32x4*)(MOD + (size_t)b * (6 * DM) + 4 * DM + cc);
            const f32x4 y = xv[j] * rstd * nw * (sc + 1.0f) + sh;
            h16 hh[4], ll[4];
#pragma unroll
            for (int e = 0; e < 4; ++e) { hh[e] = (h16)y[e]; ll[e] = (h16)(y[e] - (float)hh[e]); }
            h16* dst = H2X + (size_t)r * 6144 + cc;
            *(h16x4*)(dst) = (h16x4){hh[0], hh[1], hh[2], hh[3]}; *(h16x4*)(dst + 4096) = (h16x4){hh[0], hh[1], hh[2], hh[3]}; *(h16x4*)(dst + 2048) = (h16x4){ll[0], ll[1], ll[2], ll[3]};
            { int p8 = __builtin_amdgcn_cvt_pk_fp8_f32(y[0], y[1], 0, false); p8 = __builtin_amdgcn_cvt_pk_fp8_f32(y[2], y[3], p8, true); *(int*)((unsigned char*)(F.ws + WS_H2F8) + (size_t)r * DM + cc) = p8; } }
    }
}
struct SchedRT {
    int G, c;
    __device__ __forceinline__ bool next(int i, pg8::Unit& u) const { const int L = i * G + c; if (L >= 256) return false; u.pm = L >> 3; u.pn = 0; u.ko = (L & 7) * 768; u.nt = 0; u.keep = 0; return true; }
};
struct EpiLG {
    float* LGP;
    __device__ __forceinline__ void operator()(f32x4 (&acc)[2][2][4][2], const pg8::Unit& u, int wr, int wc, int fr, int fq) const {
        float* dst = LGP + (size_t)(u.ko / 768) * MLAT * NEXP;
#pragma unroll
        for (int ai = 0; ai < 2; ++ai)
#pragma unroll
            for (int m = 0; m < 4; ++m) { const int row = u.pm * 256 + ai * 128 + wr * 64 + m * 16 + fr;
#pragma unroll
                for (int bj = 0; bj < 2; ++bj)
#pragma unroll
                    for (int n = 0; n < 2; ++n) { const int col = bj * 128 + wc * 32 + 16 * n + 4 * fq; *(f32x4*)(dst + (size_t)row * NEXP + col) = acc[ai][bj][m][n]; } }
    }
};
__device__ __forceinline__ void p11_router(Frame& F) {
    pg8::Gemm g{(const h16*)(F.ws + WS_H2X), (const h16*)(F.ws + WS_WRTR), 6144, 6144, 768};
    SchedRT S; S.G = F.G; S.c = (int)blockIdx.x;
    EpiLG E{(float*)(F.ws + WS_LGP)};
    pg8::gemm_phase<EpiLG, SchedRT>(F.lds, g, S, E);
}
__device__ __forceinline__ void p12_topk(Frame& F) {
    const float* LGP = (const float*)(F.ws + WS_LGP); int* EIDX = (int*)(F.ws + WS_EIDX); float* EW = (float*)(F.ws + WS_EW); u32x2* LIST = (u32x2*)(F.ws + WS_LIST2);
    unsigned* CNT = (unsigned*)(F.ws + WS_CTL) + CW_CNT;
    const int gw = F.vcu * NWAVES + F.wave, NGW = F.G * NWAVES, lane = F.lane;
    const f32x4 bias = *(const f32x4*)(F.router_bias + 4 * lane);
    for (int t = gw; t < MLAT; t += NGW) {
        f32x4 lg = *(const f32x4*)(LGP + (size_t)t * NEXP + 4 * lane);
#pragma unroll
        for (int ks = 1; ks < 8; ++ks) lg += *(const f32x4*)(LGP + ((size_t)ks * MLAT + t) * NEXP + 4 * lane);
        float sc[4], sel[4];
#pragma unroll
        for (int i = 0; i < 4; ++i) { sc[i] = 1.0f / (1.0f + __expf(-lg[i])); sel[i] = sc[i] + bias[i]; }
        float a1 = fmaxf(sel[0], sel[1]), a2 = fminf(sel[0], sel[1]);
        { const float b1 = fmaxf(sel[2], sel[3]), b2 = fminf(sel[2], sel[3]); const float n1 = fmaxf(a1, b1), n2 = fmaxf(fminf(a1, b1), fmaxf(a2, b2)); a1 = n1; a2 = n2; }
#pragma unroll
        for (int off = 1; off < 8; off <<= 1) { const float b1 = __shfl_xor(a1, off), b2 = __shfl_xor(a2, off); const float n1 = fmaxf(a1, b1), n2 = fmaxf(fminf(a1, b1), fmaxf(a2, b2)); a1 = n1; a2 = n2; }
        const float gs = a1 + a2; const int g = lane >> 3;
        int rank = 0;
#pragma unroll
        for (int j = 0; j < 8; ++j) { const float o = __shfl(gs, 8 * j); rank += (o > gs || (o == gs && j < g)) ? 1 : 0; }
        const bool gsel = rank < 4;
        float ms[4];
#pragma unroll
        for (int i = 0; i < 4; ++i) ms[i] = gsel ? sel[i] : -INFINITY;
        float myw = 0.f; int mye = 0; float wsum = 0.f;
#pragma unroll
        for (int k = 0; k < TOPK; ++k) {
            float bv = ms[0]; int bi = 4 * lane;
#pragma unroll
            for (int i = 1; i < 4; ++i) if (ms[i] > bv) { bv = ms[i]; bi = 4 * lane + i; }
#pragma unroll
            for (int off = 1; off < 64; off <<= 1) { const float ov = __shfl_xor(bv, off); const int oi = __shfl_xor(bi, off); if (ov > bv || (ov == bv && oi < bi)) { bv = ov; bi = oi; } }
            const int ol = bi >> 2, oi = bi & 3;
            const float mysc = (oi == 0) ? sc[0] : (oi == 1) ? sc[1] : (oi == 2) ? sc[2] : sc[3];
            const float w = __shfl(mysc, ol);
            if (lane == ol) {
#pragma unroll
                for (int i = 0; i < 4; ++i) if (i == oi) ms[i] = -INFINITY; }
            wsum += w;
            if (lane == k) { myw = w; mye = bi; }
        }
        if (lane < TOPK) {
            const float wn = myw / wsum * 2.5f;
            EIDX[t * TOPK + lane] = mye; EW[t * TOPK + lane] = wn;
            const unsigned pos = atomicAdd(&CNT[mye], 1u);
            LIST[mye * MLAT + pos] = (u32x2){(unsigned)(t * TOPK + lane), __float_as_uint(wn)};
        }
    }
}
constexpr int EX_NSTG = 3, EX_ASTG = 24576, EX_WSTG = 16384, EX_A0 = 0, EX_W0 = EX_NSTG * EX_ASTG, EX_WH0 = EX_W0 + EX_NSTG * EX_WSTG, EX_WHS = 10240, EX_ROW0 = EX_WH0 + 2 * EX_WHS;
constexpr int EX_TAB0 = EX_ROW0 + 3200, EX_SCR0 = EX_TAB0 + 3072;
static_assert(EX_ROW0 == 143360 && EX_SCR0 + 8192 <= LDSCTL_OFF, "expert LDS map");
template <bool GU>
__device__ __forceinline__ void ring_w_prologue(Frame& F, const float* W, int cgrp) {
    constexpr int LDB = GU ? 512 : 2048;
    const int lane = F.lane, w = F.wave, v = 4 * (lane & 31);
    const int wcol0 = GU ? (((v >> 5) & 1) * 256 + 32 * (v >> 6) + (v & 31) + 64 * cgrp) : (v + 512 * cgrp);
    const float* wlane = W + (size_t)(4 * w + (lane >> 5)) * LDB + wcol0;
#pragma unroll
    for (int s = 0; s < 3; ++s)
#pragma unroll
        for (int j = 0; j < 2; ++j) __builtin_amdgcn_global_load_lds((const unsigned*)(wlane + (size_t)(s * 32 + 2 * j) * LDB), (LAS unsigned*)(F.lds + EX_W0 + s * EX_WSTG + (2 * w + j) * 1024), 16, 0, 2);
}
template <bool GU, int NLAY>
__device__ __forceinline__ void expert_ring(Frame& F, const float* W, const h16* Abase, const int (&arow)[3], int nr, int cgrp, h16* ACTrow0, h16* Y) {
    constexpr int KT = GU ? 64 : 8, NP = GU ? 1 : 4, LDB = GU ? 512 : 2048, NS = KT * NP;
    const int tid = F.tid, lane = F.lane, hi = lane >> 5, ln = lane & 31, cp = F.wave & 1, rg = F.wave >> 1, w = F.wave;
    const LAS int* RSLOT = (const LAS int*)(F.lds + EX_ROW0); const LAS float* RW = (const LAS float*)(F.lds + EX_ROW0 + 1536);
    const int ngrp = (nr + 15) >> 4;
    const int nA = (w < ngrp ? 1 : 0) + (w + 8 < ngrp ? 1 : 0) + (w + 16 < ngrp ? 1 : 0);
    const int achunk = ((lane & 3) ^ ((lane >> 4) & 3)) * 8;
    const int v = 4 * (lane & 31);
    const int wcol0 = GU ? (((v >> 5) & 1) * 256 + 32 * (v >> 6) + (v & 31) + 64 * cgrp) : (v + 512 * cgrp);
    const float* wlane = W + (size_t)(4 * w + (lane >> 5)) * LDB + wcol0;
    const unsigned lds0 = (unsigned)(uintptr_t)F.lds;
    const int xs = (ln >> 2) & 3;
    const unsigned aofs0 = (unsigned)((2 * rg + (ln >> 4)) * 1024 + (ln & 15) * 64 + ((hi ^ xs) * 16)), aofs1 = (unsigned)((2 * rg + (ln >> 4)) * 1024 + (ln & 15) * 64 + (((2 + hi) ^ xs) * 16));
    const unsigned tofs = (unsigned)((8 * hi + ((lane & 15) >> 2)) * 320 + (64 * cp + 16 * ((lane >> 4) & 1) + 4 * (lane & 3)) * 2);
    f32x16 acc[2 * NLAY];
#pragma unroll
    for (int i = 0; i < 2 * NLAY; ++i) acc[i] = (f32x16){};
#define EX_DMA_A(s) do { const int kt_ = (s) % KT, stg_ = (s) % EX_NSTG; \
        _Pragma("unroll") for (int j = 0; j < 3; ++j) if (j < nA) __builtin_amdgcn_global_load_lds((const unsigned*)(Abase + arow[j] + kt_ * 32 + achunk), (LAS unsigned*)(F.lds + EX_A0 + stg_ * EX_ASTG + (w + 8 * j) * 1024), 16, 0, 0); } while (0)
#define EX_DMA_W(s) do { const int pass_ = (s) / KT, kt_ = (s) % KT, stg_ = (s) % EX_NSTG; \
        _Pragma("unroll") for (int j = 0; j < 2; ++j) __builtin_amdgcn_global_load_lds((const unsigned*)(wlane + (size_t)(kt_ * 32 + 2 * j) * LDB + 128 * pass_), (LAS unsigned*)(F.lds + EX_W0 + stg_ * EX_WSTG + (2 * w + j) * 1024), 16, 0, 2); } while (0)
#define EX_WAITV(k) asm volatile("s_waitcnt vmcnt(" #k ")" ::: "memory")
#define EX_WAITN() do { if (nA == 3) EX_WAITV(5); else if (nA == 2) EX_WAITV(4); else if (nA == 1) EX_WAITV(3); else EX_WAITV(2); } while (0)
    const unsigned cvsrc = lds0 + EX_W0 + (tid >> 4) * 512 + (tid & 15) * 32, cvdst = lds0 + EX_WH0 + (tid >> 4) * 320 + (tid & 15) * 16;
    EX_DMA_A(0); EX_DMA_A(1);
    if (nA == 3) EX_WAITV(3); else if (nA == 2) EX_WAITV(2); else if (nA == 1) EX_WAITV(1); else EX_WAITV(0);
    __builtin_amdgcn_s_barrier(); asm volatile("" ::: "memory");
    { f32x4 c0, c1; asm volatile("ds_read_b128 %0, %2\n\tds_read_b128 %1, %2 offset:16\n\ts_waitcnt lgkmcnt(0)" : "=&v"(c0), "=&v"(c1) : "v"(cvsrc) : "memory");
      const h16x8 hv = pack8(c0[0], c0[1], c0[2], c0[3], c1[0], c1[1], c1[2], c1[3]); asm volatile("ds_write_b128 %0, %1" :: "v"(cvdst), "v"(hv) : "memory"); }
    typedef short s16x8 __attribute__((ext_vector_type(8)));
    for (int s = 0; s < NS; ++s) {
        if (s + 2 < NS) EX_WAITN(); else EX_WAITV(0);
        asm volatile("s_waitcnt lgkmcnt(0)" ::: "memory");
        __builtin_amdgcn_s_barrier();
        asm volatile("" ::: "memory");
        const bool pend = ((s % KT) == KT - 1);
        if (!pend) { if (s + 2 < NS) EX_DMA_A(s + 2); if (s + 3 < NS) EX_DMA_W(s + 3); }
        const unsigned abase = lds0 + EX_A0 + (s % EX_NSTG) * EX_ASTG, wbase = lds0 + EX_WH0 + (s & 1) * EX_WHS + tofs;
        const unsigned cs = cvsrc + ((s + 1) % EX_NSTG) * EX_WSTG;
        const unsigned pa0 = abase + aofs0, pa1 = abase + aofs1;
        if constexpr (NLAY < 3) {
            v4i16_t t0, t1, t2, t3, t4, t5, t6, t7; h16x8 a0[NLAY], a1[NLAY];
            asm volatile("ds_read_b64_tr_b16 %0, %8\n\tds_read_b64_tr_b16 %1, %8 offset:1280\n\tds_read_b64_tr_b16 %2, %8 offset:64\n\tds_read_b64_tr_b16 %3, %8 offset:1344\n\t"
                         "ds_read_b64_tr_b16 %4, %8 offset:5120\n\tds_read_b64_tr_b16 %5, %8 offset:6400\n\tds_read_b64_tr_b16 %6, %8 offset:5184\n\tds_read_b64_tr_b16 %7, %8 offset:6464"
                         : "=&v"(t0), "=&v"(t1), "=&v"(t2), "=&v"(t3), "=&v"(t4), "=&v"(t5), "=&v"(t6), "=&v"(t7) : "v"(wbase) : "memory");
            asm volatile("ds_read_b128 %0, %2\n\tds_read_b128 %1, %3" : "=&v"(a0[0]), "=&v"(a1[0]) : "v"(pa0), "v"(pa1) : "memory");
            if constexpr (NLAY >= 2) asm volatile("ds_read_b128 %0, %2 offset:8192\n\tds_read_b128 %1, %3 offset:8192" : "=&v"(a0[1]), "=&v"(a1[1]) : "v"(pa0), "v"(pa1) : "memory");
            asm volatile("s_waitcnt lgkmcnt(0)" ::: "memory");
            __builtin_amdgcn_sched_barrier(0);
            const h16x8 b00 = __builtin_bit_cast(h16x8, (s16x8){t0[0], t0[1], t0[2], t0[3], t1[0], t1[1], t1[2], t1[3]}), b01 = __builtin_bit_cast(h16x8, (s16x8){t2[0], t2[1], t2[2], t2[3], t3[0], t3[1], t3[2], t3[3]});
            const h16x8 b10 = __builtin_bit_cast(h16x8, (s16x8){t4[0], t4[1], t4[2], t4[3], t5[0], t5[1], t5[2], t5[3]}), b11 = __builtin_bit_cast(h16x8, (s16x8){t6[0], t6[1], t6[2], t6[3], t7[0], t7[1], t7[2], t7[3]});
#pragma unroll
            for (int i = 0; i < NLAY; ++i) { acc[2 * i] = MFMA32(a0[i], b00, acc[2 * i]); acc[2 * i + 1] = MFMA32(a0[i], b01, acc[2 * i + 1]); }
#pragma unroll
            for (int i = 0; i < NLAY; ++i) { acc[2 * i] = MFMA32(a1[i], b10, acc[2 * i]); acc[2 * i + 1] = MFMA32(a1[i], b11, acc[2 * i + 1]); }
        } else {
#pragma unroll
            for (int k16 = 0; k16 < 2; ++k16) {
                v4i16_t t0, t1, t2, t3; h16x8 a[3]; const unsigned pa = k16 ? pa1 : pa0, pw = wbase + k16 * 5120;
                asm volatile("ds_read_b64_tr_b16 %0, %4\n\tds_read_b64_tr_b16 %1, %4 offset:1280\n\tds_read_b64_tr_b16 %2, %4 offset:64\n\tds_read_b64_tr_b16 %3, %4 offset:1344"
                             : "=&v"(t0), "=&v"(t1), "=&v"(t2), "=&v"(t3) : "v"(pw) : "memory");
                asm volatile("ds_read_b128 %0, %3\n\tds_read_b128 %1, %3 offset:8192\n\tds_read_b128 %2, %3 offset:16384\n\ts_waitcnt lgkmcnt(0)" : "=&v"(a[0]), "=&v"(a[1]), "=&v"(a[2]) : "v"(pa) : "memory");
                __builtin_amdgcn_sched_barrier(0);
                const h16x8 b0 = __builtin_bit_cast(h16x8, (s16x8){t0[0], t0[1], t0[2], t0[3], t1[0], t1[1], t1[2], t1[3]}), b1 = __builtin_bit_cast(h16x8, (s16x8){t2[0], t2[1], t2[2], t2[3], t3[0], t3[1], t3[2], t3[3]});
#pragma unroll
                for (int i = 0; i < 3; ++i) { acc[2 * i] = MFMA32(a[i], b0, acc[2 * i]); acc[2 * i + 1] = MFMA32(a[i], b1, acc[2 * i + 1]); }
                __builtin_amdgcn_sched_barrier(0);
            }
        }
        if (s + 1 < NS) {
            f32x4 c0, c1; asm volatile("ds_read_b128 %0, %2\n\tds_read_b128 %1, %2 offset:16\n\ts_waitcnt lgkmcnt(0)" : "=&v"(c0), "=&v"(c1) : "v"(cs) : "memory");
            const h16x8 hv = pack8(c0[0], c0[1], c0[2], c0[3], c1[0], c1[1], c1[2], c1[3]); const unsigned cd = cvdst + ((s + 1) & 1) * EX_WHS; asm volatile("ds_write_b128 %0, %1" :: "v"(cd), "v"(hv) : "memory"); }
        if (pend) {
            const int pass = s / KT;
            int hio = hi, lno = ln; asm volatile("" : "+v"(hio), "+v"(lno));
            if (GU) {
#pragma unroll
                for (int i = 0; i < NLAY; ++i) { const int rt = rg + 4 * i;
#pragma unroll
                    for (int r = 0; r < 16; ++r) { const int row = 32 * rt + crow(r, hio);
                        if (row < nr) ACTrow0[(size_t)row * DEXP + 64 * cgrp + 32 * cp + lno] = (h16)(silu_f(acc[2 * i][r]) * acc[2 * i + 1][r]); }
                    acc[2 * i] = (f32x16){}; acc[2 * i + 1] = (f32x16){}; }
            } else {
                const unsigned scr = lds0 + EX_SCR0 + w * 1024;
                unsigned char* Y8 = (unsigned char*)Y;
#pragma unroll
                for (int i = 0; i < NLAY; ++i) { const int rt = rg + 4 * i;
#pragma unroll
                    for (int g8 = 0; g8 < 4; ++g8) {
#pragma unroll
                        for (int q = 0; q < 4; ++q) { const int lr = 4 * hio + q; const float wt = RW[32 * rt + 8 * g8 + lr];
                            const int pk = __builtin_amdgcn_cvt_pk_fp8_f32(acc[2 * i][4 * g8 + q] * wt, acc[2 * i + 1][4 * g8 + q] * wt, 0, false); const int pk1 = pk >> 8; const unsigned wa = scr + lr * 64 + lno;
                            asm volatile("ds_write_b8 %0, %1\n\tds_write_b8 %0, %2 offset:32" :: "v"(wa), "v"(pk), "v"(pk1) : "memory"); }
                        u32x2 pv; const unsigned ra = scr + (lane >> 3) * 64 + (lane & 7) * 8;
                        asm volatile("s_waitcnt lgkmcnt(0)\n\tds_read_b64 %0, %1\n\ts_waitcnt lgkmcnt(0)" : "=&v"(pv) : "v"(ra) : "memory");
                        const int grow = 32 * rt + 8 * g8 + (lane >> 3);
                        if (grow < nr) { const int slot = RSLOT[grow]; *(u32x2*)(Y8 + (size_t)slot * DM + 512 * cgrp + 128 * pass + 64 * cp + (lane & 7) * 8) = pv; }
                    }
                    acc[2 * i] = (f32x16){}; acc[2 * i + 1] = (f32x16){}; }
            }
            if (s + 2 < NS) EX_DMA_A(s + 2);
            if (s + 3 < NS) EX_DMA_W(s + 3);
        }
    }
    asm volatile("s_waitcnt vmcnt(0) lgkmcnt(0)" ::: "memory");
    __builtin_amdgcn_s_barrier();
    asm volatile("" ::: "memory");
#undef EX_DMA_A
#undef EX_DMA_W
#undef EX_WAITV
#undef EX_WAITN
}

constexpr int G8_NSTG = 4, G8_ASTG = 12288, G8_WSTG = 16384, G8_A0 = 0, G8_W0 = G8_NSTG * G8_ASTG, G8_WH0 = G8_W0 + G8_NSTG * G8_WSTG, G8_WHS = 4096;
static_assert(G8_WH0 + 2 * G8_WHS <= EX_ROW0, "gu8 LDS map");
__device__ __forceinline__ void gu8_w_prologue(Frame& F, const float* W, int cgrp) {
    const int lane = F.lane, w = F.wave, v = 4 * (lane & 31);
    const int wcol0 = ((v >> 5) & 1) * 256 + 32 * (v >> 6) + (v & 31) + 64 * cgrp;
    const float* wlane = W + (size_t)(4 * w + (lane >> 5)) * 512 + wcol0;
#pragma unroll
    for (int s = 0; s < 4; ++s)
#pragma unroll
        for (int j = 0; j < 2; ++j) __builtin_amdgcn_global_load_lds((const unsigned*)(wlane + (size_t)(s * 32 + 2 * j) * 512), (LAS unsigned*)(F.lds + G8_W0 + s * G8_WSTG + (2 * w + j) * 1024), 16, 0, 2);
}
template <int NLAY>
__device__ __forceinline__ void expert_ring_gu8(Frame& F, const float* W, const unsigned char* A8, const int (&arow)[2], int nr, int cgrp, h16* ACTrow0) {
    constexpr int NS = 64;
    typedef long v2i64 __attribute__((ext_vector_type(2)));
    const int tid = F.tid, lane = F.lane, hi = lane >> 5, ln = lane & 31, cp = F.wave & 1, rg = F.wave >> 1, w = F.wave;
    const int ngrp = (nr + 31) >> 5;
    const int nA = (w < ngrp ? 1 : 0) + (w + 8 < ngrp ? 1 : 0);
    const int v = 4 * (lane & 31);
    const int wcol0 = ((v >> 5) & 1) * 256 + 32 * (v >> 6) + (v & 31) + 64 * cgrp;
    const float* wlane = W + (size_t)(4 * w + (lane >> 5)) * 512 + wcol0;
    const unsigned lds0 = (unsigned)(uintptr_t)F.lds;
    const unsigned aofs = (unsigned)(rg * 1024 + ln * 32 + hi * 16);
    const unsigned bofs = (unsigned)((64 * cp + ln) * 32 + hi * 16);
    const unsigned cvsrc = lds0 + G8_W0 + (tid >> 7) * 8 * 512 + (tid & 127) * 4, cvdst = lds0 + G8_WH0 + (tid & 127) * 32 + (tid >> 7) * 8;
    f32x16 acc[2 * NLAY];
#pragma unroll
    for (int i = 0; i < 2 * NLAY; ++i) acc[i] = (f32x16){};
#define G8_DMA_A(s) do { const int stg_ = (s) & 3; \
        _Pragma("unroll") for (int j = 0; j < 2; ++j) if (j < nA) __builtin_amdgcn_global_load_lds((const unsigned*)(A8 + arow[j] + (s) * 32 + (lane & 1) * 16), (LAS unsigned*)(F.lds + G8_A0 + stg_ * G8_ASTG + (w + 8 * j) * 1024), 16, 0, 0); } while (0)
#define G8_DMA_W(s) do { const int stg_ = (s) & 3; \
        _Pragma("unroll") for (int j = 0; j < 2; ++j) __builtin_amdgcn_global_load_lds((const unsigned*)(wlane + (size_t)((s) * 32 + 2 * j) * 512), (LAS unsigned*)(F.lds + G8_W0 + stg_ * G8_WSTG + (2 * w + j) * 1024), 16, 0, 2); } while (0)
#define G8_WAITV(k) asm volatile("s_waitcnt vmcnt(" #k ")" ::: "memory")
#define G8_CVT(s) do { float c_[8]; const unsigned cs_ = cvsrc + ((s) & 3) * G8_WSTG; \
        asm volatile("ds_read_b32 %0, %8\n\tds_read_b32 %1, %8 offset:512\n\tds_read_b32 %2, %8 offset:1024\n\tds_read_b32 %3, %8 offset:1536\n\tds_read_b32 %4, %8 offset:2048\n\tds_read_b32 %5, %8 offset:2560\n\tds_read_b32 %6, %8 offset:3072\n\tds_read_b32 %7, %8 offset:3584\n\ts_waitcnt lgkmcnt(0)" \
                     : "=&v"(c_[0]), "=&v"(c_[1]), "=&v"(c_[2]), "=&v"(c_[3]), "=&v"(c_[4]), "=&v"(c_[5]), "=&v"(c_[6]), "=&v"(c_[7]) : "v"(cs_) : "memory"); \
        int p0_ = __builtin_amdgcn_cvt_pk_fp8_f32(c_[0] * 64.f, c_[1] * 64.f, 0, false); p0_ = __builtin_amdgcn_cvt_pk_fp8_f32(c_[2] * 64.f, c_[3] * 64.f, p0_, true); \
        int p1_ = __builtin_amdgcn_cvt_pk_fp8_f32(c_[4] * 64.f, c_[5] * 64.f, 0, false); p1_ = __builtin_amdgcn_cvt_pk_fp8_f32(c_[6] * 64.f, c_[7] * 64.f, p1_, true); \
        const u32x2 pk_ = {(unsigned)p0_, (unsigned)p1_}; const unsigned cd_ = cvdst + ((s) & 1) * G8_WHS; asm volatile("ds_write_b64 %0, %1" :: "v"(cd_), "v"(pk_) : "memory"); } while (0)
    G8_DMA_A(0); G8_DMA_A(1); G8_DMA_A(2);
    if (nA == 2) G8_WAITV(4); else if (nA == 1) G8_WAITV(2); else G8_WAITV(0);
    __builtin_amdgcn_s_barrier(); asm volatile("" ::: "memory");
    G8_CVT(0);
    for (int s = 0; s < NS; ++s) {
        if (s >= 2 && s + 4 < NS) { if (nA == 2) G8_WAITV(8); else if (nA == 1) G8_WAITV(6); else G8_WAITV(4); }
        else if (s < 2) { if (nA == 2) G8_WAITV(4); else if (nA == 1) G8_WAITV(3); else G8_WAITV(2); }
        else G8_WAITV(0);
        asm volatile("s_waitcnt lgkmcnt(0)" ::: "memory");
        __builtin_amdgcn_s_barrier();
        asm volatile("" ::: "memory");
        if (s + 3 < NS) G8_DMA_A(s + 3);
        if (s + 4 < NS) G8_DMA_W(s + 4);
        const unsigned pa = lds0 + G8_A0 + (s & 3) * G8_ASTG + aofs, pb = lds0 + G8_WH0 + (s & 1) * G8_WHS + bofs;
        v2i64 a[NLAY], b0, b1;
        asm volatile("ds_read_b128 %0, %2\n\tds_read_b128 %1, %2 offset:1024" : "=&v"(b0), "=&v"(b1) : "v"(pb) : "memory");
        asm volatile("ds_read_b128 %0, %1" : "=&v"(a[0]) : "v"(pa) : "memory");
        if constexpr (NLAY >= 2) asm volatile("ds_read_b128 %0, %1 offset:4096" : "=&v"(a[1]) : "v"(pa) : "memory");
        if constexpr (NLAY >= 3) asm volatile("ds_read_b128 %0, %1 offset:8192" : "=&v"(a[2]) : "v"(pa) : "memory");
        asm volatile("s_waitcnt lgkmcnt(0)" ::: "memory");
        __builtin_amdgcn_sched_barrier(0);
#pragma unroll
        for (int i = 0; i < NLAY; ++i) { acc[2 * i] = __builtin_amdgcn_mfma_f32_32x32x16_fp8_fp8(a[i][0], b0[0], acc[2 * i], 0, 0, 0); acc[2 * i + 1] = __builtin_amdgcn_mfma_f32_32x32x16_fp8_fp8(a[i][0], b1[0], acc[2 * i + 1], 0, 0, 0); }
#pragma unroll
        for (int i = 0; i < NLAY; ++i) { acc[2 * i] = __builtin_amdgcn_mfma_f32_32x32x16_fp8_fp8(a[i][1], b0[1], acc[2 * i], 0, 0, 0); acc[2 * i + 1] = __builtin_amdgcn_mfma_f32_32x32x16_fp8_fp8(a[i][1], b1[1], acc[2 * i + 1], 0, 0, 0); }
        if (s + 1 < NS) G8_CVT(s + 1);
    }
    {
        int hio = hi, lno = ln; asm volatile("" : "+v"(hio), "+v"(lno));
#pragma unroll
        for (int i = 0; i < NLAY; ++i) { const int rt = rg + 4 * i;
#pragma unroll
            for (int r = 0; r < 16; ++r) { const int row = 32 * rt + crow(r, hio);
                if (row < nr) ACTrow0[(size_t)row * DEXP + 64 * cgrp + 32 * cp + lno] = (h16)(silu_f(acc[2 * i][r] * 0.015625f) * (acc[2 * i + 1][r] * 0.015625f)); } }
    }
    asm volatile("s_waitcnt vmcnt(0) lgkmcnt(0)" ::: "memory");
    __builtin_amdgcn_s_barrier();
    asm volatile("" ::: "memory");
#undef G8_DMA_A
#undef G8_DMA_W
#undef G8_WAITV
#undef G8_CVT
}
template <bool GU>
__device__ __forceinline__ void p13_expert_phase(Frame& F, int qid) {
    const h16* H2X = (const h16*)(F.ws + WS_H2X); h16* Y = (h16*)(F.ws + WS_Y); h16* ACT = (h16*)(F.ws + WS_ACT);
    const unsigned* CNT = (const unsigned*)(F.ws + WS_CTL) + CW_CNT; unsigned* QH = (unsigned*)(F.ws + WS_CTL) + CW_Q + 64 * qid;
    LAS int* RSLOT = (LAS int*)(F.lds + EX_ROW0); LAS float* RW = (LAS float*)(F.lds + EX_ROW0 + 1536); LAS int* RED = (LAS int*)(F.lds + EX_ROW0 + 3072);
    LAS int* CN = (LAS int*)(F.lds + EX_TAB0); LAS int* ORD = CN + 256; LAS int* OFF = CN + 512;
    __syncthreads();
    if (F.tid < NEXP) CN[F.tid] = (int)CNT[F.tid];
    __syncthreads();
    if (F.tid < NEXP) { const int c = CN[F.tid]; int rank = 0, off = 0;
        for (int j = 0; j < NEXP; ++j) { const int cj = CN[j]; rank += (cj > c || (cj == c && j < F.tid)) ? 1 : 0; off += (j < F.tid) ? cj : 0; }
        ORD[rank] = F.tid; OFF[F.tid] = off; }
    __syncthreads();
    const u32x2* LIST2 = (const u32x2*)(F.ws + WS_LIST2);
    if (F.tid == 0) RED[0] = (int)__hip_atomic_fetch_add(QH, 1u, __ATOMIC_RELAXED, __HIP_MEMORY_SCOPE_AGENT);
    __syncthreads();
    int u = RED[0];
    while (u < NEXP * 4) {
        const int e = ORD[u >> 2], cg = u & 3, cnt = CN[e], off_e = OFF[e];
        const float* Wgu = F.w_exp_gu + (size_t)e * DM * 512; const float* Wdn = F.w_exp_down + (size_t)e * DEXP * DM;
        for (int rs = 0; rs < cnt; rs += 384) {
            const int nr = (cnt - rs) < 384 ? (cnt - rs) : 384;
            __syncthreads();
            if (GU) gu8_w_prologue(F, Wgu, cg); else ring_w_prologue<false>(F, Wdn, cg);
            if (F.tid < 384) { u32x2 ent = {0u, 0u}; if (F.tid < nr) ent = LIST2[e * MLAT + rs + F.tid]; RSLOT[F.tid] = (int)ent.x; RW[F.tid] = __uint_as_float(ent.y); }
            __syncthreads();
            h16* ACTrow0 = ACT + (size_t)(off_e + rs) * DEXP;
            int arow[3];
            if (GU) {
                int ar8[2];
#pragma unroll
                for (int j = 0; j < 2; ++j) { const int r = 32 * (F.wave + 8 * j) + (F.lane >> 1); ar8[j] = (r < 384 ? (RSLOT[r] >> 3) : 0) * DM; }
                const unsigned char* A8 = (const unsigned char*)(F.ws + WS_H2F8);
                if (nr > 256) expert_ring_gu8<3>(F, Wgu, A8, ar8, nr, cg, ACTrow0); else if (nr > 128) expert_ring_gu8<2>(F, Wgu, A8, ar8, nr, cg, ACTrow0); else expert_ring_gu8<1>(F, Wgu, A8, ar8, nr, cg, ACTrow0);
            } else {
#pragma unroll
                for (int j = 0; j < 3; ++j) { const int r = 16 * (F.wave + 8 * j) + (F.lane >> 2); arow[j] = ((r < nr) ? r : 0) * DEXP; }
                if (nr > 256) expert_ring<false, 3>(F, Wdn, ACTrow0, arow, nr, cg, ACTrow0, Y); else if (nr > 128) expert_ring<false, 2>(F, Wdn, ACTrow0, arow, nr, cg, ACTrow0, Y); else expert_ring<false, 1>(F, Wdn, ACTrow0, arow, nr, cg, ACTrow0, Y);
            }
        }
        __syncthreads();
        if (F.tid == 0) RED[0] = (int)__hip_atomic_fetch_add(QH, 1u, __ATOMIC_RELAXED, __HIP_MEMORY_SCOPE_AGENT);
        __syncthreads();
        u = RED[0];
    }
}
struct SchedSG {
    int G, c;
    __device__ __forceinline__ bool next(int i, pg8::Unit& u) const { const int L = i * G + c; if (L >= 256) return false; u.pm = L >> 3; u.pn = (L >> 2) & 1; u.ko = (L & 3) * 512; u.nt = 0; u.keep = 0; return true; }
};
struct EpiSGP {
    float* SGP;
    __device__ __forceinline__ void operator()(f32x4 (&acc)[2][2][4][2], const pg8::Unit& u, int wr, int wc, int fr, int fq) const {
        float* dst = SGP + (size_t)(u.ko / 512) * MLAT * 512;
#pragma unroll
        for (int ai = 0; ai < 2; ++ai)
#pragma unroll
            for (int m = 0; m < 4; ++m) { const int row = u.pm * 256 + ai * 128 + wr * 64 + m * 16 + fr;
#pragma unroll
                for (int bj = 0; bj < 2; ++bj)
#pragma unroll
                    for (int n = 0; n < 2; ++n) { const int col = u.pn * 256 + bj * 128 + wc * 32 + 16 * n + 4 * fq; *(f32x4*)(dst + (size_t)row * 512 + col) = acc[ai][bj][m][n]; } }
    }
};
__device__ __forceinline__ void p11b_shared_gu(Frame& F) {
    pg8::Gemm g{(const h16*)(F.ws + WS_H2X), (const h16*)(F.ws + WS_WSGU), 6144, 2048, 512};
    SchedSG S; S.G = F.G; S.c = (int)blockIdx.x;
    EpiSGP E{(float*)(F.ws + WS_SGP)};
    pg8::gemm_phase<EpiSGP, SchedSG>(F.lds, g, S, E);
}
__device__ __forceinline__ void p12b_shared_act(Frame& F) {
    const float* SGP = (const float*)(F.ws + WS_SGP); h16* ACTS = (h16*)(F.ws + WS_ACTS);
    for (int q = blockIdx.x * NTHR + F.tid; q < MLAT * 64; q += F.G * NTHR) {
        const int row = q >> 6, j = (q & 63) * 4, pg = 32 * (j >> 4) + (j & 15);
        f32x4 gv = {0.f, 0.f, 0.f, 0.f}, uv = gv;
#pragma unroll
        for (int ks = 0; ks < 4; ++ks) { const float* p = SGP + ((size_t)ks * MLAT + row) * 512 + pg; gv += *(const f32x4*)p; uv += *(const f32x4*)(p + 16); }
        u32x2 w; w.x = pk2h(silu_f(gv[0]) * uv[0], silu_f(gv[1]) * uv[1]); w.y = pk2h(silu_f(gv[2]) * uv[2], silu_f(gv[3]) * uv[3]);
        *(u32x2*)(ACTS + (size_t)row * DEXP + j) = w;
    }
}
struct EpiYsh {
    h16* YSH;
    __device__ __forceinline__ void operator()(f32x4 (&acc)[2][2][4][2], const pg8::Unit& u, int wr, int wc, int fr, int fq) const {
#pragma unroll
        for (int ai = 0; ai < 2; ++ai)
#pragma unroll
            for (int m = 0; m < 4; ++m) { const int row = u.pm * 256 + ai * 128 + wr * 64 + m * 16 + fr;
#pragma unroll
                for (int bj = 0; bj < 2; ++bj)
#pragma unroll
                    for (int n = 0; n < 2; ++n) { const int col = u.pn * 256 + bj * 128 + wc * 32 + 16 * n + 4 * fq; const f32x4 a = acc[ai][bj][m][n];
                        u32x2 w; w.x = pk2h(a[0], a[1]); w.y = pk2h(a[2], a[3]); *(u32x2*)(YSH + (size_t)row * DM + col) = w; } }
    }
};
struct SchedOne {
    int pm, pn;
    __device__ __forceinline__ bool next(int i, pg8::Unit& u) const { if (i != 0) return false; u.pm = pm; u.pn = pn; u.ko = 0; u.nt = 0; u.keep = 0; return true; }
};
__device__ __forceinline__ void p15_shared_down_dyn(Frame& F, int qid) {
    unsigned* QH = (unsigned*)(F.ws + WS_CTL) + CW_Q + 64 * 8 * qid;
    LAS int* RED = (LAS int*)(F.lds + EX_ROW0 + 3072);
    for (;;) {
        __syncthreads();
        if (F.tid == 0) RED[0] = (int)__hip_atomic_fetch_add(QH, 1u, __ATOMIC_RELAXED, __HIP_MEMORY_SCOPE_AGENT);
        __syncthreads();
        const int t = RED[0];
        if (t >= 256) break;
        pg8::Gemm g{(const h16*)(F.ws + WS_ACTS), (const h16*)(F.ws + WS_WSDN), 256, 256, 256};
        SchedOne S; S.pm = t >> 3; S.pn = t & 7;
        EpiYsh E{(h16*)(F.ws + WS_YSH)};
        pg8::gemm_phase<EpiYsh, SchedOne>(F.lds, g, S, E);
    }
}
__device__ __forceinline__ void p15_shared_down(Frame& F) {
    pg8::Gemm g{(const h16*)(F.ws + WS_ACTS), (const h16*)(F.ws + WS_WSDN), 256, 256, 256};
    pg8::StaticOrder S; S.init(MLAT, DM, F.G, (int)blockIdx.x);
    EpiYsh E{(h16*)(F.ws + WS_YSH)};
    pg8::gemm_phase<EpiYsh, pg8::StaticOrder>(F.lds, g, S, E);
}
__device__ __forceinline__ void p16_combine(Frame& F) {
    const float* X1 = (const float*)(F.ws + WS_X1); const float* MOD = (const float*)(F.ws + WS_MOD); const h16* Y = (const h16*)(F.ws + WS_Y); const h16* YSH = (const h16*)(F.ws + WS_YSH);
    const int gw = F.vcu * NWAVES + F.wave, NGW = F.G * NWAVES;
    for (int r = gw; r < MLAT; r += NGW) {
        const int b = r / SEQ;
        f32x4 xv[8]; float ss = 0.f;
#pragma unroll
        for (int j = 0; j < 8; ++j) { const int cc = 4 * F.lane + 256 * j;
            f32x4 m = {0.f, 0.f, 0.f, 0.f};
#pragma unroll
            for (int k = 0; k < TOPK; ++k) { const int yv = *(const int*)((const unsigned char*)Y + (size_t)(r * TOPK + k) * DM + cc);
                const f32x2 lo = __builtin_amdgcn_cvt_pk_f32_fp8(yv, false), hi2 = __builtin_amdgcn_cvt_pk_f32_fp8(yv, true); m += (f32x4){lo[0], lo[1], hi2[0], hi2[1]}; }
            { const h16x4 yv = *(const h16x4*)(YSH + (size_t)r * DM + cc); m += (f32x4){(float)yv[0], (float)yv[1], (float)yv[2], (float)yv[3]}; }
            const f32x4 g2 = *(const f32x4*)(MOD + (size_t)b * (6 * DM) + 5 * DM + cc);
            xv[j] = *(const f32x4*)(X1 + (size_t)r * DM + cc) + g2 * m;
            ss += (xv[j].x * xv[j].x + xv[j].y * xv[j].y) + (xv[j].z * xv[j].z + xv[j].w * xv[j].w); }
        const float rstd = 1.0f / sqrtf(wave_sum(ss) * (1.0f / DM) + EPS);
#pragma unroll
        for (int j = 0; j < 8; ++j) { const int cc = 4 * F.lane + 256 * j; const f32x4 nw = *(const f32x4*)(F.final_norm + cc);
            *(f32x4*)(F.out + (size_t)r * DM + cc) = xv[j] * rstd * nw; }
    }
}

__device__ __forceinline__ void p_final_plain(Frame& F, const float* xin) {
    const int gw = F.vcu * NWAVES + F.wave, NGW = F.G * NWAVES;
    for (int r = gw; r < MLAT; r += NGW) {
        const float* src = xin + (size_t)r * DM;
        f32x4 xv[8]; float ss = 0.f;
#pragma unroll
        for (int j = 0; j < 8; ++j) { xv[j] = *(const f32x4*)(src + 4 * F.lane + 256 * j); ss += (xv[j].x * xv[j].x + xv[j].y * xv[j].y) + (xv[j].z * xv[j].z + xv[j].w * xv[j].w); }
        const float rstd = 1.0f / sqrtf(wave_sum(ss) * (1.0f / DM) + EPS);
#pragma unroll
        for (int j = 0; j < 8; ++j) { const int cc = 4 * F.lane + 256 * j; const f32x4 nw = *(const f32x4*)(F.final_norm + cc);
            *(f32x4*)(F.out + (size_t)r * DM + cc) = xv[j] * rstd * nw; }
    }
}

constexpr int N_PHASES = 15;
#ifndef DUP_PHASE
#define DUP_PHASE -1
#endif
#ifndef DUP_VAR
#define DUP_VAR 7
#endif
struct Args { const float* in[22]; float* out; unsigned char* ws; int ph_lo, ph_hi; };
__global__ void __launch_bounds__(NTHR, 2) mk_fwd(Args args) {
    extern __shared__ __attribute__((aligned(16))) unsigned char lds_raw[];
    Frame F;
    F.lds = (LAS unsigned char*)lds_raw;
    F.tid = threadIdx.x; F.lane = F.tid & 63; F.wave = __builtin_amdgcn_readfirstlane(F.tid >> 6);
    F.G = gridDim.x; { const int bx = blockIdx.x; F.vcu = (F.G % 8 == 0) ? (bx % 8) * (F.G / 8) + bx / 8 : bx; }
    F.x = args.in[0]; F.c = args.in[1]; F.ctx = args.in[2]; F.c_ctx = args.in[3]; F.w_mod = args.in[4]; F.b_mod = args.in[5]; F.norm_attn = args.in[6]; F.norm_ffn = args.in[7];
    F.w_in = args.in[8]; F.ret_decay = args.in[9]; F.diff_lambda = args.in[10]; F.diff_subln = args.in[11]; F.w_ret_o = args.in[12]; F.w_diff_o = args.in[13]; F.w_out = args.in[14];
    F.w_router = args.in[15]; F.router_bias = args.in[16]; F.w_exp_gu = args.in[17]; F.w_exp_down = args.in[18]; F.w_sh_gu = args.in[19]; F.w_sh_down = args.in[20]; F.final_norm = args.in[21];
    F.out = args.out; F.ws = args.ws;
    volatile LAS unsigned* MISC = (volatile LAS unsigned*)(F.lds + LDSCTL_OFF);
    for (int u = F.tid; u < (LDS_BYTES - LDSCTL_OFF) / 4; u += NTHR) ((LAS unsigned*)(F.lds + LDSCTL_OFF))[u] = 0u;
    __syncthreads();
    const int lo = args.ph_lo, hi = args.ph_hi;
    const bool multi = (hi - lo) > 1;
    XcdBarrier bar; bar.bar = (unsigned*)(F.ws + WS_CTL) + CW_BAR; bar.x = 0; bar.st = nullptr;
    if (multi) bar = xcd_barrier_post((unsigned*)(F.ws + WS_CTL) + CW_BAR, MISC + 8);
#define IN(k) (lo <= (k) && (k) < hi)
#define SEAM(k) do { if (IN(k) && IN((k) + 1)) xcd_barrier(bar); } while (0)

#define RUNP(k, call) do { if (IN(k)) { call; if (DUP_PHASE == (k)) { xcd_barrier(bar); call; } } SEAM(k); } while (0)
    RUNP(0, p0a_mod(F));
    RUNP(1, (p1_norm1(F), p0b_weights(F)));
    RUNP(2, (p2_gemm1(F), p0c_weights_dyn(F, 5)));
    RUNP(3, p3_ret_local(F));
    RUNP(4, p4_ret_scan(F));
    RUNP(5, p5_ret_out(F));
    RUNP(6, p6_attn(F));
    RUNP(7, p7_gemm2(F));
    RUNP(8, p9_gemm3(F));
    RUNP(9, p10_norm2(F));
    RUNP(10, (p11_router(F), p11b_shared_gu(F)));
    RUNP(11, (p12_topk(F), p12b_shared_act(F)));
    if (IN(12)) { p13_expert_phase<true>(F, 0); p15_shared_down_dyn(F, 4); if (DUP_PHASE == 12) { xcd_barrier(bar); p13_expert_phase<true>(F, 2); } } SEAM(12);
    if (IN(13)) { p13_expert_phase<false>(F, 1); if (DUP_PHASE == 13) { xcd_barrier(bar); p13_expert_phase<false>(F, 3); } } SEAM(13);
    if (IN(14)) { p16_combine(F); }
#undef RUNP
#undef IN
#undef SEAM
}

constexpr bool ONE_LAUNCH = true;
extern "C" void kernel_launch(void* const* d_in, const int* in_sizes, int n_in, void* d_out, int out_size, void* d_ws, size_t ws_size, hipStream_t stream) {
    static int grid = 0;
    if (grid == 0) {
        if (n_in != 22 || out_size != MLAT * DM || ws_size < WS_END) { fprintf(stderr, "kernel_launch: unexpected sizes n_in %d out %d ws %zu\n", n_in, out_size, ws_size); grid = -1; return; }
        int dev = 0, cus = 0;
        if (hipGetDevice(&dev) != hipSuccess || hipDeviceGetAttribute(&cus, hipDeviceAttributeMultiprocessorCount, dev) != hipSuccess) { grid = -1; return; }
        if (hipFuncSetAttribute((const void*)mk_fwd, hipFuncAttributeMaxDynamicSharedMemorySize, LDS_BYTES) != hipSuccess) { fprintf(stderr, "kernel_launch: hipFuncSetAttribute failed\n"); grid = -1; return; }
        int per_cu = 0;
        if (hipOccupancyMaxActiveBlocksPerMultiprocessor(&per_cu, (const void*)mk_fwd, NTHR, LDS_BYTES) != hipSuccess || per_cu < 1) fprintf(stderr, "kernel_launch: occupancy query reports %d\n", per_cu);
        (void)hipGetLastError();
        grid = cus;
    }
    if (grid < 0) return;
    (void)hipMemsetAsync((char*)d_ws + WS_CTL, 0, CTL_ZERO_BYTES, stream);
    Args a{};
    for (int i = 0; i < 22; ++i) a.in[i] = (const float*)d_in[i];
    a.out = (float*)d_out; a.ws = (unsigned char*)d_ws;
    if (ONE_LAUNCH) {
        a.ph_lo = 0; a.ph_hi = N_PHASES;
        hipLaunchKernelGGL(mk_fwd, dim3(grid), dim3(NTHR), LDS_BYTES, stream, a);
    } else {
        for (int p = 0; p < N_PHASES; ++p) { a.ph_lo = p; a.ph_hi = p + 1; hipLaunchKernelGGL(mk_fwd, dim3(grid), dim3(NTHR), LDS_BYTES, stream, a); }
    }
}
```

```cpp
#include <hip/hip_runtime.h>
#include <cstdio>
#include <cstdint>

#define LAS __attribute__((address_space(3)))
#define GAS __attribute__((address_space(1)))
typedef _Float16 h16;
typedef _Float16 h16x8 __attribute__((ext_vector_type(8)));
typedef _Float16 h16x4 __attribute__((ext_vector_type(4)));
typedef _Float16 h16x2 __attribute__((ext_vector_type(2)));
typedef float f32x2 __attribute__((ext_vector_type(2)));
typedef float f32x4 __attribute__((ext_vector_type(4)));
typedef float f32x16 __attribute__((ext_vector_type(16)));
typedef unsigned u32x4 __attribute__((ext_vector_type(4)));
typedef unsigned u32x2 __attribute__((ext_vector_type(2)));
typedef short v4i16_t __attribute__((ext_vector_type(4)));

constexpr int DM = 2048, NBATCH = 2, SEQ = 4096, CTXL = 256;
constexpr int MLAT = NBATCH * SEQ, MCTX = NBATCH * CTXL, MALL = MLAT + MCTX;
constexpr int IN_COLS = 13312, KV_COLS = 5120;
constexpr int C_RK = 0, C_RV = 1024, C_DK = 3072, C_DV = 4096, C_RQ = 5120, C_RG = 6144, C_DQ = 8192, C_GR = 9216, C_GD = 11264;
constexpr int NEXP = 256, TOPK = 8, DEXP = 256;
constexpr float EPS = 1e-6f;
constexpr int NWAVES = 8, NTHR = 512;

constexpr size_t MiB = 1u << 20;
constexpr size_t WS_CTL = 0, CTL_ZERO_BYTES = 1 * MiB;
constexpr size_t WS_MODP = 1 * MiB;
constexpr size_t WS_MOD = 3 * MiB;
constexpr size_t WS_ROPE = 3 * MiB + 512 * 1024;
constexpr size_t WS_WINT = 4 * MiB;
constexpr size_t WS_WRET = 56 * MiB;
constexpr size_t WS_WDIF = 64 * MiB;
constexpr size_t WS_WOUT = 68 * MiB;
constexpr size_t WS_WSGU = 76 * MiB;
constexpr size_t WS_WSDN = 78 * MiB;
constexpr size_t WS_WRTR = 79 * MiB;
constexpr size_t WS_H = 82 * MiB;
constexpr size_t WS_P = 116 * MiB;
constexpr size_t WS_LST = 340 * MiB;
constexpr size_t WS_SST = 408 * MiB;
constexpr size_t WS_ARET = 472 * MiB;
constexpr size_t WS_ADIF = 504 * MiB;
constexpr size_t WS_T = 520 * MiB;
constexpr size_t WS_U = 584 * MiB;
constexpr size_t WS_X1 = 616 * MiB;
constexpr size_t WS_H2X = 680 * MiB;
constexpr size_t WS_LG = 776 * MiB;
constexpr size_t WS_EIDX = 784 * MiB;
constexpr size_t WS_EW = 785 * MiB;
constexpr size_t WS_LIST = 786 * MiB;
constexpr size_t WS_ACTS = 794 * MiB;
constexpr size_t WS_YSH = 798 * MiB;
constexpr size_t WS_Y = 830 * MiB;
constexpr size_t WS_ACT = 1086 * MiB;
constexpr size_t WS_LGP = 1118 * MiB;
constexpr size_t WS_SGP = 1182 * MiB;
constexpr size_t WS_ACAT = 1246 * MiB;
constexpr size_t WS_WCAT = 1294 * MiB;
constexpr size_t WS_LIST2 = 1306 * MiB;
constexpr size_t WS_H2F8 = 1322 * MiB;
constexpr size_t WS_END = 1338 * MiB;

constexpr int CW_BAR = 4096;
constexpr int CW_CNT = 16384;
constexpr int CW_Q = 20480;

constexpr int RING_BYTES = 131072;
constexpr int LDS_BYTES = 163840;
constexpr int LDSCTL_OFF = LDS_BYTES - 512;
constexpr int LDS_TICKET = 146432;

#define XB_TMO      128
#define XB_XCNT(j)  (256  + 64 * (j))
#define XB_XSUB(j)  (1280 + 64 * (j))
#define XB_XGEN(j)  (2304 + 64 * (j))
#define XB_TOP      3328
#define XB_TOPGEN   3392
#define XCD_BAR_WORDS 3456
#define XB_SPIN_CAP (1u << 18)

__device__ __forceinline__ unsigned xb_ld(unsigned* p)              { return __hip_atomic_load(p, __ATOMIC_RELAXED, __HIP_MEMORY_SCOPE_AGENT); }
__device__ __forceinline__ unsigned xb_add(unsigned* p, unsigned v) { return __hip_atomic_fetch_add(p, v, __ATOMIC_RELAXED, __HIP_MEMORY_SCOPE_AGENT); }
__device__ __forceinline__ unsigned xb_xcc_id() { return (unsigned)__builtin_amdgcn_s_getreg((3 << 11) | 20) & 0xFu; }
#define XB_SPIN(cond, bar) do { unsigned _sp = 0; while (cond) { __builtin_amdgcn_s_sleep(1); \
    if ((++_sp & 255u) == 0u) { if (xb_ld(&(bar)[XB_TMO])) break; if (_sp > XB_SPIN_CAP) { atomicAdd(&(bar)[XB_TMO], 1u); break; } } } } while (0)

struct XcdBarrier { unsigned* bar; unsigned x; volatile LAS unsigned* st; };

__device__ __forceinline__ XcdBarrier xcd_barrier_post(unsigned* bar, volatile LAS unsigned* st) {
    XcdBarrier b; b.bar = bar; b.x = xb_xcc_id(); b.st = st;
    if (threadIdx.x == 0) (void)xb_add(&bar[XB_XCNT(b.x)], 1u);
    return b;
}
__device__ __forceinline__ void xcd_barrier_complete(unsigned* bar, unsigned x, unsigned& nloc, unsigned& nx) {
    const unsigned G = gridDim.x * gridDim.y * gridDim.z;
    unsigned sum, cnt, mine, sp = 0u;
    for (;;) {
        sum = 0u; cnt = 0u; mine = 0u;
#pragma unroll
        for (unsigned j = 0; j < 16; ++j) { const unsigned c = xb_ld(&bar[XB_XCNT(j)]); sum += c; cnt += (c > 0u) ? 1u : 0u; mine = (j == x) ? c : mine; }
        if (sum == G) break;
        __builtin_amdgcn_s_sleep(1);
        if ((++sp & 255u) == 0u) { if (xb_ld(&bar[XB_TMO])) break; if (sp > XB_SPIN_CAP) { atomicAdd(&bar[XB_TMO], 1u); break; } }
    }
    nloc = mine > 0u ? mine : 1u; nx = cnt > 0u ? cnt : 1u;
}
__device__ __forceinline__ void xcd_barrier(const XcdBarrier& b) {
    asm volatile("s_waitcnt vmcnt(0)" ::: "memory");
    __syncthreads();
    if (threadIdx.x == 0) {
        unsigned* bar = b.bar;
        __builtin_amdgcn_s_waitcnt(0);
        unsigned nloc = b.st[0], nx = b.st[1];
        if (nloc == 0u) { xcd_barrier_complete(bar, b.x, nloc, nx); b.st[0] = nloc; b.st[1] = nx; }
        const unsigned old = xb_add(&bar[XB_XSUB(b.x)], 1u);
        const unsigned gen = old / nloc;
        if (old + 1u == (gen + 1u) * nloc) {
            __builtin_amdgcn_fence(__ATOMIC_RELEASE, "agent");
            asm volatile("s_waitcnt vmcnt(0)" ::: "memory");
            const unsigned og = xb_add(&bar[XB_TOP], 1u);
            const unsigned tg = og / nx;
            if (og + 1u == (tg + 1u) * nx) xb_add(&bar[XB_TOPGEN], 1u);
            else XB_SPIN(xb_ld(&bar[XB_TOPGEN]) == tg, bar);
            __builtin_amdgcn_fence(__ATOMIC_ACQUIRE, "agent");
            xb_add(&bar[XB_XGEN(b.x)], 1u);
            asm volatile("s_waitcnt vmcnt(0)" ::: "memory");
        } else {
            XB_SPIN(xb_ld(&bar[XB_XGEN(b.x)]) == gen, bar);
            __builtin_amdgcn_fence(__ATOMIC_ACQUIRE, "agent");
            asm volatile("s_waitcnt vmcnt(0)" ::: "memory");
        }
    }
    __syncthreads();
}


namespace pg8 {
constexpr int BM = 256, BK = 64, HALF = 128, HTB = HALF * BK * 2, STAGE_BYTES = 8 * HTB, NXCD = 8, WGM = 8;
__host__ __device__ __forceinline__ int lds_byte(int r, int c) { const int st = (r >> 4) * 2 + (c >> 5), rr = r & 15, cc = c & 31, ob = rr * 64 + cc * 2; return st * 1024 + (ob ^ (((ob >> 9) & 1) << 5)); }
__host__ __device__ __forceinline__ void stage_rc(int b, int& R, int& C) { const int st = b / 1024, sb = b % 1024, swz = sb ^ (((sb >> 9) & 1) << 5); R = (st >> 1) * 16 + swz / 64; C = (st & 1) * 32 + (swz % 64) / 2; }
struct Unit { int pm, pn, ko, nt, keep; };
struct Gemm { const h16* A; const h16* Bt; int lda, ldb, K; };
struct StaticOrder {
    int nM, nN, nwg, G, c;
    __host__ __device__ void init(int M, int N, int G_, int c_) { nM = M / BM; nN = N / BM; nwg = nM * nN; G = G_; c = c_; }
    __host__ __device__ bool next(int i, Unit& u) const {
        const long L = (long)i * G + c; if (L >= nwg) return false;
        int wgid = (int)L; { const int q = nwg / NXCD, r = nwg % NXCD, xcd = wgid % NXCD, off = wgid / NXCD; wgid = (xcd < r ? xcd * (q + 1) : r * (q + 1) + (xcd - r) * q) + off; }
        const int nig = WGM * nN, gid = wgid / nig, fm = gid * WGM, gsz = (nM - fm) < WGM ? (nM - fm) : WGM;
        u.pm = fm + ((wgid % nig) % gsz); u.pn = (wgid % nig) / gsz; u.ko = 0; u.nt = 0; u.keep = 0; return true;
    }
};
template <class Epi, class Sched, bool ALIGN_EPI = true>
__device__ __forceinline__ void gemm_phase(LAS unsigned char* lds, const Gemm g, const Sched& S, const Epi& E) {
    const int tid = threadIdx.x, wid = __builtin_amdgcn_readfirstlane(tid >> 6), lane = tid & 63, wr = wid >> 2, wc = wid & 3, fr = lane & 15, fq = lane >> 4;
    const int nt0 = g.K / BK;
    unsigned voffA[2], voffB[2];
#pragma unroll
    for (int i = 0; i < 2; ++i) { int R, C; stage_rc(tid * 16 + i * 8192, R, C); voffA[i] = (unsigned)(R * g.lda + C) * 2u; voffB[i] = (unsigned)(R * g.ldb + C) * 2u; }
    const size_t kstep = (size_t)(BK * 2);
    const size_t hstepA = (size_t)HALF * g.lda * 2, hstepB = (size_t)HALF * g.ldb * 2;
    const size_t tstepA = 2 * hstepA, tstepB = 2 * hstepB;
    const unsigned ldsw = (unsigned)wid * 1024u;
    const int aoff = lds_byte(wr * 64 + fr, fq * 8), boff = lds_byte(wc * 32 + fr, fq * 8);
#define PG8_SA(b, h) (((b) * 2 + (h)) * HTB)
#define PG8_SB(b, h) ((4 + (b) * 2 + (h)) * HTB)
#define PG8_STAGE(bufoff, gbase, voff) do { _Pragma("unroll") for (int _i = 0; _i < 2; ++_i) \
        __builtin_amdgcn_global_load_lds((const unsigned*)((const char*)(gbase) + (voff)[_i]), (LAS unsigned*)(lds + (bufoff) + ldsw + _i * 8192), 16, 0, 0); } while (0)
#define PG8_LDA(dst, b, h) do { _Pragma("unroll") for (int m = 0; m < 4; ++m) _Pragma("unroll") for (int k = 0; k < 2; ++k) dst[m][k] = *(const LAS h16x8*)(lds + PG8_SA(b, h) + aoff + m * 2048 + k * 1024); } while (0)
#define PG8_LDB(dst, b, h) do { _Pragma("unroll") for (int n = 0; n < 2; ++n) _Pragma("unroll") for (int k = 0; k < 2; ++k) dst[n][k] = *(const LAS h16x8*)(lds + PG8_SB(b, h) + boff + n * 2048 + k * 1024); } while (0)
#define PG8_MMA(ai, bj, At, Bt) do { __builtin_amdgcn_s_setprio(1); _Pragma("unroll") for (int m = 0; m < 4; ++m) _Pragma("unroll") for (int n = 0; n < 2; ++n) _Pragma("unroll") for (int k = 0; k < 2; ++k) \
        acc[ai][bj][m][n] = __builtin_amdgcn_mfma_f32_16x16x32_f16(Bt[n][k], At[m][k], acc[ai][bj][m][n], 0, 0, 0); __builtin_amdgcn_s_setprio(0); } while (0)
#define PG8_WAIT_V(n) asm volatile("s_waitcnt vmcnt(" #n ")" ::: "memory")
#define PG8_WAIT_L(n) asm volatile("s_waitcnt lgkmcnt(" #n ")" ::: "memory")
#define PG8_BAR __builtin_amdgcn_s_barrier()
#define PG8_SCHED __builtin_amdgcn_sched_barrier(0)
    Unit cur, nxt; int ui = 0;
    if (!S.next(0, cur)) return;
    f32x4 acc[2][2][4][2];
#pragma unroll
    for (int a = 0; a < 2; ++a)
#pragma unroll
        for (int b = 0; b < 2; ++b)
#pragma unroll
            for (int m = 0; m < 4; ++m)
#pragma unroll
                for (int n = 0; n < 2; ++n) acc[a][b][m][n] = (f32x4){0.f, 0.f, 0.f, 0.f};
    h16x8 At[4][2], B0[2][2], B1[2][2];
    const char* cA = (const char*)g.A + (size_t)cur.pm * tstepA + (size_t)cur.ko * 2; const char* cB = (const char*)g.Bt + (size_t)cur.pn * tstepB + (size_t)cur.ko * 2;
    {
        PG8_STAGE(PG8_SB(0, 0), cB, voffB); PG8_STAGE(PG8_SB(0, 1), cB + hstepB, voffB); PG8_STAGE(PG8_SA(0, 0), cA, voffA); PG8_STAGE(PG8_SA(0, 1), cA + hstepA, voffA);
        if (wr == 1) PG8_BAR;
        PG8_WAIT_V(2); PG8_BAR;
        PG8_STAGE(PG8_SB(1, 0), cB + kstep, voffB); PG8_STAGE(PG8_SA(1, 0), cA + kstep, voffA); PG8_STAGE(PG8_SB(1, 1), cB + hstepB + kstep, voffB);
        PG8_WAIT_V(6); PG8_BAR;
    }
    for (;;) {
        const bool has_next = S.next(ui + 1, nxt);
        const char* nA = has_next ? (const char*)g.A + (size_t)nxt.pm * tstepA + (size_t)nxt.ko * 2 : cA; const char* nB = has_next ? (const char*)g.Bt + (size_t)nxt.pn * tstepB + (size_t)nxt.ko * 2 : cB;
        int nt = cur.nt ? cur.nt : nt0; asm volatile("" : "+s"(nt));
        for (int t = 0; t < nt; t += 2) {
            const bool last = (t == nt - 2);
            const char* a1 = cA + (size_t)(t + 1) * kstep;
            const char* a2 = last ? nA : cA + (size_t)(t + 2) * kstep; const char* b2 = last ? nB : cB + (size_t)(t + 2) * kstep;
            const char* a3 = a2 + kstep; const char* b3 = b2 + kstep;
            PG8_LDB(B0, 0, 0); PG8_LDB(B1, 0, 1); PG8_SCHED; PG8_LDA(At, 0, 0); PG8_STAGE(PG8_SA(1, 1), a1 + hstepA, voffA);
            PG8_WAIT_V(8); PG8_WAIT_L(0); PG8_BAR; PG8_MMA(0, 0, At, B0); PG8_MMA(0, 1, At, B1); PG8_BAR; PG8_SCHED;
            PG8_LDA(At, 0, 1); PG8_STAGE(PG8_SB(0, 0), b2, voffB); PG8_STAGE(PG8_SB(0, 1), b2 + hstepB, voffB); PG8_STAGE(PG8_SA(0, 0), a2, voffA);
            PG8_WAIT_V(8); PG8_WAIT_L(0); PG8_BAR; PG8_MMA(1, 0, At, B0); PG8_MMA(1, 1, At, B1); PG8_BAR; PG8_SCHED;
            PG8_LDB(B0, 1, 0); PG8_LDB(B1, 1, 1); PG8_SCHED; PG8_LDA(At, 1, 0); PG8_STAGE(PG8_SA(0, 1), a2 + hstepA, voffA);
            PG8_WAIT_V(8); PG8_WAIT_L(0); PG8_BAR; PG8_MMA(0, 0, At, B0); PG8_MMA(0, 1, At, B1); PG8_BAR; PG8_SCHED;
            PG8_LDA(At, 1, 1); PG8_STAGE(PG8_SB(1, 0), b3, voffB); PG8_STAGE(PG8_SB(1, 1), b3 + hstepB, voffB); PG8_STAGE(PG8_SA(1, 0), a3, voffA);
            PG8_WAIT_V(8); PG8_WAIT_L(0); PG8_BAR; PG8_MMA(1, 0, At, B0); PG8_MMA(1, 1, At, B1); PG8_BAR; PG8_SCHED;
        }
        if constexpr (ALIGN_EPI) { if (wr == 0) PG8_BAR; }
        E(acc, cur, wr, wc, fr, fq);
        if (!has_next) break;
        if (!cur.keep) {
#pragma unroll
        for (int a = 0; a < 2; ++a)
#pragma unroll
            for (int b = 0; b < 2; ++b)
#pragma unroll
                for (int m = 0; m < 4; ++m)
#pragma unroll
                    for (int n = 0; n < 2; ++n) acc[a][b][m][n] = (f32x4){0.f, 0.f, 0.f, 0.f};
        }
        cur = nxt; cA = nA; cB = nB; ++ui;
        if constexpr (ALIGN_EPI) { if (wr == 1) PG8_BAR; }
    }
    PG8_WAIT_V(0);
    if constexpr (!ALIGN_EPI) { if (wr == 0) PG8_BAR; }
    PG8_BAR;
#undef PG8_SA
#undef PG8_SB
#undef PG8_STAGE
#undef PG8_LDA
#undef PG8_LDB
#undef PG8_MMA
#undef PG8_WAIT_V
#undef PG8_WAIT_L
#undef PG8_BAR
#undef PG8_SCHED
}
}

struct Frame {
    LAS unsigned char* lds;
    int tid, lane, wave, vcu, G;
    const float *x, *c, *ctx, *c_ctx, *w_mod, *b_mod, *norm_attn, *norm_ffn, *w_in, *ret_decay, *diff_lambda, *diff_subln,
                *w_ret_o, *w_diff_o, *w_out, *w_router, *router_bias, *w_exp_gu, *w_exp_down, *w_sh_gu, *w_sh_down, *final_norm;
    float* out;
    unsigned char* ws;
};

__device__ __forceinline__ float wave_sum(float v) {
#pragma unroll
    for (int o = 1; o < 64; o <<= 1) v += __shfl_xor(v, o);
    return v;
}
__device__ __forceinline__ unsigned pk2h(float lo, float hi) { f32x2 v = {lo, hi}; h16x2 h = __builtin_convertvector(v, h16x2); return __builtin_bit_cast(unsigned, h); }
__device__ __forceinline__ float silu_f(float v) { return v / (1.0f + __expf(-v)); }
__device__ __forceinline__ float sigmoid_f(float v) { return 1.0f / (1.0f + __expf(-v)); }

__device__ __forceinline__ void p0_mod_unit(Frame& F, int unit) {
    const int cb = unit % 24, ks = unit / 24;
    LAS float* sv = (LAS float*)F.lds;
    LAS float* red = sv + 768;
    for (int i = F.tid; i < 768; i += NTHR) { const int v = i >> 8, k = i & 255; const float cv = (v < 2) ? F.c[v * DM + ks * 256 + k] : F.c_ctx[ks * 256 + k]; sv[i] = silu_f(cv); }
    __syncthreads();
    const int cl = F.tid & 127, rl = F.tid >> 7;
    const float* wp = F.w_mod + (size_t)(ks * 256 + rl) * (6 * DM) + cb * 512 + cl * 4;
    f32x4 a0 = {0.f, 0.f, 0.f, 0.f}, a1 = a0, a2 = a0;
#pragma unroll 8
    for (int i = 0; i < 64; ++i) { const f32x4 w = *(const f32x4*)(wp + (size_t)i * 4 * (6 * DM)); const int k = rl + 4 * i; a0 += w * sv[k]; a1 += w * sv[256 + k]; a2 += w * sv[512 + k]; }
    *(LAS f32x4*)(red + (rl * 3 + 0) * 512 + cl * 4) = a0; *(LAS f32x4*)(red + (rl * 3 + 1) * 512 + cl * 4) = a1; *(LAS f32x4*)(red + (rl * 3 + 2) * 512 + cl * 4) = a2;
    __syncthreads();
    float* modp = (float*)(F.ws + WS_MODP);
    for (int i = F.tid; i < 1536; i += NTHR) { const int v = i >> 9, cc = i & 511; const float s = (red[(0 * 3 + v) * 512 + cc] + red[(1 * 3 + v) * 512 + cc]) + (red[(2 * 3 + v) * 512 + cc] + red[(3 * 3 + v) * 512 + cc]);
        modp[(size_t)(ks * 3 + v) * (6 * DM) + cb * 512 + cc] = s; }
    __syncthreads();
}
template <int MAP>
__device__ __forceinline__ void p0_transpose_item(const float* W, int K, int N, h16* WT, LAS float* scr, int item, int lane, int ldd = 0) {
    if (ldd == 0) ldd = K;
    const int nblk = N / 32, kb = item / nblk, nb = item % nblk, k0 = 64 * kb, n0 = 32 * nb;
#pragma unroll 8
    for (int i = 0; i < 32; ++i) { const int kk = 2 * i + (lane >> 5); scr[kk * 33 + (lane & 31)] = W[(size_t)(k0 + kk) * N + n0 + (lane & 31)]; }
    asm volatile("s_waitcnt lgkmcnt(0)" ::: "memory");
    const int cch = lane & 7;
#pragma unroll
    for (int j = 0; j < 4; ++j) { const int n = (lane >> 3) + 8 * j; const LAS float* s = scr + (8 * cch) * 33 + n;
        u32x4 o; o.x = pk2h(s[0 * 33], s[1 * 33]); o.y = pk2h(s[2 * 33], s[3 * 33]); o.z = pk2h(s[4 * 33], s[5 * 33]); o.w = pk2h(s[6 * 33], s[7 * 33]);
        int nn = n0 + n;
        if (MAP == 1) { const bool isrope = (nn < 1024) || (nn >= C_RQ && nn < C_RQ + 1024); if (isrope) nn = (nn & ~48) | ((nn & 16) << 1) | ((nn & 32) >> 1); }
        if (MAP == 2) { const int j = nn & 255, isu = nn >> 8; nn = 32 * (j >> 4) + 16 * isu + (j & 15); }
        *(u32x4*)(WT + (size_t)nn * ldd + k0 + 8 * cch) = o; }
    asm volatile("s_waitcnt lgkmcnt(0)" ::: "memory");
}
__device__ __forceinline__ void p0a_mod(Frame& F) {
    for (int u = F.vcu; u < 192; u += F.G) p0_mod_unit(F, u);
}
__device__ __forceinline__ void p0b_weights(Frame& F) {
    __syncthreads();
    LAS float* scr = (LAS float*)(F.lds + F.wave * 16384);
    const int gw = F.vcu * NWAVES + F.wave, NGW = F.G * NWAVES;
    constexpr int I_IN = (DM / 64) * (IN_COLS / 32);
    for (int it = gw; it < I_IN; it += NGW) p0_transpose_item<1>(F.w_in, DM, IN_COLS, (h16*)(F.ws + WS_WINT), scr, it, F.lane);
    if (blockIdx.x == 0) {
        float* rope = (float*)(F.ws + WS_ROPE);
        for (int i = F.tid; i < 64 * 32; i += NTHR) { const int pos = i >> 5, j = i & 31; const float inv = exp2f(-(float)j * (13.287712379549449f / 32.0f)); const float ang = (float)pos * inv; rope[i] = cosf(ang); rope[2048 + i] = sinf(ang); }
        for (int i = F.tid; i < 64 * 16; i += NTHR) { const int pos = i >> 4, j = i & 15; const float inv = exp2f(-(float)j * (13.287712379549449f / 16.0f)); const float ang = (float)pos * inv; rope[4096 + i] = cosf(ang); rope[4096 + 1024 + i] = sinf(ang); }
    }
}
__device__ __forceinline__ void p0c_weights_dyn(Frame& F, int qid) {
    unsigned* QH = (unsigned*)(F.ws + WS_CTL) + CW_Q + 64 * 8 * qid;
    LAS int* RED = (LAS int*)(F.lds + LDS_TICKET);
    LAS float* scr = (LAS float*)(F.lds + F.wave * 16384);
    constexpr int I_RET = (2048 / 64) * (DM / 32), I_DIF = (1024 / 64) * (DM / 32), I_OUT = (DM / 64) * (DM / 32), I_SGU = (DM / 64) * (512 / 32), I_SDN = (256 / 64) * (DM / 32), I_RT = NEXP * DM / 4 / 64;
    constexpr int NITEMS = I_RET + I_DIF + I_OUT + I_SGU + I_SDN + I_RT, NTICK = (NITEMS + 7) / 8;
    for (;;) {
        __syncthreads();
        if (F.tid == 0) RED[0] = (int)__hip_atomic_fetch_add(QH, 1u, __ATOMIC_RELAXED, __HIP_MEMORY_SCOPE_AGENT);
        __syncthreads();
        const int t = RED[0];
        if (t >= NTICK) break;
        int r = t * 8 + F.wave;
        if (r >= NITEMS) continue;
        if (r < I_RET) { p0_transpose_item<0>(F.w_ret_o, 2048, DM, (h16*)(F.ws + WS_WCAT), scr, r, F.lane, 3072); continue; } r -= I_RET;
        if (r < I_DIF) { p0_transpose_item<0>(F.w_diff_o, 1024, DM, (h16*)(F.ws + WS_WCAT) + 2048, scr, r, F.lane, 3072); continue; } r -= I_DIF;
        if (r < I_OUT) { p0_transpose_item<0>(F.w_out, DM, DM, (h16*)(F.ws + WS_WOUT), scr, r, F.lane); continue; } r -= I_OUT;
        if (r < I_SGU) { p0_transpose_item<2>(F.w_sh_gu, DM, 512, (h16*)(F.ws + WS_WSGU), scr, r, F.lane); continue; } r -= I_SGU;
        if (r < I_SDN) { p0_transpose_item<0>(F.w_sh_down, 256, DM, (h16*)(F.ws + WS_WSDN), scr, r, F.lane); continue; } r -= I_SDN;
        {
            const int q = r * 64 + F.lane, e = q / (DM / 4), k = (q % (DM / 4)) * 4;
            const f32x4 w = *(const f32x4*)(F.w_router + (size_t)e * DM + k);
            h16 hi[4], lo[4];
#pragma unroll
            for (int j = 0; j < 4; ++j) { hi[j] = (h16)w[j]; lo[j] = (h16)(w[j] - (float)hi[j]); }
            h16* dst = (h16*)(F.ws + WS_WRTR) + (size_t)e * 6144 + k;
            *(h16x4*)(dst) = (h16x4){hi[0], hi[1], hi[2], hi[3]}; *(h16x4*)(dst + 2048) = (h16x4){hi[0], hi[1], hi[2], hi[3]}; *(h16x4*)(dst + 4096) = (h16x4){lo[0], lo[1], lo[2], lo[3]};
        }
    }
}

__device__ __forceinline__ void p1_norm1(Frame& F) {
    LAS float* msh = (LAS float*)F.lds; LAS float* msc = msh + 3 * DM;
    const float* modp = (const float*)(F.ws + WS_MODP);
    for (int i = F.tid; i < 3 * 2 * DM; i += NTHR) { const int v = i / (2 * DM), cc = i % (2 * DM); float s = F.b_mod[cc];
#pragma unroll
        for (int ks = 0; ks < 8; ++ks) s += modp[(size_t)(ks * 3 + v) * (6 * DM) + cc];
        if (cc < DM) msh[v * DM + cc] = s; else msc[v * DM + cc - DM] = s; }
    __syncthreads();
    const int gw = F.vcu * NWAVES + F.wave, NGW = F.G * NWAVES;
    h16* H = (h16*)(F.ws + WS_H);
    for (int r = gw; r < MALL; r += NGW) {
        const float* src = (r < MLAT) ? F.x + (size_t)r * DM : F.ctx + (size_t)(r - MLAT) * DM; const int v = (r < MLAT) ? (r / SEQ) : 2;
        f32x4 xv[8]; float ss = 0.f;
#pragma unroll
        for (int j = 0; j < 8; ++j) { xv[j] = *(const f32x4*)(src + 4 * F.lane + 256 * j); ss += (xv[j].x * xv[j].x + xv[j].y * xv[j].y) + (xv[j].z * xv[j].z + xv[j].w * xv[j].w); }
        const float rstd = 1.0f / sqrtf(wave_sum(ss) * (1.0f / DM) + EPS);
#pragma unroll
        for (int j = 0; j < 8; ++j) { const int cc = 4 * F.lane + 256 * j; const f32x4 nw = *(const f32x4*)(F.norm_attn + cc);
            const f32x4 sc = *(LAS f32x4*)(msc + v * DM + cc), sh = *(LAS f32x4*)(msh + v * DM + cc);
            const f32x4 y = xv[j] * rstd * nw * (sc + 1.0f) + sh;
            u32x2 o; o.x = pk2h(y.x, y.y); o.y = pk2h(y.z, y.w); *(u32x2*)(H + (size_t)r * DM + cc) = o; }
    }
    float* MOD = (float*)(F.ws + WS_MOD);
    for (int i = blockIdx.x * NTHR + F.tid; i < 3 * 6 * DM; i += F.G * NTHR) { const int v = i / (6 * DM), cc = i % (6 * DM); float s = F.b_mod[cc];
#pragma unroll
        for (int ks = 0; ks < 8; ++ks) s += modp[(size_t)(ks * 3 + v) * (6 * DM) + cc];
        MOD[i] = s; }
}


__device__ __forceinline__ int crow(int r, int hi) { return (r & 3) + 8 * (r >> 2) + 4 * hi; }
__device__ __forceinline__ h16x8 frag_row(const LAS unsigned char* base, int strideB, int r0, int k0, int lane) {
    return *(const LAS h16x8*)(base + (r0 + (lane & 31)) * strideB + (k0 + 8 * (lane >> 5)) * 2);
}
__device__ __forceinline__ v4i16_t tr16(const LAS unsigned char* p) { return __builtin_amdgcn_ds_read_tr16_b64_v4i16((LAS v4i16_t*)p); }
__device__ __forceinline__ h16x8 frag_tr(const LAS unsigned char* base, int strideB, int k0, int n0, int lane) {
    const int kb = k0 + 8 * (lane >> 5) + ((lane & 15) >> 2), nc = n0 + 16 * ((lane >> 4) & 1) + 4 * (lane & 3);
    const LAS unsigned char* p = base + kb * strideB + nc * 2;
    const v4i16_t lo = tr16(p), hi = tr16(p + 4 * strideB);
    typedef short s16x8 __attribute__((ext_vector_type(8)));
    const s16x8 v = {lo[0], lo[1], lo[2], lo[3], hi[0], hi[1], hi[2], hi[3]};
    return __builtin_bit_cast(h16x8, v);
}
__device__ __forceinline__ h16x8 frag_tr_perm(const LAS unsigned char* base, int strideB, int k0, int n0, int lane) {
    const int kb = k0 + 4 * (lane >> 5) + ((lane & 15) >> 2), nc = n0 + 16 * ((lane >> 4) & 1) + 4 * (lane & 3);
    const LAS unsigned char* p = base + kb * strideB + nc * 2;
    const v4i16_t lo = tr16(p), hi = tr16(p + 8 * strideB);
    typedef short s16x8 __attribute__((ext_vector_type(8)));
    const s16x8 v = {lo[0], lo[1], lo[2], lo[3], hi[0], hi[1], hi[2], hi[3]};
    return __builtin_bit_cast(h16x8, v);
}
__device__ __forceinline__ h16x8 pack8(float a0, float a1, float a2, float a3, float a4, float a5, float a6, float a7) {
    u32x4 w; w.x = pk2h(a0, a1); w.y = pk2h(a2, a3); w.z = pk2h(a4, a5); w.w = pk2h(a6, a7); return __builtin_bit_cast(h16x8, w);
}
#define MFMA32(a, b, c) __builtin_amdgcn_mfma_f32_32x32x16_f16((a), (b), (c), 0, 0, 0)

struct SchedG1 {
    pg8::StaticOrder so; int G, c;
    __device__ __forceinline__ bool next(int i, pg8::Unit& u) const {
        const int L = i * G + c;
        if (L < 32 * 52) return so.next(i, u);
        const int r = L - 32 * 52; if (r >= 40) return false;
        u.pm = 32 + r / 20; u.pn = r % 20; u.ko = 0; u.nt = 0; u.keep = 0; return true;
    }
};
struct EpiP {
    h16* P; const float* rope;
    __device__ __forceinline__ void operator()(f32x4 (&acc)[2][2][4][2], const pg8::Unit& u, int wr, int wc, int fr, int fq) const {
        const int colt = u.pn * 256; const bool lat = u.pm < 32;
        int kind;
        if (colt < C_RV) kind = 1; else if (colt < C_DK) kind = 0; else if (colt < C_DV) kind = 3; else if (colt < C_RQ) kind = 0; else if (colt < C_RG) kind = 2; else if (colt < C_DQ) kind = 5; else if (colt < C_GR) kind = 4; else kind = 6;
        if (!lat) kind = (kind == 1) ? 7 : 0;
#pragma unroll
        for (int ai = 0; ai < 2; ++ai)
#pragma unroll
            for (int m = 0; m < 4; ++m) {
                const int row = u.pm * 256 + ai * 128 + wr * 64 + m * 16 + fr; const int t = row & (SEQ - 1);
                h16* prow = P + (size_t)row * IN_COLS;
#pragma unroll
                for (int bj = 0; bj < 2; ++bj) {
                    const int cbase = colt + bj * 128 + wc * 32;
                    const f32x4 x0 = acc[ai][bj][m][0], x1 = acc[ai][bj][m][1];
                    f32x4 o0, o1; int c0, c1;
                    if (kind == 1 || kind == 2) {
                        const int g5 = (cbase >> 5) & 1, axis = (cbase >> 6) & 1, pos = axis ? (t & 63) : (t >> 6), j0 = 16 * g5 + 4 * fq;
                        const f32x4 cs = *(const f32x4*)(rope + pos * 32 + j0), sn = *(const f32x4*)(rope + 2048 + pos * 32 + j0);
                        o0 = x0 * cs - x1 * sn; o1 = x0 * sn + x1 * cs;
                        if (kind == 2) { o0 *= 0.08838834764831845f; o1 *= 0.08838834764831845f; }
                        c0 = (cbase & ~63) + j0; c1 = c0 + 32;
                    } else if (kind == 7) {
                        const int g5 = (cbase >> 5) & 1; c0 = (cbase & ~63) + 16 * g5 + 4 * fq; c1 = c0 + 32; o0 = x0; o1 = x1;
                    } else if (kind == 3 || kind == 4) {
                        const int axis = (cbase >> 5) & 1, pos = axis ? (t & 63) : (t >> 6), j0 = 4 * fq;
                        const f32x4 cs = *(const f32x4*)(rope + 4096 + pos * 16 + j0), sn = *(const f32x4*)(rope + 5120 + pos * 16 + j0);
                        o0 = x0 * cs - x1 * sn; o1 = x0 * sn + x1 * cs;
                        if (kind == 4) { o0 *= 0.18033688011112042f; o1 *= 0.18033688011112042f; }
                        c0 = cbase + j0; c1 = c0 + 16;
                    } else {
                        c0 = cbase + 4 * fq; c1 = c0 + 16; o0 = x0; o1 = x1;
                        if (kind == 5) {
#pragma unroll
                            for (int e = 0; e < 4; ++e) { o0[e] = silu_f(x0[e]); o1[e] = silu_f(x1[e]); }
                        } else if (kind == 6) {
#pragma unroll
                            for (int e = 0; e < 4; ++e) { o0[e] = sigmoid_f(x0[e]); o1[e] = sigmoid_f(x1[e]); }
                        }
                    }
                    u32x2 w0, w1; w0.x = pk2h(o0[0], o0[1]); w0.y = pk2h(o0[2], o0[3]); w1.x = pk2h(o1[0], o1[1]); w1.y = pk2h(o1[2], o1[3]);
                    *(u32x2*)(prow + c0) = w0; *(u32x2*)(prow + c1) = w1;
                }
            }
    }
};
__device__ __forceinline__ void p2_gemm1(Frame& F) {
    pg8::Gemm g{(const h16*)(F.ws + WS_H), (const h16*)(F.ws + WS_WINT), DM, DM, DM};
    SchedG1 S; S.so.init(MLAT, IN_COLS, F.G, (int)blockIdx.x); S.G = F.G; S.c = (int)blockIdx.x;
    EpiP E{(h16*)(F.ws + WS_P), (const float*)(F.ws + WS_ROPE)};
    pg8::gemm_phase<EpiP, SchedG1>(F.lds, g, S, E);
}

__device__ __forceinline__ void p3_ret_local(Frame& F) {
    LAS unsigned char* KF = F.lds; LAS unsigned char* KB = F.lds + 40960; LAS unsigned char* VH = F.lds + 81920;
    const h16* P = (const h16*)(F.ws + WS_P); h16* LST = (h16*)(F.ws + WS_LST);
    const int hi = F.lane >> 5;
    for (int u = F.vcu; u < 16 * 34; u += F.G) {
        const int bh = u / 34, cc = u % 34, b = bh >> 3, h = bh & 7;
        const int row0 = (cc < 2) ? (MLAT + b * CTXL + cc * 128) : (b * SEQ + (cc - 2) * 128);
        const float lgf = -__expf(F.ret_decay[h]), lgb = -__expf(F.ret_decay[8 + h]);
#pragma unroll
        for (int i = 0; i < 4; ++i) { const int q = F.tid + NTHR * i, row = q >> 4, ch = q & 15;
            const h16x8 kv = *(const h16x8*)(P + (size_t)(row0 + row) * IN_COLS + C_RK + h * 128 + ch * 8);
            const float sf = __expf(lgf * (float)(127 - row)), sb = __expf(lgb * (float)row);
            *(LAS h16x8*)(KF + row * 320 + ch * 16) = pack8((float)kv[0] * sf, (float)kv[1] * sf, (float)kv[2] * sf, (float)kv[3] * sf, (float)kv[4] * sf, (float)kv[5] * sf, (float)kv[6] * sf, (float)kv[7] * sf);
            *(LAS h16x8*)(KB + row * 320 + ch * 16) = pack8((float)kv[0] * sb, (float)kv[1] * sb, (float)kv[2] * sb, (float)kv[3] * sb, (float)kv[4] * sb, (float)kv[5] * sb, (float)kv[6] * sb, (float)kv[7] * sb); }
        for (int eh = 0; eh < 2; ++eh) {
            if (eh) __syncthreads();
#pragma unroll
            for (int i = 0; i < 4; ++i) { const int q = F.tid + NTHR * i, row = q >> 4, ch = q & 15;
                *(LAS h16x8*)(VH + row * 320 + ch * 16) = *(const h16x8*)(P + (size_t)(row0 + row) * IN_COLS + C_RV + h * 256 + eh * 128 + ch * 8); }
            __syncthreads();
            const int dir = F.wave >> 2, eb = F.wave & 3; const LAS unsigned char* Kd = dir ? KB : KF;
            f32x16 acc[4];
#pragma unroll
            for (int db = 0; db < 4; ++db) acc[db] = (f32x16){};
#pragma unroll
            for (int ks = 0; ks < 8; ++ks) { const h16x8 a = frag_tr(VH, 320, 16 * ks, 32 * eb, F.lane);
#pragma unroll
                for (int db = 0; db < 4; ++db) { const h16x8 bb = frag_tr(Kd, 320, 16 * ks, 32 * db, F.lane); acc[db] = MFMA32(a, bb, acc[db]); } }
            h16* dst = LST + ((size_t)((dir * 16 + bh) * 34 + cc) * 256 + eh * 128 + eb * 32) * 128;
#pragma unroll
            for (int db = 0; db < 4; ++db)
#pragma unroll
                for (int r = 0; r < 16; ++r) dst[crow(r, hi) * 128 + db * 32 + (F.lane & 31)] = (h16)acc[db][r];
        }
        __syncthreads();
    }
}
__device__ __forceinline__ void p4_ret_scan(Frame& F) {
    const h16* LST = (const h16*)(F.ws + WS_LST); h16* SST = (h16*)(F.ws + WS_SST);
    for (int g = blockIdx.x * NTHR + F.tid; g < 2 * 16 * 4096; g += F.G * NTHR) {
        const int seq = g >> 12, off = (g & 4095) * 8, dir = seq >> 4, bh = seq & 15, h = bh & 7;
        const float cd = __expf(-__expf(F.ret_decay[dir * 8 + h]) * 128.0f);
        const h16* Lp = LST + (size_t)seq * 34 * 32768 + off; h16* Sp = SST + (size_t)seq * 32 * 32768 + off;
        float s[8];
#pragma unroll
        for (int e = 0; e < 8; ++e) s[e] = 0.f;
        if (dir == 0) {
            for (int cc = 0; cc < 33; ++cc) {
                if (cc >= 2) *(h16x8*)(Sp + (size_t)(cc - 2) * 32768) = pack8(s[0], s[1], s[2], s[3], s[4], s[5], s[6], s[7]);
                const h16x8 l = *(const h16x8*)(Lp + (size_t)cc * 32768);
#pragma unroll
                for (int e = 0; e < 8; ++e) s[e] = s[e] * cd + (float)l[e];
            }
            *(h16x8*)(Sp + (size_t)31 * 32768) = pack8(s[0], s[1], s[2], s[3], s[4], s[5], s[6], s[7]);
        } else {
            { const h16x8 l1 = *(const h16x8*)(Lp + (size_t)1 * 32768), l0 = *(const h16x8*)(Lp);
#pragma unroll
              for (int e = 0; e < 8; ++e) s[e] = (float)l1[e] * cd + (float)l0[e]; }
            for (int c = 31; c >= 0; --c) {
                *(h16x8*)(Sp + (size_t)c * 32768) = pack8(s[0], s[1], s[2], s[3], s[4], s[5], s[6], s[7]);
                const h16x8 l = *(const h16x8*)(Lp + (size_t)(c + 2) * 32768);
#pragma unroll
                for (int e = 0; e < 8; ++e) s[e] = s[e] * cd + (float)l[e];
            }
        }
    }
}
__device__ __forceinline__ void p5_ret_out(Frame& F) {
    LAS unsigned char* QL = F.lds; LAS unsigned char* KL = F.lds + 34816; LAS unsigned char* PL = KL; LAS unsigned char* VL = F.lds + 69632;
    LAS float* RED = (LAS float*)(F.lds + 69632 + 73728);
    const h16* P = (const h16*)(F.ws + WS_P); const h16* SST = (const h16*)(F.ws + WS_SST); h16* ARET = (h16*)(F.ws + WS_ACAT);
    const int hi = F.lane >> 5, ln = F.lane & 31, w = F.wave;
    for (int u = F.vcu; u < 512; u += F.G) {
        const int bh = u >> 5, c = u & 31, b = bh >> 3, h = bh & 7, row0 = b * SEQ + c * 128;
        const float lgf = -__expf(F.ret_decay[h]), lgb = -__expf(F.ret_decay[8 + h]);
#pragma unroll
        for (int i = 0; i < 4; ++i) { const int q = F.tid + NTHR * i, row = q >> 4, ch = q & 15; const h16* pr = P + (size_t)(row0 + row) * IN_COLS + h * 128 + ch * 8;
            *(LAS h16x8*)(QL + row * 272 + ch * 16) = *(const h16x8*)(pr + C_RQ); *(LAS h16x8*)(KL + row * 272 + ch * 16) = *(const h16x8*)(pr + C_RK); }
        h16x8 vreg[8];
#pragma unroll
        for (int i = 0; i < 8; ++i) { const int q = F.tid + NTHR * i, row = q >> 5, c32 = q & 31; vreg[i] = *(const h16x8*)(P + (size_t)(row0 + row) * IN_COLS + C_RV + h * 256 + c32 * 8); }
        __syncthreads();
        u32x2 pw[2][4];
        { const int jt = w >> 1;
#pragma unroll
          for (int t2 = 0; t2 < 2; ++t2) { const int ib = 2 * (w & 1) + t2, il = 32 * ib + ln; f32x16 s = (f32x16){};
#pragma unroll
            for (int ks = 0; ks < 8; ++ks) s = MFMA32(frag_row(KL, 272, 32 * jt, 16 * ks, F.lane), frag_row(QL, 272, 32 * ib, 16 * ks, F.lane), s);
#pragma unroll
            for (int r = 0; r < 16; ++r) { const int d = il - (32 * jt + crow(r, hi)); s[r] *= (d >= 0) ? __expf(lgf * (float)d) : __expf(lgb * (float)(-d)); }
#pragma unroll
            for (int r4 = 0; r4 < 4; ++r4) { pw[t2][r4].x = pk2h(s[4 * r4], s[4 * r4 + 1]); pw[t2][r4].y = pk2h(s[4 * r4 + 2], s[4 * r4 + 3]); } } }
        __syncthreads();
        { const int jt = w >> 1;
#pragma unroll
          for (int t2 = 0; t2 < 2; ++t2) { const int il = 32 * (2 * (w & 1) + t2) + ln;
#pragma unroll
            for (int r4 = 0; r4 < 4; ++r4) *(LAS u32x2*)(PL + il * 272 + (32 * jt + 8 * r4 + 4 * hi) * 2) = pw[t2][r4]; } }
#pragma unroll
        for (int i = 0; i < 8; ++i) { const int q = F.tid + NTHR * i, row = q >> 5, c32 = q & 31; *(LAS h16x8*)(VL + row * 576 + c32 * 16) = vreg[i]; }
        __syncthreads();
        f32x16 o[4];
#pragma unroll
        for (int ib = 0; ib < 4; ++ib) o[ib] = (f32x16){};
#pragma unroll
        for (int k16 = 0; k16 < 8; ++k16) { const h16x8 a = frag_tr(VL, 576, 16 * k16, 32 * w, F.lane);
#pragma unroll
            for (int ib = 0; ib < 4; ++ib) o[ib] = MFMA32(a, frag_row(PL, 272, 32 * ib, 16 * k16, F.lane), o[ib]);
            if (k16 & 1) __builtin_amdgcn_sched_barrier(0); }
#pragma unroll
        for (int dir = 0; dir < 2; ++dir) {
            h16 sc[4];
#pragma unroll
            for (int ib = 0; ib < 4; ++ib) { const int il = 32 * ib + ln; sc[ib] = (h16)(dir ? __expf(lgb * (float)(128 - il)) : __expf(lgf * (float)(il + 1))); }
            const h16* Sg = SST + ((size_t)((dir * 16 + bh) * 32 + c) * 256 + 32 * w + ln) * 128 + 8 * hi;
#pragma unroll
            for (int kh = 0; kh < 2; ++kh) {
                h16x8 sa[4];
#pragma unroll
                for (int k4 = 0; k4 < 4; ++k4) sa[k4] = *(const h16x8*)(Sg + 16 * (4 * kh + k4));
#pragma unroll
                for (int k4 = 0; k4 < 4; ++k4) {
#pragma unroll
                    for (int ib = 0; ib < 4; ++ib) o[ib] = MFMA32(sa[k4], frag_row(QL, 272, 32 * ib, 16 * (4 * kh + k4), F.lane) * sc[ib], o[ib]);
                    __builtin_amdgcn_sched_barrier(0); }
            }
        }
#pragma unroll
        for (int ib = 0; ib < 4; ++ib) { float ss = 0.f;
#pragma unroll
            for (int r = 0; r < 16; ++r) ss += o[ib][r] * o[ib][r];
            ss += __shfl_xor(ss, 32);
            if (hi == 0) RED[(w * 4 + ib) * 32 + ln] = ss; }
        __syncthreads();
#pragma unroll
        for (int ib = 0; ib < 4; ++ib) { float tot = 0.f;
#pragma unroll
            for (int ww = 0; ww < 8; ++ww) tot += RED[(ww * 4 + ib) * 32 + ln];
            const float rstd = 1.0f / sqrtf(tot * (1.0f / 256.0f) + EPS);
            const size_t grow = (size_t)(row0 + 32 * ib + ln);
#pragma unroll
            for (int r4 = 0; r4 < 4; ++r4) { const int e = 32 * w + 8 * r4 + 4 * hi;
                const h16x4 gt = *(const h16x4*)(P + grow * IN_COLS + C_RG + h * 256 + e);
                u32x2 wv; wv.x = pk2h(o[ib][4 * r4] * rstd * (float)gt[0], o[ib][4 * r4 + 1] * rstd * (float)gt[1]); wv.y = pk2h(o[ib][4 * r4 + 2] * rstd * (float)gt[2], o[ib][4 * r4 + 3] * rstd * (float)gt[3]);
                *(u32x2*)(ARET + grow * 3072 + h * 256 + e) = wv; } }
        __syncthreads();
    }
}
__device__ __forceinline__ void p6_attn(Frame& F) {
    const h16* P = (const h16*)(F.ws + WS_P); h16* ADIF = (h16*)(F.ws + WS_ACAT) + 2048;
    const int hi = F.lane >> 5, ln = F.lane & 31;
    float lam;
    { const float s1 = wave_sum(F.diff_lambda[F.lane] * F.diff_lambda[64 + F.lane]), s2 = wave_sum(F.diff_lambda[128 + F.lane] * F.diff_lambda[192 + F.lane]); lam = __expf(s1) - __expf(s2) + 0.2f; }
    constexpr int KT0 = 0, VT0 = 34816, KTB = 17408, VTB = 20480;
    LAS float* XB = (LAS float*)F.lds;
    for (int u = F.vcu; u < 512; u += F.G) {
        const int bh = u >> 5, qb = u & 31, b = bh >> 3, h = bh & 7;
        const int cm = F.wave & 1, qs = F.wave >> 1, qrow0 = b * SEQ + qb * 128 + qs * 32;
        h16x8 qf[4];
#pragma unroll
        for (int ks = 0; ks < 4; ++ks) qf[ks] = *(const h16x8*)(P + (size_t)(qrow0 + ln) * IN_COLS + C_DQ + h * 128 + cm * 64 + 16 * ks + 8 * hi);
        f32x16 o[4];
#pragma unroll
        for (int et = 0; et < 4; ++et) o[et] = (f32x16){};
        float mrun = 0.f, lsum = 0.f; f32x16 negm = (f32x16){};
        h16x8 kreg[2], vreg[2];
#define ATT_LOAD(t) do { _Pragma("unroll") for (int i = 0; i < 2; ++i) { const int q = F.tid + NTHR * i, row = q >> 4, ch = q & 15; const int j = (t) * 64 + row; \
            const size_t srow = (j < CTXL) ? (size_t)(MLAT + b * CTXL + j) : (size_t)(b * SEQ + j - CTXL); const h16* pr = P + srow * IN_COLS + h * 128 + ch * 8; \
            kreg[i] = *(const h16x8*)(pr + C_DK); vreg[i] = *(const h16x8*)(pr + C_DV); } } while (0)
#define ATT_WRITE(buf) do { _Pragma("unroll") for (int i = 0; i < 2; ++i) { const int q = F.tid + NTHR * i, row = q >> 4, ch = q & 15; \
            *(LAS h16x8*)(F.lds + KT0 + (buf) * KTB + row * 272 + ch * 16) = kreg[i]; *(LAS h16x8*)(F.lds + VT0 + (buf) * VTB + row * 320 + ch * 16) = vreg[i]; } } while (0)
        ATT_LOAD(0); ATT_WRITE(0);
        __syncthreads();
        constexpr int NT = (CTXL + SEQ) / 64;
        for (int t = 0; t < NT; ++t) {
            const int buf = t & 1;
            if (t + 1 < NT) ATT_LOAD(t + 1);
            const LAS unsigned char* Kt = F.lds + KT0 + buf * KTB; const LAS unsigned char* Vt = F.lds + VT0 + buf * VTB;
            f32x16 s[2];
#pragma unroll
            for (int kt = 0; kt < 2; ++kt) { s[kt] = negm;
#pragma unroll
                for (int ks = 0; ks < 4; ++ks) s[kt] = MFMA32(frag_row(Kt, 272, 32 * kt, cm * 64 + 16 * ks, F.lane), qf[ks], s[kt]); }
            float mx = s[0][0];
#pragma unroll
            for (int r = 0; r < 16; ++r) { mx = fmaxf(mx, s[0][r]); mx = fmaxf(mx, s[1][r]); }
            { const auto rr = __builtin_amdgcn_permlane32_swap(__float_as_uint(mx), __float_as_uint(mx), false, false); mx = fmaxf(__uint_as_float(rr[0]), __uint_as_float(rr[1])); }
            if (t == 0 || __any(mx > 8.0f)) { const float dl = (t == 0) ? mx : fmaxf(mx, 0.0f), alpha = (t == 0) ? 0.0f : __builtin_amdgcn_exp2f(-dl); mrun += dl; lsum *= alpha;
#pragma unroll
                for (int et = 0; et < 4; ++et) o[et] *= alpha;
#pragma unroll
                for (int kt = 0; kt < 2; ++kt)
#pragma unroll
                    for (int r = 0; r < 16; ++r) s[kt][r] -= dl;
#pragma unroll
                for (int r = 0; r < 16; ++r) negm[r] = -mrun; }
            float ps = 0.f;
#pragma unroll
            for (int kt = 0; kt < 2; ++kt)
#pragma unroll
                for (int r = 0; r < 16; ++r) { s[kt][r] = __builtin_amdgcn_exp2f(s[kt][r]); ps += s[kt][r]; }
            lsum += ps;
#pragma unroll
            for (int kt = 0; kt < 2; ++kt)
#pragma unroll
                for (int s2 = 0; s2 < 2; ++s2) {
                    const h16x8 pbf = pack8(s[kt][8 * s2], s[kt][8 * s2 + 1], s[kt][8 * s2 + 2], s[kt][8 * s2 + 3], s[kt][8 * s2 + 4], s[kt][8 * s2 + 5], s[kt][8 * s2 + 6], s[kt][8 * s2 + 7]);
#pragma unroll
                    for (int et = 0; et < 4; ++et) o[et] = MFMA32(frag_tr_perm(Vt, 320, 32 * kt + 16 * s2, 32 * et, F.lane), pbf, o[et]);
                }
            if (t + 1 < NT) ATT_WRITE(buf ^ 1);
            __syncthreads();
        }
#undef ATT_LOAD
#undef ATT_WRITE
        lsum += __shfl_xor(lsum, 32);
        const float inv = 1.0f / lsum;
        if (cm == 1) {
#pragma unroll
            for (int et = 0; et < 4; ++et)
#pragma unroll
                for (int r = 0; r < 16; ++r) XB[(qs * 128 + 32 * et + crow(r, hi)) * 32 + ln] = o[et][r] * inv;
        }
        __syncthreads();
        if (cm == 0) {
            float ss = 0.f;
#pragma unroll
            for (int et = 0; et < 4; ++et)
#pragma unroll
                for (int r = 0; r < 16; ++r) { const float v = o[et][r] * inv - lam * XB[(qs * 128 + 32 * et + crow(r, hi)) * 32 + ln]; o[et][r] = v; ss += v * v; }
            ss += __shfl_xor(ss, 32);
            const float rstd = 0.8f / sqrtf(ss * (1.0f / 128.0f) + EPS);
            const size_t grow = (size_t)(qrow0 + ln);
#pragma unroll
            for (int et = 0; et < 4; ++et)
#pragma unroll
                for (int r4 = 0; r4 < 4; ++r4) { const int e = 32 * et + 8 * r4 + 4 * hi; const f32x4 sw = *(const f32x4*)(F.diff_subln + e);
                    u32x2 w; w.x = pk2h(o[et][4 * r4] * rstd * sw[0], o[et][4 * r4 + 1] * rstd * sw[1]); w.y = pk2h(o[et][4 * r4 + 2] * rstd * sw[2], o[et][4 * r4 + 3] * rstd * sw[3]);
                    *(u32x2*)(ADIF + grow * 3072 + h * 128 + e) = w; }
        }
        __syncthreads();
    }
}
struct SchedG2 {
    pg8::StaticOrder so;
    __device__ __forceinline__ bool next(int i, pg8::Unit& u) const { if (!so.next(i >> 1, u)) return false; if (i & 1) { u.ko = 2048; u.nt = 16; u.keep = 0; } else { u.ko = 0; u.nt = 32; u.keep = 1; } return true; }
};
struct EpiU2 {
    h16* U; const h16* P;
    __device__ __forceinline__ void operator()(f32x4 (&acc)[2][2][4][2], const pg8::Unit& u, int wr, int wc, int fr, int fq) const {
#pragma unroll
        for (int ai = 0; ai < 2; ++ai)
#pragma unroll
            for (int m = 0; m < 4; ++m) { const int row = u.pm * 256 + ai * 128 + wr * 64 + m * 16 + fr;
#pragma unroll
                for (int bj = 0; bj < 2; ++bj)
#pragma unroll
                    for (int n = 0; n < 2; ++n) { const int col = u.pn * 256 + bj * 128 + wc * 32 + 16 * n + 4 * fq;
                        const h16x4 gd = *(const h16x4*)(P + (size_t)row * IN_COLS + C_GD + col);
                        if (u.keep) { const h16x4 gr = *(const h16x4*)(P + (size_t)row * IN_COLS + C_GR + col);
#pragma unroll
                            for (int e = 0; e < 4; ++e) acc[ai][bj][m][n][e] *= (float)gr[e] / (float)gd[e];
                        } else { const f32x4 a = acc[ai][bj][m][n];
                            u32x2 w; w.x = pk2h(a[0] * (float)gd[0], a[1] * (float)gd[1]); w.y = pk2h(a[2] * (float)gd[2], a[3] * (float)gd[3]);
                            *(u32x2*)(U + (size_t)row * DM + col) = w; } } }
    }
};
struct EpiX1 {
    float* X1; const float* x; const float* MOD;
    __device__ __forceinline__ void operator()(f32x4 (&acc)[2][2][4][2], const pg8::Unit& u, int wr, int wc, int fr, int fq) const {
        const int b = (u.pm * 256) / SEQ;
#pragma unroll
        for (int ai = 0; ai < 2; ++ai)
#pragma unroll
            for (int m = 0; m < 4; ++m) { const int row = u.pm * 256 + ai * 128 + wr * 64 + m * 16 + fr;
#pragma unroll
                for (int bj = 0; bj < 2; ++bj)
#pragma unroll
                    for (int n = 0; n < 2; ++n) { const int col = u.pn * 256 + bj * 128 + wc * 32 + 16 * n + 4 * fq;
                        const f32x4 g1 = *(const f32x4*)(MOD + (size_t)b * (6 * DM) + 2 * DM + col); const f32x4 xv = *(const f32x4*)(x + (size_t)row * DM + col);
                        *(f32x4*)(X1 + (size_t)row * DM + col) = xv + g1 * acc[ai][bj][m][n]; } }
    }
};
__device__ __forceinline__ void p7_gemm2(Frame& F) {
    pg8::Gemm g{(const h16*)(F.ws + WS_ACAT), (const h16*)(F.ws + WS_WCAT), 3072, 3072, 2048};
    SchedG2 S; S.so.init(MLAT, DM, F.G, (int)blockIdx.x);
    EpiU2 E{(h16*)(F.ws + WS_U), (const h16*)(F.ws + WS_P)};
    pg8::gemm_phase<EpiU2, SchedG2>(F.lds, g, S, E);
}
__device__ __forceinline__ void p9_gemm3(Frame& F) {
    pg8::Gemm g{(const h16*)(F.ws + WS_U), (const h16*)(F.ws + WS_WOUT), 2048, 2048, 2048};
    pg8::StaticOrder S; S.init(MLAT, DM, F.G, (int)blockIdx.x);
    EpiX1 E{(float*)(F.ws + WS_X1), F.x, (const float*)(F.ws + WS_MOD)};
    pg8::gemm_phase<EpiX1, pg8::StaticOrder>(F.lds, g, S, E);
}


__device__ __forceinline__ void p10_norm2(Frame& F) {
    const float* X1 = (const float*)(F.ws + WS_X1); const float* MOD = (const float*)(F.ws + WS_MOD); h16* H2X = (h16*)(F.ws + WS_H2X);
    const int gw = F.vcu * NWAVES + F.wave, NGW = F.G * NWAVES;
    for (int r = gw; r < MLAT; r += NGW) {
        const float* src = X1 + (size_t)r * DM; const int b = r / SEQ;
        f32x4 xv[8]; float ss = 0.f;
#pragma unroll
        for (int j = 0; j < 8; ++j) { xv[j] = *(const f32x4*)(src + 4 * F.lane + 256 * j); ss += (xv[j].x * xv[j].x + xv[j].y * xv[j].y) + (xv[j].z * xv[j].z + xv[j].w * xv[j].w); }
        const float rstd = 1.0f / sqrtf(wave_sum(ss) * (1.0f / DM) + EPS);
#pragma unroll
        for (int j = 0; j < 8; ++j) { const int cc = 4 * F.lane + 256 * j; const f32x4 nw = *(const f32x4*)(F.norm_ffn + cc);
            const f32x4 sh = *(const f32x4*)(MOD + (size_t)b * (6 * DM) + 3 * DM + cc), sc = *(const f32x4*)(MOD + (size_t)b * (6 * DM) + 4 * DM + cc);
            const f32x4 y = xv[j] * rstd * nw * (sc + 1.0f) + sh;
            h16 hh[4], ll[4];
#pragma unroll
            for (int e = 0; e < 4; ++e) { hh[e] = (h16)y[e]; ll[e] = (h16)(y[e] - (float)hh[e]); }
            h16* dst = H2X + (size_t)r * 6144 + cc;
            *(h16x4*)(dst) = (h16x4){hh[0], hh[1], hh[2], hh[3]}; *(h16x4*)(dst + 4096) = (h16x4){hh[0], hh[1], hh[2], hh[3]}; *(h16x4*)(dst + 2048) = (h16x4){ll[0], ll[1], ll[2], ll[3]};
            { int p8 = __builtin_amdgcn_cvt_pk_fp8_f32(y[0], y[1], 0, false); p8 = __builtin_amdgcn_cvt_pk_fp8_f32(y[2], y[3], p8, true); *(int*)((unsigned char*)(F.ws + WS_H2F8) + (size_t)r * DM + cc) = p8; } }
    }
}
struct SchedRT {
    int G, c;
    __device__ __forceinline__ bool next(int i, pg8::Unit& u) const { const int L = i * G + c; if (L >= 256) return false; u.pm = L >> 3; u.pn = 0; u.ko = (L & 7) * 768; u.nt = 0; u.keep = 0; return true; }
};
struct EpiLG {
    float* LGP;
    __device__ __forceinline__ void operator()(f32x4 (&acc)[2][2][4][2], const pg8::Unit& u, int wr, int wc, int fr, int fq) const {
        float* dst = LGP + (size_t)(u.ko / 768) * MLAT * NEXP;
#pragma unroll
        for (int ai = 0; ai < 2; ++ai)
#pragma unroll
            for (int m = 0; m < 4; ++m) { const int row = u.pm * 256 + ai * 128 + wr * 64 + m * 16 + fr;
#pragma unroll
                for (int bj = 0; bj < 2; ++bj)
#pragma unroll
                    for (int n = 0; n < 2; ++n) { const int col = bj * 128 + wc * 32 + 16 * n + 4 * fq; *(f32x4*)(dst + (size_t)row * NEXP + col) = acc[ai][bj][m][n]; } }
    }
};
__device__ __forceinline__ void p11_router(Frame& F) {
    pg8::Gemm g{(const h16*)(F.ws + WS_H2X), (const h16*)(F.ws + WS_WRTR), 6144, 6144, 768};
    SchedRT S; S.G = F.G; S.c = (int)blockIdx.x;
    EpiLG E{(float*)(F.ws + WS_LGP)};
    pg8::gemm_phase<EpiLG, SchedRT>(F.lds, g, S, E);
}
__device__ __forceinline__ void p12_topk(Frame& F) {
    const float* LGP = (const float*)(F.ws + WS_LGP); int* EIDX = (int*)(F.ws + WS_EIDX); float* EW = (float*)(F.ws + WS_EW); u32x2* LIST = (u32x2*)(F.ws + WS_LIST2);
    unsigned* CNT = (unsigned*)(F.ws + WS_CTL) + CW_CNT;
    const int gw = F.vcu * NWAVES + F.wave, NGW = F.G * NWAVES, lane = F.lane;
    const f32x4 bias = *(const f32x4*)(F.router_bias + 4 * lane);
    for (int t = gw; t < MLAT; t += NGW) {
        f32x4 lg = *(const f32x4*)(LGP + (size_t)t * NEXP + 4 * lane);
#pragma unroll
        for (int ks = 1; ks < 8; ++ks) lg += *(const f32x4*)(LGP + ((size_t)ks * MLAT + t) * NEXP + 4 * lane);
        float sc[4], sel[4];
#pragma unroll
        for (int i = 0; i < 4; ++i) { sc[i] = 1.0f / (1.0f + __expf(-lg[i])); sel[i] = sc[i] + bias[i]; }
        float a1 = fmaxf(sel[0], sel[1]), a2 = fminf(sel[0], sel[1]);
        { const float b1 = fmaxf(sel[2], sel[3]), b2 = fminf(sel[2], sel[3]); const float n1 = fmaxf(a1, b1), n2 = fmaxf(fminf(a1, b1), fmaxf(a2, b2)); a1 = n1; a2 = n2; }
#pragma unroll
        for (int off = 1; off < 8; off <<= 1) { const float b1 = __shfl_xor(a1, off), b2 = __shfl_xor(a2, off); const float n1 = fmaxf(a1, b1), n2 = fmaxf(fminf(a1, b1), fmaxf(a2, b2)); a1 = n1; a2 = n2; }
        const float gs = a1 + a2; const int g = lane >> 3;
        int rank = 0;
#pragma unroll
        for (int j = 0; j < 8; ++j) { const float o = __shfl(gs, 8 * j); rank += (o > gs || (o == gs && j < g)) ? 1 : 0; }
        const bool gsel = rank < 4;
        float ms[4];
#pragma unroll
        for (int i = 0; i < 4; ++i) ms[i] = gsel ? sel[i] : -INFINITY;
        float myw = 0.f; int mye = 0; float wsum = 0.f;
#pragma unroll
        for (int k = 0; k < TOPK; ++k) {
            float bv = ms[0]; int bi = 4 * lane;
#pragma unroll
            for (int i = 1; i < 4; ++i) if (ms[i] > bv) { bv = ms[i]; bi = 4 * lane + i; }
#pragma unroll
            for (int off = 1; off < 64; off <<= 1) { const float ov = __shfl_xor(bv, off); const int oi = __shfl_xor(bi, off); if (ov > bv || (ov == bv && oi < bi)) { bv = ov; bi = oi; } }
            const int ol = bi >> 2, oi = bi & 3;
            const float mysc = (oi == 0) ? sc[0] : (oi == 1) ? sc[1] : (oi == 2) ? sc[2] : sc[3];
            const float w = __shfl(mysc, ol);
            if (lane == ol) {
#pragma unroll
                for (int i = 0; i < 4; ++i) if (i == oi) ms[i] = -INFINITY; }
            wsum += w;
            if (lane == k) { myw = w; mye = bi; }
        }
        if (lane < TOPK) {
            const float wn = myw / wsum * 2.5f;
            EIDX[t * TOPK + lane] = mye; EW[t * TOPK + lane] = wn;
            const unsigned pos = atomicAdd(&CNT[mye], 1u);
            LIST[mye * MLAT + pos] = (u32x2){(unsigned)(t * TOPK + lane), __float_as_uint(wn)};
        }
    }
}
constexpr int EX_NSTG = 3, EX_ASTG = 24576, EX_WSTG = 16384, EX_A0 = 0, EX_W0 = EX_NSTG * EX_ASTG, EX_WH0 = EX_W0 + EX_NSTG * EX_WSTG, EX_WHS = 10240, EX_ROW0 = EX_WH0 + 2 * EX_WHS;
constexpr int EX_TAB0 = EX_ROW0 + 3200, EX_SCR0 = EX_TAB0 + 3072;
static_assert(EX_ROW0 == 143360 && EX_SCR0 + 8192 <= LDSCTL_OFF, "expert LDS map");
template <bool GU>
__device__ __forceinline__ void ring_w_prologue(Frame& F, const float* W, int cgrp) {
    constexpr int LDB = GU ? 512 : 2048;
    const int lane = F.lane, w = F.wave, v = 4 * (lane & 31);
    const int wcol0 = GU ? (((v >> 5) & 1) * 256 + 32 * (v >> 6) + (v & 31) + 64 * cgrp) : (v + 512 * cgrp);
    const float* wlane = W + (size_t)(4 * w + (lane >> 5)) * LDB + wcol0;
#pragma unroll
    for (int s = 0; s < 3; ++s)
#pragma unroll
        for (int j = 0; j < 2; ++j) __builtin_amdgcn_global_load_lds((const unsigned*)(wlane + (size_t)(s * 32 + 2 * j) * LDB), (LAS unsigned*)(F.lds + EX_W0 + s * EX_WSTG + (2 * w + j) * 1024), 16, 0, 2);
}
template <bool GU, int NLAY>
__device__ __forceinline__ void expert_ring(Frame& F, const float* W, const h16* Abase, const int (&arow)[3], int nr, int cgrp, h16* ACTrow0, h16* Y) {
    constexpr int KT = GU ? 64 : 8, NP = GU ? 1 : 4, LDB = GU ? 512 : 2048, NS = KT * NP;
    const int tid = F.tid, lane = F.lane, hi = lane >> 5, ln = lane & 31, cp = F.wave & 1, rg = F.wave >> 1, w = F.wave;
    const LAS int* RSLOT = (const LAS int*)(F.lds + EX_ROW0); const LAS float* RW = (const LAS float*)(F.lds + EX_ROW0 + 1536);
    const int ngrp = (nr + 15) >> 4;
    const int nA = (w < ngrp ? 1 : 0) + (w + 8 < ngrp ? 1 : 0) + (w + 16 < ngrp ? 1 : 0);
    const int achunk = ((lane & 3) ^ ((lane >> 4) & 3)) * 8;
    const int v = 4 * (lane & 31);
    const int wcol0 = GU ? (((v >> 5) & 1) * 256 + 32 * (v >> 6) + (v & 31) + 64 * cgrp) : (v + 512 * cgrp);
    const float* wlane = W + (size_t)(4 * w + (lane >> 5)) * LDB + wcol0;
    const unsigned lds0 = (unsigned)(uintptr_t)F.lds;
    const int xs = (ln >> 2) & 3;
    const unsigned aofs0 = (unsigned)((2 * rg + (ln >> 4)) * 1024 + (ln & 15) * 64 + ((hi ^ xs) * 16)), aofs1 = (unsigned)((2 * rg + (ln >> 4)) * 1024 + (ln & 15) * 64 + (((2 + hi) ^ xs) * 16));
    const unsigned tofs = (unsigned)((8 * hi + ((lane & 15) >> 2)) * 320 + (64 * cp + 16 * ((lane >> 4) & 1) + 4 * (lane & 3)) * 2);
    f32x16 acc[2 * NLAY];
#pragma unroll
    for (int i = 0; i < 2 * NLAY; ++i) acc[i] = (f32x16){};
#define EX_DMA_A(s) do { const int kt_ = (s) % KT, stg_ = (s) % EX_NSTG; \
        _Pragma("unroll") for (int j = 0; j < 3; ++j) if (j < nA) __builtin_amdgcn_global_load_lds((const unsigned*)(Abase + arow[j] + kt_ * 32 + achunk), (LAS unsigned*)(F.lds + EX_A0 + stg_ * EX_ASTG + (w + 8 * j) * 1024), 16, 0, 0); } while (0)
#define EX_DMA_W(s) do { const int pass_ = (s) / KT, kt_ = (s) % KT, stg_ = (s) % EX_NSTG; \
        _Pragma("unroll") for (int j = 0; j < 2; ++j) __builtin_amdgcn_global_load_lds((const unsigned*)(wlane + (size_t)(kt_ * 32 + 2 * j) * LDB + 128 * pass_), (LAS unsigned*)(F.lds + EX_W0 + stg_ * EX_WSTG + (2 * w + j) * 1024), 16, 0, 2); } while (0)
#define EX_WAITV(k) asm volatile("s_waitcnt vmcnt(" #k ")" ::: "memory")
#define EX_WAITN() do { if (nA == 3) EX_WAITV(5); else if (nA == 2) EX_WAITV(4); else if (nA == 1) EX_WAITV(3); else EX_WAITV(2); } while (0)
    const unsigned cvsrc = lds0 + EX_W0 + (tid >> 4) * 512 + (tid & 15) * 32, cvdst = lds0 + EX_WH0 + (tid >> 4) * 320 + (tid & 15) * 16;
    EX_DMA_A(0); EX_DMA_A(1);
    if (nA == 3) EX_WAITV(3); else if (nA == 2) EX_WAITV(2); else if (nA == 1) EX_WAITV(1); else EX_WAITV(0);
    __builtin_amdgcn_s_barrier(); asm volatile("" ::: "memory");
    { f32x4 c0, c1; asm volatile("ds_read_b128 %0, %2\n\tds_read_b128 %1, %2 offset:16\n\ts_waitcnt lgkmcnt(0)" : "=&v"(c0), "=&v"(c1) : "v"(cvsrc) : "memory");
      const h16x8 hv = pack8(c0[0], c0[1], c0[2], c0[3], c1[0], c1[1], c1[2], c1[3]); asm volatile("ds_write_b128 %0, %1" :: "v"(cvdst), "v"(hv) : "memory"); }
    typedef short s16x8 __attribute__((ext_vector_type(8)));
    for (int s = 0; s < NS; ++s) {
        if (s + 2 < NS) EX_WAITN(); else EX_WAITV(0);
        asm volatile("s_waitcnt lgkmcnt(0)" ::: "memory");
        __builtin_amdgcn_s_barrier();
        asm volatile("" ::: "memory");
        const bool pend = ((s % KT) == KT - 1);
        if (!pend) { if (s + 2 < NS) EX_DMA_A(s + 2); if (s + 3 < NS) EX_DMA_W(s + 3); }
        const unsigned abase = lds0 + EX_A0 + (s % EX_NSTG) * EX_ASTG, wbase = lds0 + EX_WH0 + (s & 1) * EX_WHS + tofs;
        const unsigned cs = cvsrc + ((s + 1) % EX_NSTG) * EX_WSTG;
        const unsigned pa0 = abase + aofs0, pa1 = abase + aofs1;
        if constexpr (NLAY < 3) {
            v4i16_t t0, t1, t2, t3, t4, t5, t6, t7; h16x8 a0[NLAY], a1[NLAY];
            asm volatile("ds_read_b64_tr_b16 %0, %8\n\tds_read_b64_tr_b16 %1, %8 offset:1280\n\tds_read_b64_tr_b16 %2, %8 offset:64\n\tds_read_b64_tr_b16 %3, %8 offset:1344\n\t"
                         "ds_read_b64_tr_b16 %4, %8 offset:5120\n\tds_read_b64_tr_b16 %5, %8 offset:6400\n\tds_read_b64_tr_b16 %6, %8 offset:5184\n\tds_read_b64_tr_b16 %7, %8 offset:6464"
                         : "=&v"(t0), "=&v"(t1), "=&v"(t2), "=&v"(t3), "=&v"(t4), "=&v"(t5), "=&v"(t6), "=&v"(t7) : "v"(wbase) : "memory");
            asm volatile("ds_read_b128 %0, %2\n\tds_read_b128 %1, %3" : "=&v"(a0[0]), "=&v"(a1[0]) : "v"(pa0), "v"(pa1) : "memory");
            if constexpr (NLAY >= 2) asm volatile("ds_read_b128 %0, %2 offset:8192\n\tds_read_b128 %1, %3 offset:8192" : "=&v"(a0[1]), "=&v"(a1[1]) : "v"(pa0), "v"(pa1) : "memory");
            asm volatile("s_waitcnt lgkmcnt(0)" ::: "memory");
            __builtin_amdgcn_sched_barrier(0);
            const h16x8 b00 = __builtin_bit_cast(h16x8, (s16x8){t0[0], t0[1], t0[2], t0[3], t1[0], t1[1], t1[2], t1[3]}), b01 = __builtin_bit_cast(h16x8, (s16x8){t2[0], t2[1], t2[2], t2[3], t3[0], t3[1], t3[2], t3[3]});
            const h16x8 b10 = __builtin_bit_cast(h16x8, (s16x8){t4[0], t4[1], t4[2], t4[3], t5[0], t5[1], t5[2], t5[3]}), b11 = __builtin_bit_cast(h16x8, (s16x8){t6[0], t6[1], t6[2], t6[3], t7[0], t7[1], t7[2], t7[3]});
#pragma unroll
            for (int i = 0; i < NLAY; ++i) { acc[2 * i] = MFMA32(a0[i], b00, acc[2 * i]); acc[2 * i + 1] = MFMA32(a0[i], b01, acc[2 * i + 1]); }
#pragma unroll
            for (int i = 0; i < NLAY; ++i) { acc[2 * i] = MFMA32(a1[i], b10, acc[2 * i]); acc[2 * i + 1] = MFMA32(a1[i], b11, acc[2 * i + 1]); }
        } else {
#pragma unroll
            for (int k16 = 0; k16 < 2; ++k16) {
                v4i16_t t0, t1, t2, t3; h16x8 a[3]; const unsigned pa = k16 ? pa1 : pa0, pw = wbase + k16 * 5120;
                asm volatile("ds_read_b64_tr_b16 %0, %4\n\tds_read_b64_tr_b16 %1, %4 offset:1280\n\tds_read_b64_tr_b16 %2, %4 offset:64\n\tds_read_b64_tr_b16 %3, %4 offset:1344"
                             : "=&v"(t0), "=&v"(t1), "=&v"(t2), "=&v"(t3) : "v"(pw) : "memory");
                asm volatile("ds_read_b128 %0, %3\n\tds_read_b128 %1, %3 offset:8192\n\tds_read_b128 %2, %3 offset:16384\n\ts_waitcnt lgkmcnt(0)" : "=&v"(a[0]), "=&v"(a[1]), "=&v"(a[2]) : "v"(pa) : "memory");
                __builtin_amdgcn_sched_barrier(0);
                const h16x8 b0 = __builtin_bit_cast(h16x8, (s16x8){t0[0], t0[1], t0[2], t0[3], t1[0], t1[1], t1[2], t1[3]}), b1 = __builtin_bit_cast(h16x8, (s16x8){t2[0], t2[1], t2[2], t2[3], t3[0], t3[1], t3[2], t3[3]});
#pragma unroll
                for (int i = 0; i < 3; ++i) { acc[2 * i] = MFMA32(a[i], b0, acc[2 * i]); acc[2 * i + 1] = MFMA32(a[i], b1, acc[2 * i + 1]); }
                __builtin_amdgcn_sched_barrier(0);
            }
        }
        if (s + 1 < NS) {
            f32x4 c0, c1; asm volatile("ds_read_b128 %0, %2\n\tds_read_b128 %1, %2 offset:16\n\ts_waitcnt lgkmcnt(0)" : "=&v"(c0), "=&v"(c1) : "v"(cs) : "memory");
            const h16x8 hv = pack8(c0[0], c0[1], c0[2], c0[3], c1[0], c1[1], c1[2], c1[3]); const unsigned cd = cvdst + ((s + 1) & 1) * EX_WHS; asm volatile("ds_write_b128 %0, %1" :: "v"(cd), "v"(hv) : "memory"); }
        if (pend) {
            const int pass = s / KT;
            int hio = hi, lno = ln; asm volatile("" : "+v"(hio), "+v"(lno));
            if (GU) {
#pragma unroll
                for (int i = 0; i < NLAY; ++i) { const int rt = rg + 4 * i;
#pragma unroll
                    for (int r = 0; r < 16; ++r) { const int row = 32 * rt + crow(r, hio);
                        if (row < nr) ACTrow0[(size_t)row * DEXP + 64 * cgrp + 32 * cp + lno] = (h16)(silu_f(acc[2 * i][r]) * acc[2 * i + 1][r]); }
                    acc[2 * i] = (f32x16){}; acc[2 * i + 1] = (f32x16){}; }
            } else {
                const unsigned scr = lds0 + EX_SCR0 + w * 1024;
                unsigned char* Y8 = (unsigned char*)Y;
#pragma unroll
                for (int i = 0; i < NLAY; ++i) { const int rt = rg + 4 * i;
#pragma unroll
                    for (int g8 = 0; g8 < 4; ++g8) {
#pragma unroll
                        for (int q = 0; q < 4; ++q) { const int lr = 4 * hio + q; const float wt = RW[32 * rt + 8 * g8 + lr];
                            const int pk = __builtin_amdgcn_cvt_pk_fp8_f32(acc[2 * i][4 * g8 + q] * wt, acc[2 * i + 1][4 * g8 + q] * wt, 0, false); const int pk1 = pk >> 8; const unsigned wa = scr + lr * 64 + lno;
                            asm volatile("ds_write_b8 %0, %1\n\tds_write_b8 %0, %2 offset:32" :: "v"(wa), "v"(pk), "v"(pk1) : "memory"); }
                        u32x2 pv; const unsigned ra = scr + (lane >> 3) * 64 + (lane & 7) * 8;
                        asm volatile("s_waitcnt lgkmcnt(0)\n\tds_read_b64 %0, %1\n\ts_waitcnt lgkmcnt(0)" : "=&v"(pv) : "v"(ra) : "memory");
                        const int grow = 32 * rt + 8 * g8 + (lane >> 3);
                        if (grow < nr) { const int slot = RSLOT[grow]; *(u32x2*)(Y8 + (size_t)slot * DM + 512 * cgrp + 128 * pass + 64 * cp + (lane & 7) * 8) = pv; }
                    }
                    acc[2 * i] = (f32x16){}; acc[2 * i + 1] = (f32x16){}; }
            }
            if (s + 2 < NS) EX_DMA_A(s + 2);
            if (s + 3 < NS) EX_DMA_W(s + 3);
        }
    }
    asm volatile("s_waitcnt vmcnt(0) lgkmcnt(0)" ::: "memory");
    __builtin_amdgcn_s_barrier();
    asm volatile("" ::: "memory");
#undef EX_DMA_A
#undef EX_DMA_W
#undef EX_WAITV
#undef EX_WAITN
}

constexpr int G8_NSTG = 4, G8_ASTG = 12288, G8_WSTG = 16384, G8_A0 = 0, G8_W0 = G8_NSTG * G8_ASTG, G8_WH0 = G8_W0 + G8_NSTG * G8_WSTG, G8_WHS = 4096;
static_assert(G8_WH0 + 2 * G8_WHS <= EX_ROW0, "gu8 LDS map");
__device__ __forceinline__ void gu8_w_prologue(Frame& F, const float* W, int cgrp) {
    const int lane = F.lane, w = F.wave, v = 4 * (lane & 31);
    const int wcol0 = ((v >> 5) & 1) * 256 + 32 * (v >> 6) + (v & 31) + 64 * cgrp;
    const float* wlane = W + (size_t)(4 * w + (lane >> 5)) * 512 + wcol0;
#pragma unroll
    for (int s = 0; s < 4; ++s)
#pragma unroll
        for (int j = 0; j < 2; ++j) __builtin_amdgcn_global_load_lds((const unsigned*)(wlane + (size_t)(s * 32 + 2 * j) * 512), (LAS unsigned*)(F.lds + G8_W0 + s * G8_WSTG + (2 * w + j) * 1024), 16, 0, 2);
}
template <int NLAY>
__device__ __forceinline__ void expert_ring_gu8(Frame& F, const float* W, const unsigned char* A8, const int (&arow)[2], int nr, int cgrp, h16* ACTrow0) {
    constexpr int NS = 64;
    typedef long v2i64 __attribute__((ext_vector_type(2)));
    const int tid = F.tid, lane = F.lane, hi = lane >> 5, ln = lane & 31, cp = F.wave & 1, rg = F.wave >> 1, w = F.wave;
    const int ngrp = (nr + 31) >> 5;
    const int nA = (w < ngrp ? 1 : 0) + (w + 8 < ngrp ? 1 : 0);
    const int v = 4 * (lane & 31);
    const int wcol0 = ((v >> 5) & 1) * 256 + 32 * (v >> 6) + (v & 31) + 64 * cgrp;
    const float* wlane = W + (size_t)(4 * w + (lane >> 5)) * 512 + wcol0;
    const unsigned lds0 = (unsigned)(uintptr_t)F.lds;
    const unsigned aofs = (unsigned)(rg * 1024 + ln * 32 + hi * 16);
    const unsigned bofs = (unsigned)((64 * cp + ln) * 32 + hi * 16);
    const unsigned cvsrc = lds0 + G8_W0 + (tid >> 7) * 8 * 512 + (tid & 127) * 4, cvdst = lds0 + G8_WH0 + (tid & 127) * 32 + (tid >> 7) * 8;
    f32x16 acc[2 * NLAY];
#pragma unroll
    for (int i = 0; i < 2 * NLAY; ++i) acc[i] = (f32x16){};
#define G8_DMA_A(s) do { const int stg_ = (s) & 3; \
        _Pragma("unroll") for (int j = 0; j < 2; ++j) if (j < nA) __builtin_amdgcn_global_load_lds((const unsigned*)(A8 + arow[j] + (s) * 32 + (lane & 1) * 16), (LAS unsigned*)(F.lds + G8_A0 + stg_ * G8_ASTG + (w + 8 * j) * 1024), 16, 0, 0); } while (0)
#define G8_DMA_W(s) do { const int stg_ = (s) & 3; \
        _Pragma("unroll") for (int j = 0; j < 2; ++j) __builtin_amdgcn_global_load_lds((const unsigned*)(wlane + (size_t)((s) * 32 + 2 * j) * 512), (LAS unsigned*)(F.lds + G8_W0 + stg_ * G8_WSTG + (2 * w + j) * 1024), 16, 0, 2); } while (0)
#define G8_WAITV(k) asm volatile("s_waitcnt vmcnt(" #k ")" ::: "memory")
#define G8_CVT(s) do { float c_[8]; const unsigned cs_ = cvsrc + ((s) & 3) * G8_WSTG; \
        asm volatile("ds_read_b32 %0, %8\n\tds_read_b32 %1, %8 offset:512\n\tds_read_b32 %2, %8 offset:1024\n\tds_read_b32 %3, %8 offset:1536\n\tds_read_b32 %4, %8 offset:2048\n\tds_read_b32 %5, %8 offset:2560\n\tds_read_b32 %6, %8 offset:3072\n\tds_read_b32 %7, %8 offset:3584\n\ts_waitcnt lgkmcnt(0)" \
                     : "=&v"(c_[0]), "=&v"(c_[1]), "=&v"(c_[2]), "=&v"(c_[3]), "=&v"(c_[4]), "=&v"(c_[5]), "=&v"(c_[6]), "=&v"(c_[7]) : "v"(cs_) : "memory"); \
        int p0_ = __builtin_amdgcn_cvt_pk_fp8_f32(c_[0] * 64.f, c_[1] * 64.f, 0, false); p0_ = __builtin_amdgcn_cvt_pk_fp8_f32(c_[2] * 64.f, c_[3] * 64.f, p0_, true); \
        int p1_ = __builtin_amdgcn_cvt_pk_fp8_f32(c_[4] * 64.f, c_[5] * 64.f, 0, false); p1_ = __builtin_amdgcn_cvt_pk_fp8_f32(c_[6] * 64.f, c_[7] * 64.f, p1_, true); \
        const u32x2 pk_ = {(unsigned)p0_, (unsigned)p1_}; const unsigned cd_ = cvdst + ((s) & 1) * G8_WHS; asm volatile("ds_write_b64 %0, %1" :: "v"(cd_), "v"(pk_) : "memory"); } while (0)
    G8_DMA_A(0); G8_DMA_A(1); G8_DMA_A(2);
    if (nA == 2) G8_WAITV(4); else if (nA == 1) G8_WAITV(2); else G8_WAITV(0);
    __builtin_amdgcn_s_barrier(); asm volatile("" ::: "memory");
    G8_CVT(0);
    for (int s = 0; s < NS; ++s) {
        if (s >= 2 && s + 4 < NS) { if (nA == 2) G8_WAITV(8); else if (nA == 1) G8_WAITV(6); else G8_WAITV(4); }
        else if (s < 2) { if (nA == 2) G8_WAITV(4); else if (nA == 1) G8_WAITV(3); else G8_WAITV(2); }
        else G8_WAITV(0);
        asm volatile("s_waitcnt lgkmcnt(0)" ::: "memory");
        __builtin_amdgcn_s_barrier();
        asm volatile("" ::: "memory");
        if (s + 3 < NS) G8_DMA_A(s + 3);
        if (s + 4 < NS) G8_DMA_W(s + 4);
        const unsigned pa = lds0 + G8_A0 + (s & 3) * G8_ASTG + aofs, pb = lds0 + G8_WH0 + (s & 1) * G8_WHS + bofs;
        v2i64 a[NLAY], b0, b1;
        asm volatile("ds_read_b128 %0, %2\n\tds_read_b128 %1, %2 offset:1024" : "=&v"(b0), "=&v"(b1) : "v"(pb) : "memory");
        asm volatile("ds_read_b128 %0, %1" : "=&v"(a[0]) : "v"(pa) : "memory");
        if constexpr (NLAY >= 2) asm volatile("ds_read_b128 %0, %1 offset:4096" : "=&v"(a[1]) : "v"(pa) : "memory");
        if constexpr (NLAY >= 3) asm volatile("ds_read_b128 %0, %1 offset:8192" : "=&v"(a[2]) : "v"(pa) : "memory");
        asm volatile("s_waitcnt lgkmcnt(0)" ::: "memory");
        __builtin_amdgcn_sched_barrier(0);
#pragma unroll
        for (int i = 0; i < NLAY; ++i) { acc[2 * i] = __builtin_amdgcn_mfma_f32_32x32x16_fp8_fp8(a[i][0], b0[0], acc[2 * i], 0, 0, 0); acc[2 * i + 1] = __builtin_amdgcn_mfma_f32_32x32x16_fp8_fp8(a[i][0], b1[0], acc[2 * i + 1], 0, 0, 0); }
#pragma unroll
        for (int i = 0; i < NLAY; ++i) { acc[2 * i] = __builtin_amdgcn_mfma_f32_32x32x16_fp8_fp8(a[i][1], b0[1], acc[2 * i], 0, 0, 0); acc[2 * i + 1] = __builtin_amdgcn_mfma_f32_32x32x16_fp8_fp8(a[i][1], b1[1], acc[2 * i + 1], 0, 0, 0); }
        if (s + 1 < NS) G8_CVT(s + 1);
    }
    {
        int hio = hi, lno = ln; asm volatile("" : "+v"(hio), "+v"(lno));
#pragma unroll
        for (int i = 0; i < NLAY; ++i) { const int rt = rg + 4 * i;
#pragma unroll
            for (int r = 0; r < 16; ++r) { const int row = 32 * rt + crow(r, hio);
                if (row < nr) ACTrow0[(size_t)row * DEXP + 64 * cgrp + 32 * cp + lno] = (h16)(silu_f(acc[2 * i][r] * 0.015625f) * (acc[2 * i + 1][r] * 0.015625f)); } }
    }
    asm volatile("s_waitcnt vmcnt(0) lgkmcnt(0)" ::: "memory");
    __builtin_amdgcn_s_barrier();
    asm volatile("" ::: "memory");
#undef G8_DMA_A
#undef G8_DMA_W
#undef G8_WAITV
#undef G8_CVT
}
template <bool GU>
__device__ __forceinline__ void p13_expert_phase(Frame& F, int qid) {
    const h16* H2X = (const h16*)(F.ws + WS_H2X); h16* Y = (h16*)(F.ws + WS_Y); h16* ACT = (h16*)(F.ws + WS_ACT);
    const unsigned* CNT = (const unsigned*)(F.ws + WS_CTL) + CW_CNT; unsigned* QH = (unsigned*)(F.ws + WS_CTL) + CW_Q + 64 * qid;
    LAS int* RSLOT = (LAS int*)(F.lds + EX_ROW0); LAS float* RW = (LAS float*)(F.lds + EX_ROW0 + 1536); LAS int* RED = (LAS int*)(F.lds + EX_ROW0 + 3072);
    LAS int* CN = (LAS int*)(F.lds + EX_TAB0); LAS int* ORD = CN + 256; LAS int* OFF = CN + 512;
    __syncthreads();
    if (F.tid < NEXP) CN[F.tid] = (int)CNT[F.tid];
    __syncthreads();
    if (F.tid < NEXP) { const int c = CN[F.tid]; int rank = 0, off = 0;
        for (int j = 0; j < NEXP; ++j) { const int cj = CN[j]; rank += (cj > c || (cj == c && j < F.tid)) ? 1 : 0; off += (j < F.tid) ? cj : 0; }
        ORD[rank] = F.tid; OFF[F.tid] = off; }
    __syncthreads();
    const u32x2* LIST2 = (const u32x2*)(F.ws + WS_LIST2);
    if (F.tid == 0) RED[0] = (int)__hip_atomic_fetch_add(QH, 1u, __ATOMIC_RELAXED, __HIP_MEMORY_SCOPE_AGENT);
    __syncthreads();
    int u = RED[0];
    while (u < NEXP * 4) {
        const int e = ORD[u >> 2], cg = u & 3, cnt = CN[e], off_e = OFF[e];
        const float* Wgu = F.w_exp_gu + (size_t)e * DM * 512; const float* Wdn = F.w_exp_down + (size_t)e * DEXP * DM;
        for (int rs = 0; rs < cnt; rs += 384) {
            const int nr = (cnt - rs) < 384 ? (cnt - rs) : 384;
            __syncthreads();
            if (GU) gu8_w_prologue(F, Wgu, cg); else ring_w_prologue<false>(F, Wdn, cg);
            if (F.tid < 384) { u32x2 ent = {0u, 0u}; if (F.tid < nr) ent = LIST2[e * MLAT + rs + F.tid]; RSLOT[F.tid] = (int)ent.x; RW[F.tid] = __uint_as_float(ent.y); }
            __syncthreads();
            h16* ACTrow0 = ACT + (size_t)(off_e + rs) * DEXP;
            int arow[3];
            if (GU) {
                int ar8[2];
#pragma unroll
                for (int j = 0; j < 2; ++j) { const int r = 32 * (F.wave + 8 * j) + (F.lane >> 1); ar8[j] = (r < 384 ? (RSLOT[r] >> 3) : 0) * DM; }
                const unsigned char* A8 = (const unsigned char*)(F.ws + WS_H2F8);
                if (nr > 256) expert_ring_gu8<3>(F, Wgu, A8, ar8, nr, cg, ACTrow0); else if (nr > 128) expert_ring_gu8<2>(F, Wgu, A8, ar8, nr, cg, ACTrow0); else expert_ring_gu8<1>(F, Wgu, A8, ar8, nr, cg, ACTrow0);
            } else {
#pragma unroll
                for (int j = 0; j < 3; ++j) { const int r = 16 * (F.wave + 8 * j) + (F.lane >> 2); arow[j] = ((r < nr) ? r : 0) * DEXP; }
                if (nr > 256) expert_ring<false, 3>(F, Wdn, ACTrow0, arow, nr, cg, ACTrow0, Y); else if (nr > 128) expert_ring<false, 2>(F, Wdn, ACTrow0, arow, nr, cg, ACTrow0, Y); else expert_ring<false, 1>(F, Wdn, ACTrow0, arow, nr, cg, ACTrow0, Y);
            }
        }
        __syncthreads();
        if (F.tid == 0) RED[0] = (int)__hip_atomic_fetch_add(QH, 1u, __ATOMIC_RELAXED, __HIP_MEMORY_SCOPE_AGENT);
        __syncthreads();
        u = RED[0];
    }
}
struct SchedSG {
    int G, c;
    __device__ __forceinline__ bool next(int i, pg8::Unit& u) const { const int L = i * G + c; if (L >= 256) return false; u.pm = L >> 3; u.pn = (L >> 2) & 1; u.ko = (L & 3) * 512; u.nt = 0; u.keep = 0; return true; }
};
struct EpiSGP {
    float* SGP;
    __device__ __forceinline__ void operator()(f32x4 (&acc)[2][2][4][2], const pg8::Unit& u, int wr, int wc, int fr, int fq) const {
        float* dst = SGP + (size_t)(u.ko / 512) * MLAT * 512;
#pragma unroll
        for (int ai = 0; ai < 2; ++ai)
#pragma unroll
            for (int m = 0; m < 4; ++m) { const int row = u.pm * 256 + ai * 128 + wr * 64 + m * 16 + fr;
#pragma unroll
                for (int bj = 0; bj < 2; ++bj)
#pragma unroll
                    for (int n = 0; n < 2; ++n) { const int col = u.pn * 256 + bj * 128 + wc * 32 + 16 * n + 4 * fq; *(f32x4*)(dst + (size_t)row * 512 + col) = acc[ai][bj][m][n]; } }
    }
};
__device__ __forceinline__ void p11b_shared_gu(Frame& F) {
    pg8::Gemm g{(const h16*)(F.ws + WS_H2X), (const h16*)(F.ws + WS_WSGU), 6144, 2048, 512};
    SchedSG S; S.G = F.G; S.c = (int)blockIdx.x;
    EpiSGP E{(float*)(F.ws + WS_SGP)};
    pg8::gemm_phase<EpiSGP, SchedSG>(F.lds, g, S, E);
}
__device__ __forceinline__ void p12b_shared_act(Frame& F) {
    const float* SGP = (const float*)(F.ws + WS_SGP); h16* ACTS = (h16*)(F.ws + WS_ACTS);
    for (int q = blockIdx.x * NTHR + F.tid; q < MLAT * 64; q += F.G * NTHR) {
        const int row = q >> 6, j = (q & 63) * 4, pg = 32 * (j >> 4) + (j & 15);
        f32x4 gv = {0.f, 0.f, 0.f, 0.f}, uv = gv;
#pragma unroll
        for (int ks = 0; ks < 4; ++ks) { const float* p = SGP + ((size_t)ks * MLAT + row) * 512 + pg; gv += *(const f32x4*)p; uv += *(const f32x4*)(p + 16); }
        u32x2 w; w.x = pk2h(silu_f(gv[0]) * uv[0], silu_f(gv[1]) * uv[1]); w.y = pk2h(silu_f(gv[2]) * uv[2], silu_f(gv[3]) * uv[3]);
        *(u32x2*)(ACTS + (size_t)row * DEXP + j) = w;
    }
}
struct EpiYsh {
    h16* YSH;
    __device__ __forceinline__ void operator()(f32x4 (&acc)[2][2][4][2], const pg8::Unit& u, int wr, int wc, int fr, int fq) const {
#pragma unroll
        for (int ai = 0; ai < 2; ++ai)
#pragma unroll
            for (int m = 0; m < 4; ++m) { const int row = u.pm * 256 + ai * 128 + wr * 64 + m * 16 + fr;
#pragma unroll
                for (int bj = 0; bj < 2; ++bj)
#pragma unroll
                    for (int n = 0; n < 2; ++n) { const int col = u.pn * 256 + bj * 128 + wc * 32 + 16 * n + 4 * fq; const f32x4 a = acc[ai][bj][m][n];
                        u32x2 w; w.x = pk2h(a[0], a[1]); w.y = pk2h(a[2], a[3]); *(u32x2*)(YSH + (size_t)row * DM + col) = w; } }
    }
};
struct SchedOne {
    int pm, pn;
    __device__ __forceinline__ bool next(int i, pg8::Unit& u) const { if (i != 0) return false; u.pm = pm; u.pn = pn; u.ko = 0; u.nt = 0; u.keep = 0; return true; }
};
__device__ __forceinline__ void p15_shared_down_dyn(Frame& F, int qid) {
    unsigned* QH = (unsigned*)(F.ws + WS_CTL) + CW_Q + 64 * 8 * qid;
    LAS int* RED = (LAS int*)(F.lds + EX_ROW0 + 3072);
    for (;;) {
        __syncthreads();
        if (F.tid == 0) RED[0] = (int)__hip_atomic_fetch_add(QH, 1u, __ATOMIC_RELAXED, __HIP_MEMORY_SCOPE_AGENT);
        __syncthreads();
        const int t = RED[0];
        if (t >= 256) break;
        pg8::Gemm g{(const h16*)(F.ws + WS_ACTS), (const h16*)(F.ws + WS_WSDN), 256, 256, 256};
        SchedOne S; S.pm = t >> 3; S.pn = t & 7;
        EpiYsh E{(h16*)(F.ws + WS_YSH)};
        pg8::gemm_phase<EpiYsh, SchedOne>(F.lds, g, S, E);
    }
}
__device__ __forceinline__ void p15_shared_down(Frame& F) {
    pg8::Gemm g{(const h16*)(F.ws + WS_ACTS), (const h16*)(F.ws + WS_WSDN), 256, 256, 256};
    pg8::StaticOrder S; S.init(MLAT, DM, F.G, (int)blockIdx.x);
    EpiYsh E{(h16*)(F.ws + WS_YSH)};
    pg8::gemm_phase<EpiYsh, pg8::StaticOrder>(F.lds, g, S, E);
}
__device__ __forceinline__ void p16_combine(Frame& F) {
    const float* X1 = (const float*)(F.ws + WS_X1); const float* MOD = (const float*)(F.ws + WS_MOD); const h16* Y = (const h16*)(F.ws + WS_Y); const h16* YSH = (const h16*)(F.ws + WS_YSH);
    const int gw = F.vcu * NWAVES + F.wave, NGW = F.G * NWAVES;
    for (int r = gw; r < MLAT; r += NGW) {
        const int b = r / SEQ;
        f32x4 xv[8]; float ss = 0.f;
#pragma unroll
        for (int j = 0; j < 8; ++j) { const int cc = 4 * F.lane + 256 * j;
            f32x4 m = {0.f, 0.f, 0.f, 0.f};
#pragma unroll
            for (int k = 0; k < TOPK; ++k) { const int yv = *(const int*)((const unsigned char*)Y + (size_t)(r * TOPK + k) * DM + cc);
                const f32x2 lo = __builtin_amdgcn_cvt_pk_f32_fp8(yv, false), hi2 = __builtin_amdgcn_cvt_pk_f32_fp8(yv, true); m += (f32x4){lo[0], lo[1], hi2[0], hi2[1]}; }
            { const h16x4 yv = *(const h16x4*)(YSH + (size_t)r * DM + cc); m += (f32x4){(float)yv[0], (float)yv[1], (float)yv[2], (float)yv[3]}; }
            const f32x4 g2 = *(const f32x4*)(MOD + (size_t)b * (6 * DM) + 5 * DM + cc);
            xv[j] = *(const f32x4*)(X1 + (size_t)r * DM + cc) + g2 * m;
            ss += (xv[j].x * xv[j].x + xv[j].y * xv[j].y) + (xv[j].z * xv[j].z + xv[j].w * xv[j].w); }
        const float rstd = 1.0f / sqrtf(wave_sum(ss) * (1.0f / DM) + EPS);
#pragma unroll
        for (int j = 0; j < 8; ++j) { const int cc = 4 * F.lane + 256 * j; const f32x4 nw = *(const f32x4*)(F.final_norm + cc);
            *(f32x4*)(F.out + (size_t)r * DM + cc) = xv[j] * rstd * nw; }
    }
}

__device__ __forceinline__ void p_final_plain(Frame& F, const float* xin) {
    const int gw = F.vcu * NWAVES + F.wave, NGW = F.G * NWAVES;
    for (int r = gw; r < MLAT; r += NGW) {
        const float* src = xin + (size_t)r * DM;
        f32x4 xv[8]; float ss = 0.f;
#pragma unroll
        for (int j = 0; j < 8; ++j) { xv[j] = *(const f32x4*)(src + 4 * F.lane + 256 * j); ss += (xv[j].x * xv[j].x + xv[j].y * xv[j].y) + (xv[j].z * xv[j].z + xv[j].w * xv[j].w); }
        const float rstd = 1.0f / sqrtf(wave_sum(ss) * (1.0f / DM) + EPS);
#pragma unroll
        for (int j = 0; j < 8; ++j) { const int cc = 4 * F.lane + 256 * j; const f32x4 nw = *(const f32x4*)(F.final_norm + cc);
            *(f32x4*)(F.out + (size_t)r * DM + cc) = xv[j] * rstd * nw; }
    }
}

constexpr int N_PHASES = 15;
#ifndef DUP_PHASE
#define DUP_PHASE -1
#endif
#ifndef DUP_VAR
#define DUP_VAR 7
#endif
struct Args { const float* in[22]; float* out; unsigned char* ws; int ph_lo, ph_hi; };
__global__ void __launch_bounds__(NTHR, 2) mk_fwd(Args args) {
    extern __shared__ __attribute__((aligned(16))) unsigned char lds_raw[];
    Frame F;
    F.lds = (LAS unsigned char*)lds_raw;
    F.tid = threadIdx.x; F.lane = F.tid & 63; F.wave = __builtin_amdgcn_readfirstlane(F.tid >> 6);
    F.G = gridDim.x; { const int bx = blockIdx.x; F.vcu = (F.G % 8 == 0) ? (bx % 8) * (F.G / 8) + bx / 8 : bx; }
    F.x = args.in[0]; F.c = args.in[1]; F.ctx = args.in[2]; F.c_ctx = args.in[3]; F.w_mod = args.in[4]; F.b_mod = args.in[5]; F.norm_attn = args.in[6]; F.norm_ffn = args.in[7];
    F.w_in = args.in[8]; F.ret_decay = args.in[9]; F.diff_lambda = args.in[10]; F.diff_subln = args.in[11]; F.w_ret_o = args.in[12]; F.w_diff_o = args.in[13]; F.w_out = args.in[14];
    F.w_router = args.in[15]; F.router_bias = args.in[16]; F.w_exp_gu = args.in[17]; F.w_exp_down = args.in[18]; F.w_sh_gu = args.in[19]; F.w_sh_down = args.in[20]; F.final_norm = args.in[21];
    F.out = args.out; F.ws = args.ws;
    volatile LAS unsigned* MISC = (volatile LAS unsigned*)(F.lds + LDSCTL_OFF);
    for (int u = F.tid; u < (LDS_BYTES - LDSCTL_OFF) / 4; u += NTHR) ((LAS unsigned*)(F.lds + LDSCTL_OFF))[u] = 0u;
    __syncthreads();
    const int lo = args.ph_lo, hi = args.ph_hi;
    const bool multi = (hi - lo) > 1;
    XcdBarrier bar; bar.bar = (unsigned*)(F.ws + WS_CTL) + CW_BAR; bar.x = 0; bar.st = nullptr;
    if (multi) bar = xcd_barrier_post((unsigned*)(F.ws + WS_CTL) + CW_BAR, MISC + 8);
#define IN(k) (lo <= (k) && (k) < hi)
#define SEAM(k) do { if (IN(k) && IN((k) + 1)) xcd_barrier(bar); } while (0)

#define RUNP(k, call) do { if (IN(k)) { call; if (DUP_PHASE == (k)) { xcd_barrier(bar); call; } } SEAM(k); } while (0)
    RUNP(0, p0a_mod(F));
    RUNP(1, (p1_norm1(F), p0b_weights(F)));
    RUNP(2, (p2_gemm1(F), p0c_weights_dyn(F, 5)));
    RUNP(3, p3_ret_local(F));
    RUNP(4, p4_ret_scan(F));
    RUNP(5, p5_ret_out(F));
    RUNP(6, p6_attn(F));
    RUNP(7, p7_gemm2(F));
    RUNP(8, p9_gemm3(F));
    RUNP(9, p10_norm2(F));
    RUNP(10, (p11_router(F), p11b_shared_gu(F)));
    RUNP(11, (p12_topk(F), p12b_shared_act(F)));
    if (IN(12)) { p13_expert_phase<true>(F, 0); p15_shared_down_dyn(F, 4); if (DUP_PHASE == 12) { xcd_barrier(bar); p13_expert_phase<true>(F, 2); } } SEAM(12);
    if (IN(13)) { p13_expert_phase<false>(F, 1); if (DUP_PHASE == 13) { xcd_barrier(bar); p13_expert_phase<false>(F, 3); } } SEAM(13);
    if (IN(14)) { p16_combine(F); }
#undef RUNP
#undef IN
#undef SEAM
}

constexpr bool ONE_LAUNCH = true;
extern "C" void kernel_launch(void* const* d_in, const int* in_sizes, int n_in, void* d_out, int out_size, void* d_ws, size_t ws_size, hipStream_t stream) {
    static int grid = 0;
    if (grid == 0) {
        if (n_in != 22 || out_size != MLAT * DM || ws_size < WS_END) { fprintf(stderr, "kernel_launch: unexpected sizes n_in %d out %d ws %zu\n", n_in, out_size, ws_size); grid = -1; return; }
        int dev = 0, cus = 0;
        if (hipGetDevice(&dev) != hipSuccess || hipDeviceGetAttribute(&cus, hipDeviceAttributeMultiprocessorCount, dev) != hipSuccess) { grid = -1; return; }
        if (hipFuncSetAttribute((const void*)mk_fwd, hipFuncAttributeMaxDynamicSharedMemorySize, LDS_BYTES) != hipSuccess) { fprintf(stderr, "kernel_launch: hipFuncSetAttribute failed\n"); grid = -1; return; }
        int per_cu = 0;
        if (hipOccupancyMaxActiveBlocksPerMultiprocessor(&per_cu, (const void*)mk_fwd, NTHR, LDS_BYTES) != hipSuccess || per_cu < 1) fprintf(stderr, "kernel_launch: occupancy query reports %d\n", per_cu);
        (void)hipGetLastError();
        grid = cus;
    }
    if (grid < 0) return;
    (void)hipMemsetAsync((char*)d_ws + WS_CTL, 0, CTL_ZERO_BYTES, stream);
    Args a{};
    for (int i = 0; i < 22; ++i) a.in[i] = (const float*)d_in[i];
    a.out = (float*)d_out; a.ws = (unsigned char*)d_ws;
    if (ONE_LAUNCH) {
        a.ph_lo = 0; a.ph_hi = N_PHASES;
        hipLaunchKernelGGL(mk_fwd, dim3(grid), dim3(NTHR), LDS_BYTES, stream, a);
    } else {
        for (int p = 0; p < N_PHASES; ++p) { a.ph_lo = p; a.ph_hi = p + 1; hipLaunchKernelGGL(mk_fwd, dim3(grid), dim3(NTHR), LDS_BYTES, stream, a); }
    }
}
```

```cpp
#include <hip/hip_runtime.h>
#include <cstdio>
#include <cstdint>

#define LAS __attribute__((address_space(3)))
#define GAS __attribute__((address_space(1)))
typedef _Float16 h16;
typedef _Float16 h16x8 __attribute__((ext_vector_type(8)));
typedef _Float16 h16x4 __attribute__((ext_vector_type(4)));
typedef _Float16 h16x2 __attribute__((ext_vector_type(2)));
typedef float f32x2 __attribute__((ext_vector_type(2)));
typedef float f32x4 __attribute__((ext_vector_type(4)));
typedef float f32x16 __attribute__((ext_vector_type(16)));
typedef unsigned u32x4 __attribute__((ext_vector_type(4)));
typedef unsigned u32x2 __attribute__((ext_vector_type(2)));
typedef short v4i16_t __attribute__((ext_vector_type(4)));

constexpr int DM = 2048, NBATCH = 2, SEQ = 4096, CTXL = 256;
constexpr int MLAT = NBATCH * SEQ, MCTX = NBATCH * CTXL, MALL = MLAT + MCTX;
constexpr int IN_COLS = 13312, KV_COLS = 5120;
constexpr int C_RK = 0, C_RV = 1024, C_DK = 3072, C_DV = 4096, C_RQ = 5120, C_RG = 6144, C_DQ = 8192, C_GR = 9216, C_GD = 11264;
constexpr int NEXP = 256, TOPK = 8, DEXP = 256;
constexpr float EPS = 1e-6f;
constexpr int NWAVES = 8, NTHR = 512;

constexpr size_t MiB = 1u << 20;
constexpr size_t WS_CTL = 0, CTL_ZERO_BYTES = 1 * MiB;
constexpr size_t WS_MODP = 1 * MiB;
constexpr size_t WS_MOD = 3 * MiB;
constexpr size_t WS_ROPE = 3 * MiB + 512 * 1024;
constexpr size_t WS_WINT = 4 * MiB;
constexpr size_t WS_WRET = 56 * MiB;
constexpr size_t WS_WDIF = 64 * MiB;
constexpr size_t WS_WOUT = 68 * MiB;
constexpr size_t WS_WSGU = 76 * MiB;
constexpr size_t WS_WSDN = 78 * MiB;
constexpr size_t WS_WRTR = 79 * MiB;
constexpr size_t WS_H = 82 * MiB;
constexpr size_t WS_P = 116 * MiB;
constexpr size_t WS_LST = 340 * MiB;
constexpr size_t WS_SST = 408 * MiB;
constexpr size_t WS_ARET = 472 * MiB;
constexpr size_t WS_ADIF = 504 * MiB;
constexpr size_t WS_T = 520 * MiB;
constexpr size_t WS_U = 584 * MiB;
constexpr size_t WS_X1 = 616 * MiB;
constexpr size_t WS_H2X = 680 * MiB;
constexpr size_t WS_LG = 776 * MiB;
constexpr size_t WS_EIDX = 784 * MiB;
constexpr size_t WS_EW = 785 * MiB;
constexpr size_t WS_LIST = 786 * MiB;
constexpr size_t WS_ACTS = 794 * MiB;
constexpr size_t WS_YSH = 798 * MiB;
constexpr size_t WS_Y = 830 * MiB;
constexpr size_t WS_ACT = 1086 * MiB;
constexpr size_t WS_LGP = 1118 * MiB;
constexpr size_t WS_SGP = 1182 * MiB;
constexpr size_t WS_ACAT = 1246 * MiB;
constexpr size_t WS_WCAT = 1294 * MiB;
constexpr size_t WS_LIST2 = 1306 * MiB;
constexpr size_t WS_H2F8 = 1322 * MiB;
constexpr size_t WS_ACT8 = 1338 * MiB;
constexpr size_t WS_END = 1354 * MiB;

constexpr int CW_BAR = 4096;
constexpr int CW_CNT = 16384;
constexpr int CW_Q = 20480;

constexpr int RING_BYTES = 131072;
constexpr int LDS_BYTES = 163840;
constexpr int LDSCTL_OFF = LDS_BYTES - 512;
constexpr int LDS_TICKET = 146432;

#define XB_TMO      128
#define XB_XCNT(j)  (256  + 64 * (j))
#define XB_XSUB(j)  (1280 + 64 * (j))
#define XB_XGEN(j)  (2304 + 64 * (j))
#define XB_TOP      3328
#define XB_TOPGEN   3392
#define XCD_BAR_WORDS 3456
#define XB_SPIN_CAP (1u << 18)

__device__ __forceinline__ unsigned xb_ld(unsigned* p)              { return __hip_atomic_load(p, __ATOMIC_RELAXED, __HIP_MEMORY_SCOPE_AGENT); }
__device__ __forceinline__ unsigned xb_add(unsigned* p, unsigned v) { return __hip_atomic_fetch_add(p, v, __ATOMIC_RELAXED, __HIP_MEMORY_SCOPE_AGENT); }
__device__ __forceinline__ unsigned xb_xcc_id() { return (unsigned)__builtin_amdgcn_s_getreg((3 << 11) | 20) & 0xFu; }
#define XB_SPIN(cond, bar) do { unsigned _sp = 0; while (cond) { __builtin_amdgcn_s_sleep(1); \
    if ((++_sp & 255u) == 0u) { if (xb_ld(&(bar)[XB_TMO])) break; if (_sp > XB_SPIN_CAP) { atomicAdd(&(bar)[XB_TMO], 1u); break; } } } } while (0)

struct XcdBarrier { unsigned* bar; unsigned x; volatile LAS unsigned* st; };

__device__ __forceinline__ XcdBarrier xcd_barrier_post(unsigned* bar, volatile LAS unsigned* st) {
    XcdBarrier b; b.bar = bar; b.x = xb_xcc_id(); b.st = st;
    if (threadIdx.x == 0) (void)xb_add(&bar[XB_XCNT(b.x)], 1u);
    return b;
}
__device__ __forceinline__ void xcd_barrier_complete(unsigned* bar, unsigned x, unsigned& nloc, unsigned& nx) {
    const unsigned G = gridDim.x * gridDim.y * gridDim.z;
    unsigned sum, cnt, mine, sp = 0u;
    for (;;) {
        sum = 0u; cnt = 0u; mine = 0u;
#pragma unroll
        for (unsigned j = 0; j < 16; ++j) { const unsigned c = xb_ld(&bar[XB_XCNT(j)]); sum += c; cnt += (c > 0u) ? 1u : 0u; mine = (j == x) ? c : mine; }
        if (sum == G) break;
        __builtin_amdgcn_s_sleep(1);
        if ((++sp & 255u) == 0u) { if (xb_ld(&bar[XB_TMO])) break; if (sp > XB_SPIN_CAP) { atomicAdd(&bar[XB_TMO], 1u); break; } }
    }
    nloc = mine > 0u ? mine : 1u; nx = cnt > 0u ? cnt : 1u;
}
__device__ __forceinline__ void xcd_barrier(const XcdBarrier& b) {
    asm volatile("s_waitcnt vmcnt(0)" ::: "memory");
    __syncthreads();
    if (threadIdx.x == 0) {
        unsigned* bar = b.bar;
        __builtin_amdgcn_s_waitcnt(0);
        unsigned nloc = b.st[0], nx = b.st[1];
        if (nloc == 0u) { xcd_barrier_complete(bar, b.x, nloc, nx); b.st[0] = nloc; b.st[1] = nx; }
        const unsigned old = xb_add(&bar[XB_XSUB(b.x)], 1u);
        const unsigned gen = old / nloc;
        if (old + 1u == (gen + 1u) * nloc) {
            __builtin_amdgcn_fence(__ATOMIC_RELEASE, "agent");
            asm volatile("s_waitcnt vmcnt(0)" ::: "memory");
            const unsigned og = xb_add(&bar[XB_TOP], 1u);
            const unsigned tg = og / nx;
            if (og + 1u == (tg + 1u) * nx) xb_add(&bar[XB_TOPGEN], 1u);
            else XB_SPIN(xb_ld(&bar[XB_TOPGEN]) == tg, bar);
            __builtin_amdgcn_fence(__ATOMIC_ACQUIRE, "agent");
            xb_add(&bar[XB_XGEN(b.x)], 1u);
            asm volatile("s_waitcnt vmcnt(0)" ::: "memory");
        } else {
            XB_SPIN(xb_ld(&bar[XB_XGEN(b.x)]) == gen, bar);
            __builtin_amdgcn_fence(__ATOMIC_ACQUIRE, "agent");
            asm volatile("s_waitcnt vmcnt(0)" ::: "memory");
        }
    }
    __syncthreads();
}


namespace pg8 {
constexpr int BM = 256, BK = 64, HALF = 128, HTB = HALF * BK * 2, STAGE_BYTES = 8 * HTB, NXCD = 8, WGM = 8;
__host__ __device__ __forceinline__ int lds_byte(int r, int c) { const int st = (r >> 4) * 2 + (c >> 5), rr = r & 15, cc = c & 31, ob = rr * 64 + cc * 2; return st * 1024 + (ob ^ (((ob >> 9) & 1) << 5)); }
__host__ __device__ __forceinline__ void stage_rc(int b, int& R, int& C) { const int st = b / 1024, sb = b % 1024, swz = sb ^ (((sb >> 9) & 1) << 5); R = (st >> 1) * 16 + swz / 64; C = (st & 1) * 32 + (swz % 64) / 2; }
struct Unit { int pm, pn, ko, nt, keep; };
struct Gemm { const h16* A; const h16* Bt; int lda, ldb, K; };
struct StaticOrder {
    int nM, nN, nwg, G, c;
    __host__ __device__ void init(int M, int N, int G_, int c_) { nM = M / BM; nN = N / BM; nwg = nM * nN; G = G_; c = c_; }
    __host__ __device__ bool next(int i, Unit& u) const {
        const long L = (long)i * G + c; if (L >= nwg) return false;
        int wgid = (int)L; { const int q = nwg / NXCD, r = nwg % NXCD, xcd = wgid % NXCD, off = wgid / NXCD; wgid = (xcd < r ? xcd * (q + 1) : r * (q + 1) + (xcd - r) * q) + off; }
        const int nig = WGM * nN, gid = wgid / nig, fm = gid * WGM, gsz = (nM - fm) < WGM ? (nM - fm) : WGM;
        u.pm = fm + ((wgid % nig) % gsz); u.pn = (wgid % nig) / gsz; u.ko = 0; u.nt = 0; u.keep = 0; return true;
    }
};
template <class Epi, class Sched, bool ALIGN_EPI = true>
__device__ __forceinline__ void gemm_phase(LAS unsigned char* lds, const Gemm g, const Sched& S, const Epi& E) {
    const int tid = threadIdx.x, wid = __builtin_amdgcn_readfirstlane(tid >> 6), lane = tid & 63, wr = wid >> 2, wc = wid & 3, fr = lane & 15, fq = lane >> 4;
    const int nt0 = g.K / BK;
    unsigned voffA[2], voffB[2];
#pragma unroll
    for (int i = 0; i < 2; ++i) { int R, C; stage_rc(tid * 16 + i * 8192, R, C); voffA[i] = (unsigned)(R * g.lda + C) * 2u; voffB[i] = (unsigned)(R * g.ldb + C) * 2u; }
    const size_t kstep = (size_t)(BK * 2);
    const size_t hstepA = (size_t)HALF * g.lda * 2, hstepB = (size_t)HALF * g.ldb * 2;
    const size_t tstepA = 2 * hstepA, tstepB = 2 * hstepB;
    const unsigned ldsw = (unsigned)wid * 1024u;
    const int aoff = lds_byte(wr * 64 + fr, fq * 8), boff = lds_byte(wc * 32 + fr, fq * 8);
#define PG8_SA(b, h) (((b) * 2 + (h)) * HTB)
#define PG8_SB(b, h) ((4 + (b) * 2 + (h)) * HTB)
#define PG8_STAGE(bufoff, gbase, voff) do { _Pragma("unroll") for (int _i = 0; _i < 2; ++_i) \
        __builtin_amdgcn_global_load_lds((const unsigned*)((const char*)(gbase) + (voff)[_i]), (LAS unsigned*)(lds + (bufoff) + ldsw + _i * 8192), 16, 0, 0); } while (0)
#define PG8_LDA(dst, b, h) do { _Pragma("unroll") for (int m = 0; m < 4; ++m) _Pragma("unroll") for (int k = 0; k < 2; ++k) dst[m][k] = *(const LAS h16x8*)(lds + PG8_SA(b, h) + aoff + m * 2048 + k * 1024); } while (0)
#define PG8_LDB(dst, b, h) do { _Pragma("unroll") for (int n = 0; n < 2; ++n) _Pragma("unroll") for (int k = 0; k < 2; ++k) dst[n][k] = *(const LAS h16x8*)(lds + PG8_SB(b, h) + boff + n * 2048 + k * 1024); } while (0)
#define PG8_MMA(ai, bj, At, Bt) do { __builtin_amdgcn_s_setprio(1); _Pragma("unroll") for (int m = 0; m < 4; ++m) _Pragma("unroll") for (int n = 0; n < 2; ++n) _Pragma("unroll") for (int k = 0; k < 2; ++k) \
        acc[ai][bj][m][n] = __builtin_amdgcn_mfma_f32_16x16x32_f16(Bt[n][k], At[m][k], acc[ai][bj][m][n], 0, 0, 0); __builtin_amdgcn_s_setprio(0); } while (0)
#define PG8_WAIT_V(n) asm volatile("s_waitcnt vmcnt(" #n ")" ::: "memory")
#define PG8_WAIT_L(n) asm volatile("s_waitcnt lgkmcnt(" #n ")" ::: "memory")
#define PG8_BAR __builtin_amdgcn_s_barrier()
#define PG8_SCHED __builtin_amdgcn_sched_barrier(0)
    Unit cur, nxt; int ui = 0;
    if (!S.next(0, cur)) return;
    f32x4 acc[2][2][4][2];
#pragma unroll
    for (int a = 0; a < 2; ++a)
#pragma unroll
        for (int b = 0; b < 2; ++b)
#pragma unroll
            for (int m = 0; m < 4; ++m)
#pragma unroll
                for (int n = 0; n < 2; ++n) acc[a][b][m][n] = (f32x4){0.f, 0.f, 0.f, 0.f};
    h16x8 At[4][2], B0[2][2], B1[2][2];
    const char* cA = (const char*)g.A + (size_t)cur.pm * tstepA + (size_t)cur.ko * 2; const char* cB = (const char*)g.Bt + (size_t)cur.pn * tstepB + (size_t)cur.ko * 2;
    {
        PG8_STAGE(PG8_SB(0, 0), cB, voffB); PG8_STAGE(PG8_SB(0, 1), cB + hstepB, voffB); PG8_STAGE(PG8_SA(0, 0), cA, voffA); PG8_STAGE(PG8_SA(0, 1), cA + hstepA, voffA);
        if (wr == 1) PG8_BAR;
        PG8_WAIT_V(2); PG8_BAR;
        PG8_STAGE(PG8_SB(1, 0), cB + kstep, voffB); PG8_STAGE(PG8_SA(1, 0), cA + kstep, voffA); PG8_STAGE(PG8_SB(1, 1), cB + hstepB + kstep, voffB);
        PG8_WAIT_V(6); PG8_BAR;
    }
    for (;;) {
        const bool has_next = S.next(ui + 1, nxt);
        const char* nA = has_next ? (const char*)g.A + (size_t)nxt.pm * tstepA + (size_t)nxt.ko * 2 : cA; const char* nB = has_next ? (const char*)g.Bt + (size_t)nxt.pn * tstepB + (size_t)nxt.ko * 2 : cB;
        int nt = cur.nt ? cur.nt : nt0; asm volatile("" : "+s"(nt));
        for (int t = 0; t < nt; t += 2) {
            const bool last = (t == nt - 2);
            const char* a1 = cA + (size_t)(t + 1) * kstep;
            const char* a2 = last ? nA : cA + (size_t)(t + 2) * kstep; const char* b2 = last ? nB : cB + (size_t)(t + 2) * kstep;
            const char* a3 = a2 + kstep; const char* b3 = b2 + kstep;
            PG8_LDB(B0, 0, 0); PG8_LDB(B1, 0, 1); PG8_SCHED; PG8_LDA(At, 0, 0); PG8_STAGE(PG8_SA(1, 1), a1 + hstepA, voffA);
            PG8_WAIT_V(8); PG8_WAIT_L(0); PG8_BAR; PG8_MMA(0, 0, At, B0); PG8_MMA(0, 1, At, B1); PG8_BAR; PG8_SCHED;
            PG8_LDA(At, 0, 1); PG8_STAGE(PG8_SB(0, 0), b2, voffB); PG8_STAGE(PG8_SB(0, 1), b2 + hstepB, voffB); PG8_STAGE(PG8_SA(0, 0), a2, voffA);
            PG8_WAIT_V(8); PG8_WAIT_L(0); PG8_BAR; PG8_MMA(1, 0, At, B0); PG8_MMA(1, 1, At, B1); PG8_BAR; PG8_SCHED;
            PG8_LDB(B0, 1, 0); PG8_LDB(B1, 1, 1); PG8_SCHED; PG8_LDA(At, 1, 0); PG8_STAGE(PG8_SA(0, 1), a2 + hstepA, voffA);
            PG8_WAIT_V(8); PG8_WAIT_L(0); PG8_BAR; PG8_MMA(0, 0, At, B0); PG8_MMA(0, 1, At, B1); PG8_BAR; PG8_SCHED;
            PG8_LDA(At, 1, 1); PG8_STAGE(PG8_SB(1, 0), b3, voffB); PG8_STAGE(PG8_SB(1, 1), b3 + hstepB, voffB); PG8_STAGE(PG8_SA(1, 0), a3, voffA);
            PG8_WAIT_V(8); PG8_WAIT_L(0); PG8_BAR; PG8_MMA(1, 0, At, B0); PG8_MMA(1, 1, At, B1); PG8_BAR; PG8_SCHED;
        }
        if constexpr (ALIGN_EPI) { if (wr == 0) PG8_BAR; }
        E(acc, cur, wr, wc, fr, fq);
        if (!has_next) break;
        if (!cur.keep) {
#pragma unroll
        for (int a = 0; a < 2; ++a)
#pragma unroll
            for (int b = 0; b < 2; ++b)
#pragma unroll
                for (int m = 0; m < 4; ++m)
#pragma unroll
                    for (int n = 0; n < 2; ++n) acc[a][b][m][n] = (f32x4){0.f, 0.f, 0.f, 0.f};
        }
        cur = nxt; cA = nA; cB = nB; ++ui;
        if constexpr (ALIGN_EPI) { if (wr == 1) PG8_BAR; }
    }
    PG8_WAIT_V(0);
    if constexpr (!ALIGN_EPI) { if (wr == 0) PG8_BAR; }
    PG8_BAR;
#undef PG8_SA
#undef PG8_SB
#undef PG8_STAGE
#undef PG8_LDA
#undef PG8_LDB
#undef PG8_MMA
#undef PG8_WAIT_V
#undef PG8_WAIT_L
#undef PG8_BAR
#undef PG8_SCHED
}
}

struct Frame {
    LAS unsigned char* lds;
    int tid, lane, wave, vcu, G;
    const float *x, *c, *ctx, *c_ctx, *w_mod, *b_mod, *norm_attn, *norm_ffn, *w_in, *ret_decay, *diff_lambda, *diff_subln,
                *w_ret_o, *w_diff_o, *w_out, *w_router, *router_bias, *w_exp_gu, *w_exp_down, *w_sh_gu, *w_sh_down, *final_norm;
    float* out;
    unsigned char* ws;
};

__device__ __forceinline__ float wave_sum(float v) {
#pragma unroll
    for (int o = 1; o < 64; o <<= 1) v += __shfl_xor(v, o);
    return v;
}
__device__ __forceinline__ unsigned pk2h(float lo, float hi) { f32x2 v = {lo, hi}; h16x2 h = __builtin_convertvector(v, h16x2); return __builtin_bit_cast(unsigned, h); }
__device__ __forceinline__ float silu_f(float v) { return v / (1.0f + __expf(-v)); }
__device__ __forceinline__ float sigmoid_f(float v) { return 1.0f / (1.0f + __expf(-v)); }

__device__ __forceinline__ void p0_mod_unit(Frame& F, int unit) {
    const int cb = unit % 24, ks = unit / 24;
    LAS float* sv = (LAS float*)F.lds;
    LAS float* red = sv + 768;
    for (int i = F.tid; i < 768; i += NTHR) { const int v = i >> 8, k = i & 255; const float cv = (v < 2) ? F.c[v * DM + ks * 256 + k] : F.c_ctx[ks * 256 + k]; sv[i] = silu_f(cv); }
    __syncthreads();
    const int cl = F.tid & 127, rl = F.tid >> 7;
    const float* wp = F.w_mod + (size_t)(ks * 256 + rl) * (6 * DM) + cb * 512 + cl * 4;
    f32x4 a0 = {0.f, 0.f, 0.f, 0.f}, a1 = a0, a2 = a0;
#pragma unroll 8
    for (int i = 0; i < 64; ++i) { const f32x4 w = *(const f32x4*)(wp + (size_t)i * 4 * (6 * DM)); const int k = rl + 4 * i; a0 += w * sv[k]; a1 += w * sv[256 + k]; a2 += w * sv[512 + k]; }
    *(LAS f32x4*)(red + (rl * 3 + 0) * 512 + cl * 4) = a0; *(LAS f32x4*)(red + (rl * 3 + 1) * 512 + cl * 4) = a1; *(LAS f32x4*)(red + (rl * 3 + 2) * 512 + cl * 4) = a2;
    __syncthreads();
    float* modp = (float*)(F.ws + WS_MODP);
    for (int i = F.tid; i < 1536; i += NTHR) { const int v = i >> 9, cc = i & 511; const float s = (red[(0 * 3 + v) * 512 + cc] + red[(1 * 3 + v) * 512 + cc]) + (red[(2 * 3 + v) * 512 + cc] + red[(3 * 3 + v) * 512 + cc]);
        modp[(size_t)(ks * 3 + v) * (6 * DM) + cb * 512 + cc] = s; }
    __syncthreads();
}
template <int MAP>
__device__ __forceinline__ void p0_transpose_item(const float* W, int K, int N, h16* WT, LAS float* scr, int item, int lane, int ldd = 0) {
    if (ldd == 0) ldd = K;
    const int nblk = N / 32, kb = item / nblk, nb = item % nblk, k0 = 64 * kb, n0 = 32 * nb;
#pragma unroll 8
    for (int i = 0; i < 32; ++i) { const int kk = 2 * i + (lane >> 5); scr[kk * 33 + (lane & 31)] = W[(size_t)(k0 + kk) * N + n0 + (lane & 31)]; }
    asm volatile("s_waitcnt lgkmcnt(0)" ::: "memory");
    const int cch = lane & 7;
#pragma unroll
    for (int j = 0; j < 4; ++j) { const int n = (lane >> 3) + 8 * j; const LAS float* s = scr + (8 * cch) * 33 + n;
        u32x4 o; o.x = pk2h(s[0 * 33], s[1 * 33]); o.y = pk2h(s[2 * 33], s[3 * 33]); o.z = pk2h(s[4 * 33], s[5 * 33]); o.w = pk2h(s[6 * 33], s[7 * 33]);
        int nn = n0 + n;
        if (MAP == 1) { const bool isrope = (nn < 1024) || (nn >= C_RQ && nn < C_RQ + 1024); if (isrope) nn = (nn & ~48) | ((nn & 16) << 1) | ((nn & 32) >> 1); }
        if (MAP == 2) { const int j = nn & 255, isu = nn >> 8; nn = 32 * (j >> 4) + 16 * isu + (j & 15); }
        *(u32x4*)(WT + (size_t)nn * ldd + k0 + 8 * cch) = o; }
    asm volatile("s_waitcnt lgkmcnt(0)" ::: "memory");
}
__device__ __forceinline__ void p0a_mod(Frame& F) {
    for (int u = F.vcu; u < 192; u += F.G) p0_mod_unit(F, u);
}
__device__ __forceinline__ void p0b_weights(Frame& F) {
    __syncthreads();
    LAS float* scr = (LAS float*)(F.lds + F.wave * 16384);
    const int gw = F.vcu * NWAVES + F.wave, NGW = F.G * NWAVES;
    constexpr int I_IN = (DM / 64) * (IN_COLS / 32);
    for (int it = gw; it < I_IN; it += NGW) p0_transpose_item<1>(F.w_in, DM, IN_COLS, (h16*)(F.ws + WS_WINT), scr, it, F.lane);
    if (blockIdx.x == 0) {
        float* rope = (float*)(F.ws + WS_ROPE);
        for (int i = F.tid; i < 64 * 32; i += NTHR) { const int pos = i >> 5, j = i & 31; const float inv = exp2f(-(float)j * (13.287712379549449f / 32.0f)); const float ang = (float)pos * inv; rope[i] = cosf(ang); rope[2048 + i] = sinf(ang); }
        for (int i = F.tid; i < 64 * 16; i += NTHR) { const int pos = i >> 4, j = i & 15; const float inv = exp2f(-(float)j * (13.287712379549449f / 16.0f)); const float ang = (float)pos * inv; rope[4096 + i] = cosf(ang); rope[4096 + 1024 + i] = sinf(ang); }
    }
}
__device__ __forceinline__ void p0c_weights_dyn(Frame& F, int qid) {
    unsigned* QH = (unsigned*)(F.ws + WS_CTL) + CW_Q + 64 * 8 * qid;
    LAS int* RED = (LAS int*)(F.lds + LDS_TICKET);
    LAS float* scr = (LAS float*)(F.lds + F.wave * 16384);
    constexpr int I_RET = (2048 / 64) * (DM / 32), I_DIF = (1024 / 64) * (DM / 32), I_OUT = (DM / 64) * (DM / 32), I_SGU = (DM / 64) * (512 / 32), I_SDN = (256 / 64) * (DM / 32), I_RT = NEXP * DM / 4 / 64;
    constexpr int NITEMS = I_RET + I_DIF + I_OUT + I_SGU + I_SDN + I_RT, NTICK = (NITEMS + 7) / 8;
    for (;;) {
        __syncthreads();
        if (F.tid == 0) RED[0] = (int)__hip_atomic_fetch_add(QH, 1u, __ATOMIC_RELAXED, __HIP_MEMORY_SCOPE_AGENT);
        __syncthreads();
        const int t = RED[0];
        if (t >= NTICK) break;
        int r = t * 8 + F.wave;
        if (r >= NITEMS) continue;
        if (r < I_RET) { p0_transpose_item<0>(F.w_ret_o, 2048, DM, (h16*)(F.ws + WS_WCAT), scr, r, F.lane, 3072); continue; } r -= I_RET;
        if (r < I_DIF) { p0_transpose_item<0>(F.w_diff_o, 1024, DM, (h16*)(F.ws + WS_WCAT) + 2048, scr, r, F.lane, 3072); continue; } r -= I_DIF;
        if (r < I_OUT) { p0_transpose_item<0>(F.w_out, DM, DM, (h16*)(F.ws + WS_WOUT), scr, r, F.lane); continue; } r -= I_OUT;
        if (r < I_SGU) { p0_transpose_item<2>(F.w_sh_gu, DM, 512, (h16*)(F.ws + WS_WSGU), scr, r, F.lane); continue; } r -= I_SGU;
        if (r < I_SDN) { p0_transpose_item<0>(F.w_sh_down, 256, DM, (h16*)(F.ws + WS_WSDN), scr, r, F.lane); continue; } r -= I_SDN;
        {
            const int q = r * 64 + F.lane, e = q / (DM / 4), k = (q % (DM / 4)) * 4;
            const f32x4 w = *(const f32x4*)(F.w_router + (size_t)e * DM + k);
            h16 hi[4], lo[4];
#pragma unroll
            for (int j = 0; j < 4; ++j) { hi[j] = (h16)w[j]; lo[j] = (h16)(w[j] - (float)hi[j]); }
            h16* dst = (h16*)(F.ws + WS_WRTR) + (size_t)e * 6144 + k;
            *(h16x4*)(dst) = (h16x4){hi[0], hi[1], hi[2], hi[3]}; *(h16x4*)(dst + 2048) = (h16x4){hi[0], hi[1], hi[2], hi[3]}; *(h16x4*)(dst + 4096) = (h16x4){lo[0], lo[1], lo[2], lo[3]};
        }
    }
}

__device__ __forceinline__ void p1_norm1(Frame& F) {
    LAS float* msh = (LAS float*)F.lds; LAS float* msc = msh + 3 * DM;
    const float* modp = (const float*)(F.ws + WS_MODP);
    for (int i = F.tid; i < 3 * 2 * DM; i += NTHR) { const int v = i / (2 * DM), cc = i % (2 * DM); float s = F.b_mod[cc];
#pragma unroll
        for (int ks = 0; ks < 8; ++ks) s += modp[(size_t)(ks * 3 + v) * (6 * DM) + cc];
        if (cc < DM) msh[v * DM + cc] = s; else msc[v * DM + cc - DM] = s; }
    __syncthreads();
    const int gw = F.vcu * NWAVES + F.wave, NGW = F.G * NWAVES;
    h16* H = (h16*)(F.ws + WS_H);
    for (int r = gw; r < MALL; r += NGW) {
        const float* src = (r < MLAT) ? F.x + (size_t)r * DM : F.ctx + (size_t)(r - MLAT) * DM; const int v = (r < MLAT) ? (r / SEQ) : 2;
        f32x4 xv[8]; float ss = 0.f;
#pragma unroll
        for (int j = 0; j < 8; ++j) { xv[j] = *(const f32x4*)(src + 4 * F.lane + 256 * j); ss += (xv[j].x * xv[j].x + xv[j].y * xv[j].y) + (xv[j].z * xv[j].z + xv[j].w * xv[j].w); }
        const float rstd = 1.0f / sqrtf(wave_sum(ss) * (1.0f / DM) + EPS);
#pragma unroll
        for (int j = 0; j < 8; ++j) { const int cc = 4 * F.lane + 256 * j; const f32x4 nw = *(const f32x4*)(F.norm_attn + cc);
            const f32x4 sc = *(LAS f32x4*)(msc + v * DM + cc), sh = *(LAS f32x4*)(msh + v * DM + cc);
            const f32x4 y = xv[j] * rstd * nw * (sc + 1.0f) + sh;
            u32x2 o; o.x = pk2h(y.x, y.y); o.y = pk2h(y.z, y.w); *(u32x2*)(H + (size_t)r * DM + cc) = o; }
    }
    float* MOD = (float*)(F.ws + WS_MOD);
    for (int i = blockIdx.x * NTHR + F.tid; i < 3 * 6 * DM; i += F.G * NTHR) { const int v = i / (6 * DM), cc = i % (6 * DM); float s = F.b_mod[cc];
#pragma unroll
        for (int ks = 0; ks < 8; ++ks) s += modp[(size_t)(ks * 3 + v) * (6 * DM) + cc];
        MOD[i] = s; }
}


__device__ __forceinline__ int crow(int r, int hi) { return (r & 3) + 8 * (r >> 2) + 4 * hi; }
__device__ __forceinline__ h16x8 frag_row(const LAS unsigned char* base, int strideB, int r0, int k0, int lane) {
    return *(const LAS h16x8*)(base + (r0 + (lane & 31)) * strideB + (k0 + 8 * (lane >> 5)) * 2);
}
__device__ __forceinline__ v4i16_t tr16(const LAS unsigned char* p) { return __builtin_amdgcn_ds_read_tr16_b64_v4i16((LAS v4i16_t*)p); }
__device__ __forceinline__ h16x8 frag_tr(const LAS unsigned char* base, int strideB, int k0, int n0, int lane) {
    const int kb = k0 + 8 * (lane >> 5) + ((lane & 15) >> 2), nc = n0 + 16 * ((lane >> 4) & 1) + 4 * (lane & 3);
    const LAS unsigned char* p = base + kb * strideB + nc * 2;
    const v4i16_t lo = tr16(p), hi = tr16(p + 4 * strideB);
    typedef short s16x8 __attribute__((ext_vector_type(8)));
    const s16x8 v = {lo[0], lo[1], lo[2], lo[3], hi[0], hi[1], hi[2], hi[3]};
    return __builtin_bit_cast(h16x8, v);
}
__device__ __forceinline__ h16x8 frag_tr_perm(const LAS unsigned char* base, int strideB, int k0, int n0, int lane) {
    const int kb = k0 + 4 * (lane >> 5) + ((lane & 15) >> 2), nc = n0 + 16 * ((lane >> 4) & 1) + 4 * (lane & 3);
    const LAS unsigned char* p = base + kb * strideB + nc * 2;
    const v4i16_t lo = tr16(p), hi = tr16(p + 8 * strideB);
    typedef short s16x8 __attribute__((ext_vector_type(8)));
    const s16x8 v = {lo[0], lo[1], lo[2], lo[3], hi[0], hi[1], hi[2], hi[3]};
    return __builtin_bit_cast(h16x8, v);
}
__device__ __forceinline__ h16x8 pack8(float a0, float a1, float a2, float a3, float a4, float a5, float a6, float a7) {
    u32x4 w; w.x = pk2h(a0, a1); w.y = pk2h(a2, a3); w.z = pk2h(a4, a5); w.w = pk2h(a6, a7); return __builtin_bit_cast(h16x8, w);
}
#define MFMA32(a, b, c) __builtin_amdgcn_mfma_f32_32x32x16_f16((a), (b), (c), 0, 0, 0)

struct SchedG1 {
    pg8::StaticOrder so; int G, c;
    __device__ __forceinline__ bool next(int i, pg8::Unit& u) const {
        const int L = i * G + c;
        if (L < 32 * 52) return so.next(i, u);
        const int r = L - 32 * 52; if (r >= 40) return false;
        u.pm = 32 + r / 20; u.pn = r % 20; u.ko = 0; u.nt = 0; u.keep = 0; return true;
    }
};
struct EpiP {
    h16* P; const float* rope;
    __device__ __forceinline__ void operator()(f32x4 (&acc)[2][2][4][2], const pg8::Unit& u, int wr, int wc, int fr, int fq) const {
        const int colt = u.pn * 256; const bool lat = u.pm < 32;
        int kind;
        if (colt < C_RV) kind = 1; else if (colt < C_DK) kind = 0; else if (colt < C_DV) kind = 3; else if (colt < C_RQ) kind = 0; else if (colt < C_RG) kind = 2; else if (colt < C_DQ) kind = 5; else if (colt < C_GR) kind = 4; else kind = 6;
        if (!lat) kind = (kind == 1) ? 7 : 0;
#pragma unroll
        for (int ai = 0; ai < 2; ++ai)
#pragma unroll
            for (int m = 0; m < 4; ++m) {
                const int row = u.pm * 256 + ai * 128 + wr * 64 + m * 16 + fr; const int t = row & (SEQ - 1);
                h16* prow = P + (size_t)row * IN_COLS;
#pragma unroll
                for (int bj = 0; bj < 2; ++bj) {
                    const int cbase = colt + bj * 128 + wc * 32;
                    const f32x4 x0 = acc[ai][bj][m][0], x1 = acc[ai][bj][m][1];
                    f32x4 o0, o1; int c0, c1;
                    if (kind == 1 || kind == 2) {
                        const int g5 = (cbase >> 5) & 1, axis = (cbase >> 6) & 1, pos = axis ? (t & 63) : (t >> 6), j0 = 16 * g5 + 4 * fq;
                        const f32x4 cs = *(const f32x4*)(rope + pos * 32 + j0), sn = *(const f32x4*)(rope + 2048 + pos * 32 + j0);
                        o0 = x0 * cs - x1 * sn; o1 = x0 * sn + x1 * cs;
                        if (kind == 2) { o0 *= 0.08838834764831845f; o1 *= 0.08838834764831845f; }
                        c0 = (cbase & ~63) + j0; c1 = c0 + 32;
                    } else if (kind == 7) {
                        const int g5 = (cbase >> 5) & 1; c0 = (cbase & ~63) + 16 * g5 + 4 * fq; c1 = c0 + 32; o0 = x0; o1 = x1;
                    } else if (kind == 3 || kind == 4) {
                        const int axis = (cbase >> 5) & 1, pos = axis ? (t & 63) : (t >> 6), j0 = 4 * fq;
                        const f32x4 cs = *(const f32x4*)(rope + 4096 + pos * 16 + j0), sn = *(const f32x4*)(rope + 5120 + pos * 16 + j0);
                        o0 = x0 * cs - x1 * sn; o1 = x0 * sn + x1 * cs;
                        if (kind == 4) { o0 *= 0.18033688011112042f; o1 *= 0.18033688011112042f; }
                        c0 = cbase + j0; c1 = c0 + 16;
                    } else {
                        c0 = cbase + 4 * fq; c1 = c0 + 16; o0 = x0; o1 = x1;
                        if (kind == 5) {
#pragma unroll
                            for (int e = 0; e < 4; ++e) { o0[e] = silu_f(x0[e]); o1[e] = silu_f(x1[e]); }
                        } else if (kind == 6) {
#pragma unroll
                            for (int e = 0; e < 4; ++e) { o0[e] = sigmoid_f(x0[e]); o1[e] = sigmoid_f(x1[e]); }
                        }
                    }
                    u32x2 w0, w1; w0.x = pk2h(o0[0], o0[1]); w0.y = pk2h(o0[2], o0[3]); w1.x = pk2h(o1[0], o1[1]); w1.y = pk2h(o1[2], o1[3]);
                    *(u32x2*)(prow + c0) = w0; *(u32x2*)(prow + c1) = w1;
                }
            }
    }
};
__device__ __forceinline__ void p2_gemm1(Frame& F) {
    pg8::Gemm g{(const h16*)(F.ws + WS_H), (const h16*)(F.ws + WS_WINT), DM, DM, DM};
    SchedG1 S; S.so.init(MLAT, IN_COLS, F.G, (int)blockIdx.x); S.G = F.G; S.c = (int)blockIdx.x;
    EpiP E{(h16*)(F.ws + WS_P), (const float*)(F.ws + WS_ROPE)};
    pg8::gemm_phase<EpiP, SchedG1>(F.lds, g, S, E);
}

__device__ __forceinline__ void p3_ret_local(Frame& F) {
    LAS unsigned char* KF = F.lds; LAS unsigned char* KB = F.lds + 40960; LAS unsigned char* VH = F.lds + 81920;
    const h16* P = (const h16*)(F.ws + WS_P); h16* LST = (h16*)(F.ws + WS_LST);
    const int hi = F.lane >> 5;
    for (int u = F.vcu; u < 16 * 34; u += F.G) {
        const int bh = u / 34, cc = u % 34, b = bh >> 3, h = bh & 7;
        const int row0 = (cc < 2) ? (MLAT + b * CTXL + cc * 128) : (b * SEQ + (cc - 2) * 128);
        const float lgf = -__expf(F.ret_decay[h]), lgb = -__expf(F.ret_decay[8 + h]);
#pragma unroll
        for (int i = 0; i < 4; ++i) { const int q = F.tid + NTHR * i, row = q >> 4, ch = q & 15;
            const h16x8 kv = *(const h16x8*)(P + (size_t)(row0 + row) * IN_COLS + C_RK + h * 128 + ch * 8);
            const float sf = __expf(lgf * (float)(127 - row)), sb = __expf(lgb * (float)row);
            *(LAS h16x8*)(KF + row * 320 + ch * 16) = pack8((float)kv[0] * sf, (float)kv[1] * sf, (float)kv[2] * sf, (float)kv[3] * sf, (float)kv[4] * sf, (float)kv[5] * sf, (float)kv[6] * sf, (float)kv[7] * sf);
            *(LAS h16x8*)(KB + row * 320 + ch * 16) = pack8((float)kv[0] * sb, (float)kv[1] * sb, (float)kv[2] * sb, (float)kv[3] * sb, (float)kv[4] * sb, (float)kv[5] * sb, (float)kv[6] * sb, (float)kv[7] * sb); }
        for (int eh = 0; eh < 2; ++eh) {
            if (eh) __syncthreads();
#pragma unroll
            for (int i = 0; i < 4; ++i) { const int q = F.tid + NTHR * i, row = q >> 4, ch = q & 15;
                *(LAS h16x8*)(VH + row * 320 + ch * 16) = *(const h16x8*)(P + (size_t)(row0 + row) * IN_COLS + C_RV + h * 256 + eh * 128 + ch * 8); }
            __syncthreads();
            const int dir = F.wave >> 2, eb = F.wave & 3; const LAS unsigned char* Kd = dir ? KB : KF;
            f32x16 acc[4];
#pragma unroll
            for (int db = 0; db < 4; ++db) acc[db] = (f32x16){};
#pragma unroll
            for (int ks = 0; ks < 8; ++ks) { const h16x8 a = frag_tr(VH, 320, 16 * ks, 32 * eb, F.lane);
#pragma unroll
                for (int db = 0; db < 4; ++db) { const h16x8 bb = frag_tr(Kd, 320, 16 * ks, 32 * db, F.lane); acc[db] = MFMA32(a, bb, acc[db]); } }
            h16* dst = LST + ((size_t)((dir * 16 + bh) * 34 + cc) * 256 + eh * 128 + eb * 32) * 128;
#pragma unroll
            for (int db = 0; db < 4; ++db)
#pragma unroll
                for (int r = 0; r < 16; ++r) dst[crow(r, hi) * 128 + db * 32 + (F.lane & 31)] = (h16)acc[db][r];
        }
        __syncthreads();
    }
}
__device__ __forceinline__ void p4_ret_scan(Frame& F) {
    const h16* LST = (const h16*)(F.ws + WS_LST); h16* SST = (h16*)(F.ws + WS_SST);
    for (int g = blockIdx.x * NTHR + F.tid; g < 2 * 16 * 4096; g += F.G * NTHR) {
        const int seq = g >> 12, off = (g & 4095) * 8, dir = seq >> 4, bh = seq & 15, h = bh & 7;
        const float cd = __expf(-__expf(F.ret_decay[dir * 8 + h]) * 128.0f);
        const h16* Lp = LST + (size_t)seq * 34 * 32768 + off; h16* Sp = SST + (size_t)seq * 32 * 32768 + off;
        float s[8];
#pragma unroll
        for (int e = 0; e < 8; ++e) s[e] = 0.f;
        if (dir == 0) {
            for (int cc = 0; cc < 33; ++cc) {
                if (cc >= 2) *(h16x8*)(Sp + (size_t)(cc - 2) * 32768) = pack8(s[0], s[1], s[2], s[3], s[4], s[5], s[6], s[7]);
                const h16x8 l = *(const h16x8*)(Lp + (size_t)cc * 32768);
#pragma unroll
                for (int e = 0; e < 8; ++e) s[e] = s[e] * cd + (float)l[e];
            }
            *(h16x8*)(Sp + (size_t)31 * 32768) = pack8(s[0], s[1], s[2], s[3], s[4], s[5], s[6], s[7]);
        } else {
            { const h16x8 l1 = *(const h16x8*)(Lp + (size_t)1 * 32768), l0 = *(const h16x8*)(Lp);
#pragma unroll
              for (int e = 0; e < 8; ++e) s[e] = (float)l1[e] * cd + (float)l0[e]; }
            for (int c = 31; c >= 0; --c) {
                *(h16x8*)(Sp + (size_t)c * 32768) = pack8(s[0], s[1], s[2], s[3], s[4], s[5], s[6], s[7]);
                const h16x8 l = *(const h16x8*)(Lp + (size_t)(c + 2) * 32768);
#pragma unroll
                for (int e = 0; e < 8; ++e) s[e] = s[e] * cd + (float)l[e];
            }
        }
    }
}
__device__ __forceinline__ void p5_ret_out(Frame& F) {
    LAS unsigned char* QL = F.lds; LAS unsigned char* KL = F.lds + 34816; LAS unsigned char* PL = KL; LAS unsigned char* VL = F.lds + 69632;
    LAS float* RED = (LAS float*)(F.lds + 69632 + 73728);
    const h16* P = (const h16*)(F.ws + WS_P); const h16* SST = (const h16*)(F.ws + WS_SST); h16* ARET = (h16*)(F.ws + WS_ACAT);
    const int hi = F.lane >> 5, ln = F.lane & 31, w = F.wave;
    for (int u = F.vcu; u < 512; u += F.G) {
        const int bh = u >> 5, c = u & 31, b = bh >> 3, h = bh & 7, row0 = b * SEQ + c * 128;
        const float lgf = -__expf(F.ret_decay[h]), lgb = -__expf(F.ret_decay[8 + h]);
#pragma unroll
        for (int i = 0; i < 4; ++i) { const int q = F.tid + NTHR * i, row = q >> 4, ch = q & 15; const h16* pr = P + (size_t)(row0 + row) * IN_COLS + h * 128 + ch * 8;
            *(LAS h16x8*)(QL + row * 272 + ch * 16) = *(const h16x8*)(pr + C_RQ); *(LAS h16x8*)(KL + row * 272 + ch * 16) = *(const h16x8*)(pr + C_RK); }
        h16x8 vreg[8];
#pragma unroll
        for (int i = 0; i < 8; ++i) { const int q = F.tid + NTHR * i, row = q >> 5, c32 = q & 31; vreg[i] = *(const h16x8*)(P + (size_t)(row0 + row) * IN_COLS + C_RV + h * 256 + c32 * 8); }
        __syncthreads();
        u32x2 pw[2][4];
        { const int jt = w >> 1;
#pragma unroll
          for (int t2 = 0; t2 < 2; ++t2) { const int ib = 2 * (w & 1) + t2, il = 32 * ib + ln; f32x16 s = (f32x16){};
#pragma unroll
            for (int ks = 0; ks < 8; ++ks) s = MFMA32(frag_row(KL, 272, 32 * jt, 16 * ks, F.lane), frag_row(QL, 272, 32 * ib, 16 * ks, F.lane), s);
#pragma unroll
            for (int r = 0; r < 16; ++r) { const int d = il - (32 * jt + crow(r, hi)); s[r] *= (d >= 0) ? __expf(lgf * (float)d) : __expf(lgb * (float)(-d)); }
#pragma unroll
            for (int r4 = 0; r4 < 4; ++r4) { pw[t2][r4].x = pk2h(s[4 * r4], s[4 * r4 + 1]); pw[t2][r4].y = pk2h(s[4 * r4 + 2], s[4 * r4 + 3]); } } }
        __syncthreads();
        { const int jt = w >> 1;
#pragma unroll
          for (int t2 = 0; t2 < 2; ++t2) { const int il = 32 * (2 * (w & 1) + t2) + ln;
#pragma unroll
            for (int r4 = 0; r4 < 4; ++r4) *(LAS u32x2*)(PL + il * 272 + (32 * jt + 8 * r4 + 4 * hi) * 2) = pw[t2][r4]; } }
#pragma unroll
        for (int i = 0; i < 8; ++i) { const int q = F.tid + NTHR * i, row = q >> 5, c32 = q & 31; *(LAS h16x8*)(VL + row * 576 + c32 * 16) = vreg[i]; }
        __syncthreads();
        f32x16 o[4];
#pragma unroll
        for (int ib = 0; ib < 4; ++ib) o[ib] = (f32x16){};
#pragma unroll
        for (int k16 = 0; k16 < 8; ++k16) { const h16x8 a = frag_tr(VL, 576, 16 * k16, 32 * w, F.lane);
#pragma unroll
            for (int ib = 0; ib < 4; ++ib) o[ib] = MFMA32(a, frag_row(PL, 272, 32 * ib, 16 * k16, F.lane), o[ib]);
            if (k16 & 1) __builtin_amdgcn_sched_barrier(0); }
#pragma unroll
        for (int dir = 0; dir < 2; ++dir) {
            h16 sc[4];
#pragma unroll
            for (int ib = 0; ib < 4; ++ib) { const int il = 32 * ib + ln; sc[ib] = (h16)(dir ? __expf(lgb * (float)(128 - il)) : __expf(lgf * (float)(il + 1))); }
            const h16* Sg = SST + ((size_t)((dir * 16 + bh) * 32 + c) * 256 + 32 * w + ln) * 128 + 8 * hi;
#pragma unroll
            for (int kh = 0; kh < 2; ++kh) {
                h16x8 sa[4];
#pragma unroll
                for (int k4 = 0; k4 < 4; ++k4) sa[k4] = *(const h16x8*)(Sg + 16 * (4 * kh + k4));
#pragma unroll
                for (int k4 = 0; k4 < 4; ++k4) {
#pragma unroll
                    for (int ib = 0; ib < 4; ++ib) o[ib] = MFMA32(sa[k4], frag_row(QL, 272, 32 * ib, 16 * (4 * kh + k4), F.lane) * sc[ib], o[ib]);
                    __builtin_amdgcn_sched_barrier(0); }
            }
        }
#pragma unroll
        for (int ib = 0; ib < 4; ++ib) { float ss = 0.f;
#pragma unroll
            for (int r = 0; r < 16; ++r) ss += o[ib][r] * o[ib][r];
            ss += __shfl_xor(ss, 32);
            if (hi == 0) RED[(w * 4 + ib) * 32 + ln] = ss; }
        __syncthreads();
#pragma unroll
        for (int ib = 0; ib < 4; ++ib) { float tot = 0.f;
#pragma unroll
            for (int ww = 0; ww < 8; ++ww) tot += RED[(ww * 4 + ib) * 32 + ln];
            const float rstd = 1.0f / sqrtf(tot * (1.0f / 256.0f) + EPS);
            const size_t grow = (size_t)(row0 + 32 * ib + ln);
#pragma unroll
            for (int r4 = 0; r4 < 4; ++r4) { const int e = 32 * w + 8 * r4 + 4 * hi;
                const h16x4 gt = *(const h16x4*)(P + grow * IN_COLS + C_RG + h * 256 + e);
                u32x2 wv; wv.x = pk2h(o[ib][4 * r4] * rstd * (float)gt[0], o[ib][4 * r4 + 1] * rstd * (float)gt[1]); wv.y = pk2h(o[ib][4 * r4 + 2] * rstd * (float)gt[2], o[ib][4 * r4 + 3] * rstd * (float)gt[3]);
                *(u32x2*)(ARET + grow * 3072 + h * 256 + e) = wv; } }
        __syncthreads();
    }
}
__device__ __forceinline__ void p6_attn(Frame& F) {
    const h16* P = (const h16*)(F.ws + WS_P); h16* ADIF = (h16*)(F.ws + WS_ACAT) + 2048;
    const int hi = F.lane >> 5, ln = F.lane & 31;
    float lam;
    { const float s1 = wave_sum(F.diff_lambda[F.lane] * F.diff_lambda[64 + F.lane]), s2 = wave_sum(F.diff_lambda[128 + F.lane] * F.diff_lambda[192 + F.lane]); lam = __expf(s1) - __expf(s2) + 0.2f; }
    constexpr int KT0 = 0, VT0 = 34816, KTB = 17408, VTB = 20480;
    LAS float* XB = (LAS float*)F.lds;
    for (int u = F.vcu; u < 512; u += F.G) {
        const int bh = u >> 5, qb = u & 31, b = bh >> 3, h = bh & 7;
        const int cm = F.wave & 1, qs = F.wave >> 1, qrow0 = b * SEQ + qb * 128 + qs * 32;
        h16x8 qf[4];
#pragma unroll
        for (int ks = 0; ks < 4; ++ks) qf[ks] = *(const h16x8*)(P + (size_t)(qrow0 + ln) * IN_COLS + C_DQ + h * 128 + cm * 64 + 16 * ks + 8 * hi);
        f32x16 o[4];
#pragma unroll
        for (int et = 0; et < 4; ++et) o[et] = (f32x16){};
        float mrun = 0.f, lsum = 0.f; f32x16 negm = (f32x16){};
        h16x8 kreg[2], vreg[2];
#define ATT_LOAD(t) do { _Pragma("unroll") for (int i = 0; i < 2; ++i) { const int q = F.tid + NTHR * i, row = q >> 4, ch = q & 15; const int j = (t) * 64 + row; \
            const size_t srow = (j < CTXL) ? (size_t)(MLAT + b * CTXL + j) : (size_t)(b * SEQ + j - CTXL); const h16* pr = P + srow * IN_COLS + h * 128 + ch * 8; \
            kreg[i] = *(const h16x8*)(pr + C_DK); vreg[i] = *(const h16x8*)(pr + C_DV); } } while (0)
#define ATT_WRITE(buf) do { _Pragma("unroll") for (int i = 0; i < 2; ++i) { const int q = F.tid + NTHR * i, row = q >> 4, ch = q & 15; \
            *(LAS h16x8*)(F.lds + KT0 + (buf) * KTB + row * 272 + ch * 16) = kreg[i]; *(LAS h16x8*)(F.lds + VT0 + (buf) * VTB + row * 320 + ch * 16) = vreg[i]; } } while (0)
        ATT_LOAD(0); ATT_WRITE(0);
        __syncthreads();
        constexpr int NT = (CTXL + SEQ) / 64;
        for (int t = 0; t < NT; ++t) {
            const int buf = t & 1;
            if (t + 1 < NT) ATT_LOAD(t + 1);
            const LAS unsigned char* Kt = F.lds + KT0 + buf * KTB; const LAS unsigned char* Vt = F.lds + VT0 + buf * VTB;
            f32x16 s[2];
#pragma unroll
            for (int kt = 0; kt < 2; ++kt) { s[kt] = negm;
#pragma unroll
                for (int ks = 0; ks < 4; ++ks) s[kt] = MFMA32(frag_row(Kt, 272, 32 * kt, cm * 64 + 16 * ks, F.lane), qf[ks], s[kt]); }
            float mx = s[0][0];
#pragma unroll
            for (int r = 0; r < 16; ++r) { mx = fmaxf(mx, s[0][r]); mx = fmaxf(mx, s[1][r]); }
            { const auto rr = __builtin_amdgcn_permlane32_swap(__float_as_uint(mx), __float_as_uint(mx), false, false); mx = fmaxf(__uint_as_float(rr[0]), __uint_as_float(rr[1])); }
            if (t == 0 || __any(mx > 8.0f)) { const float dl = (t == 0) ? mx : fmaxf(mx, 0.0f), alpha = (t == 0) ? 0.0f : __builtin_amdgcn_exp2f(-dl); mrun += dl; lsum *= alpha;
#pragma unroll
                for (int et = 0; et < 4; ++et) o[et] *= alpha;
#pragma unroll
                for (int kt = 0; kt < 2; ++kt)
#pragma unroll
                    for (int r = 0; r < 16; ++r) s[kt][r] -= dl;
#pragma unroll
                for (int r = 0; r < 16; ++r) negm[r] = -mrun; }
            float ps = 0.f;
#pragma unroll
            for (int kt = 0; kt < 2; ++kt)
#pragma unroll
                for (int r = 0; r < 16; ++r) { s[kt][r] = __builtin_amdgcn_exp2f(s[kt][r]); ps += s[kt][r]; }
            lsum += ps;
#pragma unroll
            for (int kt = 0; kt < 2; ++kt)
#pragma unroll
                for (int s2 = 0; s2 < 2; ++s2) {
                    const h16x8 pbf = pack8(s[kt][8 * s2], s[kt][8 * s2 + 1], s[kt][8 * s2 + 2], s[kt][8 * s2 + 3], s[kt][8 * s2 + 4], s[kt][8 * s2 + 5], s[kt][8 * s2 + 6], s[kt][8 * s2 + 7]);
#pragma unroll
                    for (int et = 0; et < 4; ++et) o[et] = MFMA32(frag_tr_perm(Vt, 320, 32 * kt + 16 * s2, 32 * et, F.lane), pbf, o[et]);
                }
            if (t + 1 < NT) ATT_WRITE(buf ^ 1);
            __syncthreads();
        }
#undef ATT_LOAD
#undef ATT_WRITE
        lsum += __shfl_xor(lsum, 32);
        const float inv = 1.0f / lsum;
        if (cm == 1) {
#pragma unroll
            for (int et = 0; et < 4; ++et)
#pragma unroll
                for (int r = 0; r < 16; ++r) XB[(qs * 128 + 32 * et + crow(r, hi)) * 32 + ln] = o[et][r] * inv;
        }
        __syncthreads();
        if (cm == 0) {
            float ss = 0.f;
#pragma unroll
            for (int et = 0; et < 4; ++et)
#pragma unroll
                for (int r = 0; r < 16; ++r) { const float v = o[et][r] * inv - lam * XB[(qs * 128 + 32 * et + crow(r, hi)) * 32 + ln]; o[et][r] = v; ss += v * v; }
            ss += __shfl_xor(ss, 32);
            const float rstd = 0.8f / sqrtf(ss * (1.0f / 128.0f) + EPS);
            const size_t grow = (size_t)(qrow0 + ln);
#pragma unroll
            for (int et = 0; et < 4; ++et)
#pragma unroll
                for (int r4 = 0; r4 < 4; ++r4) { const int e = 32 * et + 8 * r4 + 4 * hi; const f32x4 sw = *(const f32x4*)(F.diff_subln + e);
                    u32x2 w; w.x = pk2h(o[et][4 * r4] * rstd * sw[0], o[et][4 * r4 + 1] * rstd * sw[1]); w.y = pk2h(o[et][4 * r4 + 2] * rstd * sw[2], o[et][4 * r4 + 3] * rstd * sw[3]);
                    *(u32x2*)(ADIF + grow * 3072 + h * 128 + e) = w; }
        }
        __syncthreads();
    }
}
struct SchedG2 {
    pg8::StaticOrder so;
    __device__ __forceinline__ bool next(int i, pg8::Unit& u) const { if (!so.next(i >> 1, u)) return false; if (i & 1) { u.ko = 2048; u.nt = 16; u.keep = 0; } else { u.ko = 0; u.nt = 32; u.keep = 1; } return true; }
};
struct EpiU2 {
    h16* U; const h16* P;
    __device__ __forceinline__ void operator()(f32x4 (&acc)[2][2][4][2], const pg8::Unit& u, int wr, int wc, int fr, int fq) const {
#pragma unroll
        for (int ai = 0; ai < 2; ++ai)
#pragma unroll
            for (int m = 0; m < 4; ++m) { const int row = u.pm * 256 + ai * 128 + wr * 64 + m * 16 + fr;
#pragma unroll
                for (int bj = 0; bj < 2; ++bj)
#pragma unroll
                    for (int n = 0; n < 2; ++n) { const int col = u.pn * 256 + bj * 128 + wc * 32 + 16 * n + 4 * fq;
                        const h16x4 gd = *(const h16x4*)(P + (size_t)row * IN_COLS + C_GD + col);
                        if (u.keep) { const h16x4 gr = *(const h16x4*)(P + (size_t)row * IN_COLS + C_GR + col);
#pragma unroll
                            for (int e = 0; e < 4; ++e) acc[ai][bj][m][n][e] *= (float)gr[e] / (float)gd[e];
                        } else { const f32x4 a = acc[ai][bj][m][n];
                            u32x2 w; w.x = pk2h(a[0] * (float)gd[0], a[1] * (float)gd[1]); w.y = pk2h(a[2] * (float)gd[2], a[3] * (float)gd[3]);
                            *(u32x2*)(U + (size_t)row * DM + col) = w; } } }
    }
};
struct EpiX1 {
    float* X1; const float* x; const float* MOD;
    __device__ __forceinline__ void operator()(f32x4 (&acc)[2][2][4][2], const pg8::Unit& u, int wr, int wc, int fr, int fq) const {
        const int b = (u.pm * 256) / SEQ;
#pragma unroll
        for (int ai = 0; ai < 2; ++ai)
#pragma unroll
            for (int m = 0; m < 4; ++m) { const int row = u.pm * 256 + ai * 128 + wr * 64 + m * 16 + fr;
#pragma unroll
                for (int bj = 0; bj < 2; ++bj)
#pragma unroll
                    for (int n = 0; n < 2; ++n) { const int col = u.pn * 256 + bj * 128 + wc * 32 + 16 * n + 4 * fq;
                        const f32x4 g1 = *(const f32x4*)(MOD + (size_t)b * (6 * DM) + 2 * DM + col); const f32x4 xv = *(const f32x4*)(x + (size_t)row * DM + col);
                        *(f32x4*)(X1 + (size_t)row * DM + col) = xv + g1 * acc[ai][bj][m][n]; } }
    }
};
__device__ __forceinline__ void p7_gemm2(Frame& F) {
    pg8::Gemm g{(const h16*)(F.ws + WS_ACAT), (const h16*)(F.ws + WS_WCAT), 3072, 3072, 2048};
    SchedG2 S; S.so.init(MLAT, DM, F.G, (int)blockIdx.x);
    EpiU2 E{(h16*)(F.ws + WS_U), (const h16*)(F.ws + WS_P)};
    pg8::gemm_phase<EpiU2, SchedG2>(F.lds, g, S, E);
}
__device__ __forceinline__ void p9_gemm3(Frame& F) {
    pg8::Gemm g{(const h16*)(F.ws + WS_U), (const h16*)(F.ws + WS_WOUT), 2048, 2048, 2048};
    pg8::StaticOrder S; S.init(MLAT, DM, F.G, (int)blockIdx.x);
    EpiX1 E{(float*)(F.ws + WS_X1), F.x, (const float*)(F.ws + WS_MOD)};
    pg8::gemm_phase<EpiX1, pg8::StaticOrder>(F.lds, g, S, E);
}


__device__ __forceinline__ void p10_norm2(Frame& F) {
    const float* X1 = (const float*)(F.ws + WS_X1); const float* MOD = (const float*)(F.ws + WS_MOD); h16* H2X = (h16*)(F.ws + WS_H2X);
    const int gw = F.vcu * NWAVES + F.wave, NGW = F.G * NWAVES;
    for (int r = gw; r < MLAT; r += NGW) {
        const float* src = X1 + (size_t)r * DM; const int b = r / SEQ;
        f32x4 xv[8]; float ss = 0.f;
#pragma unroll
        for (int j = 0; j < 8; ++j) { xv[j] = *(const f32x4*)(src + 4 * F.lane + 256 * j); ss += (xv[j].x * xv[j].x + xv[j].y * xv[j].y) + (xv[j].z * xv[j].z + xv[j].w * xv[j].w); }
        const float rstd = 1.0f / sqrtf(wave_sum(ss) * (1.0f / DM) + EPS);
#pragma unroll
        for (int j = 0; j < 8; ++j) { const int cc = 4 * F.lane + 256 * j; const f32x4 nw = *(const f32x4*)(F.norm_ffn + cc);
            const f32x4 sh = *(const f32x4*)(MOD + (size_t)b * (6 * DM) + 3 * DM + cc), sc = *(const f32x4*)(MOD + (size_t)b * (6 * DM) + 4 * DM + cc);
            const f32x4 y = xv[j] * rstd * nw * (sc + 1.0f) + sh;
            h16 hh[4], ll[4];
#pragma unroll
            for (int e = 0; e < 4; ++e) { hh[e] = (h16)y[e]; ll[e] = (h16)(y[e] - (float)hh[e]); }
            h16* dst = H2X + (size_t)r * 6144 + cc;
            *(h16x4*)(dst) = (h16x4){hh[0], hh[1], hh[2], hh[3]}; *(h16x4*)(dst + 4096) = (h16x4){hh[0], hh[1], hh[2], hh[3]}; *(h16x4*)(dst + 2048) = (h16x4){ll[0], ll[1], ll[2], ll[3]};
            { int p8 = __builtin_amdgcn_cvt_pk_fp8_f32(y[0], y[1], 0, false); p8 = __builtin_amdgcn_cvt_pk_fp8_f32(y[2], y[3], p8, true); *(int*)((unsigned char*)(F.ws + WS_H2F8) + (size_t)r * DM + cc) = p8; } }
    }
}
struct SchedRT {
    int G, c;
    __device__ __forceinline__ bool next(int i, pg8::Unit& u) const { const int L = i * G + c; if (L >= 256) return false; u.pm = L >> 3; u.pn = 0; u.ko = (L & 7) * 768; u.nt = 0; u.keep = 0; return true; }
};
struct EpiLG {
    float* LGP;
    __device__ __forceinline__ void operator()(f32x4 (&acc)[2][2][4][2], const pg8::Unit& u, int wr, int wc, int fr, int fq) const {
        float* dst = LGP + (size_t)(u.ko / 768) * MLAT * NEXP;
#pragma unroll
        for (int ai = 0; ai < 2; ++ai)
#pragma unroll
            for (int m = 0; m < 4; ++m) { const int row = u.pm * 256 + ai * 128 + wr * 64 + m * 16 + fr;
#pragma unroll
                for (int bj = 0; bj < 2; ++bj)
#pragma unroll
                    for (int n = 0; n < 2; ++n) { const int col = bj * 128 + wc * 32 + 16 * n + 4 * fq; *(f32x4*)(dst + (size_t)row * NEXP + col) = acc[ai][bj][m][n]; } }
    }
};
__device__ __forceinline__ void p11_router(Frame& F) {
    pg8::Gemm g{(const h16*)(F.ws + WS_H2X), (const h16*)(F.ws + WS_WRTR), 6144, 6144, 768};
    SchedRT S; S.G = F.G; S.c = (int)blockIdx.x;
    EpiLG E{(float*)(F.ws + WS_LGP)};
    pg8::gemm_phase<EpiLG, SchedRT>(F.lds, g, S, E);
}
__device__ __forceinline__ void p12_topk(Frame& F) {
    const float* LGP = (const float*)(F.ws + WS_LGP); int* EIDX = (int*)(F.ws + WS_EIDX); float* EW = (float*)(F.ws + WS_EW); u32x2* LIST = (u32x2*)(F.ws + WS_LIST2);
    unsigned* CNT = (unsigned*)(F.ws + WS_CTL) + CW_CNT;
    const int gw = F.vcu * NWAVES + F.wave, NGW = F.G * NWAVES, lane = F.lane;
    const f32x4 bias = *(const f32x4*)(F.router_bias + 4 * lane);
    for (int t = gw; t < MLAT; t += NGW) {
        f32x4 lg = *(const f32x4*)(LGP + (size_t)t * NEXP + 4 * lane);
#pragma unroll
        for (int ks = 1; ks < 8; ++ks) lg += *(const f32x4*)(LGP + ((size_t)ks * MLAT + t) * NEXP + 4 * lane);
        float sc[4], sel[4];
#pragma unroll
        for (int i = 0; i < 4; ++i) { sc[i] = 1.0f / (1.0f + __expf(-lg[i])); sel[i] = sc[i] + bias[i]; }
        float a1 = fmaxf(sel[0], sel[1]), a2 = fminf(sel[0], sel[1]);
        { const float b1 = fmaxf(sel[2], sel[3]), b2 = fminf(sel[2], sel[3]); const float n1 = fmaxf(a1, b1), n2 = fmaxf(fminf(a1, b1), fmaxf(a2, b2)); a1 = n1; a2 = n2; }
#pragma unroll
        for (int off = 1; off < 8; off <<= 1) { const float b1 = __shfl_xor(a1, off), b2 = __shfl_xor(a2, off); const float n1 = fmaxf(a1, b1), n2 = fmaxf(fminf(a1, b1), fmaxf(a2, b2)); a1 = n1; a2 = n2; }
        const float gs = a1 + a2; const int g = lane >> 3;
        int rank = 0;
#pragma unroll
        for (int j = 0; j < 8; ++j) { const float o = __shfl(gs, 8 * j); rank += (o > gs || (o == gs && j < g)) ? 1 : 0; }
        const bool gsel = rank < 4;
        float ms[4];
#pragma unroll
        for (int i = 0; i < 4; ++i) ms[i] = gsel ? sel[i] : -INFINITY;
        float myw = 0.f; int mye = 0; float wsum = 0.f;
#pragma unroll
        for (int k = 0; k < TOPK; ++k) {
            float bv = ms[0]; int bi = 4 * lane;
#pragma unroll
            for (int i = 1; i < 4; ++i) if (ms[i] > bv) { bv = ms[i]; bi = 4 * lane + i; }
#pragma unroll
            for (int off = 1; off < 64; off <<= 1) { const float ov = __shfl_xor(bv, off); const int oi = __shfl_xor(bi, off); if (ov > bv || (ov == bv && oi < bi)) { bv = ov; bi = oi; } }
            const int ol = bi >> 2, oi = bi & 3;
            const float mysc = (oi == 0) ? sc[0] : (oi == 1) ? sc[1] : (oi == 2) ? sc[2] : sc[3];
            const float w = __shfl(mysc, ol);
            if (lane == ol) {
#pragma unroll
                for (int i = 0; i < 4; ++i) if (i == oi) ms[i] = -INFINITY; }
            wsum += w;
            if (lane == k) { myw = w; mye = bi; }
        }
        if (lane < TOPK) {
            const float wn = myw / wsum * 2.5f;
            EIDX[t * TOPK + lane] = mye; EW[t * TOPK + lane] = wn;
            const unsigned pos = atomicAdd(&CNT[mye], 1u);
            LIST[mye * MLAT + pos] = (u32x2){(unsigned)(t * TOPK + lane), __float_as_uint(wn)};
        }
    }
}
constexpr int EX_NSTG = 3, EX_ASTG = 24576, EX_WSTG = 16384, EX_A0 = 0, EX_W0 = EX_NSTG * EX_ASTG, EX_WH0 = EX_W0 + EX_NSTG * EX_WSTG, EX_WHS = 10240, EX_ROW0 = EX_WH0 + 2 * EX_WHS;
constexpr int EX_TAB0 = EX_ROW0 + 3200, EX_SCR0 = EX_TAB0 + 3072;
static_assert(EX_ROW0 == 143360 && EX_SCR0 + 8192 <= LDSCTL_OFF, "expert LDS map");
template <bool GU>
__device__ __forceinline__ void ring_w_prologue(Frame& F, const float* W, int cgrp) {
    constexpr int LDB = GU ? 512 : 2048;
    const int lane = F.lane, w = F.wave, v = 4 * (lane & 31);
    const int wcol0 = GU ? (((v >> 5) & 1) * 256 + 32 * (v >> 6) + (v & 31) + 64 * cgrp) : (v + 512 * cgrp);
    const float* wlane = W + (size_t)(4 * w + (lane >> 5)) * LDB + wcol0;
#pragma unroll
    for (int s = 0; s < 3; ++s)
#pragma unroll
        for (int j = 0; j < 2; ++j) __builtin_amdgcn_global_load_lds((const unsigned*)(wlane + (size_t)(s * 32 + 2 * j) * LDB), (LAS unsigned*)(F.lds + EX_W0 + s * EX_WSTG + (2 * w + j) * 1024), 16, 0, 2);
}
template <bool GU, int NLAY>
__device__ __forceinline__ void expert_ring(Frame& F, const float* W, const h16* Abase, const int (&arow)[3], int nr, int cgrp, h16* ACTrow0, h16* Y) {
    constexpr int KT = GU ? 64 : 8, NP = GU ? 1 : 4, LDB = GU ? 512 : 2048, NS = KT * NP;
    const int tid = F.tid, lane = F.lane, hi = lane >> 5, ln = lane & 31, cp = F.wave & 1, rg = F.wave >> 1, w = F.wave;
    const LAS int* RSLOT = (const LAS int*)(F.lds + EX_ROW0); const LAS float* RW = (const LAS float*)(F.lds + EX_ROW0 + 1536);
    const int ngrp = (nr + 15) >> 4;
    const int nA = (w < ngrp ? 1 : 0) + (w + 8 < ngrp ? 1 : 0) + (w + 16 < ngrp ? 1 : 0);
    const int achunk = ((lane & 3) ^ ((lane >> 4) & 3)) * 8;
    const int v = 4 * (lane & 31);
    const int wcol0 = GU ? (((v >> 5) & 1) * 256 + 32 * (v >> 6) + (v & 31) + 64 * cgrp) : (v + 512 * cgrp);
    const float* wlane = W + (size_t)(4 * w + (lane >> 5)) * LDB + wcol0;
    const unsigned lds0 = (unsigned)(uintptr_t)F.lds;
    const int xs = (ln >> 2) & 3;
    const unsigned aofs0 = (unsigned)((2 * rg + (ln >> 4)) * 1024 + (ln & 15) * 64 + ((hi ^ xs) * 16)), aofs1 = (unsigned)((2 * rg + (ln >> 4)) * 1024 + (ln & 15) * 64 + (((2 + hi) ^ xs) * 16));
    const unsigned tofs = (unsigned)((8 * hi + ((lane & 15) >> 2)) * 320 + (64 * cp + 16 * ((lane >> 4) & 1) + 4 * (lane & 3)) * 2);
    f32x16 acc[2 * NLAY];
#pragma unroll
    for (int i = 0; i < 2 * NLAY; ++i) acc[i] = (f32x16){};
#define EX_DMA_A(s) do { const int kt_ = (s) % KT, stg_ = (s) % EX_NSTG; \
        _Pragma("unroll") for (int j = 0; j < 3; ++j) if (j < nA) __builtin_amdgcn_global_load_lds((const unsigned*)(Abase + arow[j] + kt_ * 32 + achunk), (LAS unsigned*)(F.lds + EX_A0 + stg_ * EX_ASTG + (w + 8 * j) * 1024), 16, 0, 0); } while (0)
#define EX_DMA_W(s) do { const int pass_ = (s) / KT, kt_ = (s) % KT, stg_ = (s) % EX_NSTG; \
        _Pragma("unroll") for (int j = 0; j < 2; ++j) __builtin_amdgcn_global_load_lds((const unsigned*)(wlane + (size_t)(kt_ * 32 + 2 * j) * LDB + 128 * pass_), (LAS unsigned*)(F.lds + EX_W0 + stg_ * EX_WSTG + (2 * w + j) * 1024), 16, 0, 2); } while (0)
#define EX_WAITV(k) asm volatile("s_waitcnt vmcnt(" #k ")" ::: "memory")
#define EX_WAITN() do { if (nA == 3) EX_WAITV(5); else if (nA == 2) EX_WAITV(4); else if (nA == 1) EX_WAITV(3); else EX_WAITV(2); } while (0)
    const unsigned cvsrc = lds0 + EX_W0 + (tid >> 4) * 512 + (tid & 15) * 32, cvdst = lds0 + EX_WH0 + (tid >> 4) * 320 + (tid & 15) * 16;
    EX_DMA_A(0); EX_DMA_A(1);
    if (nA == 3) EX_WAITV(3); else if (nA == 2) EX_WAITV(2); else if (nA == 1) EX_WAITV(1); else EX_WAITV(0);
    __builtin_amdgcn_s_barrier(); asm volatile("" ::: "memory");
    { f32x4 c0, c1; asm volatile("ds_read_b128 %0, %2\n\tds_read_b128 %1, %2 offset:16\n\ts_waitcnt lgkmcnt(0)" : "=&v"(c0), "=&v"(c1) : "v"(cvsrc) : "memory");
      const h16x8 hv = pack8(c0[0], c0[1], c0[2], c0[3], c1[0], c1[1], c1[2], c1[3]); asm volatile("ds_write_b128 %0, %1" :: "v"(cvdst), "v"(hv) : "memory"); }
    typedef short s16x8 __attribute__((ext_vector_type(8)));
    for (int s = 0; s < NS; ++s) {
        if (s + 2 < NS) EX_WAITN(); else EX_WAITV(0);
        asm volatile("s_waitcnt lgkmcnt(0)" ::: "memory");
        __builtin_amdgcn_s_barrier();
        asm volatile("" ::: "memory");
        const bool pend = ((s % KT) == KT - 1);
        if (!pend) { if (s + 2 < NS) EX_DMA_A(s + 2); if (s + 3 < NS) EX_DMA_W(s + 3); }
        const unsigned abase = lds0 + EX_A0 + (s % EX_NSTG) * EX_ASTG, wbase = lds0 + EX_WH0 + (s & 1) * EX_WHS + tofs;
        const unsigned cs = cvsrc + ((s + 1) % EX_NSTG) * EX_WSTG;
        const unsigned pa0 = abase + aofs0, pa1 = abase + aofs1;
        if constexpr (NLAY < 3) {
            v4i16_t t0, t1, t2, t3, t4, t5, t6, t7; h16x8 a0[NLAY], a1[NLAY];
            asm volatile("ds_read_b64_tr_b16 %0, %8\n\tds_read_b64_tr_b16 %1, %8 offset:1280\n\tds_read_b64_tr_b16 %2, %8 offset:64\n\tds_read_b64_tr_b16 %3, %8 offset:1344\n\t"
                         "ds_read_b64_tr_b16 %4, %8 offset:5120\n\tds_read_b64_tr_b16 %5, %8 offset:6400\n\tds_read_b64_tr_b16 %6, %8 offset:5184\n\tds_read_b64_tr_b16 %7, %8 offset:6464"
                         : "=&v"(t0), "=&v"(t1), "=&v"(t2), "=&v"(t3), "=&v"(t4), "=&v"(t5), "=&v"(t6), "=&v"(t7) : "v"(wbase) : "memory");
            asm volatile("ds_read_b128 %0, %2\n\tds_read_b128 %1, %3" : "=&v"(a0[0]), "=&v"(a1[0]) : "v"(pa0), "v"(pa1) : "memory");
            if constexpr (NLAY >= 2) asm volatile("ds_read_b128 %0, %2 offset:8192\n\tds_read_b128 %1, %3 offset:8192" : "=&v"(a0[1]), "=&v"(a1[1]) : "v"(pa0), "v"(pa1) : "memory");
            asm volatile("s_waitcnt lgkmcnt(0)" ::: "memory");
            __builtin_amdgcn_sched_barrier(0);
            const h16x8 b00 = __builtin_bit_cast(h16x8, (s16x8){t0[0], t0[1], t0[2], t0[3], t1[0], t1[1], t1[2], t1[3]}), b01 = __builtin_bit_cast(h16x8, (s16x8){t2[0], t2[1], t2[2], t2[3], t3[0], t3[1], t3[2], t3[3]});
            const h16x8 b10 = __builtin_bit_cast(h16x8, (s16x8){t4[0], t4[1], t4[2], t4[3], t5[0], t5[1], t5[2], t5[3]}), b11 = __builtin_bit_cast(h16x8, (s16x8){t6[0], t6[1], t6[2], t6[3], t7[0], t7[1], t7[2], t7[3]});
#pragma unroll
            for (int i = 0; i < NLAY; ++i) { acc[2 * i] = MFMA32(a0[i], b00, acc[2 * i]); acc[2 * i + 1] = MFMA32(a0[i], b01, acc[2 * i + 1]); }
#pragma unroll
            for (int i = 0; i < NLAY; ++i) { acc[2 * i] = MFMA32(a1[i], b10, acc[2 * i]); acc[2 * i + 1] = MFMA32(a1[i], b11, acc[2 * i + 1]); }
        } else {
#pragma unroll
            for (int k16 = 0; k16 < 2; ++k16) {
                v4i16_t t0, t1, t2, t3; h16x8 a[3]; const unsigned pa = k16 ? pa1 : pa0, pw = wbase + k16 * 5120;
                asm volatile("ds_read_b64_tr_b16 %0, %4\n\tds_read_b64_tr_b16 %1, %4 offset:1280\n\tds_read_b64_tr_b16 %2, %4 offset:64\n\tds_read_b64_tr_b16 %3, %4 offset:1344"
                             : "=&v"(t0), "=&v"(t1), "=&v"(t2), "=&v"(t3) : "v"(pw) : "memory");
                asm volatile("ds_read_b128 %0, %3\n\tds_read_b128 %1, %3 offset:8192\n\tds_read_b128 %2, %3 offset:16384\n\ts_waitcnt lgkmcnt(0)" : "=&v"(a[0]), "=&v"(a[1]), "=&v"(a[2]) : "v"(pa) : "memory");
                __builtin_amdgcn_sched_barrier(0);
                const h16x8 b0 = __builtin_bit_cast(h16x8, (s16x8){t0[0], t0[1], t0[2], t0[3], t1[0], t1[1], t1[2], t1[3]}), b1 = __builtin_bit_cast(h16x8, (s16x8){t2[0], t2[1], t2[2], t2[3], t3[0], t3[1], t3[2], t3[3]});
#pragma unroll
                for (int i = 0; i < 3; ++i) { acc[2 * i] = MFMA32(a[i], b0, acc[2 * i]); acc[2 * i + 1] = MFMA32(a[i], b1, acc[2 * i + 1]); }
                __builtin_amdgcn_sched_barrier(0);
            }
        }
        if (s + 1 < NS) {
            f32x4 c0, c1; asm volatile("ds_read_b128 %0, %2\n\tds_read_b128 %1, %2 offset:16\n\ts_waitcnt lgkmcnt(0)" : "=&v"(c0), "=&v"(c1) : "v"(cs) : "memory");
            const h16x8 hv = pack8(c0[0], c0[1], c0[2], c0[3], c1[0], c1[1], c1[2], c1[3]); const unsigned cd = cvdst + ((s + 1) & 1) * EX_WHS; asm volatile("ds_write_b128 %0, %1" :: "v"(cd), "v"(hv) : "memory"); }
        if (pend) {
            const int pass = s / KT;
            int hio = hi, lno = ln; asm volatile("" : "+v"(hio), "+v"(lno));
            if (GU) {
#pragma unroll
                for (int i = 0; i < NLAY; ++i) { const int rt = rg + 4 * i;
#pragma unroll
                    for (int r = 0; r < 16; ++r) { const int row = 32 * rt + crow(r, hio);
                        if (row < nr) ACTrow0[(size_t)row * DEXP + 64 * cgrp + 32 * cp + lno] = (h16)(silu_f(acc[2 * i][r]) * acc[2 * i + 1][r]); }
                    acc[2 * i] = (f32x16){}; acc[2 * i + 1] = (f32x16){}; }
            } else {
                const unsigned scr = lds0 + EX_SCR0 + w * 1024;
                unsigned char* Y8 = (unsigned char*)Y;
#pragma unroll
                for (int i = 0; i < NLAY; ++i) { const int rt = rg + 4 * i;
#pragma unroll
                    for (int g8 = 0; g8 < 4; ++g8) {
#pragma unroll
                        for (int q = 0; q < 4; ++q) { const int lr = 4 * hio + q; const float wt = RW[32 * rt + 8 * g8 + lr];
                            const int pk = __builtin_amdgcn_cvt_pk_fp8_f32(acc[2 * i][4 * g8 + q] * wt, acc[2 * i + 1][4 * g8 + q] * wt, 0, false); const int pk1 = pk >> 8; const unsigned wa = scr + lr * 64 + lno;
                            asm volatile("ds_write_b8 %0, %1\n\tds_write_b8 %0, %2 offset:32" :: "v"(wa), "v"(pk), "v"(pk1) : "memory"); }
                        u32x2 pv; const unsigned ra = scr + (lane >> 3) * 64 + (lane & 7) * 8;
                        asm volatile("s_waitcnt lgkmcnt(0)\n\tds_read_b64 %0, %1\n\ts_waitcnt lgkmcnt(0)" : "=&v"(pv) : "v"(ra) : "memory");
                        const int grow = 32 * rt + 8 * g8 + (lane >> 3);
                        if (grow < nr) { const int slot = RSLOT[grow]; *(u32x2*)(Y8 + (size_t)slot * DM + 512 * cgrp + 128 * pass + 64 * cp + (lane & 7) * 8) = pv; }
                    }
                    acc[2 * i] = (f32x16){}; acc[2 * i + 1] = (f32x16){}; }
            }
            if (s + 2 < NS) EX_DMA_A(s + 2);
            if (s + 3 < NS) EX_DMA_W(s + 3);
        }
    }
    asm volatile("s_waitcnt vmcnt(0) lgkmcnt(0)" ::: "memory");
    __builtin_amdgcn_s_barrier();
    asm volatile("" ::: "memory");
#undef EX_DMA_A
#undef EX_DMA_W
#undef EX_WAITV
#undef EX_WAITN
}

constexpr int G8_NSTG = 4, G8_ASTG = 12288, G8_WSTG = 16384, G8_A0 = 0, G8_W0 = G8_NSTG * G8_ASTG, G8_WH0 = G8_W0 + G8_NSTG * G8_WSTG, G8_WHS = 4096;
static_assert(G8_WH0 + 2 * G8_WHS <= EX_ROW0, "gu8 LDS map");
template <bool GU>
__device__ __forceinline__ void ring8_w_prologue(Frame& F, const float* W, int cgrp) {
    constexpr int LDB = GU ? 512 : 2048;
    const int lane = F.lane, w = F.wave, v = 4 * (lane & 31);
    const int wcol0 = GU ? (((v >> 5) & 1) * 256 + 32 * (v >> 6) + (v & 31) + 64 * cgrp) : (v + 512 * cgrp);
    const float* wlane = W + (size_t)(4 * w + (lane >> 5)) * LDB + wcol0;
#pragma unroll
    for (int s = 0; s < 4; ++s)
#pragma unroll
        for (int j = 0; j < 2; ++j) __builtin_amdgcn_global_load_lds((const unsigned*)(wlane + (size_t)(s * 32 + 2 * j) * LDB), (LAS unsigned*)(F.lds + G8_W0 + s * G8_WSTG + (2 * w + j) * 1024), 16, 0, 2);
}
template <bool GU, int NLAY>
__device__ __forceinline__ void expert_ring8(Frame& F, const float* W, const unsigned char* A8, const int (&arow)[2], int nr, int cgrp, unsigned char* ACT8row0, unsigned char* Y8) {
    constexpr int KT = GU ? 64 : 8, NP = GU ? 1 : 4, LDB = GU ? 512 : 2048, NS = KT * NP;
    typedef long v2i64 __attribute__((ext_vector_type(2)));
    const int tid = F.tid, lane = F.lane, hi = lane >> 5, ln = lane & 31, cp = F.wave & 1, rg = F.wave >> 1, w = F.wave;
    const LAS int* RSLOT = (const LAS int*)(F.lds + EX_ROW0); const LAS float* RW = (const LAS float*)(F.lds + EX_ROW0 + 1536);
    const int ngrp = (nr + 31) >> 5;
    const int nA = (w < ngrp ? 1 : 0) + (w + 8 < ngrp ? 1 : 0);
    const int v = 4 * (lane & 31);
    const int wcol0 = GU ? (((v >> 5) & 1) * 256 + 32 * (v >> 6) + (v & 31) + 64 * cgrp) : (v + 512 * cgrp);
    const float* wlane = W + (size_t)(4 * w + (lane >> 5)) * LDB + wcol0;
    const unsigned lds0 = (unsigned)(uintptr_t)F.lds;
    const unsigned aofs = (unsigned)(rg * 1024 + ln * 32 + hi * 16);
    const unsigned bofs = (unsigned)((64 * cp + ln) * 32 + hi * 16);
    const unsigned cvsrc = lds0 + G8_W0 + (tid >> 7) * 8 * 512 + (tid & 127) * 4, cvdst = lds0 + G8_WH0 + (tid & 127) * 32 + (tid >> 7) * 8;
    f32x16 acc[2 * NLAY];
#pragma unroll
    for (int i = 0; i < 2 * NLAY; ++i) acc[i] = (f32x16){};
#define G8_DMA_A(s) do { const int stg_ = (s) & 3, kt_ = (s) % KT; \
        _Pragma("unroll") for (int j = 0; j < 2; ++j) if (j < nA) __builtin_amdgcn_global_load_lds((const unsigned*)(A8 + arow[j] + kt_ * 32 + (lane & 1) * 16), (LAS unsigned*)(F.lds + G8_A0 + stg_ * G8_ASTG + (w + 8 * j) * 1024), 16, 0, 0); } while (0)
#define G8_DMA_W(s) do { const int stg_ = (s) & 3, kt_ = (s) % KT, pass_ = (s) / KT; \
        _Pragma("unroll") for (int j = 0; j < 2; ++j) __builtin_amdgcn_global_load_lds((const unsigned*)(wlane + (size_t)(kt_ * 32 + 2 * j) * LDB + 128 * pass_), (LAS unsigned*)(F.lds + G8_W0 + stg_ * G8_WSTG + (2 * w + j) * 1024), 16, 0, 2); } while (0)
#define G8_WAITV(k) asm volatile("s_waitcnt vmcnt(" #k ")" ::: "memory")
#define G8_CVT(s) do { float c_[8]; const unsigned cs_ = cvsrc + ((s) & 3) * G8_WSTG; \
        asm volatile("ds_read_b32 %0, %8\n\tds_read_b32 %1, %8 offset:512\n\tds_read_b32 %2, %8 offset:1024\n\tds_read_b32 %3, %8 offset:1536\n\tds_read_b32 %4, %8 offset:2048\n\tds_read_b32 %5, %8 offset:2560\n\tds_read_b32 %6, %8 offset:3072\n\tds_read_b32 %7, %8 offset:3584\n\ts_waitcnt lgkmcnt(0)" \
                     : "=&v"(c_[0]), "=&v"(c_[1]), "=&v"(c_[2]), "=&v"(c_[3]), "=&v"(c_[4]), "=&v"(c_[5]), "=&v"(c_[6]), "=&v"(c_[7]) : "v"(cs_) : "memory"); \
        int p0_ = __builtin_amdgcn_cvt_pk_fp8_f32(c_[0] * 64.f, c_[1] * 64.f, 0, false); p0_ = __builtin_amdgcn_cvt_pk_fp8_f32(c_[2] * 64.f, c_[3] * 64.f, p0_, true); \
        int p1_ = __builtin_amdgcn_cvt_pk_fp8_f32(c_[4] * 64.f, c_[5] * 64.f, 0, false); p1_ = __builtin_amdgcn_cvt_pk_fp8_f32(c_[6] * 64.f, c_[7] * 64.f, p1_, true); \
        const u32x2 pk_ = {(unsigned)p0_, (unsigned)p1_}; const unsigned cd_ = cvdst + ((s) & 1) * G8_WHS; asm volatile("ds_write_b64 %0, %1" :: "v"(cd_), "v"(pk_) : "memory"); } while (0)
    G8_DMA_A(0); G8_DMA_A(1); G8_DMA_A(2);
    if (nA == 2) G8_WAITV(4); else if (nA == 1) G8_WAITV(2); else G8_WAITV(0);
    __builtin_amdgcn_s_barrier(); asm volatile("" ::: "memory");
    G8_CVT(0);
    for (int s = 0; s < NS; ++s) {
        if (s >= 2 && s + 4 < NS) { if (nA == 2) G8_WAITV(8); else if (nA == 1) G8_WAITV(6); else G8_WAITV(4); }
        else if (s < 2) { if (nA == 2) G8_WAITV(4); else if (nA == 1) G8_WAITV(3); else G8_WAITV(2); }
        else G8_WAITV(0);
        asm volatile("s_waitcnt lgkmcnt(0)" ::: "memory");
        __builtin_amdgcn_s_barrier();
        asm volatile("" ::: "memory");
        const bool pend = ((s % KT) == KT - 1);
        if (!pend) { if (s + 3 < NS) G8_DMA_A(s + 3); if (s + 4 < NS) G8_DMA_W(s + 4); }
        const unsigned pa = lds0 + G8_A0 + (s & 3) * G8_ASTG + aofs, pb = lds0 + G8_WH0 + (s & 1) * G8_WHS + bofs;
        v2i64 a[NLAY], b0, b1;
        asm volatile("ds_read_b128 %0, %2\n\tds_read_b128 %1, %2 offset:1024" : "=&v"(b0), "=&v"(b1) : "v"(pb) : "memory");
        asm volatile("ds_read_b128 %0, %1" : "=&v"(a[0]) : "v"(pa) : "memory");
        if constexpr (NLAY >= 2) asm volatile("ds_read_b128 %0, %1 offset:4096" : "=&v"(a[1]) : "v"(pa) : "memory");
        if constexpr (NLAY >= 3) asm volatile("ds_read_b128 %0, %1 offset:8192" : "=&v"(a[2]) : "v"(pa) : "memory");
        asm volatile("s_waitcnt lgkmcnt(0)" ::: "memory");
        __builtin_amdgcn_sched_barrier(0);
#pragma unroll
        for (int i = 0; i < NLAY; ++i) { acc[2 * i] = __builtin_amdgcn_mfma_f32_32x32x16_fp8_fp8(a[i][0], b0[0], acc[2 * i], 0, 0, 0); acc[2 * i + 1] = __builtin_amdgcn_mfma_f32_32x32x16_fp8_fp8(a[i][0], b1[0], acc[2 * i + 1], 0, 0, 0); }
#pragma unroll
        for (int i = 0; i < NLAY; ++i) { acc[2 * i] = __builtin_amdgcn_mfma_f32_32x32x16_fp8_fp8(a[i][1], b0[1], acc[2 * i], 0, 0, 0); acc[2 * i + 1] = __builtin_amdgcn_mfma_f32_32x32x16_fp8_fp8(a[i][1], b1[1], acc[2 * i + 1], 0, 0, 0); }
        if (s + 1 < NS) G8_CVT(s + 1);
        if (pend) {
            const int pass = s / KT;
            int hio = hi, lno = ln; asm volatile("" : "+v"(hio), "+v"(lno));
            const unsigned scr = lds0 + EX_SCR0 + w * 1024;
#pragma unroll
            for (int i = 0; i < NLAY; ++i) { const int rt = rg + 4 * i;
#pragma unroll
                for (int g8 = 0; g8 < 4; ++g8) {
#pragma unroll
                    for (int q = 0; q < 4; ++q) { const int lr = 4 * hio + q;
                        float v0, v1;
                        if (GU) { v0 = silu_f(acc[2 * i][4 * g8 + q] * 0.015625f) * (acc[2 * i + 1][4 * g8 + q] * 0.015625f); v1 = 0.f; }
                        else { const float wt = RW[32 * rt + 8 * g8 + lr] * 0.015625f; v0 = acc[2 * i][4 * g8 + q] * wt; v1 = acc[2 * i + 1][4 * g8 + q] * wt; }
                        const int pk = __builtin_amdgcn_cvt_pk_fp8_f32(v0, v1, 0, false); const unsigned wa = scr + lr * 64 + lno;
                        if (GU) asm volatile("ds_write_b8 %0, %1" :: "v"(wa), "v"(pk) : "memory");
                        else { const int pk1 = pk >> 8; asm volatile("ds_write_b8 %0, %1\n\tds_write_b8 %0, %2 offset:32" :: "v"(wa), "v"(pk), "v"(pk1) : "memory"); } }
                    const int grow = 32 * rt + 8 * g8 + (lane >> 3);
                    if (GU) {
                        unsigned pv; const unsigned ra = scr + (lane >> 3) * 64 + (lane & 7) * 4;
                        asm volatile("s_waitcnt lgkmcnt(0)\n\tds_read_b32 %0, %1\n\ts_waitcnt lgkmcnt(0)" : "=&v"(pv) : "v"(ra) : "memory");
                        if (grow < nr) *(unsigned*)(ACT8row0 + (size_t)grow * DEXP + 64 * cgrp + 32 * cp + (lane & 7) * 4) = pv;
                    } else {
                        u32x2 pv; const unsigned ra = scr + (lane >> 3) * 64 + (lane & 7) * 8;
                        asm volatile("s_waitcnt lgkmcnt(0)\n\tds_read_b64 %0, %1\n\ts_waitcnt lgkmcnt(0)" : "=&v"(pv) : "v"(ra) : "memory");
                        if (grow < nr) { const int slot = RSLOT[grow]; *(u32x2*)(Y8 + (size_t)slot * DM + 512 * cgrp + 128 * pass + 64 * cp + (lane & 7) * 8) = pv; }
                    }
                }
                acc[2 * i] = (f32x16){}; acc[2 * i + 1] = (f32x16){}; }
            if (s + 3 < NS) G8_DMA_A(s + 3);
            if (s + 4 < NS) G8_DMA_W(s + 4);
        }
    }
    asm volatile("s_waitcnt vmcnt(0) lgkmcnt(0)" ::: "memory");
    __builtin_amdgcn_s_barrier();
    asm volatile("" ::: "memory");
#undef G8_DMA_A
#undef G8_DMA_W
#undef G8_WAITV
#undef G8_CVT
}
template <bool GU>
__device__ __forceinline__ void p13_expert_phase(Frame& F, int qid) {
    const h16* H2X = (const h16*)(F.ws + WS_H2X); h16* Y = (h16*)(F.ws + WS_Y); h16* ACT = (h16*)(F.ws + WS_ACT);
    const unsigned* CNT = (const unsigned*)(F.ws + WS_CTL) + CW_CNT; unsigned* QH = (unsigned*)(F.ws + WS_CTL) + CW_Q + 64 * qid;
    LAS int* RSLOT = (LAS int*)(F.lds + EX_ROW0); LAS float* RW = (LAS float*)(F.lds + EX_ROW0 + 1536); LAS int* RED = (LAS int*)(F.lds + EX_ROW0 + 3072);
    LAS int* CN = (LAS int*)(F.lds + EX_TAB0); LAS int* ORD = CN + 256; LAS int* OFF = CN + 512;
    __syncthreads();
    if (F.tid < NEXP) CN[F.tid] = (int)CNT[F.tid];
    __syncthreads();
    if (F.tid < NEXP) { const int c = CN[F.tid]; int rank = 0, off = 0;
        for (int j = 0; j < NEXP; ++j) { const int cj = CN[j]; rank += (cj > c || (cj == c && j < F.tid)) ? 1 : 0; off += (j < F.tid) ? cj : 0; }
        ORD[rank] = F.tid; OFF[F.tid] = off; }
    __syncthreads();
    const u32x2* LIST2 = (const u32x2*)(F.ws + WS_LIST2);
    if (F.tid == 0) RED[0] = (int)__hip_atomic_fetch_add(QH, 1u, __ATOMIC_RELAXED, __HIP_MEMORY_SCOPE_AGENT);
    __syncthreads();
    int u = RED[0];
    while (u < NEXP * 4) {
        const int e = ORD[u >> 2], cg = u & 3, cnt = CN[e], off_e = OFF[e];
        const float* Wgu = F.w_exp_gu + (size_t)e * DM * 512; const float* Wdn = F.w_exp_down + (size_t)e * DEXP * DM;
        for (int rs = 0; rs < cnt; rs += 384) {
            const int nr = (cnt - rs) < 384 ? (cnt - rs) : 384;
            __syncthreads();
            ring8_w_prologue<GU>(F, GU ? Wgu : Wdn, cg);
            if (F.tid < 384) { u32x2 ent = {0u, 0u}; if (F.tid < nr) ent = LIST2[e * MLAT + rs + F.tid]; RSLOT[F.tid] = (int)ent.x; RW[F.tid] = __uint_as_float(ent.y); }
            __syncthreads();
            unsigned char* ACT8row0 = (unsigned char*)(F.ws + WS_ACT8) + (size_t)(off_e + rs) * DEXP;
            int ar8[2];
            if (GU) {
#pragma unroll
                for (int j = 0; j < 2; ++j) { const int r = 32 * (F.wave + 8 * j) + (F.lane >> 1); ar8[j] = (r < 384 ? (RSLOT[r] >> 3) : 0) * DM; }
                const unsigned char* A8 = (const unsigned char*)(F.ws + WS_H2F8);
                if (nr > 256) expert_ring8<true, 3>(F, Wgu, A8, ar8, nr, cg, ACT8row0, (unsigned char*)Y); else if (nr > 128) expert_ring8<true, 2>(F, Wgu, A8, ar8, nr, cg, ACT8row0, (unsigned char*)Y); else expert_ring8<true, 1>(F, Wgu, A8, ar8, nr, cg, ACT8row0, (unsigned char*)Y);
            } else {
#pragma unroll
                for (int j = 0; j < 2; ++j) { const int r = 32 * (F.wave + 8 * j) + (F.lane >> 1); ar8[j] = ((r < nr) ? r : 0) * DEXP; }
                if (nr > 256) expert_ring8<false, 3>(F, Wdn, ACT8row0, ar8, nr, cg, ACT8row0, (unsigned char*)Y); else if (nr > 128) expert_ring8<false, 2>(F, Wdn, ACT8row0, ar8, nr, cg, ACT8row0, (unsigned char*)Y); else expert_ring8<false, 1>(F, Wdn, ACT8row0, ar8, nr, cg, ACT8row0, (unsigned char*)Y);
            }
        }
        __syncthreads();
        if (F.tid == 0) RED[0] = (int)__hip_atomic_fetch_add(QH, 1u, __ATOMIC_RELAXED, __HIP_MEMORY_SCOPE_AGENT);
        __syncthreads();
        u = RED[0];
    }
}
struct SchedSG {
    int G, c;
    __device__ __forceinline__ bool next(int i, pg8::Unit& u) const { const int L = i * G + c; if (L >= 256) return false; u.pm = L >> 3; u.pn = (L >> 2) & 1; u.ko = (L & 3) * 512; u.nt = 0; u.keep = 0; return true; }
};
struct EpiSGP {
    float* SGP;
    __device__ __forceinline__ void operator()(f32x4 (&acc)[2][2][4][2], const pg8::Unit& u, int wr, int wc, int fr, int fq) const {
        float* dst = SGP + (size_t)(u.ko / 512) * MLAT * 512;
#pragma unroll
        for (int ai = 0; ai < 2; ++ai)
#pragma unroll
            for (int m = 0; m < 4; ++m) { const int row = u.pm * 256 + ai * 128 + wr * 64 + m * 16 + fr;
#pragma unroll
                for (int bj = 0; bj < 2; ++bj)
#pragma unroll
                    for (int n = 0; n < 2; ++n) { const int col = u.pn * 256 + bj * 128 + wc * 32 + 16 * n + 4 * fq; *(f32x4*)(dst + (size_t)row * 512 + col) = acc[ai][bj][m][n]; } }
    }
};
__device__ __forceinline__ void p11b_shared_gu(Frame& F) {
    pg8::Gemm g{(const h16*)(F.ws + WS_H2X), (const h16*)(F.ws + WS_WSGU), 6144, 2048, 512};
    SchedSG S; S.G = F.G; S.c = (int)blockIdx.x;
    EpiSGP E{(float*)(F.ws + WS_SGP)};
    pg8::gemm_phase<EpiSGP, SchedSG>(F.lds, g, S, E);
}
__device__ __forceinline__ void p12b_shared_act(Frame& F) {
    const float* SGP = (const float*)(F.ws + WS_SGP); h16* ACTS = (h16*)(F.ws + WS_ACTS);
    for (int q = blockIdx.x * NTHR + F.tid; q < MLAT * 64; q += F.G * NTHR) {
        const int row = q >> 6, j = (q & 63) * 4, pg = 32 * (j >> 4) + (j & 15);
        f32x4 gv = {0.f, 0.f, 0.f, 0.f}, uv = gv;
#pragma unroll
        for (int ks = 0; ks < 4; ++ks) { const float* p = SGP + ((size_t)ks * MLAT + row) * 512 + pg; gv += *(const f32x4*)p; uv += *(const f32x4*)(p + 16); }
        u32x2 w; w.x = pk2h(silu_f(gv[0]) * uv[0], silu_f(gv[1]) * uv[1]); w.y = pk2h(silu_f(gv[2]) * uv[2], silu_f(gv[3]) * uv[3]);
        *(u32x2*)(ACTS + (size_t)row * DEXP + j) = w;
    }
}
struct EpiYsh {
    h16* YSH;
    __device__ __forceinline__ void operator()(f32x4 (&acc)[2][2][4][2], const pg8::Unit& u, int wr, int wc, int fr, int fq) const {
#pragma unroll
        for (int ai = 0; ai < 2; ++ai)
#pragma unroll
            for (int m = 0; m < 4; ++m) { const int row = u.pm * 256 + ai * 128 + wr * 64 + m * 16 + fr;
#pragma unroll
                for (int bj = 0; bj < 2; ++bj)
#pragma unroll
                    for (int n = 0; n < 2; ++n) { const int col = u.pn * 256 + bj * 128 + wc * 32 + 16 * n + 4 * fq; const f32x4 a = acc[ai][bj][m][n];
                        u32x2 w; w.x = pk2h(a[0], a[1]); w.y = pk2h(a[2], a[3]); *(u32x2*)(YSH + (size_t)row * DM + col) = w; } }
    }
};
struct SchedOne {
    int pm, pn;
    __device__ __forceinline__ bool next(int i, pg8::Unit& u) const { if (i != 0) return false; u.pm = pm; u.pn = pn; u.ko = 0; u.nt = 0; u.keep = 0; return true; }
};
__device__ __forceinline__ void p15_shared_down_dyn(Frame& F, int qid) {
    unsigned* QH = (unsigned*)(F.ws + WS_CTL) + CW_Q + 64 * 8 * qid;
    LAS int* RED = (LAS int*)(F.lds + EX_ROW0 + 3072);
    for (;;) {
        __syncthreads();
        if (F.tid == 0) RED[0] = (int)__hip_atomic_fetch_add(QH, 1u, __ATOMIC_RELAXED, __HIP_MEMORY_SCOPE_AGENT);
        __syncthreads();
        const int t = RED[0];
        if (t >= 256) break;
        pg8::Gemm g{(const h16*)(F.ws + WS_ACTS), (const h16*)(F.ws + WS_WSDN), 256, 256, 256};
        SchedOne S; S.pm = t >> 3; S.pn = t & 7;
        EpiYsh E{(h16*)(F.ws + WS_YSH)};
        pg8::gemm_phase<EpiYsh, SchedOne>(F.lds, g, S, E);
    }
}
__device__ __forceinline__ void p15_shared_down(Frame& F) {
    pg8::Gemm g{(const h16*)(F.ws + WS_ACTS), (const h16*)(F.ws + WS_WSDN), 256, 256, 256};
    pg8::StaticOrder S; S.init(MLAT, DM, F.G, (int)blockIdx.x);
    EpiYsh E{(h16*)(F.ws + WS_YSH)};
    pg8::gemm_phase<EpiYsh, pg8::StaticOrder>(F.lds, g, S, E);
}
__device__ __forceinline__ void p16_combine(Frame& F) {
    const float* X1 = (const float*)(F.ws + WS_X1); const float* MOD = (const float*)(F.ws + WS_MOD); const h16* Y = (const h16*)(F.ws + WS_Y); const h16* YSH = (const h16*)(F.ws + WS_YSH);
    const int gw = F.vcu * NWAVES + F.wave, NGW = F.G * NWAVES;
    for (int r = gw; r < MLAT; r += NGW) {
        const int b = r / SEQ;
        f32x4 xv[8]; float ss = 0.f;
#pragma unroll
        for (int j = 0; j < 8; ++j) { const int cc = 4 * F.lane + 256 * j;
            f32x4 m = {0.f, 0.f, 0.f, 0.f};
#pragma unroll
            for (int k = 0; k < TOPK; ++k) { const int yv = *(const int*)((const unsigned char*)Y + (size_t)(r * TOPK + k) * DM + cc);
                const f32x2 lo = __builtin_amdgcn_cvt_pk_f32_fp8(yv, false), hi2 = __builtin_amdgcn_cvt_pk_f32_fp8(yv, true); m += (f32x4){lo[0], lo[1], hi2[0], hi2[1]}; }
            { const h16x4 yv = *(const h16x4*)(YSH + (size_t)r * DM + cc); m += (f32x4){(float)yv[0], (float)yv[1], (float)yv[2], (float)yv[3]}; }
            const f32x4 g2 = *(const f32x4*)(MOD + (size_t)b * (6 * DM) + 5 * DM + cc);
            xv[j] = *(const f32x4*)(X1 + (size_t)r * DM + cc) + g2 * m;
            ss += (xv[j].x * xv[j].x + xv[j].y * xv[j].y) + (xv[j].z * xv[j].z + xv[j].w * xv[j].w); }
        const float rstd = 1.0f / sqrtf(wave_sum(ss) * (1.0f / DM) + EPS);
#pragma unroll
        for (int j = 0; j < 8; ++j) { const int cc = 4 * F.lane + 256 * j; const f32x4 nw = *(const f32x4*)(F.final_norm + cc);
            *(f32x4*)(F.out + (size_t)r * DM + cc) = xv[j] * rstd * nw; }
    }
}

__device__ __forceinline__ void p_final_plain(Frame& F, const float* xin) {
    const int gw = F.vcu * NWAVES + F.wave, NGW = F.G * NWAVES;
    for (int r = gw; r < MLAT; r += NGW) {
        const float* src = xin + (size_t)r * DM;
        f32x4 xv[8]; float ss = 0.f;
#pragma unroll
        for (int j = 0; j < 8; ++j) { xv[j] = *(const f32x4*)(src + 4 * F.lane + 256 * j); ss += (xv[j].x * xv[j].x + xv[j].y * xv[j].y) + (xv[j].z * xv[j].z + xv[j].w * xv[j].w); }
        const float rstd = 1.0f / sqrtf(wave_sum(ss) * (1.0f / DM) + EPS);
#pragma unroll
        for (int j = 0; j < 8; ++j) { const int cc = 4 * F.lane + 256 * j; const f32x4 nw = *(const f32x4*)(F.final_norm + cc);
            *(f32x4*)(F.out + (size_t)r * DM + cc) = xv[j] * rstd * nw; }
    }
}

constexpr int N_PHASES = 15;
#ifndef DUP_PHASE
#define DUP_PHASE -1
#endif
#ifndef DUP_VAR
#define DUP_VAR 7
#endif
struct Args { const float* in[22]; float* out; unsigned char* ws; int ph_lo, ph_hi; };
__global__ void __launch_bounds__(NTHR, 2) mk_fwd(Args args) {
    extern __shared__ __attribute__((aligned(16))) unsigned char lds_raw[];
    Frame F;
    F.lds = (LAS unsigned char*)lds_raw;
    F.tid = threadIdx.x; F.lane = F.tid & 63; F.wave = __builtin_amdgcn_readfirstlane(F.tid >> 6);
    F.G = gridDim.x; { const int bx = blockIdx.x; F.vcu = (F.G % 8 == 0) ? (bx % 8) * (F.G / 8) + bx / 8 : bx; }
    F.x = args.in[0]; F.c = args.in[1]; F.ctx = args.in[2]; F.c_ctx = args.in[3]; F.w_mod = args.in[4]; F.b_mod = args.in[5]; F.norm_attn = args.in[6]; F.norm_ffn = args.in[7];
    F.w_in = args.in[8]; F.ret_decay = args.in[9]; F.diff_lambda = args.in[10]; F.diff_subln = args.in[11]; F.w_ret_o = args.in[12]; F.w_diff_o = args.in[13]; F.w_out = args.in[14];
    F.w_router = args.in[15]; F.router_bias = args.in[16]; F.w_exp_gu = args.in[17]; F.w_exp_down = args.in[18]; F.w_sh_gu = args.in[19]; F.w_sh_down = args.in[20]; F.final_norm = args.in[21];
    F.out = args.out; F.ws = args.ws;
    volatile LAS unsigned* MISC = (volatile LAS unsigned*)(F.lds + LDSCTL_OFF);
    for (int u = F.tid; u < (LDS_BYTES - LDSCTL_OFF) / 4; u += NTHR) ((LAS unsigned*)(F.lds + LDSCTL_OFF))[u] = 0u;
    __syncthreads();
    const int lo = args.ph_lo, hi = args.ph_hi;
    const bool multi = (hi - lo) > 1;
    XcdBarrier bar; bar.bar = (unsigned*)(F.ws + WS_CTL) + CW_BAR; bar.x = 0; bar.st = nullptr;
    if (multi) bar = xcd_barrier_post((unsigned*)(F.ws + WS_CTL) + CW_BAR, MISC + 8);
#define IN(k) (lo <= (k) && (k) < hi)
#define SEAM(k) do { if (IN(k) && IN((k) + 1)) xcd_barrier(bar); } while (0)

#define RUNP(k, call) do { if (IN(k)) { call; if (DUP_PHASE == (k)) { xcd_barrier(bar); call; } } SEAM(k); } while (0)
    RUNP(0, p0a_mod(F));
    RUNP(1, (p1_norm1(F), p0b_weights(F)));
    RUNP(2, (p2_gemm1(F), p0c_weights_dyn(F, 5)));
    RUNP(3, p3_ret_local(F));
    RUNP(4, p4_ret_scan(F));
    RUNP(5, p5_ret_out(F));
    RUNP(6, p6_attn(F));
    RUNP(7, p7_gemm2(F));
    RUNP(8, p9_gemm3(F));
    RUNP(9, p10_norm2(F));
    RUNP(10, (p11_router(F), p11b_shared_gu(F)));
    RUNP(11, (p12_topk(F), p12b_shared_act(F)));
    if (IN(12)) { p13_expert_phase<true>(F, 0); p15_shared_down_dyn(F, 4); if (DUP_PHASE == 12) { xcd_barrier(bar); p13_expert_phase<true>(F, 2); } } SEAM(12);
    if (IN(13)) { p13_expert_phase<false>(F, 1); if (DUP_PHASE == 13) { xcd_barrier(bar); p13_expert_phase<false>(F, 3); } } SEAM(13);
    if (IN(14)) { p16_combine(F); }
#undef RUNP
#undef IN
#undef SEAM
}

constexpr bool ONE_LAUNCH = true;
extern "C" void kernel_launch(void* const* d_in, const int* in_sizes, int n_in, void* d_out, int out_size, void* d_ws, size_t ws_size, hipStream_t stream) {
    static int grid = 0;
    if (grid == 0) {
        if (n_in != 22 || out_size != MLAT * DM || ws_size < WS_END) { fprintf(stderr, "kernel_launch: unexpected sizes n_in %d out %d ws %zu\n", n_in, out_size, ws_size); grid = -1; return; }
        int dev = 0, cus = 0;
        if (hipGetDevice(&dev) != hipSuccess || hipDeviceGetAttribute(&cus, hipDeviceAttributeMultiprocessorCount, dev) != hipSuccess) { grid = -1; return; }
        if (hipFuncSetAttribute((const void*)mk_fwd, hipFuncAttributeMaxDynamicSharedMemorySize, LDS_BYTES) != hipSuccess) { fprintf(stderr, "kernel_launch: hipFuncSetAttribute failed\n"); grid = -1; return; }
        int per_cu = 0;
        if (hipOccupancyMaxActiveBlocksPerMultiprocessor(&per_cu, (const void*)mk_fwd, NTHR, LDS_BYTES) != hipSuccess || per_cu < 1) fprintf(stderr, "kernel_launch: occupancy query reports %d\n", per_cu);
        (void)hipGetLastError();
        grid = cus;
    }
    if (grid < 0) return;
    (void)hipMemsetAsync((char*)d_ws + WS_CTL, 0, CTL_ZERO_BYTES, stream);
    Args a{};
    for (int i = 0; i < 22; ++i) a.in[i] = (const float*)d_in[i];
    a.out = (float*)d_out; a.ws = (unsigned char*)d_ws;
    if (ONE_LAUNCH) {
        a.ph_lo = 0; a.ph_hi = N_PHASES;
        hipLaunchKernelGGL(mk_fwd, dim3(grid), dim3(NTHR), LDS_BYTES, stream, a);
    } else {
        for (int p = 0; p < N_PHASES; ++p) { a.ph_lo = p; a.ph_hi = p + 1; hipLaunchKernelGGL(mk_fwd, dim3(grid), dim3(NTHR), LDS_BYTES, stream, a); }
    }
}
```

```cpp
#include <hip/hip_runtime.h>
#include <cstdio>
#include <cstdint>

#define LAS __attribute__((address_space(3)))
#define GAS __attribute__((address_space(1)))
typedef _Float16 h16;
typedef _Float16 h16x8 __attribute__((ext_vector_type(8)));
typedef _Float16 h16x4 __attribute__((ext_vector_type(4)));
typedef _Float16 h16x2 __attribute__((ext_vector_type(2)));
typedef float f32x2 __attribute__((ext_vector_type(2)));
typedef float f32x4 __attribute__((ext_vector_type(4)));
typedef float f32x16 __attribute__((ext_vector_type(16)));
typedef unsigned u32x4 __attribute__((ext_vector_type(4)));
typedef unsigned u32x2 __attribute__((ext_vector_type(2)));
typedef short v4i16_t __attribute__((ext_vector_type(4)));

constexpr int DM = 2048, NBATCH = 2, SEQ = 4096, CTXL = 256;
constexpr int MLAT = NBATCH * SEQ, MCTX = NBATCH * CTXL, MALL = MLAT + MCTX;
constexpr int IN_COLS = 13312, KV_COLS = 5120;
constexpr int C_RK = 0, C_RV = 1024, C_DK = 3072, C_DV = 4096, C_RQ = 5120, C_RG = 6144, C_DQ = 8192, C_GR = 9216, C_GD = 11264;
constexpr int NEXP = 256, TOPK = 8, DEXP = 256;
constexpr float EPS = 1e-6f;
constexpr int NWAVES = 8, NTHR = 512;

constexpr size_t MiB = 1u << 20;
constexpr size_t WS_CTL = 0, CTL_ZERO_BYTES = 1 * MiB;
constexpr size_t WS_MODP = 1 * MiB;
constexpr size_t WS_MOD = 3 * MiB;
constexpr size_t WS_ROPE = 3 * MiB + 512 * 1024;
constexpr size_t WS_WINT = 4 * MiB;
constexpr size_t WS_WRET = 56 * MiB;
constexpr size_t WS_WDIF = 64 * MiB;
constexpr size_t WS_WOUT = 68 * MiB;
constexpr size_t WS_WSGU = 76 * MiB;
constexpr size_t WS_WSDN = 78 * MiB;
constexpr size_t WS_WRTR = 79 * MiB;
constexpr size_t WS_H = 82 * MiB;
constexpr size_t WS_P = 116 * MiB;
constexpr size_t WS_LST = 340 * MiB;
constexpr size_t WS_SST = 408 * MiB;
constexpr size_t WS_ARET = 472 * MiB;
constexpr size_t WS_ADIF = 504 * MiB;
constexpr size_t WS_T = 520 * MiB;
constexpr size_t WS_U = 584 * MiB;
constexpr size_t WS_X1 = 616 * MiB;
constexpr size_t WS_H2X = 680 * MiB;
constexpr size_t WS_LG = 776 * MiB;
constexpr size_t WS_EIDX = 784 * MiB;
constexpr size_t WS_EW = 785 * MiB;
constexpr size_t WS_LIST = 786 * MiB;
constexpr size_t WS_ACTS = 794 * MiB;
constexpr size_t WS_YSH = 798 * MiB;
constexpr size_t WS_Y = 830 * MiB;
constexpr size_t WS_ACT = 1086 * MiB;
constexpr size_t WS_LGP = 1118 * MiB;
constexpr size_t WS_SGP = 1182 * MiB;
constexpr size_t WS_ACAT = 1246 * MiB;
constexpr size_t WS_WCAT = 1294 * MiB;
constexpr size_t WS_LIST2 = 1306 * MiB;
constexpr size_t WS_H2F8 = 1322 * MiB;
constexpr size_t WS_ACT8 = 1338 * MiB;
constexpr size_t WS_END = 1354 * MiB;

constexpr int CW_BAR = 4096;
constexpr int CW_CNT = 16384;
constexpr int CW_Q = 20480;

constexpr int RING_BYTES = 131072;
constexpr int LDS_BYTES = 163840;
constexpr int LDSCTL_OFF = LDS_BYTES - 512;
constexpr int LDS_TICKET = 146432;

#define XB_TMO      128
#define XB_XCNT(j)  (256  + 64 * (j))
#define XB_XSUB(j)  (1280 + 64 * (j))
#define XB_XGEN(j)  (2304 + 64 * (j))
#define XB_TOP      3328
#define XB_TOPGEN   3392
#define XCD_BAR_WORDS 3456
#define XB_SPIN_CAP (1u << 18)

__device__ __forceinline__ unsigned xb_ld(unsigned* p)              { return __hip_atomic_load(p, __ATOMIC_RELAXED, __HIP_MEMORY_SCOPE_AGENT); }
__device__ __forceinline__ unsigned xb_add(unsigned* p, unsigned v) { return __hip_atomic_fetch_add(p, v, __ATOMIC_RELAXED, __HIP_MEMORY_SCOPE_AGENT); }
__device__ __forceinline__ unsigned xb_xcc_id() { return (unsigned)__builtin_amdgcn_s_getreg((3 << 11) | 20) & 0xFu; }
#define XB_SPIN(cond, bar) do { unsigned _sp = 0; while (cond) { __builtin_amdgcn_s_sleep(1); \
    if ((++_sp & 255u) == 0u) { if (xb_ld(&(bar)[XB_TMO])) break; if (_sp > XB_SPIN_CAP) { atomicAdd(&(bar)[XB_TMO], 1u); break; } } } } while (0)

struct XcdBarrier { unsigned* bar; unsigned x; volatile LAS unsigned* st; };

__device__ __forceinline__ XcdBarrier xcd_barrier_post(unsigned* bar, volatile LAS unsigned* st) {
    XcdBarrier b; b.bar = bar; b.x = xb_xcc_id(); b.st = st;
    if (threadIdx.x == 0) (void)xb_add(&bar[XB_XCNT(b.x)], 1u);
    return b;
}
__device__ __forceinline__ void xcd_barrier_complete(unsigned* bar, unsigned x, unsigned& nloc, unsigned& nx) {
    const unsigned G = gridDim.x * gridDim.y * gridDim.z;
    unsigned sum, cnt, mine, sp = 0u;
    for (;;) {
        sum = 0u; cnt = 0u; mine = 0u;
#pragma unroll
        for (unsigned j = 0; j < 16; ++j) { const unsigned c = xb_ld(&bar[XB_XCNT(j)]); sum += c; cnt += (c > 0u) ? 1u : 0u; mine = (j == x) ? c : mine; }
        if (sum == G) break;
        __builtin_amdgcn_s_sleep(1);
        if ((++sp & 255u) == 0u) { if (xb_ld(&bar[XB_TMO])) break; if (sp > XB_SPIN_CAP) { atomicAdd(&bar[XB_TMO], 1u); break; } }
    }
    nloc = mine > 0u ? mine : 1u; nx = cnt > 0u ? cnt : 1u;
}
__device__ __forceinline__ void xcd_barrier(const XcdBarrier& b) {
    asm volatile("s_waitcnt vmcnt(0)" ::: "memory");
    __syncthreads();
    if (threadIdx.x == 0) {
        unsigned* bar = b.bar;
        __builtin_amdgcn_s_waitcnt(0);
        unsigned nloc = b.st[0], nx = b.st[1];
        if (nloc == 0u) { xcd_barrier_complete(bar, b.x, nloc, nx); b.st[0] = nloc; b.st[1] = nx; }
        const unsigned old = xb_add(&bar[XB_XSUB(b.x)], 1u);
        const unsigned gen = old / nloc;
        if (old + 1u == (gen + 1u) * nloc) {
            __builtin_amdgcn_fence(__ATOMIC_RELEASE, "agent");
            asm volatile("s_waitcnt vmcnt(0)" ::: "memory");
            const unsigned og = xb_add(&bar[XB_TOP], 1u);
            const unsigned tg = og / nx;
            if (og + 1u == (tg + 1u) * nx) xb_add(&bar[XB_TOPGEN], 1u);
            else XB_SPIN(xb_ld(&bar[XB_TOPGEN]) == tg, bar);
            __builtin_amdgcn_fence(__ATOMIC_ACQUIRE, "agent");
            xb_add(&bar[XB_XGEN(b.x)], 1u);
            asm volatile("s_waitcnt vmcnt(0)" ::: "memory");
        } else {
            XB_SPIN(xb_ld(&bar[XB_XGEN(b.x)]) == gen, bar);
            __builtin_amdgcn_fence(__ATOMIC_ACQUIRE, "agent");
            asm volatile("s_waitcnt vmcnt(0)" ::: "memory");
        }
    }
    __syncthreads();
}


namespace pg8 {
constexpr int BM = 256, BK = 64, HALF = 128, HTB = HALF * BK * 2, STAGE_BYTES = 8 * HTB, NXCD = 8, WGM = 8;
__host__ __device__ __forceinline__ int lds_byte(int r, int c) { const int st = (r >> 4) * 2 + (c >> 5), rr = r & 15, cc = c & 31, ob = rr * 64 + cc * 2; return st * 1024 + (ob ^ (((ob >> 9) & 1) << 5)); }
__host__ __device__ __forceinline__ void stage_rc(int b, int& R, int& C) { const int st = b / 1024, sb = b % 1024, swz = sb ^ (((sb >> 9) & 1) << 5); R = (st >> 1) * 16 + swz / 64; C = (st & 1) * 32 + (swz % 64) / 2; }
struct Unit { int pm, pn, ko, nt, keep; };
struct Gemm { const h16* A; const h16* Bt; int lda, ldb, K; };
struct StaticOrder {
    int nM, nN, nwg, G, c;
    __host__ __device__ void init(int M, int N, int G_, int c_) { nM = M / BM; nN = N / BM; nwg = nM * nN; G = G_; c = c_; }
    __host__ __device__ bool next(int i, Unit& u) const {
        const long L = (long)i * G + c; if (L >= nwg) return false;
        int wgid = (int)L; { const int q = nwg / NXCD, r = nwg % NXCD, xcd = wgid % NXCD, off = wgid / NXCD; wgid = (xcd < r ? xcd * (q + 1) : r * (q + 1) + (xcd - r) * q) + off; }
        const int nig = WGM * nN, gid = wgid / nig, fm = gid * WGM, gsz = (nM - fm) < WGM ? (nM - fm) : WGM;
        u.pm = fm + ((wgid % nig) % gsz); u.pn = (wgid % nig) / gsz; u.ko = 0; u.nt = 0; u.keep = 0; return true;
    }
};
template <class Epi, class Sched, bool ALIGN_EPI = true>
__device__ __forceinline__ void gemm_phase(LAS unsigned char* lds, const Gemm g, const Sched& S, const Epi& E) {
    const int tid = threadIdx.x, wid = __builtin_amdgcn_readfirstlane(tid >> 6), lane = tid & 63, wr = wid >> 2, wc = wid & 3, fr = lane & 15, fq = lane >> 4;
    const int nt0 = g.K / BK;
    unsigned voffA[2], voffB[2];
#pragma unroll
    for (int i = 0; i < 2; ++i) { int R, C; stage_rc(tid * 16 + i * 8192, R, C); voffA[i] = (unsigned)(R * g.lda + C) * 2u; voffB[i] = (unsigned)(R * g.ldb + C) * 2u; }
    const size_t kstep = (size_t)(BK * 2);
    const size_t hstepA = (size_t)HALF * g.lda * 2, hstepB = (size_t)HALF * g.ldb * 2;
    const size_t tstepA = 2 * hstepA, tstepB = 2 * hstepB;
    const unsigned ldsw = (unsigned)wid * 1024u;
    const int aoff = lds_byte(wr * 64 + fr, fq * 8), boff = lds_byte(wc * 32 + fr, fq * 8);
#define PG8_SA(b, h) (((b) * 2 + (h)) * HTB)
#define PG8_SB(b, h) ((4 + (b) * 2 + (h)) * HTB)
#define PG8_STAGE(bufoff, gbase, voff) do { _Pragma("unroll") for (int _i = 0; _i < 2; ++_i) \
        __builtin_amdgcn_global_load_lds((const unsigned*)((const char*)(gbase) + (voff)[_i]), (LAS unsigned*)(lds + (bufoff) + ldsw + _i * 8192), 16, 0, 0); } while (0)
#define PG8_LDA(dst, b, h) do { _Pragma("unroll") for (int m = 0; m < 4; ++m) _Pragma("unroll") for (int k = 0; k < 2; ++k) dst[m][k] = *(const LAS h16x8*)(lds + PG8_SA(b, h) + aoff + m * 2048 + k * 1024); } while (0)
#define PG8_LDB(dst, b, h) do { _Pragma("unroll") for (int n = 0; n < 2; ++n) _Pragma("unroll") for (int k = 0; k < 2; ++k) dst[n][k] = *(const LAS h16x8*)(lds + PG8_SB(b, h) + boff + n * 2048 + k * 1024); } while (0)
#define PG8_MMA(ai, bj, At, Bt) do { __builtin_amdgcn_s_setprio(1); _Pragma("unroll") for (int m = 0; m < 4; ++m) _Pragma("unroll") for (int n = 0; n < 2; ++n) _Pragma("unroll") for (int k = 0; k < 2; ++k) \
        acc[ai][bj][m][n] = __builtin_amdgcn_mfma_f32_16x16x32_f16(Bt[n][k], At[m][k], acc[ai][bj][m][n], 0, 0, 0); __builtin_amdgcn_s_setprio(0); } while (0)
#define PG8_WAIT_V(n) asm volatile("s_waitcnt vmcnt(" #n ")" ::: "memory")
#define PG8_WAIT_L(n) asm volatile("s_waitcnt lgkmcnt(" #n ")" ::: "memory")
#define PG8_BAR __builtin_amdgcn_s_barrier()
#define PG8_SCHED __builtin_amdgcn_sched_barrier(0)
    Unit cur, nxt; int ui = 0;
    if (!S.next(0, cur)) return;
    f32x4 acc[2][2][4][2];
#pragma unroll
    for (int a = 0; a < 2; ++a)
#pragma unroll
        for (int b = 0; b < 2; ++b)
#pragma unroll
            for (int m = 0; m < 4; ++m)
#pragma unroll
                for (int n = 0; n < 2; ++n) acc[a][b][m][n] = (f32x4){0.f, 0.f, 0.f, 0.f};
    h16x8 At[4][2], B0[2][2], B1[2][2];
    const char* cA = (const char*)g.A + (size_t)cur.pm * tstepA + (size_t)cur.ko * 2; const char* cB = (const char*)g.Bt + (size_t)cur.pn * tstepB + (size_t)cur.ko * 2;
    {
        PG8_STAGE(PG8_SB(0, 0), cB, voffB); PG8_STAGE(PG8_SB(0, 1), cB + hstepB, voffB); PG8_STAGE(PG8_SA(0, 0), cA, voffA); PG8_STAGE(PG8_SA(0, 1), cA + hstepA, voffA);
        if (wr == 1) PG8_BAR;
        PG8_WAIT_V(2); PG8_BAR;
        PG8_STAGE(PG8_SB(1, 0), cB + kstep, voffB); PG8_STAGE(PG8_SA(1, 0), cA + kstep, voffA); PG8_STAGE(PG8_SB(1, 1), cB + hstepB + kstep, voffB);
        PG8_WAIT_V(6); PG8_BAR;
    }
    for (;;) {
        const bool has_next = S.next(ui + 1, nxt);
        const char* nA = has_next ? (const char*)g.A + (size_t)nxt.pm * tstepA + (size_t)nxt.ko * 2 : cA; const char* nB = has_next ? (const char*)g.Bt + (size_t)nxt.pn * tstepB + (size_t)nxt.ko * 2 : cB;
        int nt = cur.nt ? cur.nt : nt0; asm volatile("" : "+s"(nt));
        for (int t = 0; t < nt; t += 2) {
            const bool last = (t == nt - 2);
            const char* a1 = cA + (size_t)(t + 1) * kstep;
            const char* a2 = last ? nA : cA + (size_t)(t + 2) * kstep; const char* b2 = last ? nB : cB + (size_t)(t + 2) * kstep;
            const char* a3 = a2 + kstep; const char* b3 = b2 + kstep;
            PG8_LDB(B0, 0, 0); PG8_LDB(B1, 0, 1); PG8_SCHED; PG8_LDA(At, 0, 0); PG8_STAGE(PG8_SA(1, 1), a1 + hstepA, voffA);
            PG8_WAIT_V(8); PG8_WAIT_L(0); PG8_BAR; PG8_MMA(0, 0, At, B0); PG8_MMA(0, 1, At, B1); PG8_BAR; PG8_SCHED;
            PG8_LDA(At, 0, 1); PG8_STAGE(PG8_SB(0, 0), b2, voffB); PG8_STAGE(PG8_SB(0, 1), b2 + hstepB, voffB); PG8_STAGE(PG8_SA(0, 0), a2, voffA);
            PG8_WAIT_V(8); PG8_WAIT_L(0); PG8_BAR; PG8_MMA(1, 0, At, B0); PG8_MMA(1, 1, At, B1); PG8_BAR; PG8_SCHED;
            PG8_LDB(B0, 1, 0); PG8_LDB(B1, 1, 1); PG8_SCHED; PG8_LDA(At, 1, 0); PG8_STAGE(PG8_SA(0, 1), a2 + hstepA, voffA);
            PG8_WAIT_V(8); PG8_WAIT_L(0); PG8_BAR; PG8_MMA(0, 0, At, B0); PG8_MMA(0, 1, At, B1); PG8_BAR; PG8_SCHED;
            PG8_LDA(At, 1, 1); PG8_STAGE(PG8_SB(1, 0), b3, voffB); PG8_STAGE(PG8_SB(1, 1), b3 + hstepB, voffB); PG8_STAGE(PG8_SA(1, 0), a3, voffA);
            PG8_WAIT_V(8); PG8_WAIT_L(0); PG8_BAR; PG8_MMA(1, 0, At, B0); PG8_MMA(1, 1, At, B1); PG8_BAR; PG8_SCHED;
        }
        if constexpr (ALIGN_EPI) { if (wr == 0) PG8_BAR; }
        E(acc, cur, wr, wc, fr, fq);
        if (!has_next) break;
        if (!cur.keep) {
#pragma unroll
        for (int a = 0; a < 2; ++a)
#pragma unroll
            for (int b = 0; b < 2; ++b)
#pragma unroll
                for (int m = 0; m < 4; ++m)
#pragma unroll
                    for (int n = 0; n < 2; ++n) acc[a][b][m][n] = (f32x4){0.f, 0.f, 0.f, 0.f};
        }
        cur = nxt; cA = nA; cB = nB; ++ui;
        if constexpr (ALIGN_EPI) { if (wr == 1) PG8_BAR; }
    }
    PG8_WAIT_V(0);
    if constexpr (!ALIGN_EPI) { if (wr == 0) PG8_BAR; }
    PG8_BAR;
#undef PG8_SA
#undef PG8_SB
#undef PG8_STAGE
#undef PG8_LDA
#undef PG8_LDB
#undef PG8_MMA
#undef PG8_WAIT_V
#undef PG8_WAIT_L
#undef PG8_BAR
#undef PG8_SCHED
}
}

struct Frame {
    LAS unsigned char* lds;
    int tid, lane, wave, vcu, G;
    const float *x, *c, *ctx, *c_ctx, *w_mod, *b_mod, *norm_attn, *norm_ffn, *w_in, *ret_decay, *diff_lambda, *diff_subln,
                *w_ret_o, *w_diff_o, *w_out, *w_router, *router_bias, *w_exp_gu, *w_exp_down, *w_sh_gu, *w_sh_down, *final_norm;
    float* out;
    unsigned char* ws;
};

__device__ __forceinline__ float wave_sum(float v) {
#pragma unroll
    for (int o = 1; o < 64; o <<= 1) v += __shfl_xor(v, o);
    return v;
}
__device__ __forceinline__ unsigned pk2h(float lo, float hi) { f32x2 v = {lo, hi}; h16x2 h = __builtin_convertvector(v, h16x2); return __builtin_bit_cast(unsigned, h); }
__device__ __forceinline__ float silu_f(float v) { return v / (1.0f + __expf(-v)); }
__device__ __forceinline__ float sigmoid_f(float v) { return 1.0f / (1.0f + __expf(-v)); }

__device__ __forceinline__ void p0_mod_unit(Frame& F, int unit) {
    const int cb = unit % 24, ks = unit / 24;
    LAS float* sv = (LAS float*)F.lds;
    LAS float* red = sv + 768;
    for (int i = F.tid; i < 768; i += NTHR) { const int v = i >> 8, k = i & 255; const float cv = (v < 2) ? F.c[v * DM + ks * 256 + k] : F.c_ctx[ks * 256 + k]; sv[i] = silu_f(cv); }
    __syncthreads();
    const int cl = F.tid & 127, rl = F.tid >> 7;
    const float* wp = F.w_mod + (size_t)(ks * 256 + rl) * (6 * DM) + cb * 512 + cl * 4;
    f32x4 a0 = {0.f, 0.f, 0.f, 0.f}, a1 = a0, a2 = a0;
#pragma unroll 8
    for (int i = 0; i < 64; ++i) { const f32x4 w = *(const f32x4*)(wp + (size_t)i * 4 * (6 * DM)); const int k = rl + 4 * i; a0 += w * sv[k]; a1 += w * sv[256 + k]; a2 += w * sv[512 + k]; }
    *(LAS f32x4*)(red + (rl * 3 + 0) * 512 + cl * 4) = a0; *(LAS f32x4*)(red + (rl * 3 + 1) * 512 + cl * 4) = a1; *(LAS f32x4*)(red + (rl * 3 + 2) * 512 + cl * 4) = a2;
    __syncthreads();
    float* modp = (float*)(F.ws + WS_MODP);
    for (int i = F.tid; i < 1536; i += NTHR) { const int v = i >> 9, cc = i & 511; const float s = (red[(0 * 3 + v) * 512 + cc] + red[(1 * 3 + v) * 512 + cc]) + (red[(2 * 3 + v) * 512 + cc] + red[(3 * 3 + v) * 512 + cc]);
        modp[(size_t)(ks * 3 + v) * (6 * DM) + cb * 512 + cc] = s; }
    __syncthreads();
}
template <int MAP>
__device__ __forceinline__ void p0_transpose_item(const float* W, int K, int N, h16* WT, LAS float* scr, int item, int lane, int ldd = 0) {
    if (ldd == 0) ldd = K;
    const int nblk = N / 32, kb = item / nblk, nb = item % nblk, k0 = 64 * kb, n0 = 32 * nb;
#pragma unroll 8
    for (int i = 0; i < 32; ++i) { const int kk = 2 * i + (lane >> 5); scr[kk * 33 + (lane & 31)] = W[(size_t)(k0 + kk) * N + n0 + (lane & 31)]; }
    asm volatile("s_waitcnt lgkmcnt(0)" ::: "memory");
    const int cch = lane & 7;
#pragma unroll
    for (int j = 0; j < 4; ++j) { const int n = (lane >> 3) + 8 * j; const LAS float* s = scr + (8 * cch) * 33 + n;
        u32x4 o; o.x = pk2h(s[0 * 33], s[1 * 33]); o.y = pk2h(s[2 * 33], s[3 * 33]); o.z = pk2h(s[4 * 33], s[5 * 33]); o.w = pk2h(s[6 * 33], s[7 * 33]);
        int nn = n0 + n;
        if (MAP == 1) { const bool isrope = (nn < 1024) || (nn >= C_RQ && nn < C_RQ + 1024); if (isrope) nn = (nn & ~48) | ((nn & 16) << 1) | ((nn & 32) >> 1); }
        if (MAP == 2) { const int j = nn & 255, isu = nn >> 8; nn = 32 * (j >> 4) + 16 * isu + (j & 15); }
        *(u32x4*)(WT + (size_t)nn * ldd + k0 + 8 * cch) = o; }
    asm volatile("s_waitcnt lgkmcnt(0)" ::: "memory");
}
__device__ __forceinline__ void p0a_mod(Frame& F) {
    for (int u = F.vcu; u < 192; u += F.G) p0_mod_unit(F, u);
}
__device__ __forceinline__ void p0b_weights(Frame& F) {
    __syncthreads();
    LAS float* scr = (LAS float*)(F.lds + F.wave * 16384);
    const int gw = F.vcu * NWAVES + F.wave, NGW = F.G * NWAVES;
    constexpr int I_IN = (DM / 64) * (IN_COLS / 32);
    for (int it = gw; it < I_IN; it += NGW) p0_transpose_item<1>(F.w_in, DM, IN_COLS, (h16*)(F.ws + WS_WINT), scr, it, F.lane);
    if (blockIdx.x == 0) {
        float* rope = (float*)(F.ws + WS_ROPE);
        for (int i = F.tid; i < 64 * 32; i += NTHR) { const int pos = i >> 5, j = i & 31; const float inv = exp2f(-(float)j * (13.287712379549449f / 32.0f)); const float ang = (float)pos * inv; rope[i] = cosf(ang); rope[2048 + i] = sinf(ang); }
        for (int i = F.tid; i < 64 * 16; i += NTHR) { const int pos = i >> 4, j = i & 15; const float inv = exp2f(-(float)j * (13.287712379549449f / 16.0f)); const float ang = (float)pos * inv; rope[4096 + i] = cosf(ang); rope[4096 + 1024 + i] = sinf(ang); }
    }
}
__device__ __forceinline__ void p0c_weights_dyn(Frame& F, int qid) {
    unsigned* QH = (unsigned*)(F.ws + WS_CTL) + CW_Q + 64 * 8 * qid;
    LAS int* RED = (LAS int*)(F.lds + LDS_TICKET);
    LAS float* scr = (LAS float*)(F.lds + F.wave * 16384);
    constexpr int I_RET = (2048 / 64) * (DM / 32), I_DIF = (1024 / 64) * (DM / 32), I_OUT = (DM / 64) * (DM / 32), I_SGU = (DM / 64) * (512 / 32), I_SDN = (256 / 64) * (DM / 32), I_RT = NEXP * DM / 4 / 64;
    constexpr int NITEMS = I_RET + I_DIF + I_OUT + I_SGU + I_SDN + I_RT, NTICK = (NITEMS + 7) / 8;
    for (;;) {
        __syncthreads();
        if (F.tid == 0) RED[0] = (int)__hip_atomic_fetch_add(QH, 1u, __ATOMIC_RELAXED, __HIP_MEMORY_SCOPE_AGENT);
        __syncthreads();
        const int t = RED[0];
        if (t >= NTICK) break;
        int r = t * 8 + F.wave;
        if (r >= NITEMS) continue;
        if (r < I_RET) { p0_transpose_item<0>(F.w_ret_o, 2048, DM, (h16*)(F.ws + WS_WCAT), scr, r, F.lane, 3072); continue; } r -= I_RET;
        if (r < I_DIF) { p0_transpose_item<0>(F.w_diff_o, 1024, DM, (h16*)(F.ws + WS_WCAT) + 2048, scr, r, F.lane, 3072); continue; } r -= I_DIF;
        if (r < I_OUT) { p0_transpose_item<0>(F.w_out, DM, DM, (h16*)(F.ws + WS_WOUT), scr, r, F.lane); continue; } r -= I_OUT;
        if (r < I_SGU) { p0_transpose_item<2>(F.w_sh_gu, DM, 512, (h16*)(F.ws + WS_WSGU), scr, r, F.lane); continue; } r -= I_SGU;
        if (r < I_SDN) { p0_transpose_item<0>(F.w_sh_down, 256, DM, (h16*)(F.ws + WS_WSDN), scr, r, F.lane); continue; } r -= I_SDN;
        {
            const int q = r * 64 + F.lane, e = q / (DM / 4), k = (q % (DM / 4)) * 4;
            const f32x4 w = *(const f32x4*)(F.w_router + (size_t)e * DM + k);
            h16 hi[4], lo[4];
#pragma unroll
            for (int j = 0; j < 4; ++j) { hi[j] = (h16)w[j]; lo[j] = (h16)(w[j] - (float)hi[j]); }
            h16* dst = (h16*)(F.ws + WS_WRTR) + (size_t)e * 6144 + k;
            *(h16x4*)(dst) = (h16x4){hi[0], hi[1], hi[2], hi[3]}; *(h16x4*)(dst + 2048) = (h16x4){hi[0], hi[1], hi[2], hi[3]}; *(h16x4*)(dst + 4096) = (h16x4){lo[0], lo[1], lo[2], lo[3]};
        }
    }
}

__device__ __forceinline__ void p1_norm1(Frame& F) {
    LAS float* msh = (LAS float*)F.lds; LAS float* msc = msh + 3 * DM;
    const float* modp = (const float*)(F.ws + WS_MODP);
    for (int i = F.tid; i < 3 * 2 * DM; i += NTHR) { const int v = i / (2 * DM), cc = i % (2 * DM); float s = F.b_mod[cc];
#pragma unroll
        for (int ks = 0; ks < 8; ++ks) s += modp[(size_t)(ks * 3 + v) * (6 * DM) + cc];
        if (cc < DM) msh[v * DM + cc] = s; else msc[v * DM + cc - DM] = s; }
    __syncthreads();
    const int gw = F.vcu * NWAVES + F.wave, NGW = F.G * NWAVES;
    h16* H = (h16*)(F.ws + WS_H);
    for (int r = gw; r < MALL; r += NGW) {
        const float* src = (r < MLAT) ? F.x + (size_t)r * DM : F.ctx + (size_t)(r - MLAT) * DM; const int v = (r < MLAT) ? (r / SEQ) : 2;
        f32x4 xv[8]; float ss = 0.f;
#pragma unroll
        for (int j = 0; j < 8; ++j) { xv[j] = *(const f32x4*)(src + 4 * F.lane + 256 * j); ss += (xv[j].x * xv[j].x + xv[j].y * xv[j].y) + (xv[j].z * xv[j].z + xv[j].w * xv[j].w); }
        const float rstd = 1.0f / sqrtf(wave_sum(ss) * (1.0f / DM) + EPS);
#pragma unroll
        for (int j = 0; j < 8; ++j) { const int cc = 4 * F.lane + 256 * j; const f32x4 nw = *(const f32x4*)(F.norm_attn + cc);
            const f32x4 sc = *(LAS f32x4*)(msc + v * DM + cc), sh = *(LAS f32x4*)(msh + v * DM + cc);
            const f32x4 y = xv[j] * rstd * nw * (sc + 1.0f) + sh;
            u32x2 o; o.x = pk2h(y.x, y.y); o.y = pk2h(y.z, y.w); *(u32x2*)(H + (size_t)r * DM + cc) = o; }
    }
    float* MOD = (float*)(F.ws + WS_MOD);
    for (int i = blockIdx.x * NTHR + F.tid; i < 3 * 6 * DM; i += F.G * NTHR) { const int v = i / (6 * DM), cc = i % (6 * DM); float s = F.b_mod[cc];
#pragma unroll
        for (int ks = 0; ks < 8; ++ks) s += modp[(size_t)(ks * 3 + v) * (6 * DM) + cc];
        MOD[i] = s; }
}


__device__ __forceinline__ int crow(int r, int hi) { return (r & 3) + 8 * (r >> 2) + 4 * hi; }
__device__ __forceinline__ h16x8 frag_row(const LAS unsigned char* base, int strideB, int r0, int k0, int lane) {
    return *(const LAS h16x8*)(base + (r0 + (lane & 31)) * strideB + (k0 + 8 * (lane >> 5)) * 2);
}
__device__ __forceinline__ v4i16_t tr16(const LAS unsigned char* p) { return __builtin_amdgcn_ds_read_tr16_b64_v4i16((LAS v4i16_t*)p); }
__device__ __forceinline__ h16x8 frag_tr(const LAS unsigned char* base, int strideB, int k0, int n0, int lane) {
    const int kb = k0 + 8 * (lane >> 5) + ((lane & 15) >> 2), nc = n0 + 16 * ((lane >> 4) & 1) + 4 * (lane & 3);
    const LAS unsigned char* p = base + kb * strideB + nc * 2;
    const v4i16_t lo = tr16(p), hi = tr16(p + 4 * strideB);
    typedef short s16x8 __attribute__((ext_vector_type(8)));
    const s16x8 v = {lo[0], lo[1], lo[2], lo[3], hi[0], hi[1], hi[2], hi[3]};
    return __builtin_bit_cast(h16x8, v);
}
__device__ __forceinline__ h16x8 frag_tr_perm(const LAS unsigned char* base, int strideB, int k0, int n0, int lane) {
    const int kb = k0 + 4 * (lane >> 5) + ((lane & 15) >> 2), nc = n0 + 16 * ((lane >> 4) & 1) + 4 * (lane & 3);
    const LAS unsigned char* p = base + kb * strideB + nc * 2;
    const v4i16_t lo = tr16(p), hi = tr16(p + 8 * strideB);
    typedef short s16x8 __attribute__((ext_vector_type(8)));
    const s16x8 v = {lo[0], lo[1], lo[2], lo[3], hi[0], hi[1], hi[2], hi[3]};
    return __builtin_bit_cast(h16x8, v);
}
__device__ __forceinline__ h16x8 pack8(float a0, float a1, float a2, float a3, float a4, float a5, float a6, float a7) {
    u32x4 w; w.x = pk2h(a0, a1); w.y = pk2h(a2, a3); w.z = pk2h(a4, a5); w.w = pk2h(a6, a7); return __builtin_bit_cast(h16x8, w);
}
#define MFMA32(a, b, c) __builtin_amdgcn_mfma_f32_32x32x16_f16((a), (b), (c), 0, 0, 0)

struct SchedG1 {
    pg8::StaticOrder so; int G, c;
    __device__ __forceinline__ bool next(int i, pg8::Unit& u) const {
        const int L = i * G + c;
        if (L < 32 * 52) return so.next(i, u);
        const int r = L - 32 * 52; if (r >= 40) return false;
        u.pm = 32 + r / 20; u.pn = r % 20; u.ko = 0; u.nt = 0; u.keep = 0; return true;
    }
};
struct EpiP {
    h16* P; const float* rope;
    __device__ __forceinline__ void operator()(f32x4 (&acc)[2][2][4][2], const pg8::Unit& u, int wr, int wc, int fr, int fq) const {
        const int colt = u.pn * 256; const bool lat = u.pm < 32;
        int kind;
        if (colt < C_RV) kind = 1; else if (colt < C_DK) kind = 0; else if (colt < C_DV) kind = 3; else if (colt < C_RQ) kind = 0; else if (colt < C_RG) kind = 2; else if (colt < C_DQ) kind = 5; else if (colt < C_GR) kind = 4; else kind = 6;
        if (!lat) kind = (kind == 1) ? 7 : 0;
#pragma unroll
        for (int ai = 0; ai < 2; ++ai)
#pragma unroll
            for (int m = 0; m < 4; ++m) {
                const int row = u.pm * 256 + ai * 128 + wr * 64 + m * 16 + fr; const int t = row & (SEQ - 1);
                h16* prow = P + (size_t)row * IN_COLS;
#pragma unroll
                for (int bj = 0; bj < 2; ++bj) {
                    const int cbase = colt + bj * 128 + wc * 32;
                    const f32x4 x0 = acc[ai][bj][m][0], x1 = acc[ai][bj][m][1];
                    f32x4 o0, o1; int c0, c1;
                    if (kind == 1 || kind == 2) {
                        const int g5 = (cbase >> 5) & 1, axis = (cbase >> 6) & 1, pos = axis ? (t & 63) : (t >> 6), j0 = 16 * g5 + 4 * fq;
                        const f32x4 cs = *(const f32x4*)(rope + pos * 32 + j0), sn = *(const f32x4*)(rope + 2048 + pos * 32 + j0);
                        o0 = x0 * cs - x1 * sn; o1 = x0 * sn + x1 * cs;
                        if (kind == 2) { o0 *= 0.08838834764831845f; o1 *= 0.08838834764831845f; }
                        c0 = (cbase & ~63) + j0; c1 = c0 + 32;
                    } else if (kind == 7) {
                        const int g5 = (cbase >> 5) & 1; c0 = (cbase & ~63) + 16 * g5 + 4 * fq; c1 = c0 + 32; o0 = x0; o1 = x1;
                    } else if (kind == 3 || kind == 4) {
                        const int axis = (cbase >> 5) & 1, pos = axis ? (t & 63) : (t >> 6), j0 = 4 * fq;
                        const f32x4 cs = *(const f32x4*)(rope + 4096 + pos * 16 + j0), sn = *(const f32x4*)(rope + 5120 + pos * 16 + j0);
                        o0 = x0 * cs - x1 * sn; o1 = x0 * sn + x1 * cs;
                        if (kind == 4) { o0 *= 0.18033688011112042f; o1 *= 0.18033688011112042f; }
                        c0 = cbase + j0; c1 = c0 + 16;
                    } else {
                        c0 = cbase + 4 * fq; c1 = c0 + 16; o0 = x0; o1 = x1;
                        if (kind == 5) {
#pragma unroll
                            for (int e = 0; e < 4; ++e) { o0[e] = silu_f(x0[e]); o1[e] = silu_f(x1[e]); }
                        } else if (kind == 6) {
#pragma unroll
                            for (int e = 0; e < 4; ++e) { o0[e] = sigmoid_f(x0[e]); o1[e] = sigmoid_f(x1[e]); }
                        }
                    }
                    u32x2 w0, w1; w0.x = pk2h(o0[0], o0[1]); w0.y = pk2h(o0[2], o0[3]); w1.x = pk2h(o1[0], o1[1]); w1.y = pk2h(o1[2], o1[3]);
                    *(u32x2*)(prow + c0) = w0; *(u32x2*)(prow + c1) = w1;
                }
            }
    }
};
__device__ __forceinline__ void p2_gemm1(Frame& F) {
    pg8::Gemm g{(const h16*)(F.ws + WS_H), (const h16*)(F.ws + WS_WINT), DM, DM, DM};
    SchedG1 S; S.so.init(MLAT, IN_COLS, F.G, (int)blockIdx.x); S.G = F.G; S.c = (int)blockIdx.x;
    EpiP E{(h16*)(F.ws + WS_P), (const float*)(F.ws + WS_ROPE)};
    pg8::gemm_phase<EpiP, SchedG1>(F.lds, g, S, E);
}

__device__ __forceinline__ void p3_ret_local(Frame& F) {
    LAS unsigned char* KF = F.lds; LAS unsigned char* KB = F.lds + 40960; LAS unsigned char* VH = F.lds + 81920;
    const h16* P = (const h16*)(F.ws + WS_P); h16* LST = (h16*)(F.ws + WS_LST);
    const int hi = F.lane >> 5;
    for (int u = F.vcu; u < 16 * 34; u += F.G) {
        const int bh = u / 34, cc = u % 34, b = bh >> 3, h = bh & 7;
        const int row0 = (cc < 2) ? (MLAT + b * CTXL + cc * 128) : (b * SEQ + (cc - 2) * 128);
        const float lgf = -__expf(F.ret_decay[h]), lgb = -__expf(F.ret_decay[8 + h]);
#pragma unroll
        for (int i = 0; i < 4; ++i) { const int q = F.tid + NTHR * i, row = q >> 4, ch = q & 15;
            const h16x8 kv = *(const h16x8*)(P + (size_t)(row0 + row) * IN_COLS + C_RK + h * 128 + ch * 8);
            const float sf = __expf(lgf * (float)(127 - row)), sb = __expf(lgb * (float)row);
            *(LAS h16x8*)(KF + row * 320 + ch * 16) = pack8((float)kv[0] * sf, (float)kv[1] * sf, (float)kv[2] * sf, (float)kv[3] * sf, (float)kv[4] * sf, (float)kv[5] * sf, (float)kv[6] * sf, (float)kv[7] * sf);
            *(LAS h16x8*)(KB + row * 320 + ch * 16) = pack8((float)kv[0] * sb, (float)kv[1] * sb, (float)kv[2] * sb, (float)kv[3] * sb, (float)kv[4] * sb, (float)kv[5] * sb, (float)kv[6] * sb, (float)kv[7] * sb); }
        for (int eh = 0; eh < 2; ++eh) {
            if (eh) __syncthreads();
#pragma unroll
            for (int i = 0; i < 4; ++i) { const int q = F.tid + NTHR * i, row = q >> 4, ch = q & 15;
                *(LAS h16x8*)(VH + row * 320 + ch * 16) = *(const h16x8*)(P + (size_t)(row0 + row) * IN_COLS + C_RV + h * 256 + eh * 128 + ch * 8); }
            __syncthreads();
            const int dir = F.wave >> 2, eb = F.wave & 3; const LAS unsigned char* Kd = dir ? KB : KF;
            f32x16 acc[4];
#pragma unroll
            for (int db = 0; db < 4; ++db) acc[db] = (f32x16){};
#pragma unroll
            for (int ks = 0; ks < 8; ++ks) { const h16x8 a = frag_tr(VH, 320, 16 * ks, 32 * eb, F.lane);
#pragma unroll
                for (int db = 0; db < 4; ++db) { const h16x8 bb = frag_tr(Kd, 320, 16 * ks, 32 * db, F.lane); acc[db] = MFMA32(a, bb, acc[db]); } }
            h16* dst = LST + ((size_t)((dir * 16 + bh) * 34 + cc) * 256 + eh * 128 + eb * 32) * 128;
#pragma unroll
            for (int db = 0; db < 4; ++db)
#pragma unroll
                for (int r = 0; r < 16; ++r) dst[crow(r, hi) * 128 + db * 32 + (F.lane & 31)] = (h16)acc[db][r];
        }
        __syncthreads();
    }
}
__device__ __forceinline__ void p4_ret_scan(Frame& F) {
    const h16* LST = (const h16*)(F.ws + WS_LST); h16* SST = (h16*)(F.ws + WS_SST);
    for (int g = blockIdx.x * NTHR + F.tid; g < 2 * 16 * 4096; g += F.G * NTHR) {
        const int seq = g >> 12, off = (g & 4095) * 8, dir = seq >> 4, bh = seq & 15, h = bh & 7;
        const float cd = __expf(-__expf(F.ret_decay[dir * 8 + h]) * 128.0f);
        const h16* Lp = LST + (size_t)seq * 34 * 32768 + off; h16* Sp = SST + (size_t)seq * 32 * 32768 + off;
        float s[8];
#pragma unroll
        for (int e = 0; e < 8; ++e) s[e] = 0.f;
        if (dir == 0) {
            for (int cc = 0; cc < 33; ++cc) {
                if (cc >= 2) *(h16x8*)(Sp + (size_t)(cc - 2) * 32768) = pack8(s[0], s[1], s[2], s[3], s[4], s[5], s[6], s[7]);
                const h16x8 l = *(const h16x8*)(Lp + (size_t)cc * 32768);
#pragma unroll
                for (int e = 0; e < 8; ++e) s[e] = s[e] * cd + (float)l[e];
            }
            *(h16x8*)(Sp + (size_t)31 * 32768) = pack8(s[0], s[1], s[2], s[3], s[4], s[5], s[6], s[7]);
        } else {
            { const h16x8 l1 = *(const h16x8*)(Lp + (size_t)1 * 32768), l0 = *(const h16x8*)(Lp);
#pragma unroll
              for (int e = 0; e < 8; ++e) s[e] = (float)l1[e] * cd + (float)l0[e]; }
            for (int c = 31; c >= 0; --c) {
                *(h16x8*)(Sp + (size_t)c * 32768) = pack8(s[0], s[1], s[2], s[3], s[4], s[5], s[6], s[7]);
                const h16x8 l = *(const h16x8*)(Lp + (size_t)(c + 2) * 32768);
#pragma unroll
                for (int e = 0; e < 8; ++e) s[e] = s[e] * cd + (float)l[e];
            }
        }
    }
}
__device__ __forceinline__ void p5_ret_out(Frame& F) {
    LAS unsigned char* QL = F.lds; LAS unsigned char* KL = F.lds + 34816; LAS unsigned char* PL = KL; LAS unsigned char* VL = F.lds + 69632;
    LAS float* RED = (LAS float*)(F.lds + 69632 + 73728);
    const h16* P = (const h16*)(F.ws + WS_P); const h16* SST = (const h16*)(F.ws + WS_SST); h16* ARET = (h16*)(F.ws + WS_ACAT);
    const int hi = F.lane >> 5, ln = F.lane & 31, w = F.wave;
    for (int u = F.vcu; u < 512; u += F.G) {
        const int bh = u >> 5, c = u & 31, b = bh >> 3, h = bh & 7, row0 = b * SEQ + c * 128;
        const float lgf = -__expf(F.ret_decay[h]), lgb = -__expf(F.ret_decay[8 + h]);
#pragma unroll
        for (int i = 0; i < 4; ++i) { const int q = F.tid + NTHR * i, row = q >> 4, ch = q & 15; const h16* pr = P + (size_t)(row0 + row) * IN_COLS + h * 128 + ch * 8;
            *(LAS h16x8*)(QL + row * 272 + ch * 16) = *(const h16x8*)(pr + C_RQ); *(LAS h16x8*)(KL + row * 272 + ch * 16) = *(const h16x8*)(pr + C_RK); }
        h16x8 vreg[8];
#pragma unroll
        for (int i = 0; i < 8; ++i) { const int q = F.tid + NTHR * i, row = q >> 5, c32 = q & 31; vreg[i] = *(const h16x8*)(P + (size_t)(row0 + row) * IN_COLS + C_RV + h * 256 + c32 * 8); }
        __syncthreads();
        u32x2 pw[2][4];
        { const int jt = w >> 1;
#pragma unroll
          for (int t2 = 0; t2 < 2; ++t2) { const int ib = 2 * (w & 1) + t2, il = 32 * ib + ln; f32x16 s = (f32x16){};
#pragma unroll
            for (int ks = 0; ks < 8; ++ks) s = MFMA32(frag_row(KL, 272, 32 * jt, 16 * ks, F.lane), frag_row(QL, 272, 32 * ib, 16 * ks, F.lane), s);
#pragma unroll
            for (int r = 0; r < 16; ++r) { const int d = il - (32 * jt + crow(r, hi)); s[r] *= (d >= 0) ? __expf(lgf * (float)d) : __expf(lgb * (float)(-d)); }
#pragma unroll
            for (int r4 = 0; r4 < 4; ++r4) { pw[t2][r4].x = pk2h(s[4 * r4], s[4 * r4 + 1]); pw[t2][r4].y = pk2h(s[4 * r4 + 2], s[4 * r4 + 3]); } } }
        __syncthreads();
        { const int jt = w >> 1;
#pragma unroll
          for (int t2 = 0; t2 < 2; ++t2) { const int il = 32 * (2 * (w & 1) + t2) + ln;
#pragma unroll
            for (int r4 = 0; r4 < 4; ++r4) *(LAS u32x2*)(PL + il * 272 + (32 * jt + 8 * r4 + 4 * hi) * 2) = pw[t2][r4]; } }
#pragma unroll
        for (int i = 0; i < 8; ++i) { const int q = F.tid + NTHR * i, row = q >> 5, c32 = q & 31; *(LAS h16x8*)(VL + row * 576 + c32 * 16) = vreg[i]; }
        __syncthreads();
        f32x16 o[4];
#pragma unroll
        for (int ib = 0; ib < 4; ++ib) o[ib] = (f32x16){};
#pragma unroll
        for (int k16 = 0; k16 < 8; ++k16) { const h16x8 a = frag_tr(VL, 576, 16 * k16, 32 * w, F.lane);
#pragma unroll
            for (int ib = 0; ib < 4; ++ib) o[ib] = MFMA32(a, frag_row(PL, 272, 32 * ib, 16 * k16, F.lane), o[ib]);
            if (k16 & 1) __builtin_amdgcn_sched_barrier(0); }
#pragma unroll
        for (int dir = 0; dir < 2; ++dir) {
            h16 sc[4];
#pragma unroll
            for (int ib = 0; ib < 4; ++ib) { const int il = 32 * ib + ln; sc[ib] = (h16)(dir ? __expf(lgb * (float)(128 - il)) : __expf(lgf * (float)(il + 1))); }
            const h16* Sg = SST + ((size_t)((dir * 16 + bh) * 32 + c) * 256 + 32 * w + ln) * 128 + 8 * hi;
#pragma unroll
            for (int kh = 0; kh < 2; ++kh) {
                h16x8 sa[4];
#pragma unroll
                for (int k4 = 0; k4 < 4; ++k4) sa[k4] = *(const h16x8*)(Sg + 16 * (4 * kh + k4));
#pragma unroll
                for (int k4 = 0; k4 < 4; ++k4) {
#pragma unroll
                    for (int ib = 0; ib < 4; ++ib) o[ib] = MFMA32(sa[k4], frag_row(QL, 272, 32 * ib, 16 * (4 * kh + k4), F.lane) * sc[ib], o[ib]);
                    __builtin_amdgcn_sched_barrier(0); }
            }
        }
#pragma unroll
        for (int ib = 0; ib < 4; ++ib) { float ss = 0.f;
#pragma unroll
            for (int r = 0; r < 16; ++r) ss += o[ib][r] * o[ib][r];
            ss += __shfl_xor(ss, 32);
            if (hi == 0) RED[(w * 4 + ib) * 32 + ln] = ss; }
        __syncthreads();
#pragma unroll
        for (int ib = 0; ib < 4; ++ib) { float tot = 0.f;
#pragma unroll
            for (int ww = 0; ww < 8; ++ww) tot += RED[(ww * 4 + ib) * 32 + ln];
            const float rstd = 1.0f / sqrtf(tot * (1.0f / 256.0f) + EPS);
            const size_t grow = (size_t)(row0 + 32 * ib + ln);
#pragma unroll
            for (int r4 = 0; r4 < 4; ++r4) { const int e = 32 * w + 8 * r4 + 4 * hi;
                const h16x4 gt = *(const h16x4*)(P + grow * IN_COLS + C_RG + h * 256 + e);
                u32x2 wv; wv.x = pk2h(o[ib][4 * r4] * rstd * (float)gt[0], o[ib][4 * r4 + 1] * rstd * (float)gt[1]); wv.y = pk2h(o[ib][4 * r4 + 2] * rstd * (float)gt[2], o[ib][4 * r4 + 3] * rstd * (float)gt[3]);
                *(u32x2*)(ARET + grow * 3072 + h * 256 + e) = wv; } }
        __syncthreads();
    }
}
__device__ __forceinline__ void p6_attn(Frame& F) {
    const h16* P = (const h16*)(F.ws + WS_P); h16* ADIF = (h16*)(F.ws + WS_ACAT) + 2048;
    const int hi = F.lane >> 5, ln = F.lane & 31;
    float lam;
    { const float s1 = wave_sum(F.diff_lambda[F.lane] * F.diff_lambda[64 + F.lane]), s2 = wave_sum(F.diff_lambda[128 + F.lane] * F.diff_lambda[192 + F.lane]); lam = __expf(s1) - __expf(s2) + 0.2f; }
    constexpr int KT0 = 0, VT0 = 34816, KTB = 17408, VTB = 20480;
    LAS float* XB = (LAS float*)F.lds;
    for (int u = F.vcu; u < 512; u += F.G) {
        const int bh = u >> 5, qb = u & 31, b = bh >> 3, h = bh & 7;
        const int cm = F.wave & 1, qs = F.wave >> 1, qrow0 = b * SEQ + qb * 128 + qs * 32;
        h16x8 qf[4];
#pragma unroll
        for (int ks = 0; ks < 4; ++ks) qf[ks] = *(const h16x8*)(P + (size_t)(qrow0 + ln) * IN_COLS + C_DQ + h * 128 + cm * 64 + 16 * ks + 8 * hi);
        f32x16 o[4];
#pragma unroll
        for (int et = 0; et < 4; ++et) o[et] = (f32x16){};
        float mrun = 0.f, lsum = 0.f; f32x16 negm = (f32x16){};
        h16x8 kreg[2], vreg[2];
#define ATT_LOAD(t) do { _Pragma("unroll") for (int i = 0; i < 2; ++i) { const int q = F.tid + NTHR * i, row = q >> 4, ch = q & 15; const int j = (t) * 64 + row; \
            const size_t srow = (j < CTXL) ? (size_t)(MLAT + b * CTXL + j) : (size_t)(b * SEQ + j - CTXL); const h16* pr = P + srow * IN_COLS + h * 128 + ch * 8; \
            kreg[i] = *(const h16x8*)(pr + C_DK); vreg[i] = *(const h16x8*)(pr + C_DV); } } while (0)
#define ATT_WRITE(buf) do { _Pragma("unroll") for (int i = 0; i < 2; ++i) { const int q = F.tid + NTHR * i, row = q >> 4, ch = q & 15; \
            *(LAS h16x8*)(F.lds + KT0 + (buf) * KTB + row * 272 + ch * 16) = kreg[i]; *(LAS h16x8*)(F.lds + VT0 + (buf) * VTB + row * 320 + ch * 16) = vreg[i]; } } while (0)
        ATT_LOAD(0); ATT_WRITE(0);
        __syncthreads();
        constexpr int NT = (CTXL + SEQ) / 64;
        for (int t = 0; t < NT; ++t) {
            const int buf = t & 1;
            if (t + 1 < NT) ATT_LOAD(t + 1);
            const LAS unsigned char* Kt = F.lds + KT0 + buf * KTB; const LAS unsigned char* Vt = F.lds + VT0 + buf * VTB;
            f32x16 s[2];
#pragma unroll
            for (int kt = 0; kt < 2; ++kt) { s[kt] = negm;
#pragma unroll
                for (int ks = 0; ks < 4; ++ks) s[kt] = MFMA32(frag_row(Kt, 272, 32 * kt, cm * 64 + 16 * ks, F.lane), qf[ks], s[kt]); }
            float mx = s[0][0];
#pragma unroll
            for (int r = 0; r < 16; ++r) { mx = fmaxf(mx, s[0][r]); mx = fmaxf(mx, s[1][r]); }
            { const auto rr = __builtin_amdgcn_permlane32_swap(__float_as_uint(mx), __float_as_uint(mx), false, false); mx = fmaxf(__uint_as_float(rr[0]), __uint_as_float(rr[1])); }
            if (t == 0 || __any(mx > 8.0f)) { const float dl = (t == 0) ? mx : fmaxf(mx, 0.0f), alpha = (t == 0) ? 0.0f : __builtin_amdgcn_exp2f(-dl); mrun += dl; lsum *= alpha;
#pragma unroll
                for (int et = 0; et < 4; ++et) o[et] *= alpha;
#pragma unroll
                for (int kt = 0; kt < 2; ++kt)
#pragma unroll
                    for (int r = 0; r < 16; ++r) s[kt][r] -= dl;
#pragma unroll
                for (int r = 0; r < 16; ++r) negm[r] = -mrun; }
            float ps = 0.f;
#pragma unroll
            for (int kt = 0; kt < 2; ++kt)
#pragma unroll
                for (int r = 0; r < 16; ++r) { s[kt][r] = __builtin_amdgcn_exp2f(s[kt][r]); ps += s[kt][r]; }
            lsum += ps;
#pragma unroll
            for (int kt = 0; kt < 2; ++kt)
#pragma unroll
                for (int s2 = 0; s2 < 2; ++s2) {
                    const h16x8 pbf = pack8(s[kt][8 * s2], s[kt][8 * s2 + 1], s[kt][8 * s2 + 2], s[kt][8 * s2 + 3], s[kt][8 * s2 + 4], s[kt][8 * s2 + 5], s[kt][8 * s2 + 6], s[kt][8 * s2 + 7]);
#pragma unroll
                    for (int et = 0; et < 4; ++et) o[et] = MFMA32(frag_tr_perm(Vt, 320, 32 * kt + 16 * s2, 32 * et, F.lane), pbf, o[et]);
                }
            if (t + 1 < NT) ATT_WRITE(buf ^ 1);
            __syncthreads();
        }
#undef ATT_LOAD
#undef ATT_WRITE
        lsum += __shfl_xor(lsum, 32);
        const float inv = 1.0f / lsum;
        if (cm == 1) {
#pragma unroll
            for (int et = 0; et < 4; ++et)
#pragma unroll
                for (int r = 0; r < 16; ++r) XB[(qs * 128 + 32 * et + crow(r, hi)) * 32 + ln] = o[et][r] * inv;
        }
        __syncthreads();
        if (cm == 0) {
            float ss = 0.f;
#pragma unroll
            for (int et = 0; et < 4; ++et)
#pragma unroll
                for (int r = 0; r < 16; ++r) { const float v = o[et][r] * inv - lam * XB[(qs * 128 + 32 * et + crow(r, hi)) * 32 + ln]; o[et][r] = v; ss += v * v; }
            ss += __shfl_xor(ss, 32);
            const float rstd = 0.8f / sqrtf(ss * (1.0f / 128.0f) + EPS);
            const size_t grow = (size_t)(qrow0 + ln);
#pragma unroll
            for (int et = 0; et < 4; ++et)
#pragma unroll
                for (int r4 = 0; r4 < 4; ++r4) { const int e = 32 * et + 8 * r4 + 4 * hi; const f32x4 sw = *(const f32x4*)(F.diff_subln + e);
                    u32x2 w; w.x = pk2h(o[et][4 * r4] * rstd * sw[0], o[et][4 * r4 + 1] * rstd * sw[1]); w.y = pk2h(o[et][4 * r4 + 2] * rstd * sw[2], o[et][4 * r4 + 3] * rstd * sw[3]);
                    *(u32x2*)(ADIF + grow * 3072 + h * 128 + e) = w; }
        }
        __syncthreads();
    }
}
struct SchedG2 {
    pg8::StaticOrder so;
    __device__ __forceinline__ bool next(int i, pg8::Unit& u) const { if (!so.next(i >> 1, u)) return false; if (i & 1) { u.ko = 2048; u.nt = 16; u.keep = 0; } else { u.ko = 0; u.nt = 32; u.keep = 1; } return true; }
};
struct EpiU2 {
    h16* U; const h16* P;
    __device__ __forceinline__ void operator()(f32x4 (&acc)[2][2][4][2], const pg8::Unit& u, int wr, int wc, int fr, int fq) const {
#pragma unroll
        for (int ai = 0; ai < 2; ++ai)
#pragma unroll
            for (int m = 0; m < 4; ++m) { const int row = u.pm * 256 + ai * 128 + wr * 64 + m * 16 + fr;
#pragma unroll
                for (int bj = 0; bj < 2; ++bj)
#pragma unroll
                    for (int n = 0; n < 2; ++n) { const int col = u.pn * 256 + bj * 128 + wc * 32 + 16 * n + 4 * fq;
                        const h16x4 gd = *(const h16x4*)(P + (size_t)row * IN_COLS + C_GD + col);
                        if (u.keep) { const h16x4 gr = *(const h16x4*)(P + (size_t)row * IN_COLS + C_GR + col);
#pragma unroll
                            for (int e = 0; e < 4; ++e) acc[ai][bj][m][n][e] *= (float)gr[e] / (float)gd[e];
                        } else { const f32x4 a = acc[ai][bj][m][n];
                            u32x2 w; w.x = pk2h(a[0] * (float)gd[0], a[1] * (float)gd[1]); w.y = pk2h(a[2] * (float)gd[2], a[3] * (float)gd[3]);
                            *(u32x2*)(U + (size_t)row * DM + col) = w; } } }
    }
};
struct EpiX1 {
    float* X1; const float* x; const float* MOD;
    __device__ __forceinline__ void operator()(f32x4 (&acc)[2][2][4][2], const pg8::Unit& u, int wr, int wc, int fr, int fq) const {
        const int b = (u.pm * 256) / SEQ;
#pragma unroll
        for (int ai = 0; ai < 2; ++ai)
#pragma unroll
            for (int m = 0; m < 4; ++m) { const int row = u.pm * 256 + ai * 128 + wr * 64 + m * 16 + fr;
#pragma unroll
                for (int bj = 0; bj < 2; ++bj)
#pragma unroll
                    for (int n = 0; n < 2; ++n) { const int col = u.pn * 256 + bj * 128 + wc * 32 + 16 * n + 4 * fq;
                        const f32x4 g1 = *(const f32x4*)(MOD + (size_t)b * (6 * DM) + 2 * DM + col); const f32x4 xv = *(const f32x4*)(x + (size_t)row * DM + col);
                        *(f32x4*)(X1 + (size_t)row * DM + col) = xv + g1 * acc[ai][bj][m][n]; } }
    }
};
__device__ __forceinline__ void p7_gemm2(Frame& F) {
    pg8::Gemm g{(const h16*)(F.ws + WS_ACAT), (const h16*)(F.ws + WS_WCAT), 3072, 3072, 2048};
    SchedG2 S; S.so.init(MLAT, DM, F.G, (int)blockIdx.x);
    EpiU2 E{(h16*)(F.ws + WS_U), (const h16*)(F.ws + WS_P)};
    pg8::gemm_phase<EpiU2, SchedG2>(F.lds, g, S, E);
}
__device__ __forceinline__ void p9_gemm3(Frame& F) {
    pg8::Gemm g{(const h16*)(F.ws + WS_U), (const h16*)(F.ws + WS_WOUT), 2048, 2048, 2048};
    pg8::StaticOrder S; S.init(MLAT, DM, F.G, (int)blockIdx.x);
    EpiX1 E{(float*)(F.ws + WS_X1), F.x, (const float*)(F.ws + WS_MOD)};
    pg8::gemm_phase<EpiX1, pg8::StaticOrder>(F.lds, g, S, E);
}


__device__ __forceinline__ void p10_norm2(Frame& F) {
    const float* X1 = (const float*)(F.ws + WS_X1); const float* MOD = (const float*)(F.ws + WS_MOD); h16* H2X = (h16*)(F.ws + WS_H2X);
    const int gw = F.vcu * NWAVES + F.wave, NGW = F.G * NWAVES;
    for (int r = gw; r < MLAT; r += NGW) {
        const float* src = X1 + (size_t)r * DM; const int b = r / SEQ;
        f32x4 xv[8]; float ss = 0.f;
#pragma unroll
        for (int j = 0; j < 8; ++j) { xv[j] = *(const f32x4*)(src + 4 * F.lane + 256 * j); ss += (xv[j].x * xv[j].x + xv[j].y * xv[j].y) + (xv[j].z * xv[j].z + xv[j].w * xv[j].w); }
        const float rstd = 1.0f / sqrtf(wave_sum(ss) * (1.0f / DM) + EPS);
#pragma unroll
        for (int j = 0; j < 8; ++j) { const int cc = 4 * F.lane + 256 * j; const f32x4 nw = *(const f32x4*)(F.norm_ffn + cc);
            const f32x4 sh = *(const f32x4*)(MOD + (size_t)b * (6 * DM) + 3 * DM + cc), sc = *(const f32x4*)(MOD + (size_t)b * (6 * DM) + 4 * DM + cc);
            const f32x4 y = xv[j] * rstd * nw * (sc + 1.0f) + sh;
            h16 hh[4], ll[4];
#pragma unroll
            for (int e = 0; e < 4; ++e) { hh[e] = (h16)y[e]; ll[e] = (h16)(y[e] - (float)hh[e]); }
            h16* dst = H2X + (size_t)r * 6144 + cc;
            *(h16x4*)(dst) = (h16x4){hh[0], hh[1], hh[2], hh[3]}; *(h16x4*)(dst + 4096) = (h16x4){hh[0], hh[1], hh[2], hh[3]}; *(h16x4*)(dst + 2048) = (h16x4){ll[0], ll[1], ll[2], ll[3]};
            { int p8 = __builtin_amdgcn_cvt_pk_fp8_f32(y[0], y[1], 0, false); p8 = __builtin_amdgcn_cvt_pk_fp8_f32(y[2], y[3], p8, true); *(int*)((unsigned char*)(F.ws + WS_H2F8) + (size_t)r * DM + cc) = p8; } }
    }
}
struct SchedRT {
    int G, c;
    __device__ __forceinline__ bool next(int i, pg8::Unit& u) const { const int L = i * G + c; if (L >= 256) return false; u.pm = L >> 3; u.pn = 0; u.ko = (L & 7) * 768; u.nt = 0; u.keep = 0; return true; }
};
struct EpiLG {
    float* LGP;
    __device__ __forceinline__ void operator()(f32x4 (&acc)[2][2][4][2], const pg8::Unit& u, int wr, int wc, int fr, int fq) const {
        float* dst = LGP + (size_t)(u.ko / 768) * MLAT * NEXP;
#pragma unroll
        for (int ai = 0; ai < 2; ++ai)
#pragma unroll
            for (int m = 0; m < 4; ++m) { const int row = u.pm * 256 + ai * 128 + wr * 64 + m * 16 + fr;
#pragma unroll
                for (int bj = 0; bj < 2; ++bj)
#pragma unroll
                    for (int n = 0; n < 2; ++n) { const int col = bj * 128 + wc * 32 + 16 * n + 4 * fq; *(f32x4*)(dst + (size_t)row * NEXP + col) = acc[ai][bj][m][n]; } }
    }
};
__device__ __forceinline__ void p11_router(Frame& F) {
    pg8::Gemm g{(const h16*)(F.ws + WS_H2X), (const h16*)(F.ws + WS_WRTR), 6144, 6144, 768};
    SchedRT S; S.G = F.G; S.c = (int)blockIdx.x;
    EpiLG E{(float*)(F.ws + WS_LGP)};
    pg8::gemm_phase<EpiLG, SchedRT>(F.lds, g, S, E);
}
__device__ __forceinline__ void p12_topk(Frame& F) {
    const float* LGP = (const float*)(F.ws + WS_LGP); int* EIDX = (int*)(F.ws + WS_EIDX); float* EW = (float*)(F.ws + WS_EW); u32x2* LIST = (u32x2*)(F.ws + WS_LIST2);
    unsigned* CNT = (unsigned*)(F.ws + WS_CTL) + CW_CNT;
    const int gw = F.vcu * NWAVES + F.wave, NGW = F.G * NWAVES, lane = F.lane;
    const f32x4 bias = *(const f32x4*)(F.router_bias + 4 * lane);
    for (int t = gw; t < MLAT; t += NGW) {
        f32x4 lg = *(const f32x4*)(LGP + (size_t)t * NEXP + 4 * lane);
#pragma unroll
        for (int ks = 1; ks < 8; ++ks) lg += *(const f32x4*)(LGP + ((size_t)ks * MLAT + t) * NEXP + 4 * lane);
        float sc[4], sel[4];
#pragma unroll
        for (int i = 0; i < 4; ++i) { sc[i] = 1.0f / (1.0f + __expf(-lg[i])); sel[i] = sc[i] + bias[i]; }
        float a1 = fmaxf(sel[0], sel[1]), a2 = fminf(sel[0], sel[1]);
        { const float b1 = fmaxf(sel[2], sel[3]), b2 = fminf(sel[2], sel[3]); const float n1 = fmaxf(a1, b1), n2 = fmaxf(fminf(a1, b1), fmaxf(a2, b2)); a1 = n1; a2 = n2; }
#pragma unroll
        for (int off = 1; off < 8; off <<= 1) { const float b1 = __shfl_xor(a1, off), b2 = __shfl_xor(a2, off); const float n1 = fmaxf(a1, b1), n2 = fmaxf(fminf(a1, b1), fmaxf(a2, b2)); a1 = n1; a2 = n2; }
        const float gs = a1 + a2; const int g = lane >> 3;
        int rank = 0;
#pragma unroll
        for (int j = 0; j < 8; ++j) { const float o = __shfl(gs, 8 * j); rank += (o > gs || (o == gs && j < g)) ? 1 : 0; }
        const bool gsel = rank < 4;
        float ms[4];
#pragma unroll
        for (int i = 0; i < 4; ++i) ms[i] = gsel ? sel[i] : -INFINITY;
        float myw = 0.f; int mye = 0; float wsum = 0.f;
#pragma unroll
        for (int k = 0; k < TOPK; ++k) {
            float bv = ms[0]; int bi = 4 * lane;
#pragma unroll
            for (int i = 1; i < 4; ++i) if (ms[i] > bv) { bv = ms[i]; bi = 4 * lane + i; }
#pragma unroll
            for (int off = 1; off < 64; off <<= 1) { const float ov = __shfl_xor(bv, off); const int oi = __shfl_xor(bi, off); if (ov > bv || (ov == bv && oi < bi)) { bv = ov; bi = oi; } }
            const int ol = bi >> 2, oi = bi & 3;
            const float mysc = (oi == 0) ? sc[0] : (oi == 1) ? sc[1] : (oi == 2) ? sc[2] : sc[3];
            const float w = __shfl(mysc, ol);
            if (lane == ol) {
#pragma unroll
                for (int i = 0; i < 4; ++i) if (i == oi) ms[i] = -INFINITY; }
            wsum += w;
            if (lane == k) { myw = w; mye = bi; }
        }
        if (lane < TOPK) {
            const float wn = myw / wsum * 2.5f;
            EIDX[t * TOPK + lane] = mye; EW[t * TOPK + lane] = wn;
            const unsigned pos = atomicAdd(&CNT[mye], 1u);
            LIST[mye * MLAT + pos] = (u32x2){(unsigned)(t * TOPK + lane), __float_as_uint(wn)};
        }
    }
}
constexpr int EX_NSTG = 3, EX_ASTG = 24576, EX_WSTG = 16384, EX_A0 = 0, EX_W0 = EX_NSTG * EX_ASTG, EX_WH0 = EX_W0 + EX_NSTG * EX_WSTG, EX_WHS = 10240, EX_ROW0 = EX_WH0 + 2 * EX_WHS;
constexpr int EX_TAB0 = EX_ROW0 + 3200, EX_SCR0 = EX_TAB0 + 3072;
static_assert(EX_ROW0 == 143360 && EX_SCR0 + 8192 <= LDSCTL_OFF, "expert LDS map");
template <bool GU>
__device__ __forceinline__ void ring_w_prologue(Frame& F, const float* W, int cgrp) {
    constexpr int LDB = GU ? 512 : 2048;
    const int lane = F.lane, w = F.wave, v = 4 * (lane & 31);
    const int wcol0 = GU ? (((v >> 5) & 1) * 256 + 32 * (v >> 6) + (v & 31) + 64 * cgrp) : (v + 512 * cgrp);
    const float* wlane = W + (size_t)(4 * w + (lane >> 5)) * LDB + wcol0;
#pragma unroll
    for (int s = 0; s < 3; ++s)
#pragma unroll
        for (int j = 0; j < 2; ++j) __builtin_amdgcn_global_load_lds((const unsigned*)(wlane + (size_t)(s * 32 + 2 * j) * LDB), (LAS unsigned*)(F.lds + EX_W0 + s * EX_WSTG + (2 * w + j) * 1024), 16, 0, 2);
}
template <bool GU, int NLAY>
__device__ __forceinline__ void expert_ring(Frame& F, const float* W, const h16* Abase, const int (&arow)[3], int nr, int cgrp, h16* ACTrow0, h16* Y) {
    constexpr int KT = GU ? 64 : 8, NP = GU ? 1 : 4, LDB = GU ? 512 : 2048, NS = KT * NP;
    const int tid = F.tid, lane = F.lane, hi = lane >> 5, ln = lane & 31, cp = F.wave & 1, rg = F.wave >> 1, w = F.wave;
    const LAS int* RSLOT = (const LAS int*)(F.lds + EX_ROW0); const LAS float* RW = (const LAS float*)(F.lds + EX_ROW0 + 1536);
    const int ngrp = (nr + 15) >> 4;
    const int nA = (w < ngrp ? 1 : 0) + (w + 8 < ngrp ? 1 : 0) + (w + 16 < ngrp ? 1 : 0);
    const int achunk = ((lane & 3) ^ ((lane >> 4) & 3)) * 8;
    const int v = 4 * (lane & 31);
    const int wcol0 = GU ? (((v >> 5) & 1) * 256 + 32 * (v >> 6) + (v & 31) + 64 * cgrp) : (v + 512 * cgrp);
    const float* wlane = W + (size_t)(4 * w + (lane >> 5)) * LDB + wcol0;
    const unsigned lds0 = (unsigned)(uintptr_t)F.lds;
    const int xs = (ln >> 2) & 3;
    const unsigned aofs0 = (unsigned)((2 * rg + (ln >> 4)) * 1024 + (ln & 15) * 64 + ((hi ^ xs) * 16)), aofs1 = (unsigned)((2 * rg + (ln >> 4)) * 1024 + (ln & 15) * 64 + (((2 + hi) ^ xs) * 16));
    const unsigned tofs = (unsigned)((8 * hi + ((lane & 15) >> 2)) * 320 + (64 * cp + 16 * ((lane >> 4) & 1) + 4 * (lane & 3)) * 2);
    f32x16 acc[2 * NLAY];
#pragma unroll
    for (int i = 0; i < 2 * NLAY; ++i) acc[i] = (f32x16){};
#define EX_DMA_A(s) do { const int kt_ = (s) % KT, stg_ = (s) % EX_NSTG; \
        _Pragma("unroll") for (int j = 0; j < 3; ++j) if (j < nA) __builtin_amdgcn_global_load_lds((const unsigned*)(Abase + arow[j] + kt_ * 32 + achunk), (LAS unsigned*)(F.lds + EX_A0 + stg_ * EX_ASTG + (w + 8 * j) * 1024), 16, 0, 0); } while (0)
#define EX_DMA_W(s) do { const int pass_ = (s) / KT, kt_ = (s) % KT, stg_ = (s) % EX_NSTG; \
        _Pragma("unroll") for (int j = 0; j < 2; ++j) __builtin_amdgcn_global_load_lds((const unsigned*)(wlane + (size_t)(kt_ * 32 + 2 * j) * LDB + 128 * pass_), (LAS unsigned*)(F.lds + EX_W0 + stg_ * EX_WSTG + (2 * w + j) * 1024), 16, 0, 2); } while (0)
#define EX_WAITV(k) asm volatile("s_waitcnt vmcnt(" #k ")" ::: "memory")
#define EX_WAITN() do { if (nA == 3) EX_WAITV(5); else if (nA == 2) EX_WAITV(4); else if (nA == 1) EX_WAITV(3); else EX_WAITV(2); } while (0)
    const unsigned cvsrc = lds0 + EX_W0 + (tid >> 4) * 512 + (tid & 15) * 32, cvdst = lds0 + EX_WH0 + (tid >> 4) * 320 + (tid & 15) * 16;
    EX_DMA_A(0); EX_DMA_A(1);
    if (nA == 3) EX_WAITV(3); else if (nA == 2) EX_WAITV(2); else if (nA == 1) EX_WAITV(1); else EX_WAITV(0);
    __builtin_amdgcn_s_barrier(); asm volatile("" ::: "memory");
    { f32x4 c0, c1; asm volatile("ds_read_b128 %0, %2\n\tds_read_b128 %1, %2 offset:16\n\ts_waitcnt lgkmcnt(0)" : "=&v"(c0), "=&v"(c1) : "v"(cvsrc) : "memory");
      const h16x8 hv = pack8(c0[0], c0[1], c0[2], c0[3], c1[0], c1[1], c1[2], c1[3]); asm volatile("ds_write_b128 %0, %1" :: "v"(cvdst), "v"(hv) : "memory"); }
    typedef short s16x8 __attribute__((ext_vector_type(8)));
    for (int s = 0; s < NS; ++s) {
        if (s + 2 < NS) EX_WAITN(); else EX_WAITV(0);
        asm volatile("s_waitcnt lgkmcnt(0)" ::: "memory");
        __builtin_amdgcn_s_barrier();
        asm volatile("" ::: "memory");
        const bool pend = ((s % KT) == KT - 1);
        if (!pend) { if (s + 2 < NS) EX_DMA_A(s + 2); if (s + 3 < NS) EX_DMA_W(s + 3); }
        const unsigned abase = lds0 + EX_A0 + (s % EX_NSTG) * EX_ASTG, wbase = lds0 + EX_WH0 + (s & 1) * EX_WHS + tofs;
        const unsigned cs = cvsrc + ((s + 1) % EX_NSTG) * EX_WSTG;
        const unsigned pa0 = abase + aofs0, pa1 = abase + aofs1;
        if constexpr (NLAY < 3) {
            v4i16_t t0, t1, t2, t3, t4, t5, t6, t7; h16x8 a0[NLAY], a1[NLAY];
            asm volatile("ds_read_b64_tr_b16 %0, %8\n\tds_read_b64_tr_b16 %1, %8 offset:1280\n\tds_read_b64_tr_b16 %2, %8 offset:64\n\tds_read_b64_tr_b16 %3, %8 offset:1344\n\t"
                         "ds_read_b64_tr_b16 %4, %8 offset:5120\n\tds_read_b64_tr_b16 %5, %8 offset:6400\n\tds_read_b64_tr_b16 %6, %8 offset:5184\n\tds_read_b64_tr_b16 %7, %8 offset:6464"
                         : "=&v"(t0), "=&v"(t1), "=&v"(t2), "=&v"(t3), "=&v"(t4), "=&v"(t5), "=&v"(t6), "=&v"(t7) : "v"(wbase) : "memory");
            asm volatile("ds_read_b128 %0, %2\n\tds_read_b128 %1, %3" : "=&v"(a0[0]), "=&v"(a1[0]) : "v"(pa0), "v"(pa1) : "memory");
            if constexpr (NLAY >= 2) asm volatile("ds_read_b128 %0, %2 offset:8192\n\tds_read_b128 %1, %3 offset:8192" : "=&v"(a0[1]), "=&v"(a1[1]) : "v"(pa0), "v"(pa1) : "memory");
            asm volatile("s_waitcnt lgkmcnt(0)" ::: "memory");
            __builtin_amdgcn_sched_barrier(0);
            const h16x8 b00 = __builtin_bit_cast(h16x8, (s16x8){t0[0], t0[1], t0[2], t0[3], t1[0], t1[1], t1[2], t1[3]}), b01 = __builtin_bit_cast(h16x8, (s16x8){t2[0], t2[1], t2[2], t2[3], t3[0], t3[1], t3[2], t3[3]});
            const h16x8 b10 = __builtin_bit_cast(h16x8, (s16x8){t4[0], t4[1], t4[2], t4[3], t5[0], t5[1], t5[2], t5[3]}), b11 = __builtin_bit_cast(h16x8, (s16x8){t6[0], t6[1], t6[2], t6[3], t7[0], t7[1], t7[2], t7[3]});
#pragma unroll
            for (int i = 0; i < NLAY; ++i) { acc[2 * i] = MFMA32(a0[i], b00, acc[2 * i]); acc[2 * i + 1] = MFMA32(a0[i], b01, acc[2 * i + 1]); }
#pragma unroll
            for (int i = 0; i < NLAY; ++i) { acc[2 * i] = MFMA32(a1[i], b10, acc[2 * i]); acc[2 * i + 1] = MFMA32(a1[i], b11, acc[2 * i + 1]); }
        } else {
#pragma unroll
            for (int k16 = 0; k16 < 2; ++k16) {
                v4i16_t t0, t1, t2, t3; h16x8 a[3]; const unsigned pa = k16 ? pa1 : pa0, pw = wbase + k16 * 5120;
                asm volatile("ds_read_b64_tr_b16 %0, %4\n\tds_read_b64_tr_b16 %1, %4 offset:1280\n\tds_read_b64_tr_b16 %2, %4 offset:64\n\tds_read_b64_tr_b16 %3, %4 offset:1344"
                             : "=&v"(t0), "=&v"(t1), "=&v"(t2), "=&v"(t3) : "v"(pw) : "memory");
                asm volatile("ds_read_b128 %0, %3\n\tds_read_b128 %1, %3 offset:8192\n\tds_read_b128 %2, %3 offset:16384\n\ts_waitcnt lgkmcnt(0)" : "=&v"(a[0]), "=&v"(a[1]), "=&v"(a[2]) : "v"(pa) : "memory");
                __builtin_amdgcn_sched_barrier(0);
                const h16x8 b0 = __builtin_bit_cast(h16x8, (s16x8){t0[0], t0[1], t0[2], t0[3], t1[0], t1[1], t1[2], t1[3]}), b1 = __builtin_bit_cast(h16x8, (s16x8){t2[0], t2[1], t2[2], t2[3], t3[0], t3[1], t3[2], t3[3]});
#pragma unroll
                for (int i = 0; i < 3; ++i) { acc[2 * i] = MFMA32(a[i], b0, acc[2 * i]); acc[2 * i + 1] = MFMA32(a[i], b1, acc[2 * i + 1]); }
                __builtin_amdgcn_sched_barrier(0);
            }
        }
        if (s + 1 < NS) {
            f32x4 c0, c1; asm volatile("ds_read_b128 %0, %2\n\tds_read_b128 %1, %2 offset:16\n\ts_waitcnt lgkmcnt(0)" : "=&v"(c0), "=&v"(c1) : "v"(cs) : "memory");
            const h16x8 hv = pack8(c0[0], c0[1], c0[2], c0[3], c1[0], c1[1], c1[2], c1[3]); const unsigned cd = cvdst + ((s + 1) & 1) * EX_WHS; asm volatile("ds_write_b128 %0, %1" :: "v"(cd), "v"(hv) : "memory"); }
        if (pend) {
            const int pass = s / KT;
            int hio = hi, lno = ln; asm volatile("" : "+v"(hio), "+v"(lno));
            if (GU) {
#pragma unroll
                for (int i = 0; i < NLAY; ++i) { const int rt = rg + 4 * i;
#pragma unroll
                    for (int r = 0; r < 16; ++r) { const int row = 32 * rt + crow(r, hio);
                        if (row < nr) ACTrow0[(size_t)row * DEXP + 64 * cgrp + 32 * cp + lno] = (h16)(silu_f(acc[2 * i][r]) * acc[2 * i + 1][r]); }
                    acc[2 * i] = (f32x16){}; acc[2 * i + 1] = (f32x16){}; }
            } else {
                const unsigned scr = lds0 + EX_SCR0 + w * 1024;
                unsigned char* Y8 = (unsigned char*)Y;
#pragma unroll
                for (int i = 0; i < NLAY; ++i) { const int rt = rg + 4 * i;
#pragma unroll
                    for (int g8 = 0; g8 < 4; ++g8) {
#pragma unroll
                        for (int q = 0; q < 4; ++q) { const int lr = 4 * hio + q; const float wt = RW[32 * rt + 8 * g8 + lr];
                            const int pk = __builtin_amdgcn_cvt_pk_fp8_f32(acc[2 * i][4 * g8 + q] * wt, acc[2 * i + 1][4 * g8 + q] * wt, 0, false); const int pk1 = pk >> 8; const unsigned wa = scr + lr * 64 + lno;
                            asm volatile("ds_write_b8 %0, %1\n\tds_write_b8 %0, %2 offset:32" :: "v"(wa), "v"(pk), "v"(pk1) : "memory"); }
                        u32x2 pv; const unsigned ra = scr + (lane >> 3) * 64 + (lane & 7) * 8;
                        asm volatile("s_waitcnt lgkmcnt(0)\n\tds_read_b64 %0, %1\n\ts_waitcnt lgkmcnt(0)" : "=&v"(pv) : "v"(ra) : "memory");
                        const int grow = 32 * rt + 8 * g8 + (lane >> 3);
                        if (grow < nr) { const int slot = RSLOT[grow]; *(u32x2*)(Y8 + (size_t)slot * DM + 512 * cgrp + 128 * pass + 64 * cp + (lane & 7) * 8) = pv; }
                    }
                    acc[2 * i] = (f32x16){}; acc[2 * i + 1] = (f32x16){}; }
            }
            if (s + 2 < NS) EX_DMA_A(s + 2);
            if (s + 3 < NS) EX_DMA_W(s + 3);
        }
    }
    asm volatile("s_waitcnt vmcnt(0) lgkmcnt(0)" ::: "memory");
    __builtin_amdgcn_s_barrier();
    asm volatile("" ::: "memory");
#undef EX_DMA_A
#undef EX_DMA_W
#undef EX_WAITV
#undef EX_WAITN
}

constexpr int G8_NSTG = 4, G8_ASTG = 12288, G8_WSTG = 16384, G8_A0 = 0, G8_W0 = G8_NSTG * G8_ASTG, G8_WH0 = G8_W0 + G8_NSTG * G8_WSTG, G8_WHS = 4096;
constexpr int G8_SCR0 = G8_WH0 + 2 * G8_WHS;
static_assert(G8_SCR0 + 8 * 2048 <= EX_ROW0, "gu8 LDS map");
template <bool GU>
__device__ __forceinline__ void ring8_w_prologue(Frame& F, const float* W, int cgrp) {
    constexpr int LDB = GU ? 512 : 2048;
    const int lane = F.lane, w = F.wave, v = 4 * (lane & 31);
    const int wcol0 = GU ? (((v >> 5) & 1) * 256 + 32 * (v >> 6) + (v & 31) + 64 * cgrp) : (v + 512 * cgrp);
    const float* wlane = W + (size_t)(4 * w + (lane >> 5)) * LDB + wcol0;
#pragma unroll
    for (int s = 0; s < 4; ++s)
#pragma unroll
        for (int j = 0; j < 2; ++j) __builtin_amdgcn_global_load_lds((const unsigned*)(wlane + (size_t)(s * 32 + 2 * j) * LDB), (LAS unsigned*)(F.lds + G8_W0 + s * G8_WSTG + (2 * w + j) * 1024), 16, 0, 2);
}
template <bool GU, int NLAY>
__device__ __forceinline__ void expert_ring8(Frame& F, const float* W, const unsigned char* A8, const int (&arow)[2], int nr, int cgrp, unsigned char* ACT8row0, unsigned char* Y8) {
    constexpr int KT = GU ? 64 : 8, NP = GU ? 1 : 4, LDB = GU ? 512 : 2048, NS = KT * NP;
    typedef long v2i64 __attribute__((ext_vector_type(2)));
    const int tid = F.tid, lane = F.lane, hi = lane >> 5, ln = lane & 31, cp = F.wave & 1, rg = F.wave >> 1, w = F.wave;
    const LAS int* RSLOT = (const LAS int*)(F.lds + EX_ROW0); const LAS float* RW = (const LAS float*)(F.lds + EX_ROW0 + 1536);
    const int ngrp = (nr + 31) >> 5;
    const int nA = (w < ngrp ? 1 : 0) + (w + 8 < ngrp ? 1 : 0);
    const int v = 4 * (lane & 31);
    const int wcol0 = GU ? (((v >> 5) & 1) * 256 + 32 * (v >> 6) + (v & 31) + 64 * cgrp) : (v + 512 * cgrp);
    const float* wlane = W + (size_t)(4 * w + (lane >> 5)) * LDB + wcol0;
    const unsigned lds0 = (unsigned)(uintptr_t)F.lds;
    const unsigned aofs = (unsigned)(rg * 1024 + ln * 32 + hi * 16);
    const unsigned bofs = (unsigned)((64 * cp + ln) * 32 + hi * 16);
    const unsigned cvsrc = lds0 + G8_W0 + (tid >> 7) * 8 * 512 + (tid & 127) * 4, cvdst = lds0 + G8_WH0 + (tid & 127) * 32 + (tid >> 7) * 8;
    f32x16 acc[2 * NLAY];
#pragma unroll
    for (int i = 0; i < 2 * NLAY; ++i) acc[i] = (f32x16){};
#define G8_DMA_A(s) do { const int stg_ = (s) & 3, kt_ = (s) % KT; \
        _Pragma("unroll") for (int j = 0; j < 2; ++j) if (j < nA) __builtin_amdgcn_global_load_lds((const unsigned*)(A8 + arow[j] + kt_ * 32 + (lane & 1) * 16), (LAS unsigned*)(F.lds + G8_A0 + stg_ * G8_ASTG + (w + 8 * j) * 1024), 16, 0, 0); } while (0)
#define G8_DMA_W(s) do { const int stg_ = (s) & 3, kt_ = (s) % KT, pass_ = (s) / KT; \
        _Pragma("unroll") for (int j = 0; j < 2; ++j) __builtin_amdgcn_global_load_lds((const unsigned*)(wlane + (size_t)(kt_ * 32 + 2 * j) * LDB + 128 * pass_), (LAS unsigned*)(F.lds + G8_W0 + stg_ * G8_WSTG + (2 * w + j) * 1024), 16, 0, 2); } while (0)
#define G8_WAITV(k) asm volatile("s_waitcnt vmcnt(" #k ")" ::: "memory")
#define G8_CVT(s) do { float c_[8]; const unsigned cs_ = cvsrc + ((s) & 3) * G8_WSTG; \
        asm volatile("ds_read_b32 %0, %8\n\tds_read_b32 %1, %8 offset:512\n\tds_read_b32 %2, %8 offset:1024\n\tds_read_b32 %3, %8 offset:1536\n\tds_read_b32 %4, %8 offset:2048\n\tds_read_b32 %5, %8 offset:2560\n\tds_read_b32 %6, %8 offset:3072\n\tds_read_b32 %7, %8 offset:3584\n\ts_waitcnt lgkmcnt(0)" \
                     : "=&v"(c_[0]), "=&v"(c_[1]), "=&v"(c_[2]), "=&v"(c_[3]), "=&v"(c_[4]), "=&v"(c_[5]), "=&v"(c_[6]), "=&v"(c_[7]) : "v"(cs_) : "memory"); \
        int p0_ = __builtin_amdgcn_cvt_pk_fp8_f32(c_[0] * 64.f, c_[1] * 64.f, 0, false); p0_ = __builtin_amdgcn_cvt_pk_fp8_f32(c_[2] * 64.f, c_[3] * 64.f, p0_, true); \
        int p1_ = __builtin_amdgcn_cvt_pk_fp8_f32(c_[4] * 64.f, c_[5] * 64.f, 0, false); p1_ = __builtin_amdgcn_cvt_pk_fp8_f32(c_[6] * 64.f, c_[7] * 64.f, p1_, true); \
        const u32x2 pk_ = {(unsigned)p0_, (unsigned)p1_}; const unsigned cd_ = cvdst + ((s) & 1) * G8_WHS; asm volatile("ds_write_b64 %0, %1" :: "v"(cd_), "v"(pk_) : "memory"); } while (0)
    G8_DMA_A(0); G8_DMA_A(1); G8_DMA_A(2);
    if (nA == 2) G8_WAITV(4); else if (nA == 1) G8_WAITV(2); else G8_WAITV(0);
    __builtin_amdgcn_s_barrier(); asm volatile("" ::: "memory");
    G8_CVT(0);
    for (int s = 0; s < NS; ++s) {
        if (s >= 2 && s + 4 < NS) { if (nA == 2) G8_WAITV(8); else if (nA == 1) G8_WAITV(6); else G8_WAITV(4); }
        else if (s < 2) { if (nA == 2) G8_WAITV(4); else if (nA == 1) G8_WAITV(3); else G8_WAITV(2); }
        else G8_WAITV(0);
        asm volatile("s_waitcnt lgkmcnt(0)" ::: "memory");
        __builtin_amdgcn_s_barrier();
        asm volatile("" ::: "memory");
        const bool pend = ((s % KT) == KT - 1);
        if (!pend) { if (s + 3 < NS) G8_DMA_A(s + 3); if (s + 4 < NS) G8_DMA_W(s + 4); }
        const unsigned pa = lds0 + G8_A0 + (s & 3) * G8_ASTG + aofs, pb = lds0 + G8_WH0 + (s & 1) * G8_WHS + bofs;
        v2i64 a[NLAY], b0, b1;
        asm volatile("ds_read_b128 %0, %2\n\tds_read_b128 %1, %2 offset:1024" : "=&v"(b0), "=&v"(b1) : "v"(pb) : "memory");
        asm volatile("ds_read_b128 %0, %1" : "=&v"(a[0]) : "v"(pa) : "memory");
        if constexpr (NLAY >= 2) asm volatile("ds_read_b128 %0, %1 offset:4096" : "=&v"(a[1]) : "v"(pa) : "memory");
        if constexpr (NLAY >= 3) asm volatile("ds_read_b128 %0, %1 offset:8192" : "=&v"(a[2]) : "v"(pa) : "memory");
        asm volatile("s_waitcnt lgkmcnt(0)" ::: "memory");
        __builtin_amdgcn_sched_barrier(0);
#pragma unroll
        for (int i = 0; i < NLAY; ++i) { acc[2 * i] = __builtin_amdgcn_mfma_f32_32x32x16_fp8_fp8(a[i][0], b0[0], acc[2 * i], 0, 0, 0); acc[2 * i + 1] = __builtin_amdgcn_mfma_f32_32x32x16_fp8_fp8(a[i][0], b1[0], acc[2 * i + 1], 0, 0, 0); }
#pragma unroll
        for (int i = 0; i < NLAY; ++i) { acc[2 * i] = __builtin_amdgcn_mfma_f32_32x32x16_fp8_fp8(a[i][1], b0[1], acc[2 * i], 0, 0, 0); acc[2 * i + 1] = __builtin_amdgcn_mfma_f32_32x32x16_fp8_fp8(a[i][1], b1[1], acc[2 * i + 1], 0, 0, 0); }
        if (s + 1 < NS) G8_CVT(s + 1);
        if (pend) {
            const int pass = s / KT;
            int hio = hi, lno = ln; asm volatile("" : "+v"(hio), "+v"(lno));
            const unsigned scr = lds0 + G8_SCR0 + w * 2048;
#pragma unroll
            for (int i = 0; i < NLAY; ++i) { const int rt = rg + 4 * i;
#pragma unroll
                for (int r = 0; r < 16; ++r) { const int lr = crow(r, hio);
                    float v0, v1;
                    if (GU) { v0 = silu_f(acc[2 * i][r] * 0.015625f) * (acc[2 * i + 1][r] * 0.015625f); v1 = 0.f; }
                    else { const float wt = RW[32 * rt + lr] * 0.015625f; v0 = acc[2 * i][r] * wt; v1 = acc[2 * i + 1][r] * wt; }
                    const int pk = __builtin_amdgcn_cvt_pk_fp8_f32(v0, v1, 0, false); const unsigned wa = scr + lr * 64 + lno;
                    if (GU) asm volatile("ds_write_b8 %0, %1" :: "v"(wa), "v"(pk) : "memory");
                    else { const int pk1 = pk >> 8; asm volatile("ds_write_b8 %0, %1\n\tds_write_b8 %0, %2 offset:32" :: "v"(wa), "v"(pk), "v"(pk1) : "memory"); } }
                if (GU) {
                    unsigned pv[4]; const unsigned ra = scr + (lane >> 3) * 64 + (lane & 7) * 4;
                    asm volatile("s_waitcnt lgkmcnt(0)\n\tds_read_b32 %0, %4\n\tds_read_b32 %1, %4 offset:512\n\tds_read_b32 %2, %4 offset:1024\n\tds_read_b32 %3, %4 offset:1536\n\ts_waitcnt lgkmcnt(0)" : "=&v"(pv[0]), "=&v"(pv[1]), "=&v"(pv[2]), "=&v"(pv[3]) : "v"(ra) : "memory");
#pragma unroll
                    for (int g8 = 0; g8 < 4; ++g8) { const int grow = 32 * rt + 8 * g8 + (lane >> 3);
                        if (grow < nr) *(unsigned*)(ACT8row0 + (size_t)grow * DEXP + 64 * cgrp + 32 * cp + (lane & 7) * 4) = pv[g8]; }
                } else {
                    u32x2 pv[4]; const unsigned ra = scr + (lane >> 3) * 64 + (lane & 7) * 8;
                    asm volatile("s_waitcnt lgkmcnt(0)\n\tds_read_b64 %0, %4\n\tds_read_b64 %1, %4 offset:512\n\tds_read_b64 %2, %4 offset:1024\n\tds_read_b64 %3, %4 offset:1536\n\ts_waitcnt lgkmcnt(0)" : "=&v"(pv[0]), "=&v"(pv[1]), "=&v"(pv[2]), "=&v"(pv[3]) : "v"(ra) : "memory");
#pragma unroll
                    for (int g8 = 0; g8 < 4; ++g8) { const int grow = 32 * rt + 8 * g8 + (lane >> 3);
                        if (grow < nr) { const int slot = RSLOT[grow]; *(u32x2*)(Y8 + (size_t)slot * DM + 512 * cgrp + 128 * pass + 64 * cp + (lane & 7) * 8) = pv[g8]; } }
                }
                acc[2 * i] = (f32x16){}; acc[2 * i + 1] = (f32x16){}; }
            if (s + 3 < NS) G8_DMA_A(s + 3);
            if (s + 4 < NS) G8_DMA_W(s + 4);
        }
    }
    asm volatile("s_waitcnt vmcnt(0) lgkmcnt(0)" ::: "memory");
    __builtin_amdgcn_s_barrier();
    asm volatile("" ::: "memory");
#undef G8_DMA_A
#undef G8_DMA_W
#undef G8_WAITV
#undef G8_CVT
}
template <bool GU>
__device__ __forceinline__ void p13_expert_phase(Frame& F, int qid) {
    const h16* H2X = (const h16*)(F.ws + WS_H2X); h16* Y = (h16*)(F.ws + WS_Y); h16* ACT = (h16*)(F.ws + WS_ACT);
    const unsigned* CNT = (const unsigned*)(F.ws + WS_CTL) + CW_CNT; unsigned* QH = (unsigned*)(F.ws + WS_CTL) + CW_Q + 64 * qid;
    LAS int* RSLOT = (LAS int*)(F.lds + EX_ROW0); LAS float* RW = (LAS float*)(F.lds + EX_ROW0 + 1536); LAS int* RED = (LAS int*)(F.lds + EX_ROW0 + 3072);
    LAS int* CN = (LAS int*)(F.lds + EX_TAB0); LAS int* ORD = CN + 256; LAS int* OFF = CN + 512;
    __syncthreads();
    if (F.tid < NEXP) CN[F.tid] = (int)CNT[F.tid];
    __syncthreads();
    if (F.tid < NEXP) { const int c = CN[F.tid]; int rank = 0, off = 0;
        for (int j = 0; j < NEXP; ++j) { const int cj = CN[j]; rank += (cj > c || (cj == c && j < F.tid)) ? 1 : 0; off += (j < F.tid) ? cj : 0; }
        ORD[rank] = F.tid; OFF[F.tid] = off; }
    __syncthreads();
    const u32x2* LIST2 = (const u32x2*)(F.ws + WS_LIST2);
    if (F.tid == 0) RED[0] = (int)__hip_atomic_fetch_add(QH, 1u, __ATOMIC_RELAXED, __HIP_MEMORY_SCOPE_AGENT);
    __syncthreads();
    int u = RED[0];
    while (u < NEXP * 4) {
        const int e = ORD[u >> 2], cg = u & 3, cnt = CN[e], off_e = OFF[e];
        const float* Wgu = F.w_exp_gu + (size_t)e * DM * 512; const float* Wdn = F.w_exp_down + (size_t)e * DEXP * DM;
        for (int rs = 0; rs < cnt; rs += 384) {
            const int nr = (cnt - rs) < 384 ? (cnt - rs) : 384;
            __syncthreads();
            ring8_w_prologue<GU>(F, GU ? Wgu : Wdn, cg);
            if (F.tid < 384) { u32x2 ent = {0u, 0u}; if (F.tid < nr) ent = LIST2[e * MLAT + rs + F.tid]; RSLOT[F.tid] = (int)ent.x; RW[F.tid] = __uint_as_float(ent.y); }
            __syncthreads();
            unsigned char* ACT8row0 = (unsigned char*)(F.ws + WS_ACT8) + (size_t)(off_e + rs) * DEXP;
            int ar8[2];
            if (GU) {
#pragma unroll
                for (int j = 0; j < 2; ++j) { const int r = 32 * (F.wave + 8 * j) + (F.lane >> 1); ar8[j] = (r < 384 ? (RSLOT[r] >> 3) : 0) * DM; }
                const unsigned char* A8 = (const unsigned char*)(F.ws + WS_H2F8);
                if (nr > 256) expert_ring8<true, 3>(F, Wgu, A8, ar8, nr, cg, ACT8row0, (unsigned char*)Y); else if (nr > 128) expert_ring8<true, 2>(F, Wgu, A8, ar8, nr, cg, ACT8row0, (unsigned char*)Y); else expert_ring8<true, 1>(F, Wgu, A8, ar8, nr, cg, ACT8row0, (unsigned char*)Y);
            } else {
#pragma unroll
                for (int j = 0; j < 2; ++j) { const int r = 32 * (F.wave + 8 * j) + (F.lane >> 1); ar8[j] = ((r < nr) ? r : 0) * DEXP; }
                if (nr > 256) expert_ring8<false, 3>(F, Wdn, ACT8row0, ar8, nr, cg, ACT8row0, (unsigned char*)Y); else if (nr > 128) expert_ring8<false, 2>(F, Wdn, ACT8row0, ar8, nr, cg, ACT8row0, (unsigned char*)Y); else expert_ring8<false, 1>(F, Wdn, ACT8row0, ar8, nr, cg, ACT8row0, (unsigned char*)Y);
            }
        }
        __syncthreads();
        if (F.tid == 0) RED[0] = (int)__hip_atomic_fetch_add(QH, 1u, __ATOMIC_RELAXED, __HIP_MEMORY_SCOPE_AGENT);
        __syncthreads();
        u = RED[0];
    }
}
struct SchedSG {
    int G, c;
    __device__ __forceinline__ bool next(int i, pg8::Unit& u) const { const int L = i * G + c; if (L >= 256) return false; u.pm = L >> 3; u.pn = (L >> 2) & 1; u.ko = (L & 3) * 512; u.nt = 0; u.keep = 0; return true; }
};
struct EpiSGP {
    float* SGP;
    __device__ __forceinline__ void operator()(f32x4 (&acc)[2][2][4][2], const pg8::Unit& u, int wr, int wc, int fr, int fq) const {
        float* dst = SGP + (size_t)(u.ko / 512) * MLAT * 512;
#pragma unroll
        for (int ai = 0; ai < 2; ++ai)
#pragma unroll
            for (int m = 0; m < 4; ++m) { const int row = u.pm * 256 + ai * 128 + wr * 64 + m * 16 + fr;
#pragma unroll
                for (int bj = 0; bj < 2; ++bj)
#pragma unroll
                    for (int n = 0; n < 2; ++n) { const int col = u.pn * 256 + bj * 128 + wc * 32 + 16 * n + 4 * fq; *(f32x4*)(dst + (size_t)row * 512 + col) = acc[ai][bj][m][n]; } }
    }
};
__device__ __forceinline__ void p11b_shared_gu(Frame& F) {
    pg8::Gemm g{(const h16*)(F.ws + WS_H2X), (const h16*)(F.ws + WS_WSGU), 6144, 2048, 512};
    SchedSG S; S.G = F.G; S.c = (int)blockIdx.x;
    EpiSGP E{(float*)(F.ws + WS_SGP)};
    pg8::gemm_phase<EpiSGP, SchedSG>(F.lds, g, S, E);
}
__device__ __forceinline__ void p12b_shared_act(Frame& F) {
    const float* SGP = (const float*)(F.ws + WS_SGP); h16* ACTS = (h16*)(F.ws + WS_ACTS);
    for (int q = blockIdx.x * NTHR + F.tid; q < MLAT * 64; q += F.G * NTHR) {
        const int row = q >> 6, j = (q & 63) * 4, pg = 32 * (j >> 4) + (j & 15);
        f32x4 gv = {0.f, 0.f, 0.f, 0.f}, uv = gv;
#pragma unroll
        for (int ks = 0; ks < 4; ++ks) { const float* p = SGP + ((size_t)ks * MLAT + row) * 512 + pg; gv += *(const f32x4*)p; uv += *(const f32x4*)(p + 16); }
        u32x2 w; w.x = pk2h(silu_f(gv[0]) * uv[0], silu_f(gv[1]) * uv[1]); w.y = pk2h(silu_f(gv[2]) * uv[2], silu_f(gv[3]) * uv[3]);
        *(u32x2*)(ACTS + (size_t)row * DEXP + j) = w;
    }
}
struct EpiYsh {
    h16* YSH;
    __device__ __forceinline__ void operator()(f32x4 (&acc)[2][2][4][2], const pg8::Unit& u, int wr, int wc, int fr, int fq) const {
#pragma unroll
        for (int ai = 0; ai < 2; ++ai)
#pragma unroll
            for (int m = 0; m < 4; ++m) { const int row = u.pm * 256 + ai * 128 + wr * 64 + m * 16 + fr;
#pragma unroll
                for (int bj = 0; bj < 2; ++bj)
#pragma unroll
                    for (int n = 0; n < 2; ++n) { const int col = u.pn * 256 + bj * 128 + wc * 32 + 16 * n + 4 * fq; const f32x4 a = acc[ai][bj][m][n];
                        u32x2 w; w.x = pk2h(a[0], a[1]); w.y = pk2h(a[2], a[3]); *(u32x2*)(YSH + (size_t)row * DM + col) = w; } }
    }
};
struct SchedOne {
    int pm, pn;
    __device__ __forceinline__ bool next(int i, pg8::Unit& u) const { if (i != 0) return false; u.pm = pm; u.pn = pn; u.ko = 0; u.nt = 0; u.keep = 0; return true; }
};
__device__ __forceinline__ void p15_shared_down_dyn(Frame& F, int qid) {
    unsigned* QH = (unsigned*)(F.ws + WS_CTL) + CW_Q + 64 * 8 * qid;
    LAS int* RED = (LAS int*)(F.lds + EX_ROW0 + 3072);
    for (;;) {
        __syncthreads();
        if (F.tid == 0) RED[0] = (int)__hip_atomic_fetch_add(QH, 1u, __ATOMIC_RELAXED, __HIP_MEMORY_SCOPE_AGENT);
        __syncthreads();
        const int t = RED[0];
        if (t >= 256) break;
        pg8::Gemm g{(const h16*)(F.ws + WS_ACTS), (const h16*)(F.ws + WS_WSDN), 256, 256, 256};
        SchedOne S; S.pm = t >> 3; S.pn = t & 7;
        EpiYsh E{(h16*)(F.ws + WS_YSH)};
        pg8::gemm_phase<EpiYsh, SchedOne>(F.lds, g, S, E);
    }
}
__device__ __forceinline__ void p15_shared_down(Frame& F) {
    pg8::Gemm g{(const h16*)(F.ws + WS_ACTS), (const h16*)(F.ws + WS_WSDN), 256, 256, 256};
    pg8::StaticOrder S; S.init(MLAT, DM, F.G, (int)blockIdx.x);
    EpiYsh E{(h16*)(F.ws + WS_YSH)};
    pg8::gemm_phase<EpiYsh, pg8::StaticOrder>(F.lds, g, S, E);
}
__device__ __forceinline__ void p16_combine(Frame& F) {
    const float* X1 = (const float*)(F.ws + WS_X1); const float* MOD = (const float*)(F.ws + WS_MOD); const h16* Y = (const h16*)(F.ws + WS_Y); const h16* YSH = (const h16*)(F.ws + WS_YSH);
    const int gw = F.vcu * NWAVES + F.wave, NGW = F.G * NWAVES;
    for (int r = gw; r < MLAT; r += NGW) {
        const int b = r / SEQ;
        f32x4 xv[8]; float ss = 0.f;
#pragma unroll
        for (int j = 0; j < 8; ++j) { const int cc = 4 * F.lane + 256 * j;
            f32x4 m = {0.f, 0.f, 0.f, 0.f};
#pragma unroll
            for (int k = 0; k < TOPK; ++k) { const int yv = *(const int*)((const unsigned char*)Y + (size_t)(r * TOPK + k) * DM + cc);
                const f32x2 lo = __builtin_amdgcn_cvt_pk_f32_fp8(yv, false), hi2 = __builtin_amdgcn_cvt_pk_f32_fp8(yv, true); m += (f32x4){lo[0], lo[1], hi2[0], hi2[1]}; }
            { const h16x4 yv = *(const h16x4*)(YSH + (size_t)r * DM + cc); m += (f32x4){(float)yv[0], (float)yv[1], (float)yv[2], (float)yv[3]}; }
            const f32x4 g2 = *(const f32x4*)(MOD + (size_t)b * (6 * DM) + 5 * DM + cc);
            xv[j] = *(const f32x4*)(X1 + (size_t)r * DM + cc) + g2 * m;
            ss += (xv[j].x * xv[j].x + xv[j].y * xv[j].y) + (xv[j].z * xv[j].z + xv[j].w * xv[j].w); }
        const float rstd = 1.0f / sqrtf(wave_sum(ss) * (1.0f / DM) + EPS);
#pragma unroll
        for (int j = 0; j < 8; ++j) { const int cc = 4 * F.lane + 256 * j; const f32x4 nw = *(const f32x4*)(F.final_norm + cc);
            *(f32x4*)(F.out + (size_t)r * DM + cc) = xv[j] * rstd * nw; }
    }
}

__device__ __forceinline__ void p_final_plain(Frame& F, const float* xin) {
    const int gw = F.vcu * NWAVES + F.wave, NGW = F.G * NWAVES;
    for (int r = gw; r < MLAT; r += NGW) {
        const float* src = xin + (size_t)r * DM;
        f32x4 xv[8]; float ss = 0.f;
#pragma unroll
        for (int j = 0; j < 8; ++j) { xv[j] = *(const f32x4*)(src + 4 * F.lane + 256 * j); ss += (xv[j].x * xv[j].x + xv[j].y * xv[j].y) + (xv[j].z * xv[j].z + xv[j].w * xv[j].w); }
        const float rstd = 1.0f / sqrtf(wave_sum(ss) * (1.0f / DM) + EPS);
#pragma unroll
        for (int j = 0; j < 8; ++j) { const int cc = 4 * F.lane + 256 * j; const f32x4 nw = *(const f32x4*)(F.final_norm + cc);
            *(f32x4*)(F.out + (size_t)r * DM + cc) = xv[j] * rstd * nw; }
    }
}

constexpr int N_PHASES = 15;
#ifndef DUP_PHASE
#define DUP_PHASE -1
#endif
#ifndef DUP_VAR
#define DUP_VAR 7
#endif
struct Args { const float* in[22]; float* out; unsigned char* ws; int ph_lo, ph_hi; };
__global__ void __launch_bounds__(NTHR, 2) mk_fwd(Args args) {
    extern __shared__ __attribute__((aligned(16))) unsigned char lds_raw[];
    Frame F;
    F.lds = (LAS unsigned char*)lds_raw;
    F.tid = threadIdx.x; F.lane = F.tid & 63; F.wave = __builtin_amdgcn_readfirstlane(F.tid >> 6);
    F.G = gridDim.x; { const int bx = blockIdx.x; F.vcu = (F.G % 8 == 0) ? (bx % 8) * (F.G / 8) + bx / 8 : bx; }
    F.x = args.in[0]; F.c = args.in[1]; F.ctx = args.in[2]; F.c_ctx = args.in[3]; F.w_mod = args.in[4]; F.b_mod = args.in[5]; F.norm_attn = args.in[6]; F.norm_ffn = args.in[7];
    F.w_in = args.in[8]; F.ret_decay = args.in[9]; F.diff_lambda = args.in[10]; F.diff_subln = args.in[11]; F.w_ret_o = args.in[12]; F.w_diff_o = args.in[13]; F.w_out = args.in[14];
    F.w_router = args.in[15]; F.router_bias = args.in[16]; F.w_exp_gu = args.in[17]; F.w_exp_down = args.in[18]; F.w_sh_gu = args.in[19]; F.w_sh_down = args.in[20]; F.final_norm = args.in[21];
    F.out = args.out; F.ws = args.ws;
    volatile LAS unsigned* MISC = (volatile LAS unsigned*)(F.lds + LDSCTL_OFF);
    for (int u = F.tid; u < (LDS_BYTES - LDSCTL_OFF) / 4; u += NTHR) ((LAS unsigned*)(F.lds + LDSCTL_OFF))[u] = 0u;
    __syncthreads();
    const int lo = args.ph_lo, hi = args.ph_hi;
    const bool multi = (hi - lo) > 1;
    XcdBarrier bar; bar.bar = (unsigned*)(F.ws + WS_CTL) + CW_BAR; bar.x = 0; bar.st = nullptr;
    if (multi) bar = xcd_barrier_post((unsigned*)(F.ws + WS_CTL) + CW_BAR, MISC + 8);
#define IN(k) (lo <= (k) && (k) < hi)
#define SEAM(k) do { if (IN(k) && IN((k) + 1)) xcd_barrier(bar); } while (0)

#define RUNP(k, call) do { if (IN(k)) { call; if (DUP_PHASE == (k)) { xcd_barrier(bar); call; } } SEAM(k); } while (0)
    RUNP(0, p0a_mod(F));
    RUNP(1, (p1_norm1(F), p0b_weights(F)));
    RUNP(2, (p2_gemm1(F), p0c_weights_dyn(F, 5)));
    RUNP(3, p3_ret_local(F));
    RUNP(4, p4_ret_scan(F));
    RUNP(5, p5_ret_out(F));
    RUNP(6, p6_attn(F));
    RUNP(7, p7_gemm2(F));
    RUNP(8, p9_gemm3(F));
    RUNP(9, p10_norm2(F));
    RUNP(10, (p11_router(F), p11b_shared_gu(F)));
    RUNP(11, (p12_topk(F), p12b_shared_act(F)));
    if (IN(12)) { p13_expert_phase<true>(F, 0); p15_shared_down_dyn(F, 4); if (DUP_PHASE == 12) { xcd_barrier(bar); p13_expert_phase<true>(F, 2); } } SEAM(12);
    if (IN(13)) { p13_expert_phase<false>(F, 1); if (DUP_PHASE == 13) { xcd_barrier(bar); p13_expert_phase<false>(F, 3); } } SEAM(13);
    if (IN(14)) { p16_combine(F); }
#undef RUNP
#undef IN
#undef SEAM
}

constexpr bool ONE_LAUNCH = true;
extern "C" void kernel_launch(void* const* d_in, const int* in_sizes, int n_in, void* d_out, int out_size, void* d_ws, size_t ws_size, hipStream_t stream) {
    static int grid = 0;
    if (grid == 0) {
        if (n_in != 22 || out_size != MLAT * DM || ws_size < WS_END) { fprintf(stderr, "kernel_launch: unexpected sizes n_in %d out %d ws %zu\n", n_in, out_size, ws_size); grid = -1; return; }
        int dev = 0, cus = 0;
        if (hipGetDevice(&dev) != hipSuccess || hipDeviceGetAttribute(&cus, hipDeviceAttributeMultiprocessorCount, dev) != hipSuccess) { grid = -1; return; }
        if (hipFuncSetAttribute((const void*)mk_fwd, hipFuncAttributeMaxDynamicSharedMemorySize, LDS_BYTES) != hipSuccess) { fprintf(stderr, "kernel_launch: hipFuncSetAttribute failed\n"); grid = -1; return; }
        int per_cu = 0;
        if (hipOccupancyMaxActiveBlocksPerMultiprocessor(&per_cu, (const void*)mk_fwd, NTHR, LDS_BYTES) != hipSuccess || per_cu < 1) fprintf(stderr, "kernel_launch: occupancy query reports %d\n", per_cu);
        (void)hipGetLastError();
        grid = cus;
    }
    if (grid < 0) return;
    (void)hipMemsetAsync((char*)d_ws + WS_CTL, 0, CTL_ZERO_BYTES, stream);
    Args a{};
    for (int i = 0; i < 22; ++i) a.in[i] = (const float*)d_in[i];
    a.out = (float*)d_out; a.ws = (unsigned char*)d_ws;
    if (ONE_LAUNCH) {
        a.ph_lo = 0; a.ph_hi = N_PHASES;
        hipLaunchKernelGGL(mk_fwd, dim3(grid), dim3(NTHR), LDS_BYTES, stream, a);
    } else {
        for (int p = 0; p < N_PHASES; ++p) { a.ph_lo = p; a.ph_hi = p + 1; hipLaunchKernelGGL(mk_fwd, dim3(grid), dim3(NTHR), LDS_BYTES, stream, a); }
    }
}
```

```cpp
#include <hip/hip_runtime.h>
#include <cstdio>
#include <cstdint>

#define LAS __attribute__((address_space(3)))
#define GAS __attribute__((address_space(1)))
typedef _Float16 h16;
typedef _Float16 h16x8 __attribute__((ext_vector_type(8)));
typedef _Float16 h16x4 __attribute__((ext_vector_type(4)));
typedef _Float16 h16x2 __attribute__((ext_vector_type(2)));
typedef float f32x2 __attribute__((ext_vector_type(2)));
typedef float f32x4 __attribute__((ext_vector_type(4)));
typedef float f32x16 __attribute__((ext_vector_type(16)));
typedef unsigned u32x4 __attribute__((ext_vector_type(4)));
typedef unsigned u32x2 __attribute__((ext_vector_type(2)));
typedef short v4i16_t __attribute__((ext_vector_type(4)));

constexpr int DM = 2048, NBATCH = 2, SEQ = 4096, CTXL = 256;
constexpr int MLAT = NBATCH * SEQ, MCTX = NBATCH * CTXL, MALL = MLAT + MCTX;
constexpr int IN_COLS = 13312, KV_COLS = 5120;
constexpr int C_RK = 0, C_RV = 1024, C_DK = 3072, C_DV = 4096, C_RQ = 5120, C_RG = 6144, C_DQ = 8192, C_GR = 9216, C_GD = 11264;
constexpr int NEXP = 256, TOPK = 8, DEXP = 256;
constexpr float EPS = 1e-6f;
constexpr int NWAVES = 8, NTHR = 512;

constexpr size_t MiB = 1u << 20;
constexpr size_t WS_CTL = 0, CTL_ZERO_BYTES = 1 * MiB;
constexpr size_t WS_MODP = 1 * MiB;
constexpr size_t WS_MOD = 3 * MiB;
constexpr size_t WS_ROPE = 3 * MiB + 512 * 1024;
constexpr size_t WS_WINT = 4 * MiB;
constexpr size_t WS_WRET = 56 * MiB;
constexpr size_t WS_WDIF = 64 * MiB;
constexpr size_t WS_WOUT = 68 * MiB;
constexpr size_t WS_WSGU = 76 * MiB;
constexpr size_t WS_WSDN = 78 * MiB;
constexpr size_t WS_WRTR = 79 * MiB;
constexpr size_t WS_H = 82 * MiB;
constexpr size_t WS_P = 116 * MiB;
constexpr size_t WS_LST = 340 * MiB;
constexpr size_t WS_SST = 408 * MiB;
constexpr size_t WS_ARET = 472 * MiB;
constexpr size_t WS_ADIF = 504 * MiB;
constexpr size_t WS_T = 520 * MiB;
constexpr size_t WS_U = 584 * MiB;
constexpr size_t WS_X1 = 616 * MiB;
constexpr size_t WS_H2X = 680 * MiB;
constexpr size_t WS_LG = 776 * MiB;
constexpr size_t WS_EIDX = 784 * MiB;
constexpr size_t WS_EW = 785 * MiB;
constexpr size_t WS_LIST = 786 * MiB;
constexpr size_t WS_ACTS = 794 * MiB;
constexpr size_t WS_YSH = 798 * MiB;
constexpr size_t WS_Y = 830 * MiB;
constexpr size_t WS_ACT = 1086 * MiB;
constexpr size_t WS_LGP = 1118 * MiB;
constexpr size_t WS_SGP = 1182 * MiB;
constexpr size_t WS_ACAT = 1246 * MiB;
constexpr size_t WS_WCAT = 1294 * MiB;
constexpr size_t WS_LIST2 = 1306 * MiB;
constexpr size_t WS_H2F8 = 1322 * MiB;
constexpr size_t WS_ACT8 = 1338 * MiB;
constexpr size_t WS_END = 1354 * MiB;

constexpr int CW_BAR = 4096;
constexpr int CW_CNT = 16384;
constexpr int CW_Q = 20480;

constexpr int RING_BYTES = 131072;
constexpr int LDS_BYTES = 163840;
constexpr int LDSCTL_OFF = LDS_BYTES - 512;
constexpr int LDS_TICKET = 146432;

#define XB_TMO      128
#define XB_XCNT(j)  (256  + 64 * (j))
#define XB_XSUB(j)  (1280 + 64 * (j))
#define XB_XGEN(j)  (2304 + 64 * (j))
#define XB_TOP      3328
#define XB_TOPGEN   3392
#define XCD_BAR_WORDS 3456
#define XB_SPIN_CAP (1u << 18)

__device__ __forceinline__ unsigned xb_ld(unsigned* p)              { return __hip_atomic_load(p, __ATOMIC_RELAXED, __HIP_MEMORY_SCOPE_AGENT); }
__device__ __forceinline__ unsigned xb_add(unsigned* p, unsigned v) { return __hip_atomic_fetch_add(p, v, __ATOMIC_RELAXED, __HIP_MEMORY_SCOPE_AGENT); }
__device__ __forceinline__ unsigned xb_xcc_id() { return (unsigned)__builtin_amdgcn_s_getreg((3 << 11) | 20) & 0xFu; }
#define XB_SPIN(cond, bar) do { unsigned _sp = 0; while (cond) { __builtin_amdgcn_s_sleep(1); \
    if ((++_sp & 255u) == 0u) { if (xb_ld(&(bar)[XB_TMO])) break; if (_sp > XB_SPIN_CAP) { atomicAdd(&(bar)[XB_TMO], 1u); break; } } } } while (0)

struct XcdBarrier { unsigned* bar; unsigned x; volatile LAS unsigned* st; };

__device__ __forceinline__ XcdBarrier xcd_barrier_post(unsigned* bar, volatile LAS unsigned* st) {
    XcdBarrier b; b.bar = bar; b.x = xb_xcc_id(); b.st = st;
    if (threadIdx.x == 0) (void)xb_add(&bar[XB_XCNT(b.x)], 1u);
    return b;
}
__device__ __forceinline__ void xcd_barrier_complete(unsigned* bar, unsigned x, unsigned& nloc, unsigned& nx) {
    const unsigned G = gridDim.x * gridDim.y * gridDim.z;
    unsigned sum, cnt, mine, sp = 0u;
    for (;;) {
        sum = 0u; cnt = 0u; mine = 0u;
#pragma unroll
        for (unsigned j = 0; j < 16; ++j) { const unsigned c = xb_ld(&bar[XB_XCNT(j)]); sum += c; cnt += (c > 0u) ? 1u : 0u; mine = (j == x) ? c : mine; }
        if (sum == G) break;
        __builtin_amdgcn_s_sleep(1);
        if ((++sp & 255u) == 0u) { if (xb_ld(&bar[XB_TMO])) break; if (sp > XB_SPIN_CAP) { atomicAdd(&bar[XB_TMO], 1u); break; } }
    }
    nloc = mine > 0u ? mine : 1u; nx = cnt > 0u ? cnt : 1u;
}
__device__ __forceinline__ void xcd_barrier(const XcdBarrier& b) {
    asm volatile("s_waitcnt vmcnt(0)" ::: "memory");
    __syncthreads();
    if (threadIdx.x == 0) {
        unsigned* bar = b.bar;
        __builtin_amdgcn_s_waitcnt(0);
        unsigned nloc = b.st[0], nx = b.st[1];
        if (nloc == 0u) { xcd_barrier_complete(bar, b.x, nloc, nx); b.st[0] = nloc; b.st[1] = nx; }
        const unsigned old = xb_add(&bar[XB_XSUB(b.x)], 1u);
        const unsigned gen = old / nloc;
        if (old + 1u == (gen + 1u) * nloc) {
            __builtin_amdgcn_fence(__ATOMIC_RELEASE, "agent");
            asm volatile("s_waitcnt vmcnt(0)" ::: "memory");
            const unsigned og = xb_add(&bar[XB_TOP], 1u);
            const unsigned tg = og / nx;
            if (og + 1u == (tg + 1u) * nx) xb_add(&bar[XB_TOPGEN], 1u);
            else XB_SPIN(xb_ld(&bar[XB_TOPGEN]) == tg, bar);
            __builtin_amdgcn_fence(__ATOMIC_ACQUIRE, "agent");
            xb_add(&bar[XB_XGEN(b.x)], 1u);
            asm volatile("s_waitcnt vmcnt(0)" ::: "memory");
        } else {
            XB_SPIN(xb_ld(&bar[XB_XGEN(b.x)]) == gen, bar);
            __builtin_amdgcn_fence(__ATOMIC_ACQUIRE, "agent");
            asm volatile("s_waitcnt vmcnt(0)" ::: "memory");
        }
    }
    __syncthreads();
}


namespace pg8 {
constexpr int BM = 256, BK = 64, HALF = 128, HTB = HALF * BK * 2, STAGE_BYTES = 8 * HTB, NXCD = 8, WGM = 8;
__host__ __device__ __forceinline__ int lds_byte(int r, int c) { const int st = (r >> 4) * 2 + (c >> 5), rr = r & 15, cc = c & 31, ob = rr * 64 + cc * 2; return st * 1024 + (ob ^ (((ob >> 9) & 1) << 5)); }
__host__ __device__ __forceinline__ void stage_rc(int b, int& R, int& C) { const int st = b / 1024, sb = b % 1024, swz = sb ^ (((sb >> 9) & 1) << 5); R = (st >> 1) * 16 + swz / 64; C = (st & 1) * 32 + (swz % 64) / 2; }
struct Unit { int pm, pn, ko, nt, keep; };
struct Gemm { const h16* A; const h16* Bt; int lda, ldb, K; };
struct StaticOrder {
    int nM, nN, nwg, G, c;
    __host__ __device__ void init(int M, int N, int G_, int c_) { nM = M / BM; nN = N / BM; nwg = nM * nN; G = G_; c = c_; }
    __host__ __device__ bool next(int i, Unit& u) const {
        const long L = (long)i * G + c; if (L >= nwg) return false;
        int wgid = (int)L; { const int q = nwg / NXCD, r = nwg % NXCD, xcd = wgid % NXCD, off = wgid / NXCD; wgid = (xcd < r ? xcd * (q + 1) : r * (q + 1) + (xcd - r) * q) + off; }
        const int nig = WGM * nN, gid = wgid / nig, fm = gid * WGM, gsz = (nM - fm) < WGM ? (nM - fm) : WGM;
        u.pm = fm + ((wgid % nig) % gsz); u.pn = (wgid % nig) / gsz; u.ko = 0; u.nt = 0; u.keep = 0; return true;
    }
};
template <class Epi, class Sched, bool ALIGN_EPI = true>
__device__ __forceinline__ void gemm_phase(LAS unsigned char* lds, const Gemm g, const Sched& S, const Epi& E) {
    const int tid = threadIdx.x, wid = __builtin_amdgcn_readfirstlane(tid >> 6), lane = tid & 63, wr = wid >> 2, wc = wid & 3, fr = lane & 15, fq = lane >> 4;
    const int nt0 = g.K / BK;
    unsigned voffA[2], voffB[2];
#pragma unroll
    for (int i = 0; i < 2; ++i) { int R, C; stage_rc(tid * 16 + i * 8192, R, C); voffA[i] = (unsigned)(R * g.lda + C) * 2u; voffB[i] = (unsigned)(R * g.ldb + C) * 2u; }
    const size_t kstep = (size_t)(BK * 2);
    const size_t hstepA = (size_t)HALF * g.lda * 2, hstepB = (size_t)HALF * g.ldb * 2;
    const size_t tstepA = 2 * hstepA, tstepB = 2 * hstepB;
    const unsigned ldsw = (unsigned)wid * 1024u;
    const int aoff = lds_byte(wr * 64 + fr, fq * 8), boff = lds_byte(wc * 32 + fr, fq * 8);
#define PG8_SA(b, h) (((b) * 2 + (h)) * HTB)
#define PG8_SB(b, h) ((4 + (b) * 2 + (h)) * HTB)
#define PG8_STAGE(bufoff, gbase, voff) do { _Pragma("unroll") for (int _i = 0; _i < 2; ++_i) \
        __builtin_amdgcn_global_load_lds((const unsigned*)((const char*)(gbase) + (voff)[_i]), (LAS unsigned*)(lds + (bufoff) + ldsw + _i * 8192), 16, 0, 0); } while (0)
#define PG8_LDA(dst, b, h) do { _Pragma("unroll") for (int m = 0; m < 4; ++m) _Pragma("unroll") for (int k = 0; k < 2; ++k) dst[m][k] = *(const LAS h16x8*)(lds + PG8_SA(b, h) + aoff + m * 2048 + k * 1024); } while (0)
#define PG8_LDB(dst, b, h) do { _Pragma("unroll") for (int n = 0; n < 2; ++n) _Pragma("unroll") for (int k = 0; k < 2; ++k) dst[n][k] = *(const LAS h16x8*)(lds + PG8_SB(b, h) + boff + n * 2048 + k * 1024); } while (0)
#define PG8_MMA(ai, bj, At, Bt) do { __builtin_amdgcn_s_setprio(1); _Pragma("unroll") for (int m = 0; m < 4; ++m) _Pragma("unroll") for (int n = 0; n < 2; ++n) _Pragma("unroll") for (int k = 0; k < 2; ++k) \
        acc[ai][bj][m][n] = __builtin_amdgcn_mfma_f32_16x16x32_f16(Bt[n][k], At[m][k], acc[ai][bj][m][n], 0, 0, 0); __builtin_amdgcn_s_setprio(0); } while (0)
#define PG8_WAIT_V(n) asm volatile("s_waitcnt vmcnt(" #n ")" ::: "memory")
#define PG8_WAIT_L(n) asm volatile("s_waitcnt lgkmcnt(" #n ")" ::: "memory")
#define PG8_BAR __builtin_amdgcn_s_barrier()
#define PG8_SCHED __builtin_amdgcn_sched_barrier(0)
    Unit cur, nxt; int ui = 0;
    if (!S.next(0, cur)) return;
    f32x4 acc[2][2][4][2];
#pragma unroll
    for (int a = 0; a < 2; ++a)
#pragma unroll
        for (int b = 0; b < 2; ++b)
#pragma unroll
            for (int m = 0; m < 4; ++m)
#pragma unroll
                for (int n = 0; n < 2; ++n) acc[a][b][m][n] = (f32x4){0.f, 0.f, 0.f, 0.f};
    h16x8 At[4][2], B0[2][2], B1[2][2];
    const char* cA = (const char*)g.A + (size_t)cur.pm * tstepA + (size_t)cur.ko * 2; const char* cB = (const char*)g.Bt + (size_t)cur.pn * tstepB + (size_t)cur.ko * 2;
    {
        PG8_STAGE(PG8_SB(0, 0), cB, voffB); PG8_STAGE(PG8_SB(0, 1), cB + hstepB, voffB); PG8_STAGE(PG8_SA(0, 0), cA, voffA); PG8_STAGE(PG8_SA(0, 1), cA + hstepA, voffA);
        if (wr == 1) PG8_BAR;
        PG8_WAIT_V(2); PG8_BAR;
        PG8_STAGE(PG8_SB(1, 0), cB + kstep, voffB); PG8_STAGE(PG8_SA(1, 0), cA + kstep, voffA); PG8_STAGE(PG8_SB(1, 1), cB + hstepB + kstep, voffB);
        PG8_WAIT_V(6); PG8_BAR;
    }
    for (;;) {
        const bool has_next = S.next(ui + 1, nxt);
        const char* nA = has_next ? (const char*)g.A + (size_t)nxt.pm * tstepA + (size_t)nxt.ko * 2 : cA; const char* nB = has_next ? (const char*)g.Bt + (size_t)nxt.pn * tstepB + (size_t)nxt.ko * 2 : cB;
        int nt = cur.nt ? cur.nt : nt0; asm volatile("" : "+s"(nt));
        for (int t = 0; t < nt; t += 2) {
            const bool last = (t == nt - 2);
            const char* a1 = cA + (size_t)(t + 1) * kstep;
            const char* a2 = last ? nA : cA + (size_t)(t + 2) * kstep; const char* b2 = last ? nB : cB + (size_t)(t + 2) * kstep;
            const char* a3 = a2 + kstep; const char* b3 = b2 + kstep;
            PG8_LDB(B0, 0, 0); PG8_LDB(B1, 0, 1); PG8_SCHED; PG8_LDA(At, 0, 0); PG8_STAGE(PG8_SA(1, 1), a1 + hstepA, voffA);
            PG8_WAIT_V(8); PG8_WAIT_L(0); PG8_BAR; PG8_MMA(0, 0, At, B0); PG8_MMA(0, 1, At, B1); PG8_BAR; PG8_SCHED;
            PG8_LDA(At, 0, 1); PG8_STAGE(PG8_SB(0, 0), b2, voffB); PG8_STAGE(PG8_SB(0, 1), b2 + hstepB, voffB); PG8_STAGE(PG8_SA(0, 0), a2, voffA);
            PG8_WAIT_V(8); PG8_WAIT_L(0); PG8_BAR; PG8_MMA(1, 0, At, B0); PG8_MMA(1, 1, At, B1); PG8_BAR; PG8_SCHED;
            PG8_LDB(B0, 1, 0); PG8_LDB(B1, 1, 1); PG8_SCHED; PG8_LDA(At, 1, 0); PG8_STAGE(PG8_SA(0, 1), a2 + hstepA, voffA);
            PG8_WAIT_V(8); PG8_WAIT_L(0); PG8_BAR; PG8_MMA(0, 0, At, B0); PG8_MMA(0, 1, At, B1); PG8_BAR; PG8_SCHED;
            PG8_LDA(At, 1, 1); PG8_STAGE(PG8_SB(1, 0), b3, voffB); PG8_STAGE(PG8_SB(1, 1), b3 + hstepB, voffB); PG8_STAGE(PG8_SA(1, 0), a3, voffA);
            PG8_WAIT_V(8); PG8_WAIT_L(0); PG8_BAR; PG8_MMA(1, 0, At, B0); PG8_MMA(1, 1, At, B1); PG8_BAR; PG8_SCHED;
        }
        if constexpr (ALIGN_EPI) { if (wr == 0) PG8_BAR; }
        E(acc, cur, wr, wc, fr, fq);
        if (!has_next) break;
        if (!cur.keep) {
#pragma unroll
        for (int a = 0; a < 2; ++a)
#pragma unroll
            for (int b = 0; b < 2; ++b)
#pragma unroll
                for (int m = 0; m < 4; ++m)
#pragma unroll
                    for (int n = 0; n < 2; ++n) acc[a][b][m][n] = (f32x4){0.f, 0.f, 0.f, 0.f};
        }
        cur = nxt; cA = nA; cB = nB; ++ui;
        if constexpr (ALIGN_EPI) { if (wr == 1) PG8_BAR; }
    }
    PG8_WAIT_V(0);
    if constexpr (!ALIGN_EPI) { if (wr == 0) PG8_BAR; }
    PG8_BAR;
#undef PG8_SA
#undef PG8_SB
#undef PG8_STAGE
#undef PG8_LDA
#undef PG8_LDB
#undef PG8_MMA
#undef PG8_WAIT_V
#undef PG8_WAIT_L
#undef PG8_BAR
#undef PG8_SCHED
}
}

struct Frame {
    LAS unsigned char* lds;
    int tid, lane, wave, vcu, G;
    const float *x, *c, *ctx, *c_ctx, *w_mod, *b_mod, *norm_attn, *norm_ffn, *w_in, *ret_decay, *diff_lambda, *diff_subln,
                *w_ret_o, *w_diff_o, *w_out, *w_router, *router_bias, *w_exp_gu, *w_exp_down, *w_sh_gu, *w_sh_down, *final_norm;
    float* out;
    unsigned char* ws;
};

template <class T> __device__ __forceinline__ const T* uni_ptr(const T* p) {
    const unsigned long long v = (unsigned long long)p;
    const unsigned lo = __builtin_amdgcn_readfirstlane((unsigned)v), hi = __builtin_amdgcn_readfirstlane((unsigned)(v >> 32));
    return (const T*)(((unsigned long long)hi << 32) | lo);
}
__device__ __forceinline__ float wave_sum(float v) {
#pragma unroll
    for (int o = 1; o < 64; o <<= 1) v += __shfl_xor(v, o);
    return v;
}
__device__ __forceinline__ unsigned pk2h(float lo, float hi) { f32x2 v = {lo, hi}; h16x2 h = __builtin_convertvector(v, h16x2); return __builtin_bit_cast(unsigned, h); }
__device__ __forceinline__ float silu_f(float v) { return v / (1.0f + __expf(-v)); }
__device__ __forceinline__ float sigmoid_f(float v) { return 1.0f / (1.0f + __expf(-v)); }

__device__ __forceinline__ void p0_mod_unit(Frame& F, int unit) {
    const int cb = unit % 24, ks = unit / 24;
    LAS float* sv = (LAS float*)F.lds;
    LAS float* red = sv + 768;
    for (int i = F.tid; i < 768; i += NTHR) { const int v = i >> 8, k = i & 255; const float cv = (v < 2) ? F.c[v * DM + ks * 256 + k] : F.c_ctx[ks * 256 + k]; sv[i] = silu_f(cv); }
    __syncthreads();
    const int cl = F.tid & 127, rl = F.tid >> 7;
    const float* wp = F.w_mod + (size_t)(ks * 256 + rl) * (6 * DM) + cb * 512 + cl * 4;
    f32x4 a0 = {0.f, 0.f, 0.f, 0.f}, a1 = a0, a2 = a0;
#pragma unroll 8
    for (int i = 0; i < 64; ++i) { const f32x4 w = *(const f32x4*)(wp + (size_t)i * 4 * (6 * DM)); const int k = rl + 4 * i; a0 += w * sv[k]; a1 += w * sv[256 + k]; a2 += w * sv[512 + k]; }
    *(LAS f32x4*)(red + (rl * 3 + 0) * 512 + cl * 4) = a0; *(LAS f32x4*)(red + (rl * 3 + 1) * 512 + cl * 4) = a1; *(LAS f32x4*)(red + (rl * 3 + 2) * 512 + cl * 4) = a2;
    __syncthreads();
    float* modp = (float*)(F.ws + WS_MODP);
    for (int i = F.tid; i < 1536; i += NTHR) { const int v = i >> 9, cc = i & 511; const float s = (red[(0 * 3 + v) * 512 + cc] + red[(1 * 3 + v) * 512 + cc]) + (red[(2 * 3 + v) * 512 + cc] + red[(3 * 3 + v) * 512 + cc]);
        modp[(size_t)(ks * 3 + v) * (6 * DM) + cb * 512 + cc] = s; }
    __syncthreads();
}
template <int MAP>
__device__ __forceinline__ void p0_transpose_item(const float* W, int K, int N, h16* WT, LAS float* scr, int item, int lane, int ldd = 0) {
    if (ldd == 0) ldd = K;
    const int nblk = N / 32, kb = item / nblk, nb = item % nblk, k0 = 64 * kb, n0 = 32 * nb;
    float wv[32];
#pragma unroll
    for (int i = 0; i < 32; ++i) { const int kk = 2 * i + (lane >> 5); wv[i] = W[(size_t)(k0 + kk) * N + n0 + (lane & 31)]; }
#pragma unroll
    for (int i = 0; i < 32; ++i) { const int kk = 2 * i + (lane >> 5); scr[kk * 33 + (lane & 31)] = wv[i]; }
    asm volatile("s_waitcnt lgkmcnt(0)" ::: "memory");
    const int cch = lane & 7;
#pragma unroll
    for (int j = 0; j < 4; ++j) { const int n = (lane >> 3) + 8 * j; const LAS float* s = scr + (8 * cch) * 33 + n;
        u32x4 o; o.x = pk2h(s[0 * 33], s[1 * 33]); o.y = pk2h(s[2 * 33], s[3 * 33]); o.z = pk2h(s[4 * 33], s[5 * 33]); o.w = pk2h(s[6 * 33], s[7 * 33]);
        int nn = n0 + n;
        if (MAP == 1) { const bool isrope = (nn < 1024) || (nn >= C_RQ && nn < C_RQ + 1024); if (isrope) nn = (nn & ~48) | ((nn & 16) << 1) | ((nn & 32) >> 1); }
        if (MAP == 2) { const int j = nn & 255, isu = nn >> 8; nn = 32 * (j >> 4) + 16 * isu + (j & 15); }
        *(u32x4*)(WT + (size_t)nn * ldd + k0 + 8 * cch) = o; }
    asm volatile("s_waitcnt lgkmcnt(0)" ::: "memory");
}
__device__ __forceinline__ void p0a_mod(Frame& F) {
    for (int u = F.vcu; u < 192; u += F.G) p0_mod_unit(F, u);
}
__device__ __forceinline__ void p0b_weights(Frame& F) {
    __syncthreads();
    LAS float* scr = (LAS float*)(F.lds + F.wave * 16384);
    const int gw = F.vcu * NWAVES + F.wave, NGW = F.G * NWAVES;
    constexpr int I_IN = (DM / 64) * (IN_COLS / 32);
    for (int it = gw; it < I_IN; it += NGW) p0_transpose_item<1>(F.w_in, DM, IN_COLS, (h16*)(F.ws + WS_WINT), scr, it, F.lane);
    if (blockIdx.x == 0) {
        float* rope = (float*)(F.ws + WS_ROPE);
        for (int i = F.tid; i < 64 * 32; i += NTHR) { const int pos = i >> 5, j = i & 31; const float inv = exp2f(-(float)j * (13.287712379549449f / 32.0f)); const float ang = (float)pos * inv; rope[i] = cosf(ang); rope[2048 + i] = sinf(ang); }
        for (int i = F.tid; i < 64 * 16; i += NTHR) { const int pos = i >> 4, j = i & 15; const float inv = exp2f(-(float)j * (13.287712379549449f / 16.0f)); const float ang = (float)pos * inv; rope[4096 + i] = cosf(ang); rope[4096 + 1024 + i] = sinf(ang); }
    }
}
__device__ __forceinline__ void p0c_weights_dyn(Frame& F, int qid) {
    unsigned* QH = (unsigned*)(F.ws + WS_CTL) + CW_Q + 64 * 8 * qid;
    LAS int* RED = (LAS int*)(F.lds + LDS_TICKET);
    LAS float* scr = (LAS float*)(F.lds + F.wave * 16384);
    constexpr int I_RET = (2048 / 64) * (DM / 32), I_DIF = (1024 / 64) * (DM / 32), I_OUT = (DM / 64) * (DM / 32), I_SGU = (DM / 64) * (512 / 32), I_SDN = (256 / 64) * (DM / 32), I_RT = NEXP * DM / 4 / 64;
    constexpr int NITEMS = I_RET + I_DIF + I_OUT + I_SGU + I_SDN + I_RT, NTICK = (NITEMS + 7) / 8;
    for (;;) {
        __syncthreads();
        if (F.tid == 0) RED[0] = (int)__hip_atomic_fetch_add(QH, 1u, __ATOMIC_RELAXED, __HIP_MEMORY_SCOPE_AGENT);
        __syncthreads();
        const int t = RED[0];
        if (t >= NTICK) break;
        int r = t * 8 + F.wave;
        if (r >= NITEMS) continue;
        if (r < I_RET) { p0_transpose_item<0>(F.w_ret_o, 2048, DM, (h16*)(F.ws + WS_WCAT), scr, r, F.lane, 3072); continue; } r -= I_RET;
        if (r < I_DIF) { p0_transpose_item<0>(F.w_diff_o, 1024, DM, (h16*)(F.ws + WS_WCAT) + 2048, scr, r, F.lane, 3072); continue; } r -= I_DIF;
        if (r < I_OUT) { p0_transpose_item<0>(F.w_out, DM, DM, (h16*)(F.ws + WS_WOUT), scr, r, F.lane); continue; } r -= I_OUT;
        if (r < I_SGU) { p0_transpose_item<2>(F.w_sh_gu, DM, 512, (h16*)(F.ws + WS_WSGU), scr, r, F.lane); continue; } r -= I_SGU;
        if (r < I_SDN) { p0_transpose_item<0>(F.w_sh_down, 256, DM, (h16*)(F.ws + WS_WSDN), scr, r, F.lane); continue; } r -= I_SDN;
        {
            const int q = r * 64 + F.lane, e = q / (DM / 4), k = (q % (DM / 4)) * 4;
            const f32x4 w = *(const f32x4*)(F.w_router + (size_t)e * DM + k);
            h16 hi[4], lo[4];
#pragma unroll
            for (int j = 0; j < 4; ++j) { hi[j] = (h16)w[j]; lo[j] = (h16)(w[j] - (float)hi[j]); }
            h16* dst = (h16*)(F.ws + WS_WRTR) + (size_t)e * 6144 + k;
            *(h16x4*)(dst) = (h16x4){hi[0], hi[1], hi[2], hi[3]}; *(h16x4*)(dst + 2048) = (h16x4){hi[0], hi[1], hi[2], hi[3]}; *(h16x4*)(dst + 4096) = (h16x4){lo[0], lo[1], lo[2], lo[3]};
        }
    }
}

__device__ __forceinline__ void p1_norm1(Frame& F) {
    LAS float* msh = (LAS float*)F.lds; LAS float* msc = msh + 3 * DM;
    const float* modp = (const float*)(F.ws + WS_MODP);
#pragma unroll 1
    for (int i0 = F.tid; i0 < 3 * 2 * DM; i0 += 4 * NTHR) { float pv[4][8], bs[4];
#pragma unroll
        for (int q = 0; q < 4; ++q) { const int i = i0 + q * NTHR, v = i / (2 * DM), cc = i % (2 * DM); bs[q] = F.b_mod[cc];
#pragma unroll
            for (int ks = 0; ks < 8; ++ks) pv[q][ks] = modp[(size_t)(ks * 3 + v) * (6 * DM) + cc]; }
#pragma unroll
        for (int q = 0; q < 4; ++q) { const int i = i0 + q * NTHR, v = i / (2 * DM), cc = i % (2 * DM); float s = bs[q];
#pragma unroll
            for (int ks = 0; ks < 8; ++ks) s += pv[q][ks];
            if (cc < DM) msh[v * DM + cc] = s; else msc[v * DM + cc - DM] = s; } }
    __syncthreads();
    const int gw = F.vcu * NWAVES + F.wave, NGW = F.G * NWAVES;
    h16* H = (h16*)(F.ws + WS_H);
    for (int r = gw; r < MALL; r += NGW) {
        const float* src = (r < MLAT) ? F.x + (size_t)r * DM : F.ctx + (size_t)(r - MLAT) * DM; const int v = (r < MLAT) ? (r / SEQ) : 2;
        f32x4 xv[8]; float ss = 0.f;
#pragma unroll
        for (int j = 0; j < 8; ++j) { xv[j] = *(const f32x4*)(src + 4 * F.lane + 256 * j); ss += (xv[j].x * xv[j].x + xv[j].y * xv[j].y) + (xv[j].z * xv[j].z + xv[j].w * xv[j].w); }
        const float rstd = 1.0f / sqrtf(wave_sum(ss) * (1.0f / DM) + EPS);
#pragma unroll
        for (int j = 0; j < 8; ++j) { const int cc = 4 * F.lane + 256 * j; const f32x4 nw = *(const f32x4*)(F.norm_attn + cc);
            const f32x4 sc = *(LAS f32x4*)(msc + v * DM + cc), sh = *(LAS f32x4*)(msh + v * DM + cc);
            const f32x4 y = xv[j] * rstd * nw * (sc + 1.0f) + sh;
            u32x2 o; o.x = pk2h(y.x, y.y); o.y = pk2h(y.z, y.w); *(u32x2*)(H + (size_t)r * DM + cc) = o; }
    }
    float* MOD = (float*)(F.ws + WS_MOD);
    for (int i = blockIdx.x * NTHR + F.tid; i < 3 * 6 * DM; i += F.G * NTHR) { const int v = i / (6 * DM), cc = i % (6 * DM); float s = F.b_mod[cc];
#pragma unroll
        for (int ks = 0; ks < 8; ++ks) s += modp[(size_t)(ks * 3 + v) * (6 * DM) + cc];
        MOD[i] = s; }
}


__device__ __forceinline__ int crow(int r, int hi) { return (r & 3) + 8 * (r >> 2) + 4 * hi; }
__device__ __forceinline__ h16x8 frag_row(const LAS unsigned char* base, int strideB, int r0, int k0, int lane) {
    return *(const LAS h16x8*)(base + (r0 + (lane & 31)) * strideB + (k0 + 8 * (lane >> 5)) * 2);
}
__device__ __forceinline__ v4i16_t tr16(const LAS unsigned char* p) { return __builtin_amdgcn_ds_read_tr16_b64_v4i16((LAS v4i16_t*)p); }
__device__ __forceinline__ h16x8 frag_tr(const LAS unsigned char* base, int strideB, int k0, int n0, int lane) {
    const int kb = k0 + 8 * (lane >> 5) + ((lane & 15) >> 2), nc = n0 + 16 * ((lane >> 4) & 1) + 4 * (lane & 3);
    const LAS unsigned char* p = base + kb * strideB + nc * 2;
    const v4i16_t lo = tr16(p), hi = tr16(p + 4 * strideB);
    typedef short s16x8 __attribute__((ext_vector_type(8)));
    const s16x8 v = {lo[0], lo[1], lo[2], lo[3], hi[0], hi[1], hi[2], hi[3]};
    return __builtin_bit_cast(h16x8, v);
}
__device__ __forceinline__ h16x8 frag_tr_perm(const LAS unsigned char* base, int strideB, int k0, int n0, int lane) {
    const int kb = k0 + 4 * (lane >> 5) + ((lane & 15) >> 2), nc = n0 + 16 * ((lane >> 4) & 1) + 4 * (lane & 3);
    const LAS unsigned char* p = base + kb * strideB + nc * 2;
    const v4i16_t lo = tr16(p), hi = tr16(p + 8 * strideB);
    typedef short s16x8 __attribute__((ext_vector_type(8)));
    const s16x8 v = {lo[0], lo[1], lo[2], lo[3], hi[0], hi[1], hi[2], hi[3]};
    return __builtin_bit_cast(h16x8, v);
}
__device__ __forceinline__ h16x8 pack8(float a0, float a1, float a2, float a3, float a4, float a5, float a6, float a7) {
    u32x4 w; w.x = pk2h(a0, a1); w.y = pk2h(a2, a3); w.z = pk2h(a4, a5); w.w = pk2h(a6, a7); return __builtin_bit_cast(h16x8, w);
}
#define MFMA32(a, b, c) __builtin_amdgcn_mfma_f32_32x32x16_f16((a), (b), (c), 0, 0, 0)

struct SchedG1 {
    pg8::StaticOrder so; int G, c;
    __device__ __forceinline__ bool next(int i, pg8::Unit& u) const {
        const int L = i * G + c;
        if (L < 32 * 52) return so.next(i, u);
        const int r = L - 32 * 52; if (r >= 40) return false;
        u.pm = 32 + r / 20; u.pn = r % 20; u.ko = 0; u.nt = 0; u.keep = 0; return true;
    }
};
struct EpiP {
    h16* P; const float* rope;
    __device__ __forceinline__ void operator()(f32x4 (&acc)[2][2][4][2], const pg8::Unit& u, int wr, int wc, int fr, int fq) const {
        const int colt = u.pn * 256; const bool lat = u.pm < 32;
        int kind;
        if (colt < C_RV) kind = 1; else if (colt < C_DK) kind = 0; else if (colt < C_DV) kind = 3; else if (colt < C_RQ) kind = 0; else if (colt < C_RG) kind = 2; else if (colt < C_DQ) kind = 5; else if (colt < C_GR) kind = 4; else kind = 6;
        if (!lat) kind = (kind == 1) ? 7 : 0;
#pragma unroll
        for (int ai = 0; ai < 2; ++ai)
#pragma unroll
            for (int m = 0; m < 4; ++m) {
                const int row = u.pm * 256 + ai * 128 + wr * 64 + m * 16 + fr; const int t = row & (SEQ - 1);
                h16* prow = P + (size_t)row * IN_COLS;
#pragma unroll
                for (int bj = 0; bj < 2; ++bj) {
                    const int cbase = colt + bj * 128 + wc * 32;
                    const f32x4 x0 = acc[ai][bj][m][0], x1 = acc[ai][bj][m][1];
                    f32x4 o0, o1; int c0, c1;
                    if (kind == 1 || kind == 2) {
                        const int g5 = (cbase >> 5) & 1, axis = (cbase >> 6) & 1, pos = axis ? (t & 63) : (t >> 6), j0 = 16 * g5 + 4 * fq;
                        const f32x4 cs = *(const f32x4*)(rope + pos * 32 + j0), sn = *(const f32x4*)(rope + 2048 + pos * 32 + j0);
                        o0 = x0 * cs - x1 * sn; o1 = x0 * sn + x1 * cs;
                        if (kind == 2) { o0 *= 0.08838834764831845f; o1 *= 0.08838834764831845f; }
                        c0 = (cbase & ~63) + j0; c1 = c0 + 32;
                    } else if (kind == 7) {
                        const int g5 = (cbase >> 5) & 1; c0 = (cbase & ~63) + 16 * g5 + 4 * fq; c1 = c0 + 32; o0 = x0; o1 = x1;
                    } else if (kind == 3 || kind == 4) {
                        const int axis = (cbase >> 5) & 1, pos = axis ? (t & 63) : (t >> 6), j0 = 4 * fq;
                        const f32x4 cs = *(const f32x4*)(rope + 4096 + pos * 16 + j0), sn = *(const f32x4*)(rope + 5120 + pos * 16 + j0);
                        o0 = x0 * cs - x1 * sn; o1 = x0 * sn + x1 * cs;
                        if (kind == 4) { o0 *= 0.18033688011112042f; o1 *= 0.18033688011112042f; }
                        c0 = cbase + j0; c1 = c0 + 16;
                    } else {
                        c0 = cbase + 4 * fq; c1 = c0 + 16; o0 = x0; o1 = x1;
                        if (kind == 5) {
#pragma unroll
                            for (int e = 0; e < 4; ++e) { o0[e] = silu_f(x0[e]); o1[e] = silu_f(x1[e]); }
                        } else if (kind == 6) {
#pragma unroll
                            for (int e = 0; e < 4; ++e) { o0[e] = sigmoid_f(x0[e]); o1[e] = sigmoid_f(x1[e]); }
                        }
                    }
                    u32x2 w0, w1; w0.x = pk2h(o0[0], o0[1]); w0.y = pk2h(o0[2], o0[3]); w1.x = pk2h(o1[0], o1[1]); w1.y = pk2h(o1[2], o1[3]);
                    *(u32x2*)(prow + c0) = w0; *(u32x2*)(prow + c1) = w1;
                }
            }
    }
};
__device__ __forceinline__ void p2_gemm1(Frame& F) {
    pg8::Gemm g{(const h16*)(F.ws + WS_H), (const h16*)(F.ws + WS_WINT), DM, DM, DM};
    SchedG1 S; S.so.init(MLAT, IN_COLS, F.G, (int)blockIdx.x); S.G = F.G; S.c = (int)blockIdx.x;
    EpiP E{(h16*)(F.ws + WS_P), (const float*)(F.ws + WS_ROPE)};
    pg8::gemm_phase<EpiP, SchedG1>(F.lds, g, S, E);
}

__device__ __forceinline__ void p3_ret_local(Frame& F) {
    LAS unsigned char* KF = F.lds; LAS unsigned char* KB = F.lds + 40960; LAS unsigned char* VH = F.lds + 81920;
    const h16* P = (const h16*)(F.ws + WS_P); h16* LST = (h16*)(F.ws + WS_LST);
    const int hi = F.lane >> 5;
    for (int u = F.vcu; u < 16 * 34; u += F.G) {
        const int bh = u / 34, cc = u % 34, b = bh >> 3, h = bh & 7;
        const int row0 = (cc < 2) ? (MLAT + b * CTXL + cc * 128) : (b * SEQ + (cc - 2) * 128);
        const float lgf = -__expf(F.ret_decay[h]), lgb = -__expf(F.ret_decay[8 + h]);
#pragma unroll
        for (int i = 0; i < 4; ++i) { const int q = F.tid + NTHR * i, row = q >> 4, ch = q & 15;
            const h16x8 kv = *(const h16x8*)(P + (size_t)(row0 + row) * IN_COLS + C_RK + h * 128 + ch * 8);
            const float sf = __expf(lgf * (float)(127 - row)), sb = __expf(lgb * (float)row);
            *(LAS h16x8*)(KF + row * 320 + ch * 16) = pack8((float)kv[0] * sf, (float)kv[1] * sf, (float)kv[2] * sf, (float)kv[3] * sf, (float)kv[4] * sf, (float)kv[5] * sf, (float)kv[6] * sf, (float)kv[7] * sf);
            *(LAS h16x8*)(KB + row * 320 + ch * 16) = pack8((float)kv[0] * sb, (float)kv[1] * sb, (float)kv[2] * sb, (float)kv[3] * sb, (float)kv[4] * sb, (float)kv[5] * sb, (float)kv[6] * sb, (float)kv[7] * sb); }
        for (int eh = 0; eh < 2; ++eh) {
            if (eh) __syncthreads();
#pragma unroll
            for (int i = 0; i < 4; ++i) { const int q = F.tid + NTHR * i, row = q >> 4, ch = q & 15;
                *(LAS h16x8*)(VH + row * 320 + ch * 16) = *(const h16x8*)(P + (size_t)(row0 + row) * IN_COLS + C_RV + h * 256 + eh * 128 + ch * 8); }
            __syncthreads();
            const int dir = F.wave >> 2, eb = F.wave & 3; const LAS unsigned char* Kd = dir ? KB : KF;
            f32x16 acc[4];
#pragma unroll
            for (int db = 0; db < 4; ++db) acc[db] = (f32x16){};
#pragma unroll
            for (int ks = 0; ks < 8; ++ks) { const h16x8 a = frag_tr(VH, 320, 16 * ks, 32 * eb, F.lane);
#pragma unroll
                for (int db = 0; db < 4; ++db) { const h16x8 bb = frag_tr(Kd, 320, 16 * ks, 32 * db, F.lane); acc[db] = MFMA32(a, bb, acc[db]); } }
            h16* dst = LST + ((size_t)((dir * 16 + bh) * 34 + cc) * 256 + eh * 128 + eb * 32) * 128;
#pragma unroll
            for (int db = 0; db < 4; ++db)
#pragma unroll
                for (int r = 0; r < 16; ++r) dst[crow(r, hi) * 128 + db * 32 + (F.lane & 31)] = (h16)acc[db][r];
        }
        __syncthreads();
    }
}
__device__ __forceinline__ void p4_ret_scan(Frame& F) {
    const h16* LST = (const h16*)(F.ws + WS_LST); h16* SST = (h16*)(F.ws + WS_SST);
    for (int g = blockIdx.x * NTHR + F.tid; g < 2 * 16 * 4096; g += F.G * NTHR) {
        const int seq = g >> 12, off = (g & 4095) * 8, dir = seq >> 4, bh = seq & 15, h = bh & 7;
        const float cd = __expf(-__expf(F.ret_decay[dir * 8 + h]) * 128.0f);
        const h16* Lp = LST + (size_t)seq * 34 * 32768 + off; h16* Sp = SST + (size_t)seq * 32 * 32768 + off;
        float s[8];
#pragma unroll
        for (int e = 0; e < 8; ++e) s[e] = 0.f;
        if (dir == 0) {
            for (int cc = 0; cc < 33; ++cc) {
                if (cc >= 2) *(h16x8*)(Sp + (size_t)(cc - 2) * 32768) = pack8(s[0], s[1], s[2], s[3], s[4], s[5], s[6], s[7]);
                const h16x8 l = *(const h16x8*)(Lp + (size_t)cc * 32768);
#pragma unroll
                for (int e = 0; e < 8; ++e) s[e] = s[e] * cd + (float)l[e];
            }
            *(h16x8*)(Sp + (size_t)31 * 32768) = pack8(s[0], s[1], s[2], s[3], s[4], s[5], s[6], s[7]);
        } else {
            { const h16x8 l1 = *(const h16x8*)(Lp + (size_t)1 * 32768), l0 = *(const h16x8*)(Lp);
#pragma unroll
              for (int e = 0; e < 8; ++e) s[e] = (float)l1[e] * cd + (float)l0[e]; }
            for (int c = 31; c >= 0; --c) {
                *(h16x8*)(Sp + (size_t)c * 32768) = pack8(s[0], s[1], s[2], s[3], s[4], s[5], s[6], s[7]);
                const h16x8 l = *(const h16x8*)(Lp + (size_t)(c + 2) * 32768);
#pragma unroll
                for (int e = 0; e < 8; ++e) s[e] = s[e] * cd + (float)l[e];
            }
        }
    }
}
__device__ __forceinline__ void p5_ret_out(Frame& F) {
    LAS unsigned char* QL = F.lds; LAS unsigned char* KL = F.lds + 34816; LAS unsigned char* PL = KL; LAS unsigned char* VL = F.lds + 69632;
    LAS float* RED = (LAS float*)(F.lds + 69632 + 73728);
    const h16* P = (const h16*)(F.ws + WS_P); const h16* SST = (const h16*)(F.ws + WS_SST); h16* ARET = (h16*)(F.ws + WS_ACAT);
    const int hi = F.lane >> 5, ln = F.lane & 31, w = F.wave;
    for (int u = F.vcu; u < 512; u += F.G) {
        const int bh = u >> 5, c = u & 31, b = bh >> 3, h = bh & 7, row0 = b * SEQ + c * 128;
        const float lgf = -__expf(F.ret_decay[h]), lgb = -__expf(F.ret_decay[8 + h]);
#pragma unroll
        for (int i = 0; i < 4; ++i) { const int q = F.tid + NTHR * i, row = q >> 4, ch = q & 15; const h16* pr = P + (size_t)(row0 + row) * IN_COLS + h * 128 + ch * 8;
            *(LAS h16x8*)(QL + row * 272 + ch * 16) = *(const h16x8*)(pr + C_RQ); *(LAS h16x8*)(KL + row * 272 + ch * 16) = *(const h16x8*)(pr + C_RK); }
        h16x8 vreg[8];
#pragma unroll
        for (int i = 0; i < 8; ++i) { const int q = F.tid + NTHR * i, row = q >> 5, c32 = q & 31; vreg[i] = *(const h16x8*)(P + (size_t)(row0 + row) * IN_COLS + C_RV + h * 256 + c32 * 8); }
        __syncthreads();
        u32x2 pw[2][4];
        { const int jt = w >> 1;
#pragma unroll
          for (int t2 = 0; t2 < 2; ++t2) { const int ib = 2 * (w & 1) + t2, il = 32 * ib + ln; f32x16 s = (f32x16){};
#pragma unroll
            for (int ks = 0; ks < 8; ++ks) s = MFMA32(frag_row(KL, 272, 32 * jt, 16 * ks, F.lane), frag_row(QL, 272, 32 * ib, 16 * ks, F.lane), s);
#pragma unroll
            for (int r = 0; r < 16; ++r) { const int d = il - (32 * jt + crow(r, hi)); s[r] *= (d >= 0) ? __expf(lgf * (float)d) : __expf(lgb * (float)(-d)); }
#pragma unroll
            for (int r4 = 0; r4 < 4; ++r4) { pw[t2][r4].x = pk2h(s[4 * r4], s[4 * r4 + 1]); pw[t2][r4].y = pk2h(s[4 * r4 + 2], s[4 * r4 + 3]); } } }
        __syncthreads();
        { const int jt = w >> 1;
#pragma unroll
          for (int t2 = 0; t2 < 2; ++t2) { const int il = 32 * (2 * (w & 1) + t2) + ln;
#pragma unroll
            for (int r4 = 0; r4 < 4; ++r4) *(LAS u32x2*)(PL + il * 272 + (32 * jt + 8 * r4 + 4 * hi) * 2) = pw[t2][r4]; } }
#pragma unroll
        for (int i = 0; i < 8; ++i) { const int q = F.tid + NTHR * i, row = q >> 5, c32 = q & 31; *(LAS h16x8*)(VL + row * 576 + c32 * 16) = vreg[i]; }
        __syncthreads();
        f32x16 o[4];
#pragma unroll
        for (int ib = 0; ib < 4; ++ib) o[ib] = (f32x16){};
#pragma unroll
        for (int k16 = 0; k16 < 8; ++k16) { const h16x8 a = frag_tr(VL, 576, 16 * k16, 32 * w, F.lane);
#pragma unroll
            for (int ib = 0; ib < 4; ++ib) o[ib] = MFMA32(a, frag_row(PL, 272, 32 * ib, 16 * k16, F.lane), o[ib]);
            if (k16 & 1) __builtin_amdgcn_sched_barrier(0); }
#pragma unroll
        for (int dir = 0; dir < 2; ++dir) {
            h16 sc[4];
#pragma unroll
            for (int ib = 0; ib < 4; ++ib) { const int il = 32 * ib + ln; sc[ib] = (h16)(dir ? __expf(lgb * (float)(128 - il)) : __expf(lgf * (float)(il + 1))); }
            const h16* Sg = SST + ((size_t)((dir * 16 + bh) * 32 + c) * 256 + 32 * w + ln) * 128 + 8 * hi;
#pragma unroll
            for (int kh = 0; kh < 2; ++kh) {
                h16x8 sa[4];
#pragma unroll
                for (int k4 = 0; k4 < 4; ++k4) sa[k4] = *(const h16x8*)(Sg + 16 * (4 * kh + k4));
#pragma unroll
                for (int k4 = 0; k4 < 4; ++k4) {
#pragma unroll
                    for (int ib = 0; ib < 4; ++ib) o[ib] = MFMA32(sa[k4], frag_row(QL, 272, 32 * ib, 16 * (4 * kh + k4), F.lane) * sc[ib], o[ib]);
                    __builtin_amdgcn_sched_barrier(0); }
            }
        }
#pragma unroll
        for (int ib = 0; ib < 4; ++ib) { float ss = 0.f;
#pragma unroll
            for (int r = 0; r < 16; ++r) ss += o[ib][r] * o[ib][r];
            ss += __shfl_xor(ss, 32);
            if (hi == 0) RED[(w * 4 + ib) * 32 + ln] = ss; }
        __syncthreads();
#pragma unroll
        for (int ib = 0; ib < 4; ++ib) { float tot = 0.f;
#pragma unroll
            for (int ww = 0; ww < 8; ++ww) tot += RED[(ww * 4 + ib) * 32 + ln];
            const float rstd = 1.0f / sqrtf(tot * (1.0f / 256.0f) + EPS);
            const size_t grow = (size_t)(row0 + 32 * ib + ln);
#pragma unroll
            for (int r4 = 0; r4 < 4; ++r4) { const int e = 32 * w + 8 * r4 + 4 * hi;
                const h16x4 gt = *(const h16x4*)(P + grow * IN_COLS + C_RG + h * 256 + e);
                u32x2 wv; wv.x = pk2h(o[ib][4 * r4] * rstd * (float)gt[0], o[ib][4 * r4 + 1] * rstd * (float)gt[1]); wv.y = pk2h(o[ib][4 * r4 + 2] * rstd * (float)gt[2], o[ib][4 * r4 + 3] * rstd * (float)gt[3]);
                *(u32x2*)(ARET + grow * 3072 + h * 256 + e) = wv; } }
        __syncthreads();
    }
}
__device__ __forceinline__ void p6_attn(Frame& F) {
    const h16* P = (const h16*)(F.ws + WS_P); h16* ADIF = (h16*)(F.ws + WS_ACAT) + 2048;
    const int hi = F.lane >> 5, ln = F.lane & 31;
    float lam;
    { const float s1 = wave_sum(F.diff_lambda[F.lane] * F.diff_lambda[64 + F.lane]), s2 = wave_sum(F.diff_lambda[128 + F.lane] * F.diff_lambda[192 + F.lane]); lam = __expf(s1) - __expf(s2) + 0.2f; }
    constexpr int KT0 = 0, VT0 = 34816, KTB = 17408, VTB = 20480;
    LAS float* XB = (LAS float*)F.lds;
    for (int u = F.vcu; u < 512; u += F.G) {
        const int bh = u >> 5, qb = u & 31, b = bh >> 3, h = bh & 7;
        const int cm = F.wave & 1, qs = F.wave >> 1, qrow0 = b * SEQ + qb * 128 + qs * 32;
        h16x8 qf[4];
#pragma unroll
        for (int ks = 0; ks < 4; ++ks) qf[ks] = *(const h16x8*)(P + (size_t)(qrow0 + ln) * IN_COLS + C_DQ + h * 128 + cm * 64 + 16 * ks + 8 * hi);
        f32x16 o[4];
#pragma unroll
        for (int et = 0; et < 4; ++et) o[et] = (f32x16){};
        float mrun = 0.f, lsum = 0.f; f32x16 negm = (f32x16){};
        h16x8 kreg[2], vreg[2];
#define ATT_LOAD(t) do { _Pragma("unroll") for (int i = 0; i < 2; ++i) { const int q = F.tid + NTHR * i, row = q >> 4, ch = q & 15; const int j = (t) * 64 + row; \
            const size_t srow = (j < CTXL) ? (size_t)(MLAT + b * CTXL + j) : (size_t)(b * SEQ + j - CTXL); const h16* pr = P + srow * IN_COLS + h * 128 + ch * 8; \
            kreg[i] = *(const h16x8*)(pr + C_DK); vreg[i] = *(const h16x8*)(pr + C_DV); } } while (0)
#define ATT_WRITE(buf) do { _Pragma("unroll") for (int i = 0; i < 2; ++i) { const int q = F.tid + NTHR * i, row = q >> 4, ch = q & 15; \
            *(LAS h16x8*)(F.lds + KT0 + (buf) * KTB + row * 272 + ch * 16) = kreg[i]; *(LAS h16x8*)(F.lds + VT0 + (buf) * VTB + row * 320 + ch * 16) = vreg[i]; } } while (0)
        ATT_LOAD(0); ATT_WRITE(0);
        __syncthreads();
        constexpr int NT = (CTXL + SEQ) / 64;
        for (int t = 0; t < NT; ++t) {
            const int buf = t & 1;
            if (t + 1 < NT) ATT_LOAD(t + 1);
            const LAS unsigned char* Kt = F.lds + KT0 + buf * KTB; const LAS unsigned char* Vt = F.lds + VT0 + buf * VTB;
            f32x16 s[2];
#pragma unroll
            for (int kt = 0; kt < 2; ++kt) { s[kt] = negm;
#pragma unroll
                for (int ks = 0; ks < 4; ++ks) s[kt] = MFMA32(frag_row(Kt, 272, 32 * kt, cm * 64 + 16 * ks, F.lane), qf[ks], s[kt]); }
            float mx = s[0][0];
#pragma unroll
            for (int r = 0; r < 16; ++r) { mx = fmaxf(mx, s[0][r]); mx = fmaxf(mx, s[1][r]); }
            { const auto rr = __builtin_amdgcn_permlane32_swap(__float_as_uint(mx), __float_as_uint(mx), false, false); mx = fmaxf(__uint_as_float(rr[0]), __uint_as_float(rr[1])); }
            if (t == 0 || __any(mx > 8.0f)) { const float dl = (t == 0) ? mx : fmaxf(mx, 0.0f), alpha = (t == 0) ? 0.0f : __builtin_amdgcn_exp2f(-dl); mrun += dl; lsum *= alpha;
#pragma unroll
                for (int et = 0; et < 4; ++et) o[et] *= alpha;
#pragma unroll
                for (int kt = 0; kt < 2; ++kt)
#pragma unroll
                    for (int r = 0; r < 16; ++r) s[kt][r] -= dl;
#pragma unroll
                for (int r = 0; r < 16; ++r) negm[r] = -mrun; }
            f32x2 ps2 = {0.f, 0.f};
#pragma unroll
            for (int kt = 0; kt < 2; ++kt)
#pragma unroll
                for (int r = 0; r < 16; r += 2) { s[kt][r] = __builtin_amdgcn_exp2f(s[kt][r]); s[kt][r + 1] = __builtin_amdgcn_exp2f(s[kt][r + 1]); ps2 += (f32x2){s[kt][r], s[kt][r + 1]}; }
            lsum += ps2[0] + ps2[1];
#pragma unroll
            for (int kt = 0; kt < 2; ++kt)
#pragma unroll
                for (int s2 = 0; s2 < 2; ++s2) {
                    const h16x8 pbf = pack8(s[kt][8 * s2], s[kt][8 * s2 + 1], s[kt][8 * s2 + 2], s[kt][8 * s2 + 3], s[kt][8 * s2 + 4], s[kt][8 * s2 + 5], s[kt][8 * s2 + 6], s[kt][8 * s2 + 7]);
#pragma unroll
                    for (int et = 0; et < 4; ++et) o[et] = MFMA32(frag_tr_perm(Vt, 320, 32 * kt + 16 * s2, 32 * et, F.lane), pbf, o[et]);
                }
            if (t + 1 < NT) ATT_WRITE(buf ^ 1);
            __syncthreads();
        }
#undef ATT_LOAD
#undef ATT_WRITE
        lsum += __shfl_xor(lsum, 32);
        const float inv = 1.0f / lsum;
        if (cm == 1) {
#pragma unroll
            for (int et = 0; et < 4; ++et)
#pragma unroll
                for (int r = 0; r < 16; ++r) XB[(qs * 128 + 32 * et + crow(r, hi)) * 32 + ln] = o[et][r] * inv;
        }
        __syncthreads();
        if (cm == 0) {
            float ss = 0.f;
#pragma unroll
            for (int et = 0; et < 4; ++et)
#pragma unroll
                for (int r = 0; r < 16; ++r) { const float v = o[et][r] * inv - lam * XB[(qs * 128 + 32 * et + crow(r, hi)) * 32 + ln]; o[et][r] = v; ss += v * v; }
            ss += __shfl_xor(ss, 32);
            const float rstd = 0.8f / sqrtf(ss * (1.0f / 128.0f) + EPS);
            const size_t grow = (size_t)(qrow0 + ln);
#pragma unroll
            for (int et = 0; et < 4; ++et)
#pragma unroll
                for (int r4 = 0; r4 < 4; ++r4) { const int e = 32 * et + 8 * r4 + 4 * hi; const f32x4 sw = *(const f32x4*)(F.diff_subln + e);
                    u32x2 w; w.x = pk2h(o[et][4 * r4] * rstd * sw[0], o[et][4 * r4 + 1] * rstd * sw[1]); w.y = pk2h(o[et][4 * r4 + 2] * rstd * sw[2], o[et][4 * r4 + 3] * rstd * sw[3]);
                    *(u32x2*)(ADIF + grow * 3072 + h * 128 + e) = w; }
        }
        __syncthreads();
    }
}
struct SchedG2 {
    pg8::StaticOrder so;
    __device__ __forceinline__ bool next(int i, pg8::Unit& u) const { if (!so.next(i >> 1, u)) return false; if (i & 1) { u.ko = 2048; u.nt = 16; u.keep = 0; } else { u.ko = 0; u.nt = 32; u.keep = 1; } return true; }
};
struct EpiU2 {
    h16* U; const h16* P;
    __device__ __forceinline__ void operator()(f32x4 (&acc)[2][2][4][2], const pg8::Unit& u, int wr, int wc, int fr, int fq) const {
#pragma unroll
        for (int ai = 0; ai < 2; ++ai)
#pragma unroll
            for (int m = 0; m < 4; ++m) { const int row = u.pm * 256 + ai * 128 + wr * 64 + m * 16 + fr;
#pragma unroll
                for (int bj = 0; bj < 2; ++bj)
#pragma unroll
                    for (int n = 0; n < 2; ++n) { const int col = u.pn * 256 + bj * 128 + wc * 32 + 16 * n + 4 * fq;
                        const h16x4 gd = *(const h16x4*)(P + (size_t)row * IN_COLS + C_GD + col);
                        if (u.keep) { const h16x4 gr = *(const h16x4*)(P + (size_t)row * IN_COLS + C_GR + col);
#pragma unroll
                            for (int e = 0; e < 4; ++e) acc[ai][bj][m][n][e] *= (float)gr[e] / (float)gd[e];
                        } else { const f32x4 a = acc[ai][bj][m][n];
                            u32x2 w; w.x = pk2h(a[0] * (float)gd[0], a[1] * (float)gd[1]); w.y = pk2h(a[2] * (float)gd[2], a[3] * (float)gd[3]);
                            *(u32x2*)(U + (size_t)row * DM + col) = w; } } }
    }
};
struct EpiX1 {
    float* X1; const float* x; const float* MOD;
    __device__ __forceinline__ void operator()(f32x4 (&acc)[2][2][4][2], const pg8::Unit& u, int wr, int wc, int fr, int fq) const {
        const int b = (u.pm * 256) / SEQ;
#pragma unroll
        for (int ai = 0; ai < 2; ++ai)
#pragma unroll
            for (int m = 0; m < 4; ++m) { const int row = u.pm * 256 + ai * 128 + wr * 64 + m * 16 + fr;
#pragma unroll
                for (int bj = 0; bj < 2; ++bj)
#pragma unroll
                    for (int n = 0; n < 2; ++n) { const int col = u.pn * 256 + bj * 128 + wc * 32 + 16 * n + 4 * fq;
                        const f32x4 g1 = *(const f32x4*)(MOD + (size_t)b * (6 * DM) + 2 * DM + col); const f32x4 xv = *(const f32x4*)(x + (size_t)row * DM + col);
                        *(f32x4*)(X1 + (size_t)row * DM + col) = xv + g1 * acc[ai][bj][m][n]; } }
    }
};
__device__ __forceinline__ void p7_gemm2(Frame& F) {
    pg8::Gemm g{(const h16*)(F.ws + WS_ACAT), (const h16*)(F.ws + WS_WCAT), 3072, 3072, 2048};
    SchedG2 S; S.so.init(MLAT, DM, F.G, (int)blockIdx.x);
    EpiU2 E{(h16*)(F.ws + WS_U), (const h16*)(F.ws + WS_P)};
    pg8::gemm_phase<EpiU2, SchedG2>(F.lds, g, S, E);
}
__device__ __forceinline__ void p9_gemm3(Frame& F) {
    pg8::Gemm g{(const h16*)(F.ws + WS_U), (const h16*)(F.ws + WS_WOUT), 2048, 2048, 2048};
    pg8::StaticOrder S; S.init(MLAT, DM, F.G, (int)blockIdx.x);
    EpiX1 E{(float*)(F.ws + WS_X1), F.x, (const float*)(F.ws + WS_MOD)};
    pg8::gemm_phase<EpiX1, pg8::StaticOrder>(F.lds, g, S, E);
}


__device__ __forceinline__ void p10_norm2(Frame& F) {
    const float* X1 = (const float*)(F.ws + WS_X1); const float* MOD = (const float*)(F.ws + WS_MOD); h16* H2X = (h16*)(F.ws + WS_H2X);
    const int gw = F.vcu * NWAVES + F.wave, NGW = F.G * NWAVES;
    for (int r = gw; r < MLAT; r += NGW) {
        const float* src = X1 + (size_t)r * DM; const int b = r / SEQ;
        f32x4 xv[8]; float ss = 0.f;
#pragma unroll
        for (int j = 0; j < 8; ++j) { xv[j] = *(const f32x4*)(src + 4 * F.lane + 256 * j); ss += (xv[j].x * xv[j].x + xv[j].y * xv[j].y) + (xv[j].z * xv[j].z + xv[j].w * xv[j].w); }
        const float rstd = 1.0f / sqrtf(wave_sum(ss) * (1.0f / DM) + EPS);
#pragma unroll
        for (int j = 0; j < 8; ++j) { const int cc = 4 * F.lane + 256 * j; const f32x4 nw = *(const f32x4*)(F.norm_ffn + cc);
            const f32x4 sh = *(const f32x4*)(MOD + (size_t)b * (6 * DM) + 3 * DM + cc), sc = *(const f32x4*)(MOD + (size_t)b * (6 * DM) + 4 * DM + cc);
            const f32x4 y = xv[j] * rstd * nw * (sc + 1.0f) + sh;
            h16 hh[4], ll[4];
#pragma unroll
            for (int e = 0; e < 4; ++e) { hh[e] = (h16)y[e]; ll[e] = (h16)(y[e] - (float)hh[e]); }
            h16* dst = H2X + (size_t)r * 6144 + cc;
            *(h16x4*)(dst) = (h16x4){hh[0], hh[1], hh[2], hh[3]}; *(h16x4*)(dst + 4096) = (h16x4){hh[0], hh[1], hh[2], hh[3]}; *(h16x4*)(dst + 2048) = (h16x4){ll[0], ll[1], ll[2], ll[3]};
            { int p8 = __builtin_amdgcn_cvt_pk_fp8_f32(y[0], y[1], 0, false); p8 = __builtin_amdgcn_cvt_pk_fp8_f32(y[2], y[3], p8, true); *(int*)((unsigned char*)(F.ws + WS_H2F8) + (size_t)r * DM + cc) = p8; } }
    }
}
struct SchedRT {
    int G, c;
    __device__ __forceinline__ bool next(int i, pg8::Unit& u) const { const int L = i * G + c; if (L >= 256) return false; u.pm = L >> 3; u.pn = 0; u.ko = (L & 7) * 768; u.nt = 0; u.keep = 0; return true; }
};
struct EpiLG {
    float* LGP;
    __device__ __forceinline__ void operator()(f32x4 (&acc)[2][2][4][2], const pg8::Unit& u, int wr, int wc, int fr, int fq) const {
        float* dst = LGP + (size_t)(u.ko / 768) * MLAT * NEXP;
#pragma unroll
        for (int ai = 0; ai < 2; ++ai)
#pragma unroll
            for (int m = 0; m < 4; ++m) { const int row = u.pm * 256 + ai * 128 + wr * 64 + m * 16 + fr;
#pragma unroll
                for (int bj = 0; bj < 2; ++bj)
#pragma unroll
                    for (int n = 0; n < 2; ++n) { const int col = bj * 128 + wc * 32 + 16 * n + 4 * fq; *(f32x4*)(dst + (size_t)row * NEXP + col) = acc[ai][bj][m][n]; } }
    }
};
__device__ __forceinline__ void p11_router(Frame& F) {
    pg8::Gemm g{(const h16*)(F.ws + WS_H2X), (const h16*)(F.ws + WS_WRTR), 6144, 6144, 768};
    SchedRT S; S.G = F.G; S.c = (int)blockIdx.x;
    EpiLG E{(float*)(F.ws + WS_LGP)};
    pg8::gemm_phase<EpiLG, SchedRT>(F.lds, g, S, E);
}
__device__ __forceinline__ void p12_topk(Frame& F) {
    const float* LGP = (const float*)(F.ws + WS_LGP); int* EIDX = (int*)(F.ws + WS_EIDX); float* EW = (float*)(F.ws + WS_EW); u32x2* LIST = (u32x2*)(F.ws + WS_LIST2);
    unsigned* CNT = (unsigned*)(F.ws + WS_CTL) + CW_CNT;
    const int gw = F.vcu * NWAVES + F.wave, NGW = F.G * NWAVES, lane = F.lane;
    const f32x4 bias = *(const f32x4*)(F.router_bias + 4 * lane);
    f32x4 lgn[8];
#pragma unroll
    for (int ks = 0; ks < 8; ++ks) lgn[ks] = *(const f32x4*)(LGP + ((size_t)ks * MLAT + (gw < MLAT ? gw : 0)) * NEXP + 4 * lane);
    for (int t = gw; t < MLAT; t += NGW) {
        f32x4 lg = lgn[0];
#pragma unroll
        for (int ks = 1; ks < 8; ++ks) lg += lgn[ks];
        { const int tn = (t + NGW < MLAT) ? t + NGW : t;
#pragma unroll
          for (int ks = 0; ks < 8; ++ks) lgn[ks] = *(const f32x4*)(LGP + ((size_t)ks * MLAT + tn) * NEXP + 4 * lane); }
        float sc[4], sel[4];
#pragma unroll
        for (int i = 0; i < 4; ++i) { sc[i] = 1.0f / (1.0f + __expf(-lg[i])); sel[i] = sc[i] + bias[i]; }
        float a1 = fmaxf(sel[0], sel[1]), a2 = fminf(sel[0], sel[1]);
        { const float b1 = fmaxf(sel[2], sel[3]), b2 = fminf(sel[2], sel[3]); const float n1 = fmaxf(a1, b1), n2 = fmaxf(fminf(a1, b1), fmaxf(a2, b2)); a1 = n1; a2 = n2; }
#pragma unroll
        for (int off = 1; off < 8; off <<= 1) { const float b1 = __shfl_xor(a1, off), b2 = __shfl_xor(a2, off); const float n1 = fmaxf(a1, b1), n2 = fmaxf(fminf(a1, b1), fmaxf(a2, b2)); a1 = n1; a2 = n2; }
        const float gs = a1 + a2; const int g = lane >> 3;
        int rank = 0;
#pragma unroll
        for (int j = 0; j < 8; ++j) { const float o = __shfl(gs, 8 * j); rank += (o > gs || (o == gs && j < g)) ? 1 : 0; }
        const bool gsel = rank < 4;
        float ms[4];
#pragma unroll
        for (int i = 0; i < 4; ++i) ms[i] = gsel ? sel[i] : -INFINITY;
        float myw = 0.f; int mye = 0; float wsum = 0.f;
#pragma unroll
        for (int k = 0; k < TOPK; ++k) {
            float bv = ms[0]; int bi = 4 * lane;
#pragma unroll
            for (int i = 1; i < 4; ++i) if (ms[i] > bv) { bv = ms[i]; bi = 4 * lane + i; }
#pragma unroll
            for (int off = 1; off < 64; off <<= 1) { const float ov = __shfl_xor(bv, off); const int oi = __shfl_xor(bi, off); if (ov > bv || (ov == bv && oi < bi)) { bv = ov; bi = oi; } }
            const int ol = bi >> 2, oi = bi & 3;
            const float mysc = (oi == 0) ? sc[0] : (oi == 1) ? sc[1] : (oi == 2) ? sc[2] : sc[3];
            const float w = __shfl(mysc, ol);
            if (lane == ol) {
#pragma unroll
                for (int i = 0; i < 4; ++i) if (i == oi) ms[i] = -INFINITY; }
            wsum += w;
            if (lane == k) { myw = w; mye = bi; }
        }
        if (lane < TOPK) {
            const float wn = myw / wsum * 2.5f;
            EIDX[t * TOPK + lane] = mye; EW[t * TOPK + lane] = wn;
            const unsigned pos = atomicAdd(&CNT[mye], 1u);
            LIST[mye * MLAT + pos] = (u32x2){(unsigned)(t * TOPK + lane), __float_as_uint(wn)};
        }
    }
}
constexpr int EX_NSTG = 3, EX_ASTG = 24576, EX_WSTG = 16384, EX_A0 = 0, EX_W0 = EX_NSTG * EX_ASTG, EX_WH0 = EX_W0 + EX_NSTG * EX_WSTG, EX_WHS = 10240, EX_ROW0 = EX_WH0 + 2 * EX_WHS;
constexpr int EX_TAB0 = EX_ROW0 + 3200, EX_SCR0 = EX_TAB0 + 3072;
static_assert(EX_ROW0 == 143360 && EX_SCR0 + 8192 <= LDSCTL_OFF, "expert LDS map");
template <bool GU>
__device__ __forceinline__ void ring_w_prologue(Frame& F, const float* W, int cgrp) {
    constexpr int LDB = GU ? 512 : 2048;
    const int lane = F.lane, w = F.wave, v = 4 * (lane & 31);
    const int wcol0 = GU ? (((v >> 5) & 1) * 256 + 32 * (v >> 6) + (v & 31) + 64 * cgrp) : (v + 512 * cgrp);
    const float* wlane = W + (size_t)(4 * w + (lane >> 5)) * LDB + wcol0;
#pragma unroll
    for (int s = 0; s < 3; ++s)
#pragma unroll
        for (int j = 0; j < 2; ++j) __builtin_amdgcn_global_load_lds((const unsigned*)(wlane + (size_t)(s * 32 + 2 * j) * LDB), (LAS unsigned*)(F.lds + EX_W0 + s * EX_WSTG + (2 * w + j) * 1024), 16, 0, 2);
}
template <bool GU, int NLAY>
__device__ __forceinline__ void expert_ring(Frame& F, const float* W, const h16* Abase, const int (&arow)[3], int nr, int cgrp, h16* ACTrow0, h16* Y) {
    constexpr int KT = GU ? 64 : 8, NP = GU ? 1 : 4, LDB = GU ? 512 : 2048, NS = KT * NP;
    const int tid = F.tid, lane = F.lane, hi = lane >> 5, ln = lane & 31, cp = F.wave & 1, rg = F.wave >> 1, w = F.wave;
    const LAS int* RSLOT = (const LAS int*)(F.lds + EX_ROW0); const LAS float* RW = (const LAS float*)(F.lds + EX_ROW0 + 1536);
    const int ngrp = (nr + 15) >> 4;
    const int nA = (w < ngrp ? 1 : 0) + (w + 8 < ngrp ? 1 : 0) + (w + 16 < ngrp ? 1 : 0);
    const int achunk = ((lane & 3) ^ ((lane >> 4) & 3)) * 8;
    const int v = 4 * (lane & 31);
    const int wcol0 = GU ? (((v >> 5) & 1) * 256 + 32 * (v >> 6) + (v & 31) + 64 * cgrp) : (v + 512 * cgrp);
    const float* wlane = W + (size_t)(4 * w + (lane >> 5)) * LDB + wcol0;
    const unsigned lds0 = (unsigned)(uintptr_t)F.lds;
    const int xs = (ln >> 2) & 3;
    const unsigned aofs0 = (unsigned)((2 * rg + (ln >> 4)) * 1024 + (ln & 15) * 64 + ((hi ^ xs) * 16)), aofs1 = (unsigned)((2 * rg + (ln >> 4)) * 1024 + (ln & 15) * 64 + (((2 + hi) ^ xs) * 16));
    const unsigned tofs = (unsigned)((8 * hi + ((lane & 15) >> 2)) * 320 + (64 * cp + 16 * ((lane >> 4) & 1) + 4 * (lane & 3)) * 2);
    f32x16 acc[2 * NLAY];
#pragma unroll
    for (int i = 0; i < 2 * NLAY; ++i) acc[i] = (f32x16){};
#define EX_DMA_A(s) do { const int kt_ = (s) % KT, stg_ = (s) % EX_NSTG; \
        _Pragma("unroll") for (int j = 0; j < 3; ++j) if (j < nA) __builtin_amdgcn_global_load_lds((const unsigned*)(Abase + arow[j] + kt_ * 32 + achunk), (LAS unsigned*)(F.lds + EX_A0 + stg_ * EX_ASTG + (w + 8 * j) * 1024), 16, 0, 0); } while (0)
#define EX_DMA_W(s) do { const int pass_ = (s) / KT, kt_ = (s) % KT, stg_ = (s) % EX_NSTG; \
        _Pragma("unroll") for (int j = 0; j < 2; ++j) __builtin_amdgcn_global_load_lds((const unsigned*)(wlane + (size_t)(kt_ * 32 + 2 * j) * LDB + 128 * pass_), (LAS unsigned*)(F.lds + EX_W0 + stg_ * EX_WSTG + (2 * w + j) * 1024), 16, 0, 2); } while (0)
#define EX_WAITV(k) asm volatile("s_waitcnt vmcnt(" #k ")" ::: "memory")
#define EX_WAITN() do { if (nA == 3) EX_WAITV(5); else if (nA == 2) EX_WAITV(4); else if (nA == 1) EX_WAITV(3); else EX_WAITV(2); } while (0)
    const unsigned cvsrc = lds0 + EX_W0 + (tid >> 4) * 512 + (tid & 15) * 32, cvdst = lds0 + EX_WH0 + (tid >> 4) * 320 + (tid & 15) * 16;
    EX_DMA_A(0); EX_DMA_A(1);
    if (nA == 3) EX_WAITV(3); else if (nA == 2) EX_WAITV(2); else if (nA == 1) EX_WAITV(1); else EX_WAITV(0);
    __builtin_amdgcn_s_barrier(); asm volatile("" ::: "memory");
    { f32x4 c0, c1; asm volatile("ds_read_b128 %0, %2\n\tds_read_b128 %1, %2 offset:16\n\ts_waitcnt lgkmcnt(0)" : "=&v"(c0), "=&v"(c1) : "v"(cvsrc) : "memory");
      const h16x8 hv = pack8(c0[0], c0[1], c0[2], c0[3], c1[0], c1[1], c1[2], c1[3]); asm volatile("ds_write_b128 %0, %1" :: "v"(cvdst), "v"(hv) : "memory"); }
    typedef short s16x8 __attribute__((ext_vector_type(8)));
    for (int s = 0; s < NS; ++s) {
        if (s + 2 < NS) EX_WAITN(); else EX_WAITV(0);
        asm volatile("s_waitcnt lgkmcnt(0)" ::: "memory");
        __builtin_amdgcn_s_barrier();
        asm volatile("" ::: "memory");
        const bool pend = ((s % KT) == KT - 1);
        if (!pend) { if (s + 2 < NS) EX_DMA_A(s + 2); if (s + 3 < NS) EX_DMA_W(s + 3); }
        const unsigned abase = lds0 + EX_A0 + (s % EX_NSTG) * EX_ASTG, wbase = lds0 + EX_WH0 + (s & 1) * EX_WHS + tofs;
        const unsigned cs = cvsrc + ((s + 1) % EX_NSTG) * EX_WSTG;
        const unsigned pa0 = abase + aofs0, pa1 = abase + aofs1;
        if constexpr (NLAY < 3) {
            v4i16_t t0, t1, t2, t3, t4, t5, t6, t7; h16x8 a0[NLAY], a1[NLAY];
            asm volatile("ds_read_b64_tr_b16 %0, %8\n\tds_read_b64_tr_b16 %1, %8 offset:1280\n\tds_read_b64_tr_b16 %2, %8 offset:64\n\tds_read_b64_tr_b16 %3, %8 offset:1344\n\t"
                         "ds_read_b64_tr_b16 %4, %8 offset:5120\n\tds_read_b64_tr_b16 %5, %8 offset:6400\n\tds_read_b64_tr_b16 %6, %8 offset:5184\n\tds_read_b64_tr_b16 %7, %8 offset:6464"
                         : "=&v"(t0), "=&v"(t1), "=&v"(t2), "=&v"(t3), "=&v"(t4), "=&v"(t5), "=&v"(t6), "=&v"(t7) : "v"(wbase) : "memory");
            asm volatile("ds_read_b128 %0, %2\n\tds_read_b128 %1, %3" : "=&v"(a0[0]), "=&v"(a1[0]) : "v"(pa0), "v"(pa1) : "memory");
            if constexpr (NLAY >= 2) asm volatile("ds_read_b128 %0, %2 offset:8192\n\tds_read_b128 %1, %3 offset:8192" : "=&v"(a0[1]), "=&v"(a1[1]) : "v"(pa0), "v"(pa1) : "memory");
            asm volatile("s_waitcnt lgkmcnt(0)" ::: "memory");
            __builtin_amdgcn_sched_barrier(0);
            const h16x8 b00 = __builtin_bit_cast(h16x8, (s16x8){t0[0], t0[1], t0[2], t0[3], t1[0], t1[1], t1[2], t1[3]}), b01 = __builtin_bit_cast(h16x8, (s16x8){t2[0], t2[1], t2[2], t2[3], t3[0], t3[1], t3[2], t3[3]});
            const h16x8 b10 = __builtin_bit_cast(h16x8, (s16x8){t4[0], t4[1], t4[2], t4[3], t5[0], t5[1], t5[2], t5[3]}), b11 = __builtin_bit_cast(h16x8, (s16x8){t6[0], t6[1], t6[2], t6[3], t7[0], t7[1], t7[2], t7[3]});
#pragma unroll
            for (int i = 0; i < NLAY; ++i) { acc[2 * i] = MFMA32(a0[i], b00, acc[2 * i]); acc[2 * i + 1] = MFMA32(a0[i], b01, acc[2 * i + 1]); }
#pragma unroll
            for (int i = 0; i < NLAY; ++i) { acc[2 * i] = MFMA32(a1[i], b10, acc[2 * i]); acc[2 * i + 1] = MFMA32(a1[i], b11, acc[2 * i + 1]); }
        } else {
#pragma unroll
            for (int k16 = 0; k16 < 2; ++k16) {
                v4i16_t t0, t1, t2, t3; h16x8 a[3]; const unsigned pa = k16 ? pa1 : pa0, pw = wbase + k16 * 5120;
                asm volatile("ds_read_b64_tr_b16 %0, %4\n\tds_read_b64_tr_b16 %1, %4 offset:1280\n\tds_read_b64_tr_b16 %2, %4 offset:64\n\tds_read_b64_tr_b16 %3, %4 offset:1344"
                             : "=&v"(t0), "=&v"(t1), "=&v"(t2), "=&v"(t3) : "v"(pw) : "memory");
                asm volatile("ds_read_b128 %0, %3\n\tds_read_b128 %1, %3 offset:8192\n\tds_read_b128 %2, %3 offset:16384\n\ts_waitcnt lgkmcnt(0)" : "=&v"(a[0]), "=&v"(a[1]), "=&v"(a[2]) : "v"(pa) : "memory");
                __builtin_amdgcn_sched_barrier(0);
                const h16x8 b0 = __builtin_bit_cast(h16x8, (s16x8){t0[0], t0[1], t0[2], t0[3], t1[0], t1[1], t1[2], t1[3]}), b1 = __builtin_bit_cast(h16x8, (s16x8){t2[0], t2[1], t2[2], t2[3], t3[0], t3[1], t3[2], t3[3]});
#pragma unroll
                for (int i = 0; i < 3; ++i) { acc[2 * i] = MFMA32(a[i], b0, acc[2 * i]); acc[2 * i + 1] = MFMA32(a[i], b1, acc[2 * i + 1]); }
                __builtin_amdgcn_sched_barrier(0);
            }
        }
        if (s + 1 < NS) {
            f32x4 c0, c1; asm volatile("ds_read_b128 %0, %2\n\tds_read_b128 %1, %2 offset:16\n\ts_waitcnt lgkmcnt(0)" : "=&v"(c0), "=&v"(c1) : "v"(cs) : "memory");
            const h16x8 hv = pack8(c0[0], c0[1], c0[2], c0[3], c1[0], c1[1], c1[2], c1[3]); const unsigned cd = cvdst + ((s + 1) & 1) * EX_WHS; asm volatile("ds_write_b128 %0, %1" :: "v"(cd), "v"(hv) : "memory"); }
        if (pend) {
            const int pass = s / KT;
            int hio = hi, lno = ln; asm volatile("" : "+v"(hio), "+v"(lno));
            if (GU) {
#pragma unroll
                for (int i = 0; i < NLAY; ++i) { const int rt = rg + 4 * i;
#pragma unroll
                    for (int r = 0; r < 16; ++r) { const int row = 32 * rt + crow(r, hio);
                        if (row < nr) ACTrow0[(size_t)row * DEXP + 64 * cgrp + 32 * cp + lno] = (h16)(silu_f(acc[2 * i][r]) * acc[2 * i + 1][r]); }
                    acc[2 * i] = (f32x16){}; acc[2 * i + 1] = (f32x16){}; }
            } else {
                const unsigned scr = lds0 + EX_SCR0 + w * 1024;
                unsigned char* Y8 = (unsigned char*)Y;
#pragma unroll
                for (int i = 0; i < NLAY; ++i) { const int rt = rg + 4 * i;
#pragma unroll
                    for (int g8 = 0; g8 < 4; ++g8) {
#pragma unroll
                        for (int q = 0; q < 4; ++q) { const int lr = 4 * hio + q; const float wt = RW[32 * rt + 8 * g8 + lr];
                            const int pk = __builtin_amdgcn_cvt_pk_fp8_f32(acc[2 * i][4 * g8 + q] * wt, acc[2 * i + 1][4 * g8 + q] * wt, 0, false); const int pk1 = pk >> 8; const unsigned wa = scr + lr * 64 + lno;
                            asm volatile("ds_write_b8 %0, %1\n\tds_write_b8 %0, %2 offset:32" :: "v"(wa), "v"(pk), "v"(pk1) : "memory"); }
                        u32x2 pv; const unsigned ra = scr + (lane >> 3) * 64 + (lane & 7) * 8;
                        asm volatile("s_waitcnt lgkmcnt(0)\n\tds_read_b64 %0, %1\n\ts_waitcnt lgkmcnt(0)" : "=&v"(pv) : "v"(ra) : "memory");
                        const int grow = 32 * rt + 8 * g8 + (lane >> 3);
                        if (grow < nr) { const int slot = RSLOT[grow]; *(u32x2*)(Y8 + (size_t)slot * DM + 512 * cgrp + 128 * pass + 64 * cp + (lane & 7) * 8) = pv; }
                    }
                    acc[2 * i] = (f32x16){}; acc[2 * i + 1] = (f32x16){}; }
            }
            if (s + 2 < NS) EX_DMA_A(s + 2);
            if (s + 3 < NS) EX_DMA_W(s + 3);
        }
    }
    asm volatile("s_waitcnt vmcnt(0) lgkmcnt(0)" ::: "memory");
    __builtin_amdgcn_s_barrier();
    asm volatile("" ::: "memory");
#undef EX_DMA_A
#undef EX_DMA_W
#undef EX_WAITV
#undef EX_WAITN
}

constexpr int G8_NSTG = 4, G8_ASTG = 12288, G8_WSTG = 16384, G8_A0 = 0, G8_W0 = G8_NSTG * G8_ASTG, G8_WH0 = G8_W0 + G8_NSTG * G8_WSTG, G8_WHS = 4096;
constexpr int G8_SCR0 = G8_WH0 + 2 * G8_WHS;
static_assert(G8_SCR0 + 8 * 2048 <= EX_ROW0, "gu8 LDS map");
template <bool GU>
__device__ __forceinline__ void ring8_w_prologue(Frame& F, const float* W, int cgrp) {
    constexpr int LDB = GU ? 512 : 2048;
    const int lane = F.lane, w = F.wave, v = 4 * (lane & 31);
    if (w >= 4) return;
    const int wcol0 = GU ? (((v >> 5) & 1) * 256 + 32 * (v >> 6) + (v & 31) + 64 * cgrp) : (v + 512 * cgrp);
    const char* Wu = uni_ptr((const char*)W);
    const unsigned wvo = (unsigned)(((8 * w + (lane >> 5)) * LDB + wcol0) * 4);
#pragma unroll
    for (int s = 0; s < 4; ++s)
#pragma unroll
        for (int j = 0; j < 4; ++j) __builtin_amdgcn_global_load_lds((const unsigned*)(Wu + (size_t)(s * 32 + 2 * j) * LDB * 4 + (size_t)wvo), (LAS unsigned*)(F.lds + G8_W0 + s * G8_WSTG + (4 * w + j) * 1024), 16, 0, 2);
}
template <bool GU, int NLAY>
__device__ __forceinline__ void expert_ring8(Frame& F, const float* W, const unsigned char* A8, const int ap0, const int ap1, int nr, int cgrp, unsigned char* ACT8row0, unsigned char* Y8) {
    constexpr int KT = GU ? 64 : 8, NP = GU ? 1 : 4, LDB = GU ? 512 : 2048, NS = KT * NP;
    typedef long v2i64 __attribute__((ext_vector_type(2)));
    const int tid = F.tid, lane = F.lane, hi = lane >> 5, ln = lane & 31, cp = F.wave & 1, rg = F.wave >> 1, w = F.wave;
    const LAS int* RSLOT = (const LAS int*)(F.lds + EX_ROW0); const LAS float* RW = (const LAS float*)(F.lds + EX_ROW0 + 1536);
    const int ngrp = (nr + 31) >> 5;
    const bool ldr = w < 4;
    const int nA = ldr ? NLAY : 0;
    const unsigned avo0 = (unsigned)((ap0 & 0xffff) * (GU ? DM : DEXP) + (lane & 1) * 16), avo1 = (unsigned)((int)((unsigned)ap0 >> 16) * (GU ? DM : DEXP) + (lane & 1) * 16), avo2 = (unsigned)(ap1 * (GU ? DM : DEXP) + (lane & 1) * 16);
    const int v = 4 * (lane & 31);
    const int wcol0 = GU ? (((v >> 5) & 1) * 256 + 32 * (v >> 6) + (v & 31) + 64 * cgrp) : (v + 512 * cgrp);
    const char* Wu = uni_ptr((const char*)W); const char* Au = uni_ptr((const char*)A8);
    const unsigned wvo = (unsigned)(((8 * w + (lane >> 5)) * LDB + wcol0) * 4);
    const unsigned lds0 = (unsigned)(uintptr_t)F.lds;
    const unsigned aofs = (unsigned)(rg * 1024 + ln * 32 + hi * 16);
    const unsigned bofs = (unsigned)((64 * cp + ln) * 32 + hi * 16);
    const unsigned cvsrc = lds0 + G8_W0 + (tid >> 7) * 8 * 512 + (tid & 127) * 4, cvdst = lds0 + G8_WH0 + (tid & 127) * 32 + (tid >> 7) * 8;
    f32x16 acc[2 * NLAY];
#pragma unroll
    for (int i = 0; i < 2 * NLAY; ++i) acc[i] = (f32x16){};
#define G8_DMA_A(s) do { const int stg_ = (s) & 3, kt_ = (s) % KT; \
        if (ldr) { _Pragma("unroll") for (int j = 0; j < NLAY; ++j) { const unsigned vo_ = j == 0 ? avo0 : j == 1 ? avo1 : avo2; \
            __builtin_amdgcn_global_load_lds((const unsigned*)(Au + kt_ * 32 + (size_t)vo_), (LAS unsigned*)(F.lds + G8_A0 + stg_ * G8_ASTG + (w + 4 * j) * 1024), 16, 0, 0); } } } while (0)
#define G8_DMA_W(s) do { const int stg_ = (s) & 3, kt_ = (s) % KT, pass_ = (s) / KT; \
        if (ldr) { _Pragma("unroll") for (int j = 0; j < 4; ++j) __builtin_amdgcn_global_load_lds((const unsigned*)(Wu + ((size_t)(kt_ * 32 + 2 * j) * LDB + 128 * pass_) * 4 + (size_t)wvo), (LAS unsigned*)(F.lds + G8_W0 + stg_ * G8_WSTG + (4 * w + j) * 1024), 16, 0, 2); } } while (0)
#define G8_WAITV(k) asm volatile("s_waitcnt vmcnt(" #k ")" ::: "memory")
#define G8_CVT(s) do { float c_[8]; const unsigned cs_ = cvsrc + ((s) & 3) * G8_WSTG; \
        asm volatile("ds_read_b32 %0, %8\n\tds_read_b32 %1, %8 offset:512\n\tds_read_b32 %2, %8 offset:1024\n\tds_read_b32 %3, %8 offset:1536\n\tds_read_b32 %4, %8 offset:2048\n\tds_read_b32 %5, %8 offset:2560\n\tds_read_b32 %6, %8 offset:3072\n\tds_read_b32 %7, %8 offset:3584\n\ts_waitcnt lgkmcnt(0)" \
                     : "=&v"(c_[0]), "=&v"(c_[1]), "=&v"(c_[2]), "=&v"(c_[3]), "=&v"(c_[4]), "=&v"(c_[5]), "=&v"(c_[6]), "=&v"(c_[7]) : "v"(cs_) : "memory"); \
        int p0_ = __builtin_amdgcn_cvt_pk_fp8_f32(c_[0] * 64.f, c_[1] * 64.f, 0, false); p0_ = __builtin_amdgcn_cvt_pk_fp8_f32(c_[2] * 64.f, c_[3] * 64.f, p0_, true); \
        int p1_ = __builtin_amdgcn_cvt_pk_fp8_f32(c_[4] * 64.f, c_[5] * 64.f, 0, false); p1_ = __builtin_amdgcn_cvt_pk_fp8_f32(c_[6] * 64.f, c_[7] * 64.f, p1_, true); \
        const u32x2 pk_ = {(unsigned)p0_, (unsigned)p1_}; const unsigned cd_ = cvdst + ((s) & 1) * G8_WHS; asm volatile("ds_write_b64 %0, %1" :: "v"(cd_), "v"(pk_) : "memory"); } while (0)
    struct Frag { v2i64 a[NLAY], b0, b1; };
    Frag f0, f1; float c_[8];
    const bool top = 128 * (NLAY - 1) + 32 * rg < nr;
#define G8_RD_FRAG(fr, s) do { const unsigned pa_ = lds0 + G8_A0 + ((s) & 3) * G8_ASTG + aofs, pb_ = lds0 + G8_WH0 + ((s) & 1) * G8_WHS + bofs; \
        asm volatile("ds_read_b128 %0, %2\n\tds_read_b128 %1, %2 offset:1024" : "=&v"(fr.b0), "=&v"(fr.b1) : "v"(pb_) : "memory"); \
        asm volatile("ds_read_b128 %0, %1" : "=&v"(fr.a[0]) : "v"(pa_) : "memory"); \
        if constexpr (NLAY >= 2) asm volatile("ds_read_b128 %0, %1 offset:4096" : "=&v"(fr.a[1]) : "v"(pa_) : "memory"); \
        if constexpr (NLAY >= 3) asm volatile("ds_read_b128 %0, %1 offset:8192" : "=&v"(fr.a[2]) : "v"(pa_) : "memory"); } while (0)
#define G8_RD_CV(s) do { const unsigned cs_ = cvsrc + ((s) & 3) * G8_WSTG; \
        asm volatile("ds_read_b32 %0, %8\n\tds_read_b32 %1, %8 offset:512\n\tds_read_b32 %2, %8 offset:1024\n\tds_read_b32 %3, %8 offset:1536\n\tds_read_b32 %4, %8 offset:2048\n\tds_read_b32 %5, %8 offset:2560\n\tds_read_b32 %6, %8 offset:3072\n\tds_read_b32 %7, %8 offset:3584" \
                     : "=&v"(c_[0]), "=&v"(c_[1]), "=&v"(c_[2]), "=&v"(c_[3]), "=&v"(c_[4]), "=&v"(c_[5]), "=&v"(c_[6]), "=&v"(c_[7]) : "v"(cs_) : "memory"); } while (0)
#define G8_LWAIT(fr) do { asm volatile("s_waitcnt lgkmcnt(0)" : "+v"(fr.b0), "+v"(fr.b1), "+v"(fr.a[0]), "+v"(c_[0]), "+v"(c_[1]), "+v"(c_[2]), "+v"(c_[3]), "+v"(c_[4]), "+v"(c_[5]), "+v"(c_[6]), "+v"(c_[7]) :: "memory"); \
        if constexpr (NLAY >= 2) asm volatile("" : "+v"(fr.a[1])); if constexpr (NLAY >= 3) asm volatile("" : "+v"(fr.a[2])); } while (0)
#define G8_CV_WR(s) do { typedef float f2_ __attribute__((ext_vector_type(2))); \
        const f2_ m0_ = (f2_){c_[0], c_[1]} * 64.f, m1_ = (f2_){c_[2], c_[3]} * 64.f, m2_ = (f2_){c_[4], c_[5]} * 64.f, m3_ = (f2_){c_[6], c_[7]} * 64.f; \
        int p0_ = __builtin_amdgcn_cvt_pk_fp8_f32(m0_[0], m0_[1], 0, false); p0_ = __builtin_amdgcn_cvt_pk_fp8_f32(m1_[0], m1_[1], p0_, true); \
        int p1_ = __builtin_amdgcn_cvt_pk_fp8_f32(m2_[0], m2_[1], 0, false); p1_ = __builtin_amdgcn_cvt_pk_fp8_f32(m3_[0], m3_[1], p1_, true); \
        const u32x2 pk_ = {(unsigned)p0_, (unsigned)p1_}; const unsigned cd_ = cvdst + ((s) & 1) * G8_WHS; asm volatile("ds_write_b64 %0, %1" :: "v"(cd_), "v"(pk_) : "memory"); } while (0)
#define G8_SB() __builtin_amdgcn_sched_barrier(0)
#define G8_MF(fr, i, h, c) acc[2 * (i) + (c)] = __builtin_amdgcn_mfma_f32_32x32x16_fp8_fp8(fr.a[i][h], (c) ? fr.b1[h] : fr.b0[h], acc[2 * (i) + (c)], 0, 0, 0)
#define G8_RC01() asm volatile("ds_read_b32 %0, %2\n\tds_read_b32 %1, %2 offset:512" : "=&v"(c_[0]), "=&v"(c_[1]) : "v"(cs_) : "memory")
#define G8_RC23() asm volatile("ds_read_b32 %0, %2 offset:1024\n\tds_read_b32 %1, %2 offset:1536" : "=&v"(c_[2]), "=&v"(c_[3]) : "v"(cs_) : "memory")
#define G8_RC45() asm volatile("ds_read_b32 %0, %2 offset:2048\n\tds_read_b32 %1, %2 offset:2560" : "=&v"(c_[4]), "=&v"(c_[5]) : "v"(cs_) : "memory")
#define G8_RC67() asm volatile("ds_read_b32 %0, %2 offset:3072\n\tds_read_b32 %1, %2 offset:3584" : "=&v"(c_[6]), "=&v"(c_[7]) : "v"(cs_) : "memory")
#define G8_RB(fr) asm volatile("ds_read_b128 %0, %2\n\tds_read_b128 %1, %2 offset:1024" : "=&v"(fr.b0), "=&v"(fr.b1) : "v"(pb_) : "memory")
#define G8_RA(fr, i, ofs) asm volatile("ds_read_b128 %0, %1 offset:" ofs : "=&v"(fr.a[i]) : "v"(pa_) : "memory")
#define G8_CWAIT(n) asm volatile("s_waitcnt lgkmcnt(" n ")" : "+v"(c_[0]), "+v"(c_[1]), "+v"(c_[2]), "+v"(c_[3]), "+v"(c_[4]), "+v"(c_[5]), "+v"(c_[6]), "+v"(c_[7]) :: "memory")
#define G8_CMUL() do { m0_ = (f2_){c_[0], c_[1]} * 64.f; m1_ = (f2_){c_[2], c_[3]} * 64.f; m2_ = (f2_){c_[4], c_[5]} * 64.f; m3_ = (f2_){c_[6], c_[7]} * 64.f; } while (0)
#define G8_CCVT0() do { p0_ = __builtin_amdgcn_cvt_pk_fp8_f32(m0_[0], m0_[1], 0, false); p0_ = __builtin_amdgcn_cvt_pk_fp8_f32(m1_[0], m1_[1], p0_, true); } while (0)
#define G8_CCVT1() do { p1_ = __builtin_amdgcn_cvt_pk_fp8_f32(m2_[0], m2_[1], 0, false); p1_ = __builtin_amdgcn_cvt_pk_fp8_f32(m3_[0], m3_[1], p1_, true); } while (0)
#define G8_CWR() do { const u32x2 pk_ = {(unsigned)p0_, (unsigned)p1_}; asm volatile("ds_write_b64 %0, %1" :: "v"(cd_), "v"(pk_) : "memory"); } while (0)
#define G8_FWAIT(fr) do { asm volatile("s_waitcnt lgkmcnt(0)" : "+v"(fr.b0), "+v"(fr.b1), "+v"(fr.a[0]) :: "memory"); \
        if constexpr (NLAY >= 2) asm volatile("" : "+v"(fr.a[1])); if constexpr (NLAY >= 3) asm volatile("" : "+v"(fr.a[2])); } while (0)
#define G8_BAR() do { asm volatile("s_waitcnt lgkmcnt(0)" ::: "memory"); __builtin_amdgcn_s_barrier(); asm volatile("" ::: "memory"); } while (0)
    auto epilogue = [&](const int s) {
            const int pass = s / KT;
            int hio = hi, lno = ln; asm volatile("" : "+v"(hio), "+v"(lno));
            const unsigned scr = lds0 + G8_SCR0 + w * 2048;
#pragma unroll
            for (int i = 0; i < NLAY; ++i) { const int rt = rg + 4 * i;
                if (i == NLAY - 1 && !top) continue;
#pragma unroll
                for (int r = 0; r < 16; ++r) { const int lr = crow(r, hio);
                    float v0, v1;
                    if (GU) { v0 = silu_f(acc[2 * i][r] * 0.015625f) * (acc[2 * i + 1][r] * 0.015625f); v1 = 0.f; }
                    else { const float wt = RW[32 * rt + lr] * 0.015625f; v0 = acc[2 * i][r] * wt; v1 = acc[2 * i + 1][r] * wt; }
                    const int pk = __builtin_amdgcn_cvt_pk_fp8_f32(v0, v1, 0, false); const unsigned wa = scr + lr * 64 + lno;
                    if (GU) asm volatile("ds_write_b8 %0, %1" :: "v"(wa), "v"(pk) : "memory");
                    else { const int pk1 = pk >> 8; asm volatile("ds_write_b8 %0, %1\n\tds_write_b8 %0, %2 offset:32" :: "v"(wa), "v"(pk), "v"(pk1) : "memory"); } }
                if (GU) {
                    unsigned pv[4]; const unsigned ra = scr + (lane >> 3) * 64 + (lane & 7) * 4;
                    asm volatile("s_waitcnt lgkmcnt(0)\n\tds_read_b32 %0, %4\n\tds_read_b32 %1, %4 offset:512\n\tds_read_b32 %2, %4 offset:1024\n\tds_read_b32 %3, %4 offset:1536\n\ts_waitcnt lgkmcnt(0)" : "=&v"(pv[0]), "=&v"(pv[1]), "=&v"(pv[2]), "=&v"(pv[3]) : "v"(ra) : "memory");
#pragma unroll
                    for (int g8 = 0; g8 < 4; ++g8) { const int grow = 32 * rt + 8 * g8 + (lane >> 3);
                        if (grow < nr) *(unsigned*)(ACT8row0 + (size_t)grow * DEXP + 64 * cgrp + 32 * cp + (lane & 7) * 4) = pv[g8]; }
                } else {
                    u32x2 pv[4]; const unsigned ra = scr + (lane >> 3) * 64 + (lane & 7) * 8;
                    asm volatile("s_waitcnt lgkmcnt(0)\n\tds_read_b64 %0, %4\n\tds_read_b64 %1, %4 offset:512\n\tds_read_b64 %2, %4 offset:1024\n\tds_read_b64 %3, %4 offset:1536\n\ts_waitcnt lgkmcnt(0)" : "=&v"(pv[0]), "=&v"(pv[1]), "=&v"(pv[2]), "=&v"(pv[3]) : "v"(ra) : "memory");
#pragma unroll
                    for (int g8 = 0; g8 < 4; ++g8) { const int grow = 32 * rt + 8 * g8 + (lane >> 3);
                        if (grow < nr) { const int slot = RSLOT[grow]; *(u32x2*)(Y8 + (size_t)slot * DM + 512 * cgrp + 128 * pass + 64 * cp + (lane & 7) * 8) = pv[g8]; } }
                }
                acc[2 * i] = (f32x16){}; acc[2 * i + 1] = (f32x16){}; }
            if (s + 4 < NS) G8_DMA_A(s + 4);
            if (s + 5 < NS) G8_DMA_W(s + 5);
    };
    G8_DMA_A(0); G8_DMA_A(1); G8_DMA_A(2); G8_DMA_A(3);
    if constexpr (NLAY == 3) G8_WAITV(12); else if constexpr (NLAY == 2) G8_WAITV(8); else G8_WAITV(4);
    G8_BAR();
    G8_RD_CV(0);
    asm volatile("s_waitcnt lgkmcnt(0)" : "+v"(c_[0]), "+v"(c_[1]), "+v"(c_[2]), "+v"(c_[3]), "+v"(c_[4]), "+v"(c_[5]), "+v"(c_[6]), "+v"(c_[7]) :: "memory");
    G8_CV_WR(0);
    if constexpr (NLAY == 3) G8_WAITV(9); else if constexpr (NLAY == 2) G8_WAITV(6); else G8_WAITV(3);
    G8_BAR();
    G8_DMA_W(4);
    G8_RD_FRAG(f0, 0); G8_RD_CV(1);
    G8_LWAIT(f0);
    G8_CV_WR(1);
#define G8_STEP(s, cur, nxt, MAYPEND) do { \
        if ((s) > 0 && (s) + 4 < NS) { if constexpr (NLAY == 3) G8_WAITV(14); else if constexpr (NLAY == 2) G8_WAITV(12); else G8_WAITV(10); }     \
        else if ((s) == 0) { if constexpr (NLAY == 3) G8_WAITV(10); else if constexpr (NLAY == 2) G8_WAITV(8); else G8_WAITV(6); } \
        else G8_WAITV(0); \
        G8_BAR(); \
        const bool pend = MAYPEND && (((s) % KT) == KT - 1); \
        if (!pend) { if ((s) + 4 < NS) G8_DMA_A((s) + 4); if ((s) + 5 < NS) G8_DMA_W((s) + 5); } \
          \
          \
        const unsigned pa_ = lds0 + G8_A0 + (((s) + 1) & 3) * G8_ASTG + aofs, pb_ = lds0 + G8_WH0 + (((s) + 1) & 1) * G8_WHS + bofs, cs_ = cvsrc + (((s) + 2) & 3) * G8_WSTG, cd_ = cvdst + ((s) & 1) * G8_WHS; \
        typedef float f2_ __attribute__((ext_vector_type(2))); f2_ m0_, m1_, m2_, m3_; int p0_, p1_; \
        G8_SB(); \
          \
          \
        if constexpr (NLAY == 3) { \
            if (top) { G8_RA(nxt, 2, "8192"); G8_SB(); } \
            G8_MF(cur, 0, 0, 0); G8_SB(); G8_RC01(); G8_SB(); G8_MF(cur, 0, 0, 1); G8_SB(); G8_RC23(); G8_SB(); G8_MF(cur, 1, 0, 0); G8_SB(); G8_RC45(); G8_SB(); G8_MF(cur, 1, 0, 1); G8_SB(); G8_RC67(); G8_SB(); \
            G8_MF(cur, 0, 1, 0); G8_SB(); G8_RB(nxt); G8_SB(); G8_MF(cur, 0, 1, 1); G8_SB(); G8_RA(nxt, 0, "0"); G8_SB(); G8_MF(cur, 1, 1, 0); G8_SB(); G8_RA(nxt, 1, "4096"); G8_SB(); G8_MF(cur, 1, 1, 1); G8_SB(); \
            G8_CWAIT("4"); G8_SB(); G8_CMUL(); G8_SB(); \
            if (top) { G8_MF(cur, 2, 0, 0); G8_SB(); G8_CCVT0(); G8_SB(); G8_MF(cur, 2, 0, 1); G8_SB(); G8_CCVT1(); G8_SB(); G8_MF(cur, 2, 1, 0); G8_SB(); G8_CWR(); G8_SB(); G8_MF(cur, 2, 1, 1); G8_SB(); } \
            else { G8_CCVT0(); G8_CCVT1(); G8_CWR(); G8_SB(); } \
        } else if constexpr (NLAY == 2) { \
            if (top) { G8_RA(nxt, 1, "4096"); G8_SB(); } \
            G8_MF(cur, 0, 0, 0); G8_SB(); G8_RC01(); G8_RC23(); G8_SB(); G8_MF(cur, 0, 0, 1); G8_SB(); G8_RC45(); G8_RC67(); G8_SB(); G8_MF(cur, 0, 1, 0); G8_SB(); G8_RB(nxt); G8_SB(); G8_MF(cur, 0, 1, 1); G8_SB(); G8_RA(nxt, 0, "0"); G8_SB(); \
            G8_CWAIT("3"); G8_SB(); G8_CMUL(); G8_SB(); \
            if (top) { G8_MF(cur, 1, 0, 0); G8_SB(); G8_CCVT0(); G8_SB(); G8_MF(cur, 1, 0, 1); G8_SB(); G8_CCVT1(); G8_SB(); G8_MF(cur, 1, 1, 0); G8_SB(); G8_CWR(); G8_SB(); G8_MF(cur, 1, 1, 1); G8_SB(); } \
            else { G8_CCVT0(); G8_CCVT1(); G8_CWR(); G8_SB(); } \
        } else { \
            if (top) { G8_RA(nxt, 0, "0"); G8_SB(); G8_MF(cur, 0, 0, 0); G8_SB(); } \
            G8_RC01(); G8_RC23(); G8_RC45(); G8_RC67(); G8_SB(); \
            if (top) { G8_MF(cur, 0, 0, 1); G8_SB(); } \
            G8_RB(nxt); G8_SB(); G8_CWAIT("2"); G8_SB(); G8_CMUL(); G8_SB(); \
            if (top) { G8_MF(cur, 0, 1, 0); G8_SB(); } \
            G8_CCVT0(); G8_CCVT1(); G8_SB(); \
            if (top) { G8_MF(cur, 0, 1, 1); G8_SB(); } \
            G8_CWR(); G8_SB(); \
        } \
        G8_FWAIT(nxt); \
        if (pend) epilogue((s)); } while (0)
    for (int s = 0; s < NS; s += 2) { G8_STEP(s, f0, f1, false); G8_STEP(s + 1, f1, f0, true); }
#undef G8_STEP
#undef G8_RC01
#undef G8_RC23
#undef G8_RC45
#undef G8_RC67
#undef G8_RB
#undef G8_RA
#undef G8_CWAIT
#undef G8_CMUL
#undef G8_CCVT0
#undef G8_CCVT1
#undef G8_CWR
#undef G8_FWAIT
#undef G8_SB
#undef G8_MF
#undef G8_RD_FRAG
#undef G8_RD_CV
#undef G8_LWAIT
#undef G8_CV_WR
#undef G8_BAR
    asm volatile("s_waitcnt vmcnt(0) lgkmcnt(0)" ::: "memory");
    __builtin_amdgcn_s_barrier();
    asm volatile("" ::: "memory");
#undef G8_DMA_A
#undef G8_DMA_W
#undef G8_WAITV
#undef G8_CVT
}
template <bool GU>
__device__ __forceinline__ void p13_expert_phase(Frame& F, int qid) {
    const h16* H2X = (const h16*)(F.ws + WS_H2X); h16* Y = (h16*)(F.ws + WS_Y); h16* ACT = (h16*)(F.ws + WS_ACT);
    const unsigned* CNT = (const unsigned*)(F.ws + WS_CTL) + CW_CNT; unsigned* QH = (unsigned*)(F.ws + WS_CTL) + CW_Q + 64 * qid;
    LAS int* RSLOT = (LAS int*)(F.lds + EX_ROW0); LAS float* RW = (LAS float*)(F.lds + EX_ROW0 + 1536); LAS int* RED = (LAS int*)(F.lds + EX_ROW0 + 3072);
    LAS int* CN = (LAS int*)(F.lds + EX_TAB0); LAS int* ORD = CN + 256; LAS int* OFF = CN + 512;
    __syncthreads();
    if (F.tid < NEXP) CN[F.tid] = (int)CNT[F.tid];
    __syncthreads();
    if (F.tid < NEXP) { const int c = CN[F.tid]; int rank = 0, off = 0;
        for (int j = 0; j < NEXP; ++j) { const int cj = CN[j]; rank += (cj > c || (cj == c && j < F.tid)) ? 1 : 0; off += (j < F.tid) ? cj : 0; }
        ORD[rank] = F.tid; OFF[F.tid] = off; }
    __syncthreads();
    const u32x2* LIST2 = (const u32x2*)(F.ws + WS_LIST2);
    if (F.tid == 0) RED[0] = (int)__hip_atomic_fetch_add(QH, 1u, __ATOMIC_RELAXED, __HIP_MEMORY_SCOPE_AGENT);
    __syncthreads();
    int u = RED[0];
    while (u < NEXP * 4) {
        const int e = ORD[u >> 2], cg = u & 3, cnt = CN[e], off_e = OFF[e];
        const float* Wgu = F.w_exp_gu + (size_t)e * DM * 512; const float* Wdn = F.w_exp_down + (size_t)e * DEXP * DM;
        for (int rs = 0; rs < cnt; rs += 384) {
            const int nr = (cnt - rs) < 384 ? (cnt - rs) : 384;
            __syncthreads();
            ring8_w_prologue<GU>(F, GU ? Wgu : Wdn, cg);
            if (F.tid < 384) { u32x2 ent = {0u, 0u}; if (F.tid < nr) ent = LIST2[e * MLAT + rs + F.tid]; RSLOT[F.tid] = (int)ent.x; RW[F.tid] = __uint_as_float(ent.y); }
            __syncthreads();
            unsigned char* ACT8row0 = (unsigned char*)(F.ws + WS_ACT8) + (size_t)(off_e + rs) * DEXP;
            int ar8[3];
            if (GU) {
#pragma unroll
                for (int j = 0; j < 3; ++j) { const int r = 32 * ((F.wave & 3) + 4 * j) + (F.lane >> 1); ar8[j] = (r < 384 ? (RSLOT[r] >> 3) : 0); }
                const unsigned char* A8 = (const unsigned char*)(F.ws + WS_H2F8);
                if (nr > 256) expert_ring8<true, 3>(F, Wgu, A8, ar8[0] | (ar8[1] << 16), ar8[2], nr, cg, ACT8row0, (unsigned char*)Y); else if (nr > 128) expert_ring8<true, 2>(F, Wgu, A8, ar8[0] | (ar8[1] << 16), ar8[2], nr, cg, ACT8row0, (unsigned char*)Y); else expert_ring8<true, 1>(F, Wgu, A8, ar8[0] | (ar8[1] << 16), ar8[2], nr, cg, ACT8row0, (unsigned char*)Y);
            } else {
#pragma unroll
                for (int j = 0; j < 3; ++j) { const int r = 32 * ((F.wave & 3) + 4 * j) + (F.lane >> 1); ar8[j] = ((r < nr) ? r : 0); }
                if (nr > 256) expert_ring8<false, 3>(F, Wdn, ACT8row0, ar8[0] | (ar8[1] << 16), ar8[2], nr, cg, ACT8row0, (unsigned char*)Y); else if (nr > 128) expert_ring8<false, 2>(F, Wdn, ACT8row0, ar8[0] | (ar8[1] << 16), ar8[2], nr, cg, ACT8row0, (unsigned char*)Y); else expert_ring8<false, 1>(F, Wdn, ACT8row0, ar8[0] | (ar8[1] << 16), ar8[2], nr, cg, ACT8row0, (unsigned char*)Y);
            }
        }
        __syncthreads();
        if (F.tid == 0) RED[0] = (int)__hip_atomic_fetch_add(QH, 1u, __ATOMIC_RELAXED, __HIP_MEMORY_SCOPE_AGENT);
        __syncthreads();
        u = RED[0];
    }
}
struct SchedSG {
    int G, c;
    __device__ __forceinline__ bool next(int i, pg8::Unit& u) const { const int L = i * G + c; if (L >= 256) return false; u.pm = L >> 3; u.pn = (L >> 2) & 1; u.ko = (L & 3) * 512; u.nt = 0; u.keep = 0; return true; }
};
struct EpiSGP {
    float* SGP;
    __device__ __forceinline__ void operator()(f32x4 (&acc)[2][2][4][2], const pg8::Unit& u, int wr, int wc, int fr, int fq) const {
        float* dst = SGP + (size_t)(u.ko / 512) * MLAT * 512;
#pragma unroll
        for (int ai = 0; ai < 2; ++ai)
#pragma unroll
            for (int m = 0; m < 4; ++m) { const int row = u.pm * 256 + ai * 128 + wr * 64 + m * 16 + fr;
#pragma unroll
                for (int bj = 0; bj < 2; ++bj)
#pragma unroll
                    for (int n = 0; n < 2; ++n) { const int col = u.pn * 256 + bj * 128 + wc * 32 + 16 * n + 4 * fq; *(f32x4*)(dst + (size_t)row * 512 + col) = acc[ai][bj][m][n]; } }
    }
};
__device__ __forceinline__ void p11b_shared_gu(Frame& F) {
    pg8::Gemm g{(const h16*)(F.ws + WS_H2X), (const h16*)(F.ws + WS_WSGU), 6144, 2048, 512};
    SchedSG S; S.G = F.G; S.c = (int)blockIdx.x;
    EpiSGP E{(float*)(F.ws + WS_SGP)};
    pg8::gemm_phase<EpiSGP, SchedSG>(F.lds, g, S, E);
}
__device__ __forceinline__ void p12b_shared_act(Frame& F) {
    const float* SGP = (const float*)(F.ws + WS_SGP); h16* ACTS = (h16*)(F.ws + WS_ACTS);
    for (int q = blockIdx.x * NTHR + F.tid; q < MLAT * 64; q += F.G * NTHR) {
        const int row = q >> 6, j = (q & 63) * 4, pg = 32 * (j >> 4) + (j & 15);
        f32x4 gv = {0.f, 0.f, 0.f, 0.f}, uv = gv;
#pragma unroll
        for (int ks = 0; ks < 4; ++ks) { const float* p = SGP + ((size_t)ks * MLAT + row) * 512 + pg; gv += *(const f32x4*)p; uv += *(const f32x4*)(p + 16); }
        u32x2 w; w.x = pk2h(silu_f(gv[0]) * uv[0], silu_f(gv[1]) * uv[1]); w.y = pk2h(silu_f(gv[2]) * uv[2], silu_f(gv[3]) * uv[3]);
        *(u32x2*)(ACTS + (size_t)row * DEXP + j) = w;
    }
}
struct EpiYsh {
    h16* YSH;
    __device__ __forceinline__ void operator()(f32x4 (&acc)[2][2][4][2], const pg8::Unit& u, int wr, int wc, int fr, int fq) const {
#pragma unroll
        for (int ai = 0; ai < 2; ++ai)
#pragma unroll
            for (int m = 0; m < 4; ++m) { const int row = u.pm * 256 + ai * 128 + wr * 64 + m * 16 + fr;
#pragma unroll
                for (int bj = 0; bj < 2; ++bj)
#pragma unroll
                    for (int n = 0; n < 2; ++n) { const int col = u.pn * 256 + bj * 128 + wc * 32 + 16 * n + 4 * fq; const f32x4 a = acc[ai][bj][m][n];
                        u32x2 w; w.x = pk2h(a[0], a[1]); w.y = pk2h(a[2], a[3]); *(u32x2*)(YSH + (size_t)row * DM + col) = w; } }
    }
};
struct SchedOne {
    int pm, pn;
    __device__ __forceinline__ bool next(int i, pg8::Unit& u) const { if (i != 0) return false; u.pm = pm; u.pn = pn; u.ko = 0; u.nt = 0; u.keep = 0; return true; }
};
__device__ __forceinline__ void p15_shared_down_dyn(Frame& F, int qid) {
    unsigned* QH = (unsigned*)(F.ws + WS_CTL) + CW_Q + 64 * 8 * qid;
    LAS int* RED = (LAS int*)(F.lds + EX_ROW0 + 3072);
    for (;;) {
        __syncthreads();
        if (F.tid == 0) RED[0] = (int)__hip_atomic_fetch_add(QH, 1u, __ATOMIC_RELAXED, __HIP_MEMORY_SCOPE_AGENT);
        __syncthreads();
        const int t = RED[0];
        if (t >= 256) break;
        pg8::Gemm g{(const h16*)(F.ws + WS_ACTS), (const h16*)(F.ws + WS_WSDN), 256, 256, 256};
        SchedOne S; S.pm = t >> 3; S.pn = t & 7;
        EpiYsh E{(h16*)(F.ws + WS_YSH)};
        pg8::gemm_phase<EpiYsh, SchedOne>(F.lds, g, S, E);
    }
}
__device__ __forceinline__ void p15_shared_down(Frame& F) {
    pg8::Gemm g{(const h16*)(F.ws + WS_ACTS), (const h16*)(F.ws + WS_WSDN), 256, 256, 256};
    pg8::StaticOrder S; S.init(MLAT, DM, F.G, (int)blockIdx.x);
    EpiYsh E{(h16*)(F.ws + WS_YSH)};
    pg8::gemm_phase<EpiYsh, pg8::StaticOrder>(F.lds, g, S, E);
}
__device__ __forceinline__ void p16_combine(Frame& F) {
    const float* X1 = (const float*)(F.ws + WS_X1); const float* MOD = (const float*)(F.ws + WS_MOD); const h16* Y = (const h16*)(F.ws + WS_Y); const h16* YSH = (const h16*)(F.ws + WS_YSH);
    const int gw = F.vcu * NWAVES + F.wave, NGW = F.G * NWAVES;
    for (int r = gw; r < MLAT; r += NGW) {
        const int b = r / SEQ;
        f32x4 xv[8]; float ss = 0.f;
#pragma unroll
        for (int j = 0; j < 8; ++j) { const int cc = 4 * F.lane + 256 * j;
            f32x4 m = {0.f, 0.f, 0.f, 0.f};
#pragma unroll
            for (int k = 0; k < TOPK; ++k) { const int yv = *(const int*)((const unsigned char*)Y + (size_t)(r * TOPK + k) * DM + cc);
                const f32x2 lo = __builtin_amdgcn_cvt_pk_f32_fp8(yv, false), hi2 = __builtin_amdgcn_cvt_pk_f32_fp8(yv, true); m += (f32x4){lo[0], lo[1], hi2[0], hi2[1]}; }
            { const h16x4 yv = *(const h16x4*)(YSH + (size_t)r * DM + cc); m += (f32x4){(float)yv[0], (float)yv[1], (float)yv[2], (float)yv[3]}; }
            const f32x4 g2 = *(const f32x4*)(MOD + (size_t)b * (6 * DM) + 5 * DM + cc);
            xv[j] = *(const f32x4*)(X1 + (size_t)r * DM + cc) + g2 * m;
            ss += (xv[j].x * xv[j].x + xv[j].y * xv[j].y) + (xv[j].z * xv[j].z + xv[j].w * xv[j].w); }
        const float rstd = 1.0f / sqrtf(wave_sum(ss) * (1.0f / DM) + EPS);
#pragma unroll
        for (int j = 0; j < 8; ++j) { const int cc = 4 * F.lane + 256 * j; const f32x4 nw = *(const f32x4*)(F.final_norm + cc);
            *(f32x4*)(F.out + (size_t)r * DM + cc) = xv[j] * rstd * nw; }
    }
}

__device__ __forceinline__ void p_final_plain(Frame& F, const float* xin) {
    const int gw = F.vcu * NWAVES + F.wave, NGW = F.G * NWAVES;
    for (int r = gw; r < MLAT; r += NGW) {
        const float* src = xin + (size_t)r * DM;
        f32x4 xv[8]; float ss = 0.f;
#pragma unroll
        for (int j = 0; j < 8; ++j) { xv[j] = *(const f32x4*)(src + 4 * F.lane + 256 * j); ss += (xv[j].x * xv[j].x + xv[j].y * xv[j].y) + (xv[j].z * xv[j].z + xv[j].w * xv[j].w); }
        const float rstd = 1.0f / sqrtf(wave_sum(ss) * (1.0f / DM) + EPS);
#pragma unroll
        for (int j = 0; j < 8; ++j) { const int cc = 4 * F.lane + 256 * j; const f32x4 nw = *(const f32x4*)(F.final_norm + cc);
            *(f32x4*)(F.out + (size_t)r * DM + cc) = xv[j] * rstd * nw; }
    }
}

constexpr int N_PHASES = 15;
#ifndef DUP_PHASE
#define DUP_PHASE -1
#endif
#ifndef DUP_VAR
#define DUP_VAR 7
#endif
struct Args { const float* in[22]; float* out; unsigned char* ws; int ph_lo, ph_hi; };
__global__ void __launch_bounds__(NTHR, 2) mk_fwd(Args args) {
    extern __shared__ __attribute__((aligned(16))) unsigned char lds_raw[];
    Frame F;
    F.lds = (LAS unsigned char*)lds_raw;
    F.tid = threadIdx.x; F.lane = F.tid & 63; F.wave = __builtin_amdgcn_readfirstlane(F.tid >> 6);
    F.G = gridDim.x; { const int bx = blockIdx.x; F.vcu = (F.G % 8 == 0) ? (bx % 8) * (F.G / 8) + bx / 8 : bx; }
    F.x = args.in[0]; F.c = args.in[1]; F.ctx = args.in[2]; F.c_ctx = args.in[3]; F.w_mod = args.in[4]; F.b_mod = args.in[5]; F.norm_attn = args.in[6]; F.norm_ffn = args.in[7];
    F.w_in = args.in[8]; F.ret_decay = args.in[9]; F.diff_lambda = args.in[10]; F.diff_subln = args.in[11]; F.w_ret_o = args.in[12]; F.w_diff_o = args.in[13]; F.w_out = args.in[14];
    F.w_router = args.in[15]; F.router_bias = args.in[16]; F.w_exp_gu = args.in[17]; F.w_exp_down = args.in[18]; F.w_sh_gu = args.in[19]; F.w_sh_down = args.in[20]; F.final_norm = args.in[21];
    F.out = args.out; F.ws = args.ws;
    volatile LAS unsigned* MISC = (volatile LAS unsigned*)(F.lds + LDSCTL_OFF);
    for (int u = F.tid; u < (LDS_BYTES - LDSCTL_OFF) / 4; u += NTHR) ((LAS unsigned*)(F.lds + LDSCTL_OFF))[u] = 0u;
    __syncthreads();
    const int lo = args.ph_lo, hi = args.ph_hi;
    const bool multi = (hi - lo) > 1;
    XcdBarrier bar; bar.bar = (unsigned*)(F.ws + WS_CTL) + CW_BAR; bar.x = 0; bar.st = nullptr;
    if (multi) bar = xcd_barrier_post((unsigned*)(F.ws + WS_CTL) + CW_BAR, MISC + 8);
#define IN(k) (lo <= (k) && (k) < hi)
#define SEAM(k) do { if (IN(k) && IN((k) + 1)) xcd_barrier(bar); } while (0)

#define RUNP(k, call) do { if (IN(k)) { call; if (DUP_PHASE == (k)) { xcd_barrier(bar); call; } } SEAM(k); } while (0)
    RUNP(0, p0a_mod(F));
    RUNP(1, (p1_norm1(F), p0b_weights(F)));
    RUNP(2, (p2_gemm1(F), p0c_weights_dyn(F, 5)));
    RUNP(3, p3_ret_local(F));
    RUNP(4, p4_ret_scan(F));
    RUNP(5, p5_ret_out(F));
    RUNP(6, p6_attn(F));
    RUNP(7, p7_gemm2(F));
    RUNP(8, p9_gemm3(F));
    RUNP(9, p10_norm2(F));
    RUNP(10, (p11_router(F), p11b_shared_gu(F)));
    RUNP(11, (p12_topk(F), p12b_shared_act(F)));
    if (IN(12)) { p13_expert_phase<true>(F, 0); p15_shared_down_dyn(F, 4); if (DUP_PHASE == 12) { xcd_barrier(bar); p13_expert_phase<true>(F, 2); } } SEAM(12);
    if (IN(13)) { p13_expert_phase<false>(F, 1); if (DUP_PHASE == 13) { xcd_barrier(bar); p13_expert_phase<false>(F, 3); } } SEAM(13);
    if (IN(14)) { p16_combine(F); }
#undef RUNP
#undef IN
#undef SEAM
}

constexpr bool ONE_LAUNCH = true;
extern "C" void kernel_launch(void* const* d_in, const int* in_sizes, int n_in, void* d_out, int out_size, void* d_ws, size_t ws_size, hipStream_t stream) {
    static int grid = 0;
    if (grid == 0) {
        if (n_in != 22 || out_size != MLAT * DM || ws_size < WS_END) { fprintf(stderr, "kernel_launch: unexpected sizes n_in %d out %d ws %zu\n", n_in, out_size, ws_size); grid = -1; return; }
        int dev = 0, cus = 0;
        if (hipGetDevice(&dev) != hipSuccess || hipDeviceGetAttribute(&cus, hipDeviceAttributeMultiprocessorCount, dev) != hipSuccess) { grid = -1; return; }
        if (hipFuncSetAttribute((const void*)mk_fwd, hipFuncAttributeMaxDynamicSharedMemorySize, LDS_BYTES) != hipSuccess) { fprintf(stderr, "kernel_launch: hipFuncSetAttribute failed\n"); grid = -1; return; }
        int per_cu = 0;
        if (hipOccupancyMaxActiveBlocksPerMultiprocessor(&per_cu, (const void*)mk_fwd, NTHR, LDS_BYTES) != hipSuccess || per_cu < 1) fprintf(stderr, "kernel_launch: occupancy query reports %d\n", per_cu);
        (void)hipGetLastError();
        grid = cus;
    }
    if (grid < 0) return;
    (void)hipMemsetAsync((char*)d_ws + WS_CTL, 0, CTL_ZERO_BYTES, stream);
    Args a{};
    for (int i = 0; i < 22; ++i) a.in[i] = (const float*)d_in[i];
    a.out = (float*)d_out; a.ws = (unsigned char*)d_ws;
    if (ONE_LAUNCH) {
        a.ph_lo = 0; a.ph_hi = N_PHASES;
        hipLaunchKernelGGL(mk_fwd, dim3(grid), dim3(NTHR), LDS_BYTES, stream, a);
    } else {
        for (int p = 0; p < N_PHASES; ++p) { a.ph_lo = p; a.ph_hi = p + 1; hipLaunchKernelGGL(mk_fwd, dim3(grid), dim3(NTHR), LDS_BYTES, stream, a); }
    }
}
```

```cpp
#include <hip/hip_runtime.h>
#include <cstdio>
#include <cstdint>

#define LAS __attribute__((address_space(3)))
#define GAS __attribute__((address_space(1)))
typedef _Float16 h16;
typedef _Float16 h16x8 __attribute__((ext_vector_type(8)));
typedef _Float16 h16x4 __attribute__((ext_vector_type(4)));
typedef _Float16 h16x2 __attribute__((ext_vector_type(2)));
typedef float f32x2 __attribute__((ext_vector_type(2)));
typedef float f32x4 __attribute__((ext_vector_type(4)));
typedef float f32x16 __attribute__((ext_vector_type(16)));
typedef unsigned u32x4 __attribute__((ext_vector_type(4)));
typedef unsigned u32x2 __attribute__((ext_vector_type(2)));
typedef short v4i16_t __attribute__((ext_vector_type(4)));

constexpr int DM = 2048, NBATCH = 2, SEQ = 4096, CTXL = 256;
constexpr int MLAT = NBATCH * SEQ, MCTX = NBATCH * CTXL, MALL = MLAT + MCTX;
constexpr int IN_COLS = 13312, KV_COLS = 5120;
constexpr int C_RK = 0, C_RV = 1024, C_DK = 3072, C_DV = 4096, C_RQ = 5120, C_RG = 6144, C_DQ = 8192, C_GR = 9216, C_GD = 11264;
constexpr int NEXP = 256, TOPK = 8, DEXP = 256;
constexpr float EPS = 1e-6f;
constexpr int NWAVES = 8, NTHR = 512;

constexpr size_t MiB = 1u << 20;
constexpr size_t WS_CTL = 0, CTL_ZERO_BYTES = 1 * MiB;
constexpr size_t WS_MODP = 1 * MiB;
constexpr size_t WS_MOD = 3 * MiB;
constexpr size_t WS_ROPE = 3 * MiB + 512 * 1024;
constexpr size_t WS_WINT = 4 * MiB;
constexpr size_t WS_WRET = 56 * MiB;
constexpr size_t WS_WDIF = 64 * MiB;
constexpr size_t WS_WOUT = 68 * MiB;
constexpr size_t WS_WSGU = 76 * MiB;
constexpr size_t WS_WSDN = 78 * MiB;
constexpr size_t WS_WRTR = 79 * MiB;
constexpr size_t WS_H = 82 * MiB;
constexpr size_t WS_P = 116 * MiB;
constexpr size_t WS_LST = 340 * MiB;
constexpr size_t WS_SST = 408 * MiB;
constexpr size_t WS_ARET = 472 * MiB;
constexpr size_t WS_ADIF = 504 * MiB;
constexpr size_t WS_T = 520 * MiB;
constexpr size_t WS_U = 584 * MiB;
constexpr size_t WS_X1 = 616 * MiB;
constexpr size_t WS_H2X = 680 * MiB;
constexpr size_t WS_LG = 776 * MiB;
constexpr size_t WS_EIDX = 784 * MiB;
constexpr size_t WS_EW = 785 * MiB;
constexpr size_t WS_LIST = 786 * MiB;
constexpr size_t WS_ACTS = 794 * MiB;
constexpr size_t WS_YSH = 798 * MiB;
constexpr size_t WS_Y = 830 * MiB;
constexpr size_t WS_ACT = 1086 * MiB;
constexpr size_t WS_LGP = 1118 * MiB;
constexpr size_t WS_SGP = 1182 * MiB;
constexpr size_t WS_ACAT = 1246 * MiB;
constexpr size_t WS_WCAT = 1294 * MiB;
constexpr size_t WS_LIST2 = 1306 * MiB;
constexpr size_t WS_H2F8 = 1322 * MiB;
constexpr size_t WS_ACT8 = 1338 * MiB;
constexpr size_t WS_END = 1354 * MiB;

constexpr int CW_BAR = 4096;
constexpr int CW_CNT = 16384;
constexpr int CW_Q = 20480;

constexpr int RING_BYTES = 131072;
constexpr int LDS_BYTES = 163840;
constexpr int LDSCTL_OFF = LDS_BYTES - 512;
constexpr int LDS_TICKET = 146432;

#define XB_TMO      128
#define XB_XCNT(j)  (256  + 64 * (j))
#define XB_XSUB(j)  (1280 + 64 * (j))
#define XB_XGEN(j)  (2304 + 64 * (j))
#define XB_TOP      3328
#define XB_TOPGEN   3392
#define XCD_BAR_WORDS 3456
#define XB_SPIN_CAP (1u << 18)

__device__ __forceinline__ unsigned xb_ld(unsigned* p)              { return __hip_atomic_load(p, __ATOMIC_RELAXED, __HIP_MEMORY_SCOPE_AGENT); }
__device__ __forceinline__ unsigned xb_add(unsigned* p, unsigned v) { return __hip_atomic_fetch_add(p, v, __ATOMIC_RELAXED, __HIP_MEMORY_SCOPE_AGENT); }
__device__ __forceinline__ unsigned xb_xcc_id() { return (unsigned)__builtin_amdgcn_s_getreg((3 << 11) | 20) & 0xFu; }
#define XB_SPIN(cond, bar) do { unsigned _sp = 0; while (cond) { __builtin_amdgcn_s_sleep(1); \
    if ((++_sp & 255u) == 0u) { if (xb_ld(&(bar)[XB_TMO])) break; if (_sp > XB_SPIN_CAP) { atomicAdd(&(bar)[XB_TMO], 1u); break; } } } } while (0)

struct XcdBarrier { unsigned* bar; unsigned x; volatile LAS unsigned* st; };

__device__ __forceinline__ XcdBarrier xcd_barrier_post(unsigned* bar, volatile LAS unsigned* st) {
    XcdBarrier b; b.bar = bar; b.x = xb_xcc_id(); b.st = st;
    if (threadIdx.x == 0) (void)xb_add(&bar[XB_XCNT(b.x)], 1u);
    return b;
}
__device__ __forceinline__ void xcd_barrier_complete(unsigned* bar, unsigned x, unsigned& nloc, unsigned& nx) {
    const unsigned G = gridDim.x * gridDim.y * gridDim.z;
    unsigned sum, cnt, mine, sp = 0u;
    for (;;) {
        sum = 0u; cnt = 0u; mine = 0u;
#pragma unroll
        for (unsigned j = 0; j < 16; ++j) { const unsigned c = xb_ld(&bar[XB_XCNT(j)]); sum += c; cnt += (c > 0u) ? 1u : 0u; mine = (j == x) ? c : mine; }
        if (sum == G) break;
        __builtin_amdgcn_s_sleep(1);
        if ((++sp & 255u) == 0u) { if (xb_ld(&bar[XB_TMO])) break; if (sp > XB_SPIN_CAP) { atomicAdd(&bar[XB_TMO], 1u); break; } }
    }
    nloc = mine > 0u ? mine : 1u; nx = cnt > 0u ? cnt : 1u;
}
__device__ __forceinline__ void xcd_barrier(const XcdBarrier& b) {
    asm volatile("s_waitcnt vmcnt(0)" ::: "memory");
    __syncthreads();
    if (threadIdx.x == 0) {
        unsigned* bar = b.bar;
        __builtin_amdgcn_s_waitcnt(0);
        unsigned nloc = b.st[0], nx = b.st[1];
        if (nloc == 0u) { xcd_barrier_complete(bar, b.x, nloc, nx); b.st[0] = nloc; b.st[1] = nx; }
        const unsigned old = xb_add(&bar[XB_XSUB(b.x)], 1u);
        const unsigned gen = old / nloc;
        if (old + 1u == (gen + 1u) * nloc) {
            __builtin_amdgcn_fence(__ATOMIC_RELEASE, "agent");
            asm volatile("s_waitcnt vmcnt(0)" ::: "memory");
            const unsigned og = xb_add(&bar[XB_TOP], 1u);
            const unsigned tg = og / nx;
            if (og + 1u == (tg + 1u) * nx) xb_add(&bar[XB_TOPGEN], 1u);
            else XB_SPIN(xb_ld(&bar[XB_TOPGEN]) == tg, bar);
            __builtin_amdgcn_fence(__ATOMIC_ACQUIRE, "agent");
            xb_add(&bar[XB_XGEN(b.x)], 1u);
            asm volatile("s_waitcnt vmcnt(0)" ::: "memory");
        } else {
            XB_SPIN(xb_ld(&bar[XB_XGEN(b.x)]) == gen, bar);
            __builtin_amdgcn_fence(__ATOMIC_ACQUIRE, "agent");
            asm volatile("s_waitcnt vmcnt(0)" ::: "memory");
        }
    }
    __syncthreads();
}


namespace pg8 {
constexpr int BM = 256, BK = 64, HALF = 128, HTB = HALF * BK * 2, STAGE_BYTES = 8 * HTB, NXCD = 8, WGM = 8;
__host__ __device__ __forceinline__ int lds_byte(int r, int c) { const int st = (r >> 4) * 2 + (c >> 5), rr = r & 15, cc = c & 31, ob = rr * 64 + cc * 2; return st * 1024 + (ob ^ (((ob >> 9) & 1) << 5)); }
__host__ __device__ __forceinline__ void stage_rc(int b, int& R, int& C) { const int st = b / 1024, sb = b % 1024, swz = sb ^ (((sb >> 9) & 1) << 5); R = (st >> 1) * 16 + swz / 64; C = (st & 1) * 32 + (swz % 64) / 2; }
struct Unit { int pm, pn, ko, nt, keep; };
struct Gemm { const h16* A; const h16* Bt; int lda, ldb, K; };
struct StaticOrder {
    int nM, nN, nwg, G, c;
    __host__ __device__ void init(int M, int N, int G_, int c_) { nM = M / BM; nN = N / BM; nwg = nM * nN; G = G_; c = c_; }
    __host__ __device__ bool next(int i, Unit& u) const {
        const long L = (long)i * G + c; if (L >= nwg) return false;
        int wgid = (int)L; { const int q = nwg / NXCD, r = nwg % NXCD, xcd = wgid % NXCD, off = wgid / NXCD; wgid = (xcd < r ? xcd * (q + 1) : r * (q + 1) + (xcd - r) * q) + off; }
        const int nig = WGM * nN, gid = wgid / nig, fm = gid * WGM, gsz = (nM - fm) < WGM ? (nM - fm) : WGM;
        u.pm = fm + ((wgid % nig) % gsz); u.pn = (wgid % nig) / gsz; u.ko = 0; u.nt = 0; u.keep = 0; return true;
    }
};
template <class Epi, class Sched, bool ALIGN_EPI = true>
__device__ __forceinline__ void gemm_phase(LAS unsigned char* lds, const Gemm g, const Sched& S, const Epi& E) {
    const int tid = threadIdx.x, wid = __builtin_amdgcn_readfirstlane(tid >> 6), lane = tid & 63, wr = wid >> 2, wc = wid & 3, fr = lane & 15, fq = lane >> 4;
    const int nt0 = g.K / BK;
    unsigned voffA[2], voffB[2];
#pragma unroll
    for (int i = 0; i < 2; ++i) { int R, C; stage_rc(tid * 16 + i * 8192, R, C); voffA[i] = (unsigned)(R * g.lda + C) * 2u; voffB[i] = (unsigned)(R * g.ldb + C) * 2u; }
    const size_t kstep = (size_t)(BK * 2);
    const size_t hstepA = (size_t)HALF * g.lda * 2, hstepB = (size_t)HALF * g.ldb * 2;
    const size_t tstepA = 2 * hstepA, tstepB = 2 * hstepB;
    const unsigned ldsw = (unsigned)wid * 1024u;
    const int aoff = lds_byte(wr * 64 + fr, fq * 8), boff = lds_byte(wc * 32 + fr, fq * 8);
#define PG8_SA(b, h) (((b) * 2 + (h)) * HTB)
#define PG8_SB(b, h) ((4 + (b) * 2 + (h)) * HTB)
#define PG8_STAGE(bufoff, gbase, voff) do { _Pragma("unroll") for (int _i = 0; _i < 2; ++_i) \
        __builtin_amdgcn_global_load_lds((const unsigned*)((const char*)(gbase) + (voff)[_i]), (LAS unsigned*)(lds + (bufoff) + ldsw + _i * 8192), 16, 0, 0); } while (0)
#define PG8_LDA(dst, b, h) do { _Pragma("unroll") for (int m = 0; m < 4; ++m) _Pragma("unroll") for (int k = 0; k < 2; ++k) dst[m][k] = *(const LAS h16x8*)(lds + PG8_SA(b, h) + aoff + m * 2048 + k * 1024); } while (0)
#define PG8_LDB(dst, b, h) do { _Pragma("unroll") for (int n = 0; n < 2; ++n) _Pragma("unroll") for (int k = 0; k < 2; ++k) dst[n][k] = *(const LAS h16x8*)(lds + PG8_SB(b, h) + boff + n * 2048 + k * 1024); } while (0)
#define PG8_MMA(ai, bj, At, Bt) do { __builtin_amdgcn_s_setprio(1); _Pragma("unroll") for (int m = 0; m < 4; ++m) _Pragma("unroll") for (int n = 0; n < 2; ++n) _Pragma("unroll") for (int k = 0; k < 2; ++k) \
        acc[ai][bj][m][n] = __builtin_amdgcn_mfma_f32_16x16x32_f16(Bt[n][k], At[m][k], acc[ai][bj][m][n], 0, 0, 0); __builtin_amdgcn_s_setprio(0); } while (0)
#define PG8_WAIT_V(n) asm volatile("s_waitcnt vmcnt(" #n ")" ::: "memory")
#define PG8_WAIT_L(n) asm volatile("s_waitcnt lgkmcnt(" #n ")" ::: "memory")
#define PG8_BAR __builtin_amdgcn_s_barrier()
#define PG8_SCHED __builtin_amdgcn_sched_barrier(0)
    Unit cur, nxt; int ui = 0;
    if (!S.next(0, cur)) return;
    f32x4 acc[2][2][4][2];
#pragma unroll
    for (int a = 0; a < 2; ++a)
#pragma unroll
        for (int b = 0; b < 2; ++b)
#pragma unroll
            for (int m = 0; m < 4; ++m)
#pragma unroll
                for (int n = 0; n < 2; ++n) acc[a][b][m][n] = (f32x4){0.f, 0.f, 0.f, 0.f};
    h16x8 At[4][2], B0[2][2], B1[2][2];
    const char* cA = (const char*)g.A + (size_t)cur.pm * tstepA + (size_t)cur.ko * 2; const char* cB = (const char*)g.Bt + (size_t)cur.pn * tstepB + (size_t)cur.ko * 2;
    {
        PG8_STAGE(PG8_SB(0, 0), cB, voffB); PG8_STAGE(PG8_SB(0, 1), cB + hstepB, voffB); PG8_STAGE(PG8_SA(0, 0), cA, voffA); PG8_STAGE(PG8_SA(0, 1), cA + hstepA, voffA);
        if (wr == 1) PG8_BAR;
        PG8_WAIT_V(2); PG8_BAR;
        PG8_STAGE(PG8_SB(1, 0), cB + kstep, voffB); PG8_STAGE(PG8_SA(1, 0), cA + kstep, voffA); PG8_STAGE(PG8_SB(1, 1), cB + hstepB + kstep, voffB);
        PG8_WAIT_V(6); PG8_BAR;
    }
    for (;;) {
        const bool has_next = S.next(ui + 1, nxt);
        const char* nA = has_next ? (const char*)g.A + (size_t)nxt.pm * tstepA + (size_t)nxt.ko * 2 : cA; const char* nB = has_next ? (const char*)g.Bt + (size_t)nxt.pn * tstepB + (size_t)nxt.ko * 2 : cB;
        int nt = cur.nt ? cur.nt : nt0; asm volatile("" : "+s"(nt));
        for (int t = 0; t < nt; t += 2) {
            const bool last = (t == nt - 2);
            const char* a1 = cA + (size_t)(t + 1) * kstep;
            const char* a2 = last ? nA : cA + (size_t)(t + 2) * kstep; const char* b2 = last ? nB : cB + (size_t)(t + 2) * kstep;
            const char* a3 = a2 + kstep; const char* b3 = b2 + kstep;
            PG8_LDB(B0, 0, 0); PG8_LDB(B1, 0, 1); PG8_SCHED; PG8_LDA(At, 0, 0); PG8_STAGE(PG8_SA(1, 1), a1 + hstepA, voffA);
            PG8_WAIT_V(8); PG8_WAIT_L(0); PG8_BAR; PG8_MMA(0, 0, At, B0); PG8_MMA(0, 1, At, B1); PG8_BAR; PG8_SCHED;
            PG8_LDA(At, 0, 1); PG8_STAGE(PG8_SB(0, 0), b2, voffB); PG8_STAGE(PG8_SB(0, 1), b2 + hstepB, voffB); PG8_STAGE(PG8_SA(0, 0), a2, voffA);
            PG8_WAIT_V(8); PG8_WAIT_L(0); PG8_BAR; PG8_MMA(1, 0, At, B0); PG8_MMA(1, 1, At, B1); PG8_BAR; PG8_SCHED;
            PG8_LDB(B0, 1, 0); PG8_LDB(B1, 1, 1); PG8_SCHED; PG8_LDA(At, 1, 0); PG8_STAGE(PG8_SA(0, 1), a2 + hstepA, voffA);
            PG8_WAIT_V(8); PG8_WAIT_L(0); PG8_BAR; PG8_MMA(0, 0, At, B0); PG8_MMA(0, 1, At, B1); PG8_BAR; PG8_SCHED;
            PG8_LDA(At, 1, 1); PG8_STAGE(PG8_SB(1, 0), b3, voffB); PG8_STAGE(PG8_SB(1, 1), b3 + hstepB, voffB); PG8_STAGE(PG8_SA(1, 0), a3, voffA);
            PG8_WAIT_V(8); PG8_WAIT_L(0); PG8_BAR; PG8_MMA(1, 0, At, B0); PG8_MMA(1, 1, At, B1); PG8_BAR; PG8_SCHED;
        }
        if constexpr (ALIGN_EPI) { if (wr == 0) PG8_BAR; }
        E(acc, cur, wr, wc, fr, fq);
        if (!has_next) break;
        if (!cur.keep) {
#pragma unroll
        for (int a = 0; a < 2; ++a)
#pragma unroll
            for (int b = 0; b < 2; ++b)
#pragma unroll
                for (int m = 0; m < 4; ++m)
#pragma unroll
                    for (int n = 0; n < 2; ++n) acc[a][b][m][n] = (f32x4){0.f, 0.f, 0.f, 0.f};
        }
        cur = nxt; cA = nA; cB = nB; ++ui;
        if constexpr (ALIGN_EPI) { if (wr == 1) PG8_BAR; }
    }
    PG8_WAIT_V(0);
    if constexpr (!ALIGN_EPI) { if (wr == 0) PG8_BAR; }
    PG8_BAR;
#undef PG8_SA
#undef PG8_SB
#undef PG8_STAGE
#undef PG8_LDA
#undef PG8_LDB
#undef PG8_MMA
#undef PG8_WAIT_V
#undef PG8_WAIT_L
#undef PG8_BAR
#undef PG8_SCHED
}
}

struct Frame {
    LAS unsigned char* lds;
    int tid, lane, wave, vcu, G;
    const float *x, *c, *ctx, *c_ctx, *w_mod, *b_mod, *norm_attn, *norm_ffn, *w_in, *ret_decay, *diff_lambda, *diff_subln,
                *w_ret_o, *w_diff_o, *w_out, *w_router, *router_bias, *w_exp_gu, *w_exp_down, *w_sh_gu, *w_sh_down, *final_norm;
    float* out;
    unsigned char* ws;
};

template <class T> __device__ __forceinline__ const T* uni_ptr(const T* p) {
    const unsigned long long v = (unsigned long long)p;
    const unsigned lo = __builtin_amdgcn_readfirstlane((unsigned)v), hi = __builtin_amdgcn_readfirstlane((unsigned)(v >> 32));
    return (const T*)(((unsigned long long)hi << 32) | lo);
}
__device__ __forceinline__ float wave_sum(float v) {
#pragma unroll
    for (int o = 1; o < 64; o <<= 1) v += __shfl_xor(v, o);
    return v;
}
__device__ __forceinline__ unsigned pk2h(float lo, float hi) { f32x2 v = {lo, hi}; h16x2 h = __builtin_convertvector(v, h16x2); return __builtin_bit_cast(unsigned, h); }
__device__ __forceinline__ float silu_f(float v) { return v * __builtin_amdgcn_rcpf(1.0f + __expf(-v)); }
__device__ __forceinline__ float sigmoid_f(float v) { return __builtin_amdgcn_rcpf(1.0f + __expf(-v)); }

__device__ __forceinline__ void p0_mod_unit(Frame& F, int unit) {
    const int cb = unit % 24, ks = unit / 24;
    LAS float* sv = (LAS float*)F.lds;
    LAS float* red = sv + 768;
    for (int i = F.tid; i < 768; i += NTHR) { const int v = i >> 8, k = i & 255; const float cv = (v < 2) ? F.c[v * DM + ks * 256 + k] : F.c_ctx[ks * 256 + k]; sv[i] = silu_f(cv); }
    __syncthreads();
    const int cl = F.tid & 127, rl = F.tid >> 7;
    const float* wp = F.w_mod + (size_t)(ks * 256 + rl) * (6 * DM) + cb * 512 + cl * 4;
    f32x4 a0 = {0.f, 0.f, 0.f, 0.f}, a1 = a0, a2 = a0;
#pragma unroll 8
    for (int i = 0; i < 64; ++i) { const f32x4 w = *(const f32x4*)(wp + (size_t)i * 4 * (6 * DM)); const int k = rl + 4 * i; a0 += w * sv[k]; a1 += w * sv[256 + k]; a2 += w * sv[512 + k]; }
    *(LAS f32x4*)(red + (rl * 3 + 0) * 512 + cl * 4) = a0; *(LAS f32x4*)(red + (rl * 3 + 1) * 512 + cl * 4) = a1; *(LAS f32x4*)(red + (rl * 3 + 2) * 512 + cl * 4) = a2;
    __syncthreads();
    float* modp = (float*)(F.ws + WS_MODP);
    for (int i = F.tid; i < 1536; i += NTHR) { const int v = i >> 9, cc = i & 511; const float s = (red[(0 * 3 + v) * 512 + cc] + red[(1 * 3 + v) * 512 + cc]) + (red[(2 * 3 + v) * 512 + cc] + red[(3 * 3 + v) * 512 + cc]);
        modp[(size_t)(ks * 3 + v) * (6 * DM) + cb * 512 + cc] = s; }
    __syncthreads();
}
template <int MAP>
__device__ __forceinline__ void p0_transpose_item(const float* W, int K, int N, h16* WT, LAS float* scr, int item, int lane, int ldd = 0) {
    if (ldd == 0) ldd = K;
    const int nblk = N / 32, kb = item / nblk, nb = item % nblk, k0 = 64 * kb, n0 = 32 * nb;
    float wv[32];
#pragma unroll
    for (int i = 0; i < 32; ++i) { const int kk = 2 * i + (lane >> 5); wv[i] = W[(size_t)(k0 + kk) * N + n0 + (lane & 31)]; }
#pragma unroll
    for (int i = 0; i < 32; ++i) { const int kk = 2 * i + (lane >> 5); scr[kk * 33 + (lane & 31)] = wv[i]; }
    asm volatile("s_waitcnt lgkmcnt(0)" ::: "memory");
    const int cch = lane & 7;
#pragma unroll
    for (int j = 0; j < 4; ++j) { const int n = (lane >> 3) + 8 * j; const LAS float* s = scr + (8 * cch) * 33 + n;
        u32x4 o; o.x = pk2h(s[0 * 33], s[1 * 33]); o.y = pk2h(s[2 * 33], s[3 * 33]); o.z = pk2h(s[4 * 33], s[5 * 33]); o.w = pk2h(s[6 * 33], s[7 * 33]);
        int nn = n0 + n;
        if (MAP == 1) { const bool isrope = (nn < 1024) || (nn >= C_RQ && nn < C_RQ + 1024); if (isrope) nn = (nn & ~48) | ((nn & 16) << 1) | ((nn & 32) >> 1); }
        if (MAP == 2) { const int j = nn & 255, isu = nn >> 8; nn = 32 * (j >> 4) + 16 * isu + (j & 15); }
        *(u32x4*)(WT + (size_t)nn * ldd + k0 + 8 * cch) = o; }
    asm volatile("s_waitcnt lgkmcnt(0)" ::: "memory");
}
__device__ __forceinline__ void p0a_mod(Frame& F) {
    for (int u = F.vcu; u < 192; u += F.G) p0_mod_unit(F, u);
}
__device__ __forceinline__ void p0b_weights(Frame& F) {
    __syncthreads();
    LAS float* scr = (LAS float*)(F.lds + F.wave * 16384);
    const int gw = F.vcu * NWAVES + F.wave, NGW = F.G * NWAVES;
    constexpr int I_IN = (DM / 64) * (IN_COLS / 32);
    for (int it = gw; it < I_IN; it += NGW) p0_transpose_item<1>(F.w_in, DM, IN_COLS, (h16*)(F.ws + WS_WINT), scr, it, F.lane);
    if (blockIdx.x == 0) {
        float* rope = (float*)(F.ws + WS_ROPE);
        for (int i = F.tid; i < 64 * 32; i += NTHR) { const int pos = i >> 5, j = i & 31; const float inv = exp2f(-(float)j * (13.287712379549449f / 32.0f)); const float ang = (float)pos * inv; rope[i] = cosf(ang); rope[2048 + i] = sinf(ang); }
        for (int i = F.tid; i < 64 * 16; i += NTHR) { const int pos = i >> 4, j = i & 15; const float inv = exp2f(-(float)j * (13.287712379549449f / 16.0f)); const float ang = (float)pos * inv; rope[4096 + i] = cosf(ang); rope[4096 + 1024 + i] = sinf(ang); }
    }
}
__device__ __forceinline__ void p0c_weights_dyn(Frame& F, int qid) {
    unsigned* QH = (unsigned*)(F.ws + WS_CTL) + CW_Q + 64 * 8 * qid;
    LAS int* RED = (LAS int*)(F.lds + LDS_TICKET);
    LAS float* scr = (LAS float*)(F.lds + F.wave * 16384);
    constexpr int I_RET = (2048 / 64) * (DM / 32), I_DIF = (1024 / 64) * (DM / 32), I_OUT = (DM / 64) * (DM / 32), I_SGU = (DM / 64) * (512 / 32), I_SDN = (256 / 64) * (DM / 32), I_RT = NEXP * DM / 4 / 64;
    constexpr int NITEMS = I_RET + I_DIF + I_OUT + I_SGU + I_SDN + I_RT, NTICK = (NITEMS + 7) / 8;
    for (;;) {
        __syncthreads();
        if (F.tid == 0) RED[0] = (int)__hip_atomic_fetch_add(QH, 1u, __ATOMIC_RELAXED, __HIP_MEMORY_SCOPE_AGENT);
        __syncthreads();
        const int t = RED[0];
        if (t >= NTICK) break;
        int r = t * 8 + F.wave;
        if (r >= NITEMS) continue;
        if (r < I_RET) { p0_transpose_item<0>(F.w_ret_o, 2048, DM, (h16*)(F.ws + WS_WCAT), scr, r, F.lane, 3072); continue; } r -= I_RET;
        if (r < I_DIF) { p0_transpose_item<0>(F.w_diff_o, 1024, DM, (h16*)(F.ws + WS_WCAT) + 2048, scr, r, F.lane, 3072); continue; } r -= I_DIF;
        if (r < I_OUT) { p0_transpose_item<0>(F.w_out, DM, DM, (h16*)(F.ws + WS_WOUT), scr, r, F.lane); continue; } r -= I_OUT;
        if (r < I_SGU) { p0_transpose_item<2>(F.w_sh_gu, DM, 512, (h16*)(F.ws + WS_WSGU), scr, r, F.lane); continue; } r -= I_SGU;
        if (r < I_SDN) { p0_transpose_item<0>(F.w_sh_down, 256, DM, (h16*)(F.ws + WS_WSDN), scr, r, F.lane); continue; } r -= I_SDN;
        {
            const int q = r * 64 + F.lane, e = q / (DM / 4), k = (q % (DM / 4)) * 4;
            const f32x4 w = *(const f32x4*)(F.w_router + (size_t)e * DM + k);
            h16 hi[4], lo[4];
#pragma unroll
            for (int j = 0; j < 4; ++j) { hi[j] = (h16)w[j]; lo[j] = (h16)(w[j] - (float)hi[j]); }
            h16* dst = (h16*)(F.ws + WS_WRTR) + (size_t)e * 6144 + k;
            *(h16x4*)(dst) = (h16x4){hi[0], hi[1], hi[2], hi[3]}; *(h16x4*)(dst + 2048) = (h16x4){hi[0], hi[1], hi[2], hi[3]}; *(h16x4*)(dst + 4096) = (h16x4){lo[0], lo[1], lo[2], lo[3]};
        }
    }
}

__device__ __forceinline__ void p1_norm1(Frame& F) {
    LAS float* msh = (LAS float*)F.lds; LAS float* msc = msh + 3 * DM;
    const float* modp = (const float*)(F.ws + WS_MODP);
#pragma unroll 1
    for (int i0 = F.tid; i0 < 3 * 2 * DM; i0 += 4 * NTHR) { float pv[4][8], bs[4];
#pragma unroll
        for (int q = 0; q < 4; ++q) { const int i = i0 + q * NTHR, v = i / (2 * DM), cc = i % (2 * DM); bs[q] = F.b_mod[cc];
#pragma unroll
            for (int ks = 0; ks < 8; ++ks) pv[q][ks] = modp[(size_t)(ks * 3 + v) * (6 * DM) + cc]; }
#pragma unroll
        for (int q = 0; q < 4; ++q) { const int i = i0 + q * NTHR, v = i / (2 * DM), cc = i % (2 * DM); float s = bs[q];
#pragma unroll
            for (int ks = 0; ks < 8; ++ks) s += pv[q][ks];
            if (cc < DM) msh[v * DM + cc] = s; else msc[v * DM + cc - DM] = s; } }
    __syncthreads();
    const int gw = F.vcu * NWAVES + F.wave, NGW = F.G * NWAVES;
    h16* H = (h16*)(F.ws + WS_H);
    for (int r = gw; r < MALL; r += NGW) {
        const float* src = (r < MLAT) ? F.x + (size_t)r * DM : F.ctx + (size_t)(r - MLAT) * DM; const int v = (r < MLAT) ? (r / SEQ) : 2;
        f32x4 xv[8]; float ss = 0.f;
#pragma unroll
        for (int j = 0; j < 8; ++j) { xv[j] = *(const f32x4*)(src + 4 * F.lane + 256 * j); ss += (xv[j].x * xv[j].x + xv[j].y * xv[j].y) + (xv[j].z * xv[j].z + xv[j].w * xv[j].w); }
        const float rstd = 1.0f / sqrtf(wave_sum(ss) * (1.0f / DM) + EPS);
#pragma unroll
        for (int j = 0; j < 8; ++j) { const int cc = 4 * F.lane + 256 * j; const f32x4 nw = *(const f32x4*)(F.norm_attn + cc);
            const f32x4 sc = *(LAS f32x4*)(msc + v * DM + cc), sh = *(LAS f32x4*)(msh + v * DM + cc);
            const f32x4 y = xv[j] * rstd * nw * (sc + 1.0f) + sh;
            u32x2 o; o.x = pk2h(y.x, y.y); o.y = pk2h(y.z, y.w); *(u32x2*)(H + (size_t)r * DM + cc) = o; }
    }
    float* MOD = (float*)(F.ws + WS_MOD);
    for (int i = blockIdx.x * NTHR + F.tid; i < 3 * 6 * DM; i += F.G * NTHR) { const int v = i / (6 * DM), cc = i % (6 * DM); float s = F.b_mod[cc];
#pragma unroll
        for (int ks = 0; ks < 8; ++ks) s += modp[(size_t)(ks * 3 + v) * (6 * DM) + cc];
        MOD[i] = s; }
}


__device__ __forceinline__ int crow(int r, int hi) { return (r & 3) + 8 * (r >> 2) + 4 * hi; }
__device__ __forceinline__ h16x8 frag_row(const LAS unsigned char* base, int strideB, int r0, int k0, int lane) {
    return *(const LAS h16x8*)(base + (r0 + (lane & 31)) * strideB + (k0 + 8 * (lane >> 5)) * 2);
}
__device__ __forceinline__ v4i16_t tr16(const LAS unsigned char* p) { return __builtin_amdgcn_ds_read_tr16_b64_v4i16((LAS v4i16_t*)p); }
__device__ __forceinline__ h16x8 frag_tr(const LAS unsigned char* base, int strideB, int k0, int n0, int lane) {
    const int kb = k0 + 8 * (lane >> 5) + ((lane & 15) >> 2), nc = n0 + 16 * ((lane >> 4) & 1) + 4 * (lane & 3);
    const LAS unsigned char* p = base + kb * strideB + nc * 2;
    const v4i16_t lo = tr16(p), hi = tr16(p + 4 * strideB);
    typedef short s16x8 __attribute__((ext_vector_type(8)));
    const s16x8 v = {lo[0], lo[1], lo[2], lo[3], hi[0], hi[1], hi[2], hi[3]};
    return __builtin_bit_cast(h16x8, v);
}
__device__ __forceinline__ h16x8 frag_tr_perm(const LAS unsigned char* base, int strideB, int k0, int n0, int lane) {
    const int kb = k0 + 4 * (lane >> 5) + ((lane & 15) >> 2), nc = n0 + 16 * ((lane >> 4) & 1) + 4 * (lane & 3);
    const LAS unsigned char* p = base + kb * strideB + nc * 2;
    const v4i16_t lo = tr16(p), hi = tr16(p + 8 * strideB);
    typedef short s16x8 __attribute__((ext_vector_type(8)));
    const s16x8 v = {lo[0], lo[1], lo[2], lo[3], hi[0], hi[1], hi[2], hi[3]};
    return __builtin_bit_cast(h16x8, v);
}
__device__ __forceinline__ h16x8 pack8(float a0, float a1, float a2, float a3, float a4, float a5, float a6, float a7) {
    u32x4 w; w.x = pk2h(a0, a1); w.y = pk2h(a2, a3); w.z = pk2h(a4, a5); w.w = pk2h(a6, a7); return __builtin_bit_cast(h16x8, w);
}
#define MFMA32(a, b, c) __builtin_amdgcn_mfma_f32_32x32x16_f16((a), (b), (c), 0, 0, 0)

struct SchedG1 {
    pg8::StaticOrder so; int G, c;
    __device__ __forceinline__ bool next(int i, pg8::Unit& u) const {
        const int L = i * G + c;
        if (L < 32 * 52) return so.next(i, u);
        const int r = L - 32 * 52; if (r >= 40) return false;
        u.pm = 32 + r / 20; u.pn = r % 20; u.ko = 0; u.nt = 0; u.keep = 0; return true;
    }
};
struct EpiP {
    h16* P; const float* rope;
    __device__ __forceinline__ void operator()(f32x4 (&acc)[2][2][4][2], const pg8::Unit& u, int wr, int wc, int fr, int fq) const {
        const int colt = u.pn * 256; const bool lat = u.pm < 32;
        int kind;
        if (colt < C_RV) kind = 1; else if (colt < C_DK) kind = 0; else if (colt < C_DV) kind = 3; else if (colt < C_RQ) kind = 0; else if (colt < C_RG) kind = 2; else if (colt < C_DQ) kind = 5; else if (colt < C_GR) kind = 4; else kind = 6;
        if (!lat) kind = (kind == 1) ? 7 : 0;
#pragma unroll
        for (int ai = 0; ai < 2; ++ai)
#pragma unroll
            for (int m = 0; m < 4; ++m) {
                const int row = u.pm * 256 + ai * 128 + wr * 64 + m * 16 + fr; const int t = row & (SEQ - 1);
                h16* prow = P + (size_t)row * IN_COLS;
#pragma unroll
                for (int bj = 0; bj < 2; ++bj) {
                    const int cbase = colt + bj * 128 + wc * 32;
                    const f32x4 x0 = acc[ai][bj][m][0], x1 = acc[ai][bj][m][1];
                    f32x4 o0, o1; int c0, c1;
                    if (kind == 1 || kind == 2) {
                        const int g5 = (cbase >> 5) & 1, axis = (cbase >> 6) & 1, pos = axis ? (t & 63) : (t >> 6), j0 = 16 * g5 + 4 * fq;
                        const f32x4 cs = *(const f32x4*)(rope + pos * 32 + j0), sn = *(const f32x4*)(rope + 2048 + pos * 32 + j0);
                        o0 = x0 * cs - x1 * sn; o1 = x0 * sn + x1 * cs;
                        if (kind == 2) { o0 *= 0.08838834764831845f; o1 *= 0.08838834764831845f; }
                        c0 = (cbase & ~63) + j0; c1 = c0 + 32;
                    } else if (kind == 7) {
                        const int g5 = (cbase >> 5) & 1; c0 = (cbase & ~63) + 16 * g5 + 4 * fq; c1 = c0 + 32; o0 = x0; o1 = x1;
                    } else if (kind == 3 || kind == 4) {
                        const int axis = (cbase >> 5) & 1, pos = axis ? (t & 63) : (t >> 6), j0 = 4 * fq;
                        const f32x4 cs = *(const f32x4*)(rope + 4096 + pos * 16 + j0), sn = *(const f32x4*)(rope + 5120 + pos * 16 + j0);
                        o0 = x0 * cs - x1 * sn; o1 = x0 * sn + x1 * cs;
                        if (kind == 4) { o0 *= 0.18033688011112042f; o1 *= 0.18033688011112042f; }
                        c0 = cbase + j0; c1 = c0 + 16;
                    } else {
                        c0 = cbase + 4 * fq; c1 = c0 + 16; o0 = x0; o1 = x1;
                        if (kind == 5) {
#pragma unroll
                            for (int e = 0; e < 4; ++e) { o0[e] = silu_f(x0[e]); o1[e] = silu_f(x1[e]); }
                        } else if (kind == 6) {
#pragma unroll
                            for (int e = 0; e < 4; ++e) { o0[e] = sigmoid_f(x0[e]); o1[e] = sigmoid_f(x1[e]); }
                        }
                    }
                    u32x2 w0, w1; w0.x = pk2h(o0[0], o0[1]); w0.y = pk2h(o0[2], o0[3]); w1.x = pk2h(o1[0], o1[1]); w1.y = pk2h(o1[2], o1[3]);
                    *(u32x2*)(prow + c0) = w0; *(u32x2*)(prow + c1) = w1;
                }
            }
    }
};
__device__ __forceinline__ void p2_gemm1(Frame& F) {
    pg8::Gemm g{(const h16*)(F.ws + WS_H), (const h16*)(F.ws + WS_WINT), DM, DM, DM};
    SchedG1 S; S.so.init(MLAT, IN_COLS, F.G, (int)blockIdx.x); S.G = F.G; S.c = (int)blockIdx.x;
    EpiP E{(h16*)(F.ws + WS_P), (const float*)(F.ws + WS_ROPE)};
    pg8::gemm_phase<EpiP, SchedG1>(F.lds, g, S, E);
}

__device__ __forceinline__ void p3_ret_local(Frame& F) {
    LAS unsigned char* KF = F.lds; LAS unsigned char* KB = F.lds + 40960; LAS unsigned char* VH = F.lds + 81920;
    const h16* P = (const h16*)(F.ws + WS_P); h16* LST = (h16*)(F.ws + WS_LST);
    const int hi = F.lane >> 5;
    for (int u = F.vcu; u < 16 * 34; u += F.G) {
        const int bh = u / 34, cc = u % 34, b = bh >> 3, h = bh & 7;
        const int row0 = (cc < 2) ? (MLAT + b * CTXL + cc * 128) : (b * SEQ + (cc - 2) * 128);
        const float lgf = -__expf(F.ret_decay[h]), lgb = -__expf(F.ret_decay[8 + h]);
#pragma unroll
        for (int i = 0; i < 4; ++i) { const int q = F.tid + NTHR * i, row = q >> 4, ch = q & 15;
            const h16x8 kv = *(const h16x8*)(P + (size_t)(row0 + row) * IN_COLS + C_RK + h * 128 + ch * 8);
            const float sf = __expf(lgf * (float)(127 - row)), sb = __expf(lgb * (float)row);
            *(LAS h16x8*)(KF + row * 320 + ch * 16) = pack8((float)kv[0] * sf, (float)kv[1] * sf, (float)kv[2] * sf, (float)kv[3] * sf, (float)kv[4] * sf, (float)kv[5] * sf, (float)kv[6] * sf, (float)kv[7] * sf);
            *(LAS h16x8*)(KB + row * 320 + ch * 16) = pack8((float)kv[0] * sb, (float)kv[1] * sb, (float)kv[2] * sb, (float)kv[3] * sb, (float)kv[4] * sb, (float)kv[5] * sb, (float)kv[6] * sb, (float)kv[7] * sb); }
        for (int eh = 0; eh < 2; ++eh) {
            if (eh) __syncthreads();
#pragma unroll
            for (int i = 0; i < 4; ++i) { const int q = F.tid + NTHR * i, row = q >> 4, ch = q & 15;
                *(LAS h16x8*)(VH + row * 320 + ch * 16) = *(const h16x8*)(P + (size_t)(row0 + row) * IN_COLS + C_RV + h * 256 + eh * 128 + ch * 8); }
            __syncthreads();
            const int dir = F.wave >> 2, eb = F.wave & 3; const LAS unsigned char* Kd = dir ? KB : KF;
            f32x16 acc[4];
#pragma unroll
            for (int db = 0; db < 4; ++db) acc[db] = (f32x16){};
#pragma unroll
            for (int ks = 0; ks < 8; ++ks) { const h16x8 a = frag_tr(VH, 320, 16 * ks, 32 * eb, F.lane);
#pragma unroll
                for (int db = 0; db < 4; ++db) { const h16x8 bb = frag_tr(Kd, 320, 16 * ks, 32 * db, F.lane); acc[db] = MFMA32(a, bb, acc[db]); } }
            h16* dst = LST + ((size_t)((dir * 16 + bh) * 34 + cc) * 256 + eh * 128 + eb * 32) * 128;
#pragma unroll
            for (int db = 0; db < 4; ++db)
#pragma unroll
                for (int r = 0; r < 16; ++r) dst[crow(r, hi) * 128 + db * 32 + (F.lane & 31)] = (h16)acc[db][r];
        }
        __syncthreads();
    }
}
__device__ __forceinline__ void p4_ret_scan(Frame& F) {
    const h16* LST = (const h16*)(F.ws + WS_LST); h16* SST = (h16*)(F.ws + WS_SST);
    for (int g = blockIdx.x * NTHR + F.tid; g < 2 * 16 * 4096; g += F.G * NTHR) {
        const int seq = g >> 12, off = (g & 4095) * 8, dir = seq >> 4, bh = seq & 15, h = bh & 7;
        const float cd = __expf(-__expf(F.ret_decay[dir * 8 + h]) * 128.0f);
        const h16* Lp = LST + (size_t)seq * 34 * 32768 + off; h16* Sp = SST + (size_t)seq * 32 * 32768 + off;
        float s[8];
#pragma unroll
        for (int e = 0; e < 8; ++e) s[e] = 0.f;
        if (dir == 0) {
            for (int cc = 0; cc < 33; ++cc) {
                if (cc >= 2) *(h16x8*)(Sp + (size_t)(cc - 2) * 32768) = pack8(s[0], s[1], s[2], s[3], s[4], s[5], s[6], s[7]);
                const h16x8 l = *(const h16x8*)(Lp + (size_t)cc * 32768);
#pragma unroll
                for (int e = 0; e < 8; ++e) s[e] = s[e] * cd + (float)l[e];
            }
            *(h16x8*)(Sp + (size_t)31 * 32768) = pack8(s[0], s[1], s[2], s[3], s[4], s[5], s[6], s[7]);
        } else {
            { const h16x8 l1 = *(const h16x8*)(Lp + (size_t)1 * 32768), l0 = *(const h16x8*)(Lp);
#pragma unroll
              for (int e = 0; e < 8; ++e) s[e] = (float)l1[e] * cd + (float)l0[e]; }
            for (int c = 31; c >= 0; --c) {
                *(h16x8*)(Sp + (size_t)c * 32768) = pack8(s[0], s[1], s[2], s[3], s[4], s[5], s[6], s[7]);
                const h16x8 l = *(const h16x8*)(Lp + (size_t)(c + 2) * 32768);
#pragma unroll
                for (int e = 0; e < 8; ++e) s[e] = s[e] * cd + (float)l[e];
            }
        }
    }
}
__device__ __forceinline__ void p5_ret_out(Frame& F) {
    LAS unsigned char* QL = F.lds; LAS unsigned char* KL = F.lds + 34816; LAS unsigned char* PL = KL; LAS unsigned char* VL = F.lds + 69632;
    LAS float* RED = (LAS float*)(F.lds + 69632 + 73728);
    const h16* P = (const h16*)(F.ws + WS_P); const h16* SST = (const h16*)(F.ws + WS_SST); h16* ARET = (h16*)(F.ws + WS_ACAT);
    const int hi = F.lane >> 5, ln = F.lane & 31, w = F.wave;
    for (int u = F.vcu; u < 512; u += F.G) {
        const int bh = u >> 5, c = u & 31, b = bh >> 3, h = bh & 7, row0 = b * SEQ + c * 128;
        const float lgf = -__expf(F.ret_decay[h]), lgb = -__expf(F.ret_decay[8 + h]);
#pragma unroll
        for (int i = 0; i < 4; ++i) { const int q = F.tid + NTHR * i, row = q >> 4, ch = q & 15; const h16* pr = P + (size_t)(row0 + row) * IN_COLS + h * 128 + ch * 8;
            *(LAS h16x8*)(QL + row * 272 + ch * 16) = *(const h16x8*)(pr + C_RQ); *(LAS h16x8*)(KL + row * 272 + ch * 16) = *(const h16x8*)(pr + C_RK); }
        h16x8 vreg[8];
#pragma unroll
        for (int i = 0; i < 8; ++i) { const int q = F.tid + NTHR * i, row = q >> 5, c32 = q & 31; vreg[i] = *(const h16x8*)(P + (size_t)(row0 + row) * IN_COLS + C_RV + h * 256 + c32 * 8); }
        __syncthreads();
        u32x2 pw[2][4];
        { const int jt = w >> 1;
#pragma unroll
          for (int t2 = 0; t2 < 2; ++t2) { const int ib = 2 * (w & 1) + t2, il = 32 * ib + ln; f32x16 s = (f32x16){};
#pragma unroll
            for (int ks = 0; ks < 8; ++ks) s = MFMA32(frag_row(KL, 272, 32 * jt, 16 * ks, F.lane), frag_row(QL, 272, 32 * ib, 16 * ks, F.lane), s);
#pragma unroll
            for (int r = 0; r < 16; ++r) { const int d = il - (32 * jt + crow(r, hi)); s[r] *= (d >= 0) ? __expf(lgf * (float)d) : __expf(lgb * (float)(-d)); }
#pragma unroll
            for (int r4 = 0; r4 < 4; ++r4) { pw[t2][r4].x = pk2h(s[4 * r4], s[4 * r4 + 1]); pw[t2][r4].y = pk2h(s[4 * r4 + 2], s[4 * r4 + 3]); } } }
        __syncthreads();
        { const int jt = w >> 1;
#pragma unroll
          for (int t2 = 0; t2 < 2; ++t2) { const int il = 32 * (2 * (w & 1) + t2) + ln;
#pragma unroll
            for (int r4 = 0; r4 < 4; ++r4) *(LAS u32x2*)(PL + il * 272 + (32 * jt + 8 * r4 + 4 * hi) * 2) = pw[t2][r4]; } }
#pragma unroll
        for (int i = 0; i < 8; ++i) { const int q = F.tid + NTHR * i, row = q >> 5, c32 = q & 31; *(LAS h16x8*)(VL + row * 576 + c32 * 16) = vreg[i]; }
        __syncthreads();
        f32x16 o[4];
#pragma unroll
        for (int ib = 0; ib < 4; ++ib) o[ib] = (f32x16){};
#pragma unroll
        for (int k16 = 0; k16 < 8; ++k16) { const h16x8 a = frag_tr(VL, 576, 16 * k16, 32 * w, F.lane);
#pragma unroll
            for (int ib = 0; ib < 4; ++ib) o[ib] = MFMA32(a, frag_row(PL, 272, 32 * ib, 16 * k16, F.lane), o[ib]);
            if (k16 & 1) __builtin_amdgcn_sched_barrier(0); }
#pragma unroll
        for (int dir = 0; dir < 2; ++dir) {
            h16 sc[4];
#pragma unroll
            for (int ib = 0; ib < 4; ++ib) { const int il = 32 * ib + ln; sc[ib] = (h16)(dir ? __expf(lgb * (float)(128 - il)) : __expf(lgf * (float)(il + 1))); }
            const h16* Sg = SST + ((size_t)((dir * 16 + bh) * 32 + c) * 256 + 32 * w + ln) * 128 + 8 * hi;
#pragma unroll
            for (int kh = 0; kh < 2; ++kh) {
                h16x8 sa[4];
#pragma unroll
                for (int k4 = 0; k4 < 4; ++k4) sa[k4] = *(const h16x8*)(Sg + 16 * (4 * kh + k4));
#pragma unroll
                for (int k4 = 0; k4 < 4; ++k4) {
#pragma unroll
                    for (int ib = 0; ib < 4; ++ib) o[ib] = MFMA32(sa[k4], frag_row(QL, 272, 32 * ib, 16 * (4 * kh + k4), F.lane) * sc[ib], o[ib]);
                    __builtin_amdgcn_sched_barrier(0); }
            }
        }
#pragma unroll
        for (int ib = 0; ib < 4; ++ib) { float ss = 0.f;
#pragma unroll
            for (int r = 0; r < 16; ++r) ss += o[ib][r] * o[ib][r];
            ss += __shfl_xor(ss, 32);
            if (hi == 0) RED[(w * 4 + ib) * 32 + ln] = ss; }
        __syncthreads();
#pragma unroll
        for (int ib = 0; ib < 4; ++ib) { float tot = 0.f;
#pragma unroll
            for (int ww = 0; ww < 8; ++ww) tot += RED[(ww * 4 + ib) * 32 + ln];
            const float rstd = 1.0f / sqrtf(tot * (1.0f / 256.0f) + EPS);
            const size_t grow = (size_t)(row0 + 32 * ib + ln);
#pragma unroll
            for (int r4 = 0; r4 < 4; ++r4) { const int e = 32 * w + 8 * r4 + 4 * hi;
                const h16x4 gt = *(const h16x4*)(P + grow * IN_COLS + C_RG + h * 256 + e);
                u32x2 wv; wv.x = pk2h(o[ib][4 * r4] * rstd * (float)gt[0], o[ib][4 * r4 + 1] * rstd * (float)gt[1]); wv.y = pk2h(o[ib][4 * r4 + 2] * rstd * (float)gt[2], o[ib][4 * r4 + 3] * rstd * (float)gt[3]);
                *(u32x2*)(ARET + grow * 3072 + h * 256 + e) = wv; } }
        __syncthreads();
    }
}
__device__ __forceinline__ void p6_attn(Frame& F) {
    const h16* P = (const h16*)(F.ws + WS_P); h16* ADIF = (h16*)(F.ws + WS_ACAT) + 2048;
    const int hi = F.lane >> 5, ln = F.lane & 31;
    float lam;
    { const float s1 = wave_sum(F.diff_lambda[F.lane] * F.diff_lambda[64 + F.lane]), s2 = wave_sum(F.diff_lambda[128 + F.lane] * F.diff_lambda[192 + F.lane]); lam = __expf(s1) - __expf(s2) + 0.2f; }
    constexpr int KT0 = 0, VT0 = 34816, KTB = 17408, VTB = 20480;
    LAS float* XB = (LAS float*)F.lds;
    for (int u = F.vcu; u < 512; u += F.G) {
        const int bh = u >> 5, qb = u & 31, b = bh >> 3, h = bh & 7;
        const int cm = F.wave & 1, qs = F.wave >> 1, qrow0 = b * SEQ + qb * 128 + qs * 32;
        h16x8 qf[4];
#pragma unroll
        for (int ks = 0; ks < 4; ++ks) qf[ks] = *(const h16x8*)(P + (size_t)(qrow0 + ln) * IN_COLS + C_DQ + h * 128 + cm * 64 + 16 * ks + 8 * hi);
        f32x16 o[4];
#pragma unroll
        for (int et = 0; et < 4; ++et) o[et] = (f32x16){};
        float mrun = 0.f, lsum = 0.f; f32x16 negm = (f32x16){};
        h16x8 kreg[2], vreg[2];
#define ATT_LOAD(t) do { _Pragma("unroll") for (int i = 0; i < 2; ++i) { const int q = F.tid + NTHR * i, row = q >> 4, ch = q & 15; const int j = (t) * 64 + row; \
            const size_t srow = (j < CTXL) ? (size_t)(MLAT + b * CTXL + j) : (size_t)(b * SEQ + j - CTXL); const h16* pr = P + srow * IN_COLS + h * 128 + ch * 8; \
            kreg[i] = *(const h16x8*)(pr + C_DK); vreg[i] = *(const h16x8*)(pr + C_DV); } } while (0)
#define ATT_WRITE(buf) do { _Pragma("unroll") for (int i = 0; i < 2; ++i) { const int q = F.tid + NTHR * i, row = q >> 4, ch = q & 15; \
            *(LAS h16x8*)(F.lds + KT0 + (buf) * KTB + row * 272 + ch * 16) = kreg[i]; *(LAS h16x8*)(F.lds + VT0 + (buf) * VTB + row * 320 + ch * 16) = vreg[i]; } } while (0)
        ATT_LOAD(0); ATT_WRITE(0);
        __syncthreads();
        constexpr int NT = (CTXL + SEQ) / 64;
        for (int t = 0; t < NT; ++t) {
            const int buf = t & 1;
            if (t + 1 < NT) ATT_LOAD(t + 1);
            const LAS unsigned char* Kt = F.lds + KT0 + buf * KTB; const LAS unsigned char* Vt = F.lds + VT0 + buf * VTB;
            f32x16 s[2];
#pragma unroll
            for (int kt = 0; kt < 2; ++kt) { s[kt] = negm;
#pragma unroll
                for (int ks = 0; ks < 4; ++ks) s[kt] = MFMA32(frag_row(Kt, 272, 32 * kt, cm * 64 + 16 * ks, F.lane), qf[ks], s[kt]); }
            float mx = s[0][0];
#pragma unroll
            for (int r = 0; r < 16; ++r) { mx = fmaxf(mx, s[0][r]); mx = fmaxf(mx, s[1][r]); }
            { const auto rr = __builtin_amdgcn_permlane32_swap(__float_as_uint(mx), __float_as_uint(mx), false, false); mx = fmaxf(__uint_as_float(rr[0]), __uint_as_float(rr[1])); }
            if (t == 0 || __any(mx > 8.0f)) { const float dl = (t == 0) ? mx : fmaxf(mx, 0.0f), alpha = (t == 0) ? 0.0f : __builtin_amdgcn_exp2f(-dl); mrun += dl; lsum *= alpha;
#pragma unroll
                for (int et = 0; et < 4; ++et) o[et] *= alpha;
#pragma unroll
                for (int kt = 0; kt < 2; ++kt)
#pragma unroll
                    for (int r = 0; r < 16; ++r) s[kt][r] -= dl;
#pragma unroll
                for (int r = 0; r < 16; ++r) negm[r] = -mrun; }
            f32x2 ps2 = {0.f, 0.f};
#pragma unroll
            for (int kt = 0; kt < 2; ++kt)
#pragma unroll
                for (int r = 0; r < 16; r += 2) { s[kt][r] = __builtin_amdgcn_exp2f(s[kt][r]); s[kt][r + 1] = __builtin_amdgcn_exp2f(s[kt][r + 1]); ps2 += (f32x2){s[kt][r], s[kt][r + 1]}; }
            lsum += ps2[0] + ps2[1];
#pragma unroll
            for (int kt = 0; kt < 2; ++kt)
#pragma unroll
                for (int s2 = 0; s2 < 2; ++s2) {
                    const h16x8 pbf = pack8(s[kt][8 * s2], s[kt][8 * s2 + 1], s[kt][8 * s2 + 2], s[kt][8 * s2 + 3], s[kt][8 * s2 + 4], s[kt][8 * s2 + 5], s[kt][8 * s2 + 6], s[kt][8 * s2 + 7]);
#pragma unroll
                    for (int et = 0; et < 4; ++et) o[et] = MFMA32(frag_tr_perm(Vt, 320, 32 * kt + 16 * s2, 32 * et, F.lane), pbf, o[et]);
                }
            if (t + 1 < NT) ATT_WRITE(buf ^ 1);
            __syncthreads();
        }
#undef ATT_LOAD
#undef ATT_WRITE
        lsum += __shfl_xor(lsum, 32);
        const float inv = 1.0f / lsum;
        if (cm == 1) {
#pragma unroll
            for (int et = 0; et < 4; ++et)
#pragma unroll
                for (int r = 0; r < 16; ++r) XB[(qs * 128 + 32 * et + crow(r, hi)) * 32 + ln] = o[et][r] * inv;
        }
        __syncthreads();
        if (cm == 0) {
            float ss = 0.f;
#pragma unroll
            for (int et = 0; et < 4; ++et)
#pragma unroll
                for (int r = 0; r < 16; ++r) { const float v = o[et][r] * inv - lam * XB[(qs * 128 + 32 * et + crow(r, hi)) * 32 + ln]; o[et][r] = v; ss += v * v; }
            ss += __shfl_xor(ss, 32);
            const float rstd = 0.8f / sqrtf(ss * (1.0f / 128.0f) + EPS);
            const size_t grow = (size_t)(qrow0 + ln);
#pragma unroll
            for (int et = 0; et < 4; ++et)
#pragma unroll
                for (int r4 = 0; r4 < 4; ++r4) { const int e = 32 * et + 8 * r4 + 4 * hi; const f32x4 sw = *(const f32x4*)(F.diff_subln + e);
                    u32x2 w; w.x = pk2h(o[et][4 * r4] * rstd * sw[0], o[et][4 * r4 + 1] * rstd * sw[1]); w.y = pk2h(o[et][4 * r4 + 2] * rstd * sw[2], o[et][4 * r4 + 3] * rstd * sw[3]);
                    *(u32x2*)(ADIF + grow * 3072 + h * 128 + e) = w; }
        }
        __syncthreads();
    }
}
struct SchedG2 {
    pg8::StaticOrder so;
    __device__ __forceinline__ bool next(int i, pg8::Unit& u) const { if (!so.next(i >> 1, u)) return false; if (i & 1) { u.ko = 2048; u.nt = 16; u.keep = 0; } else { u.ko = 0; u.nt = 32; u.keep = 1; } return true; }
};
struct EpiU2 {
    h16* U; const h16* P;
    __device__ __forceinline__ void operator()(f32x4 (&acc)[2][2][4][2], const pg8::Unit& u, int wr, int wc, int fr, int fq) const {
#pragma unroll
        for (int ai = 0; ai < 2; ++ai)
#pragma unroll
            for (int m = 0; m < 4; ++m) { const int row = u.pm * 256 + ai * 128 + wr * 64 + m * 16 + fr;
#pragma unroll
                for (int bj = 0; bj < 2; ++bj)
#pragma unroll
                    for (int n = 0; n < 2; ++n) { const int col = u.pn * 256 + bj * 128 + wc * 32 + 16 * n + 4 * fq;
                        const h16x4 gd = *(const h16x4*)(P + (size_t)row * IN_COLS + C_GD + col);
                        if (u.keep) { const h16x4 gr = *(const h16x4*)(P + (size_t)row * IN_COLS + C_GR + col);
#pragma unroll
                            for (int e = 0; e < 4; ++e) acc[ai][bj][m][n][e] *= (float)gr[e] * __builtin_amdgcn_rcpf((float)gd[e]);
                        } else { const f32x4 a = acc[ai][bj][m][n];
                            u32x2 w; w.x = pk2h(a[0] * (float)gd[0], a[1] * (float)gd[1]); w.y = pk2h(a[2] * (float)gd[2], a[3] * (float)gd[3]);
                            *(u32x2*)(U + (size_t)row * DM + col) = w; } } }
    }
};
struct EpiX1 {
    float* X1; const float* x; const float* MOD;
    __device__ __forceinline__ void operator()(f32x4 (&acc)[2][2][4][2], const pg8::Unit& u, int wr, int wc, int fr, int fq) const {
        const int b = (u.pm * 256) / SEQ;
#pragma unroll
        for (int ai = 0; ai < 2; ++ai)
#pragma unroll
            for (int m = 0; m < 4; ++m) { const int row = u.pm * 256 + ai * 128 + wr * 64 + m * 16 + fr;
#pragma unroll
                for (int bj = 0; bj < 2; ++bj)
#pragma unroll
                    for (int n = 0; n < 2; ++n) { const int col = u.pn * 256 + bj * 128 + wc * 32 + 16 * n + 4 * fq;
                        const f32x4 g1 = *(const f32x4*)(MOD + (size_t)b * (6 * DM) + 2 * DM + col); const f32x4 xv = *(const f32x4*)(x + (size_t)row * DM + col);
                        *(f32x4*)(X1 + (size_t)row * DM + col) = xv + g1 * acc[ai][bj][m][n]; } }
    }
};
__device__ __forceinline__ void p7_gemm2(Frame& F) {
    pg8::Gemm g{(const h16*)(F.ws + WS_ACAT), (const h16*)(F.ws + WS_WCAT), 3072, 3072, 2048};
    SchedG2 S; S.so.init(MLAT, DM, F.G, (int)blockIdx.x);
    EpiU2 E{(h16*)(F.ws + WS_U), (const h16*)(F.ws + WS_P)};
    pg8::gemm_phase<EpiU2, SchedG2>(F.lds, g, S, E);
}
__device__ __forceinline__ void p9_gemm3(Frame& F) {
    pg8::Gemm g{(const h16*)(F.ws + WS_U), (const h16*)(F.ws + WS_WOUT), 2048, 2048, 2048};
    pg8::StaticOrder S; S.init(MLAT, DM, F.G, (int)blockIdx.x);
    EpiX1 E{(float*)(F.ws + WS_X1), F.x, (const float*)(F.ws + WS_MOD)};
    pg8::gemm_phase<EpiX1, pg8::StaticOrder>(F.lds, g, S, E);
}


__device__ __forceinline__ void p10_norm2(Frame& F) {
    const float* X1 = (const float*)(F.ws + WS_X1); const float* MOD = (const float*)(F.ws + WS_MOD); h16* H2X = (h16*)(F.ws + WS_H2X);
    const int gw = F.vcu * NWAVES + F.wave, NGW = F.G * NWAVES;
    for (int r = gw; r < MLAT; r += NGW) {
        const float* src = X1 + (size_t)r * DM; const int b = r / SEQ;
        f32x4 xv[8]; float ss = 0.f;
#pragma unroll
        for (int j = 0; j < 8; ++j) { xv[j] = *(const f32x4*)(src + 4 * F.lane + 256 * j); ss += (xv[j].x * xv[j].x + xv[j].y * xv[j].y) + (xv[j].z * xv[j].z + xv[j].w * xv[j].w); }
        const float rstd = 1.0f / sqrtf(wave_sum(ss) * (1.0f / DM) + EPS);
#pragma unroll
        for (int j = 0; j < 8; ++j) { const int cc = 4 * F.lane + 256 * j; const f32x4 nw = *(const f32x4*)(F.norm_ffn + cc);
            const f32x4 sh = *(const f32x4*)(MOD + (size_t)b * (6 * DM) + 3 * DM + cc), sc = *(const f32x4*)(MOD + (size_t)b * (6 * DM) + 4 * DM + cc);
            const f32x4 y = xv[j] * rstd * nw * (sc + 1.0f) + sh;
            h16 hh[4], ll[4];
#pragma unroll
            for (int e = 0; e < 4; ++e) { hh[e] = (h16)y[e]; ll[e] = (h16)(y[e] - (float)hh[e]); }
            h16* dst = H2X + (size_t)r * 6144 + cc;
            *(h16x4*)(dst) = (h16x4){hh[0], hh[1], hh[2], hh[3]}; *(h16x4*)(dst + 4096) = (h16x4){hh[0], hh[1], hh[2], hh[3]}; *(h16x4*)(dst + 2048) = (h16x4){ll[0], ll[1], ll[2], ll[3]};
            { int p8 = __builtin_amdgcn_cvt_pk_fp8_f32(y[0], y[1], 0, false); p8 = __builtin_amdgcn_cvt_pk_fp8_f32(y[2], y[3], p8, true); *(int*)((unsigned char*)(F.ws + WS_H2F8) + (size_t)r * DM + cc) = p8; } }
    }
}
struct SchedRT {
    int G, c;
    __device__ __forceinline__ bool next(int i, pg8::Unit& u) const { const int L = i * G + c; if (L >= 256) return false; u.pm = L >> 3; u.pn = 0; u.ko = (L & 7) * 768; u.nt = 0; u.keep = 0; return true; }
};
struct EpiLG {
    float* LGP;
    __device__ __forceinline__ void operator()(f32x4 (&acc)[2][2][4][2], const pg8::Unit& u, int wr, int wc, int fr, int fq) const {
        float* dst = LGP + (size_t)(u.ko / 768) * MLAT * NEXP;
#pragma unroll
        for (int ai = 0; ai < 2; ++ai)
#pragma unroll
            for (int m = 0; m < 4; ++m) { const int row = u.pm * 256 + ai * 128 + wr * 64 + m * 16 + fr;
#pragma unroll
                for (int bj = 0; bj < 2; ++bj)
#pragma unroll
                    for (int n = 0; n < 2; ++n) { const int col = bj * 128 + wc * 32 + 16 * n + 4 * fq; *(f32x4*)(dst + (size_t)row * NEXP + col) = acc[ai][bj][m][n]; } }
    }
};
__device__ __forceinline__ void p11_router(Frame& F) {
    pg8::Gemm g{(const h16*)(F.ws + WS_H2X), (const h16*)(F.ws + WS_WRTR), 6144, 6144, 768};
    SchedRT S; S.G = F.G; S.c = (int)blockIdx.x;
    EpiLG E{(float*)(F.ws + WS_LGP)};
    pg8::gemm_phase<EpiLG, SchedRT>(F.lds, g, S, E);
}
__device__ __forceinline__ void p12_topk(Frame& F) {
    const float* LGP = (const float*)(F.ws + WS_LGP); int* EIDX = (int*)(F.ws + WS_EIDX); float* EW = (float*)(F.ws + WS_EW); u32x2* LIST = (u32x2*)(F.ws + WS_LIST2);
    unsigned* CNT = (unsigned*)(F.ws + WS_CTL) + CW_CNT;
    const int gw = F.vcu * NWAVES + F.wave, NGW = F.G * NWAVES, lane = F.lane;
    const f32x4 bias = *(const f32x4*)(F.router_bias + 4 * lane);
    f32x4 lgn[8];
#pragma unroll
    for (int ks = 0; ks < 8; ++ks) lgn[ks] = *(const f32x4*)(LGP + ((size_t)ks * MLAT + (gw < MLAT ? gw : 0)) * NEXP + 4 * lane);
    for (int t = gw; t < MLAT; t += NGW) {
        f32x4 lg = lgn[0];
#pragma unroll
        for (int ks = 1; ks < 8; ++ks) lg += lgn[ks];
        { const int tn = (t + NGW < MLAT) ? t + NGW : t;
#pragma unroll
          for (int ks = 0; ks < 8; ++ks) lgn[ks] = *(const f32x4*)(LGP + ((size_t)ks * MLAT + tn) * NEXP + 4 * lane); }
        float sc[4], sel[4];
#pragma unroll
        for (int i = 0; i < 4; ++i) { sc[i] = 1.0f / (1.0f + __expf(-lg[i])); sel[i] = sc[i] + bias[i]; }
        float a1 = fmaxf(sel[0], sel[1]), a2 = fminf(sel[0], sel[1]);
        { const float b1 = fmaxf(sel[2], sel[3]), b2 = fminf(sel[2], sel[3]); const float n1 = fmaxf(a1, b1), n2 = fmaxf(fminf(a1, b1), fmaxf(a2, b2)); a1 = n1; a2 = n2; }
#pragma unroll
        for (int off = 1; off < 8; off <<= 1) { const float b1 = __shfl_xor(a1, off), b2 = __shfl_xor(a2, off); const float n1 = fmaxf(a1, b1), n2 = fmaxf(fminf(a1, b1), fmaxf(a2, b2)); a1 = n1; a2 = n2; }
        const float gs = a1 + a2; const int g = lane >> 3;
        int rank = 0;
#pragma unroll
        for (int j = 0; j < 8; ++j) { const float o = __shfl(gs, 8 * j); rank += (o > gs || (o == gs && j < g)) ? 1 : 0; }
        const bool gsel = rank < 4;
        float ms[4];
#pragma unroll
        for (int i = 0; i < 4; ++i) ms[i] = gsel ? sel[i] : -INFINITY;
        float myw = 0.f; int mye = 0; float wsum = 0.f;
#pragma unroll
        for (int k = 0; k < TOPK; ++k) {
            float bv = ms[0]; int bi = 4 * lane;
#pragma unroll
            for (int i = 1; i < 4; ++i) if (ms[i] > bv) { bv = ms[i]; bi = 4 * lane + i; }
#pragma unroll
            for (int off = 1; off < 64; off <<= 1) { const float ov = __shfl_xor(bv, off); const int oi = __shfl_xor(bi, off); if (ov > bv || (ov == bv && oi < bi)) { bv = ov; bi = oi; } }
            const int ol = bi >> 2, oi = bi & 3;
            const float mysc = (oi == 0) ? sc[0] : (oi == 1) ? sc[1] : (oi == 2) ? sc[2] : sc[3];
            const float w = __shfl(mysc, ol);
            if (lane == ol) {
#pragma unroll
                for (int i = 0; i < 4; ++i) if (i == oi) ms[i] = -INFINITY; }
            wsum += w;
            if (lane == k) { myw = w; mye = bi; }
        }
        if (lane < TOPK) {
            const float wn = myw / wsum * 2.5f;
            EIDX[t * TOPK + lane] = mye; EW[t * TOPK + lane] = wn;
            const unsigned pos = atomicAdd(&CNT[mye], 1u);
            LIST[mye * MLAT + pos] = (u32x2){(unsigned)(t * TOPK + lane), __float_as_uint(wn)};
        }
    }
}
constexpr int EX_NSTG = 3, EX_ASTG = 24576, EX_WSTG = 16384, EX_A0 = 0, EX_W0 = EX_NSTG * EX_ASTG, EX_WH0 = EX_W0 + EX_NSTG * EX_WSTG, EX_WHS = 10240, EX_ROW0 = EX_WH0 + 2 * EX_WHS;
constexpr int EX_TAB0 = EX_ROW0 + 3200, EX_SCR0 = EX_TAB0 + 3072;
static_assert(EX_ROW0 == 143360 && EX_SCR0 + 8192 <= LDSCTL_OFF, "expert LDS map");
template <bool GU>
__device__ __forceinline__ void ring_w_prologue(Frame& F, const float* W, int cgrp) {
    constexpr int LDB = GU ? 512 : 2048;
    const int lane = F.lane, w = F.wave, v = 4 * (lane & 31);
    const int wcol0 = GU ? (((v >> 5) & 1) * 256 + 32 * (v >> 6) + (v & 31) + 64 * cgrp) : (v + 512 * cgrp);
    const float* wlane = W + (size_t)(4 * w + (lane >> 5)) * LDB + wcol0;
#pragma unroll
    for (int s = 0; s < 3; ++s)
#pragma unroll
        for (int j = 0; j < 2; ++j) __builtin_amdgcn_global_load_lds((const unsigned*)(wlane + (size_t)(s * 32 + 2 * j) * LDB), (LAS unsigned*)(F.lds + EX_W0 + s * EX_WSTG + (2 * w + j) * 1024), 16, 0, 2);
}
template <bool GU, int NLAY>
__device__ __forceinline__ void expert_ring(Frame& F, const float* W, const h16* Abase, const int (&arow)[3], int nr, int cgrp, h16* ACTrow0, h16* Y) {
    constexpr int KT = GU ? 64 : 8, NP = GU ? 1 : 4, LDB = GU ? 512 : 2048, NS = KT * NP;
    const int tid = F.tid, lane = F.lane, hi = lane >> 5, ln = lane & 31, cp = F.wave & 1, rg = F.wave >> 1, w = F.wave;
    const LAS int* RSLOT = (const LAS int*)(F.lds + EX_ROW0); const LAS float* RW = (const LAS float*)(F.lds + EX_ROW0 + 1536);
    const int ngrp = (nr + 15) >> 4;
    const int nA = (w < ngrp ? 1 : 0) + (w + 8 < ngrp ? 1 : 0) + (w + 16 < ngrp ? 1 : 0);
    const int achunk = ((lane & 3) ^ ((lane >> 4) & 3)) * 8;
    const int v = 4 * (lane & 31);
    const int wcol0 = GU ? (((v >> 5) & 1) * 256 + 32 * (v >> 6) + (v & 31) + 64 * cgrp) : (v + 512 * cgrp);
    const float* wlane = W + (size_t)(4 * w + (lane >> 5)) * LDB + wcol0;
    const unsigned lds0 = (unsigned)(uintptr_t)F.lds;
    const int xs = (ln >> 2) & 3;
    const unsigned aofs0 = (unsigned)((2 * rg + (ln >> 4)) * 1024 + (ln & 15) * 64 + ((hi ^ xs) * 16)), aofs1 = (unsigned)((2 * rg + (ln >> 4)) * 1024 + (ln & 15) * 64 + (((2 + hi) ^ xs) * 16));
    const unsigned tofs = (unsigned)((8 * hi + ((lane & 15) >> 2)) * 320 + (64 * cp + 16 * ((lane >> 4) & 1) + 4 * (lane & 3)) * 2);
    f32x16 acc[2 * NLAY];
#pragma unroll
    for (int i = 0; i < 2 * NLAY; ++i) acc[i] = (f32x16){};
#define EX_DMA_A(s) do { const int kt_ = (s) % KT, stg_ = (s) % EX_NSTG; \
        _Pragma("unroll") for (int j = 0; j < 3; ++j) if (j < nA) __builtin_amdgcn_global_load_lds((const unsigned*)(Abase + arow[j] + kt_ * 32 + achunk), (LAS unsigned*)(F.lds + EX_A0 + stg_ * EX_ASTG + (w + 8 * j) * 1024), 16, 0, 0); } while (0)
#define EX_DMA_W(s) do { const int pass_ = (s) / KT, kt_ = (s) % KT, stg_ = (s) % EX_NSTG; \
        _Pragma("unroll") for (int j = 0; j < 2; ++j) __builtin_amdgcn_global_load_lds((const unsigned*)(wlane + (size_t)(kt_ * 32 + 2 * j) * LDB + 128 * pass_), (LAS unsigned*)(F.lds + EX_W0 + stg_ * EX_WSTG + (2 * w + j) * 1024), 16, 0, 2); } while (0)
#define EX_WAITV(k) asm volatile("s_waitcnt vmcnt(" #k ")" ::: "memory")
#define EX_WAITN() do { if (nA == 3) EX_WAITV(5); else if (nA == 2) EX_WAITV(4); else if (nA == 1) EX_WAITV(3); else EX_WAITV(2); } while (0)
    const unsigned cvsrc = lds0 + EX_W0 + (tid >> 4) * 512 + (tid & 15) * 32, cvdst = lds0 + EX_WH0 + (tid >> 4) * 320 + (tid & 15) * 16;
    EX_DMA_A(0); EX_DMA_A(1);
    if (nA == 3) EX_WAITV(3); else if (nA == 2) EX_WAITV(2); else if (nA == 1) EX_WAITV(1); else EX_WAITV(0);
    __builtin_amdgcn_s_barrier(); asm volatile("" ::: "memory");
    { f32x4 c0, c1; asm volatile("ds_read_b128 %0, %2\n\tds_read_b128 %1, %2 offset:16\n\ts_waitcnt lgkmcnt(0)" : "=&v"(c0), "=&v"(c1) : "v"(cvsrc) : "memory");
      const h16x8 hv = pack8(c0[0], c0[1], c0[2], c0[3], c1[0], c1[1], c1[2], c1[3]); asm volatile("ds_write_b128 %0, %1" :: "v"(cvdst), "v"(hv) : "memory"); }
    typedef short s16x8 __attribute__((ext_vector_type(8)));
    for (int s = 0; s < NS; ++s) {
        if (s + 2 < NS) EX_WAITN(); else EX_WAITV(0);
        asm volatile("s_waitcnt lgkmcnt(0)" ::: "memory");
        __builtin_amdgcn_s_barrier();
        asm volatile("" ::: "memory");
        const bool pend = ((s % KT) == KT - 1);
        if (!pend) { if (s + 2 < NS) EX_DMA_A(s + 2); if (s + 3 < NS) EX_DMA_W(s + 3); }
        const unsigned abase = lds0 + EX_A0 + (s % EX_NSTG) * EX_ASTG, wbase = lds0 + EX_WH0 + (s & 1) * EX_WHS + tofs;
        const unsigned cs = cvsrc + ((s + 1) % EX_NSTG) * EX_WSTG;
        const unsigned pa0 = abase + aofs0, pa1 = abase + aofs1;
        if constexpr (NLAY < 3) {
            v4i16_t t0, t1, t2, t3, t4, t5, t6, t7; h16x8 a0[NLAY], a1[NLAY];
            asm volatile("ds_read_b64_tr_b16 %0, %8\n\tds_read_b64_tr_b16 %1, %8 offset:1280\n\tds_read_b64_tr_b16 %2, %8 offset:64\n\tds_read_b64_tr_b16 %3, %8 offset:1344\n\t"
                         "ds_read_b64_tr_b16 %4, %8 offset:5120\n\tds_read_b64_tr_b16 %5, %8 offset:6400\n\tds_read_b64_tr_b16 %6, %8 offset:5184\n\tds_read_b64_tr_b16 %7, %8 offset:6464"
                         : "=&v"(t0), "=&v"(t1), "=&v"(t2), "=&v"(t3), "=&v"(t4), "=&v"(t5), "=&v"(t6), "=&v"(t7) : "v"(wbase) : "memory");
            asm volatile("ds_read_b128 %0, %2\n\tds_read_b128 %1, %3" : "=&v"(a0[0]), "=&v"(a1[0]) : "v"(pa0), "v"(pa1) : "memory");
            if constexpr (NLAY >= 2) asm volatile("ds_read_b128 %0, %2 offset:8192\n\tds_read_b128 %1, %3 offset:8192" : "=&v"(a0[1]), "=&v"(a1[1]) : "v"(pa0), "v"(pa1) : "memory");
            asm volatile("s_waitcnt lgkmcnt(0)" ::: "memory");
            __builtin_amdgcn_sched_barrier(0);
            const h16x8 b00 = __builtin_bit_cast(h16x8, (s16x8){t0[0], t0[1], t0[2], t0[3], t1[0], t1[1], t1[2], t1[3]}), b01 = __builtin_bit_cast(h16x8, (s16x8){t2[0], t2[1], t2[2], t2[3], t3[0], t3[1], t3[2], t3[3]});
            const h16x8 b10 = __builtin_bit_cast(h16x8, (s16x8){t4[0], t4[1], t4[2], t4[3], t5[0], t5[1], t5[2], t5[3]}), b11 = __builtin_bit_cast(h16x8, (s16x8){t6[0], t6[1], t6[2], t6[3], t7[0], t7[1], t7[2], t7[3]});
#pragma unroll
            for (int i = 0; i < NLAY; ++i) { acc[2 * i] = MFMA32(a0[i], b00, acc[2 * i]); acc[2 * i + 1] = MFMA32(a0[i], b01, acc[2 * i + 1]); }
#pragma unroll
            for (int i = 0; i < NLAY; ++i) { acc[2 * i] = MFMA32(a1[i], b10, acc[2 * i]); acc[2 * i + 1] = MFMA32(a1[i], b11, acc[2 * i + 1]); }
        } else {
#pragma unroll
            for (int k16 = 0; k16 < 2; ++k16) {
                v4i16_t t0, t1, t2, t3; h16x8 a[3]; const unsigned pa = k16 ? pa1 : pa0, pw = wbase + k16 * 5120;
                asm volatile("ds_read_b64_tr_b16 %0, %4\n\tds_read_b64_tr_b16 %1, %4 offset:1280\n\tds_read_b64_tr_b16 %2, %4 offset:64\n\tds_read_b64_tr_b16 %3, %4 offset:1344"
                             : "=&v"(t0), "=&v"(t1), "=&v"(t2), "=&v"(t3) : "v"(pw) : "memory");
                asm volatile("ds_read_b128 %0, %3\n\tds_read_b128 %1, %3 offset:8192\n\tds_read_b128 %2, %3 offset:16384\n\ts_waitcnt lgkmcnt(0)" : "=&v"(a[0]), "=&v"(a[1]), "=&v"(a[2]) : "v"(pa) : "memory");
                __builtin_amdgcn_sched_barrier(0);
                const h16x8 b0 = __builtin_bit_cast(h16x8, (s16x8){t0[0], t0[1], t0[2], t0[3], t1[0], t1[1], t1[2], t1[3]}), b1 = __builtin_bit_cast(h16x8, (s16x8){t2[0], t2[1], t2[2], t2[3], t3[0], t3[1], t3[2], t3[3]});
#pragma unroll
                for (int i = 0; i < 3; ++i) { acc[2 * i] = MFMA32(a[i], b0, acc[2 * i]); acc[2 * i + 1] = MFMA32(a[i], b1, acc[2 * i + 1]); }
                __builtin_amdgcn_sched_barrier(0);
            }
        }
        if (s + 1 < NS) {
            f32x4 c0, c1; asm volatile("ds_read_b128 %0, %2\n\tds_read_b128 %1, %2 offset:16\n\ts_waitcnt lgkmcnt(0)" : "=&v"(c0), "=&v"(c1) : "v"(cs) : "memory");
            const h16x8 hv = pack8(c0[0], c0[1], c0[2], c0[3], c1[0], c1[1], c1[2], c1[3]); const unsigned cd = cvdst + ((s + 1) & 1) * EX_WHS; asm volatile("ds_write_b128 %0, %1" :: "v"(cd), "v"(hv) : "memory"); }
        if (pend) {
            const int pass = s / KT;
            int hio = hi, lno = ln; asm volatile("" : "+v"(hio), "+v"(lno));
            if (GU) {
#pragma unroll
                for (int i = 0; i < NLAY; ++i) { const int rt = rg + 4 * i;
#pragma unroll
                    for (int r = 0; r < 16; ++r) { const int row = 32 * rt + crow(r, hio);
                        if (row < nr) ACTrow0[(size_t)row * DEXP + 64 * cgrp + 32 * cp + lno] = (h16)(silu_f(acc[2 * i][r]) * acc[2 * i + 1][r]); }
                    acc[2 * i] = (f32x16){}; acc[2 * i + 1] = (f32x16){}; }
            } else {
                const unsigned scr = lds0 + EX_SCR0 + w * 1024;
                unsigned char* Y8 = (unsigned char*)Y;
#pragma unroll
                for (int i = 0; i < NLAY; ++i) { const int rt = rg + 4 * i;
#pragma unroll
                    for (int g8 = 0; g8 < 4; ++g8) {
#pragma unroll
                        for (int q = 0; q < 4; ++q) { const int lr = 4 * hio + q; const float wt = RW[32 * rt + 8 * g8 + lr];
                            const int pk = __builtin_amdgcn_cvt_pk_fp8_f32(acc[2 * i][4 * g8 + q] * wt, acc[2 * i + 1][4 * g8 + q] * wt, 0, false); const int pk1 = pk >> 8; const unsigned wa = scr + lr * 64 + lno;
                            asm volatile("ds_write_b8 %0, %1\n\tds_write_b8 %0, %2 offset:32" :: "v"(wa), "v"(pk), "v"(pk1) : "memory"); }
                        u32x2 pv; const unsigned ra = scr + (lane >> 3) * 64 + (lane & 7) * 8;
                        asm volatile("s_waitcnt lgkmcnt(0)\n\tds_read_b64 %0, %1\n\ts_waitcnt lgkmcnt(0)" : "=&v"(pv) : "v"(ra) : "memory");
                        const int grow = 32 * rt + 8 * g8 + (lane >> 3);
                        if (grow < nr) { const int slot = RSLOT[grow]; *(u32x2*)(Y8 + (size_t)slot * DM + 512 * cgrp + 128 * pass + 64 * cp + (lane & 7) * 8) = pv; }
                    }
                    acc[2 * i] = (f32x16){}; acc[2 * i + 1] = (f32x16){}; }
            }
            if (s + 2 < NS) EX_DMA_A(s + 2);
            if (s + 3 < NS) EX_DMA_W(s + 3);
        }
    }
    asm volatile("s_waitcnt vmcnt(0) lgkmcnt(0)" ::: "memory");
    __builtin_amdgcn_s_barrier();
    asm volatile("" ::: "memory");
#undef EX_DMA_A
#undef EX_DMA_W
#undef EX_WAITV
#undef EX_WAITN
}

constexpr int G8_NSTG = 4, G8_ASTG = 12288, G8_WSTG = 16384, G8_A0 = 0, G8_W0 = G8_NSTG * G8_ASTG, G8_WH0 = G8_W0 + G8_NSTG * G8_WSTG, G8_WHS = 4096;
constexpr int G8_SCR0 = G8_WH0 + 2 * G8_WHS;
static_assert(G8_SCR0 + 8 * 2048 <= EX_ROW0, "gu8 LDS map");
template <bool GU>
__device__ __forceinline__ void ring8_w_prologue(Frame& F, const float* W, int cgrp) {
    constexpr int LDB = GU ? 512 : 2048;
    const int lane = F.lane, w = F.wave, v = 4 * (lane & 31);
    if (w >= 4) return;
    const int wcol0 = GU ? (((v >> 5) & 1) * 256 + 32 * (v >> 6) + (v & 31) + 64 * cgrp) : (v + 512 * cgrp);
    const char* Wu = uni_ptr((const char*)W);
    const unsigned wvo = (unsigned)(((8 * w + (lane >> 5)) * LDB + wcol0) * 4);
#pragma unroll
    for (int s = 0; s < 4; ++s)
#pragma unroll
        for (int j = 0; j < 4; ++j) __builtin_amdgcn_global_load_lds((const unsigned*)(Wu + (size_t)(s * 32 + 2 * j) * LDB * 4 + (size_t)wvo), (LAS unsigned*)(F.lds + G8_W0 + s * G8_WSTG + (4 * w + j) * 1024), 16, 0, 2);
}
template <bool GU, int NLAY>
__device__ __forceinline__ void expert_ring8(Frame& F, const float* W, const unsigned char* A8, const int ap0, const int ap1, int nr, int cgrp, unsigned char* ACT8row0, unsigned char* Y8) {
    constexpr int KT = GU ? 64 : 8, NP = GU ? 1 : 4, LDB = GU ? 512 : 2048, NS = KT * NP;
    typedef long v2i64 __attribute__((ext_vector_type(2)));
    const int tid = F.tid, lane = F.lane, hi = lane >> 5, ln = lane & 31, cp = F.wave & 1, rg = F.wave >> 1, w = F.wave;
    const LAS int* RSLOT = (const LAS int*)(F.lds + EX_ROW0); const LAS float* RW = (const LAS float*)(F.lds + EX_ROW0 + 1536);
    const int ngrp = (nr + 31) >> 5;
    const bool ldr = w < 4;
    const int nA = ldr ? NLAY : 0;
    const unsigned avo0 = (unsigned)((ap0 & 0xffff) * (GU ? DM : DEXP) + (lane & 1) * 16), avo1 = (unsigned)((int)((unsigned)ap0 >> 16) * (GU ? DM : DEXP) + (lane & 1) * 16), avo2 = (unsigned)(ap1 * (GU ? DM : DEXP) + (lane & 1) * 16);
    const int v = 4 * (lane & 31);
    const int wcol0 = GU ? (((v >> 5) & 1) * 256 + 32 * (v >> 6) + (v & 31) + 64 * cgrp) : (v + 512 * cgrp);
    const char* Wu = uni_ptr((const char*)W); const char* Au = uni_ptr((const char*)A8);
    const unsigned wvo = (unsigned)(((8 * w + (lane >> 5)) * LDB + wcol0) * 4);
    const unsigned lds0 = (unsigned)(uintptr_t)F.lds;
    const unsigned aofs = (unsigned)(rg * 1024 + ln * 32 + hi * 16);
    const unsigned bofs = (unsigned)((64 * cp + ln) * 32 + hi * 16);
    const unsigned cvsrc = lds0 + G8_W0 + (tid >> 7) * 8 * 512 + (tid & 127) * 4, cvdst = lds0 + G8_WH0 + (tid & 127) * 32 + (tid >> 7) * 8;
    f32x16 acc[2 * NLAY];
#pragma unroll
    for (int i = 0; i < 2 * NLAY; ++i) acc[i] = (f32x16){};
#define G8_DMA_A(s) do { const int stg_ = (s) & 3, kt_ = (s) % KT; \
        if (ldr) { _Pragma("unroll") for (int j = 0; j < NLAY; ++j) { const unsigned vo_ = j == 0 ? avo0 : j == 1 ? avo1 : avo2; \
            __builtin_amdgcn_global_load_lds((const unsigned*)(Au + kt_ * 32 + (size_t)vo_), (LAS unsigned*)(F.lds + G8_A0 + stg_ * G8_ASTG + (w + 4 * j) * 1024), 16, 0, 0); } } } while (0)
#define G8_DMA_W(s) do { const int stg_ = (s) & 3, kt_ = (s) % KT, pass_ = (s) / KT; \
        if (ldr) { _Pragma("unroll") for (int j = 0; j < 4; ++j) __builtin_amdgcn_global_load_lds((const unsigned*)(Wu + ((size_t)(kt_ * 32 + 2 * j) * LDB + 128 * pass_) * 4 + (size_t)wvo), (LAS unsigned*)(F.lds + G8_W0 + stg_ * G8_WSTG + (4 * w + j) * 1024), 16, 0, 2); } } while (0)
#define G8_WAITV(k) asm volatile("s_waitcnt vmcnt(" #k ")" ::: "memory")
#define G8_CVT(s) do { float c_[8]; const unsigned cs_ = cvsrc + ((s) & 3) * G8_WSTG; \
        asm volatile("ds_read_b32 %0, %8\n\tds_read_b32 %1, %8 offset:512\n\tds_read_b32 %2, %8 offset:1024\n\tds_read_b32 %3, %8 offset:1536\n\tds_read_b32 %4, %8 offset:2048\n\tds_read_b32 %5, %8 offset:2560\n\tds_read_b32 %6, %8 offset:3072\n\tds_read_b32 %7, %8 offset:3584\n\ts_waitcnt lgkmcnt(0)" \
                     : "=&v"(c_[0]), "=&v"(c_[1]), "=&v"(c_[2]), "=&v"(c_[3]), "=&v"(c_[4]), "=&v"(c_[5]), "=&v"(c_[6]), "=&v"(c_[7]) : "v"(cs_) : "memory"); \
        int p0_ = __builtin_amdgcn_cvt_pk_fp8_f32(c_[0] * 64.f, c_[1] * 64.f, 0, false); p0_ = __builtin_amdgcn_cvt_pk_fp8_f32(c_[2] * 64.f, c_[3] * 64.f, p0_, true); \
        int p1_ = __builtin_amdgcn_cvt_pk_fp8_f32(c_[4] * 64.f, c_[5] * 64.f, 0, false); p1_ = __builtin_amdgcn_cvt_pk_fp8_f32(c_[6] * 64.f, c_[7] * 64.f, p1_, true); \
        const u32x2 pk_ = {(unsigned)p0_, (unsigned)p1_}; const unsigned cd_ = cvdst + ((s) & 1) * G8_WHS; asm volatile("ds_write_b64 %0, %1" :: "v"(cd_), "v"(pk_) : "memory"); } while (0)
    struct Frag { v2i64 a[NLAY], b0, b1; };
    Frag f0, f1; float c_[8];
    const bool top = 128 * (NLAY - 1) + 32 * rg < nr;
#define G8_RD_FRAG(fr, s) do { const unsigned pa_ = lds0 + G8_A0 + ((s) & 3) * G8_ASTG + aofs, pb_ = lds0 + G8_WH0 + ((s) & 1) * G8_WHS + bofs; \
        asm volatile("ds_read_b128 %0, %2\n\tds_read_b128 %1, %2 offset:1024" : "=&v"(fr.b0), "=&v"(fr.b1) : "v"(pb_) : "memory"); \
        asm volatile("ds_read_b128 %0, %1" : "=&v"(fr.a[0]) : "v"(pa_) : "memory"); \
        if constexpr (NLAY >= 2) asm volatile("ds_read_b128 %0, %1 offset:4096" : "=&v"(fr.a[1]) : "v"(pa_) : "memory"); \
        if constexpr (NLAY >= 3) asm volatile("ds_read_b128 %0, %1 offset:8192" : "=&v"(fr.a[2]) : "v"(pa_) : "memory"); } while (0)
#define G8_RD_CV(s) do { const unsigned cs_ = cvsrc + ((s) & 3) * G8_WSTG; \
        asm volatile("ds_read_b32 %0, %8\n\tds_read_b32 %1, %8 offset:512\n\tds_read_b32 %2, %8 offset:1024\n\tds_read_b32 %3, %8 offset:1536\n\tds_read_b32 %4, %8 offset:2048\n\tds_read_b32 %5, %8 offset:2560\n\tds_read_b32 %6, %8 offset:3072\n\tds_read_b32 %7, %8 offset:3584" \
                     : "=&v"(c_[0]), "=&v"(c_[1]), "=&v"(c_[2]), "=&v"(c_[3]), "=&v"(c_[4]), "=&v"(c_[5]), "=&v"(c_[6]), "=&v"(c_[7]) : "v"(cs_) : "memory"); } while (0)
#define G8_LWAIT(fr) do { asm volatile("s_waitcnt lgkmcnt(0)" : "+v"(fr.b0), "+v"(fr.b1), "+v"(fr.a[0]), "+v"(c_[0]), "+v"(c_[1]), "+v"(c_[2]), "+v"(c_[3]), "+v"(c_[4]), "+v"(c_[5]), "+v"(c_[6]), "+v"(c_[7]) :: "memory"); \
        if constexpr (NLAY >= 2) asm volatile("" : "+v"(fr.a[1])); if constexpr (NLAY >= 3) asm volatile("" : "+v"(fr.a[2])); } while (0)
#define G8_CV_WR(s) do { typedef float f2_ __attribute__((ext_vector_type(2))); \
        const f2_ m0_ = (f2_){c_[0], c_[1]} * 64.f, m1_ = (f2_){c_[2], c_[3]} * 64.f, m2_ = (f2_){c_[4], c_[5]} * 64.f, m3_ = (f2_){c_[6], c_[7]} * 64.f; \
        int p0_ = __builtin_amdgcn_cvt_pk_fp8_f32(m0_[0], m0_[1], 0, false); p0_ = __builtin_amdgcn_cvt_pk_fp8_f32(m1_[0], m1_[1], p0_, true); \
        int p1_ = __builtin_amdgcn_cvt_pk_fp8_f32(m2_[0], m2_[1], 0, false); p1_ = __builtin_amdgcn_cvt_pk_fp8_f32(m3_[0], m3_[1], p1_, true); \
        const u32x2 pk_ = {(unsigned)p0_, (unsigned)p1_}; const unsigned cd_ = cvdst + ((s) & 1) * G8_WHS; asm volatile("ds_write_b64 %0, %1" :: "v"(cd_), "v"(pk_) : "memory"); } while (0)
#define G8_SB() __builtin_amdgcn_sched_barrier(0)
#define G8_MF(fr, i, h, c) acc[2 * (i) + (c)] = __builtin_amdgcn_mfma_f32_32x32x16_fp8_fp8(fr.a[i][h], (c) ? fr.b1[h] : fr.b0[h], acc[2 * (i) + (c)], 0, 0, 0)
#define G8_RC01() asm volatile("ds_read_b32 %0, %2\n\tds_read_b32 %1, %2 offset:512" : "=&v"(c_[0]), "=&v"(c_[1]) : "v"(cs_) : "memory")
#define G8_RC23() asm volatile("ds_read_b32 %0, %2 offset:1024\n\tds_read_b32 %1, %2 offset:1536" : "=&v"(c_[2]), "=&v"(c_[3]) : "v"(cs_) : "memory")
#define G8_RC45() asm volatile("ds_read_b32 %0, %2 offset:2048\n\tds_read_b32 %1, %2 offset:2560" : "=&v"(c_[4]), "=&v"(c_[5]) : "v"(cs_) : "memory")
#define G8_RC67() asm volatile("ds_read_b32 %0, %2 offset:3072\n\tds_read_b32 %1, %2 offset:3584" : "=&v"(c_[6]), "=&v"(c_[7]) : "v"(cs_) : "memory")
#define G8_RB(fr) asm volatile("ds_read_b128 %0, %2\n\tds_read_b128 %1, %2 offset:1024" : "=&v"(fr.b0), "=&v"(fr.b1) : "v"(pb_) : "memory")
#define G8_RA(fr, i, ofs) asm volatile("ds_read_b128 %0, %1 offset:" ofs : "=&v"(fr.a[i]) : "v"(pa_) : "memory")
#define G8_CWAIT(n) asm volatile("s_waitcnt lgkmcnt(" n ")" : "+v"(c_[0]), "+v"(c_[1]), "+v"(c_[2]), "+v"(c_[3]), "+v"(c_[4]), "+v"(c_[5]), "+v"(c_[6]), "+v"(c_[7]) :: "memory")
#define G8_CMUL() do { m0_ = (f2_){c_[0], c_[1]} * 64.f; m1_ = (f2_){c_[2], c_[3]} * 64.f; m2_ = (f2_){c_[4], c_[5]} * 64.f; m3_ = (f2_){c_[6], c_[7]} * 64.f; } while (0)
#define G8_CCVT0() do { p0_ = __builtin_amdgcn_cvt_pk_fp8_f32(m0_[0], m0_[1], 0, false); p0_ = __builtin_amdgcn_cvt_pk_fp8_f32(m1_[0], m1_[1], p0_, true); } while (0)
#define G8_CCVT1() do { p1_ = __builtin_amdgcn_cvt_pk_fp8_f32(m2_[0], m2_[1], 0, false); p1_ = __builtin_amdgcn_cvt_pk_fp8_f32(m3_[0], m3_[1], p1_, true); } while (0)
#define G8_CWR() do { const u32x2 pk_ = {(unsigned)p0_, (unsigned)p1_}; asm volatile("ds_write_b64 %0, %1" :: "v"(cd_), "v"(pk_) : "memory"); } while (0)
#define G8_FWAIT(fr) do { asm volatile("s_waitcnt lgkmcnt(0)" : "+v"(fr.b0), "+v"(fr.b1), "+v"(fr.a[0]) :: "memory"); \
        if constexpr (NLAY >= 2) asm volatile("" : "+v"(fr.a[1])); if constexpr (NLAY >= 3) asm volatile("" : "+v"(fr.a[2])); } while (0)
#define G8_BAR() do { asm volatile("s_waitcnt lgkmcnt(0)" ::: "memory"); __builtin_amdgcn_s_barrier(); asm volatile("" ::: "memory"); } while (0)
    auto epilogue = [&](const int s) {
            const int pass = s / KT;
            int hio = hi, lno = ln; asm volatile("" : "+v"(hio), "+v"(lno));
            const unsigned scr = lds0 + G8_SCR0 + w * 2048;
#pragma unroll
            for (int i = 0; i < NLAY; ++i) { const int rt = rg + 4 * i;
                if (i == NLAY - 1 && !top) continue;
#pragma unroll
                for (int r = 0; r < 16; ++r) { const int lr = crow(r, hio);
                    float v0, v1;
                    if (GU) { v0 = silu_f(acc[2 * i][r] * 0.015625f) * (acc[2 * i + 1][r] * 0.015625f); v1 = 0.f; }
                    else { const float wt = RW[32 * rt + lr] * 0.015625f; v0 = acc[2 * i][r] * wt; v1 = acc[2 * i + 1][r] * wt; }
                    const int pk = __builtin_amdgcn_cvt_pk_fp8_f32(v0, v1, 0, false); const unsigned wa = scr + lr * 64 + lno;
                    if (GU) asm volatile("ds_write_b8 %0, %1" :: "v"(wa), "v"(pk) : "memory");
                    else { const int pk1 = pk >> 8; asm volatile("ds_write_b8 %0, %1\n\tds_write_b8 %0, %2 offset:32" :: "v"(wa), "v"(pk), "v"(pk1) : "memory"); } }
                if (GU) {
                    unsigned pv[4]; const unsigned ra = scr + (lane >> 3) * 64 + (lane & 7) * 4;
                    asm volatile("s_waitcnt lgkmcnt(0)\n\tds_read_b32 %0, %4\n\tds_read_b32 %1, %4 offset:512\n\tds_read_b32 %2, %4 offset:1024\n\tds_read_b32 %3, %4 offset:1536\n\ts_waitcnt lgkmcnt(0)" : "=&v"(pv[0]), "=&v"(pv[1]), "=&v"(pv[2]), "=&v"(pv[3]) : "v"(ra) : "memory");
#pragma unroll
                    for (int g8 = 0; g8 < 4; ++g8) { const int grow = 32 * rt + 8 * g8 + (lane >> 3);
                        if (grow < nr) *(unsigned*)(ACT8row0 + (size_t)grow * DEXP + 64 * cgrp + 32 * cp + (lane & 7) * 4) = pv[g8]; }
                } else {
                    u32x2 pv[4]; const unsigned ra = scr + (lane >> 3) * 64 + (lane & 7) * 8;
                    asm volatile("s_waitcnt lgkmcnt(0)\n\tds_read_b64 %0, %4\n\tds_read_b64 %1, %4 offset:512\n\tds_read_b64 %2, %4 offset:1024\n\tds_read_b64 %3, %4 offset:1536\n\ts_waitcnt lgkmcnt(0)" : "=&v"(pv[0]), "=&v"(pv[1]), "=&v"(pv[2]), "=&v"(pv[3]) : "v"(ra) : "memory");
#pragma unroll
                    for (int g8 = 0; g8 < 4; ++g8) { const int grow = 32 * rt + 8 * g8 + (lane >> 3);
                        if (grow < nr) { const int slot = RSLOT[grow]; *(u32x2*)(Y8 + (size_t)slot * DM + 512 * cgrp + 128 * pass + 64 * cp + (lane & 7) * 8) = pv[g8]; } }
                }
                acc[2 * i] = (f32x16){}; acc[2 * i + 1] = (f32x16){}; }
            if (s + 4 < NS) G8_DMA_A(s + 4);
            if (s + 5 < NS) G8_DMA_W(s + 5);
    };
    G8_DMA_A(0); G8_DMA_A(1); G8_DMA_A(2); G8_DMA_A(3);
    if constexpr (NLAY == 3) G8_WAITV(12); else if constexpr (NLAY == 2) G8_WAITV(8); else G8_WAITV(4);
    G8_BAR();
    G8_RD_CV(0);
    asm volatile("s_waitcnt lgkmcnt(0)" : "+v"(c_[0]), "+v"(c_[1]), "+v"(c_[2]), "+v"(c_[3]), "+v"(c_[4]), "+v"(c_[5]), "+v"(c_[6]), "+v"(c_[7]) :: "memory");
    G8_CV_WR(0);
    if constexpr (NLAY == 3) G8_WAITV(9); else if constexpr (NLAY == 2) G8_WAITV(6); else G8_WAITV(3);
    G8_BAR();
    G8_DMA_W(4);
    G8_RD_FRAG(f0, 0); G8_RD_CV(1);
    G8_LWAIT(f0);
    G8_CV_WR(1);
#define G8_STEP(s, cur, nxt, MAYPEND) do { \
        if ((s) > 0 && (s) + 4 < NS) { if constexpr (NLAY == 3) G8_WAITV(14); else if constexpr (NLAY == 2) G8_WAITV(12); else G8_WAITV(10); }     \
        else if ((s) == 0) { if constexpr (NLAY == 3) G8_WAITV(10); else if constexpr (NLAY == 2) G8_WAITV(8); else G8_WAITV(6); } \
        else G8_WAITV(0); \
        G8_BAR(); \
        const bool pend = MAYPEND && (((s) % KT) == KT - 1); \
        if (!pend) { if ((s) + 4 < NS) G8_DMA_A((s) + 4); if ((s) + 5 < NS) G8_DMA_W((s) + 5); } \
          \
          \
        const unsigned pa_ = lds0 + G8_A0 + (((s) + 1) & 3) * G8_ASTG + aofs, pb_ = lds0 + G8_WH0 + (((s) + 1) & 1) * G8_WHS + bofs, cs_ = cvsrc + (((s) + 2) & 3) * G8_WSTG, cd_ = cvdst + ((s) & 1) * G8_WHS; \
        typedef float f2_ __attribute__((ext_vector_type(2))); f2_ m0_, m1_, m2_, m3_; int p0_, p1_; \
        G8_SB(); \
          \
          \
        if constexpr (NLAY == 3) { \
            if (top) { G8_RA(nxt, 2, "8192"); G8_SB(); } \
            G8_MF(cur, 0, 0, 0); G8_SB(); G8_RC01(); G8_SB(); G8_MF(cur, 0, 0, 1); G8_SB(); G8_RC23(); G8_SB(); G8_MF(cur, 1, 0, 0); G8_SB(); G8_RC45(); G8_SB(); G8_MF(cur, 1, 0, 1); G8_SB(); G8_RC67(); G8_SB(); \
            G8_MF(cur, 0, 1, 0); G8_SB(); G8_RB(nxt); G8_SB(); G8_MF(cur, 0, 1, 1); G8_SB(); G8_RA(nxt, 0, "0"); G8_SB(); G8_MF(cur, 1, 1, 0); G8_SB(); G8_RA(nxt, 1, "4096"); G8_SB(); G8_MF(cur, 1, 1, 1); G8_SB(); \
            G8_CWAIT("4"); G8_SB(); G8_CMUL(); G8_SB(); \
            if (top) { G8_MF(cur, 2, 0, 0); G8_SB(); G8_CCVT0(); G8_SB(); G8_MF(cur, 2, 0, 1); G8_SB(); G8_CCVT1(); G8_SB(); G8_MF(cur, 2, 1, 0); G8_SB(); G8_CWR(); G8_SB(); G8_MF(cur, 2, 1, 1); G8_SB(); } \
            else { G8_CCVT0(); G8_CCVT1(); G8_CWR(); G8_SB(); } \
        } else if constexpr (NLAY == 2) { \
            if (top) { G8_RA(nxt, 1, "4096"); G8_SB(); } \
            G8_MF(cur, 0, 0, 0); G8_SB(); G8_RC01(); G8_RC23(); G8_SB(); G8_MF(cur, 0, 0, 1); G8_SB(); G8_RC45(); G8_RC67(); G8_SB(); G8_MF(cur, 0, 1, 0); G8_SB(); G8_RB(nxt); G8_SB(); G8_MF(cur, 0, 1, 1); G8_SB(); G8_RA(nxt, 0, "0"); G8_SB(); \
            G8_CWAIT("3"); G8_SB(); G8_CMUL(); G8_SB(); \
            if (top) { G8_MF(cur, 1, 0, 0); G8_SB(); G8_CCVT0(); G8_SB(); G8_MF(cur, 1, 0, 1); G8_SB(); G8_CCVT1(); G8_SB(); G8_MF(cur, 1, 1, 0); G8_SB(); G8_CWR(); G8_SB(); G8_MF(cur, 1, 1, 1); G8_SB(); } \
            else { G8_CCVT0(); G8_CCVT1(); G8_CWR(); G8_SB(); } \
        } else { \
            if (top) { G8_RA(nxt, 0, "0"); G8_SB(); G8_MF(cur, 0, 0, 0); G8_SB(); } \
            G8_RC01(); G8_RC23(); G8_RC45(); G8_RC67(); G8_SB(); \
            if (top) { G8_MF(cur, 0, 0, 1); G8_SB(); } \
            G8_RB(nxt); G8_SB(); G8_CWAIT("2"); G8_SB(); G8_CMUL(); G8_SB(); \
            if (top) { G8_MF(cur, 0, 1, 0); G8_SB(); } \
            G8_CCVT0(); G8_CCVT1(); G8_SB(); \
            if (top) { G8_MF(cur, 0, 1, 1); G8_SB(); } \
            G8_CWR(); G8_SB(); \
        } \
        G8_FWAIT(nxt); \
        if (pend) epilogue((s)); } while (0)
    for (int s = 0; s < NS; s += 2) { G8_STEP(s, f0, f1, false); G8_STEP(s + 1, f1, f0, true); }
#undef G8_STEP
#undef G8_RC01
#undef G8_RC23
#undef G8_RC45
#undef G8_RC67
#undef G8_RB
#undef G8_RA
#undef G8_CWAIT
#undef G8_CMUL
#undef G8_CCVT0
#undef G8_CCVT1
#undef G8_CWR
#undef G8_FWAIT
#undef G8_SB
#undef G8_MF
#undef G8_RD_FRAG
#undef G8_RD_CV
#undef G8_LWAIT
#undef G8_CV_WR
#undef G8_BAR
    asm volatile("s_waitcnt vmcnt(0) lgkmcnt(0)" ::: "memory");
    __builtin_amdgcn_s_barrier();
    asm volatile("" ::: "memory");
#undef G8_DMA_A
#undef G8_DMA_W
#undef G8_WAITV
#undef G8_CVT
}
template <bool GU>
__device__ __forceinline__ void p13_expert_phase(Frame& F, int qid) {
    const h16* H2X = (const h16*)(F.ws + WS_H2X); h16* Y = (h16*)(F.ws + WS_Y); h16* ACT = (h16*)(F.ws + WS_ACT);
    const unsigned* CNT = (const unsigned*)(F.ws + WS_CTL) + CW_CNT; unsigned* QH = (unsigned*)(F.ws + WS_CTL) + CW_Q + 64 * qid;
    LAS int* RSLOT = (LAS int*)(F.lds + EX_ROW0); LAS float* RW = (LAS float*)(F.lds + EX_ROW0 + 1536); LAS int* RED = (LAS int*)(F.lds + EX_ROW0 + 3072);
    LAS int* CN = (LAS int*)(F.lds + EX_TAB0); LAS int* ORD = CN + 256; LAS int* OFF = CN + 512;
    __syncthreads();
    if (F.tid < NEXP) CN[F.tid] = (int)CNT[F.tid];
    __syncthreads();
    if (F.tid < NEXP) { const int c = CN[F.tid]; int rank = 0, off = 0;
        for (int j = 0; j < NEXP; ++j) { const int cj = CN[j]; rank += (cj > c || (cj == c && j < F.tid)) ? 1 : 0; off += (j < F.tid) ? cj : 0; }
        ORD[rank] = F.tid; OFF[F.tid] = off; }
    __syncthreads();
    const u32x2* LIST2 = (const u32x2*)(F.ws + WS_LIST2);
    if (F.tid == 0) RED[0] = (int)__hip_atomic_fetch_add(QH, 1u, __ATOMIC_RELAXED, __HIP_MEMORY_SCOPE_AGENT);
    __syncthreads();
    int u = RED[0];
    while (u < NEXP * 4) {
        const int e = ORD[u >> 2], cg = u & 3, cnt = CN[e], off_e = OFF[e];
        const float* Wgu = F.w_exp_gu + (size_t)e * DM * 512; const float* Wdn = F.w_exp_down + (size_t)e * DEXP * DM;
        for (int rs = 0; rs < cnt; rs += 384) {
            const int nr = (cnt - rs) < 384 ? (cnt - rs) : 384;
            __syncthreads();
            ring8_w_prologue<GU>(F, GU ? Wgu : Wdn, cg);
            if (F.tid < 384) { u32x2 ent = {0u, 0u}; if (F.tid < nr) ent = LIST2[e * MLAT + rs + F.tid]; RSLOT[F.tid] = (int)ent.x; RW[F.tid] = __uint_as_float(ent.y); }
            __syncthreads();
            unsigned char* ACT8row0 = (unsigned char*)(F.ws + WS_ACT8) + (size_t)(off_e + rs) * DEXP;
            int ar8[3];
            if (GU) {
#pragma unroll
                for (int j = 0; j < 3; ++j) { const int r = 32 * ((F.wave & 3) + 4 * j) + (F.lane >> 1); ar8[j] = (r < 384 ? (RSLOT[r] >> 3) : 0); }
                const unsigned char* A8 = (const unsigned char*)(F.ws + WS_H2F8);
                if (nr > 256) expert_ring8<true, 3>(F, Wgu, A8, ar8[0] | (ar8[1] << 16), ar8[2], nr, cg, ACT8row0, (unsigned char*)Y); else if (nr > 128) expert_ring8<true, 2>(F, Wgu, A8, ar8[0] | (ar8[1] << 16), ar8[2], nr, cg, ACT8row0, (unsigned char*)Y); else expert_ring8<true, 1>(F, Wgu, A8, ar8[0] | (ar8[1] << 16), ar8[2], nr, cg, ACT8row0, (unsigned char*)Y);
            } else {
#pragma unroll
                for (int j = 0; j < 3; ++j) { const int r = 32 * ((F.wave & 3) + 4 * j) + (F.lane >> 1); ar8[j] = ((r < nr) ? r : 0); }
                if (nr > 256) expert_ring8<false, 3>(F, Wdn, ACT8row0, ar8[0] | (ar8[1] << 16), ar8[2], nr, cg, ACT8row0, (unsigned char*)Y); else if (nr > 128) expert_ring8<false, 2>(F, Wdn, ACT8row0, ar8[0] | (ar8[1] << 16), ar8[2], nr, cg, ACT8row0, (unsigned char*)Y); else expert_ring8<false, 1>(F, Wdn, ACT8row0, ar8[0] | (ar8[1] << 16), ar8[2], nr, cg, ACT8row0, (unsigned char*)Y);
            }
        }
        __syncthreads();
        if (F.tid == 0) RED[0] = (int)__hip_atomic_fetch_add(QH, 1u, __ATOMIC_RELAXED, __HIP_MEMORY_SCOPE_AGENT);
        __syncthreads();
        u = RED[0];
    }
}
struct SchedSG {
    int G, c;
    __device__ __forceinline__ bool next(int i, pg8::Unit& u) const { const int L = i * G + c; if (L >= 256) return false; u.pm = L >> 3; u.pn = (L >> 2) & 1; u.ko = (L & 3) * 512; u.nt = 0; u.keep = 0; return true; }
};
struct EpiSGP {
    float* SGP;
    __device__ __forceinline__ void operator()(f32x4 (&acc)[2][2][4][2], const pg8::Unit& u, int wr, int wc, int fr, int fq) const {
        float* dst = SGP + (size_t)(u.ko / 512) * MLAT * 512;
#pragma unroll
        for (int ai = 0; ai < 2; ++ai)
#pragma unroll
            for (int m = 0; m < 4; ++m) { const int row = u.pm * 256 + ai * 128 + wr * 64 + m * 16 + fr;
#pragma unroll
                for (int bj = 0; bj < 2; ++bj)
#pragma unroll
                    for (int n = 0; n < 2; ++n) { const int col = u.pn * 256 + bj * 128 + wc * 32 + 16 * n + 4 * fq; *(f32x4*)(dst + (size_t)row * 512 + col) = acc[ai][bj][m][n]; } }
    }
};
__device__ __forceinline__ void p11b_shared_gu(Frame& F) {
    pg8::Gemm g{(const h16*)(F.ws + WS_H2X), (const h16*)(F.ws + WS_WSGU), 6144, 2048, 512};
    SchedSG S; S.G = F.G; S.c = (int)blockIdx.x;
    EpiSGP E{(float*)(F.ws + WS_SGP)};
    pg8::gemm_phase<EpiSGP, SchedSG>(F.lds, g, S, E);
}
__device__ __forceinline__ void p12b_shared_act(Frame& F) {
    const float* SGP = (const float*)(F.ws + WS_SGP); h16* ACTS = (h16*)(F.ws + WS_ACTS);
    for (int q = blockIdx.x * NTHR + F.tid; q < MLAT * 64; q += F.G * NTHR) {
        const int row = q >> 6, j = (q & 63) * 4, pg = 32 * (j >> 4) + (j & 15);
        f32x4 gv = {0.f, 0.f, 0.f, 0.f}, uv = gv;
#pragma unroll
        for (int ks = 0; ks < 4; ++ks) { const float* p = SGP + ((size_t)ks * MLAT + row) * 512 + pg; gv += *(const f32x4*)p; uv += *(const f32x4*)(p + 16); }
        u32x2 w; w.x = pk2h(silu_f(gv[0]) * uv[0], silu_f(gv[1]) * uv[1]); w.y = pk2h(silu_f(gv[2]) * uv[2], silu_f(gv[3]) * uv[3]);
        *(u32x2*)(ACTS + (size_t)row * DEXP + j) = w;
    }
}
struct EpiYsh {
    h16* YSH;
    __device__ __forceinline__ void operator()(f32x4 (&acc)[2][2][4][2], const pg8::Unit& u, int wr, int wc, int fr, int fq) const {
#pragma unroll
        for (int ai = 0; ai < 2; ++ai)
#pragma unroll
            for (int m = 0; m < 4; ++m) { const int row = u.pm * 256 + ai * 128 + wr * 64 + m * 16 + fr;
#pragma unroll
                for (int bj = 0; bj < 2; ++bj)
#pragma unroll
                    for (int n = 0; n < 2; ++n) { const int col = u.pn * 256 + bj * 128 + wc * 32 + 16 * n + 4 * fq; const f32x4 a = acc[ai][bj][m][n];
                        u32x2 w; w.x = pk2h(a[0], a[1]); w.y = pk2h(a[2], a[3]); *(u32x2*)(YSH + (size_t)row * DM + col) = w; } }
    }
};
struct SchedOne {
    int pm, pn;
    __device__ __forceinline__ bool next(int i, pg8::Unit& u) const { if (i != 0) return false; u.pm = pm; u.pn = pn; u.ko = 0; u.nt = 0; u.keep = 0; return true; }
};
__device__ __forceinline__ void p15_shared_down_dyn(Frame& F, int qid) {
    unsigned* QH = (unsigned*)(F.ws + WS_CTL) + CW_Q + 64 * 8 * qid;
    LAS int* RED = (LAS int*)(F.lds + EX_ROW0 + 3072);
    for (;;) {
        __syncthreads();
        if (F.tid == 0) RED[0] = (int)__hip_atomic_fetch_add(QH, 1u, __ATOMIC_RELAXED, __HIP_MEMORY_SCOPE_AGENT);
        __syncthreads();
        const int t = RED[0];
        if (t >= 256) break;
        pg8::Gemm g{(const h16*)(F.ws + WS_ACTS), (const h16*)(F.ws + WS_WSDN), 256, 256, 256};
        SchedOne S; S.pm = t >> 3; S.pn = t & 7;
        EpiYsh E{(h16*)(F.ws + WS_YSH)};
        pg8::gemm_phase<EpiYsh, SchedOne>(F.lds, g, S, E);
    }
}
__device__ __forceinline__ void p15_shared_down(Frame& F) {
    pg8::Gemm g{(const h16*)(F.ws + WS_ACTS), (const h16*)(F.ws + WS_WSDN), 256, 256, 256};
    pg8::StaticOrder S; S.init(MLAT, DM, F.G, (int)blockIdx.x);
    EpiYsh E{(h16*)(F.ws + WS_YSH)};
    pg8::gemm_phase<EpiYsh, pg8::StaticOrder>(F.lds, g, S, E);
}
__device__ __forceinline__ void p16_combine(Frame& F) {
    const float* X1 = (const float*)(F.ws + WS_X1); const float* MOD = (const float*)(F.ws + WS_MOD); const h16* Y = (const h16*)(F.ws + WS_Y); const h16* YSH = (const h16*)(F.ws + WS_YSH);
    const int gw = F.vcu * NWAVES + F.wave, NGW = F.G * NWAVES;
    for (int r = gw; r < MLAT; r += NGW) {
        const int b = r / SEQ;
        f32x4 xv[8]; float ss = 0.f;
#pragma unroll
        for (int j = 0; j < 8; ++j) { const int cc = 4 * F.lane + 256 * j;
            f32x4 m = {0.f, 0.f, 0.f, 0.f};
#pragma unroll
            for (int k = 0; k < TOPK; ++k) { const int yv = *(const int*)((const unsigned char*)Y + (size_t)(r * TOPK + k) * DM + cc);
                const f32x2 lo = __builtin_amdgcn_cvt_pk_f32_fp8(yv, false), hi2 = __builtin_amdgcn_cvt_pk_f32_fp8(yv, true); m += (f32x4){lo[0], lo[1], hi2[0], hi2[1]}; }
            { const h16x4 yv = *(const h16x4*)(YSH + (size_t)r * DM + cc); m += (f32x4){(float)yv[0], (float)yv[1], (float)yv[2], (float)yv[3]}; }
            const f32x4 g2 = *(const f32x4*)(MOD + (size_t)b * (6 * DM) + 5 * DM + cc);
            xv[j] = *(const f32x4*)(X1 + (size_t)r * DM + cc) + g2 * m;
            ss += (xv[j].x * xv[j].x + xv[j].y * xv[j].y) + (xv[j].z * xv[j].z + xv[j].w * xv[j].w); }
        const float rstd = 1.0f / sqrtf(wave_sum(ss) * (1.0f / DM) + EPS);
#pragma unroll
        for (int j = 0; j < 8; ++j) { const int cc = 4 * F.lane + 256 * j; const f32x4 nw = *(const f32x4*)(F.final_norm + cc);
            *(f32x4*)(F.out + (size_t)r * DM + cc) = xv[j] * rstd * nw; }
    }
}

__device__ __forceinline__ void p_final_plain(Frame& F, const float* xin) {
    const int gw = F.vcu * NWAVES + F.wave, NGW = F.G * NWAVES;
    for (int r = gw; r < MLAT; r += NGW) {
        const float* src = xin + (size_t)r * DM;
        f32x4 xv[8]; float ss = 0.f;
#pragma unroll
        for (int j = 0; j < 8; ++j) { xv[j] = *(const f32x4*)(src + 4 * F.lane + 256 * j); ss += (xv[j].x * xv[j].x + xv[j].y * xv[j].y) + (xv[j].z * xv[j].z + xv[j].w * xv[j].w); }
        const float rstd = 1.0f / sqrtf(wave_sum(ss) * (1.0f / DM) + EPS);
#pragma unroll
        for (int j = 0; j < 8; ++j) { const int cc = 4 * F.lane + 256 * j; const f32x4 nw = *(const f32x4*)(F.final_norm + cc);
            *(f32x4*)(F.out + (size_t)r * DM + cc) = xv[j] * rstd * nw; }
    }
}

constexpr int N_PHASES = 15;
#ifndef DUP_PHASE
#define DUP_PHASE -1
#endif
#ifndef DUP_VAR
#define DUP_VAR 7
#endif
struct Args { const float* in[22]; float* out; unsigned char* ws; int ph_lo, ph_hi; };
__global__ void __launch_bounds__(NTHR, 2) mk_fwd(Args args) {
    extern __shared__ __attribute__((aligned(16))) unsigned char lds_raw[];
    Frame F;
    F.lds = (LAS unsigned char*)lds_raw;
    F.tid = threadIdx.x; F.lane = F.tid & 63; F.wave = __builtin_amdgcn_readfirstlane(F.tid >> 6);
    F.G = gridDim.x; { const int bx = blockIdx.x; F.vcu = (F.G % 8 == 0) ? (bx % 8) * (F.G / 8) + bx / 8 : bx; }
    F.x = args.in[0]; F.c = args.in[1]; F.ctx = args.in[2]; F.c_ctx = args.in[3]; F.w_mod = args.in[4]; F.b_mod = args.in[5]; F.norm_attn = args.in[6]; F.norm_ffn = args.in[7];
    F.w_in = args.in[8]; F.ret_decay = args.in[9]; F.diff_lambda = args.in[10]; F.diff_subln = args.in[11]; F.w_ret_o = args.in[12]; F.w_diff_o = args.in[13]; F.w_out = args.in[14];
    F.w_router = args.in[15]; F.router_bias = args.in[16]; F.w_exp_gu = args.in[17]; F.w_exp_down = args.in[18]; F.w_sh_gu = args.in[19]; F.w_sh_down = args.in[20]; F.final_norm = args.in[21];
    F.out = args.out; F.ws = args.ws;
    volatile LAS unsigned* MISC = (volatile LAS unsigned*)(F.lds + LDSCTL_OFF);
    for (int u = F.tid; u < (LDS_BYTES - LDSCTL_OFF) / 4; u += NTHR) ((LAS unsigned*)(F.lds + LDSCTL_OFF))[u] = 0u;
    __syncthreads();
    const int lo = args.ph_lo, hi = args.ph_hi;
    const bool multi = (hi - lo) > 1;
    XcdBarrier bar; bar.bar = (unsigned*)(F.ws + WS_CTL) + CW_BAR; bar.x = 0; bar.st = nullptr;
    if (multi) bar = xcd_barrier_post((unsigned*)(F.ws + WS_CTL) + CW_BAR, MISC + 8);
#define IN(k) (lo <= (k) && (k) < hi)
#define SEAM(k) do { if (IN(k) && IN((k) + 1)) xcd_barrier(bar); } while (0)

#define RUNP(k, call) do { if (IN(k)) { call; if (DUP_PHASE == (k)) { xcd_barrier(bar); call; } } SEAM(k); } while (0)
    RUNP(0, p0a_mod(F));
    RUNP(1, (p1_norm1(F), p0b_weights(F)));
    RUNP(2, (p2_gemm1(F), p0c_weights_dyn(F, 5)));
    RUNP(3, p3_ret_local(F));
    RUNP(4, p4_ret_scan(F));
    RUNP(5, p5_ret_out(F));
    RUNP(6, p6_attn(F));
    RUNP(7, p7_gemm2(F));
    RUNP(8, p9_gemm3(F));
    RUNP(9, p10_norm2(F));
    RUNP(10, (p11_router(F), p11b_shared_gu(F)));
    RUNP(11, (p12_topk(F), p12b_shared_act(F)));
    if (IN(12)) { p13_expert_phase<true>(F, 0); p15_shared_down_dyn(F, 4); if (DUP_PHASE == 12) { xcd_barrier(bar); p13_expert_phase<true>(F, 2); } } SEAM(12);
    if (IN(13)) { p13_expert_phase<false>(F, 1); if (DUP_PHASE == 13) { xcd_barrier(bar); p13_expert_phase<false>(F, 3); } } SEAM(13);
    if (IN(14)) { p16_combine(F); }
#undef RUNP
#undef IN
#undef SEAM
}

constexpr bool ONE_LAUNCH = true;
extern "C" void kernel_launch(void* const* d_in, const int* in_sizes, int n_in, void* d_out, int out_size, void* d_ws, size_t ws_size, hipStream_t stream) {
    static int grid = 0;
    if (grid == 0) {
        if (n_in != 22 || out_size != MLAT * DM || ws_size < WS_END) { fprintf(stderr, "kernel_launch: unexpected sizes n_in %d out %d ws %zu\n", n_in, out_size, ws_size); grid = -1; return; }
        int dev = 0, cus = 0;
        if (hipGetDevice(&dev) != hipSuccess || hipDeviceGetAttribute(&cus, hipDeviceAttributeMultiprocessorCount, dev) != hipSuccess) { grid = -1; return; }
        if (hipFuncSetAttribute((const void*)mk_fwd, hipFuncAttributeMaxDynamicSharedMemorySize, LDS_BYTES) != hipSuccess) { fprintf(stderr, "kernel_launch: hipFuncSetAttribute failed\n"); grid = -1; return; }
        int per_cu = 0;
        if (hipOccupancyMaxActiveBlocksPerMultiprocessor(&per_cu, (const void*)mk_fwd, NTHR, LDS_BYTES) != hipSuccess || per_cu < 1) fprintf(stderr, "kernel_launch: occupancy query reports %d\n", per_cu);
        (void)hipGetLastError();
        grid = cus;
    }
    if (grid < 0) return;
    (void)hipMemsetAsync((char*)d_ws + WS_CTL, 0, CTL_ZERO_BYTES, stream);
    Args a{};
    for (int i = 0; i < 22; ++i) a.in[i] = (const float*)d_in[i];
    a.out = (float*)d_out; a.ws = (unsigned char*)d_ws;
    if (ONE_LAUNCH) {
        a.ph_lo = 0; a.ph_hi = N_PHASES;
        hipLaunchKernelGGL(mk_fwd, dim3(grid), dim3(NTHR), LDS_BYTES, stream, a);
    } else {
        for (int p = 0; p < N_PHASES; ++p) { a.ph_lo = p; a.ph_hi = p + 1; hipLaunchKernelGGL(mk_fwd, dim3(grid), dim3(NTHR), LDS_BYTES, stream, a); }
    }
}
```

```cpp
#include <hip/hip_runtime.h>
#include <cstdio>
#include <cstdint>

#define LAS __attribute__((address_space(3)))
#define GAS __attribute__((address_space(1)))
typedef _Float16 h16;
typedef _Float16 h16x8 __attribute__((ext_vector_type(8)));
typedef _Float16 h16x4 __attribute__((ext_vector_type(4)));
typedef _Float16 h16x2 __attribute__((ext_vector_type(2)));
typedef float f32x2 __attribute__((ext_vector_type(2)));
typedef float f32x4 __attribute__((ext_vector_type(4)));
typedef float f32x16 __attribute__((ext_vector_type(16)));
typedef unsigned u32x4 __attribute__((ext_vector_type(4)));
typedef unsigned u32x2 __attribute__((ext_vector_type(2)));
typedef short v4i16_t __attribute__((ext_vector_type(4)));

constexpr int DM = 2048, NBATCH = 2, SEQ = 4096, CTXL = 256;
constexpr int MLAT = NBATCH * SEQ, MCTX = NBATCH * CTXL, MALL = MLAT + MCTX;
constexpr int IN_COLS = 13312, KV_COLS = 5120;
constexpr int C_RK = 0, C_RV = 1024, C_DK = 3072, C_DV = 4096, C_RQ = 5120, C_RG = 6144, C_DQ = 8192, C_GR = 9216, C_GD = 11264;
constexpr int NEXP = 256, TOPK = 8, DEXP = 256;
constexpr float EPS = 1e-6f;
constexpr int NWAVES = 8, NTHR = 512;

constexpr size_t MiB = 1u << 20;
constexpr size_t WS_CTL = 0, CTL_ZERO_BYTES = 1 * MiB;
constexpr size_t WS_MODP = 1 * MiB;
constexpr size_t WS_MOD = 3 * MiB;
constexpr size_t WS_ROPE = 3 * MiB + 512 * 1024;
constexpr size_t WS_WINT = 4 * MiB;
constexpr size_t WS_WRET = 56 * MiB;
constexpr size_t WS_WDIF = 64 * MiB;
constexpr size_t WS_WOUT = 68 * MiB;
constexpr size_t WS_WSGU = 76 * MiB;
constexpr size_t WS_WSDN = 78 * MiB;
constexpr size_t WS_WRTR = 79 * MiB;
constexpr size_t WS_H = 82 * MiB;
constexpr size_t WS_P = 116 * MiB;
constexpr size_t WS_LST = 340 * MiB;
constexpr size_t WS_SST = 408 * MiB;
constexpr size_t WS_ARET = 472 * MiB;
constexpr size_t WS_ADIF = 504 * MiB;
constexpr size_t WS_T = 520 * MiB;
constexpr size_t WS_U = 584 * MiB;
constexpr size_t WS_X1 = 616 * MiB;
constexpr size_t WS_H2X = 680 * MiB;
constexpr size_t WS_LG = 776 * MiB;
constexpr size_t WS_EIDX = 784 * MiB;
constexpr size_t WS_EW = 785 * MiB;
constexpr size_t WS_LIST = 786 * MiB;
constexpr size_t WS_ACTS = 794 * MiB;
constexpr size_t WS_YSH = 798 * MiB;
constexpr size_t WS_Y = 830 * MiB;
constexpr size_t WS_ACT = 1086 * MiB;
constexpr size_t WS_LGP = 1118 * MiB;
constexpr size_t WS_SGP = 1182 * MiB;
constexpr size_t WS_ACAT = 1246 * MiB;
constexpr size_t WS_WCAT = 1294 * MiB;
constexpr size_t WS_LIST2 = 1306 * MiB;
constexpr size_t WS_H2F8 = 1322 * MiB;
constexpr size_t WS_ACT8 = 1338 * MiB;
constexpr size_t WS_END = 1354 * MiB;

constexpr int CW_BAR = 4096;
constexpr int CW_CNT = 16384;
constexpr int CW_Q = 20480;

constexpr int RING_BYTES = 131072;
constexpr int LDS_BYTES = 163840;
constexpr int LDSCTL_OFF = LDS_BYTES - 512;
constexpr int LDS_TICKET = 146432;

#define XB_TMO      128
#define XB_XCNT(j)  (256  + 64 * (j))
#define XB_XSUB(j)  (1280 + 64 * (j))
#define XB_XGEN(j)  (2304 + 64 * (j))
#define XB_TOP      3328
#define XB_TOPGEN   3392
#define XCD_BAR_WORDS 3456
#define XB_SPIN_CAP (1u << 18)

__device__ __forceinline__ unsigned xb_ld(unsigned* p)              { return __hip_atomic_load(p, __ATOMIC_RELAXED, __HIP_MEMORY_SCOPE_AGENT); }
__device__ __forceinline__ unsigned xb_add(unsigned* p, unsigned v) { return __hip_atomic_fetch_add(p, v, __ATOMIC_RELAXED, __HIP_MEMORY_SCOPE_AGENT); }
__device__ __forceinline__ unsigned xb_xcc_id() { return (unsigned)__builtin_amdgcn_s_getreg((3 << 11) | 20) & 0xFu; }
#define XB_SPIN(cond, bar) do { unsigned _sp = 0; while (cond) { __builtin_amdgcn_s_sleep(1); \
    if ((++_sp & 255u) == 0u) { if (xb_ld(&(bar)[XB_TMO])) break; if (_sp > XB_SPIN_CAP) { atomicAdd(&(bar)[XB_TMO], 1u); break; } } } } while (0)

struct XcdBarrier { unsigned* bar; unsigned x; volatile LAS unsigned* st; };

__device__ __forceinline__ XcdBarrier xcd_barrier_post(unsigned* bar, volatile LAS unsigned* st) {
    XcdBarrier b; b.bar = bar; b.x = xb_xcc_id(); b.st = st;
    if (threadIdx.x == 0) (void)xb_add(&bar[XB_XCNT(b.x)], 1u);
    return b;
}
__device__ __forceinline__ void xcd_barrier_complete(unsigned* bar, unsigned x, unsigned& nloc, unsigned& nx) {
    const unsigned G = gridDim.x * gridDim.y * gridDim.z;
    unsigned sum, cnt, mine, sp = 0u;
    for (;;) {
        sum = 0u; cnt = 0u; mine = 0u;
#pragma unroll
        for (unsigned j = 0; j < 16; ++j) { const unsigned c = xb_ld(&bar[XB_XCNT(j)]); sum += c; cnt += (c > 0u) ? 1u : 0u; mine = (j == x) ? c : mine; }
        if (sum == G) break;
        __builtin_amdgcn_s_sleep(1);
        if ((++sp & 255u) == 0u) { if (xb_ld(&bar[XB_TMO])) break; if (sp > XB_SPIN_CAP) { atomicAdd(&bar[XB_TMO], 1u); break; } }
    }
    nloc = mine > 0u ? mine : 1u; nx = cnt > 0u ? cnt : 1u;
}
__device__ __forceinline__ void xcd_barrier(const XcdBarrier& b) {
    asm volatile("s_waitcnt vmcnt(0)" ::: "memory");
    __syncthreads();
    if (threadIdx.x == 0) {
        unsigned* bar = b.bar;
        __builtin_amdgcn_s_waitcnt(0);
        unsigned nloc = b.st[0], nx = b.st[1];
        if (nloc == 0u) { xcd_barrier_complete(bar, b.x, nloc, nx); b.st[0] = nloc; b.st[1] = nx; }
        const unsigned old = xb_add(&bar[XB_XSUB(b.x)], 1u);
        const unsigned gen = old / nloc;
        if (old + 1u == (gen + 1u) * nloc) {
            __builtin_amdgcn_fence(__ATOMIC_RELEASE, "agent");
            asm volatile("s_waitcnt vmcnt(0)" ::: "memory");
            const unsigned og = xb_add(&bar[XB_TOP], 1u);
            const unsigned tg = og / nx;
            if (og + 1u == (tg + 1u) * nx) xb_add(&bar[XB_TOPGEN], 1u);
            else XB_SPIN(xb_ld(&bar[XB_TOPGEN]) == tg, bar);
            __builtin_amdgcn_fence(__ATOMIC_ACQUIRE, "agent");
            xb_add(&bar[XB_XGEN(b.x)], 1u);
            asm volatile("s_waitcnt vmcnt(0)" ::: "memory");
        } else {
            XB_SPIN(xb_ld(&bar[XB_XGEN(b.x)]) == gen, bar);
            __builtin_amdgcn_fence(__ATOMIC_ACQUIRE, "agent");
            asm volatile("s_waitcnt vmcnt(0)" ::: "memory");
        }
    }
    __syncthreads();
}


constexpr int CW_FLAT = 12288;
__device__ __forceinline__ void flat_barrier(const XcdBarrier& b, unsigned* ctl, const unsigned nbar) {
    asm volatile("s_waitcnt vmcnt(0)" ::: "memory");
    __syncthreads();
    if (threadIdx.x == 0) {
        unsigned* cnt = ctl + CW_FLAT; unsigned* bar = b.bar;
        __builtin_amdgcn_s_waitcnt(0);
        unsigned nloc = b.st[0], nx = b.st[1];
        if (nloc == 0u) { xcd_barrier_complete(bar, b.x, nloc, nx); b.st[0] = nloc; b.st[1] = nx; }
        const unsigned old = xb_add(&cnt[64 * b.x], 1u);
        if (old + 1u == (nbar + 1u) * nloc) {
            __builtin_amdgcn_fence(__ATOMIC_RELEASE, "agent");
            asm volatile("s_waitcnt vmcnt(0)" ::: "memory");
            (void)__hip_atomic_fetch_add(&cnt[64 * 16], 1u, __ATOMIC_RELAXED, __HIP_MEMORY_SCOPE_AGENT);
        }
        const unsigned target = (nbar + 1u) * nx;
        unsigned sp = 0u;
        while (xb_ld(&cnt[64 * 16]) < target) { __builtin_amdgcn_s_sleep(1);
            if ((++sp & 255u) == 0u) { if (xb_ld(&bar[XB_TMO])) break; if (sp > XB_SPIN_CAP) { atomicAdd(&bar[XB_TMO], 1u); break; } } }
        __builtin_amdgcn_fence(__ATOMIC_ACQUIRE, "agent");
        asm volatile("s_waitcnt vmcnt(0)" ::: "memory");
    }
    __syncthreads();
}

namespace pg8 {
constexpr int BM = 256, BK = 64, HALF = 128, HTB = HALF * BK * 2, STAGE_BYTES = 8 * HTB, NXCD = 8, WGM = 8;
__host__ __device__ __forceinline__ int lds_byte(int r, int c) { const int st = (r >> 4) * 2 + (c >> 5), rr = r & 15, cc = c & 31, ob = rr * 64 + cc * 2; return st * 1024 + (ob ^ (((ob >> 9) & 1) << 5)); }
__host__ __device__ __forceinline__ void stage_rc(int b, int& R, int& C) { const int st = b / 1024, sb = b % 1024, swz = sb ^ (((sb >> 9) & 1) << 5); R = (st >> 1) * 16 + swz / 64; C = (st & 1) * 32 + (swz % 64) / 2; }
struct Unit { int pm, pn, ko, nt, keep; };
struct Gemm { const h16* A; const h16* Bt; int lda, ldb, K; };
struct StaticOrder {
    int nM, nN, nwg, G, c;
    __host__ __device__ void init(int M, int N, int G_, int c_) { nM = M / BM; nN = N / BM; nwg = nM * nN; G = G_; c = c_; }
    __host__ __device__ bool next(int i, Unit& u) const {
        const long L = (long)i * G + c; if (L >= nwg) return false;
        int wgid = (int)L; { const int q = nwg / NXCD, r = nwg % NXCD, xcd = wgid % NXCD, off = wgid / NXCD; wgid = (xcd < r ? xcd * (q + 1) : r * (q + 1) + (xcd - r) * q) + off; }
        const int nig = WGM * nN, gid = wgid / nig, fm = gid * WGM, gsz = (nM - fm) < WGM ? (nM - fm) : WGM;
        u.pm = fm + ((wgid % nig) % gsz); u.pn = (wgid % nig) / gsz; u.ko = 0; u.nt = 0; u.keep = 0; return true;
    }
};
template <class Epi, class Sched, bool ALIGN_EPI = true>
__device__ __forceinline__ void gemm_phase(LAS unsigned char* lds, const Gemm g, const Sched& S, const Epi& E) {
    const int tid = threadIdx.x, wid = __builtin_amdgcn_readfirstlane(tid >> 6), lane = tid & 63, wr = wid >> 2, wc = wid & 3, fr = lane & 15, fq = lane >> 4;
    const int nt0 = g.K / BK;
    unsigned voffA[2], voffB[2];
#pragma unroll
    for (int i = 0; i < 2; ++i) { int R, C; stage_rc(tid * 16 + i * 8192, R, C); voffA[i] = (unsigned)(R * g.lda + C) * 2u; voffB[i] = (unsigned)(R * g.ldb + C) * 2u; }
    const size_t kstep = (size_t)(BK * 2);
    const size_t hstepA = (size_t)HALF * g.lda * 2, hstepB = (size_t)HALF * g.ldb * 2;
    const size_t tstepA = 2 * hstepA, tstepB = 2 * hstepB;
    const unsigned ldsw = (unsigned)wid * 1024u;
    const int aoff = lds_byte(wr * 64 + fr, fq * 8), boff = lds_byte(wc * 32 + fr, fq * 8);
#define PG8_SA(b, h) (((b) * 2 + (h)) * HTB)
#define PG8_SB(b, h) ((4 + (b) * 2 + (h)) * HTB)
#define PG8_STAGE(bufoff, gbase, voff) do { _Pragma("unroll") for (int _i = 0; _i < 2; ++_i) \
        __builtin_amdgcn_global_load_lds((const unsigned*)((const char*)(gbase) + (voff)[_i]), (LAS unsigned*)(lds + (bufoff) + ldsw + _i * 8192), 16, 0, 0); } while (0)
#define PG8_LDA(dst, b, h) do { _Pragma("unroll") for (int m = 0; m < 4; ++m) _Pragma("unroll") for (int k = 0; k < 2; ++k) dst[m][k] = *(const LAS h16x8*)(lds + PG8_SA(b, h) + aoff + m * 2048 + k * 1024); } while (0)
#define PG8_LDB(dst, b, h) do { _Pragma("unroll") for (int n = 0; n < 2; ++n) _Pragma("unroll") for (int k = 0; k < 2; ++k) dst[n][k] = *(const LAS h16x8*)(lds + PG8_SB(b, h) + boff + n * 2048 + k * 1024); } while (0)
#define PG8_MMA(ai, bj, At, Bt) do { __builtin_amdgcn_s_setprio(1); _Pragma("unroll") for (int m = 0; m < 4; ++m) _Pragma("unroll") for (int n = 0; n < 2; ++n) _Pragma("unroll") for (int k = 0; k < 2; ++k) \
        acc[ai][bj][m][n] = __builtin_amdgcn_mfma_f32_16x16x32_f16(Bt[n][k], At[m][k], acc[ai][bj][m][n], 0, 0, 0); __builtin_amdgcn_s_setprio(0); } while (0)
#define PG8_WAIT_V(n) asm volatile("s_waitcnt vmcnt(" #n ")" ::: "memory")
#define PG8_WAIT_L(n) asm volatile("s_waitcnt lgkmcnt(" #n ")" ::: "memory")
#define PG8_BAR __builtin_amdgcn_s_barrier()
#define PG8_SCHED __builtin_amdgcn_sched_barrier(0)
    Unit cur, nxt; int ui = 0;
    if (!S.next(0, cur)) return;
    f32x4 acc[2][2][4][2];
#pragma unroll
    for (int a = 0; a < 2; ++a)
#pragma unroll
        for (int b = 0; b < 2; ++b)
#pragma unroll
            for (int m = 0; m < 4; ++m)
#pragma unroll
                for (int n = 0; n < 2; ++n) acc[a][b][m][n] = (f32x4){0.f, 0.f, 0.f, 0.f};
    h16x8 At[4][2], B0[2][2], B1[2][2];
    const char* cA = (const char*)g.A + (size_t)cur.pm * tstepA + (size_t)cur.ko * 2; const char* cB = (const char*)g.Bt + (size_t)cur.pn * tstepB + (size_t)cur.ko * 2;
    {
        PG8_STAGE(PG8_SB(0, 0), cB, voffB); PG8_STAGE(PG8_SB(0, 1), cB + hstepB, voffB); PG8_STAGE(PG8_SA(0, 0), cA, voffA); PG8_STAGE(PG8_SA(0, 1), cA + hstepA, voffA);
        if (wr == 1) PG8_BAR;
        PG8_WAIT_V(2); PG8_BAR;
        PG8_STAGE(PG8_SB(1, 0), cB + kstep, voffB); PG8_STAGE(PG8_SA(1, 0), cA + kstep, voffA); PG8_STAGE(PG8_SB(1, 1), cB + hstepB + kstep, voffB);
        PG8_WAIT_V(6); PG8_BAR;
    }
    for (;;) {
        const bool has_next = S.next(ui + 1, nxt);
        const char* nA = has_next ? (const char*)g.A + (size_t)nxt.pm * tstepA + (size_t)nxt.ko * 2 : cA; const char* nB = has_next ? (const char*)g.Bt + (size_t)nxt.pn * tstepB + (size_t)nxt.ko * 2 : cB;
        int nt = cur.nt ? cur.nt : nt0; asm volatile("" : "+s"(nt));
        for (int t = 0; t < nt; t += 2) {
            const bool last = (t == nt - 2);
            const char* a1 = cA + (size_t)(t + 1) * kstep;
            const char* a2 = last ? nA : cA + (size_t)(t + 2) * kstep; const char* b2 = last ? nB : cB + (size_t)(t + 2) * kstep;
            const char* a3 = a2 + kstep; const char* b3 = b2 + kstep;
            PG8_LDB(B0, 0, 0); PG8_LDB(B1, 0, 1); PG8_SCHED; PG8_LDA(At, 0, 0); PG8_STAGE(PG8_SA(1, 1), a1 + hstepA, voffA);
            PG8_WAIT_V(8); PG8_WAIT_L(0); PG8_BAR; PG8_MMA(0, 0, At, B0); PG8_MMA(0, 1, At, B1); PG8_BAR; PG8_SCHED;
            PG8_LDA(At, 0, 1); PG8_STAGE(PG8_SB(0, 0), b2, voffB); PG8_STAGE(PG8_SB(0, 1), b2 + hstepB, voffB); PG8_STAGE(PG8_SA(0, 0), a2, voffA);
            PG8_WAIT_V(8); PG8_WAIT_L(0); PG8_BAR; PG8_MMA(1, 0, At, B0); PG8_MMA(1, 1, At, B1); PG8_BAR; PG8_SCHED;
            PG8_LDB(B0, 1, 0); PG8_LDB(B1, 1, 1); PG8_SCHED; PG8_LDA(At, 1, 0); PG8_STAGE(PG8_SA(0, 1), a2 + hstepA, voffA);
            PG8_WAIT_V(8); PG8_WAIT_L(0); PG8_BAR; PG8_MMA(0, 0, At, B0); PG8_MMA(0, 1, At, B1); PG8_BAR; PG8_SCHED;
            PG8_LDA(At, 1, 1); PG8_STAGE(PG8_SB(1, 0), b3, voffB); PG8_STAGE(PG8_SB(1, 1), b3 + hstepB, voffB); PG8_STAGE(PG8_SA(1, 0), a3, voffA);
            PG8_WAIT_V(8); PG8_WAIT_L(0); PG8_BAR; PG8_MMA(1, 0, At, B0); PG8_MMA(1, 1, At, B1); PG8_BAR; PG8_SCHED;
        }
        if constexpr (ALIGN_EPI) { if (wr == 0) PG8_BAR; }
        E(acc, cur, wr, wc, fr, fq);
        if (!has_next) break;
        if (!cur.keep) {
#pragma unroll
        for (int a = 0; a < 2; ++a)
#pragma unroll
            for (int b = 0; b < 2; ++b)
#pragma unroll
                for (int m = 0; m < 4; ++m)
#pragma unroll
                    for (int n = 0; n < 2; ++n) acc[a][b][m][n] = (f32x4){0.f, 0.f, 0.f, 0.f};
        }
        cur = nxt; cA = nA; cB = nB; ++ui;
        if constexpr (ALIGN_EPI) { if (wr == 1) PG8_BAR; }
    }
    PG8_WAIT_V(0);
    if constexpr (!ALIGN_EPI) { if (wr == 0) PG8_BAR; }
    PG8_BAR;
#undef PG8_SA
#undef PG8_SB
#undef PG8_STAGE
#undef PG8_LDA
#undef PG8_LDB
#undef PG8_MMA
#undef PG8_WAIT_V
#undef PG8_WAIT_L
#undef PG8_BAR
#undef PG8_SCHED
}
}

struct Frame {
    LAS unsigned char* lds;
    int tid, lane, wave, vcu, G;
    const float *x, *c, *ctx, *c_ctx, *w_mod, *b_mod, *norm_attn, *norm_ffn, *w_in, *ret_decay, *diff_lambda, *diff_subln,
                *w_ret_o, *w_diff_o, *w_out, *w_router, *router_bias, *w_exp_gu, *w_exp_down, *w_sh_gu, *w_sh_down, *final_norm;
    float* out;
    unsigned char* ws;
};

template <class T> __device__ __forceinline__ const T* uni_ptr(const T* p) {
    const unsigned long long v = (unsigned long long)p;
    const unsigned lo = __builtin_amdgcn_readfirstlane((unsigned)v), hi = __builtin_amdgcn_readfirstlane((unsigned)(v >> 32));
    return (const T*)(((unsigned long long)hi << 32) | lo);
}
__device__ __forceinline__ float wave_sum(float v) {
#pragma unroll
    for (int o = 1; o < 64; o <<= 1) v += __shfl_xor(v, o);
    return v;
}
__device__ __forceinline__ unsigned pk2h(float lo, float hi) { f32x2 v = {lo, hi}; h16x2 h = __builtin_convertvector(v, h16x2); return __builtin_bit_cast(unsigned, h); }
__device__ __forceinline__ float silu_f(float v) { return v * __builtin_amdgcn_rcpf(1.0f + __expf(-v)); }
__device__ __forceinline__ float sigmoid_f(float v) { return __builtin_amdgcn_rcpf(1.0f + __expf(-v)); }

__device__ __forceinline__ void p0_mod_unit(Frame& F, int unit) {
    const int cb = unit % 24, ks = unit / 24;
    LAS float* sv = (LAS float*)F.lds;
    LAS float* red = sv + 768;
    for (int i = F.tid; i < 768; i += NTHR) { const int v = i >> 8, k = i & 255; const float cv = (v < 2) ? F.c[v * DM + ks * 256 + k] : F.c_ctx[ks * 256 + k]; sv[i] = silu_f(cv); }
    __syncthreads();
    const int cl = F.tid & 127, rl = F.tid >> 7;
    const float* wp = F.w_mod + (size_t)(ks * 256 + rl) * (6 * DM) + cb * 512 + cl * 4;
    f32x4 a0 = {0.f, 0.f, 0.f, 0.f}, a1 = a0, a2 = a0;
#pragma unroll 8
    for (int i = 0; i < 64; ++i) { const f32x4 w = *(const f32x4*)(wp + (size_t)i * 4 * (6 * DM)); const int k = rl + 4 * i; a0 += w * sv[k]; a1 += w * sv[256 + k]; a2 += w * sv[512 + k]; }
    *(LAS f32x4*)(red + (rl * 3 + 0) * 512 + cl * 4) = a0; *(LAS f32x4*)(red + (rl * 3 + 1) * 512 + cl * 4) = a1; *(LAS f32x4*)(red + (rl * 3 + 2) * 512 + cl * 4) = a2;
    __syncthreads();
    float* modp = (float*)(F.ws + WS_MODP);
    for (int i = F.tid; i < 1536; i += NTHR) { const int v = i >> 9, cc = i & 511; const float s = (red[(0 * 3 + v) * 512 + cc] + red[(1 * 3 + v) * 512 + cc]) + (red[(2 * 3 + v) * 512 + cc] + red[(3 * 3 + v) * 512 + cc]);
        modp[(size_t)(ks * 3 + v) * (6 * DM) + cb * 512 + cc] = s; }
    __syncthreads();
}
template <int MAP>
__device__ __forceinline__ void p0_transpose_item(const float* W, int K, int N, h16* WT, LAS float* scr, int item, int lane, int ldd = 0) {
    if (ldd == 0) ldd = K;
    const int nblk = N / 32, kb = item / nblk, nb = item % nblk, k0 = 64 * kb, n0 = 32 * nb;
    float wv[32];
#pragma unroll
    for (int i = 0; i < 32; ++i) { const int kk = 2 * i + (lane >> 5); wv[i] = W[(size_t)(k0 + kk) * N + n0 + (lane & 31)]; }
#pragma unroll
    for (int i = 0; i < 32; ++i) { const int kk = 2 * i + (lane >> 5); scr[kk * 33 + (lane & 31)] = wv[i]; }
    asm volatile("s_waitcnt lgkmcnt(0)" ::: "memory");
    const int cch = lane & 7;
#pragma unroll
    for (int j = 0; j < 4; ++j) { const int n = (lane >> 3) + 8 * j; const LAS float* s = scr + (8 * cch) * 33 + n;
        u32x4 o; o.x = pk2h(s[0 * 33], s[1 * 33]); o.y = pk2h(s[2 * 33], s[3 * 33]); o.z = pk2h(s[4 * 33], s[5 * 33]); o.w = pk2h(s[6 * 33], s[7 * 33]);
        int nn = n0 + n;
        if (MAP == 1) { const bool isrope = (nn < 1024) || (nn >= C_RQ && nn < C_RQ + 1024); if (isrope) nn = (nn & ~48) | ((nn & 16) << 1) | ((nn & 32) >> 1); }
        if (MAP == 2) { const int j = nn & 255, isu = nn >> 8; nn = 32 * (j >> 4) + 16 * isu + (j & 15); }
        *(u32x4*)(WT + (size_t)nn * ldd + k0 + 8 * cch) = o; }
    asm volatile("s_waitcnt lgkmcnt(0)" ::: "memory");
}
__device__ __forceinline__ void p0a_mod(Frame& F) {
    for (int u = F.vcu; u < 192; u += F.G) p0_mod_unit(F, u);
}
__device__ __forceinline__ void p0b_weights(Frame& F) {
    __syncthreads();
    LAS float* scr = (LAS float*)(F.lds + F.wave * 16384);
    const int gw = F.vcu * NWAVES + F.wave, NGW = F.G * NWAVES;
    constexpr int I_IN = (DM / 64) * (IN_COLS / 32);
    for (int it = gw; it < I_IN; it += NGW) p0_transpose_item<1>(F.w_in, DM, IN_COLS, (h16*)(F.ws + WS_WINT), scr, it, F.lane);
    if (blockIdx.x == 0) {
        float* rope = (float*)(F.ws + WS_ROPE);
        for (int i = F.tid; i < 64 * 32; i += NTHR) { const int pos = i >> 5, j = i & 31; const float inv = exp2f(-(float)j * (13.287712379549449f / 32.0f)); const float ang = (float)pos * inv; rope[i] = cosf(ang); rope[2048 + i] = sinf(ang); }
        for (int i = F.tid; i < 64 * 16; i += NTHR) { const int pos = i >> 4, j = i & 15; const float inv = exp2f(-(float)j * (13.287712379549449f / 16.0f)); const float ang = (float)pos * inv; rope[4096 + i] = cosf(ang); rope[4096 + 1024 + i] = sinf(ang); }
    }
}
__device__ __forceinline__ void p0c_weights_dyn(Frame& F, int qid) {
    unsigned* QH = (unsigned*)(F.ws + WS_CTL) + CW_Q + 64 * 8 * qid;
    LAS int* RED = (LAS int*)(F.lds + LDS_TICKET);
    LAS float* scr = (LAS float*)(F.lds + F.wave * 16384);
    constexpr int I_RET = (2048 / 64) * (DM / 32), I_DIF = (1024 / 64) * (DM / 32), I_OUT = (DM / 64) * (DM / 32), I_SGU = (DM / 64) * (512 / 32), I_SDN = (256 / 64) * (DM / 32), I_RT = NEXP * DM / 4 / 64;
    constexpr int NITEMS = I_RET + I_DIF + I_OUT + I_SGU + I_SDN + I_RT, NTICK = (NITEMS + 7) / 8;
    for (;;) {
        __syncthreads();
        if (F.tid == 0) RED[0] = (int)__hip_atomic_fetch_add(QH, 1u, __ATOMIC_RELAXED, __HIP_MEMORY_SCOPE_AGENT);
        __syncthreads();
        const int t = RED[0];
        if (t >= NTICK) break;
        int r = t * 8 + F.wave;
        if (r >= NITEMS) continue;
        if (r < I_RET) { p0_transpose_item<0>(F.w_ret_o, 2048, DM, (h16*)(F.ws + WS_WCAT), scr, r, F.lane, 3072); continue; } r -= I_RET;
        if (r < I_DIF) { p0_transpose_item<0>(F.w_diff_o, 1024, DM, (h16*)(F.ws + WS_WCAT) + 2048, scr, r, F.lane, 3072); continue; } r -= I_DIF;
        if (r < I_OUT) { p0_transpose_item<0>(F.w_out, DM, DM, (h16*)(F.ws + WS_WOUT), scr, r, F.lane); continue; } r -= I_OUT;
        if (r < I_SGU) { p0_transpose_item<2>(F.w_sh_gu, DM, 512, (h16*)(F.ws + WS_WSGU), scr, r, F.lane); continue; } r -= I_SGU;
        if (r < I_SDN) { p0_transpose_item<0>(F.w_sh_down, 256, DM, (h16*)(F.ws + WS_WSDN), scr, r, F.lane); continue; } r -= I_SDN;
        {
            const int q = r * 64 + F.lane, e = q / (DM / 4), k = (q % (DM / 4)) * 4;
            const f32x4 w = *(const f32x4*)(F.w_router + (size_t)e * DM + k);
            h16 hi[4], lo[4];
#pragma unroll
            for (int j = 0; j < 4; ++j) { hi[j] = (h16)w[j]; lo[j] = (h16)(w[j] - (float)hi[j]); }
            h16* dst = (h16*)(F.ws + WS_WRTR) + (size_t)e * 6144 + k;
            *(h16x4*)(dst) = (h16x4){hi[0], hi[1], hi[2], hi[3]}; *(h16x4*)(dst + 2048) = (h16x4){hi[0], hi[1], hi[2], hi[3]}; *(h16x4*)(dst + 4096) = (h16x4){lo[0], lo[1], lo[2], lo[3]};
        }
    }
}

__device__ __forceinline__ void p1_norm1(Frame& F) {
    LAS float* msh = (LAS float*)F.lds; LAS float* msc = msh + 3 * DM;
    const float* modp = (const float*)(F.ws + WS_MODP);
#pragma unroll 1
    for (int i0 = F.tid; i0 < 3 * 2 * DM; i0 += 4 * NTHR) { float pv[4][8], bs[4];
#pragma unroll
        for (int q = 0; q < 4; ++q) { const int i = i0 + q * NTHR, v = i / (2 * DM), cc = i % (2 * DM); bs[q] = F.b_mod[cc];
#pragma unroll
            for (int ks = 0; ks < 8; ++ks) pv[q][ks] = modp[(size_t)(ks * 3 + v) * (6 * DM) + cc]; }
#pragma unroll
        for (int q = 0; q < 4; ++q) { const int i = i0 + q * NTHR, v = i / (2 * DM), cc = i % (2 * DM); float s = bs[q];
#pragma unroll
            for (int ks = 0; ks < 8; ++ks) s += pv[q][ks];
            if (cc < DM) msh[v * DM + cc] = s; else msc[v * DM + cc - DM] = s; } }
    __syncthreads();
    const int gw = F.vcu * NWAVES + F.wave, NGW = F.G * NWAVES;
    h16* H = (h16*)(F.ws + WS_H);
    for (int r = gw; r < MALL; r += NGW) {
        const float* src = (r < MLAT) ? F.x + (size_t)r * DM : F.ctx + (size_t)(r - MLAT) * DM; const int v = (r < MLAT) ? (r / SEQ) : 2;
        f32x4 xv[8]; float ss = 0.f;
#pragma unroll
        for (int j = 0; j < 8; ++j) { xv[j] = *(const f32x4*)(src + 4 * F.lane + 256 * j); ss += (xv[j].x * xv[j].x + xv[j].y * xv[j].y) + (xv[j].z * xv[j].z + xv[j].w * xv[j].w); }
        const float rstd = 1.0f / sqrtf(wave_sum(ss) * (1.0f / DM) + EPS);
#pragma unroll
        for (int j = 0; j < 8; ++j) { const int cc = 4 * F.lane + 256 * j; const f32x4 nw = *(const f32x4*)(F.norm_attn + cc);
            const f32x4 sc = *(LAS f32x4*)(msc + v * DM + cc), sh = *(LAS f32x4*)(msh + v * DM + cc);
            const f32x4 y = xv[j] * rstd * nw * (sc + 1.0f) + sh;
            u32x2 o; o.x = pk2h(y.x, y.y); o.y = pk2h(y.z, y.w); *(u32x2*)(H + (size_t)r * DM + cc) = o; }
    }
    float* MOD = (float*)(F.ws + WS_MOD);
    for (int i = blockIdx.x * NTHR + F.tid; i < 3 * 6 * DM; i += F.G * NTHR) { const int v = i / (6 * DM), cc = i % (6 * DM); float s = F.b_mod[cc];
#pragma unroll
        for (int ks = 0; ks < 8; ++ks) s += modp[(size_t)(ks * 3 + v) * (6 * DM) + cc];
        MOD[i] = s; }
}


__device__ __forceinline__ int crow(int r, int hi) { return (r & 3) + 8 * (r >> 2) + 4 * hi; }
__device__ __forceinline__ h16x8 frag_row(const LAS unsigned char* base, int strideB, int r0, int k0, int lane) {
    return *(const LAS h16x8*)(base + (r0 + (lane & 31)) * strideB + (k0 + 8 * (lane >> 5)) * 2);
}
__device__ __forceinline__ v4i16_t tr16(const LAS unsigned char* p) { return __builtin_amdgcn_ds_read_tr16_b64_v4i16((LAS v4i16_t*)p); }
__device__ __forceinline__ h16x8 frag_tr(const LAS unsigned char* base, int strideB, int k0, int n0, int lane) {
    const int kb = k0 + 8 * (lane >> 5) + ((lane & 15) >> 2), nc = n0 + 16 * ((lane >> 4) & 1) + 4 * (lane & 3);
    const LAS unsigned char* p = base + kb * strideB + nc * 2;
    const v4i16_t lo = tr16(p), hi = tr16(p + 4 * strideB);
    typedef short s16x8 __attribute__((ext_vector_type(8)));
    const s16x8 v = {lo[0], lo[1], lo[2], lo[3], hi[0], hi[1], hi[2], hi[3]};
    return __builtin_bit_cast(h16x8, v);
}
__device__ __forceinline__ h16x8 frag_tr_perm(const LAS unsigned char* base, int strideB, int k0, int n0, int lane) {
    const int kb = k0 + 4 * (lane >> 5) + ((lane & 15) >> 2), nc = n0 + 16 * ((lane >> 4) & 1) + 4 * (lane & 3);
    const LAS unsigned char* p = base + kb * strideB + nc * 2;
    const v4i16_t lo = tr16(p), hi = tr16(p + 8 * strideB);
    typedef short s16x8 __attribute__((ext_vector_type(8)));
    const s16x8 v = {lo[0], lo[1], lo[2], lo[3], hi[0], hi[1], hi[2], hi[3]};
    return __builtin_bit_cast(h16x8, v);
}
__device__ __forceinline__ h16x8 pack8(float a0, float a1, float a2, float a3, float a4, float a5, float a6, float a7) {
    u32x4 w; w.x = pk2h(a0, a1); w.y = pk2h(a2, a3); w.z = pk2h(a4, a5); w.w = pk2h(a6, a7); return __builtin_bit_cast(h16x8, w);
}
#define MFMA32(a, b, c) __builtin_amdgcn_mfma_f32_32x32x16_f16((a), (b), (c), 0, 0, 0)

struct SchedG1 {
    pg8::StaticOrder so; int G, c;
    __device__ __forceinline__ bool next(int i, pg8::Unit& u) const {
        const int L = i * G + c;
        if (L < 32 * 52) return so.next(i, u);
        const int r = L - 32 * 52; if (r >= 40) return false;
        u.pm = 32 + r / 20; u.pn = r % 20; u.ko = 0; u.nt = 0; u.keep = 0; return true;
    }
};
struct EpiP {
    h16* P; const float* rope;
    __device__ __forceinline__ void operator()(f32x4 (&acc)[2][2][4][2], const pg8::Unit& u, int wr, int wc, int fr, int fq) const {
        const int colt = u.pn * 256; const bool lat = u.pm < 32;
        int kind;
        if (colt < C_RV) kind = 1; else if (colt < C_DK) kind = 0; else if (colt < C_DV) kind = 3; else if (colt < C_RQ) kind = 0; else if (colt < C_RG) kind = 2; else if (colt < C_DQ) kind = 5; else if (colt < C_GR) kind = 4; else kind = 6;
        if (!lat) kind = (kind == 1) ? 7 : 0;
#pragma unroll
        for (int ai = 0; ai < 2; ++ai)
#pragma unroll
            for (int m = 0; m < 4; ++m) {
                const int row = u.pm * 256 + ai * 128 + wr * 64 + m * 16 + fr; const int t = row & (SEQ - 1);
                h16* prow = P + (size_t)row * IN_COLS;
#pragma unroll
                for (int bj = 0; bj < 2; ++bj) {
                    const int cbase = colt + bj * 128 + wc * 32;
                    const f32x4 x0 = acc[ai][bj][m][0], x1 = acc[ai][bj][m][1];
                    f32x4 o0, o1; int c0, c1;
                    if (kind == 1 || kind == 2) {
                        const int g5 = (cbase >> 5) & 1, axis = (cbase >> 6) & 1, pos = axis ? (t & 63) : (t >> 6), j0 = 16 * g5 + 4 * fq;
                        const f32x4 cs = *(const f32x4*)(rope + pos * 32 + j0), sn = *(const f32x4*)(rope + 2048 + pos * 32 + j0);
                        o0 = x0 * cs - x1 * sn; o1 = x0 * sn + x1 * cs;
                        if (kind == 2) { o0 *= 0.08838834764831845f; o1 *= 0.08838834764831845f; }
                        c0 = (cbase & ~63) + j0; c1 = c0 + 32;
                    } else if (kind == 7) {
                        const int g5 = (cbase >> 5) & 1; c0 = (cbase & ~63) + 16 * g5 + 4 * fq; c1 = c0 + 32; o0 = x0; o1 = x1;
                    } else if (kind == 3 || kind == 4) {
                        const int axis = (cbase >> 5) & 1, pos = axis ? (t & 63) : (t >> 6), j0 = 4 * fq;
                        const f32x4 cs = *(const f32x4*)(rope + 4096 + pos * 16 + j0), sn = *(const f32x4*)(rope + 5120 + pos * 16 + j0);
                        o0 = x0 * cs - x1 * sn; o1 = x0 * sn + x1 * cs;
                        if (kind == 4) { o0 *= 0.18033688011112042f; o1 *= 0.18033688011112042f; }
                        c0 = cbase + j0; c1 = c0 + 16;
                    } else {
                        c0 = cbase + 4 * fq; c1 = c0 + 16; o0 = x0; o1 = x1;
                        if (kind == 5) {
#pragma unroll
                            for (int e = 0; e < 4; ++e) { o0[e] = silu_f(x0[e]); o1[e] = silu_f(x1[e]); }
                        } else if (kind == 6) {
#pragma unroll
                            for (int e = 0; e < 4; ++e) { o0[e] = sigmoid_f(x0[e]); o1[e] = sigmoid_f(x1[e]); }
                        }
                    }
                    u32x2 w0, w1; w0.x = pk2h(o0[0], o0[1]); w0.y = pk2h(o0[2], o0[3]); w1.x = pk2h(o1[0], o1[1]); w1.y = pk2h(o1[2], o1[3]);
                    *(u32x2*)(prow + c0) = w0; *(u32x2*)(prow + c1) = w1;
                }
            }
    }
};
__device__ __forceinline__ void p2_gemm1(Frame& F) {
    pg8::Gemm g{(const h16*)(F.ws + WS_H), (const h16*)(F.ws + WS_WINT), DM, DM, DM};
    SchedG1 S; S.so.init(MLAT, IN_COLS, F.G, (int)blockIdx.x); S.G = F.G; S.c = (int)blockIdx.x;
    EpiP E{(h16*)(F.ws + WS_P), (const float*)(F.ws + WS_ROPE)};
    pg8::gemm_phase<EpiP, SchedG1>(F.lds, g, S, E);
}

__device__ __forceinline__ void p3_ret_local(Frame& F) {
    LAS unsigned char* KF = F.lds; LAS unsigned char* KB = F.lds + 40960; LAS unsigned char* VH = F.lds + 81920;
    const h16* P = (const h16*)(F.ws + WS_P); h16* LST = (h16*)(F.ws + WS_LST);
    const int hi = F.lane >> 5;
    for (int u = F.vcu; u < 16 * 34; u += F.G) {
        const int bh = u / 34, cc = u % 34, b = bh >> 3, h = bh & 7;
        const int row0 = (cc < 2) ? (MLAT + b * CTXL + cc * 128) : (b * SEQ + (cc - 2) * 128);
        const float lgf = -__expf(F.ret_decay[h]), lgb = -__expf(F.ret_decay[8 + h]);
#pragma unroll
        for (int i = 0; i < 4; ++i) { const int q = F.tid + NTHR * i, row = q >> 4, ch = q & 15;
            const h16x8 kv = *(const h16x8*)(P + (size_t)(row0 + row) * IN_COLS + C_RK + h * 128 + ch * 8);
            const float sf = __expf(lgf * (float)(127 - row)), sb = __expf(lgb * (float)row);
            *(LAS h16x8*)(KF + row * 320 + ch * 16) = pack8((float)kv[0] * sf, (float)kv[1] * sf, (float)kv[2] * sf, (float)kv[3] * sf, (float)kv[4] * sf, (float)kv[5] * sf, (float)kv[6] * sf, (float)kv[7] * sf);
            *(LAS h16x8*)(KB + row * 320 + ch * 16) = pack8((float)kv[0] * sb, (float)kv[1] * sb, (float)kv[2] * sb, (float)kv[3] * sb, (float)kv[4] * sb, (float)kv[5] * sb, (float)kv[6] * sb, (float)kv[7] * sb); }
        for (int eh = 0; eh < 2; ++eh) {
            if (eh) __syncthreads();
#pragma unroll
            for (int i = 0; i < 4; ++i) { const int q = F.tid + NTHR * i, row = q >> 4, ch = q & 15;
                *(LAS h16x8*)(VH + row * 320 + ch * 16) = *(const h16x8*)(P + (size_t)(row0 + row) * IN_COLS + C_RV + h * 256 + eh * 128 + ch * 8); }
            __syncthreads();
            const int dir = F.wave >> 2, eb = F.wave & 3; const LAS unsigned char* Kd = dir ? KB : KF;
            f32x16 acc[4];
#pragma unroll
            for (int db = 0; db < 4; ++db) acc[db] = (f32x16){};
#pragma unroll
            for (int ks = 0; ks < 8; ++ks) { const h16x8 a = frag_tr(VH, 320, 16 * ks, 32 * eb, F.lane);
#pragma unroll
                for (int db = 0; db < 4; ++db) { const h16x8 bb = frag_tr(Kd, 320, 16 * ks, 32 * db, F.lane); acc[db] = MFMA32(a, bb, acc[db]); } }
            h16* dst = LST + ((size_t)((dir * 16 + bh) * 34 + cc) * 256 + eh * 128 + eb * 32) * 128;
#pragma unroll
            for (int db = 0; db < 4; ++db)
#pragma unroll
                for (int r = 0; r < 16; ++r) dst[crow(r, hi) * 128 + db * 32 + (F.lane & 31)] = (h16)acc[db][r];
        }
        __syncthreads();
    }
}
__device__ __forceinline__ void p4_ret_scan(Frame& F) {
    const h16* LST = (const h16*)(F.ws + WS_LST); h16* SST = (h16*)(F.ws + WS_SST);
    for (int g = blockIdx.x * NTHR + F.tid; g < 2 * 16 * 4096; g += F.G * NTHR) {
        const int seq = g >> 12, off = (g & 4095) * 8, dir = seq >> 4, bh = seq & 15, h = bh & 7;
        const float cd = __expf(-__expf(F.ret_decay[dir * 8 + h]) * 128.0f);
        const h16* Lp = LST + (size_t)seq * 34 * 32768 + off; h16* Sp = SST + (size_t)seq * 32 * 32768 + off;
        float s[8];
#pragma unroll
        for (int e = 0; e < 8; ++e) s[e] = 0.f;
        if (dir == 0) {
            for (int cc = 0; cc < 33; ++cc) {
                if (cc >= 2) *(h16x8*)(Sp + (size_t)(cc - 2) * 32768) = pack8(s[0], s[1], s[2], s[3], s[4], s[5], s[6], s[7]);
                const h16x8 l = *(const h16x8*)(Lp + (size_t)cc * 32768);
#pragma unroll
                for (int e = 0; e < 8; ++e) s[e] = s[e] * cd + (float)l[e];
            }
            *(h16x8*)(Sp + (size_t)31 * 32768) = pack8(s[0], s[1], s[2], s[3], s[4], s[5], s[6], s[7]);
        } else {
            { const h16x8 l1 = *(const h16x8*)(Lp + (size_t)1 * 32768), l0 = *(const h16x8*)(Lp);
#pragma unroll
              for (int e = 0; e < 8; ++e) s[e] = (float)l1[e] * cd + (float)l0[e]; }
            for (int c = 31; c >= 0; --c) {
                *(h16x8*)(Sp + (size_t)c * 32768) = pack8(s[0], s[1], s[2], s[3], s[4], s[5], s[6], s[7]);
                const h16x8 l = *(const h16x8*)(Lp + (size_t)(c + 2) * 32768);
#pragma unroll
                for (int e = 0; e < 8; ++e) s[e] = s[e] * cd + (float)l[e];
            }
        }
    }
}
__device__ __forceinline__ void p5_ret_out(Frame& F) {
    LAS unsigned char* QL = F.lds; LAS unsigned char* KL = F.lds + 34816; LAS unsigned char* PL = KL; LAS unsigned char* VL = F.lds + 69632;
    LAS float* RED = (LAS float*)(F.lds + 69632 + 73728);
    const h16* P = (const h16*)(F.ws + WS_P); const h16* SST = (const h16*)(F.ws + WS_SST); h16* ARET = (h16*)(F.ws + WS_ACAT);
    const int hi = F.lane >> 5, ln = F.lane & 31, w = F.wave;
    for (int u = F.vcu; u < 512; u += F.G) {
        const int bh = u >> 5, c = u & 31, b = bh >> 3, h = bh & 7, row0 = b * SEQ + c * 128;
        const float lgf = -__expf(F.ret_decay[h]), lgb = -__expf(F.ret_decay[8 + h]);
#pragma unroll
        for (int i = 0; i < 4; ++i) { const int q = F.tid + NTHR * i, row = q >> 4, ch = q & 15; const h16* pr = P + (size_t)(row0 + row) * IN_COLS + h * 128 + ch * 8;
            *(LAS h16x8*)(QL + row * 272 + ch * 16) = *(const h16x8*)(pr + C_RQ); *(LAS h16x8*)(KL + row * 272 + ch * 16) = *(const h16x8*)(pr + C_RK); }
        h16x8 vreg[8];
#pragma unroll
        for (int i = 0; i < 8; ++i) { const int q = F.tid + NTHR * i, row = q >> 5, c32 = q & 31; vreg[i] = *(const h16x8*)(P + (size_t)(row0 + row) * IN_COLS + C_RV + h * 256 + c32 * 8); }
        __syncthreads();
        u32x2 pw[2][4];
        { const int jt = w >> 1;
#pragma unroll
          for (int t2 = 0; t2 < 2; ++t2) { const int ib = 2 * (w & 1) + t2, il = 32 * ib + ln; f32x16 s = (f32x16){};
#pragma unroll
            for (int ks = 0; ks < 8; ++ks) s = MFMA32(frag_row(KL, 272, 32 * jt, 16 * ks, F.lane), frag_row(QL, 272, 32 * ib, 16 * ks, F.lane), s);
#pragma unroll
            for (int r = 0; r < 16; ++r) { const int d = il - (32 * jt + crow(r, hi)); s[r] *= (d >= 0) ? __expf(lgf * (float)d) : __expf(lgb * (float)(-d)); }
#pragma unroll
            for (int r4 = 0; r4 < 4; ++r4) { pw[t2][r4].x = pk2h(s[4 * r4], s[4 * r4 + 1]); pw[t2][r4].y = pk2h(s[4 * r4 + 2], s[4 * r4 + 3]); } } }
        __syncthreads();
        { const int jt = w >> 1;
#pragma unroll
          for (int t2 = 0; t2 < 2; ++t2) { const int il = 32 * (2 * (w & 1) + t2) + ln;
#pragma unroll
            for (int r4 = 0; r4 < 4; ++r4) *(LAS u32x2*)(PL + il * 272 + (32 * jt + 8 * r4 + 4 * hi) * 2) = pw[t2][r4]; } }
#pragma unroll
        for (int i = 0; i < 8; ++i) { const int q = F.tid + NTHR * i, row = q >> 5, c32 = q & 31; *(LAS h16x8*)(VL + row * 576 + c32 * 16) = vreg[i]; }
        __syncthreads();
        f32x16 o[4];
#pragma unroll
        for (int ib = 0; ib < 4; ++ib) o[ib] = (f32x16){};
#pragma unroll
        for (int k16 = 0; k16 < 8; ++k16) { const h16x8 a = frag_tr(VL, 576, 16 * k16, 32 * w, F.lane);
#pragma unroll
            for (int ib = 0; ib < 4; ++ib) o[ib] = MFMA32(a, frag_row(PL, 272, 32 * ib, 16 * k16, F.lane), o[ib]);
            if (k16 & 1) __builtin_amdgcn_sched_barrier(0); }
#pragma unroll
        for (int dir = 0; dir < 2; ++dir) {
            h16 sc[4];
#pragma unroll
            for (int ib = 0; ib < 4; ++ib) { const int il = 32 * ib + ln; sc[ib] = (h16)(dir ? __expf(lgb * (float)(128 - il)) : __expf(lgf * (float)(il + 1))); }
            const h16* Sg = SST + ((size_t)((dir * 16 + bh) * 32 + c) * 256 + 32 * w + ln) * 128 + 8 * hi;
#pragma unroll
            for (int kh = 0; kh < 2; ++kh) {
                h16x8 sa[4];
#pragma unroll
                for (int k4 = 0; k4 < 4; ++k4) sa[k4] = *(const h16x8*)(Sg + 16 * (4 * kh + k4));
#pragma unroll
                for (int k4 = 0; k4 < 4; ++k4) {
#pragma unroll
                    for (int ib = 0; ib < 4; ++ib) o[ib] = MFMA32(sa[k4], frag_row(QL, 272, 32 * ib, 16 * (4 * kh + k4), F.lane) * sc[ib], o[ib]);
                    __builtin_amdgcn_sched_barrier(0); }
            }
        }
#pragma unroll
        for (int ib = 0; ib < 4; ++ib) { float ss = 0.f;
#pragma unroll
            for (int r = 0; r < 16; ++r) ss += o[ib][r] * o[ib][r];
            ss += __shfl_xor(ss, 32);
            if (hi == 0) RED[(w * 4 + ib) * 32 + ln] = ss; }
        __syncthreads();
#pragma unroll
        for (int ib = 0; ib < 4; ++ib) { float tot = 0.f;
#pragma unroll
            for (int ww = 0; ww < 8; ++ww) tot += RED[(ww * 4 + ib) * 32 + ln];
            const float rstd = 1.0f / sqrtf(tot * (1.0f / 256.0f) + EPS);
            const size_t grow = (size_t)(row0 + 32 * ib + ln);
#pragma unroll
            for (int r4 = 0; r4 < 4; ++r4) { const int e = 32 * w + 8 * r4 + 4 * hi;
                const h16x4 gt = *(const h16x4*)(P + grow * IN_COLS + C_RG + h * 256 + e);
                u32x2 wv; wv.x = pk2h(o[ib][4 * r4] * rstd * (float)gt[0], o[ib][4 * r4 + 1] * rstd * (float)gt[1]); wv.y = pk2h(o[ib][4 * r4 + 2] * rstd * (float)gt[2], o[ib][4 * r4 + 3] * rstd * (float)gt[3]);
                *(u32x2*)(ARET + grow * 3072 + h * 256 + e) = wv; } }
        __syncthreads();
    }
}
__device__ __forceinline__ void p6_attn(Frame& F) {
    const h16* P = (const h16*)(F.ws + WS_P); h16* ADIF = (h16*)(F.ws + WS_ACAT) + 2048;
    const int hi = F.lane >> 5, ln = F.lane & 31;
    float lam;
    { const float s1 = wave_sum(F.diff_lambda[F.lane] * F.diff_lambda[64 + F.lane]), s2 = wave_sum(F.diff_lambda[128 + F.lane] * F.diff_lambda[192 + F.lane]); lam = __expf(s1) - __expf(s2) + 0.2f; }
    constexpr int KT0 = 0, VT0 = 34816, KTB = 17408, VTB = 20480;
    LAS float* XB = (LAS float*)F.lds;
    for (int u = F.vcu; u < 512; u += F.G) {
        const int bh = u >> 5, qb = u & 31, b = bh >> 3, h = bh & 7;
        const int cm = F.wave & 1, qs = F.wave >> 1, qrow0 = b * SEQ + qb * 128 + qs * 32;
        h16x8 qf[4];
#pragma unroll
        for (int ks = 0; ks < 4; ++ks) qf[ks] = *(const h16x8*)(P + (size_t)(qrow0 + ln) * IN_COLS + C_DQ + h * 128 + cm * 64 + 16 * ks + 8 * hi);
        f32x16 o[4];
#pragma unroll
        for (int et = 0; et < 4; ++et) o[et] = (f32x16){};
        float mrun = 0.f, lsum = 0.f; f32x16 negm = (f32x16){};
        h16x8 kreg[2], vreg[2];
#define ATT_LOAD(t) do { _Pragma("unroll") for (int i = 0; i < 2; ++i) { const int q = F.tid + NTHR * i, row = q >> 4, ch = q & 15; const int j = (t) * 64 + row; \
            const size_t srow = (j < CTXL) ? (size_t)(MLAT + b * CTXL + j) : (size_t)(b * SEQ + j - CTXL); const h16* pr = P + srow * IN_COLS + h * 128 + ch * 8; \
            kreg[i] = *(const h16x8*)(pr + C_DK); vreg[i] = *(const h16x8*)(pr + C_DV); } } while (0)
#define ATT_WRITE(buf) do { _Pragma("unroll") for (int i = 0; i < 2; ++i) { const int q = F.tid + NTHR * i, row = q >> 4, ch = q & 15; \
            *(LAS h16x8*)(F.lds + KT0 + (buf) * KTB + row * 272 + ch * 16) = kreg[i]; *(LAS h16x8*)(F.lds + VT0 + (buf) * VTB + row * 320 + ch * 16) = vreg[i]; } } while (0)
        ATT_LOAD(0); ATT_WRITE(0);
        __syncthreads();
        constexpr int NT = (CTXL + SEQ) / 64;
        for (int t = 0; t < NT; ++t) {
            const int buf = t & 1;
            if (t + 1 < NT) ATT_LOAD(t + 1);
            const LAS unsigned char* Kt = F.lds + KT0 + buf * KTB; const LAS unsigned char* Vt = F.lds + VT0 + buf * VTB;
            f32x16 s[2];
#pragma unroll
            for (int kt = 0; kt < 2; ++kt) { s[kt] = negm;
#pragma unroll
                for (int ks = 0; ks < 4; ++ks) s[kt] = MFMA32(frag_row(Kt, 272, 32 * kt, cm * 64 + 16 * ks, F.lane), qf[ks], s[kt]); }
            float mx = s[0][0];
#pragma unroll
            for (int r = 0; r < 16; ++r) { mx = fmaxf(mx, s[0][r]); mx = fmaxf(mx, s[1][r]); }
            { const auto rr = __builtin_amdgcn_permlane32_swap(__float_as_uint(mx), __float_as_uint(mx), false, false); mx = fmaxf(__uint_as_float(rr[0]), __uint_as_float(rr[1])); }
            if (t == 0 || __any(mx > 8.0f)) { const float dl = (t == 0) ? mx : fmaxf(mx, 0.0f), alpha = (t == 0) ? 0.0f : __builtin_amdgcn_exp2f(-dl); mrun += dl; lsum *= alpha;
#pragma unroll
                for (int et = 0; et < 4; ++et) o[et] *= alpha;
#pragma unroll
                for (int kt = 0; kt < 2; ++kt)
#pragma unroll
                    for (int r = 0; r < 16; ++r) s[kt][r] -= dl;
#pragma unroll
                for (int r = 0; r < 16; ++r) negm[r] = -mrun; }
            f32x2 ps2 = {0.f, 0.f};
#pragma unroll
            for (int kt = 0; kt < 2; ++kt)
#pragma unroll
                for (int r = 0; r < 16; r += 2) { s[kt][r] = __builtin_amdgcn_exp2f(s[kt][r]); s[kt][r + 1] = __builtin_amdgcn_exp2f(s[kt][r + 1]); ps2 += (f32x2){s[kt][r], s[kt][r + 1]}; }
            lsum += ps2[0] + ps2[1];
#pragma unroll
            for (int kt = 0; kt < 2; ++kt)
#pragma unroll
                for (int s2 = 0; s2 < 2; ++s2) {
                    const h16x8 pbf = pack8(s[kt][8 * s2], s[kt][8 * s2 + 1], s[kt][8 * s2 + 2], s[kt][8 * s2 + 3], s[kt][8 * s2 + 4], s[kt][8 * s2 + 5], s[kt][8 * s2 + 6], s[kt][8 * s2 + 7]);
#pragma unroll
                    for (int et = 0; et < 4; ++et) o[et] = MFMA32(frag_tr_perm(Vt, 320, 32 * kt + 16 * s2, 32 * et, F.lane), pbf, o[et]);
                }
            if (t + 1 < NT) ATT_WRITE(buf ^ 1);
            __syncthreads();
        }
#undef ATT_LOAD
#undef ATT_WRITE
        lsum += __shfl_xor(lsum, 32);
        const float inv = 1.0f / lsum;
        if (cm == 1) {
#pragma unroll
            for (int et = 0; et < 4; ++et)
#pragma unroll
                for (int r = 0; r < 16; ++r) XB[(qs * 128 + 32 * et + crow(r, hi)) * 32 + ln] = o[et][r] * inv;
        }
        __syncthreads();
        if (cm == 0) {
            float ss = 0.f;
#pragma unroll
            for (int et = 0; et < 4; ++et)
#pragma unroll
                for (int r = 0; r < 16; ++r) { const float v = o[et][r] * inv - lam * XB[(qs * 128 + 32 * et + crow(r, hi)) * 32 + ln]; o[et][r] = v; ss += v * v; }
            ss += __shfl_xor(ss, 32);
            const float rstd = 0.8f / sqrtf(ss * (1.0f / 128.0f) + EPS);
            const size_t grow = (size_t)(qrow0 + ln);
#pragma unroll
            for (int et = 0; et < 4; ++et)
#pragma unroll
                for (int r4 = 0; r4 < 4; ++r4) { const int e = 32 * et + 8 * r4 + 4 * hi; const f32x4 sw = *(const f32x4*)(F.diff_subln + e);
                    u32x2 w; w.x = pk2h(o[et][4 * r4] * rstd * sw[0], o[et][4 * r4 + 1] * rstd * sw[1]); w.y = pk2h(o[et][4 * r4 + 2] * rstd * sw[2], o[et][4 * r4 + 3] * rstd * sw[3]);
                    *(u32x2*)(ADIF + grow * 3072 + h * 128 + e) = w; }
        }
        __syncthreads();
    }
}
struct SchedG2 {
    pg8::StaticOrder so;
    __device__ __forceinline__ bool next(int i, pg8::Unit& u) const { if (!so.next(i >> 1, u)) return false; if (i & 1) { u.ko = 2048; u.nt = 16; u.keep = 0; } else { u.ko = 0; u.nt = 32; u.keep = 1; } return true; }
};
struct EpiU2 {
    h16* U; const h16* P;
    __device__ __forceinline__ void operator()(f32x4 (&acc)[2][2][4][2], const pg8::Unit& u, int wr, int wc, int fr, int fq) const {
#pragma unroll
        for (int ai = 0; ai < 2; ++ai)
#pragma unroll
            for (int m = 0; m < 4; ++m) { const int row = u.pm * 256 + ai * 128 + wr * 64 + m * 16 + fr;
#pragma unroll
                for (int bj = 0; bj < 2; ++bj)
#pragma unroll
                    for (int n = 0; n < 2; ++n) { const int col = u.pn * 256 + bj * 128 + wc * 32 + 16 * n + 4 * fq;
                        const h16x4 gd = *(const h16x4*)(P + (size_t)row * IN_COLS + C_GD + col);
                        if (u.keep) { const h16x4 gr = *(const h16x4*)(P + (size_t)row * IN_COLS + C_GR + col);
#pragma unroll
                            for (int e = 0; e < 4; ++e) acc[ai][bj][m][n][e] *= (float)gr[e] * __builtin_amdgcn_rcpf((float)gd[e]);
                        } else { const f32x4 a = acc[ai][bj][m][n];
                            u32x2 w; w.x = pk2h(a[0] * (float)gd[0], a[1] * (float)gd[1]); w.y = pk2h(a[2] * (float)gd[2], a[3] * (float)gd[3]);
                            *(u32x2*)(U + (size_t)row * DM + col) = w; } } }
    }
};
struct EpiX1 {
    float* X1; const float* x; const float* MOD;
    __device__ __forceinline__ void operator()(f32x4 (&acc)[2][2][4][2], const pg8::Unit& u, int wr, int wc, int fr, int fq) const {
        const int b = (u.pm * 256) / SEQ;
#pragma unroll
        for (int ai = 0; ai < 2; ++ai)
#pragma unroll
            for (int m = 0; m < 4; ++m) { const int row = u.pm * 256 + ai * 128 + wr * 64 + m * 16 + fr;
#pragma unroll
                for (int bj = 0; bj < 2; ++bj)
#pragma unroll
                    for (int n = 0; n < 2; ++n) { const int col = u.pn * 256 + bj * 128 + wc * 32 + 16 * n + 4 * fq;
                        const f32x4 g1 = *(const f32x4*)(MOD + (size_t)b * (6 * DM) + 2 * DM + col); const f32x4 xv = *(const f32x4*)(x + (size_t)row * DM + col);
                        *(f32x4*)(X1 + (size_t)row * DM + col) = xv + g1 * acc[ai][bj][m][n]; } }
    }
};
__device__ __forceinline__ void p7_gemm2(Frame& F) {
    pg8::Gemm g{(const h16*)(F.ws + WS_ACAT), (const h16*)(F.ws + WS_WCAT), 3072, 3072, 2048};
    SchedG2 S; S.so.init(MLAT, DM, F.G, (int)blockIdx.x);
    EpiU2 E{(h16*)(F.ws + WS_U), (const h16*)(F.ws + WS_P)};
    pg8::gemm_phase<EpiU2, SchedG2>(F.lds, g, S, E);
}
__device__ __forceinline__ void p9_gemm3(Frame& F) {
    pg8::Gemm g{(const h16*)(F.ws + WS_U), (const h16*)(F.ws + WS_WOUT), 2048, 2048, 2048};
    pg8::StaticOrder S; S.init(MLAT, DM, F.G, (int)blockIdx.x);
    EpiX1 E{(float*)(F.ws + WS_X1), F.x, (const float*)(F.ws + WS_MOD)};
    pg8::gemm_phase<EpiX1, pg8::StaticOrder>(F.lds, g, S, E);
}


__device__ __forceinline__ void p10_norm2(Frame& F) {
    const float* X1 = (const float*)(F.ws + WS_X1); const float* MOD = (const float*)(F.ws + WS_MOD); h16* H2X = (h16*)(F.ws + WS_H2X);
    const int gw = F.vcu * NWAVES + F.wave, NGW = F.G * NWAVES;
    for (int r = gw; r < MLAT; r += NGW) {
        const float* src = X1 + (size_t)r * DM; const int b = r / SEQ;
        f32x4 xv[8]; float ss = 0.f;
#pragma unroll
        for (int j = 0; j < 8; ++j) { xv[j] = *(const f32x4*)(src + 4 * F.lane + 256 * j); ss += (xv[j].x * xv[j].x + xv[j].y * xv[j].y) + (xv[j].z * xv[j].z + xv[j].w * xv[j].w); }
        const float rstd = 1.0f / sqrtf(wave_sum(ss) * (1.0f / DM) + EPS);
#pragma unroll
        for (int j = 0; j < 8; ++j) { const int cc = 4 * F.lane + 256 * j; const f32x4 nw = *(const f32x4*)(F.norm_ffn + cc);
            const f32x4 sh = *(const f32x4*)(MOD + (size_t)b * (6 * DM) + 3 * DM + cc), sc = *(const f32x4*)(MOD + (size_t)b * (6 * DM) + 4 * DM + cc);
            const f32x4 y = xv[j] * rstd * nw * (sc + 1.0f) + sh;
            h16 hh[4], ll[4];
#pragma unroll
            for (int e = 0; e < 4; ++e) { hh[e] = (h16)y[e]; ll[e] = (h16)(y[e] - (float)hh[e]); }
            h16* dst = H2X + (size_t)r * 6144 + cc;
            *(h16x4*)(dst) = (h16x4){hh[0], hh[1], hh[2], hh[3]}; *(h16x4*)(dst + 4096) = (h16x4){hh[0], hh[1], hh[2], hh[3]}; *(h16x4*)(dst + 2048) = (h16x4){ll[0], ll[1], ll[2], ll[3]};
            { int p8 = __builtin_amdgcn_cvt_pk_fp8_f32(y[0], y[1], 0, false); p8 = __builtin_amdgcn_cvt_pk_fp8_f32(y[2], y[3], p8, true); *(int*)((unsigned char*)(F.ws + WS_H2F8) + (size_t)r * DM + cc) = p8; } }
    }
}
struct SchedRT {
    int G, c;
    __device__ __forceinline__ bool next(int i, pg8::Unit& u) const { const int L = i * G + c; if (L >= 256) return false; u.pm = L >> 3; u.pn = 0; u.ko = (L & 7) * 768; u.nt = 0; u.keep = 0; return true; }
};
struct EpiLG {
    float* LGP;
    __device__ __forceinline__ void operator()(f32x4 (&acc)[2][2][4][2], const pg8::Unit& u, int wr, int wc, int fr, int fq) const {
        float* dst = LGP + (size_t)(u.ko / 768) * MLAT * NEXP;
#pragma unroll
        for (int ai = 0; ai < 2; ++ai)
#pragma unroll
            for (int m = 0; m < 4; ++m) { const int row = u.pm * 256 + ai * 128 + wr * 64 + m * 16 + fr;
#pragma unroll
                for (int bj = 0; bj < 2; ++bj)
#pragma unroll
                    for (int n = 0; n < 2; ++n) { const int col = bj * 128 + wc * 32 + 16 * n + 4 * fq; *(f32x4*)(dst + (size_t)row * NEXP + col) = acc[ai][bj][m][n]; } }
    }
};
__device__ __forceinline__ void p11_router(Frame& F) {
    pg8::Gemm g{(const h16*)(F.ws + WS_H2X), (const h16*)(F.ws + WS_WRTR), 6144, 6144, 768};
    SchedRT S; S.G = F.G; S.c = (int)blockIdx.x;
    EpiLG E{(float*)(F.ws + WS_LGP)};
    pg8::gemm_phase<EpiLG, SchedRT>(F.lds, g, S, E);
}
__device__ __forceinline__ void p12_topk(Frame& F) {
    const float* LGP = (const float*)(F.ws + WS_LGP); int* EIDX = (int*)(F.ws + WS_EIDX); float* EW = (float*)(F.ws + WS_EW); u32x2* LIST = (u32x2*)(F.ws + WS_LIST2);
    unsigned* CNT = (unsigned*)(F.ws + WS_CTL) + CW_CNT;
    const int gw = F.vcu * NWAVES + F.wave, NGW = F.G * NWAVES, lane = F.lane;
    const f32x4 bias = *(const f32x4*)(F.router_bias + 4 * lane);
    f32x4 lgn[8];
#pragma unroll
    for (int ks = 0; ks < 8; ++ks) lgn[ks] = *(const f32x4*)(LGP + ((size_t)ks * MLAT + (gw < MLAT ? gw : 0)) * NEXP + 4 * lane);
    for (int t = gw; t < MLAT; t += NGW) {
        f32x4 lg = lgn[0];
#pragma unroll
        for (int ks = 1; ks < 8; ++ks) lg += lgn[ks];
        { const int tn = (t + NGW < MLAT) ? t + NGW : t;
#pragma unroll
          for (int ks = 0; ks < 8; ++ks) lgn[ks] = *(const f32x4*)(LGP + ((size_t)ks * MLAT + tn) * NEXP + 4 * lane); }
        float sc[4], sel[4];
#pragma unroll
        for (int i = 0; i < 4; ++i) { sc[i] = 1.0f / (1.0f + __expf(-lg[i])); sel[i] = sc[i] + bias[i]; }
        float a1 = fmaxf(sel[0], sel[1]), a2 = fminf(sel[0], sel[1]);
        { const float b1 = fmaxf(sel[2], sel[3]), b2 = fminf(sel[2], sel[3]); const float n1 = fmaxf(a1, b1), n2 = fmaxf(fminf(a1, b1), fmaxf(a2, b2)); a1 = n1; a2 = n2; }
#pragma unroll
        for (int off = 1; off < 8; off <<= 1) { const float b1 = __shfl_xor(a1, off), b2 = __shfl_xor(a2, off); const float n1 = fmaxf(a1, b1), n2 = fmaxf(fminf(a1, b1), fmaxf(a2, b2)); a1 = n1; a2 = n2; }
        const float gs = a1 + a2; const int g = lane >> 3;
        int rank = 0;
#pragma unroll
        for (int j = 0; j < 8; ++j) { const float o = __shfl(gs, 8 * j); rank += (o > gs || (o == gs && j < g)) ? 1 : 0; }
        const bool gsel = rank < 4;
        float ms[4];
#pragma unroll
        for (int i = 0; i < 4; ++i) ms[i] = gsel ? sel[i] : -INFINITY;
        float myw = 0.f; int mye = 0; float wsum = 0.f;
#pragma unroll
        for (int k = 0; k < TOPK; ++k) {
            float bv = ms[0]; int bi = 4 * lane;
#pragma unroll
            for (int i = 1; i < 4; ++i) if (ms[i] > bv) { bv = ms[i]; bi = 4 * lane + i; }
#pragma unroll
            for (int off = 1; off < 64; off <<= 1) { const float ov = __shfl_xor(bv, off); const int oi = __shfl_xor(bi, off); if (ov > bv || (ov == bv && oi < bi)) { bv = ov; bi = oi; } }
            const int ol = bi >> 2, oi = bi & 3;
            const float mysc = (oi == 0) ? sc[0] : (oi == 1) ? sc[1] : (oi == 2) ? sc[2] : sc[3];
            const float w = __shfl(mysc, ol);
            if (lane == ol) {
#pragma unroll
                for (int i = 0; i < 4; ++i) if (i == oi) ms[i] = -INFINITY; }
            wsum += w;
            if (lane == k) { myw = w; mye = bi; }
        }
        if (lane < TOPK) {
            const float wn = myw / wsum * 2.5f;
            EIDX[t * TOPK + lane] = mye; EW[t * TOPK + lane] = wn;
            const unsigned pos = atomicAdd(&CNT[mye], 1u);
            LIST[mye * MLAT + pos] = (u32x2){(unsigned)(t * TOPK + lane), __float_as_uint(wn)};
        }
    }
}
constexpr int EX_NSTG = 3, EX_ASTG = 24576, EX_WSTG = 16384, EX_A0 = 0, EX_W0 = EX_NSTG * EX_ASTG, EX_WH0 = EX_W0 + EX_NSTG * EX_WSTG, EX_WHS = 10240, EX_ROW0 = EX_WH0 + 2 * EX_WHS;
constexpr int EX_TAB0 = EX_ROW0 + 3200, EX_SCR0 = EX_TAB0 + 3072;
static_assert(EX_ROW0 == 143360 && EX_SCR0 + 8192 <= LDSCTL_OFF, "expert LDS map");
template <bool GU>
__device__ __forceinline__ void ring_w_prologue(Frame& F, const float* W, int cgrp) {
    constexpr int LDB = GU ? 512 : 2048;
    const int lane = F.lane, w = F.wave, v = 4 * (lane & 31);
    const int wcol0 = GU ? (((v >> 5) & 1) * 256 + 32 * (v >> 6) + (v & 31) + 64 * cgrp) : (v + 512 * cgrp);
    const float* wlane = W + (size_t)(4 * w + (lane >> 5)) * LDB + wcol0;
#pragma unroll
    for (int s = 0; s < 3; ++s)
#pragma unroll
        for (int j = 0; j < 2; ++j) __builtin_amdgcn_global_load_lds((const unsigned*)(wlane + (size_t)(s * 32 + 2 * j) * LDB), (LAS unsigned*)(F.lds + EX_W0 + s * EX_WSTG + (2 * w + j) * 1024), 16, 0, 2);
}
template <bool GU, int NLAY>
__device__ __forceinline__ void expert_ring(Frame& F, const float* W, const h16* Abase, const int (&arow)[3], int nr, int cgrp, h16* ACTrow0, h16* Y) {
    constexpr int KT = GU ? 64 : 8, NP = GU ? 1 : 4, LDB = GU ? 512 : 2048, NS = KT * NP;
    const int tid = F.tid, lane = F.lane, hi = lane >> 5, ln = lane & 31, cp = F.wave & 1, rg = F.wave >> 1, w = F.wave;
    const LAS int* RSLOT = (const LAS int*)(F.lds + EX_ROW0); const LAS float* RW = (const LAS float*)(F.lds + EX_ROW0 + 1536);
    const int ngrp = (nr + 15) >> 4;
    const int nA = (w < ngrp ? 1 : 0) + (w + 8 < ngrp ? 1 : 0) + (w + 16 < ngrp ? 1 : 0);
    const int achunk = ((lane & 3) ^ ((lane >> 4) & 3)) * 8;
    const int v = 4 * (lane & 31);
    const int wcol0 = GU ? (((v >> 5) & 1) * 256 + 32 * (v >> 6) + (v & 31) + 64 * cgrp) : (v + 512 * cgrp);
    const float* wlane = W + (size_t)(4 * w + (lane >> 5)) * LDB + wcol0;
    const unsigned lds0 = (unsigned)(uintptr_t)F.lds;
    const int xs = (ln >> 2) & 3;
    const unsigned aofs0 = (unsigned)((2 * rg + (ln >> 4)) * 1024 + (ln & 15) * 64 + ((hi ^ xs) * 16)), aofs1 = (unsigned)((2 * rg + (ln >> 4)) * 1024 + (ln & 15) * 64 + (((2 + hi) ^ xs) * 16));
    const unsigned tofs = (unsigned)((8 * hi + ((lane & 15) >> 2)) * 320 + (64 * cp + 16 * ((lane >> 4) & 1) + 4 * (lane & 3)) * 2);
    f32x16 acc[2 * NLAY];
#pragma unroll
    for (int i = 0; i < 2 * NLAY; ++i) acc[i] = (f32x16){};
#define EX_DMA_A(s) do { const int kt_ = (s) % KT, stg_ = (s) % EX_NSTG; \
        _Pragma("unroll") for (int j = 0; j < 3; ++j) if (j < nA) __builtin_amdgcn_global_load_lds((const unsigned*)(Abase + arow[j] + kt_ * 32 + achunk), (LAS unsigned*)(F.lds + EX_A0 + stg_ * EX_ASTG + (w + 8 * j) * 1024), 16, 0, 0); } while (0)
#define EX_DMA_W(s) do { const int pass_ = (s) / KT, kt_ = (s) % KT, stg_ = (s) % EX_NSTG; \
        _Pragma("unroll") for (int j = 0; j < 2; ++j) __builtin_amdgcn_global_load_lds((const unsigned*)(wlane + (size_t)(kt_ * 32 + 2 * j) * LDB + 128 * pass_), (LAS unsigned*)(F.lds + EX_W0 + stg_ * EX_WSTG + (2 * w + j) * 1024), 16, 0, 2); } while (0)
#define EX_WAITV(k) asm volatile("s_waitcnt vmcnt(" #k ")" ::: "memory")
#define EX_WAITN() do { if (nA == 3) EX_WAITV(5); else if (nA == 2) EX_WAITV(4); else if (nA == 1) EX_WAITV(3); else EX_WAITV(2); } while (0)
    const unsigned cvsrc = lds0 + EX_W0 + (tid >> 4) * 512 + (tid & 15) * 32, cvdst = lds0 + EX_WH0 + (tid >> 4) * 320 + (tid & 15) * 16;
    EX_DMA_A(0); EX_DMA_A(1);
    if (nA == 3) EX_WAITV(3); else if (nA == 2) EX_WAITV(2); else if (nA == 1) EX_WAITV(1); else EX_WAITV(0);
    __builtin_amdgcn_s_barrier(); asm volatile("" ::: "memory");
    { f32x4 c0, c1; asm volatile("ds_read_b128 %0, %2\n\tds_read_b128 %1, %2 offset:16\n\ts_waitcnt lgkmcnt(0)" : "=&v"(c0), "=&v"(c1) : "v"(cvsrc) : "memory");
      const h16x8 hv = pack8(c0[0], c0[1], c0[2], c0[3], c1[0], c1[1], c1[2], c1[3]); asm volatile("ds_write_b128 %0, %1" :: "v"(cvdst), "v"(hv) : "memory"); }
    typedef short s16x8 __attribute__((ext_vector_type(8)));
    for (int s = 0; s < NS; ++s) {
        if (s + 2 < NS) EX_WAITN(); else EX_WAITV(0);
        asm volatile("s_waitcnt lgkmcnt(0)" ::: "memory");
        __builtin_amdgcn_s_barrier();
        asm volatile("" ::: "memory");
        const bool pend = ((s % KT) == KT - 1);
        if (!pend) { if (s + 2 < NS) EX_DMA_A(s + 2); if (s + 3 < NS) EX_DMA_W(s + 3); }
        const unsigned abase = lds0 + EX_A0 + (s % EX_NSTG) * EX_ASTG, wbase = lds0 + EX_WH0 + (s & 1) * EX_WHS + tofs;
        const unsigned cs = cvsrc + ((s + 1) % EX_NSTG) * EX_WSTG;
        const unsigned pa0 = abase + aofs0, pa1 = abase + aofs1;
        if constexpr (NLAY < 3) {
            v4i16_t t0, t1, t2, t3, t4, t5, t6, t7; h16x8 a0[NLAY], a1[NLAY];
            asm volatile("ds_read_b64_tr_b16 %0, %8\n\tds_read_b64_tr_b16 %1, %8 offset:1280\n\tds_read_b64_tr_b16 %2, %8 offset:64\n\tds_read_b64_tr_b16 %3, %8 offset:1344\n\t"
                         "ds_read_b64_tr_b16 %4, %8 offset:5120\n\tds_read_b64_tr_b16 %5, %8 offset:6400\n\tds_read_b64_tr_b16 %6, %8 offset:5184\n\tds_read_b64_tr_b16 %7, %8 offset:6464"
                         : "=&v"(t0), "=&v"(t1), "=&v"(t2), "=&v"(t3), "=&v"(t4), "=&v"(t5), "=&v"(t6), "=&v"(t7) : "v"(wbase) : "memory");
            asm volatile("ds_read_b128 %0, %2\n\tds_read_b128 %1, %3" : "=&v"(a0[0]), "=&v"(a1[0]) : "v"(pa0), "v"(pa1) : "memory");
            if constexpr (NLAY >= 2) asm volatile("ds_read_b128 %0, %2 offset:8192\n\tds_read_b128 %1, %3 offset:8192" : "=&v"(a0[1]), "=&v"(a1[1]) : "v"(pa0), "v"(pa1) : "memory");
            asm volatile("s_waitcnt lgkmcnt(0)" ::: "memory");
            __builtin_amdgcn_sched_barrier(0);
            const h16x8 b00 = __builtin_bit_cast(h16x8, (s16x8){t0[0], t0[1], t0[2], t0[3], t1[0], t1[1], t1[2], t1[3]}), b01 = __builtin_bit_cast(h16x8, (s16x8){t2[0], t2[1], t2[2], t2[3], t3[0], t3[1], t3[2], t3[3]});
            const h16x8 b10 = __builtin_bit_cast(h16x8, (s16x8){t4[0], t4[1], t4[2], t4[3], t5[0], t5[1], t5[2], t5[3]}), b11 = __builtin_bit_cast(h16x8, (s16x8){t6[0], t6[1], t6[2], t6[3], t7[0], t7[1], t7[2], t7[3]});
#pragma unroll
            for (int i = 0; i < NLAY; ++i) { acc[2 * i] = MFMA32(a0[i], b00, acc[2 * i]); acc[2 * i + 1] = MFMA32(a0[i], b01, acc[2 * i + 1]); }
#pragma unroll
            for (int i = 0; i < NLAY; ++i) { acc[2 * i] = MFMA32(a1[i], b10, acc[2 * i]); acc[2 * i + 1] = MFMA32(a1[i], b11, acc[2 * i + 1]); }
        } else {
#pragma unroll
            for (int k16 = 0; k16 < 2; ++k16) {
                v4i16_t t0, t1, t2, t3; h16x8 a[3]; const unsigned pa = k16 ? pa1 : pa0, pw = wbase + k16 * 5120;
                asm volatile("ds_read_b64_tr_b16 %0, %4\n\tds_read_b64_tr_b16 %1, %4 offset:1280\n\tds_read_b64_tr_b16 %2, %4 offset:64\n\tds_read_b64_tr_b16 %3, %4 offset:1344"
                             : "=&v"(t0), "=&v"(t1), "=&v"(t2), "=&v"(t3) : "v"(pw) : "memory");
                asm volatile("ds_read_b128 %0, %3\n\tds_read_b128 %1, %3 offset:8192\n\tds_read_b128 %2, %3 offset:16384\n\ts_waitcnt lgkmcnt(0)" : "=&v"(a[0]), "=&v"(a[1]), "=&v"(a[2]) : "v"(pa) : "memory");
                __builtin_amdgcn_sched_barrier(0);
                const h16x8 b0 = __builtin_bit_cast(h16x8, (s16x8){t0[0], t0[1], t0[2], t0[3], t1[0], t1[1], t1[2], t1[3]}), b1 = __builtin_bit_cast(h16x8, (s16x8){t2[0], t2[1], t2[2], t2[3], t3[0], t3[1], t3[2], t3[3]});
#pragma unroll
                for (int i = 0; i < 3; ++i) { acc[2 * i] = MFMA32(a[i], b0, acc[2 * i]); acc[2 * i + 1] = MFMA32(a[i], b1, acc[2 * i + 1]); }
                __builtin_amdgcn_sched_barrier(0);
            }
        }
        if (s + 1 < NS) {
            f32x4 c0, c1; asm volatile("ds_read_b128 %0, %2\n\tds_read_b128 %1, %2 offset:16\n\ts_waitcnt lgkmcnt(0)" : "=&v"(c0), "=&v"(c1) : "v"(cs) : "memory");
            const h16x8 hv = pack8(c0[0], c0[1], c0[2], c0[3], c1[0], c1[1], c1[2], c1[3]); const unsigned cd = cvdst + ((s + 1) & 1) * EX_WHS; asm volatile("ds_write_b128 %0, %1" :: "v"(cd), "v"(hv) : "memory"); }
        if (pend) {
            const int pass = s / KT;
            int hio = hi, lno = ln; asm volatile("" : "+v"(hio), "+v"(lno));
            if (GU) {
#pragma unroll
                for (int i = 0; i < NLAY; ++i) { const int rt = rg + 4 * i;
#pragma unroll
                    for (int r = 0; r < 16; ++r) { const int row = 32 * rt + crow(r, hio);
                        if (row < nr) ACTrow0[(size_t)row * DEXP + 64 * cgrp + 32 * cp + lno] = (h16)(silu_f(acc[2 * i][r]) * acc[2 * i + 1][r]); }
                    acc[2 * i] = (f32x16){}; acc[2 * i + 1] = (f32x16){}; }
            } else {
                const unsigned scr = lds0 + EX_SCR0 + w * 1024;
                unsigned char* Y8 = (unsigned char*)Y;
#pragma unroll
                for (int i = 0; i < NLAY; ++i) { const int rt = rg + 4 * i;
#pragma unroll
                    for (int g8 = 0; g8 < 4; ++g8) {
#pragma unroll
                        for (int q = 0; q < 4; ++q) { const int lr = 4 * hio + q; const float wt = RW[32 * rt + 8 * g8 + lr];
                            const int pk = __builtin_amdgcn_cvt_pk_fp8_f32(acc[2 * i][4 * g8 + q] * wt, acc[2 * i + 1][4 * g8 + q] * wt, 0, false); const int pk1 = pk >> 8; const unsigned wa = scr + lr * 64 + lno;
                            asm volatile("ds_write_b8 %0, %1\n\tds_write_b8 %0, %2 offset:32" :: "v"(wa), "v"(pk), "v"(pk1) : "memory"); }
                        u32x2 pv; const unsigned ra = scr + (lane >> 3) * 64 + (lane & 7) * 8;
                        asm volatile("s_waitcnt lgkmcnt(0)\n\tds_read_b64 %0, %1\n\ts_waitcnt lgkmcnt(0)" : "=&v"(pv) : "v"(ra) : "memory");
                        const int grow = 32 * rt + 8 * g8 + (lane >> 3);
                        if (grow < nr) { const int slot = RSLOT[grow]; *(u32x2*)(Y8 + (size_t)slot * DM + 512 * cgrp + 128 * pass + 64 * cp + (lane & 7) * 8) = pv; }
                    }
                    acc[2 * i] = (f32x16){}; acc[2 * i + 1] = (f32x16){}; }
            }
            if (s + 2 < NS) EX_DMA_A(s + 2);
            if (s + 3 < NS) EX_DMA_W(s + 3);
        }
    }
    asm volatile("s_waitcnt vmcnt(0) lgkmcnt(0)" ::: "memory");
    __builtin_amdgcn_s_barrier();
    asm volatile("" ::: "memory");
#undef EX_DMA_A
#undef EX_DMA_W
#undef EX_WAITV
#undef EX_WAITN
}

constexpr int G8_NSTG = 4, G8_ASTG = 12288, G8_WSTG = 16384, G8_A0 = 0, G8_W0 = G8_NSTG * G8_ASTG, G8_WH0 = G8_W0 + G8_NSTG * G8_WSTG, G8_WHS = 4096;
constexpr int G8_SCR0 = G8_WH0 + 2 * G8_WHS;
static_assert(G8_SCR0 + 8 * 2048 <= EX_ROW0, "gu8 LDS map");
template <bool GU>
__device__ __forceinline__ void ring8_w_prologue(Frame& F, const float* W, int cgrp) {
    constexpr int LDB = GU ? 512 : 2048;
    const int lane = F.lane, w = F.wave, v = 4 * (lane & 31);
    if (w >= 4) return;
    const int wcol0 = GU ? (((v >> 5) & 1) * 256 + 32 * (v >> 6) + (v & 31) + 64 * cgrp) : (v + 512 * cgrp);
    const char* Wu = uni_ptr((const char*)W);
    const unsigned wvo = (unsigned)(((8 * w + (lane >> 5)) * LDB + wcol0) * 4);
#pragma unroll
    for (int s = 0; s < 4; ++s)
#pragma unroll
        for (int j = 0; j < 4; ++j) __builtin_amdgcn_global_load_lds((const unsigned*)(Wu + (size_t)(s * 32 + 2 * j) * LDB * 4 + (size_t)wvo), (LAS unsigned*)(F.lds + G8_W0 + s * G8_WSTG + (4 * w + j) * 1024), 16, 0, 2);
}
template <bool GU, int NLAY>
__device__ __forceinline__ void expert_ring8(Frame& F, const float* W, const unsigned char* A8, const int ap0, const int ap1, int nr, int cgrp, unsigned char* ACT8row0, unsigned char* Y8) {
    constexpr int KT = GU ? 64 : 8, NP = GU ? 1 : 4, LDB = GU ? 512 : 2048, NS = KT * NP;
    typedef long v2i64 __attribute__((ext_vector_type(2)));
    const int tid = F.tid, lane = F.lane, hi = lane >> 5, ln = lane & 31, cp = F.wave & 1, rg = F.wave >> 1, w = F.wave;
    const LAS int* RSLOT = (const LAS int*)(F.lds + EX_ROW0); const LAS float* RW = (const LAS float*)(F.lds + EX_ROW0 + 1536);
    const int ngrp = (nr + 31) >> 5;
    const bool ldr = w < 4;
    const int nA = ldr ? NLAY : 0;
    const unsigned avo0 = (unsigned)((ap0 & 0xffff) * (GU ? DM : DEXP) + (lane & 1) * 16), avo1 = (unsigned)((int)((unsigned)ap0 >> 16) * (GU ? DM : DEXP) + (lane & 1) * 16), avo2 = (unsigned)(ap1 * (GU ? DM : DEXP) + (lane & 1) * 16);
    const int v = 4 * (lane & 31);
    const int wcol0 = GU ? (((v >> 5) & 1) * 256 + 32 * (v >> 6) + (v & 31) + 64 * cgrp) : (v + 512 * cgrp);
    const char* Wu = uni_ptr((const char*)W); const char* Au = uni_ptr((const char*)A8);
    const unsigned wvo = (unsigned)(((8 * w + (lane >> 5)) * LDB + wcol0) * 4);
    const unsigned lds0 = (unsigned)(uintptr_t)F.lds;
    const unsigned aofs = (unsigned)(rg * 1024 + ln * 32 + hi * 16);
    const unsigned bofs = (unsigned)((64 * cp + ln) * 32 + hi * 16);
    const unsigned cvsrc = lds0 + G8_W0 + (tid >> 7) * 8 * 512 + (tid & 127) * 4, cvdst = lds0 + G8_WH0 + (tid & 127) * 32 + (tid >> 7) * 8;
    f32x16 acc[2 * NLAY];
#pragma unroll
    for (int i = 0; i < 2 * NLAY; ++i) acc[i] = (f32x16){};
#define G8_DMA_A(s) do { const int stg_ = (s) & 3, kt_ = (s) % KT; \
        if (ldr) { _Pragma("unroll") for (int j = 0; j < NLAY; ++j) { const unsigned vo_ = j == 0 ? avo0 : j == 1 ? avo1 : avo2; \
            __builtin_amdgcn_global_load_lds((const unsigned*)(Au + kt_ * 32 + (size_t)vo_), (LAS unsigned*)(F.lds + G8_A0 + stg_ * G8_ASTG + (w + 4 * j) * 1024), 16, 0, 0); } } } while (0)
#define G8_DMA_W(s) do { const int stg_ = (s) & 3, kt_ = (s) % KT, pass_ = (s) / KT; \
        if (ldr) { _Pragma("unroll") for (int j = 0; j < 4; ++j) __builtin_amdgcn_global_load_lds((const unsigned*)(Wu + ((size_t)(kt_ * 32 + 2 * j) * LDB + 128 * pass_) * 4 + (size_t)wvo), (LAS unsigned*)(F.lds + G8_W0 + stg_ * G8_WSTG + (4 * w + j) * 1024), 16, 0, 2); } } while (0)
#define G8_WAITV(k) asm volatile("s_waitcnt vmcnt(" #k ")" ::: "memory")
#define G8_CVT(s) do { float c_[8]; const unsigned cs_ = cvsrc + ((s) & 3) * G8_WSTG; \
        asm volatile("ds_read_b32 %0, %8\n\tds_read_b32 %1, %8 offset:512\n\tds_read_b32 %2, %8 offset:1024\n\tds_read_b32 %3, %8 offset:1536\n\tds_read_b32 %4, %8 offset:2048\n\tds_read_b32 %5, %8 offset:2560\n\tds_read_b32 %6, %8 offset:3072\n\tds_read_b32 %7, %8 offset:3584\n\ts_waitcnt lgkmcnt(0)" \
                     : "=&v"(c_[0]), "=&v"(c_[1]), "=&v"(c_[2]), "=&v"(c_[3]), "=&v"(c_[4]), "=&v"(c_[5]), "=&v"(c_[6]), "=&v"(c_[7]) : "v"(cs_) : "memory"); \
        int p0_ = __builtin_amdgcn_cvt_pk_fp8_f32(c_[0] * 64.f, c_[1] * 64.f, 0, false); p0_ = __builtin_amdgcn_cvt_pk_fp8_f32(c_[2] * 64.f, c_[3] * 64.f, p0_, true); \
        int p1_ = __builtin_amdgcn_cvt_pk_fp8_f32(c_[4] * 64.f, c_[5] * 64.f, 0, false); p1_ = __builtin_amdgcn_cvt_pk_fp8_f32(c_[6] * 64.f, c_[7] * 64.f, p1_, true); \
        const u32x2 pk_ = {(unsigned)p0_, (unsigned)p1_}; const unsigned cd_ = cvdst + ((s) & 1) * G8_WHS; asm volatile("ds_write_b64 %0, %1" :: "v"(cd_), "v"(pk_) : "memory"); } while (0)
    struct Frag { v2i64 a[NLAY], b0, b1; };
    Frag f0, f1; float c_[8];
    const bool top = 128 * (NLAY - 1) + 32 * rg < nr;
#define G8_RD_FRAG(fr, s) do { const unsigned pa_ = lds0 + G8_A0 + ((s) & 3) * G8_ASTG + aofs, pb_ = lds0 + G8_WH0 + ((s) & 1) * G8_WHS + bofs; \
        asm volatile("ds_read_b128 %0, %2\n\tds_read_b128 %1, %2 offset:1024" : "=&v"(fr.b0), "=&v"(fr.b1) : "v"(pb_) : "memory"); \
        asm volatile("ds_read_b128 %0, %1" : "=&v"(fr.a[0]) : "v"(pa_) : "memory"); \
        if constexpr (NLAY >= 2) asm volatile("ds_read_b128 %0, %1 offset:4096" : "=&v"(fr.a[1]) : "v"(pa_) : "memory"); \
        if constexpr (NLAY >= 3) asm volatile("ds_read_b128 %0, %1 offset:8192" : "=&v"(fr.a[2]) : "v"(pa_) : "memory"); } while (0)
#define G8_RD_CV(s) do { const unsigned cs_ = cvsrc + ((s) & 3) * G8_WSTG; \
        asm volatile("ds_read_b32 %0, %8\n\tds_read_b32 %1, %8 offset:512\n\tds_read_b32 %2, %8 offset:1024\n\tds_read_b32 %3, %8 offset:1536\n\tds_read_b32 %4, %8 offset:2048\n\tds_read_b32 %5, %8 offset:2560\n\tds_read_b32 %6, %8 offset:3072\n\tds_read_b32 %7, %8 offset:3584" \
                     : "=&v"(c_[0]), "=&v"(c_[1]), "=&v"(c_[2]), "=&v"(c_[3]), "=&v"(c_[4]), "=&v"(c_[5]), "=&v"(c_[6]), "=&v"(c_[7]) : "v"(cs_) : "memory"); } while (0)
#define G8_LWAIT(fr) do { asm volatile("s_waitcnt lgkmcnt(0)" : "+v"(fr.b0), "+v"(fr.b1), "+v"(fr.a[0]), "+v"(c_[0]), "+v"(c_[1]), "+v"(c_[2]), "+v"(c_[3]), "+v"(c_[4]), "+v"(c_[5]), "+v"(c_[6]), "+v"(c_[7]) :: "memory"); \
        if constexpr (NLAY >= 2) asm volatile("" : "+v"(fr.a[1])); if constexpr (NLAY >= 3) asm volatile("" : "+v"(fr.a[2])); } while (0)
#define G8_CV_WR(s) do { typedef float f2_ __attribute__((ext_vector_type(2))); \
        const f2_ m0_ = (f2_){c_[0], c_[1]} * 64.f, m1_ = (f2_){c_[2], c_[3]} * 64.f, m2_ = (f2_){c_[4], c_[5]} * 64.f, m3_ = (f2_){c_[6], c_[7]} * 64.f; \
        int p0_ = __builtin_amdgcn_cvt_pk_fp8_f32(m0_[0], m0_[1], 0, false); p0_ = __builtin_amdgcn_cvt_pk_fp8_f32(m1_[0], m1_[1], p0_, true); \
        int p1_ = __builtin_amdgcn_cvt_pk_fp8_f32(m2_[0], m2_[1], 0, false); p1_ = __builtin_amdgcn_cvt_pk_fp8_f32(m3_[0], m3_[1], p1_, true); \
        const u32x2 pk_ = {(unsigned)p0_, (unsigned)p1_}; const unsigned cd_ = cvdst + ((s) & 1) * G8_WHS; asm volatile("ds_write_b64 %0, %1" :: "v"(cd_), "v"(pk_) : "memory"); } while (0)
#define G8_SB() __builtin_amdgcn_sched_barrier(0)
#define G8_MF(fr, i, h, c) acc[2 * (i) + (c)] = __builtin_amdgcn_mfma_f32_32x32x16_fp8_fp8(fr.a[i][h], (c) ? fr.b1[h] : fr.b0[h], acc[2 * (i) + (c)], 0, 0, 0)
#define G8_RC01() asm volatile("ds_read_b32 %0, %2\n\tds_read_b32 %1, %2 offset:512" : "=&v"(c_[0]), "=&v"(c_[1]) : "v"(cs_) : "memory")
#define G8_RC23() asm volatile("ds_read_b32 %0, %2 offset:1024\n\tds_read_b32 %1, %2 offset:1536" : "=&v"(c_[2]), "=&v"(c_[3]) : "v"(cs_) : "memory")
#define G8_RC45() asm volatile("ds_read_b32 %0, %2 offset:2048\n\tds_read_b32 %1, %2 offset:2560" : "=&v"(c_[4]), "=&v"(c_[5]) : "v"(cs_) : "memory")
#define G8_RC67() asm volatile("ds_read_b32 %0, %2 offset:3072\n\tds_read_b32 %1, %2 offset:3584" : "=&v"(c_[6]), "=&v"(c_[7]) : "v"(cs_) : "memory")
#define G8_RB(fr) asm volatile("ds_read_b128 %0, %2\n\tds_read_b128 %1, %2 offset:1024" : "=&v"(fr.b0), "=&v"(fr.b1) : "v"(pb_) : "memory")
#define G8_RA(fr, i, ofs) asm volatile("ds_read_b128 %0, %1 offset:" ofs : "=&v"(fr.a[i]) : "v"(pa_) : "memory")
#define G8_CWAIT(n) asm volatile("s_waitcnt lgkmcnt(" n ")" : "+v"(c_[0]), "+v"(c_[1]), "+v"(c_[2]), "+v"(c_[3]), "+v"(c_[4]), "+v"(c_[5]), "+v"(c_[6]), "+v"(c_[7]) :: "memory")
#define G8_CMUL() do { m0_ = (f2_){c_[0], c_[1]} * 64.f; m1_ = (f2_){c_[2], c_[3]} * 64.f; m2_ = (f2_){c_[4], c_[5]} * 64.f; m3_ = (f2_){c_[6], c_[7]} * 64.f; } while (0)
#define G8_CCVT0() do { p0_ = __builtin_amdgcn_cvt_pk_fp8_f32(m0_[0], m0_[1], 0, false); p0_ = __builtin_amdgcn_cvt_pk_fp8_f32(m1_[0], m1_[1], p0_, true); } while (0)
#define G8_CCVT1() do { p1_ = __builtin_amdgcn_cvt_pk_fp8_f32(m2_[0], m2_[1], 0, false); p1_ = __builtin_amdgcn_cvt_pk_fp8_f32(m3_[0], m3_[1], p1_, true); } while (0)
#define G8_CWR() do { const u32x2 pk_ = {(unsigned)p0_, (unsigned)p1_}; asm volatile("ds_write_b64 %0, %1" :: "v"(cd_), "v"(pk_) : "memory"); } while (0)
#define G8_FWAIT(fr) do { asm volatile("s_waitcnt lgkmcnt(0)" : "+v"(fr.b0), "+v"(fr.b1), "+v"(fr.a[0]) :: "memory"); \
        if constexpr (NLAY >= 2) asm volatile("" : "+v"(fr.a[1])); if constexpr (NLAY >= 3) asm volatile("" : "+v"(fr.a[2])); } while (0)
#define G8_BAR() do { asm volatile("s_waitcnt lgkmcnt(0)" ::: "memory"); __builtin_amdgcn_s_barrier(); asm volatile("" ::: "memory"); } while (0)
    auto epilogue = [&](const int s) {
            const int pass = s / KT;
            int hio = hi, lno = ln; asm volatile("" : "+v"(hio), "+v"(lno));
            const unsigned scr = lds0 + G8_SCR0 + w * 2048;
#pragma unroll
            for (int i = 0; i < NLAY; ++i) { const int rt = rg + 4 * i;
                if (i == NLAY - 1 && !top) continue;
#pragma unroll
                for (int r = 0; r < 16; ++r) { const int lr = crow(r, hio);
                    float v0, v1;
                    if (GU) { v0 = silu_f(acc[2 * i][r] * 0.015625f) * (acc[2 * i + 1][r] * 0.015625f); v1 = 0.f; }
                    else { const float wt = RW[32 * rt + lr] * 0.015625f; v0 = acc[2 * i][r] * wt; v1 = acc[2 * i + 1][r] * wt; }
                    const int pk = __builtin_amdgcn_cvt_pk_fp8_f32(v0, v1, 0, false); const unsigned wa = scr + lr * 64 + lno;
                    if (GU) asm volatile("ds_write_b8 %0, %1" :: "v"(wa), "v"(pk) : "memory");
                    else { const int pk1 = pk >> 8; asm volatile("ds_write_b8 %0, %1\n\tds_write_b8 %0, %2 offset:32" :: "v"(wa), "v"(pk), "v"(pk1) : "memory"); } }
                if (GU) {
                    unsigned pv[4]; const unsigned ra = scr + (lane >> 3) * 64 + (lane & 7) * 4;
                    asm volatile("s_waitcnt lgkmcnt(0)\n\tds_read_b32 %0, %4\n\tds_read_b32 %1, %4 offset:512\n\tds_read_b32 %2, %4 offset:1024\n\tds_read_b32 %3, %4 offset:1536\n\ts_waitcnt lgkmcnt(0)" : "=&v"(pv[0]), "=&v"(pv[1]), "=&v"(pv[2]), "=&v"(pv[3]) : "v"(ra) : "memory");
#pragma unroll
                    for (int g8 = 0; g8 < 4; ++g8) { const int grow = 32 * rt + 8 * g8 + (lane >> 3);
                        if (grow < nr) *(unsigned*)(ACT8row0 + (size_t)grow * DEXP + 64 * cgrp + 32 * cp + (lane & 7) * 4) = pv[g8]; }
                } else {
                    u32x2 pv[4]; const unsigned ra = scr + (lane >> 3) * 64 + (lane & 7) * 8;
                    asm volatile("s_waitcnt lgkmcnt(0)\n\tds_read_b64 %0, %4\n\tds_read_b64 %1, %4 offset:512\n\tds_read_b64 %2, %4 offset:1024\n\tds_read_b64 %3, %4 offset:1536\n\ts_waitcnt lgkmcnt(0)" : "=&v"(pv[0]), "=&v"(pv[1]), "=&v"(pv[2]), "=&v"(pv[3]) : "v"(ra) : "memory");
#pragma unroll
                    for (int g8 = 0; g8 < 4; ++g8) { const int grow = 32 * rt + 8 * g8 + (lane >> 3);
                        if (grow < nr) { const int slot = RSLOT[grow]; *(u32x2*)(Y8 + (size_t)slot * DM + 512 * cgrp + 128 * pass + 64 * cp + (lane & 7) * 8) = pv[g8]; } }
                }
                acc[2 * i] = (f32x16){}; acc[2 * i + 1] = (f32x16){}; }
            if (s + 4 < NS) G8_DMA_A(s + 4);
            if (s + 5 < NS) G8_DMA_W(s + 5);
    };
    G8_DMA_A(0); G8_DMA_A(1); G8_DMA_A(2); G8_DMA_A(3);
    if constexpr (NLAY == 3) G8_WAITV(12); else if constexpr (NLAY == 2) G8_WAITV(8); else G8_WAITV(4);
    G8_BAR();
    G8_RD_CV(0);
    asm volatile("s_waitcnt lgkmcnt(0)" : "+v"(c_[0]), "+v"(c_[1]), "+v"(c_[2]), "+v"(c_[3]), "+v"(c_[4]), "+v"(c_[5]), "+v"(c_[6]), "+v"(c_[7]) :: "memory");
    G8_CV_WR(0);
    if constexpr (NLAY == 3) G8_WAITV(9); else if constexpr (NLAY == 2) G8_WAITV(6); else G8_WAITV(3);
    G8_BAR();
    G8_DMA_W(4);
    G8_RD_FRAG(f0, 0); G8_RD_CV(1);
    G8_LWAIT(f0);
    G8_CV_WR(1);
#define G8_STEP(s, cur, nxt, MAYPEND) do { \
        if ((s) > 0 && (s) + 4 < NS) { if constexpr (NLAY == 3) G8_WAITV(14); else if constexpr (NLAY == 2) G8_WAITV(12); else G8_WAITV(10); }     \
        else if ((s) == 0) { if constexpr (NLAY == 3) G8_WAITV(10); else if constexpr (NLAY == 2) G8_WAITV(8); else G8_WAITV(6); } \
        else G8_WAITV(0); \
        G8_BAR(); \
        const bool pend = MAYPEND && (((s) % KT) == KT - 1); \
        if (!pend) { if ((s) + 4 < NS) G8_DMA_A((s) + 4); if ((s) + 5 < NS) G8_DMA_W((s) + 5); } \
          \
          \
        const unsigned pa_ = lds0 + G8_A0 + (((s) + 1) & 3) * G8_ASTG + aofs, pb_ = lds0 + G8_WH0 + (((s) + 1) & 1) * G8_WHS + bofs, cs_ = cvsrc + (((s) + 2) & 3) * G8_WSTG, cd_ = cvdst + ((s) & 1) * G8_WHS; \
        typedef float f2_ __attribute__((ext_vector_type(2))); f2_ m0_, m1_, m2_, m3_; int p0_, p1_; \
        G8_SB(); \
          \
          \
        if constexpr (NLAY == 3) { \
            if (top) { G8_RA(nxt, 2, "8192"); G8_SB(); } \
            G8_MF(cur, 0, 0, 0); G8_SB(); G8_RC01(); G8_SB(); G8_MF(cur, 0, 0, 1); G8_SB(); G8_RC23(); G8_SB(); G8_MF(cur, 1, 0, 0); G8_SB(); G8_RC45(); G8_SB(); G8_MF(cur, 1, 0, 1); G8_SB(); G8_RC67(); G8_SB(); \
            G8_MF(cur, 0, 1, 0); G8_SB(); G8_RB(nxt); G8_SB(); G8_MF(cur, 0, 1, 1); G8_SB(); G8_RA(nxt, 0, "0"); G8_SB(); G8_MF(cur, 1, 1, 0); G8_SB(); G8_RA(nxt, 1, "4096"); G8_SB(); G8_MF(cur, 1, 1, 1); G8_SB(); \
            G8_CWAIT("4"); G8_SB(); G8_CMUL(); G8_SB(); \
            if (top) { G8_MF(cur, 2, 0, 0); G8_SB(); G8_CCVT0(); G8_SB(); G8_MF(cur, 2, 0, 1); G8_SB(); G8_CCVT1(); G8_SB(); G8_MF(cur, 2, 1, 0); G8_SB(); G8_CWR(); G8_SB(); G8_MF(cur, 2, 1, 1); G8_SB(); } \
            else { G8_CCVT0(); G8_CCVT1(); G8_CWR(); G8_SB(); } \
        } else if constexpr (NLAY == 2) { \
            if (top) { G8_RA(nxt, 1, "4096"); G8_SB(); } \
            G8_MF(cur, 0, 0, 0); G8_SB(); G8_RC01(); G8_RC23(); G8_SB(); G8_MF(cur, 0, 0, 1); G8_SB(); G8_RC45(); G8_RC67(); G8_SB(); G8_MF(cur, 0, 1, 0); G8_SB(); G8_RB(nxt); G8_SB(); G8_MF(cur, 0, 1, 1); G8_SB(); G8_RA(nxt, 0, "0"); G8_SB(); \
            G8_CWAIT("3"); G8_SB(); G8_CMUL(); G8_SB(); \
            if (top) { G8_MF(cur, 1, 0, 0); G8_SB(); G8_CCVT0(); G8_SB(); G8_MF(cur, 1, 0, 1); G8_SB(); G8_CCVT1(); G8_SB(); G8_MF(cur, 1, 1, 0); G8_SB(); G8_CWR(); G8_SB(); G8_MF(cur, 1, 1, 1); G8_SB(); } \
            else { G8_CCVT0(); G8_CCVT1(); G8_CWR(); G8_SB(); } \
        } else { \
            if (top) { G8_RA(nxt, 0, "0"); G8_SB(); G8_MF(cur, 0, 0, 0); G8_SB(); } \
            G8_RC01(); G8_RC23(); G8_RC45(); G8_RC67(); G8_SB(); \
            if (top) { G8_MF(cur, 0, 0, 1); G8_SB(); } \
            G8_RB(nxt); G8_SB(); G8_CWAIT("2"); G8_SB(); G8_CMUL(); G8_SB(); \
            if (top) { G8_MF(cur, 0, 1, 0); G8_SB(); } \
            G8_CCVT0(); G8_CCVT1(); G8_SB(); \
            if (top) { G8_MF(cur, 0, 1, 1); G8_SB(); } \
            G8_CWR(); G8_SB(); \
        } \
        G8_FWAIT(nxt); \
        if (pend) epilogue((s)); } while (0)
    for (int s = 0; s < NS; s += 2) { G8_STEP(s, f0, f1, false); G8_STEP(s + 1, f1, f0, true); }
#undef G8_STEP
#undef G8_RC01
#undef G8_RC23
#undef G8_RC45
#undef G8_RC67
#undef G8_RB
#undef G8_RA
#undef G8_CWAIT
#undef G8_CMUL
#undef G8_CCVT0
#undef G8_CCVT1
#undef G8_CWR
#undef G8_FWAIT
#undef G8_SB
#undef G8_MF
#undef G8_RD_FRAG
#undef G8_RD_CV
#undef G8_LWAIT
#undef G8_CV_WR
#undef G8_BAR
    asm volatile("s_waitcnt vmcnt(0) lgkmcnt(0)" ::: "memory");
    __builtin_amdgcn_s_barrier();
    asm volatile("" ::: "memory");
#undef G8_DMA_A
#undef G8_DMA_W
#undef G8_WAITV
#undef G8_CVT
}
template <bool GU>
__device__ __forceinline__ void p13_expert_phase(Frame& F, int qid) {
    const h16* H2X = (const h16*)(F.ws + WS_H2X); h16* Y = (h16*)(F.ws + WS_Y); h16* ACT = (h16*)(F.ws + WS_ACT);
    const unsigned* CNT = (const unsigned*)(F.ws + WS_CTL) + CW_CNT; unsigned* QH = (unsigned*)(F.ws + WS_CTL) + CW_Q + 64 * qid;
    LAS int* RSLOT = (LAS int*)(F.lds + EX_ROW0); LAS float* RW = (LAS float*)(F.lds + EX_ROW0 + 1536); LAS int* RED = (LAS int*)(F.lds + EX_ROW0 + 3072);
    LAS int* CN = (LAS int*)(F.lds + EX_TAB0); LAS int* ORD = CN + 256; LAS int* OFF = CN + 512;
    __syncthreads();
    if (F.tid < NEXP) CN[F.tid] = (int)CNT[F.tid];
    __syncthreads();
    if (F.tid < NEXP) { const int c = CN[F.tid]; int rank = 0, off = 0;
        for (int j = 0; j < NEXP; ++j) { const int cj = CN[j]; rank += (cj > c || (cj == c && j < F.tid)) ? 1 : 0; off += (j < F.tid) ? cj : 0; }
        ORD[rank] = F.tid; OFF[F.tid] = off; }
    __syncthreads();
    const u32x2* LIST2 = (const u32x2*)(F.ws + WS_LIST2);
    if (F.tid == 0) RED[0] = (int)__hip_atomic_fetch_add(QH, 1u, __ATOMIC_RELAXED, __HIP_MEMORY_SCOPE_AGENT);
    __syncthreads();
    int u = RED[0];
    while (u < NEXP * 4) {
        const int e = ORD[u >> 2], cg = u & 3, cnt = CN[e], off_e = OFF[e];
        const float* Wgu = F.w_exp_gu + (size_t)e * DM * 512; const float* Wdn = F.w_exp_down + (size_t)e * DEXP * DM;
        for (int rs = 0; rs < cnt; rs += 384) {
            const int nr = (cnt - rs) < 384 ? (cnt - rs) : 384;
            __syncthreads();
            ring8_w_prologue<GU>(F, GU ? Wgu : Wdn, cg);
            if (F.tid < 384) { u32x2 ent = {0u, 0u}; if (F.tid < nr) ent = LIST2[e * MLAT + rs + F.tid]; RSLOT[F.tid] = (int)ent.x; RW[F.tid] = __uint_as_float(ent.y); }
            __syncthreads();
            unsigned char* ACT8row0 = (unsigned char*)(F.ws + WS_ACT8) + (size_t)(off_e + rs) * DEXP;
            int ar8[3];
            if (GU) {
#pragma unroll
                for (int j = 0; j < 3; ++j) { const int r = 32 * ((F.wave & 3) + 4 * j) + (F.lane >> 1); ar8[j] = (r < 384 ? (RSLOT[r] >> 3) : 0); }
                const unsigned char* A8 = (const unsigned char*)(F.ws + WS_H2F8);
                if (nr > 256) expert_ring8<true, 3>(F, Wgu, A8, ar8[0] | (ar8[1] << 16), ar8[2], nr, cg, ACT8row0, (unsigned char*)Y); else if (nr > 128) expert_ring8<true, 2>(F, Wgu, A8, ar8[0] | (ar8[1] << 16), ar8[2], nr, cg, ACT8row0, (unsigned char*)Y); else expert_ring8<true, 1>(F, Wgu, A8, ar8[0] | (ar8[1] << 16), ar8[2], nr, cg, ACT8row0, (unsigned char*)Y);
            } else {
#pragma unroll
                for (int j = 0; j < 3; ++j) { const int r = 32 * ((F.wave & 3) + 4 * j) + (F.lane >> 1); ar8[j] = ((r < nr) ? r : 0); }
                if (nr > 256) expert_ring8<false, 3>(F, Wdn, ACT8row0, ar8[0] | (ar8[1] << 16), ar8[2], nr, cg, ACT8row0, (unsigned char*)Y); else if (nr > 128) expert_ring8<false, 2>(F, Wdn, ACT8row0, ar8[0] | (ar8[1] << 16), ar8[2], nr, cg, ACT8row0, (unsigned char*)Y); else expert_ring8<false, 1>(F, Wdn, ACT8row0, ar8[0] | (ar8[1] << 16), ar8[2], nr, cg, ACT8row0, (unsigned char*)Y);
            }
        }
        __syncthreads();
        if (F.tid == 0) RED[0] = (int)__hip_atomic_fetch_add(QH, 1u, __ATOMIC_RELAXED, __HIP_MEMORY_SCOPE_AGENT);
        __syncthreads();
        u = RED[0];
    }
}
struct SchedSG {
    int G, c;
    __device__ __forceinline__ bool next(int i, pg8::Unit& u) const { const int L = i * G + c; if (L >= 256) return false; u.pm = L >> 3; u.pn = (L >> 2) & 1; u.ko = (L & 3) * 512; u.nt = 0; u.keep = 0; return true; }
};
struct EpiSGP {
    float* SGP;
    __device__ __forceinline__ void operator()(f32x4 (&acc)[2][2][4][2], const pg8::Unit& u, int wr, int wc, int fr, int fq) const {
        float* dst = SGP + (size_t)(u.ko / 512) * MLAT * 512;
#pragma unroll
        for (int ai = 0; ai < 2; ++ai)
#pragma unroll
            for (int m = 0; m < 4; ++m) { const int row = u.pm * 256 + ai * 128 + wr * 64 + m * 16 + fr;
#pragma unroll
                for (int bj = 0; bj < 2; ++bj)
#pragma unroll
                    for (int n = 0; n < 2; ++n) { const int col = u.pn * 256 + bj * 128 + wc * 32 + 16 * n + 4 * fq; *(f32x4*)(dst + (size_t)row * 512 + col) = acc[ai][bj][m][n]; } }
    }
};
__device__ __forceinline__ void p11b_shared_gu(Frame& F) {
    pg8::Gemm g{(const h16*)(F.ws + WS_H2X), (const h16*)(F.ws + WS_WSGU), 6144, 2048, 512};
    SchedSG S; S.G = F.G; S.c = (int)blockIdx.x;
    EpiSGP E{(float*)(F.ws + WS_SGP)};
    pg8::gemm_phase<EpiSGP, SchedSG>(F.lds, g, S, E);
}
__device__ __forceinline__ void p12b_shared_act(Frame& F) {
    const float* SGP = (const float*)(F.ws + WS_SGP); h16* ACTS = (h16*)(F.ws + WS_ACTS);
    for (int q = blockIdx.x * NTHR + F.tid; q < MLAT * 64; q += F.G * NTHR) {
        const int row = q >> 6, j = (q & 63) * 4, pg = 32 * (j >> 4) + (j & 15);
        f32x4 gv = {0.f, 0.f, 0.f, 0.f}, uv = gv;
#pragma unroll
        for (int ks = 0; ks < 4; ++ks) { const float* p = SGP + ((size_t)ks * MLAT + row) * 512 + pg; gv += *(const f32x4*)p; uv += *(const f32x4*)(p + 16); }
        u32x2 w; w.x = pk2h(silu_f(gv[0]) * uv[0], silu_f(gv[1]) * uv[1]); w.y = pk2h(silu_f(gv[2]) * uv[2], silu_f(gv[3]) * uv[3]);
        *(u32x2*)(ACTS + (size_t)row * DEXP + j) = w;
    }
}
struct EpiYsh {
    h16* YSH;
    __device__ __forceinline__ void operator()(f32x4 (&acc)[2][2][4][2], const pg8::Unit& u, int wr, int wc, int fr, int fq) const {
#pragma unroll
        for (int ai = 0; ai < 2; ++ai)
#pragma unroll
            for (int m = 0; m < 4; ++m) { const int row = u.pm * 256 + ai * 128 + wr * 64 + m * 16 + fr;
#pragma unroll
                for (int bj = 0; bj < 2; ++bj)
#pragma unroll
                    for (int n = 0; n < 2; ++n) { const int col = u.pn * 256 + bj * 128 + wc * 32 + 16 * n + 4 * fq; const f32x4 a = acc[ai][bj][m][n];
                        u32x2 w; w.x = pk2h(a[0], a[1]); w.y = pk2h(a[2], a[3]); *(u32x2*)(YSH + (size_t)row * DM + col) = w; } }
    }
};
struct SchedOne {
    int pm, pn;
    __device__ __forceinline__ bool next(int i, pg8::Unit& u) const { if (i != 0) return false; u.pm = pm; u.pn = pn; u.ko = 0; u.nt = 0; u.keep = 0; return true; }
};
__device__ __forceinline__ void p15_shared_down_dyn(Frame& F, int qid) {
    unsigned* QH = (unsigned*)(F.ws + WS_CTL) + CW_Q + 64 * 8 * qid;
    LAS int* RED = (LAS int*)(F.lds + EX_ROW0 + 3072);
    for (;;) {
        __syncthreads();
        if (F.tid == 0) RED[0] = (int)__hip_atomic_fetch_add(QH, 1u, __ATOMIC_RELAXED, __HIP_MEMORY_SCOPE_AGENT);
        __syncthreads();
        const int t = RED[0];
        if (t >= 256) break;
        pg8::Gemm g{(const h16*)(F.ws + WS_ACTS), (const h16*)(F.ws + WS_WSDN), 256, 256, 256};
        SchedOne S; S.pm = t >> 3; S.pn = t & 7;
        EpiYsh E{(h16*)(F.ws + WS_YSH)};
        pg8::gemm_phase<EpiYsh, SchedOne>(F.lds, g, S, E);
    }
}
__device__ __forceinline__ void p15_shared_down(Frame& F) {
    pg8::Gemm g{(const h16*)(F.ws + WS_ACTS), (const h16*)(F.ws + WS_WSDN), 256, 256, 256};
    pg8::StaticOrder S; S.init(MLAT, DM, F.G, (int)blockIdx.x);
    EpiYsh E{(h16*)(F.ws + WS_YSH)};
    pg8::gemm_phase<EpiYsh, pg8::StaticOrder>(F.lds, g, S, E);
}
__device__ __forceinline__ void p16_combine(Frame& F) {
    const float* X1 = (const float*)(F.ws + WS_X1); const float* MOD = (const float*)(F.ws + WS_MOD); const h16* Y = (const h16*)(F.ws + WS_Y); const h16* YSH = (const h16*)(F.ws + WS_YSH);
    const int gw = F.vcu * NWAVES + F.wave, NGW = F.G * NWAVES;
    for (int r = gw; r < MLAT; r += NGW) {
        const int b = r / SEQ;
        f32x4 xv[8]; float ss = 0.f;
#pragma unroll
        for (int j = 0; j < 8; ++j) { const int cc = 4 * F.lane + 256 * j;
            f32x4 m = {0.f, 0.f, 0.f, 0.f};
#pragma unroll
            for (int k = 0; k < TOPK; ++k) { const int yv = *(const int*)((const unsigned char*)Y + (size_t)(r * TOPK + k) * DM + cc);
                const f32x2 lo = __builtin_amdgcn_cvt_pk_f32_fp8(yv, false), hi2 = __builtin_amdgcn_cvt_pk_f32_fp8(yv, true); m += (f32x4){lo[0], lo[1], hi2[0], hi2[1]}; }
            { const h16x4 yv = *(const h16x4*)(YSH + (size_t)r * DM + cc); m += (f32x4){(float)yv[0], (float)yv[1], (float)yv[2], (float)yv[3]}; }
            const f32x4 g2 = *(const f32x4*)(MOD + (size_t)b * (6 * DM) + 5 * DM + cc);
            xv[j] = *(const f32x4*)(X1 + (size_t)r * DM + cc) + g2 * m;
            ss += (xv[j].x * xv[j].x + xv[j].y * xv[j].y) + (xv[j].z * xv[j].z + xv[j].w * xv[j].w); }
        const float rstd = 1.0f / sqrtf(wave_sum(ss) * (1.0f / DM) + EPS);
#pragma unroll
        for (int j = 0; j < 8; ++j) { const int cc = 4 * F.lane + 256 * j; const f32x4 nw = *(const f32x4*)(F.final_norm + cc);
            *(f32x4*)(F.out + (size_t)r * DM + cc) = xv[j] * rstd * nw; }
    }
}

__device__ __forceinline__ void p_final_plain(Frame& F, const float* xin) {
    const int gw = F.vcu * NWAVES + F.wave, NGW = F.G * NWAVES;
    for (int r = gw; r < MLAT; r += NGW) {
        const float* src = xin + (size_t)r * DM;
        f32x4 xv[8]; float ss = 0.f;
#pragma unroll
        for (int j = 0; j < 8; ++j) { xv[j] = *(const f32x4*)(src + 4 * F.lane + 256 * j); ss += (xv[j].x * xv[j].x + xv[j].y * xv[j].y) + (xv[j].z * xv[j].z + xv[j].w * xv[j].w); }
        const float rstd = 1.0f / sqrtf(wave_sum(ss) * (1.0f / DM) + EPS);
#pragma unroll
        for (int j = 0; j < 8; ++j) { const int cc = 4 * F.lane + 256 * j; const f32x4 nw = *(const f32x4*)(F.final_norm + cc);
            *(f32x4*)(F.out + (size_t)r * DM + cc) = xv[j] * rstd * nw; }
    }
}

constexpr int N_PHASES = 15;
#ifndef DUP_PHASE
#define DUP_PHASE -1
#endif
#ifndef DUP_VAR
#define DUP_VAR 7
#endif
struct Args { const float* in[22]; float* out; unsigned char* ws; int ph_lo, ph_hi; };
__global__ void __launch_bounds__(NTHR, 2) mk_fwd(Args args) {
    extern __shared__ __attribute__((aligned(16))) unsigned char lds_raw[];
    Frame F;
    F.lds = (LAS unsigned char*)lds_raw;
    F.tid = threadIdx.x; F.lane = F.tid & 63; F.wave = __builtin_amdgcn_readfirstlane(F.tid >> 6);
    F.G = gridDim.x; { const int bx = blockIdx.x; F.vcu = (F.G % 8 == 0) ? (bx % 8) * (F.G / 8) + bx / 8 : bx; }
    F.x = args.in[0]; F.c = args.in[1]; F.ctx = args.in[2]; F.c_ctx = args.in[3]; F.w_mod = args.in[4]; F.b_mod = args.in[5]; F.norm_attn = args.in[6]; F.norm_ffn = args.in[7];
    F.w_in = args.in[8]; F.ret_decay = args.in[9]; F.diff_lambda = args.in[10]; F.diff_subln = args.in[11]; F.w_ret_o = args.in[12]; F.w_diff_o = args.in[13]; F.w_out = args.in[14];
    F.w_router = args.in[15]; F.router_bias = args.in[16]; F.w_exp_gu = args.in[17]; F.w_exp_down = args.in[18]; F.w_sh_gu = args.in[19]; F.w_sh_down = args.in[20]; F.final_norm = args.in[21];
    F.out = args.out; F.ws = args.ws;
    volatile LAS unsigned* MISC = (volatile LAS unsigned*)(F.lds + LDSCTL_OFF);
    for (int u = F.tid; u < (LDS_BYTES - LDSCTL_OFF) / 4; u += NTHR) ((LAS unsigned*)(F.lds + LDSCTL_OFF))[u] = 0u;
    __syncthreads();
    const int lo = args.ph_lo, hi = args.ph_hi;
    const bool multi = (hi - lo) > 1;
    XcdBarrier bar; bar.bar = (unsigned*)(F.ws + WS_CTL) + CW_BAR; bar.x = 0; bar.st = nullptr;
    if (multi) bar = xcd_barrier_post((unsigned*)(F.ws + WS_CTL) + CW_BAR, MISC + 8);
#define IN(k) (lo <= (k) && (k) < hi)
#define SEAM(k) do { if (IN(k) && IN((k) + 1)) flat_barrier(bar, (unsigned*)(F.ws + WS_CTL), (unsigned)((k) - lo + ((DUP_PHASE >= 0 && (k) >= DUP_PHASE && lo <= DUP_PHASE) ? 1 : 0))); } while (0)
#define DUPBAR(k) flat_barrier(bar, (unsigned*)(F.ws + WS_CTL), (unsigned)((k) - lo))

#define RUNP(k, call) do { if (IN(k)) { call; if (DUP_PHASE == (k)) { DUPBAR(k); call; } } SEAM(k); } while (0)
    RUNP(0, p0a_mod(F));
    RUNP(1, (p1_norm1(F), p0b_weights(F)));
    RUNP(2, (p2_gemm1(F), p0c_weights_dyn(F, 5)));
    RUNP(3, p3_ret_local(F));
    RUNP(4, p4_ret_scan(F));
    RUNP(5, p5_ret_out(F));
    RUNP(6, p6_attn(F));
    RUNP(7, p7_gemm2(F));
    RUNP(8, p9_gemm3(F));
    RUNP(9, p10_norm2(F));
    RUNP(10, (p11_router(F), p11b_shared_gu(F)));
    RUNP(11, (p12_topk(F), p12b_shared_act(F)));
    if (IN(12)) { p13_expert_phase<true>(F, 0); p15_shared_down_dyn(F, 4); if (DUP_PHASE == 12) { DUPBAR(12); p13_expert_phase<true>(F, 2); } } SEAM(12);
    if (IN(13)) { p13_expert_phase<false>(F, 1); if (DUP_PHASE == 13) { DUPBAR(13); p13_expert_phase<false>(F, 3); } } SEAM(13);
    if (IN(14)) { p16_combine(F); }
#undef RUNP
#undef IN
#undef SEAM
#undef DUPBAR
}

constexpr bool ONE_LAUNCH = true;
extern "C" void kernel_launch(void* const* d_in, const int* in_sizes, int n_in, void* d_out, int out_size, void* d_ws, size_t ws_size, hipStream_t stream) {
    static int grid = 0;
    if (grid == 0) {
        if (n_in != 22 || out_size != MLAT * DM || ws_size < WS_END) { fprintf(stderr, "kernel_launch: unexpected sizes n_in %d out %d ws %zu\n", n_in, out_size, ws_size); grid = -1; return; }
        int dev = 0, cus = 0;
        if (hipGetDevice(&dev) != hipSuccess || hipDeviceGetAttribute(&cus, hipDeviceAttributeMultiprocessorCount, dev) != hipSuccess) { grid = -1; return; }
        if (hipFuncSetAttribute((const void*)mk_fwd, hipFuncAttributeMaxDynamicSharedMemorySize, LDS_BYTES) != hipSuccess) { fprintf(stderr, "kernel_launch: hipFuncSetAttribute failed\n"); grid = -1; return; }
        int per_cu = 0;
        if (hipOccupancyMaxActiveBlocksPerMultiprocessor(&per_cu, (const void*)mk_fwd, NTHR, LDS_BYTES) != hipSuccess || per_cu < 1) fprintf(stderr, "kernel_launch: occupancy query reports %d\n", per_cu);
        (void)hipGetLastError();
        grid = cus;
    }
    if (grid < 0) return;
    (void)hipMemsetAsync((char*)d_ws + WS_CTL, 0, CTL_ZERO_BYTES, stream);
    Args a{};
    for (int i = 0; i < 22; ++i) a.in[i] = (const float*)d_in[i];
    a.out = (float*)d_out; a.ws = (unsigned char*)d_ws;
    if (ONE_LAUNCH) {
        a.ph_lo = 0; a.ph_hi = N_PHASES;
        hipLaunchKernelGGL(mk_fwd, dim3(grid), dim3(NTHR), LDS_BYTES, stream, a);
    } else {
        for (int p = 0; p < N_PHASES; ++p) { a.ph_lo = p; a.ph_hi = p + 1; hipLaunchKernelGGL(mk_fwd, dim3(grid), dim3(NTHR), LDS_BYTES, stream, a); }
    }
}
```

```cpp
#include <hip/hip_runtime.h>
#include <cstdio>
#include <cstdint>

#define LAS __attribute__((address_space(3)))
#define GAS __attribute__((address_space(1)))
typedef _Float16 h16;
typedef _Float16 h16x8 __attribute__((ext_vector_type(8)));
typedef _Float16 h16x4 __attribute__((ext_vector_type(4)));
typedef _Float16 h16x2 __attribute__((ext_vector_type(2)));
typedef float f32x2 __attribute__((ext_vector_type(2)));
typedef float f32x4 __attribute__((ext_vector_type(4)));
typedef float f32x16 __attribute__((ext_vector_type(16)));
typedef unsigned u32x4 __attribute__((ext_vector_type(4)));
typedef unsigned u32x2 __attribute__((ext_vector_type(2)));
typedef short v4i16_t __attribute__((ext_vector_type(4)));

constexpr int DM = 2048, NBATCH = 2, SEQ = 4096, CTXL = 256;
constexpr int MLAT = NBATCH * SEQ, MCTX = NBATCH * CTXL, MALL = MLAT + MCTX;
constexpr int IN_COLS = 13312, KV_COLS = 5120;
constexpr int C_RK = 0, C_RV = 1024, C_DK = 3072, C_DV = 4096, C_RQ = 5120, C_RG = 6144, C_DQ = 8192, C_GR = 9216, C_GD = 11264;
constexpr int NEXP = 256, TOPK = 8, DEXP = 256;
constexpr float EPS = 1e-6f;
constexpr int NWAVES = 8, NTHR = 512;

constexpr size_t MiB = 1u << 20;
constexpr size_t WS_CTL = 0, CTL_ZERO_BYTES = 1 * MiB;
constexpr size_t WS_MODP = 1 * MiB;
constexpr size_t WS_MOD = 3 * MiB;
constexpr size_t WS_ROPE = 3 * MiB + 512 * 1024;
constexpr size_t WS_WINT = 4 * MiB;
constexpr size_t WS_WRET = 56 * MiB;
constexpr size_t WS_WDIF = 64 * MiB;
constexpr size_t WS_WOUT = 68 * MiB;
constexpr size_t WS_WSGU = 76 * MiB;
constexpr size_t WS_WSDN = 78 * MiB;
constexpr size_t WS_WRTR = 79 * MiB;
constexpr size_t WS_H = 82 * MiB;
constexpr size_t WS_P = 116 * MiB;
constexpr size_t WS_LST = 340 * MiB;
constexpr size_t WS_SST = 408 * MiB;
constexpr size_t WS_ARET = 472 * MiB;
constexpr size_t WS_ADIF = 504 * MiB;
constexpr size_t WS_T = 520 * MiB;
constexpr size_t WS_U = 584 * MiB;
constexpr size_t WS_X1 = 616 * MiB;
constexpr size_t WS_H2X = 680 * MiB;
constexpr size_t WS_LG = 776 * MiB;
constexpr size_t WS_EIDX = 784 * MiB;
constexpr size_t WS_EW = 785 * MiB;
constexpr size_t WS_LIST = 786 * MiB;
constexpr size_t WS_ACTS = 794 * MiB;
constexpr size_t WS_YSH = 798 * MiB;
constexpr size_t WS_Y = 830 * MiB;
constexpr size_t WS_ACT = 1086 * MiB;
constexpr size_t WS_LGP = 1118 * MiB;
constexpr size_t WS_SGP = 1182 * MiB;
constexpr size_t WS_ACAT = 1246 * MiB;
constexpr size_t WS_WCAT = 1294 * MiB;
constexpr size_t WS_LIST2 = 1306 * MiB;
constexpr size_t WS_H2F8 = 1322 * MiB;
constexpr size_t WS_ACT8 = 1338 * MiB;
constexpr size_t WS_GATE = 1354 * MiB;
constexpr size_t WS_END = 1418 * MiB;

constexpr int CW_BAR = 4096;
constexpr int CW_CNT = 16384;
constexpr int CW_Q = 20480;

constexpr int RING_BYTES = 131072;
constexpr int LDS_BYTES = 163840;
constexpr int LDSCTL_OFF = LDS_BYTES - 512;
constexpr int LDS_TICKET = 146432;

#define XB_TMO      128
#define XB_XCNT(j)  (256  + 64 * (j))
#define XB_XSUB(j)  (1280 + 64 * (j))
#define XB_XGEN(j)  (2304 + 64 * (j))
#define XB_TOP      3328
#define XB_TOPGEN   3392
#define XCD_BAR_WORDS 3456
#define XB_SPIN_CAP (1u << 18)

__device__ __forceinline__ unsigned xb_ld(unsigned* p)              { return __hip_atomic_load(p, __ATOMIC_RELAXED, __HIP_MEMORY_SCOPE_AGENT); }
__device__ __forceinline__ unsigned xb_add(unsigned* p, unsigned v) { return __hip_atomic_fetch_add(p, v, __ATOMIC_RELAXED, __HIP_MEMORY_SCOPE_AGENT); }
__device__ __forceinline__ unsigned xb_xcc_id() { return (unsigned)__builtin_amdgcn_s_getreg((3 << 11) | 20) & 0xFu; }
#define XB_SPIN(cond, bar) do { unsigned _sp = 0; while (cond) { __builtin_amdgcn_s_sleep(1); \
    if ((++_sp & 255u) == 0u) { if (xb_ld(&(bar)[XB_TMO])) break; if (_sp > XB_SPIN_CAP) { atomicAdd(&(bar)[XB_TMO], 1u); break; } } } } while (0)

struct XcdBarrier { unsigned* bar; unsigned x; volatile LAS unsigned* st; };

__device__ __forceinline__ XcdBarrier xcd_barrier_post(unsigned* bar, volatile LAS unsigned* st) {
    XcdBarrier b; b.bar = bar; b.x = xb_xcc_id(); b.st = st;
    if (threadIdx.x == 0) (void)xb_add(&bar[XB_XCNT(b.x)], 1u);
    return b;
}
__device__ __forceinline__ void xcd_barrier_complete(unsigned* bar, unsigned x, unsigned& nloc, unsigned& nx) {
    const unsigned G = gridDim.x * gridDim.y * gridDim.z;
    unsigned sum, cnt, mine, sp = 0u;
    for (;;) {
        sum = 0u; cnt = 0u; mine = 0u;
#pragma unroll
        for (unsigned j = 0; j < 16; ++j) { const unsigned c = xb_ld(&bar[XB_XCNT(j)]); sum += c; cnt += (c > 0u) ? 1u : 0u; mine = (j == x) ? c : mine; }
        if (sum == G) break;
        __builtin_amdgcn_s_sleep(1);
        if ((++sp & 255u) == 0u) { if (xb_ld(&bar[XB_TMO])) break; if (sp > XB_SPIN_CAP) { atomicAdd(&bar[XB_TMO], 1u); break; } }
    }
    nloc = mine > 0u ? mine : 1u; nx = cnt > 0u ? cnt : 1u;
}
__device__ __forceinline__ void xcd_barrier(const XcdBarrier& b) {
    asm volatile("s_waitcnt vmcnt(0)" ::: "memory");
    __syncthreads();
    if (threadIdx.x == 0) {
        unsigned* bar = b.bar;
        __builtin_amdgcn_s_waitcnt(0);
        unsigned nloc = b.st[0], nx = b.st[1];
        if (nloc == 0u) { xcd_barrier_complete(bar, b.x, nloc, nx); b.st[0] = nloc; b.st[1] = nx; }
        const unsigned old = xb_add(&bar[XB_XSUB(b.x)], 1u);
        const unsigned gen = old / nloc;
        if (old + 1u == (gen + 1u) * nloc) {
            __builtin_amdgcn_fence(__ATOMIC_RELEASE, "agent");
            asm volatile("s_waitcnt vmcnt(0)" ::: "memory");
            const unsigned og = xb_add(&bar[XB_TOP], 1u);
            const unsigned tg = og / nx;
            if (og + 1u == (tg + 1u) * nx) xb_add(&bar[XB_TOPGEN], 1u);
            else XB_SPIN(xb_ld(&bar[XB_TOPGEN]) == tg, bar);
            __builtin_amdgcn_fence(__ATOMIC_ACQUIRE, "agent");
            xb_add(&bar[XB_XGEN(b.x)], 1u);
            asm volatile("s_waitcnt vmcnt(0)" ::: "memory");
        } else {
            XB_SPIN(xb_ld(&bar[XB_XGEN(b.x)]) == gen, bar);
            __builtin_amdgcn_fence(__ATOMIC_ACQUIRE, "agent");
            asm volatile("s_waitcnt vmcnt(0)" ::: "memory");
        }
    }
    __syncthreads();
}


constexpr int CW_FLAT = 12288;
__device__ __forceinline__ void flat_barrier(const XcdBarrier& b, unsigned* ctl, const unsigned nbar) {
    asm volatile("s_waitcnt vmcnt(0)" ::: "memory");
    __syncthreads();
    if (threadIdx.x == 0) {
        unsigned* cnt = ctl + CW_FLAT; unsigned* bar = b.bar;
        __builtin_amdgcn_s_waitcnt(0);
        unsigned nloc = b.st[0], nx = b.st[1];
        if (nloc == 0u) { xcd_barrier_complete(bar, b.x, nloc, nx); b.st[0] = nloc; b.st[1] = nx; }
        const unsigned old = xb_add(&cnt[64 * b.x], 1u);
        if (old + 1u == (nbar + 1u) * nloc) {
            __builtin_amdgcn_fence(__ATOMIC_RELEASE, "agent");
            asm volatile("s_waitcnt vmcnt(0)" ::: "memory");
            (void)__hip_atomic_fetch_add(&cnt[64 * 16], 1u, __ATOMIC_RELAXED, __HIP_MEMORY_SCOPE_AGENT);
        }
        const unsigned target = (nbar + 1u) * nx;
        unsigned sp = 0u;
        while (xb_ld(&cnt[64 * 16]) < target) { __builtin_amdgcn_s_sleep(1);
            if ((++sp & 255u) == 0u) { if (xb_ld(&bar[XB_TMO])) break; if (sp > XB_SPIN_CAP) { atomicAdd(&bar[XB_TMO], 1u); break; } } }
        __builtin_amdgcn_fence(__ATOMIC_ACQUIRE, "agent");
        asm volatile("s_waitcnt vmcnt(0)" ::: "memory");
    }
    __syncthreads();
}

namespace pg8 {
constexpr int BM = 256, BK = 64, HALF = 128, HTB = HALF * BK * 2, STAGE_BYTES = 8 * HTB, NXCD = 8, WGM = 8;
__host__ __device__ __forceinline__ int lds_byte(int r, int c) { const int st = (r >> 4) * 2 + (c >> 5), rr = r & 15, cc = c & 31, ob = rr * 64 + cc * 2; return st * 1024 + (ob ^ (((ob >> 9) & 1) << 5)); }
__host__ __device__ __forceinline__ void stage_rc(int b, int& R, int& C) { const int st = b / 1024, sb = b % 1024, swz = sb ^ (((sb >> 9) & 1) << 5); R = (st >> 1) * 16 + swz / 64; C = (st & 1) * 32 + (swz % 64) / 2; }
struct Unit { int pm, pn, ko, nt, keep; };
struct Gemm { const h16* A; const h16* Bt; int lda, ldb, K; };
struct StaticOrder {
    int nM, nN, nwg, G, c;
    __host__ __device__ void init(int M, int N, int G_, int c_) { nM = M / BM; nN = N / BM; nwg = nM * nN; G = G_; c = c_; }
    __host__ __device__ bool next(int i, Unit& u) const {
        const long L = (long)i * G + c; if (L >= nwg) return false;
        int wgid = (int)L; { const int q = nwg / NXCD, r = nwg % NXCD, xcd = wgid % NXCD, off = wgid / NXCD; wgid = (xcd < r ? xcd * (q + 1) : r * (q + 1) + (xcd - r) * q) + off; }
        const int nig = WGM * nN, gid = wgid / nig, fm = gid * WGM, gsz = (nM - fm) < WGM ? (nM - fm) : WGM;
        u.pm = fm + ((wgid % nig) % gsz); u.pn = (wgid % nig) / gsz; u.ko = 0; u.nt = 0; u.keep = 0; return true;
    }
};
template <class Epi, class Sched, bool ALIGN_EPI = true>
__device__ __forceinline__ void gemm_phase(LAS unsigned char* lds, const Gemm g, const Sched& S, const Epi& E) {
    const int tid = threadIdx.x, wid = __builtin_amdgcn_readfirstlane(tid >> 6), lane = tid & 63, wr = wid >> 2, wc = wid & 3, fr = lane & 15, fq = lane >> 4;
    const int nt0 = g.K / BK;
    unsigned voffA[2], voffB[2];
#pragma unroll
    for (int i = 0; i < 2; ++i) { int R, C; stage_rc(tid * 16 + i * 8192, R, C); voffA[i] = (unsigned)(R * g.lda + C) * 2u; voffB[i] = (unsigned)(R * g.ldb + C) * 2u; }
    const size_t kstep = (size_t)(BK * 2);
    const size_t hstepA = (size_t)HALF * g.lda * 2, hstepB = (size_t)HALF * g.ldb * 2;
    const size_t tstepA = 2 * hstepA, tstepB = 2 * hstepB;
    const unsigned ldsw = (unsigned)wid * 1024u;
    const int aoff = lds_byte(wr * 64 + fr, fq * 8), boff = lds_byte(wc * 32 + fr, fq * 8);
#define PG8_SA(b, h) (((b) * 2 + (h)) * HTB)
#define PG8_SB(b, h) ((4 + (b) * 2 + (h)) * HTB)
#define PG8_STAGE(bufoff, gbase, voff) do { _Pragma("unroll") for (int _i = 0; _i < 2; ++_i) \
        __builtin_amdgcn_global_load_lds((const unsigned*)((const char*)(gbase) + (voff)[_i]), (LAS unsigned*)(lds + (bufoff) + ldsw + _i * 8192), 16, 0, 0); } while (0)
#define PG8_LDA(dst, b, h) do { _Pragma("unroll") for (int m = 0; m < 4; ++m) _Pragma("unroll") for (int k = 0; k < 2; ++k) dst[m][k] = *(const LAS h16x8*)(lds + PG8_SA(b, h) + aoff + m * 2048 + k * 1024); } while (0)
#define PG8_LDB(dst, b, h) do { _Pragma("unroll") for (int n = 0; n < 2; ++n) _Pragma("unroll") for (int k = 0; k < 2; ++k) dst[n][k] = *(const LAS h16x8*)(lds + PG8_SB(b, h) + boff + n * 2048 + k * 1024); } while (0)
#define PG8_MMA(ai, bj, At, Bt) do { __builtin_amdgcn_s_setprio(1); _Pragma("unroll") for (int m = 0; m < 4; ++m) _Pragma("unroll") for (int n = 0; n < 2; ++n) _Pragma("unroll") for (int k = 0; k < 2; ++k) \
        acc[ai][bj][m][n] = __builtin_amdgcn_mfma_f32_16x16x32_f16(Bt[n][k], At[m][k], acc[ai][bj][m][n], 0, 0, 0); __builtin_amdgcn_s_setprio(0); } while (0)
#define PG8_WAIT_V(n) asm volatile("s_waitcnt vmcnt(" #n ")" ::: "memory")
#define PG8_WAIT_L(n) asm volatile("s_waitcnt lgkmcnt(" #n ")" ::: "memory")
#define PG8_BAR __builtin_amdgcn_s_barrier()
#define PG8_SCHED __builtin_amdgcn_sched_barrier(0)
    Unit cur, nxt; int ui = 0;
    if (!S.next(0, cur)) return;
    f32x4 acc[2][2][4][2];
#pragma unroll
    for (int a = 0; a < 2; ++a)
#pragma unroll
        for (int b = 0; b < 2; ++b)
#pragma unroll
            for (int m = 0; m < 4; ++m)
#pragma unroll
                for (int n = 0; n < 2; ++n) acc[a][b][m][n] = (f32x4){0.f, 0.f, 0.f, 0.f};
    h16x8 At[4][2], B0[2][2], B1[2][2];
    const char* cA = (const char*)g.A + (size_t)cur.pm * tstepA + (size_t)cur.ko * 2; const char* cB = (const char*)g.Bt + (size_t)cur.pn * tstepB + (size_t)cur.ko * 2;
    {
        PG8_STAGE(PG8_SB(0, 0), cB, voffB); PG8_STAGE(PG8_SB(0, 1), cB + hstepB, voffB); PG8_STAGE(PG8_SA(0, 0), cA, voffA); PG8_STAGE(PG8_SA(0, 1), cA + hstepA, voffA);
        if (wr == 1) PG8_BAR;
        PG8_WAIT_V(2); PG8_BAR;
        PG8_STAGE(PG8_SB(1, 0), cB + kstep, voffB); PG8_STAGE(PG8_SA(1, 0), cA + kstep, voffA); PG8_STAGE(PG8_SB(1, 1), cB + hstepB + kstep, voffB);
        PG8_WAIT_V(6); PG8_BAR;
    }
    for (;;) {
        const bool has_next = S.next(ui + 1, nxt);
        const char* nA = has_next ? (const char*)g.A + (size_t)nxt.pm * tstepA + (size_t)nxt.ko * 2 : cA; const char* nB = has_next ? (const char*)g.Bt + (size_t)nxt.pn * tstepB + (size_t)nxt.ko * 2 : cB;
        int nt = cur.nt ? cur.nt : nt0; asm volatile("" : "+s"(nt));
        for (int t = 0; t < nt; t += 2) {
            const bool last = (t == nt - 2);
            const char* a1 = cA + (size_t)(t + 1) * kstep;
            const char* a2 = last ? nA : cA + (size_t)(t + 2) * kstep; const char* b2 = last ? nB : cB + (size_t)(t + 2) * kstep;
            const char* a3 = a2 + kstep; const char* b3 = b2 + kstep;
            PG8_LDB(B0, 0, 0); PG8_LDB(B1, 0, 1); PG8_SCHED; PG8_LDA(At, 0, 0); PG8_STAGE(PG8_SA(1, 1), a1 + hstepA, voffA);
            PG8_WAIT_V(8); PG8_WAIT_L(0); PG8_BAR; PG8_MMA(0, 0, At, B0); PG8_MMA(0, 1, At, B1); PG8_BAR; PG8_SCHED;
            PG8_LDA(At, 0, 1); PG8_STAGE(PG8_SB(0, 0), b2, voffB); PG8_STAGE(PG8_SB(0, 1), b2 + hstepB, voffB); PG8_STAGE(PG8_SA(0, 0), a2, voffA);
            PG8_WAIT_V(8); PG8_WAIT_L(0); PG8_BAR; PG8_MMA(1, 0, At, B0); PG8_MMA(1, 1, At, B1); PG8_BAR; PG8_SCHED;
            PG8_LDB(B0, 1, 0); PG8_LDB(B1, 1, 1); PG8_SCHED; PG8_LDA(At, 1, 0); PG8_STAGE(PG8_SA(0, 1), a2 + hstepA, voffA);
            PG8_WAIT_V(8); PG8_WAIT_L(0); PG8_BAR; PG8_MMA(0, 0, At, B0); PG8_MMA(0, 1, At, B1); PG8_BAR; PG8_SCHED;
            PG8_LDA(At, 1, 1); PG8_STAGE(PG8_SB(1, 0), b3, voffB); PG8_STAGE(PG8_SB(1, 1), b3 + hstepB, voffB); PG8_STAGE(PG8_SA(1, 0), a3, voffA);
            PG8_WAIT_V(8); PG8_WAIT_L(0); PG8_BAR; PG8_MMA(1, 0, At, B0); PG8_MMA(1, 1, At, B1); PG8_BAR; PG8_SCHED;
        }
        if constexpr (ALIGN_EPI) { if (wr == 0) PG8_BAR; }
        E(acc, cur, wr, wc, fr, fq);
        if (!has_next) break;
        if (!cur.keep) {
#pragma unroll
        for (int a = 0; a < 2; ++a)
#pragma unroll
            for (int b = 0; b < 2; ++b)
#pragma unroll
                for (int m = 0; m < 4; ++m)
#pragma unroll
                    for (int n = 0; n < 2; ++n) acc[a][b][m][n] = (f32x4){0.f, 0.f, 0.f, 0.f};
        }
        cur = nxt; cA = nA; cB = nB; ++ui;
        if constexpr (ALIGN_EPI) { if (wr == 1) PG8_BAR; }
    }
    PG8_WAIT_V(0);
    if constexpr (!ALIGN_EPI) { if (wr == 0) PG8_BAR; }
    PG8_BAR;
#undef PG8_SA
#undef PG8_SB
#undef PG8_STAGE
#undef PG8_LDA
#undef PG8_LDB
#undef PG8_MMA
#undef PG8_WAIT_V
#undef PG8_WAIT_L
#undef PG8_BAR
#undef PG8_SCHED
}
}

struct Frame {
    LAS unsigned char* lds;
    int tid, lane, wave, vcu, G;
    const float *x, *c, *ctx, *c_ctx, *w_mod, *b_mod, *norm_attn, *norm_ffn, *w_in, *ret_decay, *diff_lambda, *diff_subln,
                *w_ret_o, *w_diff_o, *w_out, *w_router, *router_bias, *w_exp_gu, *w_exp_down, *w_sh_gu, *w_sh_down, *final_norm;
    float* out;
    unsigned char* ws;
};

template <class T> __device__ __forceinline__ const T* uni_ptr(const T* p) {
    const unsigned long long v = (unsigned long long)p;
    const unsigned lo = __builtin_amdgcn_readfirstlane((unsigned)v), hi = __builtin_amdgcn_readfirstlane((unsigned)(v >> 32));
    return (const T*)(((unsigned long long)hi << 32) | lo);
}
__device__ __forceinline__ float wave_sum(float v) {
#pragma unroll
    for (int o = 1; o < 64; o <<= 1) v += __shfl_xor(v, o);
    return v;
}
__device__ __forceinline__ unsigned pk2h(float lo, float hi) { f32x2 v = {lo, hi}; h16x2 h = __builtin_convertvector(v, h16x2); return __builtin_bit_cast(unsigned, h); }
__device__ __forceinline__ float silu_f(float v) { return v * __builtin_amdgcn_rcpf(1.0f + __expf(-v)); }
__device__ __forceinline__ float sigmoid_f(float v) { return __builtin_amdgcn_rcpf(1.0f + __expf(-v)); }

__device__ __forceinline__ void p0_mod_unit(Frame& F, int unit) {
    const int cb = unit % 24, ks = unit / 24;
    LAS float* sv = (LAS float*)F.lds;
    LAS float* red = sv + 768;
    for (int i = F.tid; i < 768; i += NTHR) { const int v = i >> 8, k = i & 255; const float cv = (v < 2) ? F.c[v * DM + ks * 256 + k] : F.c_ctx[ks * 256 + k]; sv[i] = silu_f(cv); }
    __syncthreads();
    const int cl = F.tid & 127, rl = F.tid >> 7;
    const float* wp = F.w_mod + (size_t)(ks * 256 + rl) * (6 * DM) + cb * 512 + cl * 4;
    f32x4 a0 = {0.f, 0.f, 0.f, 0.f}, a1 = a0, a2 = a0;
#pragma unroll 8
    for (int i = 0; i < 64; ++i) { const f32x4 w = *(const f32x4*)(wp + (size_t)i * 4 * (6 * DM)); const int k = rl + 4 * i; a0 += w * sv[k]; a1 += w * sv[256 + k]; a2 += w * sv[512 + k]; }
    *(LAS f32x4*)(red + (rl * 3 + 0) * 512 + cl * 4) = a0; *(LAS f32x4*)(red + (rl * 3 + 1) * 512 + cl * 4) = a1; *(LAS f32x4*)(red + (rl * 3 + 2) * 512 + cl * 4) = a2;
    __syncthreads();
    float* modp = (float*)(F.ws + WS_MODP);
    for (int i = F.tid; i < 1536; i += NTHR) { const int v = i >> 9, cc = i & 511; const float s = (red[(0 * 3 + v) * 512 + cc] + red[(1 * 3 + v) * 512 + cc]) + (red[(2 * 3 + v) * 512 + cc] + red[(3 * 3 + v) * 512 + cc]);
        modp[(size_t)(ks * 3 + v) * (6 * DM) + cb * 512 + cc] = s; }
    __syncthreads();
}
template <int MAP>
__device__ __forceinline__ void p0_transpose_item(const float* W, int K, int N, h16* WT, LAS float* scr, int item, int lane, int ldd = 0) {
    if (ldd == 0) ldd = K;
    const int nblk = N / 32, kb = item / nblk, nb = item % nblk, k0 = 64 * kb, n0 = 32 * nb;
    float wv[32];
#pragma unroll
    for (int i = 0; i < 32; ++i) { const int kk = 2 * i + (lane >> 5); wv[i] = W[(size_t)(k0 + kk) * N + n0 + (lane & 31)]; }
#pragma unroll
    for (int i = 0; i < 32; ++i) { const int kk = 2 * i + (lane >> 5); scr[kk * 33 + (lane & 31)] = wv[i]; }
    asm volatile("s_waitcnt lgkmcnt(0)" ::: "memory");
    const int cch = lane & 7;
#pragma unroll
    for (int j = 0; j < 4; ++j) { const int n = (lane >> 3) + 8 * j; const LAS float* s = scr + (8 * cch) * 33 + n;
        u32x4 o; o.x = pk2h(s[0 * 33], s[1 * 33]); o.y = pk2h(s[2 * 33], s[3 * 33]); o.z = pk2h(s[4 * 33], s[5 * 33]); o.w = pk2h(s[6 * 33], s[7 * 33]);
        int nn = n0 + n;
        if (MAP == 1) { const bool isrope = (nn < 1024) || (nn >= C_RQ && nn < C_RQ + 1024); if (isrope) nn = (nn & ~48) | ((nn & 16) << 1) | ((nn & 32) >> 1); }
        if (MAP == 2) { const int j = nn & 255, isu = nn >> 8; nn = 32 * (j >> 4) + 16 * isu + (j & 15); }
        *(u32x4*)(WT + (size_t)nn * ldd + k0 + 8 * cch) = o; }
    asm volatile("s_waitcnt lgkmcnt(0)" ::: "memory");
}
__device__ __forceinline__ void p0a_mod(Frame& F) {
    for (int u = F.vcu; u < 192; u += F.G) p0_mod_unit(F, u);
}
__device__ __forceinline__ void p0b_weights(Frame& F) {
    __syncthreads();
    LAS float* scr = (LAS float*)(F.lds + F.wave * 16384);
    const int gw = F.vcu * NWAVES + F.wave, NGW = F.G * NWAVES;
    constexpr int I_IN = (DM / 64) * (IN_COLS / 32);
    for (int it = gw; it < I_IN; it += NGW) p0_transpose_item<1>(F.w_in, DM, IN_COLS, (h16*)(F.ws + WS_WINT), scr, it, F.lane);
    if (blockIdx.x == 0) {
        float* rope = (float*)(F.ws + WS_ROPE);
        for (int i = F.tid; i < 64 * 32; i += NTHR) { const int pos = i >> 5, j = i & 31; const float inv = exp2f(-(float)j * (13.287712379549449f / 32.0f)); const float ang = (float)pos * inv; rope[i] = cosf(ang); rope[2048 + i] = sinf(ang); }
        for (int i = F.tid; i < 64 * 16; i += NTHR) { const int pos = i >> 4, j = i & 15; const float inv = exp2f(-(float)j * (13.287712379549449f / 16.0f)); const float ang = (float)pos * inv; rope[4096 + i] = cosf(ang); rope[4096 + 1024 + i] = sinf(ang); }
    }
}
__device__ __forceinline__ void p0c_weights_dyn(Frame& F, int qid) {
    unsigned* QH = (unsigned*)(F.ws + WS_CTL) + CW_Q + 64 * 8 * qid;
    LAS int* RED = (LAS int*)(F.lds + LDS_TICKET);
    LAS float* scr = (LAS float*)(F.lds + F.wave * 16384);
    constexpr int I_RET = (2048 / 64) * (DM / 32), I_DIF = (1024 / 64) * (DM / 32), I_OUT = (DM / 64) * (DM / 32), I_SGU = (DM / 64) * (512 / 32), I_SDN = (256 / 64) * (DM / 32), I_RT = NEXP * DM / 4 / 64;
    constexpr int NITEMS = I_RET + I_DIF + I_OUT + I_SGU + I_SDN + I_RT, NTICK = (NITEMS + 7) / 8;
    for (;;) {
        __syncthreads();
        if (F.tid == 0) RED[0] = (int)__hip_atomic_fetch_add(QH, 1u, __ATOMIC_RELAXED, __HIP_MEMORY_SCOPE_AGENT);
        __syncthreads();
        const int t = RED[0];
        if (t >= NTICK) break;
        int r = t * 8 + F.wave;
        if (r >= NITEMS) continue;
        if (r < I_RET) { p0_transpose_item<0>(F.w_ret_o, 2048, DM, (h16*)(F.ws + WS_WCAT), scr, r, F.lane, 3072); continue; } r -= I_RET;
        if (r < I_DIF) { p0_transpose_item<0>(F.w_diff_o, 1024, DM, (h16*)(F.ws + WS_WCAT) + 2048, scr, r, F.lane, 3072); continue; } r -= I_DIF;
        if (r < I_OUT) { p0_transpose_item<0>(F.w_out, DM, DM, (h16*)(F.ws + WS_WOUT), scr, r, F.lane); continue; } r -= I_OUT;
        if (r < I_SGU) { p0_transpose_item<2>(F.w_sh_gu, DM, 512, (h16*)(F.ws + WS_WSGU), scr, r, F.lane); continue; } r -= I_SGU;
        if (r < I_SDN) { p0_transpose_item<0>(F.w_sh_down, 256, DM, (h16*)(F.ws + WS_WSDN), scr, r, F.lane); continue; } r -= I_SDN;
        {
            const int q = r * 64 + F.lane, e = q / (DM / 4), k = (q % (DM / 4)) * 4;
            const f32x4 w = *(const f32x4*)(F.w_router + (size_t)e * DM + k);
            h16 hi[4], lo[4];
#pragma unroll
            for (int j = 0; j < 4; ++j) { hi[j] = (h16)w[j]; lo[j] = (h16)(w[j] - (float)hi[j]); }
            h16* dst = (h16*)(F.ws + WS_WRTR) + (size_t)e * 6144 + k;
            *(h16x4*)(dst) = (h16x4){hi[0], hi[1], hi[2], hi[3]}; *(h16x4*)(dst + 2048) = (h16x4){hi[0], hi[1], hi[2], hi[3]}; *(h16x4*)(dst + 4096) = (h16x4){lo[0], lo[1], lo[2], lo[3]};
        }
    }
}

__device__ __forceinline__ void p1_norm1(Frame& F) {
    LAS float* msh = (LAS float*)F.lds; LAS float* msc = msh + 3 * DM;
    const float* modp = (const float*)(F.ws + WS_MODP);
#pragma unroll 1
    for (int i0 = F.tid; i0 < 3 * 2 * DM; i0 += 4 * NTHR) { float pv[4][8], bs[4];
#pragma unroll
        for (int q = 0; q < 4; ++q) { const int i = i0 + q * NTHR, v = i / (2 * DM), cc = i % (2 * DM); bs[q] = F.b_mod[cc];
#pragma unroll
            for (int ks = 0; ks < 8; ++ks) pv[q][ks] = modp[(size_t)(ks * 3 + v) * (6 * DM) + cc]; }
#pragma unroll
        for (int q = 0; q < 4; ++q) { const int i = i0 + q * NTHR, v = i / (2 * DM), cc = i % (2 * DM); float s = bs[q];
#pragma unroll
            for (int ks = 0; ks < 8; ++ks) s += pv[q][ks];
            if (cc < DM) msh[v * DM + cc] = s; else msc[v * DM + cc - DM] = s; } }
    __syncthreads();
    const int gw = F.vcu * NWAVES + F.wave, NGW = F.G * NWAVES;
    h16* H = (h16*)(F.ws + WS_H);
    f32x4 xn[8];
    if (gw < MALL) { const float* s0 = (gw < MLAT) ? F.x + (size_t)gw * DM : F.ctx + (size_t)(gw - MLAT) * DM;
#pragma unroll
        for (int j = 0; j < 8; ++j) xn[j] = *(const f32x4*)(s0 + 4 * F.lane + 256 * j); }
    for (int r = gw; r < MALL; r += NGW) {
        const int v = (r < MLAT) ? (r / SEQ) : 2;
        f32x4 xv[8], nwv[8]; float ss = 0.f;
#pragma unroll
        for (int j = 0; j < 8; ++j) xv[j] = xn[j];
        { const int rn = (r + NGW < MALL) ? r + NGW : r; const float* sn_ = (rn < MLAT) ? F.x + (size_t)rn * DM : F.ctx + (size_t)(rn - MLAT) * DM;
#pragma unroll
          for (int j = 0; j < 8; ++j) xn[j] = *(const f32x4*)(sn_ + 4 * F.lane + 256 * j); }
#pragma unroll
        for (int j = 0; j < 8; ++j) nwv[j] = *(const f32x4*)(F.norm_attn + 4 * F.lane + 256 * j);
#pragma unroll
        for (int j = 0; j < 8; ++j) ss += (xv[j].x * xv[j].x + xv[j].y * xv[j].y) + (xv[j].z * xv[j].z + xv[j].w * xv[j].w);
        const float rstd = 1.0f / sqrtf(wave_sum(ss) * (1.0f / DM) + EPS);
#pragma unroll
        for (int j = 0; j < 8; ++j) { const int cc = 4 * F.lane + 256 * j; const f32x4 nw = nwv[j];
            const f32x4 sc = *(LAS f32x4*)(msc + v * DM + cc), sh = *(LAS f32x4*)(msh + v * DM + cc);
            const f32x4 y = xv[j] * rstd * nw * (sc + 1.0f) + sh;
            u32x2 o; o.x = pk2h(y.x, y.y); o.y = pk2h(y.z, y.w); *(u32x2*)(H + (size_t)r * DM + cc) = o; }
    }
    float* MOD = (float*)(F.ws + WS_MOD);
    for (int i = blockIdx.x * NTHR + F.tid; i < 3 * 6 * DM; i += F.G * NTHR) { const int v = i / (6 * DM), cc = i % (6 * DM); float s = F.b_mod[cc];
#pragma unroll
        for (int ks = 0; ks < 8; ++ks) s += modp[(size_t)(ks * 3 + v) * (6 * DM) + cc];
        MOD[i] = s; }
}


__device__ __forceinline__ int crow(int r, int hi) { return (r & 3) + 8 * (r >> 2) + 4 * hi; }
__device__ __forceinline__ h16x8 frag_row(const LAS unsigned char* base, int strideB, int r0, int k0, int lane) {
    return *(const LAS h16x8*)(base + (r0 + (lane & 31)) * strideB + (k0 + 8 * (lane >> 5)) * 2);
}
__device__ __forceinline__ v4i16_t tr16(const LAS unsigned char* p) { return __builtin_amdgcn_ds_read_tr16_b64_v4i16((LAS v4i16_t*)p); }
__device__ __forceinline__ h16x8 frag_tr(const LAS unsigned char* base, int strideB, int k0, int n0, int lane) {
    const int kb = k0 + 8 * (lane >> 5) + ((lane & 15) >> 2), nc = n0 + 16 * ((lane >> 4) & 1) + 4 * (lane & 3);
    const LAS unsigned char* p = base + kb * strideB + nc * 2;
    const v4i16_t lo = tr16(p), hi = tr16(p + 4 * strideB);
    typedef short s16x8 __attribute__((ext_vector_type(8)));
    const s16x8 v = {lo[0], lo[1], lo[2], lo[3], hi[0], hi[1], hi[2], hi[3]};
    return __builtin_bit_cast(h16x8, v);
}
__device__ __forceinline__ h16x8 frag_tr_perm(const LAS unsigned char* base, int strideB, int k0, int n0, int lane) {
    const int kb = k0 + 4 * (lane >> 5) + ((lane & 15) >> 2), nc = n0 + 16 * ((lane >> 4) & 1) + 4 * (lane & 3);
    const LAS unsigned char* p = base + kb * strideB + nc * 2;
    const v4i16_t lo = tr16(p), hi = tr16(p + 8 * strideB);
    typedef short s16x8 __attribute__((ext_vector_type(8)));
    const s16x8 v = {lo[0], lo[1], lo[2], lo[3], hi[0], hi[1], hi[2], hi[3]};
    return __builtin_bit_cast(h16x8, v);
}
__device__ __forceinline__ h16x8 pack8(float a0, float a1, float a2, float a3, float a4, float a5, float a6, float a7) {
    u32x4 w; w.x = pk2h(a0, a1); w.y = pk2h(a2, a3); w.z = pk2h(a4, a5); w.w = pk2h(a6, a7); return __builtin_bit_cast(h16x8, w);
}
#define MFMA32(a, b, c) __builtin_amdgcn_mfma_f32_32x32x16_f16((a), (b), (c), 0, 0, 0)

struct SchedG1 {
    pg8::StaticOrder so; int G, c;
    __device__ __forceinline__ bool next(int i, pg8::Unit& u) const {
        const int L = i * G + c;
        if (L < 32 * 52) return so.next(i, u);
        const int r = L - 32 * 52; if (r >= 40) return false;
        u.pm = 32 + r / 20; u.pn = r % 20; u.ko = 0; u.nt = 0; u.keep = 0; return true;
    }
};
struct EpiP {
    h16* P; const float* rope; u32x2* GATE;
    __device__ __forceinline__ void operator()(f32x4 (&acc)[2][2][4][2], const pg8::Unit& u, int wr, int wc, int fr, int fq) const {
        const int colt = u.pn * 256; const bool lat = u.pm < 32;
        int kind;
        if (colt < C_RV) kind = 1; else if (colt < C_DK) kind = 0; else if (colt < C_DV) kind = 3; else if (colt < C_RQ) kind = 0; else if (colt < C_RG) kind = 2; else if (colt < C_DQ) kind = 5; else if (colt < C_GR) kind = 4; else kind = 6;
        if (!lat) kind = (kind == 1) ? 7 : 0;
#pragma unroll
        for (int ai = 0; ai < 2; ++ai)
#pragma unroll
            for (int m = 0; m < 4; ++m) {
                const int row = u.pm * 256 + ai * 128 + wr * 64 + m * 16 + fr; const int t = row & (SEQ - 1);
                h16* prow = P + (size_t)row * IN_COLS;
                f32x4 csv[2], snv[2];
                if (kind >= 1 && kind <= 4) {
#pragma unroll
                    for (int bj = 0; bj < 2; ++bj) { const int cb_ = colt + bj * 128 + wc * 32; int offc, offs;
                        if (kind <= 2) { const int g5 = (cb_ >> 5) & 1, axis = (cb_ >> 6) & 1, pos = axis ? (t & 63) : (t >> 6); offc = pos * 32 + 16 * g5 + 4 * fq; offs = offc + 2048; }
                        else { const int axis = (cb_ >> 5) & 1, pos = axis ? (t & 63) : (t >> 6); offc = 4096 + pos * 16 + 4 * fq; offs = offc + 1024; }
                        csv[bj] = *(const f32x4*)(rope + offc); snv[bj] = *(const f32x4*)(rope + offs); }
                    asm volatile("" : "+v"(csv[0]), "+v"(csv[1]), "+v"(snv[0]), "+v"(snv[1]));
                }
#pragma unroll
                for (int bj = 0; bj < 2; ++bj) {
                    const int cbase = colt + bj * 128 + wc * 32;
                    const f32x4 x0 = acc[ai][bj][m][0], x1 = acc[ai][bj][m][1];
                    f32x4 o0, o1; int c0, c1;
                    if (kind == 1 || kind == 2) {
                        const int g5 = (cbase >> 5) & 1, j0 = 16 * g5 + 4 * fq;
                        const f32x4 cs = csv[bj], sn = snv[bj];
                        o0 = x0 * cs - x1 * sn; o1 = x0 * sn + x1 * cs;
                        if (kind == 2) { o0 *= 0.08838834764831845f; o1 *= 0.08838834764831845f; }
                        c0 = (cbase & ~63) + j0; c1 = c0 + 32;
                    } else if (kind == 7) {
                        const int g5 = (cbase >> 5) & 1; c0 = (cbase & ~63) + 16 * g5 + 4 * fq; c1 = c0 + 32; o0 = x0; o1 = x1;
                    } else if (kind == 3 || kind == 4) {
                        const int j0 = 4 * fq;
                        const f32x4 cs = csv[bj], sn = snv[bj];
                        o0 = x0 * cs - x1 * sn; o1 = x0 * sn + x1 * cs;
                        if (kind == 4) { o0 *= 0.18033688011112042f; o1 *= 0.18033688011112042f; }
                        c0 = cbase + j0; c1 = c0 + 16;
                    } else {
                        c0 = cbase + 4 * fq; c1 = c0 + 16; o0 = x0; o1 = x1;
                        if (kind == 5) {
#pragma unroll
                            for (int e = 0; e < 4; ++e) { o0[e] = silu_f(x0[e]); o1[e] = silu_f(x1[e]); }
                        } else if (kind == 6) {
#pragma unroll
                            for (int e = 0; e < 4; ++e) { o0[e] = sigmoid_f(x0[e]); o1[e] = sigmoid_f(x1[e]); }
                        }
                    }
                    u32x2 w0, w1; w0.x = pk2h(o0[0], o0[1]); w0.y = pk2h(o0[2], o0[3]); w1.x = pk2h(o1[0], o1[1]); w1.y = pk2h(o1[2], o1[3]);
                    if (kind == 6) {
                        const int gt = (colt - C_GR) >> 8, tid_ = (wr * 4 + wc) * 64 + fq * 16 + fr;
                        u32x2* gp = GATE + ((size_t)(((gt >> 3) * 32 + u.pm) * 8 + (gt & 7)) * 32 + ((ai * 4 + m) * 2 + bj) * 2) * 512 + tid_;
                        gp[0] = w0; gp[512] = w1;
                    } else { *(u32x2*)(prow + c0) = w0; *(u32x2*)(prow + c1) = w1; }
                }
            }
    }
};
__device__ __forceinline__ void p2_gemm1(Frame& F) {
    pg8::Gemm g{(const h16*)(F.ws + WS_H), (const h16*)(F.ws + WS_WINT), DM, DM, DM};
    SchedG1 S; S.so.init(MLAT, IN_COLS, F.G, (int)blockIdx.x); S.G = F.G; S.c = (int)blockIdx.x;
    EpiP E{(h16*)(F.ws + WS_P), (const float*)(F.ws + WS_ROPE), (u32x2*)(F.ws + WS_GATE)};
    pg8::gemm_phase<EpiP, SchedG1>(F.lds, g, S, E);
}

__device__ __forceinline__ void p3_ret_local(Frame& F) {
    LAS unsigned char* KF = F.lds; LAS unsigned char* KB = F.lds + 40960; LAS unsigned char* VH = F.lds + 81920;
    const h16* P = (const h16*)(F.ws + WS_P); h16* LST = (h16*)(F.ws + WS_LST);
    const int hi = F.lane >> 5;
    for (int u = F.vcu; u < 16 * 34; u += F.G) {
        const int bh = u / 34, cc = u % 34, b = bh >> 3, h = bh & 7;
        const int row0 = (cc < 2) ? (MLAT + b * CTXL + cc * 128) : (b * SEQ + (cc - 2) * 128);
        const float lgf = -__expf(F.ret_decay[h]), lgb = -__expf(F.ret_decay[8 + h]);
#pragma unroll
        for (int i = 0; i < 4; ++i) { const int q = F.tid + NTHR * i, row = q >> 4, ch = q & 15;
            const h16x8 kv = *(const h16x8*)(P + (size_t)(row0 + row) * IN_COLS + C_RK + h * 128 + ch * 8);
            const float sf = __expf(lgf * (float)(127 - row)), sb = __expf(lgb * (float)row);
            *(LAS h16x8*)(KF + row * 320 + ch * 16) = pack8((float)kv[0] * sf, (float)kv[1] * sf, (float)kv[2] * sf, (float)kv[3] * sf, (float)kv[4] * sf, (float)kv[5] * sf, (float)kv[6] * sf, (float)kv[7] * sf);
            *(LAS h16x8*)(KB + row * 320 + ch * 16) = pack8((float)kv[0] * sb, (float)kv[1] * sb, (float)kv[2] * sb, (float)kv[3] * sb, (float)kv[4] * sb, (float)kv[5] * sb, (float)kv[6] * sb, (float)kv[7] * sb); }
        h16x8 vpre[2][4];
#pragma unroll
        for (int eh = 0; eh < 2; ++eh)
#pragma unroll
            for (int i = 0; i < 4; ++i) { const int q = F.tid + NTHR * i, row = q >> 4, ch = q & 15; vpre[eh][i] = *(const h16x8*)(P + (size_t)(row0 + row) * IN_COLS + C_RV + h * 256 + eh * 128 + ch * 8); }
#pragma unroll
        for (int eh = 0; eh < 2; ++eh) {
            if (eh) __syncthreads();
#pragma unroll
            for (int i = 0; i < 4; ++i) { const int q = F.tid + NTHR * i, row = q >> 4, ch = q & 15;
                *(LAS h16x8*)(VH + row * 320 + ch * 16) = vpre[eh][i]; }
            __syncthreads();
            const int dir = F.wave >> 2, eb = F.wave & 3; const LAS unsigned char* Kd = dir ? KB : KF;
            f32x16 acc[4];
#pragma unroll
            for (int db = 0; db < 4; ++db) acc[db] = (f32x16){};
#pragma unroll
            for (int ks = 0; ks < 8; ++ks) { const h16x8 a = frag_tr(VH, 320, 16 * ks, 32 * eb, F.lane);
#pragma unroll
                for (int db = 0; db < 4; ++db) { const h16x8 bb = frag_tr(Kd, 320, 16 * ks, 32 * db, F.lane); acc[db] = MFMA32(a, bb, acc[db]); } }
            h16* dst = LST + ((size_t)((dir * 16 + bh) * 34 + cc) * 256 + eh * 128 + eb * 32) * 128;
#pragma unroll
            for (int db = 0; db < 4; ++db)
#pragma unroll
                for (int r = 0; r < 16; ++r) dst[crow(r, hi) * 128 + db * 32 + (F.lane & 31)] = (h16)acc[db][r];
        }
        __syncthreads();
    }
}
__device__ __forceinline__ void p4_ret_scan(Frame& F) {
    const h16* LST = (const h16*)(F.ws + WS_LST); h16* SST = (h16*)(F.ws + WS_SST);
    for (int g = blockIdx.x * NTHR + F.tid; g < 2 * 16 * 4096; g += F.G * NTHR) {
        const int seq = g >> 12, off = (g & 4095) * 8, dir = seq >> 4, bh = seq & 15, h = bh & 7;
        const float cd = __expf(-__expf(F.ret_decay[dir * 8 + h]) * 128.0f);
        const h16* Lp = LST + (size_t)seq * 34 * 32768 + off; h16* Sp = SST + (size_t)seq * 32 * 32768 + off;
        float s[8];
#pragma unroll
        for (int e = 0; e < 8; ++e) s[e] = 0.f;
        if (dir == 0) {
            for (int cc = 0; cc < 33; ++cc) {
                if (cc >= 2) *(h16x8*)(Sp + (size_t)(cc - 2) * 32768) = pack8(s[0], s[1], s[2], s[3], s[4], s[5], s[6], s[7]);
                const h16x8 l = *(const h16x8*)(Lp + (size_t)cc * 32768);
#pragma unroll
                for (int e = 0; e < 8; ++e) s[e] = s[e] * cd + (float)l[e];
            }
            *(h16x8*)(Sp + (size_t)31 * 32768) = pack8(s[0], s[1], s[2], s[3], s[4], s[5], s[6], s[7]);
        } else {
            { const h16x8 l1 = *(const h16x8*)(Lp + (size_t)1 * 32768), l0 = *(const h16x8*)(Lp);
#pragma unroll
              for (int e = 0; e < 8; ++e) s[e] = (float)l1[e] * cd + (float)l0[e]; }
            for (int c = 31; c >= 0; --c) {
                *(h16x8*)(Sp + (size_t)c * 32768) = pack8(s[0], s[1], s[2], s[3], s[4], s[5], s[6], s[7]);
                const h16x8 l = *(const h16x8*)(Lp + (size_t)(c + 2) * 32768);
#pragma unroll
                for (int e = 0; e < 8; ++e) s[e] = s[e] * cd + (float)l[e];
            }
        }
    }
}
__device__ __forceinline__ void p5_ret_out(Frame& F) {
    LAS unsigned char* QL = F.lds; LAS unsigned char* KL = F.lds + 34816; LAS unsigned char* PL = KL; LAS unsigned char* VL = F.lds + 69632;
    LAS float* RED = (LAS float*)(F.lds + 69632 + 73728);
    const h16* P = (const h16*)(F.ws + WS_P); const h16* SST = (const h16*)(F.ws + WS_SST); h16* ARET = (h16*)(F.ws + WS_ACAT);
    const int hi = F.lane >> 5, ln = F.lane & 31, w = F.wave;
    for (int u = F.vcu; u < 512; u += F.G) {
        const int bh = u >> 5, c = u & 31, b = bh >> 3, h = bh & 7, row0 = b * SEQ + c * 128;
        const float lgf = -__expf(F.ret_decay[h]), lgb = -__expf(F.ret_decay[8 + h]);
#pragma unroll
        for (int i = 0; i < 4; ++i) { const int q = F.tid + NTHR * i, row = q >> 4, ch = q & 15; const h16* pr = P + (size_t)(row0 + row) * IN_COLS + h * 128 + ch * 8;
            *(LAS h16x8*)(QL + row * 272 + ch * 16) = *(const h16x8*)(pr + C_RQ); *(LAS h16x8*)(KL + row * 272 + ch * 16) = *(const h16x8*)(pr + C_RK); }
        h16x8 vreg[8];
#pragma unroll
        for (int i = 0; i < 8; ++i) { const int q = F.tid + NTHR * i, row = q >> 5, c32 = q & 31; vreg[i] = *(const h16x8*)(P + (size_t)(row0 + row) * IN_COLS + C_RV + h * 256 + c32 * 8); }
        __syncthreads();
        u32x2 pw[2][4];
        { const int jt = w >> 1;
#pragma unroll
          for (int t2 = 0; t2 < 2; ++t2) { const int ib = 2 * (w & 1) + t2, il = 32 * ib + ln; f32x16 s = (f32x16){};
#pragma unroll
            for (int ks = 0; ks < 8; ++ks) s = MFMA32(frag_row(KL, 272, 32 * jt, 16 * ks, F.lane), frag_row(QL, 272, 32 * ib, 16 * ks, F.lane), s);
#pragma unroll
            for (int r = 0; r < 16; ++r) { const int d = il - (32 * jt + crow(r, hi)); s[r] *= (d >= 0) ? __expf(lgf * (float)d) : __expf(lgb * (float)(-d)); }
#pragma unroll
            for (int r4 = 0; r4 < 4; ++r4) { pw[t2][r4].x = pk2h(s[4 * r4], s[4 * r4 + 1]); pw[t2][r4].y = pk2h(s[4 * r4 + 2], s[4 * r4 + 3]); } } }
        __syncthreads();
        { const int jt = w >> 1;
#pragma unroll
          for (int t2 = 0; t2 < 2; ++t2) { const int il = 32 * (2 * (w & 1) + t2) + ln;
#pragma unroll
            for (int r4 = 0; r4 < 4; ++r4) *(LAS u32x2*)(PL + il * 272 + (32 * jt + 8 * r4 + 4 * hi) * 2) = pw[t2][r4]; } }
#pragma unroll
        for (int i = 0; i < 8; ++i) { const int q = F.tid + NTHR * i, row = q >> 5, c32 = q & 31; *(LAS h16x8*)(VL + row * 576 + c32 * 16) = vreg[i]; }
        __syncthreads();
        h16x8 sst[4][4];
#define P5_SLOAD(s) do { _Pragma("unroll") for (int k4 = 0; k4 < 4; ++k4) sst[s][k4] = *(const h16x8*)(SST + ((size_t)((((s) >> 1) * 16 + bh) * 32 + c) * 256 + 32 * w + ln) * 128 + 8 * hi + 16 * (4 * ((s) & 1) + k4)); } while (0)
        P5_SLOAD(0);
        f32x16 o[4];
#pragma unroll
        for (int ib = 0; ib < 4; ++ib) o[ib] = (f32x16){};
#pragma unroll
        for (int k16 = 0; k16 < 8; ++k16) { const h16x8 a = frag_tr(VL, 576, 16 * k16, 32 * w, F.lane);
#pragma unroll
            for (int ib = 0; ib < 4; ++ib) o[ib] = MFMA32(a, frag_row(PL, 272, 32 * ib, 16 * k16, F.lane), o[ib]);
            if (k16 & 1) __builtin_amdgcn_sched_barrier(0); }
#pragma unroll
        for (int dir = 0; dir < 2; ++dir) {
            h16 sc[4];
#pragma unroll
            for (int ib = 0; ib < 4; ++ib) { const int il = 32 * ib + ln; sc[ib] = (h16)(dir ? __expf(lgb * (float)(128 - il)) : __expf(lgf * (float)(il + 1))); }
#pragma unroll
            for (int kh = 0; kh < 2; ++kh) {
                if (2 * dir + kh == 0) P5_SLOAD(1); else if (2 * dir + kh == 1) P5_SLOAD(2); else if (2 * dir + kh == 2) P5_SLOAD(3);
                h16x8 sa[4];
#pragma unroll
                for (int k4 = 0; k4 < 4; ++k4) sa[k4] = sst[2 * dir + kh][k4];
#pragma unroll
                for (int k4 = 0; k4 < 4; ++k4) {
#pragma unroll
                    for (int ib = 0; ib < 4; ++ib) o[ib] = MFMA32(sa[k4], frag_row(QL, 272, 32 * ib, 16 * (4 * kh + k4), F.lane) * sc[ib], o[ib]);
                    __builtin_amdgcn_sched_barrier(0); }
            }
        }
#pragma unroll
        for (int ib = 0; ib < 4; ++ib) { float ss = 0.f;
#pragma unroll
            for (int r = 0; r < 16; ++r) ss += o[ib][r] * o[ib][r];
            ss += __shfl_xor(ss, 32);
            if (hi == 0) RED[(w * 4 + ib) * 32 + ln] = ss; }
        __syncthreads();
        u32x2 gtv[16];
#pragma unroll
        for (int j = 0; j < 16; ++j) gtv[j] = *(const u32x2*)(P + (size_t)(row0 + 32 * (j >> 2) + ln) * IN_COLS + C_RG + h * 256 + 32 * w + 8 * (j & 3) + 4 * hi);
        asm volatile("" : "+v"(gtv[0]), "+v"(gtv[1]), "+v"(gtv[2]), "+v"(gtv[3]), "+v"(gtv[4]), "+v"(gtv[5]), "+v"(gtv[6]), "+v"(gtv[7]));
        asm volatile("" : "+v"(gtv[8]), "+v"(gtv[9]), "+v"(gtv[10]), "+v"(gtv[11]), "+v"(gtv[12]), "+v"(gtv[13]), "+v"(gtv[14]), "+v"(gtv[15]));
#pragma unroll
        for (int ib = 0; ib < 4; ++ib) { float tot = 0.f;
#pragma unroll
            for (int ww = 0; ww < 8; ++ww) tot += RED[(ww * 4 + ib) * 32 + ln];
            const float rstd = 1.0f / sqrtf(tot * (1.0f / 256.0f) + EPS);
            const size_t grow = (size_t)(row0 + 32 * ib + ln);
#pragma unroll
            for (int r4 = 0; r4 < 4; ++r4) { const int e = 32 * w + 8 * r4 + 4 * hi;
                const h16x4 gt = __builtin_bit_cast(h16x4, gtv[ib * 4 + r4]);
                u32x2 wv; wv.x = pk2h(o[ib][4 * r4] * rstd * (float)gt[0], o[ib][4 * r4 + 1] * rstd * (float)gt[1]); wv.y = pk2h(o[ib][4 * r4 + 2] * rstd * (float)gt[2], o[ib][4 * r4 + 3] * rstd * (float)gt[3]);
                *(u32x2*)(ARET + grow * 3072 + h * 256 + e) = wv; } }
        __syncthreads();
    }
}
__device__ __forceinline__ void p6_attn(Frame& F) {
    const h16* P = (const h16*)(F.ws + WS_P); h16* ADIF = (h16*)(F.ws + WS_ACAT) + 2048;
    const int hi = F.lane >> 5, ln = F.lane & 31;
    float lam;
    { const float s1 = wave_sum(F.diff_lambda[F.lane] * F.diff_lambda[64 + F.lane]), s2 = wave_sum(F.diff_lambda[128 + F.lane] * F.diff_lambda[192 + F.lane]); lam = __expf(s1) - __expf(s2) + 0.2f; }
    constexpr int KT0 = 0, VT0 = 34816, KTB = 17408, VTB = 20480;
    LAS float* XB = (LAS float*)F.lds;
    for (int u = F.vcu; u < 512; u += F.G) {
        const int bh = u >> 5, qb = u & 31, b = bh >> 3, h = bh & 7;
        const int cm = F.wave & 1, qs = F.wave >> 1, qrow0 = b * SEQ + qb * 128 + qs * 32;
        h16x8 qf[4];
#pragma unroll
        for (int ks = 0; ks < 4; ++ks) qf[ks] = *(const h16x8*)(P + (size_t)(qrow0 + ln) * IN_COLS + C_DQ + h * 128 + cm * 64 + 16 * ks + 8 * hi);
        f32x16 o[4];
#pragma unroll
        for (int et = 0; et < 4; ++et) o[et] = (f32x16){};
        float mrun = 0.f, lsum = 0.f; f32x16 negm = (f32x16){};
        h16x8 kreg[2], vreg[2];
#define ATT_LOAD(t) do { _Pragma("unroll") for (int i = 0; i < 2; ++i) { const int q = F.tid + NTHR * i, row = q >> 4, ch = q & 15; const int j = (t) * 64 + row; \
            const size_t srow = (j < CTXL) ? (size_t)(MLAT + b * CTXL + j) : (size_t)(b * SEQ + j - CTXL); const h16* pr = P + srow * IN_COLS + h * 128 + ch * 8; \
            kreg[i] = *(const h16x8*)(pr + C_DK); vreg[i] = *(const h16x8*)(pr + C_DV); } } while (0)
#define ATT_WRITE(buf) do { _Pragma("unroll") for (int i = 0; i < 2; ++i) { const int q = F.tid + NTHR * i, row = q >> 4, ch = q & 15; \
            *(LAS h16x8*)(F.lds + KT0 + (buf) * KTB + row * 272 + ch * 16) = kreg[i]; *(LAS h16x8*)(F.lds + VT0 + (buf) * VTB + row * 320 + ch * 16) = vreg[i]; } } while (0)
        ATT_LOAD(0); ATT_WRITE(0);
        __syncthreads();
        constexpr int NT = (CTXL + SEQ) / 64;
        for (int t = 0; t < NT; ++t) {
            const int buf = t & 1;
            if (t + 1 < NT) ATT_LOAD(t + 1);
            const LAS unsigned char* Kt = F.lds + KT0 + buf * KTB; const LAS unsigned char* Vt = F.lds + VT0 + buf * VTB;
            f32x16 s[2];
#pragma unroll
            for (int kt = 0; kt < 2; ++kt) { s[kt] = negm;
#pragma unroll
                for (int ks = 0; ks < 4; ++ks) s[kt] = MFMA32(frag_row(Kt, 272, 32 * kt, cm * 64 + 16 * ks, F.lane), qf[ks], s[kt]); }
            float mx = s[0][0];
#pragma unroll
            for (int r = 0; r < 16; ++r) { mx = fmaxf(mx, s[0][r]); mx = fmaxf(mx, s[1][r]); }
            { const auto rr = __builtin_amdgcn_permlane32_swap(__float_as_uint(mx), __float_as_uint(mx), false, false); mx = fmaxf(__uint_as_float(rr[0]), __uint_as_float(rr[1])); }
            if (t == 0 || __any(mx > 8.0f)) { const float dl = (t == 0) ? mx : fmaxf(mx, 0.0f), alpha = (t == 0) ? 0.0f : __builtin_amdgcn_exp2f(-dl); mrun += dl; lsum *= alpha;
#pragma unroll
                for (int et = 0; et < 4; ++et) o[et] *= alpha;
#pragma unroll
                for (int kt = 0; kt < 2; ++kt)
#pragma unroll
                    for (int r = 0; r < 16; ++r) s[kt][r] -= dl;
#pragma unroll
                for (int r = 0; r < 16; ++r) negm[r] = -mrun; }
            f32x2 ps2 = {0.f, 0.f};
#pragma unroll
            for (int kt = 0; kt < 2; ++kt)
#pragma unroll
                for (int r = 0; r < 16; r += 2) { s[kt][r] = __builtin_amdgcn_exp2f(s[kt][r]); s[kt][r + 1] = __builtin_amdgcn_exp2f(s[kt][r + 1]); ps2 += (f32x2){s[kt][r], s[kt][r + 1]}; }
            lsum += ps2[0] + ps2[1];
#pragma unroll
            for (int kt = 0; kt < 2; ++kt)
#pragma unroll
                for (int s2 = 0; s2 < 2; ++s2) {
                    const h16x8 pbf = pack8(s[kt][8 * s2], s[kt][8 * s2 + 1], s[kt][8 * s2 + 2], s[kt][8 * s2 + 3], s[kt][8 * s2 + 4], s[kt][8 * s2 + 5], s[kt][8 * s2 + 6], s[kt][8 * s2 + 7]);
#pragma unroll
                    for (int et = 0; et < 4; ++et) o[et] = MFMA32(frag_tr_perm(Vt, 320, 32 * kt + 16 * s2, 32 * et, F.lane), pbf, o[et]);
                }
            if (t + 1 < NT) ATT_WRITE(buf ^ 1);
            __syncthreads();
        }
#undef ATT_LOAD
#undef ATT_WRITE
        lsum += __shfl_xor(lsum, 32);
        const float inv = 1.0f / lsum;
        if (cm == 1) {
#pragma unroll
            for (int et = 0; et < 4; ++et)
#pragma unroll
                for (int r = 0; r < 16; ++r) XB[(qs * 128 + 32 * et + crow(r, hi)) * 32 + ln] = o[et][r] * inv;
        }
        __syncthreads();
        if (cm == 0) {
            float ss = 0.f;
#pragma unroll
            for (int et = 0; et < 4; ++et)
#pragma unroll
                for (int r = 0; r < 16; ++r) { const float v = o[et][r] * inv - lam * XB[(qs * 128 + 32 * et + crow(r, hi)) * 32 + ln]; o[et][r] = v; ss += v * v; }
            ss += __shfl_xor(ss, 32);
            const float rstd = 0.8f / sqrtf(ss * (1.0f / 128.0f) + EPS);
            const size_t grow = (size_t)(qrow0 + ln);
            f32x4 swv[16];
#pragma unroll
            for (int j = 0; j < 16; ++j) swv[j] = *(const f32x4*)(F.diff_subln + 32 * (j >> 2) + 8 * (j & 3) + 4 * hi);
#pragma unroll
            for (int et = 0; et < 4; ++et)
#pragma unroll
                for (int r4 = 0; r4 < 4; ++r4) { const int e = 32 * et + 8 * r4 + 4 * hi; const f32x4 sw = swv[et * 4 + r4];
                    u32x2 w; w.x = pk2h(o[et][4 * r4] * rstd * sw[0], o[et][4 * r4 + 1] * rstd * sw[1]); w.y = pk2h(o[et][4 * r4 + 2] * rstd * sw[2], o[et][4 * r4 + 3] * rstd * sw[3]);
                    *(u32x2*)(ADIF + grow * 3072 + h * 128 + e) = w; }
        }
        __syncthreads();
    }
}
struct SchedG2 {
    pg8::StaticOrder so;
    __device__ __forceinline__ bool next(int i, pg8::Unit& u) const { if (!so.next(i >> 1, u)) return false; if (i & 1) { u.ko = 2048; u.nt = 16; u.keep = 0; } else { u.ko = 0; u.nt = 32; u.keep = 1; } return true; }
};
struct EpiU2 {
    h16* U; const u32x2* GATE;
    __device__ __forceinline__ void operator()(f32x4 (&acc)[2][2][4][2], const pg8::Unit& u, int wr, int wc, int fr, int fq) const {
        int fro = fr; asm volatile("" : "+v"(fro));
        const int tid_ = (wr * 4 + wc) * 64 + fq * 16 + fro;
        const char* grb = (const char*)(GATE + (size_t)(u.pm * 8 + u.pn) * 32 * 512); const char* gdb = grb + (size_t)32 * 8 * 32 * 512 * 8; const unsigned gvo = (unsigned)tid_ * 8u;
#pragma unroll
        for (int ai = 0; ai < 2; ++ai)
#pragma unroll
            for (int mp = 0; mp < 2; ++mp) {
                u32x2 gdv[8], grv[8];
#pragma unroll
                for (int k = 0; k < 8; ++k) { const size_t o = (size_t)(((ai * 4 + 2 * mp) * 4 + k) * 4096) + (size_t)gvo; gdv[k] = *(const u32x2*)(gdb + o); grv[k] = *(const u32x2*)(grb + o); }
                asm volatile("" : "+v"(gdv[0]), "+v"(gdv[1]), "+v"(gdv[2]), "+v"(gdv[3]), "+v"(grv[0]), "+v"(grv[1]), "+v"(grv[2]), "+v"(grv[3]));
                asm volatile("" : "+v"(gdv[4]), "+v"(gdv[5]), "+v"(gdv[6]), "+v"(gdv[7]), "+v"(grv[4]), "+v"(grv[5]), "+v"(grv[6]), "+v"(grv[7]));
#pragma unroll
                for (int k8 = 0; k8 < 8; ++k8) { const int m = 2 * mp + (k8 >> 2), k = k8 & 3; const int row = u.pm * 256 + ai * 128 + wr * 64 + m * 16 + fro;
                    const int bj = k >> 1, n = k & 1; const h16x4 gd = __builtin_bit_cast(h16x4, gdv[k8]);
                    if (u.keep) { const h16x4 gr = __builtin_bit_cast(h16x4, grv[k8]);
#pragma unroll
                        for (int e = 0; e < 4; ++e) acc[ai][bj][m][n][e] *= (float)gr[e] * __builtin_amdgcn_rcpf((float)gd[e]);
                    } else { const int col = u.pn * 256 + bj * 128 + wc * 32 + 16 * n + 4 * fq; const f32x4 a = acc[ai][bj][m][n];
                        u32x2 w; w.x = pk2h(a[0] * (float)gd[0], a[1] * (float)gd[1]); w.y = pk2h(a[2] * (float)gd[2], a[3] * (float)gd[3]);
                        *(u32x2*)(U + (size_t)row * DM + col) = w; } }
            }
    }
};
struct EpiX1 {
    float* X1; const float* x; const float* MOD;
    __device__ __forceinline__ void operator()(f32x4 (&acc)[2][2][4][2], const pg8::Unit& u, int wr, int wc, int fr, int fq) const {
        const int b = (u.pm * 256) / SEQ;
        int fro = fr; asm volatile("" : "+v"(fro));
        const int col0 = u.pn * 256 + wc * 32 + 4 * fq;
        f32x4 g1[4];
#pragma unroll
        for (int k = 0; k < 4; ++k) g1[k] = *(const f32x4*)(MOD + (size_t)b * (6 * DM) + 2 * DM + col0 + (k >> 1) * 128 + (k & 1) * 16);
#pragma unroll
        for (int ai = 0; ai < 2; ++ai) {
                f32x4 xv[16];
#pragma unroll
                for (int j = 0; j < 16; ++j) { const int m = j >> 2, k = j & 3; const int row = u.pm * 256 + ai * 128 + wr * 64 + m * 16 + fro;
                    xv[j] = *(const f32x4*)(x + (size_t)row * DM + col0 + (k >> 1) * 128 + (k & 1) * 16); }
                asm volatile("" : "+v"(xv[0]), "+v"(xv[1]), "+v"(xv[2]), "+v"(xv[3]), "+v"(xv[4]), "+v"(xv[5]), "+v"(xv[6]), "+v"(xv[7]));
                asm volatile("" : "+v"(xv[8]), "+v"(xv[9]), "+v"(xv[10]), "+v"(xv[11]), "+v"(xv[12]), "+v"(xv[13]), "+v"(xv[14]), "+v"(xv[15]));
#pragma unroll
                for (int j = 0; j < 16; ++j) { const int m = j >> 2, k = j & 3; const int row = u.pm * 256 + ai * 128 + wr * 64 + m * 16 + fro;
                    *(f32x4*)(X1 + (size_t)row * DM + col0 + (k >> 1) * 128 + (k & 1) * 16) = xv[j] + g1[k] * acc[ai][k >> 1][m][k & 1]; }
        }
    }
};
__device__ __forceinline__ void p7_gemm2(Frame& F) {
    pg8::Gemm g{(const h16*)(F.ws + WS_ACAT), (const h16*)(F.ws + WS_WCAT), 3072, 3072, 2048};
    SchedG2 S; S.so.init(MLAT, DM, F.G, (int)blockIdx.x);
    EpiU2 E{(h16*)(F.ws + WS_U), (const u32x2*)(F.ws + WS_GATE)};
    pg8::gemm_phase<EpiU2, SchedG2>(F.lds, g, S, E);
}
__device__ __forceinline__ void p9_gemm3(Frame& F) {
    pg8::Gemm g{(const h16*)(F.ws + WS_U), (const h16*)(F.ws + WS_WOUT), 2048, 2048, 2048};
    pg8::StaticOrder S; S.init(MLAT, DM, F.G, (int)blockIdx.x);
    EpiX1 E{(float*)(F.ws + WS_X1), F.x, (const float*)(F.ws + WS_MOD)};
    pg8::gemm_phase<EpiX1, pg8::StaticOrder>(F.lds, g, S, E);
}


__device__ __forceinline__ void p10_norm2(Frame& F) {
    const float* X1 = (const float*)(F.ws + WS_X1); const float* MOD = (const float*)(F.ws + WS_MOD); h16* H2X = (h16*)(F.ws + WS_H2X);
    const int gw = F.vcu * NWAVES + F.wave, NGW = F.G * NWAVES;
    f32x4 xn[8];
    if (gw < MLAT) {
#pragma unroll
        for (int j = 0; j < 8; ++j) xn[j] = *(const f32x4*)(X1 + (size_t)gw * DM + 4 * F.lane + 256 * j); }
    for (int r = gw; r < MLAT; r += NGW) {
        const int b = r / SEQ;
        f32x4 xv[8], nwv[8], shv[8], scv[8]; float ss = 0.f;
#pragma unroll
        for (int j = 0; j < 8; ++j) xv[j] = xn[j];
        { const int rn = (r + NGW < MLAT) ? r + NGW : r;
#pragma unroll
          for (int j = 0; j < 8; ++j) xn[j] = *(const f32x4*)(X1 + (size_t)rn * DM + 4 * F.lane + 256 * j); }
#pragma unroll
        for (int j = 0; j < 8; ++j) { const int cc = 4 * F.lane + 256 * j; nwv[j] = *(const f32x4*)(F.norm_ffn + cc);
            shv[j] = *(const f32x4*)(MOD + (size_t)b * (6 * DM) + 3 * DM + cc); scv[j] = *(const f32x4*)(MOD + (size_t)b * (6 * DM) + 4 * DM + cc); }
#pragma unroll
        for (int j = 0; j < 8; ++j) ss += (xv[j].x * xv[j].x + xv[j].y * xv[j].y) + (xv[j].z * xv[j].z + xv[j].w * xv[j].w);
        const float rstd = 1.0f / sqrtf(wave_sum(ss) * (1.0f / DM) + EPS);
#pragma unroll
        for (int j = 0; j < 8; ++j) { const int cc = 4 * F.lane + 256 * j; const f32x4 nw = nwv[j], sh = shv[j], sc = scv[j];
            const f32x4 y = xv[j] * rstd * nw * (sc + 1.0f) + sh;
            h16 hh[4], ll[4];
#pragma unroll
            for (int e = 0; e < 4; ++e) { hh[e] = (h16)y[e]; ll[e] = (h16)(y[e] - (float)hh[e]); }
            h16* dst = H2X + (size_t)r * 6144 + cc;
            *(h16x4*)(dst) = (h16x4){hh[0], hh[1], hh[2], hh[3]}; *(h16x4*)(dst + 4096) = (h16x4){hh[0], hh[1], hh[2], hh[3]}; *(h16x4*)(dst + 2048) = (h16x4){ll[0], ll[1], ll[2], ll[3]};
            { int p8 = __builtin_amdgcn_cvt_pk_fp8_f32(y[0], y[1], 0, false); p8 = __builtin_amdgcn_cvt_pk_fp8_f32(y[2], y[3], p8, true); *(int*)((unsigned char*)(F.ws + WS_H2F8) + (size_t)r * DM + cc) = p8; } }
    }
}
struct SchedRT {
    int G, c;
    __device__ __forceinline__ bool next(int i, pg8::Unit& u) const { const int L = i * G + c; if (L >= 256) return false; u.pm = L >> 3; u.pn = 0; u.ko = (L & 7) * 768; u.nt = 0; u.keep = 0; return true; }
};
struct EpiLG {
    float* LGP;
    __device__ __forceinline__ void operator()(f32x4 (&acc)[2][2][4][2], const pg8::Unit& u, int wr, int wc, int fr, int fq) const {
        float* dst = LGP + (size_t)(u.ko / 768) * MLAT * NEXP;
#pragma unroll
        for (int ai = 0; ai < 2; ++ai)
#pragma unroll
            for (int m = 0; m < 4; ++m) { const int row = u.pm * 256 + ai * 128 + wr * 64 + m * 16 + fr;
#pragma unroll
                for (int bj = 0; bj < 2; ++bj)
#pragma unroll
                    for (int n = 0; n < 2; ++n) { const int col = bj * 128 + wc * 32 + 16 * n + 4 * fq; *(f32x4*)(dst + (size_t)row * NEXP + col) = acc[ai][bj][m][n]; } }
    }
};
__device__ __forceinline__ void p11_router(Frame& F) {
    pg8::Gemm g{(const h16*)(F.ws + WS_H2X), (const h16*)(F.ws + WS_WRTR), 6144, 6144, 768};
    SchedRT S; S.G = F.G; S.c = (int)blockIdx.x;
    EpiLG E{(float*)(F.ws + WS_LGP)};
    pg8::gemm_phase<EpiLG, SchedRT>(F.lds, g, S, E);
}
__device__ __forceinline__ void p12_topk(Frame& F) {
    const float* LGP = (const float*)(F.ws + WS_LGP); int* EIDX = (int*)(F.ws + WS_EIDX); float* EW = (float*)(F.ws + WS_EW); u32x2* LIST = (u32x2*)(F.ws + WS_LIST2);
    unsigned* CNT = (unsigned*)(F.ws + WS_CTL) + CW_CNT;
    const int gw = F.vcu * NWAVES + F.wave, NGW = F.G * NWAVES, lane = F.lane;
    const f32x4 bias = *(const f32x4*)(F.router_bias + 4 * lane);
    f32x4 lgn[8];
#pragma unroll
    for (int ks = 0; ks < 8; ++ks) lgn[ks] = *(const f32x4*)(LGP + ((size_t)ks * MLAT + (gw < MLAT ? gw : 0)) * NEXP + 4 * lane);
    int pmye = 0; unsigned ppos = 0u; u32x2 pent = {0u, 0u}; bool have = false;
    for (int t = gw; t < MLAT; t += NGW) {
        f32x4 lg = lgn[0];
#pragma unroll
        for (int ks = 1; ks < 8; ++ks) lg += lgn[ks];
        { const int tn = (t + NGW < MLAT) ? t + NGW : t;
#pragma unroll
          for (int ks = 0; ks < 8; ++ks) lgn[ks] = *(const f32x4*)(LGP + ((size_t)ks * MLAT + tn) * NEXP + 4 * lane); }
        float sc[4], sel[4];
#pragma unroll
        for (int i = 0; i < 4; ++i) { sc[i] = 1.0f / (1.0f + __expf(-lg[i])); sel[i] = sc[i] + bias[i]; }
        float a1 = fmaxf(sel[0], sel[1]), a2 = fminf(sel[0], sel[1]);
        { const float b1 = fmaxf(sel[2], sel[3]), b2 = fminf(sel[2], sel[3]); const float n1 = fmaxf(a1, b1), n2 = fmaxf(fminf(a1, b1), fmaxf(a2, b2)); a1 = n1; a2 = n2; }
#pragma unroll
        for (int off = 1; off < 8; off <<= 1) { const float b1 = __shfl_xor(a1, off), b2 = __shfl_xor(a2, off); const float n1 = fmaxf(a1, b1), n2 = fmaxf(fminf(a1, b1), fmaxf(a2, b2)); a1 = n1; a2 = n2; }
        const float gs = a1 + a2; const int g = lane >> 3;
        int rank = 0;
#pragma unroll
        for (int j = 0; j < 8; ++j) { const float o = __shfl(gs, 8 * j); rank += (o > gs || (o == gs && j < g)) ? 1 : 0; }
        const bool gsel = rank < 4;
        float ms[4];
#pragma unroll
        for (int i = 0; i < 4; ++i) ms[i] = gsel ? sel[i] : -INFINITY;
        float myw = 0.f; int mye = 0; float wsum = 0.f;
#pragma unroll
        for (int k = 0; k < TOPK; ++k) {
            float bv = ms[0]; int bi = 4 * lane;
#pragma unroll
            for (int i = 1; i < 4; ++i) if (ms[i] > bv) { bv = ms[i]; bi = 4 * lane + i; }
#pragma unroll
            for (int off = 1; off < 64; off <<= 1) { const float ov = __shfl_xor(bv, off); const int oi = __shfl_xor(bi, off); if (ov > bv || (ov == bv && oi < bi)) { bv = ov; bi = oi; } }
            const int ol = bi >> 2, oi = bi & 3;
            const float mysc = (oi == 0) ? sc[0] : (oi == 1) ? sc[1] : (oi == 2) ? sc[2] : sc[3];
            const float w = __shfl(mysc, ol);
            if (lane == ol) {
#pragma unroll
                for (int i = 0; i < 4; ++i) if (i == oi) ms[i] = -INFINITY; }
            wsum += w;
            if (lane == k) { myw = w; mye = bi; }
        }
        if (have && lane < TOPK) LIST[pmye * MLAT + ppos] = pent;
        if (lane < TOPK) {
            const float wn = myw / wsum * 2.5f;
            EIDX[t * TOPK + lane] = mye; EW[t * TOPK + lane] = wn;
            ppos = atomicAdd(&CNT[mye], 1u); pmye = mye; pent = (u32x2){(unsigned)(t * TOPK + lane), __float_as_uint(wn)};
        }
        have = true;
    }
    if (have && lane < TOPK) LIST[pmye * MLAT + ppos] = pent;
}
constexpr int EX_NSTG = 3, EX_ASTG = 24576, EX_WSTG = 16384, EX_A0 = 0, EX_W0 = EX_NSTG * EX_ASTG, EX_WH0 = EX_W0 + EX_NSTG * EX_WSTG, EX_WHS = 10240, EX_ROW0 = EX_WH0 + 2 * EX_WHS;
constexpr int EX_TAB0 = EX_ROW0 + 3200, EX_SCR0 = EX_TAB0 + 3072;
static_assert(EX_ROW0 == 143360 && EX_SCR0 + 8192 <= LDSCTL_OFF, "expert LDS map");
template <bool GU>
__device__ __forceinline__ void ring_w_prologue(Frame& F, const float* W, int cgrp) {
    constexpr int LDB = GU ? 512 : 2048;
    const int lane = F.lane, w = F.wave, v = 4 * (lane & 31);
    const int wcol0 = GU ? (((v >> 5) & 1) * 256 + 32 * (v >> 6) + (v & 31) + 64 * cgrp) : (v + 512 * cgrp);
    const float* wlane = W + (size_t)(4 * w + (lane >> 5)) * LDB + wcol0;
#pragma unroll
    for (int s = 0; s < 3; ++s)
#pragma unroll
        for (int j = 0; j < 2; ++j) __builtin_amdgcn_global_load_lds((const unsigned*)(wlane + (size_t)(s * 32 + 2 * j) * LDB), (LAS unsigned*)(F.lds + EX_W0 + s * EX_WSTG + (2 * w + j) * 1024), 16, 0, 2);
}
template <bool GU, int NLAY>
__device__ __forceinline__ void expert_ring(Frame& F, const float* W, const h16* Abase, const int (&arow)[3], int nr, int cgrp, h16* ACTrow0, h16* Y) {
    constexpr int KT = GU ? 64 : 8, NP = GU ? 1 : 4, LDB = GU ? 512 : 2048, NS = KT * NP;
    const int tid = F.tid, lane = F.lane, hi = lane >> 5, ln = lane & 31, cp = F.wave & 1, rg = F.wave >> 1, w = F.wave;
    const LAS int* RSLOT = (const LAS int*)(F.lds + EX_ROW0); const LAS float* RW = (const LAS float*)(F.lds + EX_ROW0 + 1536);
    const int ngrp = (nr + 15) >> 4;
    const int nA = (w < ngrp ? 1 : 0) + (w + 8 < ngrp ? 1 : 0) + (w + 16 < ngrp ? 1 : 0);
    const int achunk = ((lane & 3) ^ ((lane >> 4) & 3)) * 8;
    const int v = 4 * (lane & 31);
    const int wcol0 = GU ? (((v >> 5) & 1) * 256 + 32 * (v >> 6) + (v & 31) + 64 * cgrp) : (v + 512 * cgrp);
    const float* wlane = W + (size_t)(4 * w + (lane >> 5)) * LDB + wcol0;
    const unsigned lds0 = (unsigned)(uintptr_t)F.lds;
    const int xs = (ln >> 2) & 3;
    const unsigned aofs0 = (unsigned)((2 * rg + (ln >> 4)) * 1024 + (ln & 15) * 64 + ((hi ^ xs) * 16)), aofs1 = (unsigned)((2 * rg + (ln >> 4)) * 1024 + (ln & 15) * 64 + (((2 + hi) ^ xs) * 16));
    const unsigned tofs = (unsigned)((8 * hi + ((lane & 15) >> 2)) * 320 + (64 * cp + 16 * ((lane >> 4) & 1) + 4 * (lane & 3)) * 2);
    f32x16 acc[2 * NLAY];
#pragma unroll
    for (int i = 0; i < 2 * NLAY; ++i) acc[i] = (f32x16){};
#define EX_DMA_A(s) do { const int kt_ = (s) % KT, stg_ = (s) % EX_NSTG; \
        _Pragma("unroll") for (int j = 0; j < 3; ++j) if (j < nA) __builtin_amdgcn_global_load_lds((const unsigned*)(Abase + arow[j] + kt_ * 32 + achunk), (LAS unsigned*)(F.lds + EX_A0 + stg_ * EX_ASTG + (w + 8 * j) * 1024), 16, 0, 0); } while (0)
#define EX_DMA_W(s) do { const int pass_ = (s) / KT, kt_ = (s) % KT, stg_ = (s) % EX_NSTG; \
        _Pragma("unroll") for (int j = 0; j < 2; ++j) __builtin_amdgcn_global_load_lds((const unsigned*)(wlane + (size_t)(kt_ * 32 + 2 * j) * LDB + 128 * pass_), (LAS unsigned*)(F.lds + EX_W0 + stg_ * EX_WSTG + (2 * w + j) * 1024), 16, 0, 2); } while (0)
#define EX_WAITV(k) asm volatile("s_waitcnt vmcnt(" #k ")" ::: "memory")
#define EX_WAITN() do { if (nA == 3) EX_WAITV(5); else if (nA == 2) EX_WAITV(4); else if (nA == 1) EX_WAITV(3); else EX_WAITV(2); } while (0)
    const unsigned cvsrc = lds0 + EX_W0 + (tid >> 4) * 512 + (tid & 15) * 32, cvdst = lds0 + EX_WH0 + (tid >> 4) * 320 + (tid & 15) * 16;
    EX_DMA_A(0); EX_DMA_A(1);
    if (nA == 3) EX_WAITV(3); else if (nA == 2) EX_WAITV(2); else if (nA == 1) EX_WAITV(1); else EX_WAITV(0);
    __builtin_amdgcn_s_barrier(); asm volatile("" ::: "memory");
    { f32x4 c0, c1; asm volatile("ds_read_b128 %0, %2\n\tds_read_b128 %1, %2 offset:16\n\ts_waitcnt lgkmcnt(0)" : "=&v"(c0), "=&v"(c1) : "v"(cvsrc) : "memory");
      const h16x8 hv = pack8(c0[0], c0[1], c0[2], c0[3], c1[0], c1[1], c1[2], c1[3]); asm volatile("ds_write_b128 %0, %1" :: "v"(cvdst), "v"(hv) : "memory"); }
    typedef short s16x8 __attribute__((ext_vector_type(8)));
    for (int s = 0; s < NS; ++s) {
        if (s + 2 < NS) EX_WAITN(); else EX_WAITV(0);
        asm volatile("s_waitcnt lgkmcnt(0)" ::: "memory");
        __builtin_amdgcn_s_barrier();
        asm volatile("" ::: "memory");
        const bool pend = ((s % KT) == KT - 1);
        if (!pend) { if (s + 2 < NS) EX_DMA_A(s + 2); if (s + 3 < NS) EX_DMA_W(s + 3); }
        const unsigned abase = lds0 + EX_A0 + (s % EX_NSTG) * EX_ASTG, wbase = lds0 + EX_WH0 + (s & 1) * EX_WHS + tofs;
        const unsigned cs = cvsrc + ((s + 1) % EX_NSTG) * EX_WSTG;
        const unsigned pa0 = abase + aofs0, pa1 = abase + aofs1;
        if constexpr (NLAY < 3) {
            v4i16_t t0, t1, t2, t3, t4, t5, t6, t7; h16x8 a0[NLAY], a1[NLAY];
            asm volatile("ds_read_b64_tr_b16 %0, %8\n\tds_read_b64_tr_b16 %1, %8 offset:1280\n\tds_read_b64_tr_b16 %2, %8 offset:64\n\tds_read_b64_tr_b16 %3, %8 offset:1344\n\t"
                         "ds_read_b64_tr_b16 %4, %8 offset:5120\n\tds_read_b64_tr_b16 %5, %8 offset:6400\n\tds_read_b64_tr_b16 %6, %8 offset:5184\n\tds_read_b64_tr_b16 %7, %8 offset:6464"
                         : "=&v"(t0), "=&v"(t1), "=&v"(t2), "=&v"(t3), "=&v"(t4), "=&v"(t5), "=&v"(t6), "=&v"(t7) : "v"(wbase) : "memory");
            asm volatile("ds_read_b128 %0, %2\n\tds_read_b128 %1, %3" : "=&v"(a0[0]), "=&v"(a1[0]) : "v"(pa0), "v"(pa1) : "memory");
            if constexpr (NLAY >= 2) asm volatile("ds_read_b128 %0, %2 offset:8192\n\tds_read_b128 %1, %3 offset:8192" : "=&v"(a0[1]), "=&v"(a1[1]) : "v"(pa0), "v"(pa1) : "memory");
            asm volatile("s_waitcnt lgkmcnt(0)" ::: "memory");
            __builtin_amdgcn_sched_barrier(0);
            const h16x8 b00 = __builtin_bit_cast(h16x8, (s16x8){t0[0], t0[1], t0[2], t0[3], t1[0], t1[1], t1[2], t1[3]}), b01 = __builtin_bit_cast(h16x8, (s16x8){t2[0], t2[1], t2[2], t2[3], t3[0], t3[1], t3[2], t3[3]});
            const h16x8 b10 = __builtin_bit_cast(h16x8, (s16x8){t4[0], t4[1], t4[2], t4[3], t5[0], t5[1], t5[2], t5[3]}), b11 = __builtin_bit_cast(h16x8, (s16x8){t6[0], t6[1], t6[2], t6[3], t7[0], t7[1], t7[2], t7[3]});
#pragma unroll
            for (int i = 0; i < NLAY; ++i) { acc[2 * i] = MFMA32(a0[i], b00, acc[2 * i]); acc[2 * i + 1] = MFMA32(a0[i], b01, acc[2 * i + 1]); }
#pragma unroll
            for (int i = 0; i < NLAY; ++i) { acc[2 * i] = MFMA32(a1[i], b10, acc[2 * i]); acc[2 * i + 1] = MFMA32(a1[i], b11, acc[2 * i + 1]); }
        } else {
#pragma unroll
            for (int k16 = 0; k16 < 2; ++k16) {
                v4i16_t t0, t1, t2, t3; h16x8 a[3]; const unsigned pa = k16 ? pa1 : pa0, pw = wbase + k16 * 5120;
                asm volatile("ds_read_b64_tr_b16 %0, %4\n\tds_read_b64_tr_b16 %1, %4 offset:1280\n\tds_read_b64_tr_b16 %2, %4 offset:64\n\tds_read_b64_tr_b16 %3, %4 offset:1344"
                             : "=&v"(t0), "=&v"(t1), "=&v"(t2), "=&v"(t3) : "v"(pw) : "memory");
                asm volatile("ds_read_b128 %0, %3\n\tds_read_b128 %1, %3 offset:8192\n\tds_read_b128 %2, %3 offset:16384\n\ts_waitcnt lgkmcnt(0)" : "=&v"(a[0]), "=&v"(a[1]), "=&v"(a[2]) : "v"(pa) : "memory");
                __builtin_amdgcn_sched_barrier(0);
                const h16x8 b0 = __builtin_bit_cast(h16x8, (s16x8){t0[0], t0[1], t0[2], t0[3], t1[0], t1[1], t1[2], t1[3]}), b1 = __builtin_bit_cast(h16x8, (s16x8){t2[0], t2[1], t2[2], t2[3], t3[0], t3[1], t3[2], t3[3]});
#pragma unroll
                for (int i = 0; i < 3; ++i) { acc[2 * i] = MFMA32(a[i], b0, acc[2 * i]); acc[2 * i + 1] = MFMA32(a[i], b1, acc[2 * i + 1]); }
                __builtin_amdgcn_sched_barrier(0);
            }
        }
        if (s + 1 < NS) {
            f32x4 c0, c1; asm volatile("ds_read_b128 %0, %2\n\tds_read_b128 %1, %2 offset:16\n\ts_waitcnt lgkmcnt(0)" : "=&v"(c0), "=&v"(c1) : "v"(cs) : "memory");
            const h16x8 hv = pack8(c0[0], c0[1], c0[2], c0[3], c1[0], c1[1], c1[2], c1[3]); const unsigned cd = cvdst + ((s + 1) & 1) * EX_WHS; asm volatile("ds_write_b128 %0, %1" :: "v"(cd), "v"(hv) : "memory"); }
        if (pend) {
            const int pass = s / KT;
            int hio = hi, lno = ln; asm volatile("" : "+v"(hio), "+v"(lno));
            if (GU) {
#pragma unroll
                for (int i = 0; i < NLAY; ++i) { const int rt = rg + 4 * i;
#pragma unroll
                    for (int r = 0; r < 16; ++r) { const int row = 32 * rt + crow(r, hio);
                        if (row < nr) ACTrow0[(size_t)row * DEXP + 64 * cgrp + 32 * cp + lno] = (h16)(silu_f(acc[2 * i][r]) * acc[2 * i + 1][r]); }
                    acc[2 * i] = (f32x16){}; acc[2 * i + 1] = (f32x16){}; }
            } else {
                const unsigned scr = lds0 + EX_SCR0 + w * 1024;
                unsigned char* Y8 = (unsigned char*)Y;
#pragma unroll
                for (int i = 0; i < NLAY; ++i) { const int rt = rg + 4 * i;
#pragma unroll
                    for (int g8 = 0; g8 < 4; ++g8) {
#pragma unroll
                        for (int q = 0; q < 4; ++q) { const int lr = 4 * hio + q; const float wt = RW[32 * rt + 8 * g8 + lr];
                            const int pk = __builtin_amdgcn_cvt_pk_fp8_f32(acc[2 * i][4 * g8 + q] * wt, acc[2 * i + 1][4 * g8 + q] * wt, 0, false); const int pk1 = pk >> 8; const unsigned wa = scr + lr * 64 + lno;
                            asm volatile("ds_write_b8 %0, %1\n\tds_write_b8 %0, %2 offset:32" :: "v"(wa), "v"(pk), "v"(pk1) : "memory"); }
                        u32x2 pv; const unsigned ra = scr + (lane >> 3) * 64 + (lane & 7) * 8;
                        asm volatile("s_waitcnt lgkmcnt(0)\n\tds_read_b64 %0, %1\n\ts_waitcnt lgkmcnt(0)" : "=&v"(pv) : "v"(ra) : "memory");
                        const int grow = 32 * rt + 8 * g8 + (lane >> 3);
                        if (grow < nr) { const int slot = RSLOT[grow]; *(u32x2*)(Y8 + (size_t)slot * DM + 512 * cgrp + 128 * pass + 64 * cp + (lane & 7) * 8) = pv; }
                    }
                    acc[2 * i] = (f32x16){}; acc[2 * i + 1] = (f32x16){}; }
            }
            if (s + 2 < NS) EX_DMA_A(s + 2);
            if (s + 3 < NS) EX_DMA_W(s + 3);
        }
    }
    asm volatile("s_waitcnt vmcnt(0) lgkmcnt(0)" ::: "memory");
    __builtin_amdgcn_s_barrier();
    asm volatile("" ::: "memory");
#undef EX_DMA_A
#undef EX_DMA_W
#undef EX_WAITV
#undef EX_WAITN
}

constexpr int G8_NSTG = 4, G8_ASTG = 12288, G8_WSTG = 16384, G8_A0 = 0, G8_W0 = G8_NSTG * G8_ASTG, G8_WH0 = G8_W0 + G8_NSTG * G8_WSTG, G8_WHS = 4096;
constexpr int G8_SCR0 = G8_WH0 + 2 * G8_WHS;
static_assert(G8_SCR0 + 8 * 2048 <= EX_ROW0, "gu8 LDS map");
template <bool GU>
__device__ __forceinline__ void ring8_w_prologue(Frame& F, const float* W, int cgrp) {
    constexpr int LDB = GU ? 512 : 2048;
    const int lane = F.lane, w = F.wave, v = 4 * (lane & 31);
    if (w >= 4) return;
    const int wcol0 = GU ? (((v >> 5) & 1) * 256 + 32 * (v >> 6) + (v & 31) + 64 * cgrp) : (v + 512 * cgrp);
    const char* Wu = uni_ptr((const char*)W);
    const unsigned wvo = (unsigned)(((8 * w + (lane >> 5)) * LDB + wcol0) * 4);
#pragma unroll
    for (int s = 0; s < 4; ++s)
#pragma unroll
        for (int j = 0; j < 4; ++j) __builtin_amdgcn_global_load_lds((const unsigned*)(Wu + (size_t)(s * 32 + 2 * j) * LDB * 4 + (size_t)wvo), (LAS unsigned*)(F.lds + G8_W0 + s * G8_WSTG + (4 * w + j) * 1024), 16, 0, 2);
}
template <bool GU, int NLAY>
__device__ __forceinline__ void expert_ring8(Frame& F, const float* W, const unsigned char* A8, const int ap0, const int ap1, int nr, int cgrp, unsigned char* ACT8row0, unsigned char* Y8) {
    constexpr int KT = GU ? 64 : 8, NP = GU ? 1 : 4, LDB = GU ? 512 : 2048, NS = KT * NP;
    typedef long v2i64 __attribute__((ext_vector_type(2)));
    const int tid = F.tid, lane = F.lane, hi = lane >> 5, ln = lane & 31, cp = F.wave & 1, rg = F.wave >> 1, w = F.wave;
    const LAS int* RSLOT = (const LAS int*)(F.lds + EX_ROW0); const LAS float* RW = (const LAS float*)(F.lds + EX_ROW0 + 1536);
    const int ngrp = (nr + 31) >> 5;
    const bool ldr = w < 4;
    const int nA = ldr ? NLAY : 0;
    const unsigned avo0 = (unsigned)((ap0 & 0xffff) * (GU ? DM : DEXP) + (lane & 1) * 16), avo1 = (unsigned)((int)((unsigned)ap0 >> 16) * (GU ? DM : DEXP) + (lane & 1) * 16), avo2 = (unsigned)(ap1 * (GU ? DM : DEXP) + (lane & 1) * 16);
    const int v = 4 * (lane & 31);
    const int wcol0 = GU ? (((v >> 5) & 1) * 256 + 32 * (v >> 6) + (v & 31) + 64 * cgrp) : (v + 512 * cgrp);
    const char* Wu = uni_ptr((const char*)W); const char* Au = uni_ptr((const char*)A8);
    const unsigned wvo = (unsigned)(((8 * w + (lane >> 5)) * LDB + wcol0) * 4);
    const unsigned lds0 = (unsigned)(uintptr_t)F.lds;
    const unsigned aofs = (unsigned)(rg * 1024 + ln * 32 + hi * 16);
    const unsigned bofs = (unsigned)((64 * cp + ln) * 32 + hi * 16);
    const unsigned cvsrc = lds0 + G8_W0 + (tid >> 7) * 8 * 512 + (tid & 127) * 4, cvdst = lds0 + G8_WH0 + (tid & 127) * 32 + (tid >> 7) * 8;
    f32x16 acc[2 * NLAY];
#pragma unroll
    for (int i = 0; i < 2 * NLAY; ++i) acc[i] = (f32x16){};
#define G8_DMA_A(s) do { const int stg_ = (s) & 3, kt_ = (s) % KT; \
        if (ldr) { _Pragma("unroll") for (int j = 0; j < NLAY; ++j) { const unsigned vo_ = j == 0 ? avo0 : j == 1 ? avo1 : avo2; \
            __builtin_amdgcn_global_load_lds((const unsigned*)(Au + kt_ * 32 + (size_t)vo_), (LAS unsigned*)(F.lds + G8_A0 + stg_ * G8_ASTG + (w + 4 * j) * 1024), 16, 0, 0); } } } while (0)
#define G8_DMA_W(s) do { const int stg_ = (s) & 3, kt_ = (s) % KT, pass_ = (s) / KT; \
        if (ldr) { _Pragma("unroll") for (int j = 0; j < 4; ++j) __builtin_amdgcn_global_load_lds((const unsigned*)(Wu + ((size_t)(kt_ * 32 + 2 * j) * LDB + 128 * pass_) * 4 + (size_t)wvo), (LAS unsigned*)(F.lds + G8_W0 + stg_ * G8_WSTG + (4 * w + j) * 1024), 16, 0, 2); } } while (0)
#define G8_WAITV(k) asm volatile("s_waitcnt vmcnt(" #k ")" ::: "memory")
#define G8_CVT(s) do { float c_[8]; const unsigned cs_ = cvsrc + ((s) & 3) * G8_WSTG; \
        asm volatile("ds_read_b32 %0, %8\n\tds_read_b32 %1, %8 offset:512\n\tds_read_b32 %2, %8 offset:1024\n\tds_read_b32 %3, %8 offset:1536\n\tds_read_b32 %4, %8 offset:2048\n\tds_read_b32 %5, %8 offset:2560\n\tds_read_b32 %6, %8 offset:3072\n\tds_read_b32 %7, %8 offset:3584\n\ts_waitcnt lgkmcnt(0)" \
                     : "=&v"(c_[0]), "=&v"(c_[1]), "=&v"(c_[2]), "=&v"(c_[3]), "=&v"(c_[4]), "=&v"(c_[5]), "=&v"(c_[6]), "=&v"(c_[7]) : "v"(cs_) : "memory"); \
        int p0_ = __builtin_amdgcn_cvt_pk_fp8_f32(c_[0] * 64.f, c_[1] * 64.f, 0, false); p0_ = __builtin_amdgcn_cvt_pk_fp8_f32(c_[2] * 64.f, c_[3] * 64.f, p0_, true); \
        int p1_ = __builtin_amdgcn_cvt_pk_fp8_f32(c_[4] * 64.f, c_[5] * 64.f, 0, false); p1_ = __builtin_amdgcn_cvt_pk_fp8_f32(c_[6] * 64.f, c_[7] * 64.f, p1_, true); \
        const u32x2 pk_ = {(unsigned)p0_, (unsigned)p1_}; const unsigned cd_ = cvdst + ((s) & 1) * G8_WHS; asm volatile("ds_write_b64 %0, %1" :: "v"(cd_), "v"(pk_) : "memory"); } while (0)
    struct Frag { v2i64 a[NLAY], b0, b1; };
    Frag f0, f1; float c_[8];
    const bool top = 128 * (NLAY - 1) + 32 * rg < nr;
#define G8_RD_FRAG(fr, s) do { const unsigned pa_ = lds0 + G8_A0 + ((s) & 3) * G8_ASTG + aofs, pb_ = lds0 + G8_WH0 + ((s) & 1) * G8_WHS + bofs; \
        asm volatile("ds_read_b128 %0, %2\n\tds_read_b128 %1, %2 offset:1024" : "=&v"(fr.b0), "=&v"(fr.b1) : "v"(pb_) : "memory"); \
        asm volatile("ds_read_b128 %0, %1" : "=&v"(fr.a[0]) : "v"(pa_) : "memory"); \
        if constexpr (NLAY >= 2) asm volatile("ds_read_b128 %0, %1 offset:4096" : "=&v"(fr.a[1]) : "v"(pa_) : "memory"); \
        if constexpr (NLAY >= 3) asm volatile("ds_read_b128 %0, %1 offset:8192" : "=&v"(fr.a[2]) : "v"(pa_) : "memory"); } while (0)
#define G8_RD_CV(s) do { const unsigned cs_ = cvsrc + ((s) & 3) * G8_WSTG; \
        asm volatile("ds_read_b32 %0, %8\n\tds_read_b32 %1, %8 offset:512\n\tds_read_b32 %2, %8 offset:1024\n\tds_read_b32 %3, %8 offset:1536\n\tds_read_b32 %4, %8 offset:2048\n\tds_read_b32 %5, %8 offset:2560\n\tds_read_b32 %6, %8 offset:3072\n\tds_read_b32 %7, %8 offset:3584" \
                     : "=&v"(c_[0]), "=&v"(c_[1]), "=&v"(c_[2]), "=&v"(c_[3]), "=&v"(c_[4]), "=&v"(c_[5]), "=&v"(c_[6]), "=&v"(c_[7]) : "v"(cs_) : "memory"); } while (0)
#define G8_LWAIT(fr) do { asm volatile("s_waitcnt lgkmcnt(0)" : "+v"(fr.b0), "+v"(fr.b1), "+v"(fr.a[0]), "+v"(c_[0]), "+v"(c_[1]), "+v"(c_[2]), "+v"(c_[3]), "+v"(c_[4]), "+v"(c_[5]), "+v"(c_[6]), "+v"(c_[7]) :: "memory"); \
        if constexpr (NLAY >= 2) asm volatile("" : "+v"(fr.a[1])); if constexpr (NLAY >= 3) asm volatile("" : "+v"(fr.a[2])); } while (0)
#define G8_CV_WR(s) do { typedef float f2_ __attribute__((ext_vector_type(2))); \
        const f2_ m0_ = (f2_){c_[0], c_[1]} * 64.f, m1_ = (f2_){c_[2], c_[3]} * 64.f, m2_ = (f2_){c_[4], c_[5]} * 64.f, m3_ = (f2_){c_[6], c_[7]} * 64.f; \
        int p0_ = __builtin_amdgcn_cvt_pk_fp8_f32(m0_[0], m0_[1], 0, false); p0_ = __builtin_amdgcn_cvt_pk_fp8_f32(m1_[0], m1_[1], p0_, true); \
        int p1_ = __builtin_amdgcn_cvt_pk_fp8_f32(m2_[0], m2_[1], 0, false); p1_ = __builtin_amdgcn_cvt_pk_fp8_f32(m3_[0], m3_[1], p1_, true); \
        const u32x2 pk_ = {(unsigned)p0_, (unsigned)p1_}; const unsigned cd_ = cvdst + ((s) & 1) * G8_WHS; asm volatile("ds_write_b64 %0, %1" :: "v"(cd_), "v"(pk_) : "memory"); } while (0)
#define G8_SB() __builtin_amdgcn_sched_barrier(0)
#define G8_MF(fr, i, h, c) acc[2 * (i) + (c)] = __builtin_amdgcn_mfma_f32_32x32x16_fp8_fp8(fr.a[i][h], (c) ? fr.b1[h] : fr.b0[h], acc[2 * (i) + (c)], 0, 0, 0)
#define G8_RC01() asm volatile("ds_read_b32 %0, %2\n\tds_read_b32 %1, %2 offset:512" : "=&v"(c_[0]), "=&v"(c_[1]) : "v"(cs_) : "memory")
#define G8_RC23() asm volatile("ds_read_b32 %0, %2 offset:1024\n\tds_read_b32 %1, %2 offset:1536" : "=&v"(c_[2]), "=&v"(c_[3]) : "v"(cs_) : "memory")
#define G8_RC45() asm volatile("ds_read_b32 %0, %2 offset:2048\n\tds_read_b32 %1, %2 offset:2560" : "=&v"(c_[4]), "=&v"(c_[5]) : "v"(cs_) : "memory")
#define G8_RC67() asm volatile("ds_read_b32 %0, %2 offset:3072\n\tds_read_b32 %1, %2 offset:3584" : "=&v"(c_[6]), "=&v"(c_[7]) : "v"(cs_) : "memory")
#define G8_RB(fr) asm volatile("ds_read_b128 %0, %2\n\tds_read_b128 %1, %2 offset:1024" : "=&v"(fr.b0), "=&v"(fr.b1) : "v"(pb_) : "memory")
#define G8_RA(fr, i, ofs) asm volatile("ds_read_b128 %0, %1 offset:" ofs : "=&v"(fr.a[i]) : "v"(pa_) : "memory")
#define G8_CWAIT(n) asm volatile("s_waitcnt lgkmcnt(" n ")" : "+v"(c_[0]), "+v"(c_[1]), "+v"(c_[2]), "+v"(c_[3]), "+v"(c_[4]), "+v"(c_[5]), "+v"(c_[6]), "+v"(c_[7]) :: "memory")
#define G8_CMUL() do { m0_ = (f2_){c_[0], c_[1]} * 64.f; m1_ = (f2_){c_[2], c_[3]} * 64.f; m2_ = (f2_){c_[4], c_[5]} * 64.f; m3_ = (f2_){c_[6], c_[7]} * 64.f; } while (0)
#define G8_CCVT0() do { p0_ = __builtin_amdgcn_cvt_pk_fp8_f32(m0_[0], m0_[1], 0, false); p0_ = __builtin_amdgcn_cvt_pk_fp8_f32(m1_[0], m1_[1], p0_, true); } while (0)
#define G8_CCVT1() do { p1_ = __builtin_amdgcn_cvt_pk_fp8_f32(m2_[0], m2_[1], 0, false); p1_ = __builtin_amdgcn_cvt_pk_fp8_f32(m3_[0], m3_[1], p1_, true); } while (0)
#define G8_CWR() do { const u32x2 pk_ = {(unsigned)p0_, (unsigned)p1_}; asm volatile("ds_write_b64 %0, %1" :: "v"(cd_), "v"(pk_) : "memory"); } while (0)
#define G8_FWAIT(fr) do { asm volatile("s_waitcnt lgkmcnt(0)" : "+v"(fr.b0), "+v"(fr.b1), "+v"(fr.a[0]) :: "memory"); \
        if constexpr (NLAY >= 2) asm volatile("" : "+v"(fr.a[1])); if constexpr (NLAY >= 3) asm volatile("" : "+v"(fr.a[2])); } while (0)
#define G8_BAR() do { asm volatile("s_waitcnt lgkmcnt(0)" ::: "memory"); __builtin_amdgcn_s_barrier(); asm volatile("" ::: "memory"); } while (0)
    auto epilogue = [&](const int s) {
            const int pass = s / KT;
            int hio = hi, lno = ln; asm volatile("" : "+v"(hio), "+v"(lno));
            const unsigned scr = lds0 + G8_SCR0 + w * 2048;
#pragma unroll
            for (int i = 0; i < NLAY; ++i) { const int rt = rg + 4 * i;
                if (i == NLAY - 1 && !top) continue;
#pragma unroll
                for (int r = 0; r < 16; ++r) { const int lr = crow(r, hio);
                    float v0, v1;
                    if (GU) { v0 = silu_f(acc[2 * i][r] * 0.015625f) * (acc[2 * i + 1][r] * 0.015625f); v1 = 0.f; }
                    else { const float wt = RW[32 * rt + lr] * 0.015625f; v0 = acc[2 * i][r] * wt; v1 = acc[2 * i + 1][r] * wt; }
                    const int pk = __builtin_amdgcn_cvt_pk_fp8_f32(v0, v1, 0, false); const unsigned wa = scr + lr * 64 + lno;
                    if (GU) asm volatile("ds_write_b8 %0, %1" :: "v"(wa), "v"(pk) : "memory");
                    else { const int pk1 = pk >> 8; asm volatile("ds_write_b8 %0, %1\n\tds_write_b8 %0, %2 offset:32" :: "v"(wa), "v"(pk), "v"(pk1) : "memory"); } }
                if (GU) {
                    unsigned pv[4]; const unsigned ra = scr + (lane >> 3) * 64 + (lane & 7) * 4;
                    asm volatile("s_waitcnt lgkmcnt(0)\n\tds_read_b32 %0, %4\n\tds_read_b32 %1, %4 offset:512\n\tds_read_b32 %2, %4 offset:1024\n\tds_read_b32 %3, %4 offset:1536\n\ts_waitcnt lgkmcnt(0)" : "=&v"(pv[0]), "=&v"(pv[1]), "=&v"(pv[2]), "=&v"(pv[3]) : "v"(ra) : "memory");
#pragma unroll
                    for (int g8 = 0; g8 < 4; ++g8) { const int grow = 32 * rt + 8 * g8 + (lane >> 3);
                        if (grow < nr) *(unsigned*)(ACT8row0 + (size_t)grow * DEXP + 64 * cgrp + 32 * cp + (lane & 7) * 4) = pv[g8]; }
                } else {
                    u32x2 pv[4]; const unsigned ra = scr + (lane >> 3) * 64 + (lane & 7) * 8;
                    asm volatile("s_waitcnt lgkmcnt(0)\n\tds_read_b64 %0, %4\n\tds_read_b64 %1, %4 offset:512\n\tds_read_b64 %2, %4 offset:1024\n\tds_read_b64 %3, %4 offset:1536\n\ts_waitcnt lgkmcnt(0)" : "=&v"(pv[0]), "=&v"(pv[1]), "=&v"(pv[2]), "=&v"(pv[3]) : "v"(ra) : "memory");
#pragma unroll
                    for (int g8 = 0; g8 < 4; ++g8) { const int grow = 32 * rt + 8 * g8 + (lane >> 3);
                        if (grow < nr) { const int slot = RSLOT[grow]; *(u32x2*)(Y8 + (size_t)slot * DM + 512 * cgrp + 128 * pass + 64 * cp + (lane & 7) * 8) = pv[g8]; } }
                }
                acc[2 * i] = (f32x16){}; acc[2 * i + 1] = (f32x16){}; }
            if (s + 4 < NS) G8_DMA_A(s + 4);
            if (s + 5 < NS) G8_DMA_W(s + 5);
    };
    G8_DMA_A(0); G8_DMA_A(1); G8_DMA_A(2); G8_DMA_A(3);
    if constexpr (NLAY == 3) G8_WAITV(12); else if constexpr (NLAY == 2) G8_WAITV(8); else G8_WAITV(4);
    G8_BAR();
    G8_RD_CV(0);
    asm volatile("s_waitcnt lgkmcnt(0)" : "+v"(c_[0]), "+v"(c_[1]), "+v"(c_[2]), "+v"(c_[3]), "+v"(c_[4]), "+v"(c_[5]), "+v"(c_[6]), "+v"(c_[7]) :: "memory");
    G8_CV_WR(0);
    if constexpr (NLAY == 3) G8_WAITV(9); else if constexpr (NLAY == 2) G8_WAITV(6); else G8_WAITV(3);
    G8_BAR();
    G8_DMA_W(4);
    G8_RD_FRAG(f0, 0); G8_RD_CV(1);
    G8_LWAIT(f0);
    G8_CV_WR(1);
#define G8_STEP(s, cur, nxt, MAYPEND) do { \
        if ((s) > 0 && (s) + 4 < NS) { if constexpr (NLAY == 3) G8_WAITV(14); else if constexpr (NLAY == 2) G8_WAITV(12); else G8_WAITV(10); }     \
        else if ((s) == 0) { if constexpr (NLAY == 3) G8_WAITV(10); else if constexpr (NLAY == 2) G8_WAITV(8); else G8_WAITV(6); } \
        else G8_WAITV(0); \
        G8_BAR(); \
        const bool pend = MAYPEND && (((s) % KT) == KT - 1); \
        if (!pend) { if ((s) + 4 < NS) G8_DMA_A((s) + 4); if ((s) + 5 < NS) G8_DMA_W((s) + 5); } \
          \
          \
        const unsigned pa_ = lds0 + G8_A0 + (((s) + 1) & 3) * G8_ASTG + aofs, pb_ = lds0 + G8_WH0 + (((s) + 1) & 1) * G8_WHS + bofs, cs_ = cvsrc + (((s) + 2) & 3) * G8_WSTG, cd_ = cvdst + ((s) & 1) * G8_WHS; \
        typedef float f2_ __attribute__((ext_vector_type(2))); f2_ m0_, m1_, m2_, m3_; int p0_, p1_; \
        G8_SB(); \
          \
          \
        if constexpr (NLAY == 3) { \
            if (top) { G8_RA(nxt, 2, "8192"); G8_SB(); } \
            G8_MF(cur, 0, 0, 0); G8_SB(); G8_RC01(); G8_SB(); G8_MF(cur, 0, 0, 1); G8_SB(); G8_RC23(); G8_SB(); G8_MF(cur, 1, 0, 0); G8_SB(); G8_RC45(); G8_SB(); G8_MF(cur, 1, 0, 1); G8_SB(); G8_RC67(); G8_SB(); \
            G8_MF(cur, 0, 1, 0); G8_SB(); G8_RB(nxt); G8_SB(); G8_MF(cur, 0, 1, 1); G8_SB(); G8_RA(nxt, 0, "0"); G8_SB(); G8_MF(cur, 1, 1, 0); G8_SB(); G8_RA(nxt, 1, "4096"); G8_SB(); G8_MF(cur, 1, 1, 1); G8_SB(); \
            G8_CWAIT("4"); G8_SB(); G8_CMUL(); G8_SB(); \
            if (top) { G8_MF(cur, 2, 0, 0); G8_SB(); G8_CCVT0(); G8_SB(); G8_MF(cur, 2, 0, 1); G8_SB(); G8_CCVT1(); G8_SB(); G8_MF(cur, 2, 1, 0); G8_SB(); G8_CWR(); G8_SB(); G8_MF(cur, 2, 1, 1); G8_SB(); } \
            else { G8_CCVT0(); G8_CCVT1(); G8_CWR(); G8_SB(); } \
        } else if constexpr (NLAY == 2) { \
            if (top) { G8_RA(nxt, 1, "4096"); G8_SB(); } \
            G8_MF(cur, 0, 0, 0); G8_SB(); G8_RC01(); G8_RC23(); G8_SB(); G8_MF(cur, 0, 0, 1); G8_SB(); G8_RC45(); G8_RC67(); G8_SB(); G8_MF(cur, 0, 1, 0); G8_SB(); G8_RB(nxt); G8_SB(); G8_MF(cur, 0, 1, 1); G8_SB(); G8_RA(nxt, 0, "0"); G8_SB(); \
            G8_CWAIT("3"); G8_SB(); G8_CMUL(); G8_SB(); \
            if (top) { G8_MF(cur, 1, 0, 0); G8_SB(); G8_CCVT0(); G8_SB(); G8_MF(cur, 1, 0, 1); G8_SB(); G8_CCVT1(); G8_SB(); G8_MF(cur, 1, 1, 0); G8_SB(); G8_CWR(); G8_SB(); G8_MF(cur, 1, 1, 1); G8_SB(); } \
            else { G8_CCVT0(); G8_CCVT1(); G8_CWR(); G8_SB(); } \
        } else { \
            if (top) { G8_RA(nxt, 0, "0"); G8_SB(); G8_MF(cur, 0, 0, 0); G8_SB(); } \
            G8_RC01(); G8_RC23(); G8_RC45(); G8_RC67(); G8_SB(); \
            if (top) { G8_MF(cur, 0, 0, 1); G8_SB(); } \
            G8_RB(nxt); G8_SB(); G8_CWAIT("2"); G8_SB(); G8_CMUL(); G8_SB(); \
            if (top) { G8_MF(cur, 0, 1, 0); G8_SB(); } \
            G8_CCVT0(); G8_CCVT1(); G8_SB(); \
            if (top) { G8_MF(cur, 0, 1, 1); G8_SB(); } \
            G8_CWR(); G8_SB(); \
        } \
        G8_FWAIT(nxt); \
        if (pend) epilogue((s)); } while (0)
    for (int s = 0; s < NS; s += 2) { G8_STEP(s, f0, f1, false); G8_STEP(s + 1, f1, f0, true); }
#undef G8_STEP
#undef G8_RC01
#undef G8_RC23
#undef G8_RC45
#undef G8_RC67
#undef G8_RB
#undef G8_RA
#undef G8_CWAIT
#undef G8_CMUL
#undef G8_CCVT0
#undef G8_CCVT1
#undef G8_CWR
#undef G8_FWAIT
#undef G8_SB
#undef G8_MF
#undef G8_RD_FRAG
#undef G8_RD_CV
#undef G8_LWAIT
#undef G8_CV_WR
#undef G8_BAR
    asm volatile("s_waitcnt vmcnt(0) lgkmcnt(0)" ::: "memory");
    __builtin_amdgcn_s_barrier();
    asm volatile("" ::: "memory");
#undef G8_DMA_A
#undef G8_DMA_W
#undef G8_WAITV
#undef G8_CVT
}
template <bool GU>
__device__ __forceinline__ void p13_expert_phase(Frame& F, int qid) {
    const h16* H2X = (const h16*)(F.ws + WS_H2X); h16* Y = (h16*)(F.ws + WS_Y); h16* ACT = (h16*)(F.ws + WS_ACT);
    const unsigned* CNT = (const unsigned*)(F.ws + WS_CTL) + CW_CNT; unsigned* QH = (unsigned*)(F.ws + WS_CTL) + CW_Q + 64 * qid;
    LAS int* RSLOT = (LAS int*)(F.lds + EX_ROW0); LAS float* RW = (LAS float*)(F.lds + EX_ROW0 + 1536); LAS int* RED = (LAS int*)(F.lds + EX_ROW0 + 3072);
    LAS int* CN = (LAS int*)(F.lds + EX_TAB0); LAS int* ORD = CN + 256; LAS int* OFF = CN + 512;
    __syncthreads();
    if (F.tid < NEXP) CN[F.tid] = (int)CNT[F.tid];
    __syncthreads();
    if (F.tid < NEXP) { const int c = CN[F.tid]; int rank = 0, off = 0;
        for (int j = 0; j < NEXP; ++j) { const int cj = CN[j]; rank += (cj > c || (cj == c && j < F.tid)) ? 1 : 0; off += (j < F.tid) ? cj : 0; }
        ORD[rank] = F.tid; OFF[F.tid] = off; }
    __syncthreads();
    const u32x2* LIST2 = (const u32x2*)(F.ws + WS_LIST2);
    if (F.tid == 0) RED[0] = (int)__hip_atomic_fetch_add(QH, 1u, __ATOMIC_RELAXED, __HIP_MEMORY_SCOPE_AGENT);
    __syncthreads();
    int u = RED[0];
    while (u < NEXP * 4) {
        const int e = ORD[u >> 2], cg = u & 3, cnt = CN[e], off_e = OFF[e];
        const float* Wgu = F.w_exp_gu + (size_t)e * DM * 512; const float* Wdn = F.w_exp_down + (size_t)e * DEXP * DM;
        for (int rs = 0; rs < cnt; rs += 384) {
            const int nr = (cnt - rs) < 384 ? (cnt - rs) : 384;
            __syncthreads();
            ring8_w_prologue<GU>(F, GU ? Wgu : Wdn, cg);
            if (F.tid < 384) { u32x2 ent = {0u, 0u}; if (F.tid < nr) ent = LIST2[e * MLAT + rs + F.tid]; RSLOT[F.tid] = (int)ent.x; RW[F.tid] = __uint_as_float(ent.y); }
            __syncthreads();
            unsigned char* ACT8row0 = (unsigned char*)(F.ws + WS_ACT8) + (size_t)(off_e + rs) * DEXP;
            int ar8[3];
            if (GU) {
#pragma unroll
                for (int j = 0; j < 3; ++j) { const int r = 32 * ((F.wave & 3) + 4 * j) + (F.lane >> 1); ar8[j] = (r < 384 ? (RSLOT[r] >> 3) : 0); }
                const unsigned char* A8 = (const unsigned char*)(F.ws + WS_H2F8);
                if (nr > 256) expert_ring8<true, 3>(F, Wgu, A8, ar8[0] | (ar8[1] << 16), ar8[2], nr, cg, ACT8row0, (unsigned char*)Y); else if (nr > 128) expert_ring8<true, 2>(F, Wgu, A8, ar8[0] | (ar8[1] << 16), ar8[2], nr, cg, ACT8row0, (unsigned char*)Y); else expert_ring8<true, 1>(F, Wgu, A8, ar8[0] | (ar8[1] << 16), ar8[2], nr, cg, ACT8row0, (unsigned char*)Y);
            } else {
#pragma unroll
                for (int j = 0; j < 3; ++j) { const int r = 32 * ((F.wave & 3) + 4 * j) + (F.lane >> 1); ar8[j] = ((r < nr) ? r : 0); }
                if (nr > 256) expert_ring8<false, 3>(F, Wdn, ACT8row0, ar8[0] | (ar8[1] << 16), ar8[2], nr, cg, ACT8row0, (unsigned char*)Y); else if (nr > 128) expert_ring8<false, 2>(F, Wdn, ACT8row0, ar8[0] | (ar8[1] << 16), ar8[2], nr, cg, ACT8row0, (unsigned char*)Y); else expert_ring8<false, 1>(F, Wdn, ACT8row0, ar8[0] | (ar8[1] << 16), ar8[2], nr, cg, ACT8row0, (unsigned char*)Y);
            }
        }
        __syncthreads();
        if (F.tid == 0) RED[0] = (int)__hip_atomic_fetch_add(QH, 1u, __ATOMIC_RELAXED, __HIP_MEMORY_SCOPE_AGENT);
        __syncthreads();
        u = RED[0];
    }
}
struct SchedSG {
    int G, c;
    __device__ __forceinline__ bool next(int i, pg8::Unit& u) const { const int L = i * G + c; if (L >= 256) return false; u.pm = L >> 3; u.pn = (L >> 2) & 1; u.ko = (L & 3) * 512; u.nt = 0; u.keep = 0; return true; }
};
struct EpiSGP {
    float* SGP;
    __device__ __forceinline__ void operator()(f32x4 (&acc)[2][2][4][2], const pg8::Unit& u, int wr, int wc, int fr, int fq) const {
        float* dst = SGP + (size_t)(u.ko / 512) * MLAT * 512;
#pragma unroll
        for (int ai = 0; ai < 2; ++ai)
#pragma unroll
            for (int m = 0; m < 4; ++m) { const int row = u.pm * 256 + ai * 128 + wr * 64 + m * 16 + fr;
#pragma unroll
                for (int bj = 0; bj < 2; ++bj)
#pragma unroll
                    for (int n = 0; n < 2; ++n) { const int col = u.pn * 256 + bj * 128 + wc * 32 + 16 * n + 4 * fq; *(f32x4*)(dst + (size_t)row * 512 + col) = acc[ai][bj][m][n]; } }
    }
};
__device__ __forceinline__ void p11b_shared_gu(Frame& F) {
    pg8::Gemm g{(const h16*)(F.ws + WS_H2X), (const h16*)(F.ws + WS_WSGU), 6144, 2048, 512};
    SchedSG S; S.G = F.G; S.c = (int)blockIdx.x;
    EpiSGP E{(float*)(F.ws + WS_SGP)};
    pg8::gemm_phase<EpiSGP, SchedSG>(F.lds, g, S, E);
}
__device__ __forceinline__ void p12b_shared_act(Frame& F) {
    const float* SGP = (const float*)(F.ws + WS_SGP); h16* ACTS = (h16*)(F.ws + WS_ACTS);
    const int stride = F.G * NTHR;
    for (int q0 = blockIdx.x * NTHR + F.tid; q0 < MLAT * 64; q0 += 4 * stride) {
        f32x4 gp[4][4], up[4][4];
#pragma unroll
        for (int it = 0; it < 4; ++it) { const int q = (q0 + it * stride < MLAT * 64) ? q0 + it * stride : q0; const int row = q >> 6, j = (q & 63) * 4, pg = 32 * (j >> 4) + (j & 15);
#pragma unroll
            for (int ks = 0; ks < 4; ++ks) { const float* p = SGP + ((size_t)ks * MLAT + row) * 512 + pg; gp[it][ks] = *(const f32x4*)p; up[it][ks] = *(const f32x4*)(p + 16); } }
#pragma unroll
        for (int it = 0; it < 4; ++it) { const int q = q0 + it * stride; if (q < MLAT * 64) { const int row = q >> 6, j = (q & 63) * 4;
            f32x4 gv = gp[it][0], uv = up[it][0];
#pragma unroll
            for (int ks = 1; ks < 4; ++ks) { gv += gp[it][ks]; uv += up[it][ks]; }
            u32x2 w; w.x = pk2h(silu_f(gv[0]) * uv[0], silu_f(gv[1]) * uv[1]); w.y = pk2h(silu_f(gv[2]) * uv[2], silu_f(gv[3]) * uv[3]);
            *(u32x2*)(ACTS + (size_t)row * DEXP + j) = w; } }
    }
}
struct EpiYsh {
    h16* YSH;
    __device__ __forceinline__ void operator()(f32x4 (&acc)[2][2][4][2], const pg8::Unit& u, int wr, int wc, int fr, int fq) const {
#pragma unroll
        for (int ai = 0; ai < 2; ++ai)
#pragma unroll
            for (int m = 0; m < 4; ++m) { const int row = u.pm * 256 + ai * 128 + wr * 64 + m * 16 + fr;
#pragma unroll
                for (int bj = 0; bj < 2; ++bj)
#pragma unroll
                    for (int n = 0; n < 2; ++n) { const int col = u.pn * 256 + bj * 128 + wc * 32 + 16 * n + 4 * fq; const f32x4 a = acc[ai][bj][m][n];
                        u32x2 w; w.x = pk2h(a[0], a[1]); w.y = pk2h(a[2], a[3]); *(u32x2*)(YSH + (size_t)row * DM + col) = w; } }
    }
};
struct SchedOne {
    int pm, pn;
    __device__ __forceinline__ bool next(int i, pg8::Unit& u) const { if (i != 0) return false; u.pm = pm; u.pn = pn; u.ko = 0; u.nt = 0; u.keep = 0; return true; }
};
__device__ __forceinline__ void p15_shared_down_dyn(Frame& F, int qid) {
    unsigned* QH = (unsigned*)(F.ws + WS_CTL) + CW_Q + 64 * 8 * qid;
    LAS int* RED = (LAS int*)(F.lds + EX_ROW0 + 3072);
    for (;;) {
        __syncthreads();
        if (F.tid == 0) RED[0] = (int)__hip_atomic_fetch_add(QH, 1u, __ATOMIC_RELAXED, __HIP_MEMORY_SCOPE_AGENT);
        __syncthreads();
        const int t = RED[0];
        if (t >= 256) break;
        pg8::Gemm g{(const h16*)(F.ws + WS_ACTS), (const h16*)(F.ws + WS_WSDN), 256, 256, 256};
        SchedOne S; S.pm = t >> 3; S.pn = t & 7;
        EpiYsh E{(h16*)(F.ws + WS_YSH)};
        pg8::gemm_phase<EpiYsh, SchedOne>(F.lds, g, S, E);
    }
}
__device__ __forceinline__ void p15_shared_down(Frame& F) {
    pg8::Gemm g{(const h16*)(F.ws + WS_ACTS), (const h16*)(F.ws + WS_WSDN), 256, 256, 256};
    pg8::StaticOrder S; S.init(MLAT, DM, F.G, (int)blockIdx.x);
    EpiYsh E{(h16*)(F.ws + WS_YSH)};
    pg8::gemm_phase<EpiYsh, pg8::StaticOrder>(F.lds, g, S, E);
}
__device__ __forceinline__ void p16_combine(Frame& F) {
    const float* X1 = (const float*)(F.ws + WS_X1); const float* MOD = (const float*)(F.ws + WS_MOD); const h16* Y = (const h16*)(F.ws + WS_Y); const h16* YSH = (const h16*)(F.ws + WS_YSH);
    const int gw = F.vcu * NWAVES + F.wave, NGW = F.G * NWAVES;
    for (int r = gw; r < MLAT; r += NGW) {
        const int b = r / SEQ;
        f32x4 xv[8]; float ss = 0.f;
#pragma unroll
        for (int j = 0; j < 8; ++j) { const int cc = 4 * F.lane + 256 * j;
            f32x4 m = {0.f, 0.f, 0.f, 0.f};
#pragma unroll
            for (int k = 0; k < TOPK; ++k) { const int yv = *(const int*)((const unsigned char*)Y + (size_t)(r * TOPK + k) * DM + cc);
                const f32x2 lo = __builtin_amdgcn_cvt_pk_f32_fp8(yv, false), hi2 = __builtin_amdgcn_cvt_pk_f32_fp8(yv, true); m += (f32x4){lo[0], lo[1], hi2[0], hi2[1]}; }
            { const h16x4 yv = *(const h16x4*)(YSH + (size_t)r * DM + cc); m += (f32x4){(float)yv[0], (float)yv[1], (float)yv[2], (float)yv[3]}; }
            const f32x4 g2 = *(const f32x4*)(MOD + (size_t)b * (6 * DM) + 5 * DM + cc);
            xv[j] = *(const f32x4*)(X1 + (size_t)r * DM + cc) + g2 * m;
            ss += (xv[j].x * xv[j].x + xv[j].y * xv[j].y) + (xv[j].z * xv[j].z + xv[j].w * xv[j].w); }
        f32x4 nwv[8];
#pragma unroll
        for (int j = 0; j < 8; ++j) nwv[j] = *(const f32x4*)(F.final_norm + 4 * F.lane + 256 * j);
        const float rstd = 1.0f / sqrtf(wave_sum(ss) * (1.0f / DM) + EPS);
#pragma unroll
        for (int j = 0; j < 8; ++j) { const int cc = 4 * F.lane + 256 * j;
            *(f32x4*)(F.out + (size_t)r * DM + cc) = xv[j] * rstd * nwv[j]; }
    }
}

__device__ __forceinline__ void p_final_plain(Frame& F, const float* xin) {
    const int gw = F.vcu * NWAVES + F.wave, NGW = F.G * NWAVES;
    for (int r = gw; r < MLAT; r += NGW) {
        const float* src = xin + (size_t)r * DM;
        f32x4 xv[8]; float ss = 0.f;
#pragma unroll
        for (int j = 0; j < 8; ++j) { xv[j] = *(const f32x4*)(src + 4 * F.lane + 256 * j); ss += (xv[j].x * xv[j].x + xv[j].y * xv[j].y) + (xv[j].z * xv[j].z + xv[j].w * xv[j].w); }
        const float rstd = 1.0f / sqrtf(wave_sum(ss) * (1.0f / DM) + EPS);
#pragma unroll
        for (int j = 0; j < 8; ++j) { const int cc = 4 * F.lane + 256 * j; const f32x4 nw = *(const f32x4*)(F.final_norm + cc);
            *(f32x4*)(F.out + (size_t)r * DM + cc) = xv[j] * rstd * nw; }
    }
}

constexpr int N_PHASES = 15;
#ifndef DUP_PHASE
#define DUP_PHASE -1
#endif
#ifndef DUP_VAR
#define DUP_VAR 7
#endif
struct Args { const float* in[22]; float* out; unsigned char* ws; int ph_lo, ph_hi; };
__global__ void __launch_bounds__(NTHR, 2) mk_fwd(Args args) {
    extern __shared__ __attribute__((aligned(16))) unsigned char lds_raw[];
    Frame F;
    F.lds = (LAS unsigned char*)lds_raw;
    F.tid = threadIdx.x; F.lane = F.tid & 63; F.wave = __builtin_amdgcn_readfirstlane(F.tid >> 6);
    F.G = gridDim.x; { const int bx = blockIdx.x; F.vcu = (F.G % 8 == 0) ? (bx % 8) * (F.G / 8) + bx / 8 : bx; }
    F.x = args.in[0]; F.c = args.in[1]; F.ctx = args.in[2]; F.c_ctx = args.in[3]; F.w_mod = args.in[4]; F.b_mod = args.in[5]; F.norm_attn = args.in[6]; F.norm_ffn = args.in[7];
    F.w_in = args.in[8]; F.ret_decay = args.in[9]; F.diff_lambda = args.in[10]; F.diff_subln = args.in[11]; F.w_ret_o = args.in[12]; F.w_diff_o = args.in[13]; F.w_out = args.in[14];
    F.w_router = args.in[15]; F.router_bias = args.in[16]; F.w_exp_gu = args.in[17]; F.w_exp_down = args.in[18]; F.w_sh_gu = args.in[19]; F.w_sh_down = args.in[20]; F.final_norm = args.in[21];
    F.out = args.out; F.ws = args.ws;
    volatile LAS unsigned* MISC = (volatile LAS unsigned*)(F.lds + LDSCTL_OFF);
    for (int u = F.tid; u < (LDS_BYTES - LDSCTL_OFF) / 4; u += NTHR) ((LAS unsigned*)(F.lds + LDSCTL_OFF))[u] = 0u;
    __syncthreads();
    const int lo = args.ph_lo, hi = args.ph_hi;
    const bool multi = (hi - lo) > 1;
    XcdBarrier bar; bar.bar = (unsigned*)(F.ws + WS_CTL) + CW_BAR; bar.x = 0; bar.st = nullptr;
    if (multi) bar = xcd_barrier_post((unsigned*)(F.ws + WS_CTL) + CW_BAR, MISC + 8);
#define IN(k) (lo <= (k) && (k) < hi)
#define SEAM(k) do { if (IN(k) && IN((k) + 1)) flat_barrier(bar, (unsigned*)(F.ws + WS_CTL), (unsigned)((k) - lo + ((DUP_PHASE >= 0 && (k) >= DUP_PHASE && lo <= DUP_PHASE) ? 1 : 0))); } while (0)
#define DUPBAR(k) flat_barrier(bar, (unsigned*)(F.ws + WS_CTL), (unsigned)((k) - lo))

#define RUNP(k, call) do { if (IN(k)) { call; if (DUP_PHASE == (k)) { DUPBAR(k); call; } } SEAM(k); } while (0)
    RUNP(0, p0a_mod(F));
    RUNP(1, (p1_norm1(F), p0b_weights(F)));
    RUNP(2, (p2_gemm1(F), p0c_weights_dyn(F, 5)));
    RUNP(3, p3_ret_local(F));
    RUNP(4, p4_ret_scan(F));
    RUNP(5, p5_ret_out(F));
    RUNP(6, p6_attn(F));
    RUNP(7, p7_gemm2(F));
    RUNP(8, p9_gemm3(F));
    RUNP(9, p10_norm2(F));
    RUNP(10, (p11_router(F), p11b_shared_gu(F)));
    RUNP(11, (p12_topk(F), p12b_shared_act(F)));
    if (IN(12)) { p13_expert_phase<true>(F, 0); p15_shared_down_dyn(F, 4); if (DUP_PHASE == 12) { DUPBAR(12); p13_expert_phase<true>(F, 2); } } SEAM(12);
    if (IN(13)) { p13_expert_phase<false>(F, 1); if (DUP_PHASE == 13) { DUPBAR(13); p13_expert_phase<false>(F, 3); } } SEAM(13);
    if (IN(14)) { p16_combine(F); }
#undef RUNP
#undef IN
#undef SEAM
#undef DUPBAR
}

constexpr bool ONE_LAUNCH = true;
extern "C" void kernel_launch(void* const* d_in, const int* in_sizes, int n_in, void* d_out, int out_size, void* d_ws, size_t ws_size, hipStream_t stream) {
    static int grid = 0;
    if (grid == 0) {
        if (n_in != 22 || out_size != MLAT * DM || ws_size < WS_END) { fprintf(stderr, "kernel_launch: unexpected sizes n_in %d out %d ws %zu\n", n_in, out_size, ws_size); grid = -1; return; }
        int dev = 0, cus = 0;
        if (hipGetDevice(&dev) != hipSuccess || hipDeviceGetAttribute(&cus, hipDeviceAttributeMultiprocessorCount, dev) != hipSuccess) { grid = -1; return; }
        if (hipFuncSetAttribute((const void*)mk_fwd, hipFuncAttributeMaxDynamicSharedMemorySize, LDS_BYTES) != hipSuccess) { fprintf(stderr, "kernel_launch: hipFuncSetAttribute failed\n"); grid = -1; return; }
        int per_cu = 0;
        if (hipOccupancyMaxActiveBlocksPerMultiprocessor(&per_cu, (const void*)mk_fwd, NTHR, LDS_BYTES) != hipSuccess || per_cu < 1) fprintf(stderr, "kernel_launch: occupancy query reports %d\n", per_cu);
        (void)hipGetLastError();
        grid = cus;
    }
    if (grid < 0) return;
    (void)hipMemsetAsync((char*)d_ws + WS_CTL, 0, CTL_ZERO_BYTES, stream);
    Args a{};
    for (int i = 0; i < 22; ++i) a.in[i] = (const float*)d_in[i];
    a.out = (float*)d_out; a.ws = (unsigned char*)d_ws;
    if (ONE_LAUNCH) {
        a.ph_lo = 0; a.ph_hi = N_PHASES;
        hipLaunchKernelGGL(mk_fwd, dim3(grid), dim3(NTHR), LDS_BYTES, stream, a);
    } else {
        for (int p = 0; p < N_PHASES; ++p) { a.ph_lo = p; a.ph_hi = p + 1; hipLaunchKernelGGL(mk_fwd, dim3(grid), dim3(NTHR), LDS_BYTES, stream, a); }
    }
}
```
